# Optimizing an MI355X kernel written in HIP

```python
import math
import jax, jax.numpy as jnp
from jax import lax
import numpy as np

D_MODEL = 1024
BATCH = 8
SEQ = 4096
DEPTH = 1

RET_HEADS = 4
RET_QK_DIM = 128
RET_V_DIM = 256
RET_CHUNK = 128
RET_QK_WIDTH = RET_HEADS * RET_QK_DIM
RET_V_WIDTH = RET_HEADS * RET_V_DIM
ROPE_BASE = 10000.0
SGU_GROUPS = 4
SGU_GROUP_DIM = 256
SGU_CHUNK = 128
SGU_WIDTH = SGU_GROUPS * SGU_GROUP_DIM
IN_WIDTHS = (RET_QK_WIDTH, RET_QK_WIDTH, RET_V_WIDTH, RET_V_WIDTH, SGU_WIDTH, SGU_WIDTH, D_MODEL, D_MODEL)
IN_WIDTH = 7168
IN_SPLITS = (512, 1024, 2048, 3072, 4096, 5120, 6144)
PEER_HEADS = 8
PEER_N_KEYS = 128
PEER_N_EXPERTS = PEER_N_KEYS * PEER_N_KEYS
PEER_KEY_DIM = 256
PEER_HALF = PEER_KEY_DIM // 2
PEER_TOPK = 16
PEER_TOKEN_BLOCK = 128
N_MOD = 6
EPS = 1e-6

kernel_name = "hybrid_retention_sgu_peer_block"


def rms_norm(x, gain):
    xf = x.astype(jnp.float32)
    y = xf * lax.rsqrt(jnp.mean(xf * xf, axis=-1, keepdims=True) + EPS)
    return (y * gain.astype(jnp.float32)).astype(x.dtype)


def modulate(h, shift, scale):
    return h * (1 + scale[:, None, :]) + shift[:, None, :]


def rotary(x, pos):
    d = x.shape[-1]
    half = d // 2
    inv = ROPE_BASE ** (-jnp.arange(half, dtype=jnp.float32) * 2.0 / d)
    ang = pos[:, None] * inv[None, :]
    cos = jnp.cos(ang)[None, :, None, :].astype(x.dtype)
    sin = jnp.sin(ang)[None, :, None, :].astype(x.dtype)
    x1, x2 = x[..., :half], x[..., half:]
    return jnp.concatenate([x1 * cos - x2 * sin, x1 * sin + x2 * cos], axis=-1)


def retention(q, k, v):
    B, S, H, dk = q.shape
    dv = v.shape[-1]
    C = RET_CHUNK
    nc = S // C
    gamma = 1.0 - 2.0 ** (-5.0 - jnp.arange(H, dtype=jnp.float32))
    log_g = jnp.log(gamma)
    idx = jnp.arange(C, dtype=jnp.float32)
    diff = idx[:, None] - idx[None, :]
    decay_in = jnp.where((diff >= 0)[None], jnp.exp(log_g[:, None, None] * jnp.maximum(diff, 0.0)[None]), 0.0).astype(q.dtype)
    decay_q = jnp.exp(log_g[None, :] * (idx[:, None] + 1.0)).astype(q.dtype)[None, :, :, None]
    decay_k = jnp.exp(log_g[None, :] * (C - 1.0 - idx[:, None])).astype(q.dtype)[None, :, :, None]
    decay_chunk = jnp.exp(log_g * C).astype(q.dtype)[None, :, None, None]

    def to_chunks(t):
        return t.reshape(B, nc, C, H, t.shape[-1]).transpose(1, 0, 2, 3, 4)

    def step(state, inp):
        qi, ki, vi = inp
        s = jnp.einsum('bihd,bjhd->bhij', qi, ki) * decay_in
        inner = jnp.einsum('bhij,bjhv->bihv', s, vi)
        cross = jnp.einsum('bihd,bhdv->bihv', qi, state) * decay_q
        new_state = state * decay_chunk + jnp.einsum('bjhd,bjhv->bhdv', ki * decay_k, vi)
        return new_state, inner + cross

    state0 = jnp.zeros((B, H, dk, dv), q.dtype)
    _, y = lax.scan(step, state0, (to_chunks(q), to_chunks(k), to_chunks(v)))
    return y.transpose(1, 0, 2, 3, 4).reshape(B, S, H, dv)


def head_norm(y, gain):
    B, S = y.shape[:2]
    yf = y.astype(jnp.float32)
    mu = jnp.mean(yf, axis=-1, keepdims=True)
    var = jnp.mean(jnp.square(yf - mu), axis=-1, keepdims=True)
    yn = ((yf - mu) * lax.rsqrt(var + EPS)).reshape(B, S, -1)
    return (yn * gain.astype(jnp.float32)).astype(y.dtype)


def spatial_gating(u, sv, ln_g, ln_b, w_s, b_s):
    B, S, _ = u.shape
    vf = sv.astype(jnp.float32)
    mu = jnp.mean(vf, axis=-1, keepdims=True)
    var = jnp.mean(jnp.square(vf - mu), axis=-1, keepdims=True)
    vn = ((vf - mu) * lax.rsqrt(var + EPS) * ln_g.astype(jnp.float32) + ln_b.astype(jnp.float32)).astype(sv.dtype)
    nck = S // SGU_CHUNK
    vn = vn.reshape(B, nck, SGU_CHUNK, SGU_GROUPS, SGU_GROUP_DIM)
    mask = jnp.tril(jnp.ones((SGU_CHUNK, SGU_CHUNK), dtype=bool))
    ws = jnp.where(mask[None], w_s, jnp.zeros_like(w_s))
    mixed = jnp.einsum('gts,bnsgc->bntgc', ws, vn) + b_s.T[None, None, :, :, None]
    return u * mixed.reshape(B, S, SGU_WIDTH)


def peer(h, w_q, sub_keys, expert_u, expert_v):
    B, S, D = h.shape
    blocks = h.reshape(-1, PEER_TOKEN_BLOCK, D)
    K = PEER_TOPK

    def block(hb):
        T = hb.shape[0]
        q = (hb @ w_q).reshape(T, PEER_HEADS, 2, PEER_HALF)
        s = jnp.einsum('thpc,hpnc->thpn', q, sub_keys)
        sub_s, sub_i = lax.top_k(s, K)
        cand = (sub_s[:, :, 0, :, None] + sub_s[:, :, 1, None, :]).reshape(T, PEER_HEADS, K * K)
        top_s, top_i = lax.top_k(cand, K)
        k1 = jnp.take_along_axis(sub_i[:, :, 0], top_i // K, axis=-1)
        k2 = jnp.take_along_axis(sub_i[:, :, 1], top_i % K, axis=-1)
        expert = k1 * PEER_N_KEYS + k2
        g = jax.nn.softmax(top_s.astype(jnp.float32), axis=-1).astype(hb.dtype)
        ue = expert_u[expert]
        act = jax.nn.gelu(jnp.einsum('td,thkd->thk', hb, ue), approximate=False) * g
        ve = expert_v[expert]
        return jnp.einsum('thk,thkd->td', act, ve)

    return lax.map(block, blocks).reshape(B, S, D)


def setup_inputs(seed: int = 0) -> dict:
    key = jax.random.key(seed)
    ks = jax.random.split(key, 21)
    L, D = DEPTH, D_MODEL
    f32 = jnp.float32
    nrm = lambda k, shape, s: jax.random.normal(k, shape, f32) * s
    return {
        "x": nrm(ks[0], (BATCH, SEQ, D), 1.0),
        "c": nrm(ks[1], (BATCH, D), 1.0),
        "w_ada": nrm(ks[2], (L, D, N_MOD * D), 0.5 * D ** -0.5),
        "b_ada": nrm(ks[3], (L, N_MOD * D), 0.01),
        "norm1_g": 1.0 + nrm(ks[4], (L, D), 0.02),
        "w_in": nrm(ks[5], (L, D, IN_WIDTH), D ** -0.5),
        "ret_gn_g": 1.0 + nrm(ks[6], (L, RET_V_WIDTH), 0.02),
        "sgu_ln_g": 1.0 + nrm(ks[7], (L, SGU_WIDTH), 0.02),
        "sgu_ln_b": nrm(ks[8], (L, SGU_WIDTH), 0.01),
        "sgu_w": nrm(ks[9], (L, SGU_GROUPS, SGU_CHUNK, SGU_CHUNK), 0.5 * SGU_CHUNK ** -0.5),
        "sgu_b": 1.0 + nrm(ks[10], (L, SGU_GROUPS, SGU_CHUNK), 0.01),
        "w_ret_out": nrm(ks[11], (L, RET_V_WIDTH, D), RET_V_WIDTH ** -0.5),
        "w_sgu_out": nrm(ks[12], (L, SGU_WIDTH, D), SGU_WIDTH ** -0.5),
        "w_out": nrm(ks[13], (L, D, D), D ** -0.5),
        "norm2_g": 1.0 + nrm(ks[14], (L, D), 0.02),
        "peer_w_q": nrm(ks[15], (L, D, PEER_HEADS * PEER_KEY_DIM), D ** -0.5),
        "peer_sub_keys": nrm(ks[16], (L, PEER_HEADS, 2, PEER_N_KEYS, PEER_HALF), PEER_HALF ** -0.5),
        "peer_u": nrm(ks[17], (L, PEER_N_EXPERTS, D), D ** -0.5),
        "peer_v": nrm(ks[18], (L, PEER_N_EXPERTS, D), 1.0),
        "final_g": 1.0 + nrm(ks[19], (D,), 0.02),
    }


def reference(x, c, w_ada, b_ada, norm1_g, w_in, ret_gn_g, sgu_ln_g, sgu_ln_b, sgu_w, sgu_b, w_ret_out, w_sgu_out, w_out, norm2_g, peer_w_q, peer_sub_keys, peer_u, peer_v, final_g):
    B, S, D = x.shape
    pos = jnp.arange(S, dtype=jnp.float32)
    c_act = jax.nn.silu(c)
    for l in range(DEPTH):
        mod = c_act @ w_ada[l] + b_ada[l]
        shift1, scale1, gate1, shift2, scale2, gate2 = jnp.split(mod, N_MOD, axis=-1)

        h = modulate(rms_norm(x, norm1_g[l]), shift1, scale1)
        proj = h @ w_in[l]
        q, k, v, g_ret, u, sv, gate_a, gate_b = jnp.split(proj, IN_SPLITS, axis=-1)

        q = rotary(q.reshape(B, S, RET_HEADS, RET_QK_DIM), pos)
        k = rotary(k.reshape(B, S, RET_HEADS, RET_QK_DIM), pos) * (RET_QK_DIM ** -0.5)
        v = v.reshape(B, S, RET_HEADS, RET_V_DIM)
        y_ret = head_norm(retention(q, k, v), ret_gn_g[l])
        branch_a = (jax.nn.silu(g_ret) * y_ret) @ w_ret_out[l]

        y_sgu = spatial_gating(jax.nn.gelu(u, approximate=False), jax.nn.gelu(sv, approximate=False),
                               sgu_ln_g[l], sgu_ln_b[l], sgu_w[l], sgu_b[l])
        branch_b = y_sgu @ w_sgu_out[l]

        merged = jax.nn.sigmoid(gate_a) * branch_a + jax.nn.sigmoid(gate_b) * branch_b
        x = x + gate1[:, None, :] * (merged @ w_out[l])

        h2 = modulate(rms_norm(x, norm2_g[l]), shift2, scale2)
        x = x + gate2[:, None, :] * peer(h2, peer_w_q[l], peer_sub_keys[l], peer_u[l], peer_v[l])
    return rms_norm(x, final_g)
```

```cpp
#include <hip/hip_runtime.h>
#include <cstdio>
#include <cstdint>

#ifndef MK_MAXPH
#define MK_MAXPH 12
#endif
#ifndef MK_N_LAUNCHES
#define MK_N_LAUNCHES 1
#endif
namespace pg8 {
#define PG8_LAS __attribute__((address_space(3)))
typedef unsigned short bf16_t;
typedef short bf16x8 __attribute__((ext_vector_type(8)));
typedef float f32x4 __attribute__((ext_vector_type(4)));
typedef unsigned u32x4 __attribute__((ext_vector_type(4)));
constexpr int BM = 256, BK = 64, HALF = 128, HTB = HALF * BK * 2  , STAGE_BYTES = 8 * HTB, NXCD = 8, WGM = 8;

__host__ __device__ __forceinline__ int lds_byte(int r, int c) { const int st = (r >> 4) * 2 + (c >> 5), rr = r & 15, cc = c & 31, ob = rr * 64 + cc * 2; return st * 1024 + (ob ^ (((ob >> 9) & 1) << 5)); }
__host__ __device__ __forceinline__ void stage_rc(int b, int& R, int& C) { const int st = b / 1024, sb = b % 1024, swz = sb ^ (((sb >> 9) & 1) << 5); R = (st >> 1) * 16 + swz / 64; C = (st & 1) * 32 + (swz % 64) / 2; }
__host__ __device__ __forceinline__ int perm32(int rho) { const int n = rho >> 4, i = rho & 15; return 8 * (i >> 2) + 4 * n + (i & 3); }

struct Unit { int pm, pn; };
struct Gemm { const bf16_t* A; const bf16_t* Bt; int M, N, K; };

struct StaticOrder {
    int nM, nN, nwg, G, c;
    __host__ __device__ void init(int M, int N, int G_, int c_) { nM = M / BM; nN = N / BM; nwg = nM * nN; G = G_; c = c_; }
    __host__ __device__ bool next(int i, Unit& u) const {
        const long L = (long)i * G + c; if (L >= nwg) return false;
        int wgid = (int)L; { const int q = nwg / NXCD, r = nwg % NXCD, xcd = wgid % NXCD, off = wgid / NXCD; wgid = (xcd < r ? xcd * (q + 1) : r * (q + 1) + (xcd - r) * q) + off; }
        const int nig = WGM * nN, gid = wgid / nig, fm = gid * WGM, gsz = (nM - fm) < WGM ? (nM - fm) : WGM;
        u.pm = fm + ((wgid % nig) % gsz); u.pn = (wgid % nig) / gsz; return true;
    }
    __device__ __forceinline__ void a_ready(const Unit&) const {}
    __device__ __forceinline__ void done(const Unit&) const {}
};

__device__ __forceinline__ unsigned cvt_pk_bf16(float lo, float hi) { unsigned r; asm volatile("v_cvt_pk_bf16_f32 %0, %1, %2" : "=v"(r) : "v"(lo), "v"(hi)); return r; }
typedef float f32x2 __attribute__((ext_vector_type(2)));
__device__ __forceinline__ f32x2 gelu_pk(f32x2 v) {
    const f32x2 av = __builtin_elementwise_abs(v), d = av * 0.2316418882f + 1.0f;
    f32x2 t; t.x = __builtin_amdgcn_rcpf(d.x); t.y = __builtin_amdgcn_rcpf(d.y);
    f32x2 q = t * 0.5307027145f + (-0.7265760135f); q = q * t + 0.7107068705f; q = q * t + (-0.142248368f); q = q * t + 0.127414796f; q = q * t;
    const f32x2 s = (v * v) * (-0.72134752044f);
    f32x2 e; e.x = __builtin_amdgcn_exp2f(s.x); e.y = __builtin_amdgcn_exp2f(s.y);
    const f32x2 m = v * (q * e), r = v - m;
    f32x2 o; o.x = v.x < 0.f ? m.x : r.x; o.y = v.y < 0.f ? m.y : r.y; return o;
}


typedef unsigned u32x2 __attribute__((ext_vector_type(2)));
__device__ __forceinline__ float bflo(unsigned w) { return __uint_as_float(w << 16); }
__device__ __forceinline__ float bfhi(unsigned w) { return __uint_as_float(w & 0xffff0000u); }
__device__ __forceinline__ float gelu1(float v) {
    const float av = __builtin_fabsf(v), t = __builtin_amdgcn_rcpf(av * 0.2316418882f + 1.0f);
    float q = t * 0.5307027145f + (-0.7265760135f); q = q * t + 0.7107068705f; q = q * t + (-0.142248368f); q = q * t + 0.127414796f; q = q * t;
    const float e = __builtin_amdgcn_exp2f((v * v) * (-0.72134752044f));
    const float m = v * (q * e);
    return v < 0.f ? m : v - m;
}
__device__ __forceinline__ float sigm1(float v) { return __builtin_amdgcn_rcpf(1.0f + __builtin_amdgcn_exp2f(v * (-1.44269504089f))); }
__device__ __forceinline__ float silu1(float v) { return v * sigm1(v); }

struct EpiProj {
    static constexpr bool PERM = true, AFTER_DRAIN = false;
    bf16_t *Q, *Kb, *V, *G, *U, *SV, *GA, *GB; const float *cosT, *sinT;
    __device__ __forceinline__ void operator()(const f32x4 (&acc)[2][2][4][2], const Unit& u, int wr, int wc, int fr, int fq) const {
        const int colt = u.pn * BM; const int row0 = u.pm * BM + wr * 64 + fr;
        if (colt < 1024) {
            const bool isk = colt >= 512; bf16_t* base = isk ? Kb : Q; const int lc0 = (colt & 511) + wc * 32 + 8 * fq; const float sc = isk ? 0.08838834764831845f : 1.0f;
            const int fi = wc * 16 + 4 * fq;
#pragma unroll
            for (int ai = 0; ai < 2; ++ai)
#pragma unroll
                for (int m = 0; m < 4; ++m) { const int row = row0 + ai * HALF + m * 16; const int s = row & 4095;
                    f32x4 cs = *(const f32x4*)(cosT + s * 64 + fi), sn = *(const f32x4*)(sinT + s * 64 + fi);
                    cs = cs * sc; sn = sn * sc;
#pragma unroll
                    for (int bj = 0; bj < 2; ++bj) { const f32x4 v0 = acc[ai][bj][m][0], v1 = acc[ai][bj][m][1];
                        u32x4 w;
                        w.x = cvt_pk_bf16(v0[0] * cs[0] - v0[1] * sn[0], v0[0] * sn[0] + v0[1] * cs[0]);
                        w.y = cvt_pk_bf16(v0[2] * cs[1] - v0[3] * sn[1], v0[2] * sn[1] + v0[3] * cs[1]);
                        w.z = cvt_pk_bf16(v1[0] * cs[2] - v1[1] * sn[2], v1[0] * sn[2] + v1[1] * cs[2]);
                        w.w = cvt_pk_bf16(v1[2] * cs[3] - v1[3] * sn[3], v1[2] * sn[3] + v1[3] * cs[3]);
                        *(u32x4*)(base + (size_t)row * 512 + lc0 + bj * HALF) = w; } }
        } else {
            const int seg = (colt - 1024) >> 10;
            bf16_t* base = seg == 0 ? V : seg == 1 ? G : seg == 2 ? U : seg == 3 ? SV : seg == 4 ? GA : GB;
            const int lc0 = ((colt - 1024) & 1023) + wc * 32 + 8 * fq;
#pragma unroll
            for (int ai = 0; ai < 2; ++ai)
#pragma unroll
                for (int m = 0; m < 4; ++m) { const int row = row0 + ai * HALF + m * 16;
#pragma unroll
                    for (int bj = 0; bj < 2; ++bj) { f32x4 v0 = acc[ai][bj][m][0], v1 = acc[ai][bj][m][1];
                        if (seg == 1) {
#pragma unroll
                            for (int e = 0; e < 4; ++e) { v0[e] = silu1(v0[e]); v1[e] = silu1(v1[e]); }
                        } else if (seg == 2 || seg == 3) {
                            f32x2 a = gelu_pk((f32x2){v0[0], v0[1]}), b = gelu_pk((f32x2){v0[2], v0[3]}), c = gelu_pk((f32x2){v1[0], v1[1]}), d = gelu_pk((f32x2){v1[2], v1[3]});
                            v0 = (f32x4){a.x, a.y, b.x, b.y}; v1 = (f32x4){c.x, c.y, d.x, d.y};
                        } else if (seg >= 4) {
#pragma unroll
                            for (int e = 0; e < 4; ++e) { v0[e] = sigm1(v0[e]); v1[e] = sigm1(v1[e]); }
                        }
                        u32x4 w; w.x = cvt_pk_bf16(v0[0], v0[1]); w.y = cvt_pk_bf16(v0[2], v0[3]); w.z = cvt_pk_bf16(v1[0], v1[1]); w.w = cvt_pk_bf16(v1[2], v1[3]);
                        *(u32x4*)(base + (size_t)row * 1024 + lc0 + bj * HALF) = w; } }
        }
    }
};
template <bool ACCUM> struct EpiGate {
    static constexpr bool PERM = true, AFTER_DRAIN = false;
    const bf16_t* GT; bf16_t* OUT;
    __device__ __forceinline__ void operator()(const f32x4 (&acc)[2][2][4][2], const Unit& u, int wr, int wc, int fr, int fq) const {
        const int row0 = u.pm * BM + wr * 64 + fr, col0 = u.pn * BM + wc * 32 + 8 * fq;
#pragma unroll
        for (int ai = 0; ai < 2; ++ai)
#pragma unroll
            for (int m = 0; m < 4; ++m) { const size_t off = (size_t)(row0 + ai * HALF + m * 16) * 1024 + col0;
#pragma unroll
                for (int bj = 0; bj < 2; ++bj) { const f32x4 v0 = acc[ai][bj][m][0], v1 = acc[ai][bj][m][1];
                    const u32x4 g = *(const u32x4*)(GT + off + bj * HALF);
                    float o[8] = {v0[0] * bflo(g.x), v0[1] * bfhi(g.x), v0[2] * bflo(g.y), v0[3] * bfhi(g.y), v1[0] * bflo(g.z), v1[1] * bfhi(g.z), v1[2] * bflo(g.w), v1[3] * bfhi(g.w)};
                    if (ACCUM) { const u32x4 p = *(const u32x4*)(OUT + off + bj * HALF);
                        o[0] += bflo(p.x); o[1] += bfhi(p.x); o[2] += bflo(p.y); o[3] += bfhi(p.y); o[4] += bflo(p.z); o[5] += bfhi(p.z); o[6] += bflo(p.w); o[7] += bfhi(p.w); }
                    u32x4 w; w.x = cvt_pk_bf16(o[0], o[1]); w.y = cvt_pk_bf16(o[2], o[3]); w.z = cvt_pk_bf16(o[4], o[5]); w.w = cvt_pk_bf16(o[6], o[7]);
                    *(u32x4*)(OUT + off + bj * HALF) = w; } }
    }
};
struct EpiX1 {
    static constexpr bool PERM = false, AFTER_DRAIN = false;
    const float* X; const float* gate1; float* X1;
    __device__ __forceinline__ void operator()(const f32x4 (&acc)[2][2][4][2], const Unit& u, int wr, int wc, int fr, int fq) const {
        const int row0 = u.pm * BM + wr * 64 + fr, col0 = u.pn * BM + wc * 32 + 4 * fq;
        const float* gp = gate1 + (size_t)((u.pm * BM) >> 12) * 6144 + col0;
        f32x4 gv[2][2];
#pragma unroll
        for (int bj = 0; bj < 2; ++bj)
#pragma unroll
            for (int n = 0; n < 2; ++n) gv[bj][n] = *(const f32x4*)(gp + bj * HALF + n * 16);
#pragma unroll
        for (int ai = 0; ai < 2; ++ai)
#pragma unroll
            for (int m = 0; m < 4; ++m) { const size_t off = (size_t)(row0 + ai * HALF + m * 16) * 1024 + col0;
#pragma unroll
                for (int bj = 0; bj < 2; ++bj)
#pragma unroll
                    for (int n = 0; n < 2; ++n) { const f32x4 xv = *(const f32x4*)(X + off + bj * HALF + n * 16);
                        *(f32x4*)(X1 + off + bj * HALF + n * 16) = xv + gv[bj][n] * acc[ai][bj][m][n]; } }
    }
};
struct EpiPlain {
    static constexpr bool PERM = true, AFTER_DRAIN = false;
    bf16_t* O; int ldc;
    __device__ __forceinline__ void operator()(const f32x4 (&acc)[2][2][4][2], const Unit& u, int wr, int wc, int fr, int fq) const {
        const int row0 = u.pm * BM + wr * 64 + fr, col0 = u.pn * BM + wc * 32 + 8 * fq;
#pragma unroll
        for (int ai = 0; ai < 2; ++ai)
#pragma unroll
            for (int m = 0; m < 4; ++m) { bf16_t* rowp = O + (size_t)(row0 + ai * HALF + m * 16) * ldc + col0;
#pragma unroll
                for (int bj = 0; bj < 2; ++bj) { const f32x4 v0 = acc[ai][bj][m][0], v1 = acc[ai][bj][m][1];
                    u32x4 w; w.x = cvt_pk_bf16(v0[0], v0[1]); w.y = cvt_pk_bf16(v0[2], v0[3]); w.z = cvt_pk_bf16(v1[0], v1[1]); w.w = cvt_pk_bf16(v1[2], v1[3]);
                    *(u32x4*)(rowp + bj * HALF) = w; } }
    }
};
template <class Epi, class Sched, bool ALIGN_EPI = false, bool SP2 = false>
__device__ __forceinline__ void gemm_phase(PG8_LAS unsigned char* lds, const Gemm g, const Sched& S, const Epi& E) {
    const int tid = threadIdx.x, wid = __builtin_amdgcn_readfirstlane(tid >> 6), lane = tid & 63, wr = wid >> 2, wc = wid & 3, fr = lane & 15, fq = lane >> 4;
    const int K = g.K, nt = K / BK;
    unsigned voffA[2], voffB[2];
#pragma unroll
    for (int i = 0; i < 2; ++i) { int R, C; stage_rc(tid * 16 + i * 8192, R, C); const int Rb = Epi::PERM ? ((R & ~31) + perm32(R & 31)) : R;
        voffA[i] = (unsigned)(R * K + C) * 2u; voffB[i] = (unsigned)(Rb * K + C) * 2u; }
    const size_t kstep = (size_t)(BK * 2);
    const size_t hstep = (size_t)HALF * K * 2;
    const size_t tstep = 2 * hstep;
    const unsigned ldsw = (unsigned)wid * 1024u;
    const int aoff = lds_byte(wr * 64 + fr, fq * 8), boff = lds_byte(wc * 32 + fr, fq * 8);
#define PG8_SA(b, h) (((b) * 2 + (h)) * HTB)
#define PG8_SB(b, h) ((4 + (b) * 2 + (h)) * HTB)
#define PG8_STAGE(bufoff, gbase, voff) do { _Pragma("unroll") for (int _i = 0; _i < 2; ++_i) \
        __builtin_amdgcn_global_load_lds((const unsigned*)((const char*)(gbase) + (voff)[_i]), (PG8_LAS unsigned*)(lds + (bufoff) + ldsw + _i * 8192), 16, 0, 0); } while (0)
#define PG8_LDA(dst, b, h) do { _Pragma("unroll") for (int m = 0; m < 4; ++m) _Pragma("unroll") for (int k = 0; k < 2; ++k) dst[m][k] = *(const PG8_LAS bf16x8*)(lds + PG8_SA(b, h) + aoff + m * 2048 + k * 1024); } while (0)
#define PG8_LDB(dst, b, h) do { _Pragma("unroll") for (int n = 0; n < 2; ++n) _Pragma("unroll") for (int k = 0; k < 2; ++k) dst[n][k] = *(const PG8_LAS bf16x8*)(lds + PG8_SB(b, h) + boff + n * 2048 + k * 1024); } while (0)
#define PG8_MMA(ai, bj, At, Bt) do { __builtin_amdgcn_s_setprio(1); _Pragma("unroll") for (int m = 0; m < 4; ++m) _Pragma("unroll") for (int n = 0; n < 2; ++n) _Pragma("unroll") for (int k = 0; k < 2; ++k) \
        acc[ai][bj][m][n] = __builtin_amdgcn_mfma_f32_16x16x32_bf16(Bt[n][k], At[m][k], acc[ai][bj][m][n], 0, 0, 0); __builtin_amdgcn_s_setprio(0); } while (0)
#define PG8_WAIT_V(n) asm volatile("s_waitcnt vmcnt(" #n ")" ::: "memory")
#define PG8_WAIT_L(n) asm volatile("s_waitcnt lgkmcnt(" #n ")" ::: "memory")
#define PG8_BAR __builtin_amdgcn_s_barrier()
#define PG8_SCHED __builtin_amdgcn_sched_barrier(0)
    Unit cur, nxt; int ui = 0;
    if (!S.next(0, cur)) return;
    f32x4 acc[2][2][4][2];
#pragma unroll
    for (int a = 0; a < 2; ++a)
#pragma unroll
        for (int b = 0; b < 2; ++b)
#pragma unroll
            for (int m = 0; m < 4; ++m)
#pragma unroll
                for (int n = 0; n < 2; ++n) acc[a][b][m][n] = (f32x4){0.f, 0.f, 0.f, 0.f};
    bf16x8 At[4][2], B0[2][2], B1[2][2];
    const char* cA = (const char*)g.A + (size_t)cur.pm * tstep; const char* cB = (const char*)g.Bt + (size_t)cur.pn * tstep;
    S.a_ready(cur);
    if constexpr (SP2) {
        PG8_STAGE(PG8_SB(0, 0), cB, voffB); PG8_STAGE(PG8_SB(0, 1), cB + hstep, voffB); PG8_STAGE(PG8_SA(0, 0), cA, voffA); PG8_STAGE(PG8_SA(0, 1), cA + hstep, voffA);
        if (wr == 1) PG8_BAR;
        PG8_WAIT_V(2); PG8_BAR;
        PG8_STAGE(PG8_SB(1, 0), cB + kstep, voffB); PG8_STAGE(PG8_SA(1, 0), cA + kstep, voffA); PG8_STAGE(PG8_SB(1, 1), cB + hstep + kstep, voffB);
        PG8_WAIT_V(6); PG8_BAR;
    } else {
        PG8_STAGE(PG8_SB(0, 0), cB, voffB); PG8_STAGE(PG8_SA(0, 0), cA, voffA); PG8_STAGE(PG8_SB(0, 1), cB + hstep, voffB); PG8_STAGE(PG8_SA(0, 1), cA + hstep, voffA);
        if (wr == 1) PG8_BAR;
        PG8_WAIT_V(4); PG8_BAR;
        PG8_STAGE(PG8_SB(1, 0), cB + kstep, voffB); PG8_STAGE(PG8_SA(1, 0), cA + kstep, voffA); PG8_STAGE(PG8_SB(1, 1), cB + hstep + kstep, voffB);
        PG8_WAIT_V(6); PG8_BAR;
    }
    for (;;) {
        const bool has_next = S.next(ui + 1, nxt);
        const char* nA = has_next ? (const char*)g.A + (size_t)nxt.pm * tstep : cA; const char* nB = has_next ? (const char*)g.Bt + (size_t)nxt.pn * tstep : cB;
        for (int t = 0; t < nt; t += 2) {
            const bool last = (t == nt - 2);
            const char* a1 = cA + (size_t)(t + 1) * kstep;
            const char* a2 = last ? nA : cA + (size_t)(t + 2) * kstep; const char* b2 = last ? nB : cB + (size_t)(t + 2) * kstep;
            const char* a3 = a2 + kstep; const char* b3 = b2 + kstep;
            if (last && has_next) S.a_ready(nxt);
            if constexpr (SP2) {
            PG8_LDB(B0, 0, 0); PG8_LDB(B1, 0, 1); PG8_SCHED; PG8_LDA(At, 0, 0); PG8_STAGE(PG8_SA(1, 1), a1 + hstep, voffA);
            PG8_WAIT_V(8); PG8_WAIT_L(0); PG8_BAR; PG8_MMA(0, 0, At, B0); PG8_MMA(0, 1, At, B1); PG8_BAR; PG8_SCHED;
            PG8_LDA(At, 0, 1); PG8_STAGE(PG8_SB(0, 0), b2, voffB); PG8_STAGE(PG8_SB(0, 1), b2 + hstep, voffB); PG8_STAGE(PG8_SA(0, 0), a2, voffA);
            PG8_WAIT_V(8); PG8_WAIT_L(0); PG8_BAR; PG8_MMA(1, 0, At, B0); PG8_MMA(1, 1, At, B1); PG8_BAR; PG8_SCHED;
            PG8_LDB(B0, 1, 0); PG8_LDB(B1, 1, 1); PG8_SCHED; PG8_LDA(At, 1, 0); PG8_STAGE(PG8_SA(0, 1), a2 + hstep, voffA);
            PG8_WAIT_V(8); PG8_WAIT_L(0); PG8_BAR; PG8_MMA(0, 0, At, B0); PG8_MMA(0, 1, At, B1); PG8_BAR; PG8_SCHED;
            PG8_LDA(At, 1, 1); PG8_STAGE(PG8_SB(1, 0), b3, voffB); PG8_STAGE(PG8_SB(1, 1), b3 + hstep, voffB); PG8_STAGE(PG8_SA(1, 0), a3, voffA);
            PG8_WAIT_V(8); PG8_WAIT_L(0); PG8_BAR; PG8_MMA(1, 0, At, B0); PG8_MMA(1, 1, At, B1); PG8_BAR; PG8_SCHED;
            } else {
            PG8_LDB(B0, 0, 0); PG8_SCHED; PG8_LDA(At, 0, 0); PG8_STAGE(PG8_SA(1, 1), a1 + hstep, voffA);
            PG8_WAIT_L(8); PG8_BAR; PG8_WAIT_L(0); PG8_MMA(0, 0, At, B0); PG8_BAR; PG8_SCHED;
            PG8_LDB(B1, 0, 1); PG8_STAGE(PG8_SB(0, 0), b2, voffB);
            PG8_BAR; PG8_WAIT_L(0); PG8_MMA(0, 1, At, B1); PG8_BAR;
            PG8_LDA(At, 0, 1); PG8_STAGE(PG8_SA(0, 0), a2, voffA);
            PG8_BAR; PG8_WAIT_L(0); PG8_MMA(1, 0, At, B0); PG8_BAR; PG8_SCHED;
            PG8_STAGE(PG8_SB(0, 1), b2 + hstep, voffB);
            PG8_WAIT_V(6); PG8_BAR; PG8_MMA(1, 1, At, B1); PG8_BAR;
            PG8_LDB(B0, 1, 0); PG8_SCHED; PG8_LDA(At, 1, 0); PG8_STAGE(PG8_SA(0, 1), a2 + hstep, voffA);
            PG8_WAIT_L(8); PG8_BAR; PG8_WAIT_L(0); PG8_MMA(0, 0, At, B0); PG8_BAR; PG8_SCHED;
            PG8_LDB(B1, 1, 1); PG8_STAGE(PG8_SB(1, 0), b3, voffB);
            PG8_BAR; PG8_WAIT_L(0); PG8_MMA(0, 1, At, B1); PG8_BAR;
            PG8_LDA(At, 1, 1); PG8_STAGE(PG8_SA(1, 0), a3, voffA);
            PG8_BAR; PG8_WAIT_L(0); PG8_MMA(1, 0, At, B0); PG8_BAR; PG8_SCHED;
            PG8_STAGE(PG8_SB(1, 1), b3 + hstep, voffB);
            PG8_WAIT_V(6); PG8_BAR; PG8_MMA(1, 1, At, B1); PG8_BAR;
            }
        }
        if constexpr (ALIGN_EPI) { if (wr == 0) PG8_BAR; }
        if constexpr (!Epi::AFTER_DRAIN) { E(acc, cur, wr, wc, fr, fq); S.done(cur); }
        if (!has_next) break;
#pragma unroll
        for (int a = 0; a < 2; ++a)
#pragma unroll
            for (int b = 0; b < 2; ++b)
#pragma unroll
                for (int m = 0; m < 4; ++m)
#pragma unroll
                    for (int n = 0; n < 2; ++n) acc[a][b][m][n] = (f32x4){0.f, 0.f, 0.f, 0.f};
        cur = nxt; cA = nA; cB = nB; ++ui;
        if constexpr (ALIGN_EPI) { if (wr == 1) PG8_BAR; }
    }
    PG8_WAIT_V(0);
    if constexpr (!ALIGN_EPI) { if (wr == 0) PG8_BAR; }
    PG8_BAR;
    if constexpr (Epi::AFTER_DRAIN) { E.fused(acc, cur, wr, wc, fr, fq, lds, wid, lane); S.done(cur); }
#undef PG8_SA
#undef PG8_SB
#undef PG8_STAGE
#undef PG8_LDA
#undef PG8_LDB
#undef PG8_MMA
#undef PG8_WAIT_V
#undef PG8_WAIT_L
#undef PG8_BAR
#undef PG8_SCHED
}
}

constexpr int NWAVES = 8;
constexpr int N_LAUNCHES = MK_N_LAUNCHES;
constexpr int N_PHASES = 12;
constexpr int NB = 8, SEQ = 4096, DM = 1024, MT = NB * SEQ, NIN = 7168;
constexpr float EPSN = 1e-6f;

constexpr size_t MiB = 1u << 20;
constexpr size_t WS_CTL = 0, CTL_ZERO_BYTES = 1 * MiB;
constexpr size_t WS_MOD = 1 * MiB;
constexpr size_t WS_COS = 2 * MiB, WS_SIN = 3 * MiB;
constexpr size_t WS_SK = 4 * MiB;
constexpr size_t WS_SGUW = 4 * MiB + 512 * 1024;
constexpr size_t WS_WRET = 6 * MiB, WS_WSGU = 8 * MiB, WS_WOUT = 10 * MiB, WS_WQ = 12 * MiB, WS_WIN = 16 * MiB;
constexpr size_t WS_UE = 32 * MiB, WS_VE = 64 * MiB;
constexpr size_t WS_V = 96 * MiB;
constexpr size_t WS_G = 160 * MiB;
constexpr size_t WS_U = 224 * MiB;
constexpr size_t WS_SV = 288 * MiB;
constexpr size_t WS_GA = 352 * MiB, WS_GB = 416 * MiB;
constexpr size_t WS_SUB = 480 * MiB;
constexpr size_t WS_END = 512 * MiB;
constexpr size_t DO_H = 0, DO_Q = 64 * MiB, DO_K = 96 * MiB, DO_KVS = 0;

constexpr int CW_BAR = 4096;
constexpr int LDS_BYTES = 147456;
constexpr int MISC_OFF = LDS_BYTES - 256;

#define GAS __attribute__((address_space(1)))
#define LAS __attribute__((address_space(3)))
typedef unsigned short bf16;
typedef unsigned v4u __attribute__((ext_vector_type(4)));
typedef unsigned v2u __attribute__((ext_vector_type(2)));
typedef float f32x4 __attribute__((ext_vector_type(4)));
typedef float f32x2v __attribute__((ext_vector_type(2)));
typedef short bf16x8 __attribute__((ext_vector_type(8)));
typedef short s16x4 __attribute__((ext_vector_type(4)));
typedef __bf16 bf16x2_t __attribute__((ext_vector_type(2)));
typedef GAS unsigned gu32;
#define RLX_AGENT __ATOMIC_RELAXED, __HIP_MEMORY_SCOPE_AGENT
#define LDS_WAIT() asm volatile("s_waitcnt lgkmcnt(0)" ::: "memory")
using pg8::bflo; using pg8::bfhi; using pg8::gelu1;
__device__ __forceinline__ unsigned pk2(float lo, float hi) { f32x2v v = {lo, hi}; bf16x2_t b = __builtin_convertvector(v, bf16x2_t); return __builtin_bit_cast(unsigned, b); }
__device__ __forceinline__ float wave_sum(float v) {
#pragma unroll
    for (int o = 1; o < 64; o <<= 1) v += __shfl_xor(v, o);
    return v;
}
__device__ __forceinline__ float fexp2(float x) { return __builtin_amdgcn_exp2f(x); }
__device__ __forceinline__ float rl_f(float v, int l) { return __int_as_float(__builtin_amdgcn_readlane(__float_as_int(v), l)); }
__device__ __forceinline__ unsigned rl_u(unsigned v, int l) { return (unsigned)__builtin_amdgcn_readlane((int)v, l); }

#define XB_TMO      128
#define XB_XCNT(j)  (256  + 64 * (j))
#define XB_XSUB(j)  (1280 + 64 * (j))
#define XB_XGEN(j)  (2304 + 64 * (j))
#define XB_TOP      3328
#define XB_TOPGEN   3392
#define XCD_BAR_WORDS 3456
#define XB_SPIN_CAP (1u << 22)
__device__ __forceinline__ unsigned xb_ld(unsigned* p)              { return __hip_atomic_load(p, __ATOMIC_RELAXED, __HIP_MEMORY_SCOPE_AGENT); }
__device__ __forceinline__ unsigned xb_add(unsigned* p, unsigned v) { return __hip_atomic_fetch_add(p, v, __ATOMIC_RELAXED, __HIP_MEMORY_SCOPE_AGENT); }
__device__ __forceinline__ unsigned xb_xcc_id() { return (unsigned)__builtin_amdgcn_s_getreg((3 << 11) | 20) & 0xFu; }
#define XB_SPIN(cond, bar) do { unsigned _sp = 0; while (cond) { __builtin_amdgcn_s_sleep(1); \
    if ((++_sp & 255u) == 0u) { if (xb_ld(&(bar)[XB_TMO])) break; if (_sp > XB_SPIN_CAP) { atomicAdd(&(bar)[XB_TMO], 1u); break; } } } } while (0)
struct XcdBarrier { unsigned* bar; unsigned x; volatile LAS unsigned* st; };
__device__ __forceinline__ XcdBarrier xcd_barrier_post(unsigned* bar, volatile LAS unsigned* st) {
    XcdBarrier b; b.bar = bar; b.x = xb_xcc_id(); b.st = st;
    if (threadIdx.x == 0) (void)xb_add(&bar[XB_XCNT(b.x)], 1u);
    return b;
}
__device__ __forceinline__ void xcd_barrier_complete(unsigned* bar, unsigned x, unsigned& nloc, unsigned& nx) {
    const unsigned G = gridDim.x * gridDim.y * gridDim.z;
    unsigned sum, cnt, mine, sp = 0u;
    for (;;) {
        sum = 0u; cnt = 0u; mine = 0u;
#pragma unroll
        for (unsigned j = 0; j < 16; ++j) { const unsigned c = xb_ld(&bar[XB_XCNT(j)]); sum += c; cnt += (c > 0u) ? 1u : 0u; mine = (j == x) ? c : mine; }
        if (sum == G) break;
        __builtin_amdgcn_s_sleep(1);
        if ((++sp & 255u) == 0u) { if (xb_ld(&bar[XB_TMO])) break; if (sp > XB_SPIN_CAP) { atomicAdd(&bar[XB_TMO], 1u); break; } }
    }
    nloc = mine > 0u ? mine : 1u; nx = cnt > 0u ? cnt : 1u;
}
__device__ __forceinline__ void xcd_barrier(const XcdBarrier& b) {
    asm volatile("s_waitcnt vmcnt(0)" ::: "memory");
    __syncthreads();
    if (threadIdx.x == 0) {
        unsigned* bar = b.bar;
        __builtin_amdgcn_s_waitcnt(0);
        unsigned nloc = b.st[0], nx = b.st[1];
        if (nloc == 0u) { xcd_barrier_complete(bar, b.x, nloc, nx); b.st[0] = nloc; b.st[1] = nx; }
        const unsigned old = xb_add(&bar[XB_XSUB(b.x)], 1u);
        const unsigned gen = old / nloc;
        if (old + 1u == (gen + 1u) * nloc) {
            __builtin_amdgcn_fence(__ATOMIC_RELEASE, "agent");
            asm volatile("s_waitcnt vmcnt(0)" ::: "memory");
            const unsigned og = xb_add(&bar[XB_TOP], 1u);
            const unsigned tg = og / nx;
            if (og + 1u == (tg + 1u) * nx) xb_add(&bar[XB_TOPGEN], 1u);
            else XB_SPIN(xb_ld(&bar[XB_TOPGEN]) == tg, bar);
            __builtin_amdgcn_fence(__ATOMIC_ACQUIRE, "agent");
            xb_add(&bar[XB_XGEN(b.x)], 1u);
            asm volatile("s_waitcnt vmcnt(0)" ::: "memory");
        } else {
            XB_SPIN(xb_ld(&bar[XB_XGEN(b.x)]) == gen, bar);
            __builtin_amdgcn_fence(__ATOMIC_ACQUIRE, "agent");
            asm volatile("s_waitcnt vmcnt(0)" ::: "memory");
        }
    }
    __syncthreads();
}

struct Frame {
    LAS unsigned char* lds;
    int tid, lane, wave, G, bid;
    const float *x, *c, *w_ada, *b_ada, *norm1_g, *w_in, *ret_gn_g, *sgu_ln_g, *sgu_ln_b, *sgu_w, *sgu_b, *w_ret_out, *w_sgu_out, *w_out, *norm2_g, *peer_w_q, *peer_sub_keys, *peer_u, *peer_v, *final_g;
    unsigned char* ws; unsigned char* dout;
};

__device__ __forceinline__ bf16x8 lds_row_frag(LAS const unsigned char* img, int stride, int r0, int k0, int lane) {
    return *(LAS const bf16x8*)(img + (r0 + (lane & 15)) * stride + (k0 + 8 * (lane >> 4)) * 2);
}
__device__ __forceinline__ s16x4 tr16(LAS const unsigned char* p) { return __builtin_bit_cast(s16x4, __builtin_amdgcn_ds_read_tr16_b64_v4i16((LAS s16x4*)p)); }
__device__ __forceinline__ bf16x8 lds_tr_frag(LAS const unsigned char* img, int stride, int k0, int n0, int lane) {
    const int g = lane >> 4, q = (lane >> 2) & 3, p = lane & 3;
    LAS const unsigned char* a = img + (k0 + 8 * g + q) * stride + (n0 + 4 * p) * 2;
    const s16x4 lo = tr16(a), hi = tr16(a + 4 * stride);
    return __builtin_shufflevector(lo, hi, 0, 1, 2, 3, 4, 5, 6, 7);
}
#define MFMA16(a, b, c) __builtin_amdgcn_mfma_f32_16x16x32_bf16((a), (b), (c), 0, 0, 0)
constexpr int KS = 272, VS = 528;

template <class Map>
__device__ __forceinline__ void transpose_item(const float* W, int K, int N, bf16* WT, LAS float* scr, int item, int lane, Map srcmap) {
    const int nblk = N / 32, kb = item / nblk, nb = item % nblk, k0 = 64 * kb, n0 = 32 * nb;
    const int sc = srcmap(n0 + (lane & 31));
#pragma unroll 8
    for (int i = 0; i < 32; ++i) { const int kk = 2 * i + (lane >> 5); scr[kk * 33 + (lane & 31)] = W[(size_t)(k0 + kk) * N + sc]; }
    LDS_WAIT(); asm volatile("" ::: "memory");
    const int c = lane & 7;
#pragma unroll
    for (int j = 0; j < 4; ++j) { const int n = (lane >> 3) + 8 * j; const LAS float* s = scr + (8 * c) * 33 + n;
        v4u o; o.x = pk2(s[0 * 33], s[1 * 33]); o.y = pk2(s[2 * 33], s[3 * 33]); o.z = pk2(s[4 * 33], s[5 * 33]); o.w = pk2(s[6 * 33], s[7 * 33]);
        *(v4u*)(WT + (size_t)(n0 + n) * K + k0 + 8 * c) = o; }
    LDS_WAIT(); asm volatile("" ::: "memory");
}
struct MapId { __device__ __forceinline__ int operator()(int n) const { return n; } };
struct MapWin { __device__ __forceinline__ int operator()(int n) const { if (n >= 1024) return n; const int ci = n & 127; return (n & ~127) + (ci >> 1) + 64 * (ci & 1); } };

__device__ __forceinline__ void cvt8(const float* src, bf16* dst, size_t chunk) {
    const f32x4 a = *(const f32x4*)(src + chunk * 8), b = *(const f32x4*)(src + chunk * 8 + 4);
    v4u o; o.x = pk2(a[0], a[1]); o.y = pk2(a[2], a[3]); o.z = pk2(b[0], b[1]); o.w = pk2(b[2], b[3]);
    *(v4u*)(dst + chunk * 8) = o;
}

__device__ __forceinline__ void p0a(Frame& F) {
    if (F.bid < 192) {
        LAS float* sc = (LAS float*)F.lds; LAS float* part = (LAS float*)(F.lds + 32768);
        for (int i = F.tid; i < 8192; i += 512) { const float cv = F.c[i]; sc[i] = pg8::silu1(cv); }
        __syncthreads();
        const int n0 = 32 * F.bid, ks = F.tid >> 3, c4 = F.tid & 7;
        f32x4 acc[8];
#pragma unroll
        for (int b = 0; b < 8; ++b) acc[b] = (f32x4){0.f, 0.f, 0.f, 0.f};
        for (int kk = ks; kk < 1024; kk += 64) { const f32x4 w = *(const f32x4*)(F.w_ada + (size_t)kk * 6144 + n0 + 4 * c4);
#pragma unroll
            for (int b = 0; b < 8; ++b) acc[b] += w * sc[b * 1024 + kk]; }
#pragma unroll
        for (int b = 0; b < 8; ++b) *(LAS f32x4*)(part + (ks * 8 + b) * 32 + 4 * c4) = acc[b];
        __syncthreads();
        if (F.tid < 256) { const int b = F.tid >> 5, col = F.tid & 31; float s = 0.f;
            for (int k2 = 0; k2 < 64; ++k2) s += part[(k2 * 8 + b) * 32 + col];
            ((float*)(F.ws + WS_MOD))[b * 6144 + n0 + col] = s + F.b_ada[n0 + col]; }
        __syncthreads();
    }
    {
        LAS float* scr = (LAS float*)(F.lds + F.wave * 16384);
        const int gw = F.bid * NWAVES + F.wave, NGW = F.G * NWAVES;
        constexpr int I_IN = 16 * (NIN / 32), I_SQ = 16 * 32, I_Q = 16 * 64, NITEMS = I_IN + 3 * I_SQ + I_Q;
        for (int it = gw; it < NITEMS; it += NGW) {
            int r = it;
            if (r < I_IN) { transpose_item(F.w_in, 1024, NIN, (bf16*)(F.ws + WS_WIN), scr, r, F.lane, MapWin()); continue; } r -= I_IN;
            if (r < I_SQ) { transpose_item(F.w_ret_out, 1024, 1024, (bf16*)(F.ws + WS_WRET), scr, r, F.lane, MapId()); continue; } r -= I_SQ;
            if (r < I_SQ) { transpose_item(F.w_sgu_out, 1024, 1024, (bf16*)(F.ws + WS_WSGU), scr, r, F.lane, MapId()); continue; } r -= I_SQ;
            if (r < I_SQ) { transpose_item(F.w_out, 1024, 1024, (bf16*)(F.ws + WS_WOUT), scr, r, F.lane, MapId()); continue; } r -= I_SQ;
            transpose_item(F.peer_w_q, 1024, 2048, (bf16*)(F.ws + WS_WQ), scr, r, F.lane, MapId());
        }
    }
    const size_t gt = (size_t)F.bid * 512 + F.tid, NT = (size_t)F.G * 512;
    for (size_t ch = gt; ch < (size_t)16384 * 128; ch += NT) { cvt8(F.peer_u, (bf16*)(F.ws + WS_UE), ch); cvt8(F.peer_v, (bf16*)(F.ws + WS_VE), ch); }
    for (size_t ch = gt; ch < (size_t)32768; ch += NT) cvt8(F.peer_sub_keys, (bf16*)(F.ws + WS_SK), ch);
    for (size_t ch = gt; ch < (size_t)8192; ch += NT) { const int t = (int)(ch >> 4) & 127, s0 = (int)(ch & 15) * 8;
        const f32x4 a = *(const f32x4*)(F.sgu_w + ch * 8), b = *(const f32x4*)(F.sgu_w + ch * 8 + 4);
        float v[8] = {a[0], a[1], a[2], a[3], b[0], b[1], b[2], b[3]};
#pragma unroll
        for (int e = 0; e < 8; ++e) v[e] = (s0 + e <= t) ? v[e] : 0.f;
        v4u o; o.x = pk2(v[0], v[1]); o.y = pk2(v[2], v[3]); o.z = pk2(v[4], v[5]); o.w = pk2(v[6], v[7]);
        *(v4u*)((bf16*)(F.ws + WS_SGUW) + ch * 8) = o; }
    for (size_t e = gt; e < (size_t)4096 * 64; e += NT) { const int s = (int)(e >> 6), i = (int)(e & 63);
        const float inv = fexp2(-(float)i * (13.287712379549449f / 64.0f));
        const float rev = ((float)s * inv) * 0.15915494309189535f; const float fr = rev - __builtin_floorf(rev);
        ((float*)(F.ws + WS_COS))[e] = __builtin_amdgcn_cosf(fr); ((float*)(F.ws + WS_SIN))[e] = __builtin_amdgcn_sinf(fr); }
}

__device__ __forceinline__ void norm_rows(Frame& F, const float* X, const float* gain, const float* shift, const float* scale, bf16* O) {
    const int gw = F.bid * NWAVES + F.wave, NGW = F.G * NWAVES;
    for (int m = gw; m < MT; m += NGW) {
        const f32x4* xr = (const f32x4*)(X + (size_t)m * DM) + F.lane;
        f32x4 v[4]; float s = 0.f;
#pragma unroll
        for (int j = 0; j < 4; ++j) { v[j] = xr[64 * j]; s += (v[j][0] * v[j][0] + v[j][1] * v[j][1]) + (v[j][2] * v[j][2] + v[j][3] * v[j][3]); }
        const float rstd = __builtin_amdgcn_rsqf(wave_sum(s) * (1.f / DM) + EPSN);
        const int b = m >> 12;
        v2u* o8 = (v2u*)(O + (size_t)m * DM) + F.lane;
#pragma unroll
        for (int j = 0; j < 4; ++j) { const int d = 4 * F.lane + 256 * j;
            const f32x4 g = *(const f32x4*)(gain + d), sh = *(const f32x4*)(shift + b * 6144 + d), sc = *(const f32x4*)(scale + b * 6144 + d);
            const f32x4 h = v[j] * rstd * g * (sc + 1.0f) + sh;
            v2u w; w.x = pk2(h[0], h[1]); w.y = pk2(h[2], h[3]); o8[64 * j] = w; }
    }
}

__device__ __forceinline__ float lg_gamma(int h) { return __builtin_log2f(1.0f - fexp2((float)(-5 - h))); }
__device__ __forceinline__ v4u scale8(v4u w, float s) {
    v4u o; o.x = pk2(bflo(w.x) * s, bfhi(w.x) * s); o.y = pk2(bflo(w.y) * s, bfhi(w.y) * s); o.z = pk2(bflo(w.z) * s, bfhi(w.z) * s); o.w = pk2(bflo(w.w) * s, bfhi(w.w) * s); return o;
}
__device__ __forceinline__ void kv_unit(Frame& F, int u) {
    const int b = u >> 7, h = (u >> 5) & 3, c = u & 31;
    const size_t tok0 = (size_t)b * SEQ + c * 128;
    LAS unsigned char* Kimg = F.lds; LAS unsigned char* Vimg = F.lds + 34816;
    const bf16* Kb = (const bf16*)(F.dout + DO_K); const bf16* Vb = (const bf16*)(F.ws + WS_V);
    const float lg = lg_gamma(h);
#pragma unroll
    for (int i = 0; i < 4; ++i) { const int ch = F.tid + 512 * i, j = ch >> 4, cc = ch & 15;
        const v4u w = *(const v4u*)(Kb + (tok0 + j) * 512 + h * 128 + cc * 8);
        *(LAS v4u*)(Kimg + j * KS + cc * 16) = scale8(w, fexp2((float)(127 - j) * lg)); }
#pragma unroll
    for (int i = 0; i < 8; ++i) { const int ch = F.tid + 512 * i, j = ch >> 5, cc = ch & 31;
        *(LAS v4u*)(Vimg + j * VS + cc * 16) = *(const v4u*)(Vb + (tok0 + j) * 1024 + h * 256 + cc * 8); }
    __syncthreads();
    f32x4 acc[8][2];
#pragma unroll
    for (int dt = 0; dt < 8; ++dt) { acc[dt][0] = (f32x4){0.f, 0.f, 0.f, 0.f}; acc[dt][1] = (f32x4){0.f, 0.f, 0.f, 0.f}; }
#pragma unroll
    for (int js = 0; js < 4; ++js) {
        bf16x8 bv[2];
#pragma unroll
        for (int vt = 0; vt < 2; ++vt) bv[vt] = lds_tr_frag(Vimg, VS, 32 * js, 32 * F.wave + 16 * vt, F.lane);
#pragma unroll
        for (int dt = 0; dt < 8; ++dt) { const bf16x8 a = lds_tr_frag(Kimg, KS, 32 * js, 16 * dt, F.lane);
            acc[dt][0] = MFMA16(a, bv[0], acc[dt][0]); acc[dt][1] = MFMA16(a, bv[1], acc[dt][1]); }
    }
    bf16* dst = (bf16*)(F.dout + DO_KVS) + (size_t)(((b * 4 + h) * 32 + c)) * 32768;
#pragma unroll
    for (int dt = 0; dt < 8; ++dt)
#pragma unroll
        for (int vt = 0; vt < 2; ++vt) { const int v = 32 * F.wave + 16 * vt + (F.lane & 15), d0 = 16 * dt + 4 * (F.lane >> 4);
            v2u o; o.x = pk2(acc[dt][vt][0], acc[dt][vt][1]); o.y = pk2(acc[dt][vt][2], acc[dt][vt][3]);
            *(v2u*)(dst + v * 128 + d0) = o; }
    __syncthreads();
}
__device__ __forceinline__ void sgu_unit(Frame& F, int u) {
    const size_t tok0 = (size_t)u * 128;
    LAS unsigned char* Vn = F.lds; LAS unsigned char* Wimg = F.lds + 67584; LAS f32x2v* stats = (LAS f32x2v*)(F.lds + 67584 + 34816);
    const bf16* SVb = (const bf16*)(F.ws + WS_SV); bf16* Ub = (bf16*)(F.ws + WS_U); const bf16* Wm = (const bf16*)(F.ws + WS_SGUW);
    for (int rr = 0; rr < 16; ++rr) { const int r = 16 * F.wave + rr;
        const v4u* p = (const v4u*)(SVb + (tok0 + r) * 1024) + F.lane;
        const v4u a = p[0], bq = p[64]; const unsigned wv[8] = {a.x, a.y, a.z, a.w, bq.x, bq.y, bq.z, bq.w};
        float s = 0.f, s2 = 0.f;
#pragma unroll
        for (int e = 0; e < 8; ++e) { const float lo = bflo(wv[e]), hi = bfhi(wv[e]); s += lo + hi; s2 += lo * lo + hi * hi; }
        s = wave_sum(s); s2 = wave_sum(s2);
        const float mean = s * (1.f / 1024.f), var = s2 * (1.f / 1024.f) - mean * mean;
        if (F.lane == 0) stats[r] = (f32x2v){mean, __builtin_amdgcn_rsqf(var + EPSN)}; }
    __syncthreads();
    for (int g = 0; g < 4; ++g) {
#pragma unroll
        for (int i = 0; i < 8; ++i) { const int ch = F.tid + 512 * i, s = ch >> 5, cc = ch & 31; const int col = g * 256 + cc * 8;
            const v4u w = *(const v4u*)(SVb + (tok0 + s) * 1024 + col); const f32x2v st = stats[s];
            const f32x4 g0 = *(const f32x4*)(F.sgu_ln_g + col), g1 = *(const f32x4*)(F.sgu_ln_g + col + 4), b0 = *(const f32x4*)(F.sgu_ln_b + col), b1 = *(const f32x4*)(F.sgu_ln_b + col + 4);
            v4u o;
            o.x = pk2((bflo(w.x) - st.x) * st.y * g0[0] + b0[0], (bfhi(w.x) - st.x) * st.y * g0[1] + b0[1]);
            o.y = pk2((bflo(w.y) - st.x) * st.y * g0[2] + b0[2], (bfhi(w.y) - st.x) * st.y * g0[3] + b0[3]);
            o.z = pk2((bflo(w.z) - st.x) * st.y * g1[0] + b1[0], (bfhi(w.z) - st.x) * st.y * g1[1] + b1[1]);
            o.w = pk2((bflo(w.w) - st.x) * st.y * g1[2] + b1[2], (bfhi(w.w) - st.x) * st.y * g1[3] + b1[3]);
            *(LAS v4u*)(Vn + s * VS + cc * 16) = o; }
#pragma unroll
        for (int i = 0; i < 4; ++i) { const int ch = F.tid + 512 * i, t = ch >> 4, cc = ch & 15;
            *(LAS v4u*)(Wimg + t * KS + cc * 16) = *(const v4u*)(Wm + (size_t)(g * 128 + t) * 128 + cc * 8); }
        __syncthreads();
        f32x4 acc[2][8];
#pragma unroll
        for (int ct = 0; ct < 2; ++ct)
#pragma unroll
            for (int tt = 0; tt < 8; ++tt) acc[ct][tt] = (f32x4){0.f, 0.f, 0.f, 0.f};
#pragma unroll
        for (int ss = 0; ss < 4; ++ss) {
            bf16x8 av[2];
#pragma unroll
            for (int ct = 0; ct < 2; ++ct) av[ct] = lds_tr_frag(Vn, VS, 32 * ss, 32 * F.wave + 16 * ct, F.lane);
#pragma unroll
            for (int tt = 0; tt < 8; ++tt) if (tt >= 2 * ss) { const bf16x8 bw = lds_row_frag(Wimg, KS, 16 * tt, 32 * ss, F.lane);
                acc[0][tt] = MFMA16(av[0], bw, acc[0][tt]); acc[1][tt] = MFMA16(av[1], bw, acc[1][tt]); }
        }
#pragma unroll
        for (int tt = 0; tt < 8; ++tt) { const int t = 16 * tt + (F.lane & 15); const float bs = F.sgu_b[g * 128 + t];
#pragma unroll
            for (int ct = 0; ct < 2; ++ct) { const int cg = g * 256 + 32 * F.wave + 16 * ct + 4 * (F.lane >> 4);
                v2u* up = (v2u*)(Ub + (tok0 + t) * 1024 + cg); const v2u uv = *up;
                v2u o; o.x = pk2(bflo(uv.x) * (acc[ct][tt][0] + bs), bfhi(uv.x) * (acc[ct][tt][1] + bs)); o.y = pk2(bflo(uv.y) * (acc[ct][tt][2] + bs), bfhi(uv.y) * (acc[ct][tt][3] + bs));
                *up = o; } }
        __syncthreads();
    }
}
__device__ __forceinline__ void p2a(Frame& F) {
    for (int u = F.bid; u < 1024 + 256; u += F.G) { if (u < 1024) kv_unit(F, u); else sgu_unit(F, u - 1024); }
}
__device__ __forceinline__ void p2b(Frame& F) {
    bf16* KVS = (bf16*)(F.dout + DO_KVS);
    for (int item = F.bid * 512 + F.tid; item < 32 * 4096; item += F.G * 512) {
        const int bh = item >> 12, rem = item & 4095, h = bh & 3;
        const float dc = fexp2(128.0f * lg_gamma(h));
        float s[8];
#pragma unroll
        for (int e = 0; e < 8; ++e) s[e] = 0.f;
        bf16* p = KVS + (size_t)bh * 32 * 32768 + (size_t)rem * 8;
        for (int c0 = 0; c0 < 32; c0 += 8) {
            v4u kv[8];
#pragma unroll
            for (int i = 0; i < 8; ++i) kv[i] = *(const v4u*)(p + (size_t)(c0 + i) * 32768);
#pragma unroll
            for (int i = 0; i < 8; ++i) {
                v4u o; o.x = pk2(s[0], s[1]); o.y = pk2(s[2], s[3]); o.z = pk2(s[4], s[5]); o.w = pk2(s[6], s[7]);
                *(v4u*)(p + (size_t)(c0 + i) * 32768) = o;
                s[0] = s[0] * dc + bflo(kv[i].x); s[1] = s[1] * dc + bfhi(kv[i].x); s[2] = s[2] * dc + bflo(kv[i].y); s[3] = s[3] * dc + bfhi(kv[i].y);
                s[4] = s[4] * dc + bflo(kv[i].z); s[5] = s[5] * dc + bfhi(kv[i].z); s[6] = s[6] * dc + bflo(kv[i].w); s[7] = s[7] * dc + bfhi(kv[i].w);
            }
        }
    }
}
__device__ __forceinline__ void ret_unit(Frame& F, int u) {
    const int b = u >> 7, h = (u >> 5) & 3, c = u & 31;
    const size_t tok0 = (size_t)b * SEQ + c * 128;
    LAS unsigned char* Qimg = F.lds; LAS unsigned char* Kimg = F.lds + 34816; LAS unsigned char* Vimg = F.lds + 69632;
    LAS unsigned char* Sout = F.lds;
    const bf16* Qb = (const bf16*)(F.dout + DO_Q); const bf16* Kb = (const bf16*)(F.dout + DO_K); bf16* Vb = (bf16*)(F.ws + WS_V);
    const bf16* Gb = (const bf16*)(F.ws + WS_G);
    const bf16* ST = (const bf16*)(F.dout + DO_KVS) + (size_t)(((b * 4 + h) * 32 + c)) * 32768;
    const float lg = lg_gamma(h);
    const int lane = F.lane, w = F.wave, l15 = lane & 15, g4 = lane >> 4;
#pragma unroll
    for (int i = 0; i < 4; ++i) { const int ch = F.tid + 512 * i, j = ch >> 4, cc = ch & 15;
        *(LAS v4u*)(Qimg + j * KS + cc * 16) = *(const v4u*)(Qb + (tok0 + j) * 512 + h * 128 + cc * 8);
        *(LAS v4u*)(Kimg + j * KS + cc * 16) = *(const v4u*)(Kb + (tok0 + j) * 512 + h * 128 + cc * 8); }
#pragma unroll
    for (int i = 0; i < 8; ++i) { const int ch = F.tid + 512 * i, j = ch >> 5, cc = ch & 31;
        *(LAS v4u*)(Vimg + j * VS + cc * 16) = *(const v4u*)(Vb + (tok0 + j) * 1024 + h * 256 + cc * 8); }
    __syncthreads();
    f32x4 st[8];
#pragma unroll
    for (int jt = 0; jt < 8; ++jt) st[jt] = (f32x4){0.f, 0.f, 0.f, 0.f};
#pragma unroll
    for (int ds = 0; ds < 4; ++ds) { const bf16x8 bq = lds_row_frag(Qimg, KS, 16 * w, 32 * ds, lane);
#pragma unroll
        for (int jt = 0; jt < 8; ++jt) if (jt <= w) { const bf16x8 ak = lds_row_frag(Kimg, KS, 16 * jt, 32 * ds, lane); st[jt] = MFMA16(ak, bq, st[jt]); } }
    __syncthreads();
    { const int i = 16 * w + l15;
#pragma unroll
        for (int jt = 0; jt < 8; ++jt) { float o[4];
#pragma unroll
            for (int ii = 0; ii < 4; ++ii) { const int j = 16 * jt + 4 * g4 + ii; o[ii] = (i >= j) ? st[jt][ii] * fexp2((float)(i - j) * lg) : 0.f; }
            v2u pk; pk.x = pk2(o[0], o[1]); pk.y = pk2(o[2], o[3]);
            *(LAS v2u*)(Kimg + i * KS + (16 * jt + 4 * g4) * 2) = pk; } }
    __syncthreads();
    f32x4 acc[8][2];
#pragma unroll
    for (int it = 0; it < 8; ++it) { acc[it][0] = (f32x4){0.f, 0.f, 0.f, 0.f}; acc[it][1] = (f32x4){0.f, 0.f, 0.f, 0.f}; }
#pragma unroll
    for (int ds = 0; ds < 4; ++ds) { bf16x8 bs[2];
#pragma unroll
        for (int vt = 0; vt < 2; ++vt) bs[vt] = *(const bf16x8*)(ST + (size_t)(32 * w + 16 * vt + l15) * 128 + 32 * ds + 8 * g4);
#pragma unroll
        for (int it = 0; it < 8; ++it) { const bf16x8 a = lds_row_frag(Qimg, KS, 16 * it, 32 * ds, lane);
            acc[it][0] = MFMA16(a, bs[0], acc[it][0]); acc[it][1] = MFMA16(a, bs[1], acc[it][1]); } }
#pragma unroll
    for (int it = 0; it < 8; ++it)
#pragma unroll
        for (int ii = 0; ii < 4; ++ii) { const float dq = fexp2((float)(16 * it + 4 * g4 + ii + 1) * lg); acc[it][0][ii] *= dq; acc[it][1][ii] *= dq; }
#pragma unroll
    for (int js = 0; js < 4; ++js) { bf16x8 bv[2];
#pragma unroll
        for (int vt = 0; vt < 2; ++vt) bv[vt] = lds_tr_frag(Vimg, VS, 32 * js, 32 * w + 16 * vt, lane);
#pragma unroll
        for (int it = 0; it < 8; ++it) if (it >= 2 * js) { const bf16x8 a = lds_row_frag(Kimg, KS, 16 * it, 32 * js, lane);
            acc[it][0] = MFMA16(a, bv[0], acc[it][0]); acc[it][1] = MFMA16(a, bv[1], acc[it][1]); } }
    __syncthreads();
#pragma unroll
    for (int it = 0; it < 8; ++it)
#pragma unroll
        for (int vt = 0; vt < 2; ++vt)
#pragma unroll
            for (int ii = 0; ii < 4; ++ii) *(LAS float*)(Sout + (16 * it + 4 * g4 + ii) * 1040 + (32 * w + 16 * vt + l15) * 4) = acc[it][vt][ii];
    __syncthreads();
    for (int rr = 0; rr < 16; ++rr) { const int i = 16 * w + rr;
        const f32x4 y = *(LAS const f32x4*)(Sout + i * 1040 + lane * 16);
        const float mean = wave_sum((y[0] + y[1]) + (y[2] + y[3])) * (1.f / 256.f);
        const f32x4 d = y - mean;
        const float var = wave_sum((d[0] * d[0] + d[1] * d[1]) + (d[2] * d[2] + d[3] * d[3])) * (1.f / 256.f);
        const float rstd = __builtin_amdgcn_rsqf(var + EPSN);
        const f32x4 gn = *(const f32x4*)(F.ret_gn_g + h * 256 + 4 * lane);
        const size_t off = (tok0 + i) * 1024 + h * 256 + 4 * lane;
        const v2u gt = *(const v2u*)(Gb + off);
        v2u o; o.x = pk2(d[0] * rstd * gn[0] * bflo(gt.x), d[1] * rstd * gn[1] * bfhi(gt.x)); o.y = pk2(d[2] * rstd * gn[2] * bflo(gt.y), d[3] * rstd * gn[3] * bfhi(gt.y));
        *(v2u*)(Vb + off) = o; }
    __syncthreads();
}
__device__ __forceinline__ void p2c(Frame& F) { for (int u = F.bid; u < 1024; u += F.G) ret_unit(F, u); }

__device__ __forceinline__ float dppx(float v, int) { return v; }
template <int CTRL> __device__ __forceinline__ float dpp_f(float v) { return __int_as_float(__builtin_amdgcn_update_dpp(0, __float_as_int(v), CTRL, 0xF, 0xF, false)); }
template <int CTRL> __device__ __forceinline__ void merge16(float (&L)[16]) {
    float c[16];
#pragma unroll
    for (int i = 0; i < 16; ++i) c[i] = __builtin_fmaxf(L[i], dpp_f<CTRL>(L[15 - i]));
#pragma unroll
    for (int half = 8; half >= 1; half >>= 1)
#pragma unroll
        for (int i = 0; i < 16; ++i) if ((i & half) == 0) { const float hi = __builtin_fmaxf(c[i], c[i + half]), lo = __builtin_fminf(c[i], c[i + half]); c[i] = hi; c[i + half] = lo; }
#pragma unroll
    for (int i = 0; i < 16; ++i) L[i] = c[i];
}
__device__ __forceinline__ void score_unit(Frame& F, int u) {
    const int tt = u >> 4, hp = u & 15; const size_t tok0 = (size_t)tt * 128;
    LAS unsigned char* Aimg = F.lds; LAS unsigned char* Bimg = F.lds + 34816; LAS float* Sc = (LAS float*)(F.lds + 69632);
    const bf16* QP = (const bf16*)(F.ws + WS_GA); const bf16* SK = (const bf16*)(F.ws + WS_SK) + (size_t)hp * 16384;
    const int lane = F.lane, w = F.wave;
#pragma unroll
    for (int i = 0; i < 4; ++i) { const int ch = F.tid + 512 * i, r = ch >> 4, cc = ch & 15;
        *(LAS v4u*)(Aimg + r * KS + cc * 16) = *(const v4u*)(QP + (tok0 + r) * 2048 + hp * 128 + cc * 8);
        *(LAS v4u*)(Bimg + r * KS + cc * 16) = *(const v4u*)(SK + (size_t)r * 128 + cc * 8); }
    __syncthreads();
    f32x4 acc[8];
#pragma unroll
    for (int nt = 0; nt < 8; ++nt) acc[nt] = (f32x4){0.f, 0.f, 0.f, 0.f};
#pragma unroll
    for (int ks = 0; ks < 4; ++ks) { const bf16x8 a = lds_row_frag(Aimg, KS, 16 * w, 32 * ks, lane);
#pragma unroll
        for (int nt = 0; nt < 8; ++nt) { const bf16x8 bb = lds_row_frag(Bimg, KS, 16 * nt, 32 * ks, lane); acc[nt] = MFMA16(a, bb, acc[nt]); } }
#pragma unroll
    for (int nt = 0; nt < 8; ++nt)
#pragma unroll
        for (int ii = 0; ii < 4; ++ii) Sc[(16 * w + 4 * (lane >> 4) + ii) * 132 + 16 * nt + (lane & 15)] = acc[nt][ii];
    __syncthreads();
    { const int row = F.tid >> 2, q = F.tid & 3;
        float L[16];
#pragma unroll
        for (int i = 0; i < 16; ++i) L[i] = -__builtin_inff();
        for (int i = 0; i < 32; ++i) { const int n = 4 * i + q;
            float x = __uint_as_float((__float_as_uint(Sc[row * 132 + n]) & 0xFFFFFF80u) | (unsigned)n);
#pragma unroll
            for (int p = 0; p < 16; ++p) { const float hi = __builtin_fmaxf(L[p], x); x = __builtin_fminf(L[p], x); L[p] = hi; } }
        merge16<0xB1>(L); merge16<0x4E>(L);
        if (q == 0) { v4u* dst = (v4u*)((unsigned*)(F.ws + WS_SUB) + ((tok0 + row) * 16 + hp) * 16);
#pragma unroll
            for (int i = 0; i < 4; ++i) dst[i] = (v4u){__float_as_uint(L[4 * i]), __float_as_uint(L[4 * i + 1]), __float_as_uint(L[4 * i + 2]), __float_as_uint(L[4 * i + 3])}; } }
    __syncthreads();
}
__device__ __forceinline__ void p5b(Frame& F) { for (int u = F.bid; u < 4096; u += F.G) score_unit(F, u); }

__device__ __forceinline__ void p6(Frame& F) {
    const int lane = F.lane;
    LAS unsigned* Eid = (LAS unsigned*)(F.lds + F.wave * 2048); LAS float* Gw = (LAS float*)(F.lds + F.wave * 2048 + 512); LAS float* Act = (LAS float*)(F.lds + F.wave * 2048 + 1024);
    const unsigned* SUB = (const unsigned*)(F.ws + WS_SUB);
    const bf16* H2 = (const bf16*)(F.ws + WS_SV); const bf16* UE = (const bf16*)(F.ws + WS_UE); const bf16* VE = (const bf16*)(F.ws + WS_VE);
    float* X1 = (float*)F.dout; const float* gate2 = (const float*)(F.ws + WS_MOD) + 5120;
    int ci = (lane >= 16) + (lane >= 24) + (lane >= 29) + (lane >= 33) + (lane >= 36) + (lane >= 38) + (lane >= 40) + (lane >= 42) + (lane >= 43) + (lane >= 44) + (lane >= 45) + (lane >= 46) + (lane >= 47) + (lane >= 48) + (lane >= 49);
    const int st0 = ci == 0 ? 0 : ci == 1 ? 16 : ci == 2 ? 24 : ci == 3 ? 29 : ci == 4 ? 33 : ci == 5 ? 36 : ci == 6 ? 38 : ci == 7 ? 40 : 34 + ci;
    int cj = lane - st0; const bool valid = lane < 50; if (!valid) { ci = 0; cj = 0; }
    const int gw = F.bid * NWAVES + F.wave, NGW = F.G * NWAVES;
    for (int t = gw; t < MT; t += NGW) {
        for (int h = 0; h < 8; ++h) {
            const unsigned ab = SUB[((size_t)t * 16 + 2 * h) * 16 + ci], bb = SUB[((size_t)t * 16 + 2 * h + 1) * 16 + cj];
            const float val = valid ? __uint_as_float(ab) + __uint_as_float(bb) : -__builtin_inff();
            int rank = 0;
            for (int cnd = 0; cnd < 50; ++cnd) { const float vc = rl_f(val, cnd); rank += (vc > val || (vc == val && cnd < lane)) ? 1 : 0; }
            const bool sel = valid && rank < 16;
            const float mx = rl_f(val, 0);
            const float e = sel ? fexp2((val - mx) * 1.44269504089f) : 0.f;
            const float sum = wave_sum(e);
            if (sel) { Eid[h * 16 + rank] = (ab & 127u) * 128u + (bb & 127u); Gw[h * 16 + rank] = e / sum; }
        }
        LDS_WAIT(); asm volatile("" ::: "memory");
        const v4u* hp = (const v4u*)(H2 + (size_t)t * DM) + lane; const v4u ha = hp[0], hb = hp[64];
        const unsigned hw[8] = {ha.x, ha.y, ha.z, ha.w, hb.x, hb.y, hb.z, hb.w};
        for (int p0 = 0; p0 < 128; p0 += 64) {
            const unsigned myE = Eid[p0 + lane]; const float myG = Gw[p0 + lane];
            float dots = 0.f;
            for (int pp = 0; pp < 64; pp += 8) {
                v4u ua[8], ub[8];
#pragma unroll
                for (int k = 0; k < 8; ++k) { const unsigned e = rl_u(myE, pp + k); const v4u* up = (const v4u*)(UE + (size_t)e * DM) + lane; ua[k] = up[0]; ub[k] = up[64]; }
#pragma unroll
                for (int k = 0; k < 8; ++k) { const unsigned uw[8] = {ua[k].x, ua[k].y, ua[k].z, ua[k].w, ub[k].x, ub[k].y, ub[k].z, ub[k].w};
                    float s = 0.f;
#pragma unroll
                    for (int e2 = 0; e2 < 8; ++e2) s = __builtin_amdgcn_fdot2_f32_bf16(__builtin_bit_cast(bf16x2_t, hw[e2]), __builtin_bit_cast(bf16x2_t, uw[e2]), s, false);
                    s = wave_sum(s);
                    dots = (lane == pp + k) ? s : dots; }
            }
            Act[p0 + lane] = gelu1(dots) * myG;
        }
        LDS_WAIT(); asm volatile("" ::: "memory");
        float acc[16];
#pragma unroll
        for (int e = 0; e < 16; ++e) acc[e] = 0.f;
        for (int p0 = 0; p0 < 128; p0 += 64) {
            const unsigned myE = Eid[p0 + lane]; const float myA = Act[p0 + lane];
            for (int pp = 0; pp < 64; pp += 8) {
                v4u va[8], vb[8];
#pragma unroll
                for (int k = 0; k < 8; ++k) { const unsigned e = rl_u(myE, pp + k); const v4u* vp = (const v4u*)(VE + (size_t)e * DM) + lane; va[k] = vp[0]; vb[k] = vp[64]; }
#pragma unroll
                for (int k = 0; k < 8; ++k) { const float a = rl_f(myA, pp + k);
                    acc[0] += a * bflo(va[k].x); acc[1] += a * bfhi(va[k].x); acc[2] += a * bflo(va[k].y); acc[3] += a * bfhi(va[k].y);
                    acc[4] += a * bflo(va[k].z); acc[5] += a * bfhi(va[k].z); acc[6] += a * bflo(va[k].w); acc[7] += a * bfhi(va[k].w);
                    acc[8] += a * bflo(vb[k].x); acc[9] += a * bfhi(vb[k].x); acc[10] += a * bflo(vb[k].y); acc[11] += a * bfhi(vb[k].y);
                    acc[12] += a * bflo(vb[k].z); acc[13] += a * bfhi(vb[k].z); acc[14] += a * bflo(vb[k].w); acc[15] += a * bfhi(vb[k].w); }
            }
        }
        const int b = t >> 12; float* xr = X1 + (size_t)t * DM; float ss = 0.f; f32x4 xo[4];
#pragma unroll
        for (int q = 0; q < 4; ++q) { const int d = (q >> 1) * 512 + 8 * lane + 4 * (q & 1);
            const f32x4 xv = *(const f32x4*)(xr + d), g2 = *(const f32x4*)(gate2 + (size_t)b * 6144 + d);
            f32x4 o; o[0] = xv[0] + g2[0] * acc[4 * q]; o[1] = xv[1] + g2[1] * acc[4 * q + 1]; o[2] = xv[2] + g2[2] * acc[4 * q + 2]; o[3] = xv[3] + g2[3] * acc[4 * q + 3];
            xo[q] = o; ss += (o[0] * o[0] + o[1] * o[1]) + (o[2] * o[2] + o[3] * o[3]); }
        const float rstd = __builtin_amdgcn_rsqf(wave_sum(ss) * (1.f / DM) + EPSN);
#pragma unroll
        for (int q = 0; q < 4; ++q) { const int d = (q >> 1) * 512 + 8 * lane + 4 * (q & 1);
            const f32x4 fg = *(const f32x4*)(F.final_g + d); *(f32x4*)(xr + d) = xo[q] * rstd * fg; }
    }
}

struct Args { const float* in[20]; float* out; unsigned char* ws; int ph_lo, ph_hi, li, pad; };
__global__ void __launch_bounds__(NWAVES * 64, 2) mk_fwd(Args args) {
    extern __shared__ __attribute__((aligned(16))) unsigned char lds_raw[];
    Frame F;
    F.lds = (LAS unsigned char*)lds_raw;
    F.tid = threadIdx.x; F.lane = F.tid & 63; F.wave = __builtin_amdgcn_readfirstlane(F.tid >> 6); F.G = gridDim.x; F.bid = blockIdx.x;
    F.x = args.in[0]; F.c = args.in[1]; F.w_ada = args.in[2]; F.b_ada = args.in[3]; F.norm1_g = args.in[4]; F.w_in = args.in[5]; F.ret_gn_g = args.in[6]; F.sgu_ln_g = args.in[7];
    F.sgu_ln_b = args.in[8]; F.sgu_w = args.in[9]; F.sgu_b = args.in[10]; F.w_ret_out = args.in[11]; F.w_sgu_out = args.in[12]; F.w_out = args.in[13]; F.norm2_g = args.in[14];
    F.peer_w_q = args.in[15]; F.peer_sub_keys = args.in[16]; F.peer_u = args.in[17]; F.peer_v = args.in[18]; F.final_g = args.in[19];
    F.ws = args.ws; F.dout = (unsigned char*)args.out;
    volatile LAS unsigned* MISC = (volatile LAS unsigned*)(F.lds + MISC_OFF);
    if (F.tid < 64) MISC[F.tid] = 0u;
    __syncthreads();
    XcdBarrier bar; bar.bar = (unsigned*)(F.ws + WS_CTL) + CW_BAR; bar.x = 0; bar.st = nullptr;
    if (N_LAUNCHES == 1) bar = xcd_barrier_post((unsigned*)(F.ws + WS_CTL) + CW_BAR, MISC + 8);
    const int lo = args.ph_lo, hi = args.ph_hi;
#define IN(k) (lo <= (k) && (k) < hi)
#define SEAM(k) do { if (IN(k) && IN((k) + 1)) xcd_barrier(bar); } while (0)
    const float* mod = (const float*)(F.ws + WS_MOD);
    bf16* H = (bf16*)(F.dout + DO_H);
    if (IN(0)) { p0a(F); SEAM(0); }
    if (IN(1)) { norm_rows(F, F.x, F.norm1_g, mod + 0, mod + 1024, H); SEAM(1); }
    if (IN(2)) {
        pg8::Gemm g{H, (const bf16*)(F.ws + WS_WIN), MT, NIN, DM}; pg8::StaticOrder S; S.init(MT, NIN, F.G, F.bid);
        pg8::EpiProj E{(bf16*)(F.dout + DO_Q), (bf16*)(F.dout + DO_K), (bf16*)(F.ws + WS_V), (bf16*)(F.ws + WS_G), (bf16*)(F.ws + WS_U), (bf16*)(F.ws + WS_SV), (bf16*)(F.ws + WS_GA), (bf16*)(F.ws + WS_GB),
                       (const float*)(F.ws + WS_COS), (const float*)(F.ws + WS_SIN)};
        pg8::gemm_phase<pg8::EpiProj, pg8::StaticOrder, true, true>(F.lds, g, S, E);
        SEAM(2);
    }
    if (IN(3)) { p2a(F); SEAM(3); }
    if (IN(4)) { p2b(F); SEAM(4); }
    if (IN(5)) { p2c(F); SEAM(5); }
    if (IN(6)) {
        pg8::StaticOrder S; S.init(MT, DM, F.G, F.bid);
        { pg8::Gemm g{(const bf16*)(F.ws + WS_V), (const bf16*)(F.ws + WS_WRET), MT, DM, DM}; pg8::EpiGate<false> E{(const bf16*)(F.ws + WS_GA), (bf16*)(F.ws + WS_G)};
          pg8::gemm_phase<pg8::EpiGate<false>, pg8::StaticOrder, true, true>(F.lds, g, S, E); }
        { pg8::Gemm g{(const bf16*)(F.ws + WS_U), (const bf16*)(F.ws + WS_WSGU), MT, DM, DM}; pg8::EpiGate<true> E{(const bf16*)(F.ws + WS_GB), (bf16*)(F.ws + WS_G)};
          pg8::gemm_phase<pg8::EpiGate<true>, pg8::StaticOrder, true, true>(F.lds, g, S, E); }
        SEAM(6);
    }
    if (IN(7)) {
        pg8::Gemm g{(const bf16*)(F.ws + WS_G), (const bf16*)(F.ws + WS_WOUT), MT, DM, DM}; pg8::StaticOrder S; S.init(MT, DM, F.G, F.bid);
        pg8::EpiX1 E{F.x, mod + 2048, (float*)F.dout};
        pg8::gemm_phase<pg8::EpiX1, pg8::StaticOrder, true, true>(F.lds, g, S, E);
        SEAM(7);
    }
    if (IN(8)) { norm_rows(F, (const float*)F.dout, F.norm2_g, mod + 3072, mod + 4096, (bf16*)(F.ws + WS_SV)); SEAM(8); }
    if (IN(9)) {
        pg8::Gemm g{(const bf16*)(F.ws + WS_SV), (const bf16*)(F.ws + WS_WQ), MT, 2048, DM}; pg8::StaticOrder S; S.init(MT, 2048, F.G, F.bid);
        pg8::EpiPlain E{(bf16*)(F.ws + WS_GA), 2048};
        pg8::gemm_phase<pg8::EpiPlain, pg8::StaticOrder, true, true>(F.lds, g, S, E);
        SEAM(9);
    }
    if (IN(10)) { p5b(F); SEAM(10); }
    if (IN(11)) { p6(F); }
#undef IN
#undef SEAM
}

extern "C" void kernel_launch(void* const* d_in, const int* in_sizes, int n_in, void* d_out, int out_size, void* d_ws, size_t ws_size, hipStream_t stream) {
    static int grid = 0;
    if (grid == 0) {
        if (n_in != 20 || out_size != MT * DM || ws_size < WS_END) { fprintf(stderr, "kernel_launch: unexpected shapes (n_in %d, out %d, ws %zu); nothing launched\n", n_in, out_size, ws_size); grid = -1; return; }
        int dev = 0, cus = 0, per_cu = 0;
        if (hipGetDevice(&dev) != hipSuccess || hipDeviceGetAttribute(&cus, hipDeviceAttributeMultiprocessorCount, dev) != hipSuccess) { grid = -1; return; }
        if (hipFuncSetAttribute((const void*)mk_fwd, hipFuncAttributeMaxDynamicSharedMemorySize, LDS_BYTES) != hipSuccess) { fprintf(stderr, "kernel_launch: hipFuncSetAttribute failed\n"); grid = -1; return; }
        if (hipOccupancyMaxActiveBlocksPerMultiprocessor(&per_cu, (const void*)mk_fwd, NWAVES * 64, LDS_BYTES) != hipSuccess || per_cu < 1)
            fprintf(stderr, "kernel_launch: note: occupancy query reports %d workgroups per CU\n", per_cu);
        (void)hipGetLastError();
        grid = cus;
    }
    if (grid < 0) return;
    if (hipMemsetAsync((char*)d_ws + WS_CTL, 0, CTL_ZERO_BYTES, stream) != hipSuccess) { fprintf(stderr, "kernel_launch: memset failed\n"); return; }
    Args a{};
    for (int i = 0; i < 20; ++i) a.in[i] = (const float*)d_in[i];
    a.out = (float*)d_out; a.ws = (unsigned char*)d_ws;
    static_assert(N_LAUNCHES == 1 || N_LAUNCHES == N_PHASES, "N_LAUNCHES is 1 or 12");
    for (int li = 0; li < N_LAUNCHES && li < MK_MAXPH; ++li) {
        a.ph_lo = (N_LAUNCHES == 1) ? 0 : li; a.ph_hi = (N_LAUNCHES == 1) ? N_PHASES : li + 1; a.li = li;
        hipLaunchKernelGGL(mk_fwd, dim3(grid), dim3(NWAVES * 64), LDS_BYTES, stream, a);
        const hipError_t le = hipPeekAtLastError();
        if (le != hipSuccess) { fprintf(stderr, "kernel_launch: launch %d failed: %s\n", li, hipGetErrorName(le)); break; }
    }
}
```

```cpp
#include <hip/hip_runtime.h>
#include <cstdio>
#include <cstdint>

#ifndef MK_PROBE_LO
#define MK_PROBE_LO 0
#define MK_PROBE_HI 0
#endif
#ifndef MK_GPROBE
#define MK_GPROBE 0
#endif
#define MK_MISC_OFF (147456 - 256)
#ifndef MK_U4
#define MK_U4 1
#endif
#ifndef MK_ALAY
#define MK_ALAY 2
#endif
#ifndef MK_MAXPH
#define MK_MAXPH 16
#endif
#ifndef MK_N_LAUNCHES
#define MK_N_LAUNCHES 1
#endif
namespace pg8 {
#define PG8_LAS __attribute__((address_space(3)))
typedef unsigned short bf16_t;
typedef short bf16x8 __attribute__((ext_vector_type(8)));
typedef float f32x4 __attribute__((ext_vector_type(4)));
typedef unsigned u32x4 __attribute__((ext_vector_type(4)));
constexpr int BM = 256, BK = 64, HALF = 128, HTB = HALF * BK * 2  , STAGE_BYTES = 8 * HTB, NXCD = 8, WGM = 8;

__host__ __device__ __forceinline__ int lds_byte(int r, int c) { const int st = (r >> 4) * 2 + (c >> 5), rr = r & 15, cc = c & 31, ob = rr * 64 + cc * 2; return st * 1024 + (ob ^ (((ob >> 9) & 1) << 5)); }
__host__ __device__ __forceinline__ void stage_rc(int b, int& R, int& C) { const int st = b / 1024, sb = b % 1024, swz = sb ^ (((sb >> 9) & 1) << 5); R = (st >> 1) * 16 + swz / 64; C = (st & 1) * 32 + (swz % 64) / 2; }
__host__ __device__ __forceinline__ int perm32(int rho) { const int n = rho >> 4, i = rho & 15; return 8 * (i >> 2) + 4 * n + (i & 3); }

struct Unit { int pm, pn; };
struct Gemm { const bf16_t* A; const bf16_t* Bt; int M, N, K; };

struct StaticOrder {
    int nM, nN, nwg, G, c;
    __host__ __device__ void init(int M, int N, int G_, int c_) { nM = M / BM; nN = N / BM; nwg = nM * nN; G = G_; c = c_; }
    __host__ __device__ bool next(int i, Unit& u) const {
        const long L = (long)i * G + c; if (L >= nwg) return false;
        int wgid = (int)L; { const int q = nwg / NXCD, r = nwg % NXCD, xcd = wgid % NXCD, off = wgid / NXCD; wgid = (xcd < r ? xcd * (q + 1) : r * (q + 1) + (xcd - r) * q) + off; }
        const int nig = WGM * nN, gid = wgid / nig, fm = gid * WGM, gsz = (nM - fm) < WGM ? (nM - fm) : WGM;
        u.pm = fm + ((wgid % nig) % gsz); u.pn = (wgid % nig) / gsz; return true;
    }
    __device__ __forceinline__ void a_ready(const Unit&) const {}
    __device__ __forceinline__ void done(const Unit&) const {}
};

__device__ __forceinline__ unsigned cvt_pk_bf16(float lo, float hi) { unsigned r; asm volatile("v_cvt_pk_bf16_f32 %0, %1, %2" : "=v"(r) : "v"(lo), "v"(hi)); return r; }
typedef float f32x2 __attribute__((ext_vector_type(2)));
__device__ __forceinline__ f32x2 gelu_pk(f32x2 v) {
    const f32x2 av = __builtin_elementwise_abs(v), d = av * 0.2316418882f + 1.0f;
    f32x2 t; t.x = __builtin_amdgcn_rcpf(d.x); t.y = __builtin_amdgcn_rcpf(d.y);
    f32x2 q = t * 0.5307027145f + (-0.7265760135f); q = q * t + 0.7107068705f; q = q * t + (-0.142248368f); q = q * t + 0.127414796f; q = q * t;
    const f32x2 s = (v * v) * (-0.72134752044f);
    f32x2 e; e.x = __builtin_amdgcn_exp2f(s.x); e.y = __builtin_amdgcn_exp2f(s.y);
    const f32x2 m = v * (q * e), r = v - m;
    f32x2 o; o.x = v.x < 0.f ? m.x : r.x; o.y = v.y < 0.f ? m.y : r.y; return o;
}


typedef unsigned u32x2 __attribute__((ext_vector_type(2)));
__device__ __forceinline__ float bflo(unsigned w) { return __uint_as_float(w << 16); }
__device__ __forceinline__ float bfhi(unsigned w) { return __uint_as_float(w & 0xffff0000u); }
__device__ __forceinline__ float gelu1(float v) {
    const float av = __builtin_fabsf(v), t = __builtin_amdgcn_rcpf(av * 0.2316418882f + 1.0f);
    float q = t * 0.5307027145f + (-0.7265760135f); q = q * t + 0.7107068705f; q = q * t + (-0.142248368f); q = q * t + 0.127414796f; q = q * t;
    const float e = __builtin_amdgcn_exp2f((v * v) * (-0.72134752044f));
    const float m = v * (q * e);
    return v < 0.f ? m : v - m;
}
__device__ __forceinline__ float sigm1(float v) { return __builtin_amdgcn_rcpf(1.0f + __builtin_amdgcn_exp2f(v * (-1.44269504089f))); }
__device__ __forceinline__ float silu1(float v) { return v * sigm1(v); }

__device__ __forceinline__ unsigned bperm(int idx, unsigned v) { return (unsigned)__builtin_amdgcn_ds_bpermute(idx, (int)v); }
__device__ __forceinline__ float bpermf(int idx, float v) { return __int_as_float(__builtin_amdgcn_ds_bpermute(idx, __float_as_int(v))); }
__device__ __forceinline__ f32x4 bperm4(int idx, const f32x4& v) { return (f32x4){bpermf(idx, v[0]), bpermf(idx, v[1]), bpermf(idx, v[2]), bpermf(idx, v[3])}; }
__device__ __forceinline__ u32x4 bperm4u(int idx, const u32x4& v) { u32x4 r; r.x = bperm(idx, v.x); r.y = bperm(idx, v.y); r.z = bperm(idx, v.z); r.w = bperm(idx, v.w); return r; }
#define PG8_REMAP() const int lane_ = 16 * fq + fr, pidx = (16 * (lane_ & 3) + (lane_ >> 2)) * 4, fr2 = lane_ >> 2, fq2 = lane_ & 3

struct EpiProj {
    static constexpr bool PERM = true, AFTER_DRAIN = false;
    bf16_t *Q, *Kb, *V, *G, *U, *SV, *GA, *GB; const float *cosT, *sinT; float osc; float* svstat;
    __device__ __forceinline__ void operator()(const f32x4 (&acc)[2][2][4][2], const Unit& u, int wr, int wc, int fr, int fq) const {
        PG8_REMAP();
        const int colt = u.pn * BM; const int row0 = u.pm * BM + wr * 64 + fr2;
        if (colt < 1024) {
            const bool isk = colt >= 512; bf16_t* base = isk ? Kb : Q; const int lc0 = (colt & 511) + wc * 32 + 8 * fq2; const float sc = (isk ? 0.08838834764831845f : 1.0f) * osc;
            const int fi = wc * 16 + 4 * fq2;
#pragma unroll
            for (int ai = 0; ai < 2; ++ai) {
                f32x4 csv[4], snv[4];
#pragma unroll
                for (int m = 0; m < 4; ++m) { const int s = (row0 + ai * HALF + m * 16) & 4095; csv[m] = *(const f32x4*)(cosT + s * 64 + fi) * sc; snv[m] = *(const f32x4*)(sinT + s * 64 + fi) * sc; }
#pragma unroll
                for (int m = 0; m < 4; ++m) { const int row = row0 + ai * HALF + m * 16; const f32x4 cs = csv[m], sn = snv[m];
#pragma unroll
                    for (int bj = 0; bj < 2; ++bj) { const f32x4 v0 = bperm4(pidx, acc[ai][bj][m][0]), v1 = bperm4(pidx, acc[ai][bj][m][1]);
                        u32x4 w;
                        w.x = cvt_pk_bf16(v0[0] * cs[0] - v0[1] * sn[0], v0[0] * sn[0] + v0[1] * cs[0]);
                        w.y = cvt_pk_bf16(v0[2] * cs[1] - v0[3] * sn[1], v0[2] * sn[1] + v0[3] * cs[1]);
                        w.z = cvt_pk_bf16(v1[0] * cs[2] - v1[1] * sn[2], v1[0] * sn[2] + v1[1] * cs[2]);
                        w.w = cvt_pk_bf16(v1[2] * cs[3] - v1[3] * sn[3], v1[2] * sn[3] + v1[3] * cs[3]);
                        *(u32x4*)(base + (size_t)row * 512 + lc0 + bj * HALF) = w; } } }
        } else {
            const int seg = (colt - 1024) >> 10;
            bf16_t* base = seg == 0 ? V : seg == 1 ? G : seg == 2 ? U : seg == 3 ? SV : seg == 4 ? GA : GB;
            const int lc0 = ((colt - 1024) & 1023) + wc * 32 + 8 * fq2;
#pragma unroll
            for (int ai = 0; ai < 2; ++ai)
#pragma unroll
                for (int m = 0; m < 4; ++m) { const int row = row0 + ai * HALF + m * 16; float s1[2] = {0.f, 0.f}, s2[2] = {0.f, 0.f};
#pragma unroll
                    for (int bj = 0; bj < 2; ++bj) { f32x4 v0 = acc[ai][bj][m][0] * osc, v1 = acc[ai][bj][m][1] * osc;
                        if (seg == 1) {
#pragma unroll
                            for (int e = 0; e < 4; ++e) { v0[e] = silu1(v0[e]); v1[e] = silu1(v1[e]); }
                        } else if (seg == 2 || seg == 3) {
                            f32x2 a = gelu_pk((f32x2){v0[0], v0[1]}), b = gelu_pk((f32x2){v0[2], v0[3]}), c = gelu_pk((f32x2){v1[0], v1[1]}), d = gelu_pk((f32x2){v1[2], v1[3]});
                            v0 = (f32x4){a.x, a.y, b.x, b.y}; v1 = (f32x4){c.x, c.y, d.x, d.y};
                        } else if (seg >= 4) {
#pragma unroll
                            for (int e = 0; e < 4; ++e) { v0[e] = sigm1(v0[e]); v1[e] = sigm1(v1[e]); }
                        }
                        if (seg == 3) { s1[bj] = ((v0[0] + v0[1]) + (v0[2] + v0[3])) + ((v1[0] + v1[1]) + (v1[2] + v1[3]));
                            s2[bj] = ((v0[0] * v0[0] + v0[1] * v0[1]) + (v0[2] * v0[2] + v0[3] * v0[3])) + ((v1[0] * v1[0] + v1[1] * v1[1]) + (v1[2] * v1[2] + v1[3] * v1[3])); }
                        u32x4 w; w.x = cvt_pk_bf16(v0[0], v0[1]); w.y = cvt_pk_bf16(v0[2], v0[3]); w.z = cvt_pk_bf16(v1[0], v1[1]); w.w = cvt_pk_bf16(v1[2], v1[3]);
                        *(u32x4*)(base + (size_t)row * 1024 + lc0 + bj * HALF) = bperm4u(pidx, w); }
                    if (seg == 3) {
                        float a = s1[0] + s1[1], b = s2[0] + s2[1];
                        a += __shfl_xor(a, 16); b += __shfl_xor(b, 16); a += __shfl_xor(a, 32); b += __shfl_xor(b, 32);
                        if (fq == 0) { float* sp = svstat + (size_t)(u.pm * BM + wr * 64 + fr + ai * HALF + m * 16) * 2; atomicAdd(sp, a); atomicAdd(sp + 1, b); } } }
        }
    }
};
template <bool ACCUM> struct EpiGate {
    static constexpr bool PERM = true, AFTER_DRAIN = false;
    const bf16_t* GT; bf16_t* TMP; unsigned char* OUT8; float osc;
    __device__ __forceinline__ void operator()(const f32x4 (&acc)[2][2][4][2], const Unit& u, int wr, int wc, int fr, int fq) const {
        PG8_REMAP();
        const int row0 = u.pm * BM + wr * 64 + fr2, col0 = u.pn * BM + wc * 32 + 8 * fq2;
#pragma unroll
        for (int ai = 0; ai < 2; ++ai)
#pragma unroll
            for (int mp = 0; mp < 2; ++mp) {
                u32x4 gv[2][2], pv[2][2];
#pragma unroll
                for (int mm = 0; mm < 2; ++mm)
#pragma unroll
                    for (int bj = 0; bj < 2; ++bj) { const size_t off = (size_t)(row0 + ai * HALF + (2 * mp + mm) * 16) * 1024 + col0 + bj * HALF;
                        gv[mm][bj] = *(const u32x4*)(GT + off); if (ACCUM) pv[mm][bj] = *(const u32x4*)(TMP + off); }
#pragma unroll
                for (int mm = 0; mm < 2; ++mm)
#pragma unroll
                    for (int bj = 0; bj < 2; ++bj) { const int m = 2 * mp + mm; const size_t off = (size_t)(row0 + ai * HALF + m * 16) * 1024 + col0 + bj * HALF;
                        const f32x4 v0 = bperm4(pidx, acc[ai][bj][m][0]) * osc, v1 = bperm4(pidx, acc[ai][bj][m][1]) * osc; const u32x4 g = gv[mm][bj];
                        float o[8] = {v0[0] * bflo(g.x), v0[1] * bfhi(g.x), v0[2] * bflo(g.y), v0[3] * bfhi(g.y), v1[0] * bflo(g.z), v1[1] * bfhi(g.z), v1[2] * bflo(g.w), v1[3] * bfhi(g.w)};
                        if (ACCUM) { const u32x4 p = pv[mm][bj];
                            o[0] += bflo(p.x); o[1] += bfhi(p.x); o[2] += bflo(p.y); o[3] += bfhi(p.y); o[4] += bflo(p.z); o[5] += bfhi(p.z); o[6] += bflo(p.w); o[7] += bfhi(p.w);
                            u32x2 w8; int t0 = __builtin_amdgcn_cvt_pk_fp8_f32(o[0] * 8.f, o[1] * 8.f, 0, false); t0 = __builtin_amdgcn_cvt_pk_fp8_f32(o[2] * 8.f, o[3] * 8.f, t0, true);
                            int t1 = __builtin_amdgcn_cvt_pk_fp8_f32(o[4] * 8.f, o[5] * 8.f, 0, false); t1 = __builtin_amdgcn_cvt_pk_fp8_f32(o[6] * 8.f, o[7] * 8.f, t1, true);
                            w8.x = (unsigned)t0; w8.y = (unsigned)t1; *(u32x2*)(OUT8 + off) = w8;
                        } else {
                            u32x4 w; w.x = cvt_pk_bf16(o[0], o[1]); w.y = cvt_pk_bf16(o[2], o[3]); w.z = cvt_pk_bf16(o[4], o[5]); w.w = cvt_pk_bf16(o[6], o[7]);
                            *(u32x4*)(TMP + off) = w; } }
            }
    }
};
struct EpiX1 {
    static constexpr bool PERM = false, AFTER_DRAIN = false;
    const float* X; const float* gate1; float* X1; float osc;
    __device__ __forceinline__ void operator()(const f32x4 (&acc)[2][2][4][2], const Unit& u, int wr, int wc, int fr, int fq) const {
        PG8_REMAP();
        const int row0 = u.pm * BM + wr * 64 + fr2, col0 = u.pn * BM + wc * 32 + 4 * fq2;
        const float* gp = gate1 + (size_t)((u.pm * BM) >> 12) * 6144 + col0;
        f32x4 gv[2][2];
#pragma unroll
        for (int bj = 0; bj < 2; ++bj)
#pragma unroll
            for (int n = 0; n < 2; ++n) gv[bj][n] = *(const f32x4*)(gp + bj * HALF + n * 16) * osc;
#pragma unroll
        for (int ai = 0; ai < 2; ++ai)
#pragma unroll
            for (int mp = 0; mp < 2; ++mp) {
                f32x4 xv[2][2][2];
#pragma unroll
                for (int mm = 0; mm < 2; ++mm) { const size_t off = (size_t)(row0 + ai * HALF + (2 * mp + mm) * 16) * 1024 + col0;
#pragma unroll
                    for (int bj = 0; bj < 2; ++bj)
#pragma unroll
                        for (int n = 0; n < 2; ++n) xv[mm][bj][n] = *(const f32x4*)(X + off + bj * HALF + n * 16); }
#pragma unroll
                for (int mm = 0; mm < 2; ++mm) { const int m = 2 * mp + mm; const size_t off = (size_t)(row0 + ai * HALF + m * 16) * 1024 + col0;
#pragma unroll
                    for (int bj = 0; bj < 2; ++bj)
#pragma unroll
                        for (int n = 0; n < 2; ++n) *(f32x4*)(X1 + off + bj * HALF + n * 16) = xv[mm][bj][n] + gv[bj][n] * bperm4(pidx, acc[ai][bj][m][n]); }
            }
    }
};
struct EpiPlain {
    static constexpr bool PERM = true, AFTER_DRAIN = false;
    bf16_t* O; int ldc;
    __device__ __forceinline__ void operator()(const f32x4 (&acc)[2][2][4][2], const Unit& u, int wr, int wc, int fr, int fq) const {
        PG8_REMAP();
        const int row0 = u.pm * BM + wr * 64 + fr2, col0 = u.pn * BM + wc * 32 + 8 * fq2;
#pragma unroll
        for (int ai = 0; ai < 2; ++ai)
#pragma unroll
            for (int m = 0; m < 4; ++m) { bf16_t* rowp = O + (size_t)(row0 + ai * HALF + m * 16) * ldc + col0;
#pragma unroll
                for (int bj = 0; bj < 2; ++bj) { const f32x4 v0 = acc[ai][bj][m][0], v1 = acc[ai][bj][m][1];
                    u32x4 w; w.x = cvt_pk_bf16(v0[0], v0[1]); w.y = cvt_pk_bf16(v0[2], v0[3]); w.z = cvt_pk_bf16(v1[0], v1[1]); w.w = cvt_pk_bf16(v1[2], v1[3]);
                    *(u32x4*)(rowp + bj * HALF) = bperm4u(pidx, w); } }
    }
};
typedef int v8i_t __attribute__((ext_vector_type(8)));
typedef int v4i_t __attribute__((ext_vector_type(4)));
template <bool F8> __device__ __forceinline__ void mma_block(f32x4 (&acc)[4][2], const bf16x8 (&At)[4][2], const bf16x8 (&Bt)[2][2]) {
    if constexpr (F8) {
        v8i_t bb[2];
#pragma unroll
        for (int n = 0; n < 2; ++n) bb[n] = __builtin_shufflevector(__builtin_bit_cast(v4i_t, Bt[n][0]), __builtin_bit_cast(v4i_t, Bt[n][1]), 0, 1, 2, 3, 4, 5, 6, 7);
#pragma unroll
        for (int m = 0; m < 4; ++m) { const v8i_t aa = __builtin_shufflevector(__builtin_bit_cast(v4i_t, At[m][0]), __builtin_bit_cast(v4i_t, At[m][1]), 0, 1, 2, 3, 4, 5, 6, 7);
#pragma unroll
            for (int n = 0; n < 2; ++n) asm volatile("v_mfma_scale_f32_16x16x128_f8f6f4 %0, %1, %2, %0, %3, %3 op_sel_hi:[0,0,0]" : "+v"(acc[m][n]) : "v"(bb[n]), "v"(aa), "v"(0x7F7F7F7F)); }
    } else {
#pragma unroll
        for (int m = 0; m < 4; ++m)
#pragma unroll
            for (int n = 0; n < 2; ++n)
#pragma unroll
                for (int k = 0; k < 2; ++k) acc[m][n] = __builtin_amdgcn_mfma_f32_16x16x32_bf16(Bt[n][k], At[m][k], acc[m][n], 0, 0, 0);
    }
}
template <class Epi, class Sched, bool ALIGN_EPI = false, bool SP2 = false, bool F8 = false>
__device__ __forceinline__ void gemm_phase(PG8_LAS unsigned char* lds, const Gemm g, const Sched& S, const Epi& E) {
    const int tid = threadIdx.x, wid = __builtin_amdgcn_readfirstlane(tid >> 6), lane = tid & 63, wr = wid >> 2, wc = wid & 3, fr = lane & 15, fq = lane >> 4;
    const int K = g.K, nt = K / BK;
    unsigned voffA[2], voffB[2];
#pragma unroll
    for (int i = 0; i < 2; ++i) { int R, C; stage_rc(tid * 16 + i * 8192, R, C); const int Rb = Epi::PERM ? ((R & ~31) + perm32(R & 31)) : R;
        voffA[i] = (unsigned)(R * K + C) * 2u; voffB[i] = (unsigned)(Rb * K + C) * 2u; }
    const size_t kstep = (size_t)(BK * 2);
    const size_t hstep = (size_t)HALF * K * 2;
    const size_t tstep = 2 * hstep;
    const unsigned ldsw = (unsigned)wid * 1024u;
    const int aoff = lds_byte(wr * 64 + fr, fq * 8), boff = lds_byte(wc * 32 + fr, fq * 8);
#define PG8_SA(b, h) (((b) * 2 + (h)) * HTB)
#define PG8_SB(b, h) ((4 + (b) * 2 + (h)) * HTB)
#define PG8_STAGE(bufoff, gbase, voff) do { _Pragma("unroll") for (int _i = 0; _i < 2; ++_i) \
        __builtin_amdgcn_global_load_lds((const unsigned*)((const char*)(gbase) + (voff)[_i]), (PG8_LAS unsigned*)(lds + (bufoff) + ldsw + _i * 8192), 16, 0, 0); } while (0)
#define PG8_LDA(dst, b, h) do { _Pragma("unroll") for (int m = 0; m < 4; ++m) _Pragma("unroll") for (int k = 0; k < 2; ++k) dst[m][k] = *(const PG8_LAS bf16x8*)(lds + PG8_SA(b, h) + aoff + m * 2048 + k * 1024); } while (0)
#define PG8_LDB(dst, b, h) do { _Pragma("unroll") for (int n = 0; n < 2; ++n) _Pragma("unroll") for (int k = 0; k < 2; ++k) dst[n][k] = *(const PG8_LAS bf16x8*)(lds + PG8_SB(b, h) + boff + n * 2048 + k * 1024); } while (0)
#define PG8_MMA(ai, bj, At, Bt) do { __builtin_amdgcn_s_setprio(1); mma_block<F8>(acc[ai][bj], At, Bt); __builtin_amdgcn_s_setprio(0); } while (0)
#define PG8_WAIT_V(n) asm volatile("s_waitcnt vmcnt(" #n ")" ::: "memory")
#define PG8_WAIT_L(n) asm volatile("s_waitcnt lgkmcnt(" #n ")" ::: "memory")
#define PG8_BAR __builtin_amdgcn_s_barrier()
#define PG8_SCHED __builtin_amdgcn_sched_barrier(0)
    Unit cur, nxt; int ui = 0;
#if MK_GPROBE
    unsigned long long gp_k = 0, gp_e = 0, gp_t = __builtin_amdgcn_s_memrealtime();
#endif
    if (!S.next(0, cur)) return;
    f32x4 acc[2][2][4][2];
#pragma unroll
    for (int a = 0; a < 2; ++a)
#pragma unroll
        for (int b = 0; b < 2; ++b)
#pragma unroll
            for (int m = 0; m < 4; ++m)
#pragma unroll
                for (int n = 0; n < 2; ++n) acc[a][b][m][n] = (f32x4){0.f, 0.f, 0.f, 0.f};
    bf16x8 At[4][2], B0[2][2], B1[2][2];
    const char* cA = (const char*)g.A + (size_t)cur.pm * tstep; const char* cB = (const char*)g.Bt + (size_t)cur.pn * tstep;
    S.a_ready(cur);
    if constexpr (SP2) {
        PG8_STAGE(PG8_SB(0, 0), cB, voffB); PG8_STAGE(PG8_SB(0, 1), cB + hstep, voffB); PG8_STAGE(PG8_SA(0, 0), cA, voffA); PG8_STAGE(PG8_SA(0, 1), cA + hstep, voffA);
        if (wr == 1) PG8_BAR;
        PG8_WAIT_V(2); PG8_BAR;
        PG8_STAGE(PG8_SB(1, 0), cB + kstep, voffB); PG8_STAGE(PG8_SA(1, 0), cA + kstep, voffA); PG8_STAGE(PG8_SB(1, 1), cB + hstep + kstep, voffB);
        PG8_WAIT_V(6); PG8_BAR;
    } else {
        PG8_STAGE(PG8_SB(0, 0), cB, voffB); PG8_STAGE(PG8_SA(0, 0), cA, voffA); PG8_STAGE(PG8_SB(0, 1), cB + hstep, voffB); PG8_STAGE(PG8_SA(0, 1), cA + hstep, voffA);
        if (wr == 1) PG8_BAR;
        PG8_WAIT_V(4); PG8_BAR;
        PG8_STAGE(PG8_SB(1, 0), cB + kstep, voffB); PG8_STAGE(PG8_SA(1, 0), cA + kstep, voffA); PG8_STAGE(PG8_SB(1, 1), cB + hstep + kstep, voffB);
        PG8_WAIT_V(6); PG8_BAR;
    }
    for (;;) {
        const bool has_next = S.next(ui + 1, nxt);
        const char* nA = has_next ? (const char*)g.A + (size_t)nxt.pm * tstep : cA; const char* nB = has_next ? (const char*)g.Bt + (size_t)nxt.pn * tstep : cB;
#pragma clang loop unroll(disable)
        for (int t = 0; t < nt; t += 2) {
            const bool last = (t == nt - 2);
            const char* a1 = cA + (size_t)(t + 1) * kstep;
            const char* a2 = last ? nA : cA + (size_t)(t + 2) * kstep; const char* b2 = last ? nB : cB + (size_t)(t + 2) * kstep;
            const char* a3 = a2 + kstep; const char* b3 = b2 + kstep;
            if (last && has_next) S.a_ready(nxt);
            if constexpr (SP2) {
            PG8_LDB(B0, 0, 0); PG8_LDB(B1, 0, 1); PG8_SCHED; PG8_LDA(At, 0, 0); PG8_STAGE(PG8_SA(1, 1), a1 + hstep, voffA);
            PG8_WAIT_V(8); PG8_WAIT_L(0); PG8_BAR; PG8_MMA(0, 0, At, B0); PG8_MMA(0, 1, At, B1); PG8_BAR; PG8_SCHED;
            PG8_LDA(At, 0, 1); PG8_STAGE(PG8_SB(0, 0), b2, voffB); PG8_STAGE(PG8_SB(0, 1), b2 + hstep, voffB); PG8_STAGE(PG8_SA(0, 0), a2, voffA);
            PG8_WAIT_V(8); PG8_WAIT_L(0); PG8_BAR; PG8_MMA(1, 0, At, B0); PG8_MMA(1, 1, At, B1); PG8_BAR; PG8_SCHED;
            PG8_LDB(B0, 1, 0); PG8_LDB(B1, 1, 1); PG8_SCHED; PG8_LDA(At, 1, 0); PG8_STAGE(PG8_SA(0, 1), a2 + hstep, voffA);
            PG8_WAIT_V(8); PG8_WAIT_L(0); PG8_BAR; PG8_MMA(0, 0, At, B0); PG8_MMA(0, 1, At, B1); PG8_BAR; PG8_SCHED;
            PG8_LDA(At, 1, 1); PG8_STAGE(PG8_SB(1, 0), b3, voffB); PG8_STAGE(PG8_SB(1, 1), b3 + hstep, voffB); PG8_STAGE(PG8_SA(1, 0), a3, voffA);
            PG8_WAIT_V(8); PG8_WAIT_L(0); PG8_BAR; PG8_MMA(1, 0, At, B0); PG8_MMA(1, 1, At, B1); PG8_BAR; PG8_SCHED;
            } else {
            PG8_LDB(B0, 0, 0); PG8_SCHED; PG8_LDA(At, 0, 0); PG8_STAGE(PG8_SA(1, 1), a1 + hstep, voffA);
            PG8_WAIT_L(8); PG8_BAR; PG8_WAIT_L(0); PG8_MMA(0, 0, At, B0); PG8_BAR; PG8_SCHED;
            PG8_LDB(B1, 0, 1); PG8_STAGE(PG8_SB(0, 0), b2, voffB);
            PG8_BAR; PG8_WAIT_L(0); PG8_MMA(0, 1, At, B1); PG8_BAR;
            PG8_LDA(At, 0, 1); PG8_STAGE(PG8_SA(0, 0), a2, voffA);
            PG8_BAR; PG8_WAIT_L(0); PG8_MMA(1, 0, At, B0); PG8_BAR; PG8_SCHED;
            PG8_STAGE(PG8_SB(0, 1), b2 + hstep, voffB);
            PG8_WAIT_V(6); PG8_BAR; PG8_MMA(1, 1, At, B1); PG8_BAR;
            PG8_LDB(B0, 1, 0); PG8_SCHED; PG8_LDA(At, 1, 0); PG8_STAGE(PG8_SA(0, 1), a2 + hstep, voffA);
            PG8_WAIT_L(8); PG8_BAR; PG8_WAIT_L(0); PG8_MMA(0, 0, At, B0); PG8_BAR; PG8_SCHED;
            PG8_LDB(B1, 1, 1); PG8_STAGE(PG8_SB(1, 0), b3, voffB);
            PG8_BAR; PG8_WAIT_L(0); PG8_MMA(0, 1, At, B1); PG8_BAR;
            PG8_LDA(At, 1, 1); PG8_STAGE(PG8_SA(1, 0), a3, voffA);
            PG8_BAR; PG8_WAIT_L(0); PG8_MMA(1, 0, At, B0); PG8_BAR; PG8_SCHED;
            PG8_STAGE(PG8_SB(1, 1), b3 + hstep, voffB);
            PG8_WAIT_V(6); PG8_BAR; PG8_MMA(1, 1, At, B1); PG8_BAR;
            }
        }
#if MK_GPROBE
        { const unsigned long long t_ = __builtin_amdgcn_s_memrealtime(); gp_k += t_ - gp_t; gp_t = t_; }
#endif
        if constexpr (F8) asm volatile("s_nop 15\n\ts_nop 15" ::: "memory");
        if constexpr (ALIGN_EPI) { if (wr == 0) PG8_BAR; }
        if constexpr (!Epi::AFTER_DRAIN) { E(acc, cur, wr, wc, fr, fq); S.done(cur); }
#if MK_GPROBE
        { asm volatile("s_waitcnt vmcnt(0)" ::: "memory"); const unsigned long long t_ = __builtin_amdgcn_s_memrealtime(); gp_e += t_ - gp_t; gp_t = t_; }
#endif
        if (!has_next) break;
#pragma unroll
        for (int a = 0; a < 2; ++a)
#pragma unroll
            for (int b = 0; b < 2; ++b)
#pragma unroll
                for (int m = 0; m < 4; ++m)
#pragma unroll
                    for (int n = 0; n < 2; ++n) acc[a][b][m][n] = (f32x4){0.f, 0.f, 0.f, 0.f};
        cur = nxt; cA = nA; cB = nB; ++ui;
        if constexpr (ALIGN_EPI) { if (wr == 1) PG8_BAR; }
    }
    PG8_WAIT_V(0);
    if constexpr (!ALIGN_EPI) { if (wr == 0) PG8_BAR; }
    PG8_BAR;
    if constexpr (Epi::AFTER_DRAIN) { E.fused(acc, cur, wr, wc, fr, fq, lds, wid, lane); S.done(cur); }
#if MK_GPROBE
    if (blockIdx.x == 0 && wid == 0 && lane == 0) { PG8_LAS unsigned* mq = (PG8_LAS unsigned*)(lds + MK_MISC_OFF); mq[56] += (unsigned)gp_k; mq[57] += (unsigned)gp_e; }
#endif
#undef PG8_SA
#undef PG8_SB
#undef PG8_STAGE
#undef PG8_LDA
#undef PG8_LDB
#undef PG8_MMA
#undef PG8_WAIT_V
#undef PG8_WAIT_L
#undef PG8_BAR
#undef PG8_SCHED
}
}

constexpr int NWAVES = 8;
constexpr int N_LAUNCHES = MK_N_LAUNCHES;
constexpr int N_PHASES = 16;
constexpr int NB = 8, SEQ = 4096, DM = 1024, MT = NB * SEQ, NIN = 7168;
constexpr float EPSN = 1e-6f;

constexpr size_t MiB = 1u << 20;
constexpr size_t WS_CTL = 0, CTL_ZERO_BYTES = 1 * MiB;
constexpr size_t WS_SVSTAT = 512 * 1024;
constexpr size_t WS_MOD = 1 * MiB;
constexpr size_t WS_COS = 2 * MiB, WS_SIN = 3 * MiB;
constexpr size_t WS_SK = 4 * MiB;
constexpr size_t WS_SGUW = 4 * MiB + 512 * 1024;
constexpr size_t WS_WRET = 6 * MiB, WS_WSGU = 8 * MiB, WS_WOUT = 10 * MiB, WS_WQ = 12 * MiB, WS_WIN = 16 * MiB;
constexpr size_t WS_UE8 = 32 * MiB, WS_VE8 = 48 * MiB;
constexpr size_t WS_YG8 = 288 * MiB;
constexpr size_t WS_YS8 = 480 * MiB;
constexpr size_t WS_MRG8 = 96 * MiB;
constexpr size_t WS_ACT = 288 * MiB;
constexpr size_t WS_PEERS = 352 * MiB;
constexpr size_t WS_H2F8 = 96 * MiB;
constexpr size_t WS_EID = 128 * MiB, WS_GW = 144 * MiB;
constexpr size_t WS_PD = 160 * MiB;
constexpr size_t WS_V = 96 * MiB;
constexpr size_t WS_G = 160 * MiB;
constexpr size_t WS_U = 224 * MiB;
constexpr size_t WS_SV = 288 * MiB;
constexpr size_t WS_GA = 352 * MiB, WS_GB = 416 * MiB;
constexpr size_t WS_SUB = 480 * MiB;
constexpr size_t WS_END = 512 * MiB;
constexpr size_t DO_H = 0, DO_Q = 64 * MiB, DO_K = 96 * MiB, DO_KVS = 0;

constexpr int CW_BAR = 4096;
constexpr int LDS_BYTES = 147456;
constexpr int MISC_OFF = LDS_BYTES - 256;

#define GAS __attribute__((address_space(1)))
#define LAS __attribute__((address_space(3)))
typedef unsigned short bf16;
typedef unsigned v4u __attribute__((ext_vector_type(4)));
typedef unsigned v2u __attribute__((ext_vector_type(2)));
typedef float f32x4 __attribute__((ext_vector_type(4)));
typedef float f32x2v __attribute__((ext_vector_type(2)));
typedef short bf16x8 __attribute__((ext_vector_type(8)));
typedef short s16x4 __attribute__((ext_vector_type(4)));
typedef __bf16 bf16x2_t __attribute__((ext_vector_type(2)));
typedef GAS unsigned gu32;
#define RLX_AGENT __ATOMIC_RELAXED, __HIP_MEMORY_SCOPE_AGENT
#define LDS_WAIT() asm volatile("s_waitcnt lgkmcnt(0)" ::: "memory")
using pg8::bflo; using pg8::bfhi; using pg8::gelu1;
__device__ __forceinline__ unsigned pk2(float lo, float hi) { f32x2v v = {lo, hi}; bf16x2_t b = __builtin_convertvector(v, bf16x2_t); return __builtin_bit_cast(unsigned, b); }
template <int CTRL> __device__ __forceinline__ float dpp_f(float v) { return __int_as_float(__builtin_amdgcn_update_dpp(0, __float_as_int(v), CTRL, 0xF, 0xF, false)); }
__device__ __forceinline__ float wave_sum(float v) {
    v += dpp_f<0xB1>(v); v += dpp_f<0x4E>(v); v += dpp_f<0x141>(v); v += dpp_f<0x140>(v);
    const int vi = __float_as_int(v);
    return (__int_as_float(__builtin_amdgcn_readlane(vi, 0)) + __int_as_float(__builtin_amdgcn_readlane(vi, 16))) + (__int_as_float(__builtin_amdgcn_readlane(vi, 32)) + __int_as_float(__builtin_amdgcn_readlane(vi, 48)));
}
__device__ __forceinline__ float fexp2(float x) { return __builtin_amdgcn_exp2f(x); }
__device__ __forceinline__ float clamp_f8(float x) { return __builtin_amdgcn_fmed3f(x, -448.0f, 448.0f); }
__device__ __forceinline__ unsigned pk4_fp8(float a, float b, float c, float d) { int w = __builtin_amdgcn_cvt_pk_fp8_f32(clamp_f8(a), clamp_f8(b), 0, false); w = __builtin_amdgcn_cvt_pk_fp8_f32(clamp_f8(c), clamp_f8(d), w, true); return (unsigned)w; }
__device__ __forceinline__ float rl_f(float v, int l) { return __int_as_float(__builtin_amdgcn_readlane(__float_as_int(v), l)); }
__device__ __forceinline__ unsigned rl_u(unsigned v, int l) { return (unsigned)__builtin_amdgcn_readlane((int)v, l); }

#define XB_TMO      128
#define XB_XCNT(j)  (256  + 64 * (j))
#define XB_XSUB(j)  (1280 + 64 * (j))
#define XB_XGEN(j)  (2304 + 64 * (j))
#define XB_TOP      3328
#define XB_TOPGEN   3392
#define XCD_BAR_WORDS 3456
#define XB_SPIN_CAP (1u << 22)
__device__ __forceinline__ unsigned xb_ld(unsigned* p)              { return __hip_atomic_load(p, __ATOMIC_RELAXED, __HIP_MEMORY_SCOPE_AGENT); }
__device__ __forceinline__ unsigned xb_add(unsigned* p, unsigned v) { return __hip_atomic_fetch_add(p, v, __ATOMIC_RELAXED, __HIP_MEMORY_SCOPE_AGENT); }
__device__ __forceinline__ unsigned xb_xcc_id() { return (unsigned)__builtin_amdgcn_s_getreg((3 << 11) | 20) & 0xFu; }
#define XB_SPIN(cond, bar) do { unsigned _sp = 0; while (cond) { __builtin_amdgcn_s_sleep(1); \
    if ((++_sp & 255u) == 0u) { if (xb_ld(&(bar)[XB_TMO])) break; if (_sp > XB_SPIN_CAP) { atomicAdd(&(bar)[XB_TMO], 1u); break; } } } } while (0)
struct XcdBarrier { unsigned* bar; unsigned x; volatile LAS unsigned* st; };
__device__ __forceinline__ XcdBarrier xcd_barrier_post(unsigned* bar, volatile LAS unsigned* st) {
    XcdBarrier b; b.bar = bar; b.x = xb_xcc_id(); b.st = st;
    if (threadIdx.x == 0) (void)xb_add(&bar[XB_XCNT(b.x)], 1u);
    return b;
}
__device__ __forceinline__ void xcd_barrier_complete(unsigned* bar, unsigned x, unsigned& nloc, unsigned& nx) {
    const unsigned G = gridDim.x * gridDim.y * gridDim.z;
    unsigned sum, cnt, mine, sp = 0u;
    for (;;) {
        sum = 0u; cnt = 0u; mine = 0u;
#pragma unroll
        for (unsigned j = 0; j < 16; ++j) { const unsigned c = xb_ld(&bar[XB_XCNT(j)]); sum += c; cnt += (c > 0u) ? 1u : 0u; mine = (j == x) ? c : mine; }
        if (sum == G) break;
        __builtin_amdgcn_s_sleep(1);
        if ((++sp & 255u) == 0u) { if (xb_ld(&bar[XB_TMO])) break; if (sp > XB_SPIN_CAP) { atomicAdd(&bar[XB_TMO], 1u); break; } }
    }
    nloc = mine > 0u ? mine : 1u; nx = cnt > 0u ? cnt : 1u;
}
__device__ __forceinline__ void xcd_barrier(const XcdBarrier& b) {
    asm volatile("s_waitcnt vmcnt(0)" ::: "memory");
    __syncthreads();
    if (threadIdx.x == 0) {
        unsigned* bar = b.bar;
        __builtin_amdgcn_s_waitcnt(0);
        unsigned nloc = b.st[0], nx = b.st[1];
        if (nloc == 0u) { xcd_barrier_complete(bar, b.x, nloc, nx); b.st[0] = nloc; b.st[1] = nx; }
        const unsigned old = xb_add(&bar[XB_XSUB(b.x)], 1u);
        const unsigned gen = old / nloc;
        if (old + 1u == (gen + 1u) * nloc) {
            __builtin_amdgcn_fence(__ATOMIC_RELEASE, "agent");
            asm volatile("s_waitcnt vmcnt(0)" ::: "memory");
            const unsigned og = xb_add(&bar[XB_TOP], 1u);
            const unsigned tg = og / nx;
            if (og + 1u == (tg + 1u) * nx) xb_add(&bar[XB_TOPGEN], 1u);
            else XB_SPIN(xb_ld(&bar[XB_TOPGEN]) == tg, bar);
            __builtin_amdgcn_fence(__ATOMIC_ACQUIRE, "agent");
            xb_add(&bar[XB_XGEN(b.x)], 1u);
            asm volatile("s_waitcnt vmcnt(0)" ::: "memory");
        } else {
            XB_SPIN(xb_ld(&bar[XB_XGEN(b.x)]) == gen, bar);
            __builtin_amdgcn_fence(__ATOMIC_ACQUIRE, "agent");
            asm volatile("s_waitcnt vmcnt(0)" ::: "memory");
        }
    }
    __syncthreads();
}

struct Frame {
    LAS unsigned char* lds;
    int tid, lane, wave, G, bid; volatile LAS unsigned* misc;
    __device__ __forceinline__ void fence_ids() { int t = threadIdx.x; asm volatile("" : "+v"(t)); tid = t; lane = t & 63; }
    const float *x, *c, *w_ada, *b_ada, *norm1_g, *w_in, *ret_gn_g, *sgu_ln_g, *sgu_ln_b, *sgu_w, *sgu_b, *w_ret_out, *w_sgu_out, *w_out, *norm2_g, *peer_w_q, *peer_sub_keys, *peer_u, *peer_v, *final_g;
    unsigned char* ws; unsigned char* dout;
};

__device__ __forceinline__ bf16x8 lds_row_frag(LAS const unsigned char* img, int stride, int r0, int k0, int lane) {
    return *(LAS const bf16x8*)(img + (r0 + (lane & 15)) * stride + (k0 + 8 * (lane >> 4)) * 2);
}
__device__ __forceinline__ s16x4 tr16(LAS const unsigned char* p) { return __builtin_bit_cast(s16x4, __builtin_amdgcn_ds_read_tr16_b64_v4i16((LAS s16x4*)p)); }
__device__ __forceinline__ bf16x8 lds_tr_frag(LAS const unsigned char* img, int stride, int k0, int n0, int lane) {
    const int g = lane >> 4, q = (lane >> 2) & 3, p = lane & 3;
    LAS const unsigned char* a = img + (k0 + 8 * g + q) * stride + (n0 + 4 * p) * 2;
    const s16x4 lo = tr16(a), hi = tr16(a + 4 * stride);
    return __builtin_shufflevector(lo, hi, 0, 1, 2, 3, 4, 5, 6, 7);
}
#define MFMA16(a, b, c) __builtin_amdgcn_mfma_f32_16x16x32_bf16((a), (b), (c), 0, 0, 0)
constexpr int KS = 272, VS = 528;

template <bool F8, class Map>
__device__ __forceinline__ void transpose_item(const float* W, int K, int N, bf16* WT, LAS float* scr, int item, int lane, Map srcmap) {
    const int nblk = N / 32, kb = item / nblk, nb = item % nblk, k0 = 64 * kb, n0 = 32 * nb;
    const int sc = srcmap(n0 + (lane & 31));
#pragma unroll 8
    for (int i = 0; i < 32; ++i) { const int kk = 2 * i + (lane >> 5); scr[kk * 33 + (lane & 31)] = W[(size_t)(k0 + kk) * N + sc]; }
    LDS_WAIT(); asm volatile("" ::: "memory");
    const int c = lane & 7;
#pragma unroll
    for (int j = 0; j < 4; ++j) { const int n = (lane >> 3) + 8 * j; const LAS float* s = scr + (8 * c) * 33 + n;
        if (F8) { v2u o8; o8.x = pk4_fp8(s[0 * 33] * 512.f, s[1 * 33] * 512.f, s[2 * 33] * 512.f, s[3 * 33] * 512.f); o8.y = pk4_fp8(s[4 * 33] * 512.f, s[5 * 33] * 512.f, s[6 * 33] * 512.f, s[7 * 33] * 512.f);
            *(v2u*)((unsigned char*)WT + (size_t)(n0 + n) * K + k0 + 8 * c) = o8; }
        else { v4u o; o.x = pk2(s[0 * 33], s[1 * 33]); o.y = pk2(s[2 * 33], s[3 * 33]); o.z = pk2(s[4 * 33], s[5 * 33]); o.w = pk2(s[6 * 33], s[7 * 33]);
            *(v4u*)(WT + (size_t)(n0 + n) * K + k0 + 8 * c) = o; } }
    LDS_WAIT(); asm volatile("" ::: "memory");
}
struct MapId { __device__ __forceinline__ int operator()(int n) const { return n; } };
struct MapWin { __device__ __forceinline__ int operator()(int n) const { if (n >= 1024) return n; const int ci = n & 127; return (n & ~127) + (ci >> 1) + 64 * (ci & 1); } };

__device__ __forceinline__ void cvt8(const float* src, bf16* dst, size_t chunk) {
    const f32x4 a = *(const f32x4*)(src + chunk * 8), b = *(const f32x4*)(src + chunk * 8 + 4);
    v4u o; o.x = pk2(a[0], a[1]); o.y = pk2(a[2], a[3]); o.z = pk2(b[0], b[1]); o.w = pk2(b[2], b[3]);
    *(v4u*)(dst + chunk * 8) = o;
}

__device__ __forceinline__ void p0a(Frame& F) { F.fence_ids();
    if (F.bid < 192) {
        LAS float* sc = (LAS float*)F.lds; LAS float* part = (LAS float*)(F.lds + 32768);
        for (int i = F.tid; i < 8192; i += 512) { const float cv = F.c[i]; sc[i] = pg8::silu1(cv); }
        __syncthreads();
        const int n0 = 32 * F.bid, ks = F.tid >> 3, c4 = F.tid & 7;
        f32x4 acc[8];
#pragma unroll
        for (int b = 0; b < 8; ++b) acc[b] = (f32x4){0.f, 0.f, 0.f, 0.f};
        for (int kk = ks; kk < 1024; kk += 64) { const f32x4 w = *(const f32x4*)(F.w_ada + (size_t)kk * 6144 + n0 + 4 * c4);
#pragma unroll
            for (int b = 0; b < 8; ++b) acc[b] += w * sc[b * 1024 + kk]; }
#pragma unroll
        for (int b = 0; b < 8; ++b) *(LAS f32x4*)(part + (ks * 8 + b) * 32 + 4 * c4) = acc[b];
        __syncthreads();
        if (F.tid < 256) { const int b = F.tid >> 5, col = F.tid & 31; float s = 0.f;
            for (int k2 = 0; k2 < 64; ++k2) s += part[(k2 * 8 + b) * 32 + col];
            ((float*)(F.ws + WS_MOD))[b * 6144 + n0 + col] = s + F.b_ada[n0 + col]; }
        __syncthreads();
    }
    {
        LAS float* scr = (LAS float*)(F.lds + F.wave * 16384);
        const int gw = F.bid * NWAVES + F.wave, NGW = F.G * NWAVES;
        constexpr int I_IN = 16 * (NIN / 32), I_SQ = 16 * 32, I_Q = 16 * 64, NITEMS = I_IN + 3 * I_SQ + I_Q;
        for (int it = gw; it < NITEMS; it += NGW) {
            int r = it;
            if (r < I_IN) { transpose_item<true>(F.w_in, 1024, NIN, (bf16*)(F.ws + WS_WIN), scr, r, F.lane, MapWin()); continue; } r -= I_IN;
            if (r < I_SQ) { transpose_item<true>(F.w_ret_out, 1024, 1024, (bf16*)(F.ws + WS_WRET), scr, r, F.lane, MapId()); continue; } r -= I_SQ;
            if (r < I_SQ) { transpose_item<true>(F.w_sgu_out, 1024, 1024, (bf16*)(F.ws + WS_WSGU), scr, r, F.lane, MapId()); continue; } r -= I_SQ;
            if (r < I_SQ) { transpose_item<true>(F.w_out, 1024, 1024, (bf16*)(F.ws + WS_WOUT), scr, r, F.lane, MapId()); continue; } r -= I_SQ;
            transpose_item<false>(F.peer_w_q, 1024, 2048, (bf16*)(F.ws + WS_WQ), scr, r, F.lane, MapId());
        }
    }
    const size_t gt = (size_t)F.bid * 512 + F.tid, NT = (size_t)F.G * 512;
    for (size_t ch = gt; ch < (size_t)16384 * 64; ch += NT) {
        const f32x4* up = (const f32x4*)(F.peer_u + ch * 16); const f32x4* vp = (const f32x4*)(F.peer_v + ch * 16);
        v4u ou, ov;
#pragma unroll
        for (int q = 0; q < 4; ++q) { const f32x4 a = up[q] * 512.0f, b = vp[q] * 16.0f; ou[q] = pk4_fp8(a[0], a[1], a[2], a[3]); ov[q] = pk4_fp8(b[0], b[1], b[2], b[3]); }
        const size_t e_ = ch >> 6, c16_ = ch & 63, dst_ = (c16_ >> 3) * ((size_t)16384 * 128) + e_ * 128 + (c16_ & 7) * 16;
        *(v4u*)(F.ws + WS_VE8 + dst_) = ov;
        if (MK_U4) {
            v2u o4; unsigned w0 = 0u, w1 = 0u;
            { const f32x4 a0 = up[0] * 64.0f, a1 = up[1] * 64.0f, a2 = up[2] * 64.0f, a3 = up[3] * 64.0f;
              w0 = __builtin_amdgcn_cvt_scalef32_pk_fp4_f32(w0, a0[0], a0[1], 1.0f, 0); w0 = __builtin_amdgcn_cvt_scalef32_pk_fp4_f32(w0, a0[2], a0[3], 1.0f, 1);
              w0 = __builtin_amdgcn_cvt_scalef32_pk_fp4_f32(w0, a1[0], a1[1], 1.0f, 2); w0 = __builtin_amdgcn_cvt_scalef32_pk_fp4_f32(w0, a1[2], a1[3], 1.0f, 3);
              w1 = __builtin_amdgcn_cvt_scalef32_pk_fp4_f32(w1, a2[0], a2[1], 1.0f, 0); w1 = __builtin_amdgcn_cvt_scalef32_pk_fp4_f32(w1, a2[2], a2[3], 1.0f, 1);
              w1 = __builtin_amdgcn_cvt_scalef32_pk_fp4_f32(w1, a3[0], a3[1], 1.0f, 2); w1 = __builtin_amdgcn_cvt_scalef32_pk_fp4_f32(w1, a3[2], a3[3], 1.0f, 3); }
            o4.x = w0; o4.y = w1;
            *(v2u*)(F.ws + WS_UE8 + (c16_ >> 4) * ((size_t)16384 * 128) + e_ * 128 + (c16_ & 15) * 8) = o4;
        } else *(v4u*)(F.ws + WS_UE8 + dst_) = ou; }
    for (size_t ch = gt; ch < (size_t)32768; ch += NT) cvt8(F.peer_sub_keys, (bf16*)(F.ws + WS_SK), ch);
    for (size_t ch = gt; ch < (size_t)8192; ch += NT) { const int t = (int)(ch >> 4) & 127, s0 = (int)(ch & 15) * 8;
        const f32x4 a = *(const f32x4*)(F.sgu_w + ch * 8), b = *(const f32x4*)(F.sgu_w + ch * 8 + 4);
        float v[8] = {a[0], a[1], a[2], a[3], b[0], b[1], b[2], b[3]};
#pragma unroll
        for (int e = 0; e < 8; ++e) v[e] = (s0 + e <= t) ? v[e] : 0.f;
        v4u o; o.x = pk2(v[0], v[1]); o.y = pk2(v[2], v[3]); o.z = pk2(v[4], v[5]); o.w = pk2(v[6], v[7]);
        *(v4u*)((bf16*)(F.ws + WS_SGUW) + ch * 8) = o; }
    for (size_t e = gt; e < (size_t)4096 * 64; e += NT) { const int s = (int)(e >> 6), i = (int)(e & 63);
        const float inv = fexp2(-(float)i * (13.287712379549449f / 64.0f));
        const float rev = ((float)s * inv) * 0.15915494309189535f; const float fr = rev - __builtin_floorf(rev);
        ((float*)(F.ws + WS_COS))[e] = __builtin_amdgcn_cosf(fr); ((float*)(F.ws + WS_SIN))[e] = __builtin_amdgcn_sinf(fr); }
}

template <int MODE  > __device__ __forceinline__ void norm_rows(Frame& F, const float* X, const float* gain, const float* shift, const float* scale, bf16* O, unsigned char* O8) { F.fence_ids();
    const int gw = F.bid * NWAVES + F.wave, NGW = F.G * NWAVES;
    f32x4 g[4];
#pragma unroll
    for (int j = 0; j < 4; ++j) g[j] = *(const f32x4*)(gain + 4 * F.lane + 256 * j);
    f32x4 nx[4];
    if (gw < MT) {
#pragma unroll
        for (int j = 0; j < 4; ++j) nx[j] = *((const f32x4*)(X + (size_t)gw * DM) + F.lane + 64 * j); }
    for (int m = gw; m < MT; m += NGW) {
        f32x4 v[4]; float s = 0.f;
#pragma unroll
        for (int j = 0; j < 4; ++j) { v[j] = nx[j]; s += (v[j][0] * v[j][0] + v[j][1] * v[j][1]) + (v[j][2] * v[j][2] + v[j][3] * v[j][3]); }
        const int b = m >> 12;
        f32x4 sh[4], sc[4];
#pragma unroll
        for (int j = 0; j < 4; ++j) { const int d = 4 * F.lane + 256 * j; sh[j] = *(const f32x4*)(shift + b * 6144 + d); sc[j] = *(const f32x4*)(scale + b * 6144 + d); }
        if (m + NGW < MT) {
#pragma unroll
            for (int j = 0; j < 4; ++j) nx[j] = *((const f32x4*)(X + (size_t)(m + NGW) * DM) + F.lane + 64 * j); }
        const float rstd = __builtin_amdgcn_rsqf(wave_sum(s) * (1.f / DM) + EPSN);
        v2u* o8 = (v2u*)(O + (size_t)m * DM) + F.lane;
#pragma unroll
        for (int j = 0; j < 4; ++j) { const int d = 4 * F.lane + 256 * j;
            const f32x4 h = v[j] * rstd * g[j] * (sc[j] + 1.0f) + sh[j];
            if (MODE == 2) { const f32x4 h8 = h * 8.0f; *(unsigned*)(O8 + (size_t)m * DM + d) = pk4_fp8(h8[0], h8[1], h8[2], h8[3]); }
            else { v2u w; w.x = pk2(h[0], h[1]); w.y = pk2(h[2], h[3]); o8[64 * j] = w; }
            if (MODE == 1) { const f32x4 hs = h * 16.0f; *(unsigned*)(O8 + (size_t)(d >> 8) * ((size_t)MT * 256) + (size_t)m * 256 + (d & 255)) = pk4_fp8(hs[0], hs[1], hs[2], hs[3]); } }
    }
}

__device__ __forceinline__ float lg_gamma(int h) { return __builtin_log2f(1.0f - fexp2((float)(-5 - h))); }
__device__ __forceinline__ v4u scale8(v4u w, float s) {
    v4u o; o.x = pk2(bflo(w.x) * s, bfhi(w.x) * s); o.y = pk2(bflo(w.y) * s, bfhi(w.y) * s); o.z = pk2(bflo(w.z) * s, bfhi(w.z) * s); o.w = pk2(bflo(w.w) * s, bfhi(w.w) * s); return o;
}
struct KvRegs { v4u k[4], v[8]; };
__device__ __forceinline__ void kv_load(Frame& F, int u, KvRegs& R) {
    const int b = u >> 7, h = (u >> 5) & 3, c = u & 31; const size_t tok0 = (size_t)b * SEQ + c * 128;
    const bf16* Kb = (const bf16*)(F.dout + DO_K); const bf16* Vb = (const bf16*)(F.ws + WS_V);
#pragma unroll
    for (int i = 0; i < 4; ++i) { const int ch = F.tid + 512 * i, j = ch >> 4, cc = ch & 15; R.k[i] = *(const v4u*)(Kb + (tok0 + j) * 512 + h * 128 + cc * 8); }
#pragma unroll
    for (int i = 0; i < 8; ++i) { const int ch = F.tid + 512 * i, j = ch >> 5, cc = ch & 31; R.v[i] = *(const v4u*)(Vb + (tok0 + j) * 1024 + h * 256 + cc * 8); }
}
__device__ __forceinline__ void kv_unit(Frame& F, int u, KvRegs& R, int unext) {
    const int b = u >> 7, h = (u >> 5) & 3, c = u & 31;
    LAS unsigned char* Kimg = F.lds; LAS unsigned char* Vimg = F.lds + 34816;
    const float lg = lg_gamma(h);
#pragma unroll
    for (int i = 0; i < 4; ++i) { const int ch = F.tid + 512 * i, j = ch >> 4, cc = ch & 15;
        *(LAS v4u*)(Kimg + j * KS + cc * 16) = scale8(R.k[i], fexp2((float)(127 - j) * lg)); }
#pragma unroll
    for (int i = 0; i < 8; ++i) { const int ch = F.tid + 512 * i, j = ch >> 5, cc = ch & 31; *(LAS v4u*)(Vimg + j * VS + cc * 16) = R.v[i]; }
    __syncthreads();
    if (unext >= 0) kv_load(F, unext, R);
    f32x4 acc[8][2];
#pragma unroll
    for (int dt = 0; dt < 8; ++dt) { acc[dt][0] = (f32x4){0.f, 0.f, 0.f, 0.f}; acc[dt][1] = (f32x4){0.f, 0.f, 0.f, 0.f}; }
#pragma unroll
    for (int js = 0; js < 4; ++js) {
        bf16x8 bv[2];
#pragma unroll
        for (int vt = 0; vt < 2; ++vt) bv[vt] = lds_tr_frag(Vimg, VS, 32 * js, 32 * F.wave + 16 * vt, F.lane);
#pragma unroll
        for (int dt = 0; dt < 8; ++dt) { const bf16x8 a = lds_tr_frag(Kimg, KS, 32 * js, 16 * dt, F.lane);
            acc[dt][0] = MFMA16(a, bv[0], acc[dt][0]); acc[dt][1] = MFMA16(a, bv[1], acc[dt][1]); }
    }
    bf16* dst = (bf16*)(F.dout + DO_KVS) + (size_t)(((b * 4 + h) * 32 + c)) * 32768;
#pragma unroll
    for (int dt = 0; dt < 8; ++dt)
#pragma unroll
        for (int vt = 0; vt < 2; ++vt) { const int v = 32 * F.wave + 16 * vt + (F.lane & 15), d0 = 16 * dt + 4 * (F.lane >> 4);
            v2u o; o.x = pk2(acc[dt][vt][0], acc[dt][vt][1]); o.y = pk2(acc[dt][vt][2], acc[dt][vt][3]);
            *(v2u*)(dst + v * 128 + d0) = o; }
    __syncthreads();
}
struct SguRegs { v4u sv[8]; f32x2v st[8]; };
__device__ __forceinline__ void sgu_load(Frame& F, int su, SguRegs& R) {
    const size_t tok0 = (size_t)(su >> 2) * 128; const int g = su & 3; const bf16* SVb = (const bf16*)(F.ws + WS_SV); const float* stat = (const float*)(F.ws + WS_SVSTAT);
    int tq = F.tid; asm volatile("" : "+v"(tq));
#pragma unroll
    for (int i = 0; i < 8; ++i) { const int ch = tq + 512 * i, sr = ch >> 5, cc = ch & 31;
        R.sv[i] = *(const v4u*)(SVb + (tok0 + sr) * 1024 + g * 256 + cc * 8); R.st[i] = *(const f32x2v*)(stat + (tok0 + sr) * 2); }
}
__device__ __forceinline__ void sgu_unit(Frame& F, int su, SguRegs& R, int snext, int& cur_g) {
    const size_t tok0 = (size_t)(su >> 2) * 128; const int g = su & 3;
    LAS unsigned char* Vn = F.lds; LAS unsigned char* Wimg = F.lds + 67584;
    const bf16* Ub = (const bf16*)(F.ws + WS_U); const bf16* Wm = (const bf16*)(F.ws + WS_SGUW);
    { const int cc = F.tid & 31; const int col = g * 256 + cc * 8;
        const f32x4 g0 = *(const f32x4*)(F.sgu_ln_g + col), g1 = *(const f32x4*)(F.sgu_ln_g + col + 4), b0 = *(const f32x4*)(F.sgu_ln_b + col), b1 = *(const f32x4*)(F.sgu_ln_b + col + 4);
#pragma unroll
        for (int i = 0; i < 8; ++i) { const int ch = F.tid + 512 * i, sr = ch >> 5; const v4u w = R.sv[i];
            const float mean = R.st[i].x * (1.f / 1024.f), var = R.st[i].y * (1.f / 1024.f) - mean * mean, rstd = __builtin_amdgcn_rsqf(var + EPSN);
            v4u o;
            o.x = pk2((bflo(w.x) - mean) * rstd * g0[0] + b0[0], (bfhi(w.x) - mean) * rstd * g0[1] + b0[1]);
            o.y = pk2((bflo(w.y) - mean) * rstd * g0[2] + b0[2], (bfhi(w.y) - mean) * rstd * g0[3] + b0[3]);
            o.z = pk2((bflo(w.z) - mean) * rstd * g1[0] + b1[0], (bfhi(w.z) - mean) * rstd * g1[1] + b1[1]);
            o.w = pk2((bflo(w.w) - mean) * rstd * g1[2] + b1[2], (bfhi(w.w) - mean) * rstd * g1[3] + b1[3]);
            *(LAS v4u*)(Vn + sr * VS + cc * 16) = o; } }
    if (g != cur_g) { cur_g = g;
#pragma unroll
        for (int i = 0; i < 4; ++i) { const int ch = F.tid + 512 * i, t = ch >> 4, cc = ch & 15;
            *(LAS v4u*)(Wimg + t * KS + cc * 16) = *(const v4u*)(Wm + (size_t)(g * 128 + t) * 128 + cc * 8); } }
    __syncthreads();
    if (snext >= 0) sgu_load(F, snext, R);
    v2u uv[8][2];
#pragma unroll
    for (int tt = 0; tt < 8; ++tt)
#pragma unroll
        for (int ct = 0; ct < 2; ++ct) uv[tt][ct] = *(const v2u*)(Ub + (tok0 + 16 * tt + (F.lane & 15)) * 1024 + g * 256 + 32 * F.wave + 16 * ct + 4 * (F.lane >> 4));
    f32x4 acc[2][8];
#pragma unroll
    for (int ct = 0; ct < 2; ++ct)
#pragma unroll
        for (int tt = 0; tt < 8; ++tt) acc[ct][tt] = (f32x4){0.f, 0.f, 0.f, 0.f};
#pragma unroll
    for (int ss = 0; ss < 4; ++ss) {
        bf16x8 av[2];
#pragma unroll
        for (int ct = 0; ct < 2; ++ct) av[ct] = lds_tr_frag(Vn, VS, 32 * ss, 32 * F.wave + 16 * ct, F.lane);
#pragma unroll
        for (int tt = 0; tt < 8; ++tt) if (tt >= 2 * ss) { const bf16x8 bw = lds_row_frag(Wimg, KS, 16 * tt, 32 * ss, F.lane);
            acc[0][tt] = MFMA16(av[0], bw, acc[0][tt]); acc[1][tt] = MFMA16(av[1], bw, acc[1][tt]); }
    }
#pragma unroll
    for (int tt = 0; tt < 8; ++tt) { const int t = 16 * tt + (F.lane & 15); const float bs = F.sgu_b[g * 128 + t];
#pragma unroll
        for (int ct = 0; ct < 2; ++ct) { const int cg = g * 256 + 32 * F.wave + 16 * ct + 4 * (F.lane >> 4); const v2u u2 = uv[tt][ct];
            *(unsigned*)(F.ws + WS_YS8 + (tok0 + t) * 1024 + cg) = pk4_fp8(8.f * bflo(u2.x) * (acc[ct][tt][0] + bs), 8.f * bfhi(u2.x) * (acc[ct][tt][1] + bs), 8.f * bflo(u2.y) * (acc[ct][tt][2] + bs), 8.f * bfhi(u2.y) * (acc[ct][tt][3] + bs)); } }
    __syncthreads();
}
__device__ __forceinline__ void p2a(Frame& F) { F.fence_ids();
    { KvRegs R; if (F.bid < 1024) kv_load(F, F.bid, R);
      for (int u = F.bid; u < 1024; u += F.G) kv_unit(F, u, R, (u + F.G < 1024) ? u + F.G : -1); }
#if MK_PROBE_HI > 0
    if (F.bid == 0 && threadIdx.x == 0) { const unsigned long long _t = __builtin_amdgcn_s_memrealtime(); F.misc[16 + 2 * 20] = (unsigned)_t; F.misc[17 + 2 * 20] = (unsigned)(_t >> 32); }
#endif
    { SguRegs R; int cur_g = -1; if (F.bid < 1024) sgu_load(F, F.bid, R);
      for (int su = F.bid; su < 1024; su += F.G) sgu_unit(F, su, R, (su + F.G < 1024) ? su + F.G : -1, cur_g); }
}
__device__ __forceinline__ void p2b(Frame& F) { F.fence_ids();
    bf16* KVS = (bf16*)(F.dout + DO_KVS);
    for (int item = F.bid * 512 + F.tid; item < 32 * 4096; item += F.G * 512) {
        const int bh = item >> 12, rem = item & 4095, h = bh & 3;
        const float dc = fexp2(128.0f * lg_gamma(h));
        float s[8];
#pragma unroll
        for (int e = 0; e < 8; ++e) s[e] = 0.f;
        bf16* p = KVS + (size_t)bh * 32 * 32768 + (size_t)rem * 8;
        for (int c0 = 0; c0 < 32; c0 += 8) {
            v4u kv[8];
#pragma unroll
            for (int i = 0; i < 8; ++i) kv[i] = *(const v4u*)(p + (size_t)(c0 + i) * 32768);
#pragma unroll
            for (int i = 0; i < 8; ++i) {
                v4u o; o.x = pk2(s[0], s[1]); o.y = pk2(s[2], s[3]); o.z = pk2(s[4], s[5]); o.w = pk2(s[6], s[7]);
                *(v4u*)(p + (size_t)(c0 + i) * 32768) = o;
                s[0] = s[0] * dc + bflo(kv[i].x); s[1] = s[1] * dc + bfhi(kv[i].x); s[2] = s[2] * dc + bflo(kv[i].y); s[3] = s[3] * dc + bfhi(kv[i].y);
                s[4] = s[4] * dc + bflo(kv[i].z); s[5] = s[5] * dc + bfhi(kv[i].z); s[6] = s[6] * dc + bflo(kv[i].w); s[7] = s[7] * dc + bfhi(kv[i].w);
            }
        }
    }
}
struct RetRegs { v4u q[4], k[4], v[8]; };
__device__ __forceinline__ void ret_load(Frame& F, int u, RetRegs& R) {
    const int b = u >> 7, h = (u >> 5) & 3, c = u & 31; const size_t tok0 = (size_t)b * SEQ + c * 128;
    const bf16* Qb = (const bf16*)(F.dout + DO_Q); const bf16* Kb = (const bf16*)(F.dout + DO_K); const bf16* Vb = (const bf16*)(F.ws + WS_V);
#pragma unroll
    for (int i = 0; i < 4; ++i) { const int ch = F.tid + 512 * i, j = ch >> 4, cc = ch & 15;
        R.q[i] = *(const v4u*)(Qb + (tok0 + j) * 512 + h * 128 + cc * 8); R.k[i] = *(const v4u*)(Kb + (tok0 + j) * 512 + h * 128 + cc * 8); }
#pragma unroll
    for (int i = 0; i < 8; ++i) { const int ch = F.tid + 512 * i, j = ch >> 5, cc = ch & 31; R.v[i] = *(const v4u*)(Vb + (tok0 + j) * 1024 + h * 256 + cc * 8); }
}
__device__ __forceinline__ void ret_unit(Frame& F, int u, RetRegs& R, int unext) {
    const int b = u >> 7, h = (u >> 5) & 3, c = u & 31;
    const size_t tok0 = (size_t)b * SEQ + c * 128;
    LAS unsigned char* Qimg = F.lds; LAS unsigned char* Kimg = F.lds + 34816; LAS unsigned char* Vimg = F.lds + 69632;
    LAS unsigned char* Sout = F.lds;
    const bf16* Gb = (const bf16*)(F.ws + WS_G);
    const bf16* ST = (const bf16*)(F.dout + DO_KVS) + (size_t)(((b * 4 + h) * 32 + c)) * 32768;
    const float lg = lg_gamma(h);
    const int lane = F.lane, w = F.wave, l15 = lane & 15, g4 = lane >> 4;
#pragma unroll
    for (int i = 0; i < 4; ++i) { const int ch = F.tid + 512 * i, j = ch >> 4, cc = ch & 15;
        *(LAS v4u*)(Qimg + j * KS + cc * 16) = R.q[i]; *(LAS v4u*)(Kimg + j * KS + cc * 16) = R.k[i]; }
#pragma unroll
    for (int i = 0; i < 8; ++i) { const int ch = F.tid + 512 * i, j = ch >> 5, cc = ch & 31; *(LAS v4u*)(Vimg + j * VS + cc * 16) = R.v[i]; }
    bf16x8 bs[4][2];
#pragma unroll
    for (int ds = 0; ds < 4; ++ds)
#pragma unroll
        for (int vt = 0; vt < 2; ++vt) bs[ds][vt] = *(const bf16x8*)(ST + (size_t)(32 * w + 16 * vt + l15) * 128 + 32 * ds + 8 * g4);
    __syncthreads();
    f32x4 st[8];
#pragma unroll
    for (int jt = 0; jt < 8; ++jt) st[jt] = (f32x4){0.f, 0.f, 0.f, 0.f};
#pragma unroll
    for (int ds = 0; ds < 4; ++ds) { const bf16x8 bq = lds_row_frag(Qimg, KS, 16 * w, 32 * ds, lane);
#pragma unroll
        for (int jt = 0; jt < 8; ++jt) if (jt <= w) { const bf16x8 ak = lds_row_frag(Kimg, KS, 16 * jt, 32 * ds, lane); st[jt] = MFMA16(ak, bq, st[jt]); } }
    __syncthreads();
    { const int i = 16 * w + l15;
#pragma unroll
        for (int jt = 0; jt < 8; ++jt) { float o[4];
#pragma unroll
            for (int ii = 0; ii < 4; ++ii) { const int j = 16 * jt + 4 * g4 + ii; o[ii] = (i >= j) ? st[jt][ii] * fexp2((float)(i - j) * lg) : 0.f; }
            v2u pk; pk.x = pk2(o[0], o[1]); pk.y = pk2(o[2], o[3]);
            *(LAS v2u*)(Kimg + i * KS + (16 * jt + 4 * g4) * 2) = pk; } }
    __syncthreads();
    f32x4 acc[8][2];
#pragma unroll
    for (int it = 0; it < 8; ++it) { acc[it][0] = (f32x4){0.f, 0.f, 0.f, 0.f}; acc[it][1] = (f32x4){0.f, 0.f, 0.f, 0.f}; }
#pragma unroll
    for (int ds = 0; ds < 4; ++ds) {
#pragma unroll
        for (int it = 0; it < 8; ++it) { const bf16x8 a = lds_row_frag(Qimg, KS, 16 * it, 32 * ds, lane);
            acc[it][0] = MFMA16(a, bs[ds][0], acc[it][0]); acc[it][1] = MFMA16(a, bs[ds][1], acc[it][1]); } }
#pragma unroll
    for (int it = 0; it < 8; ++it)
#pragma unroll
        for (int ii = 0; ii < 4; ++ii) { const float dq = fexp2((float)(16 * it + 4 * g4 + ii + 1) * lg); acc[it][0][ii] *= dq; acc[it][1][ii] *= dq; }
#pragma unroll
    for (int js = 0; js < 4; ++js) { bf16x8 bv[2];
#pragma unroll
        for (int vt = 0; vt < 2; ++vt) bv[vt] = lds_tr_frag(Vimg, VS, 32 * js, 32 * w + 16 * vt, lane);
#pragma unroll
        for (int it = 0; it < 8; ++it) if (it >= 2 * js) { const bf16x8 a = lds_row_frag(Kimg, KS, 16 * it, 32 * js, lane);
            acc[it][0] = MFMA16(a, bv[0], acc[it][0]); acc[it][1] = MFMA16(a, bv[1], acc[it][1]); } }
    int lane_h = lane; asm volatile("" : "+v"(lane_h));
    v2u gt[16];
#pragma unroll
    for (int rr = 0; rr < 16; ++rr) gt[rr] = *(const v2u*)(Gb + (tok0 + 16 * w + rr) * 1024 + h * 256 + 4 * lane_h);
    const f32x4 gn = *(const f32x4*)(F.ret_gn_g + h * 256 + 4 * lane_h);
    __syncthreads();
#pragma unroll
    for (int it = 0; it < 8; ++it)
#pragma unroll
        for (int vt = 0; vt < 2; ++vt)
#pragma unroll
            for (int ii = 0; ii < 4; ++ii) *(LAS float*)(Sout + (16 * it + 4 * g4 + ii) * 1040 + (32 * w + 16 * vt + l15) * 4) = acc[it][vt][ii];
    __syncthreads();
#pragma unroll
    for (int rr = 0; rr < 16; ++rr) { const int i = 16 * w + rr;
        const f32x4 y = *(LAS const f32x4*)(Sout + i * 1040 + lane_h * 16);
        const float mean = wave_sum((y[0] + y[1]) + (y[2] + y[3])) * (1.f / 256.f);
        const f32x4 d = y - mean;
        const float var = wave_sum((d[0] * d[0] + d[1] * d[1]) + (d[2] * d[2] + d[3] * d[3])) * (1.f / 256.f);
        const float r8 = __builtin_amdgcn_rsqf(var + EPSN) * 4.0f;
        const size_t off = (tok0 + i) * 1024 + h * 256 + 4 * lane_h;
        *(unsigned*)(F.ws + WS_YG8 + off) = pk4_fp8(d[0] * r8 * gn[0] * bflo(gt[rr].x), d[1] * r8 * gn[1] * bfhi(gt[rr].x), d[2] * r8 * gn[2] * bflo(gt[rr].y), d[3] * r8 * gn[3] * bfhi(gt[rr].y)); }
    __syncthreads();
}
__device__ __forceinline__ void p2c(Frame& F) { F.fence_ids(); for (int u = F.bid; u < 1024; u += F.G) { RetRegs R; ret_load(F, u, R); ret_unit(F, u, R, -1); } }

__device__ __forceinline__ float dppx(float v, int) { return v; }
template <int CTRL> __device__ __forceinline__ void merge16(float (&L)[16]) {
    float c[16];
#pragma unroll
    for (int i = 0; i < 16; ++i) c[i] = __builtin_fmaxf(L[i], dpp_f<CTRL>(L[15 - i]));
#pragma unroll
    for (int half = 8; half >= 1; half >>= 1)
#pragma unroll
        for (int i = 0; i < 16; ++i) if ((i & half) == 0) { const float hi = __builtin_fmaxf(c[i], c[i + half]), lo = __builtin_fminf(c[i], c[i + half]); c[i] = hi; c[i + half] = lo; }
#pragma unroll
    for (int i = 0; i < 16; ++i) L[i] = c[i];
}
__device__ __forceinline__ void sort16_desc(float (&v)[16]) {
#pragma unroll
    for (int k = 2; k <= 16; k <<= 1)
#pragma unroll
        for (int j = k >> 1; j >= 1; j >>= 1)
#pragma unroll
            for (int i = 0; i < 16; ++i) { const int l = i ^ j; if (l > i) { const bool desc = ((i & k) == 0) || (k == 16);
                const float hi = __builtin_fmaxf(v[i], v[l]), lo = __builtin_fminf(v[i], v[l]); v[i] = desc ? hi : lo; v[l] = desc ? lo : hi; } }
}
__device__ __forceinline__ void merge_top16(float (&A)[16], const float (&B)[16]) {
#pragma unroll
    for (int i = 0; i < 16; ++i) A[i] = __builtin_fmaxf(A[i], B[15 - i]);
#pragma unroll
    for (int half = 8; half >= 1; half >>= 1)
#pragma unroll
        for (int i = 0; i < 16; ++i) if ((i & half) == 0) { const float hi = __builtin_fmaxf(A[i], A[i + half]), lo = __builtin_fminf(A[i], A[i + half]); A[i] = hi; A[i + half] = lo; }
}
__device__ __forceinline__ void p5b(Frame& F) {
    F.fence_ids();
    LAS unsigned char* Aimg = F.lds; LAS unsigned char* Bimg = F.lds + 34816; LAS float* Sc = (LAS float*)(F.lds + 69632);
    const bf16* QP = (const bf16*)(F.ws + WS_GA);
    const int lane = F.lane, w = F.wave;
    int cur_hp = -1;
    v4u pa[4];
    if (F.bid < 4096) { const int tt = F.bid >> 4, hp = F.bid & 15;
#pragma unroll
        for (int i = 0; i < 4; ++i) { const int ch = F.tid + 512 * i, r = ch >> 4, cc = ch & 15; pa[i] = *(const v4u*)(QP + ((size_t)tt * 128 + r) * 2048 + hp * 128 + cc * 8); } }
    for (int u = F.bid; u < 4096; u += F.G) {
        const int tt = u >> 4, hp = u & 15; const size_t tok0 = (size_t)tt * 128;
#pragma unroll
        for (int i = 0; i < 4; ++i) { const int ch = F.tid + 512 * i, r = ch >> 4, cc = ch & 15; *(LAS v4u*)(Aimg + r * KS + cc * 16) = pa[i]; }
        if (hp != cur_hp) { const bf16* SK = (const bf16*)(F.ws + WS_SK) + (size_t)hp * 16384; cur_hp = hp;
#pragma unroll
            for (int i = 0; i < 4; ++i) { const int ch = F.tid + 512 * i, r = ch >> 4, cc = ch & 15; *(LAS v4u*)(Bimg + r * KS + cc * 16) = *(const v4u*)(SK + (size_t)r * 128 + cc * 8); } }
        __syncthreads();
        { const int un = u + F.G; if (un < 4096) { const int tn = un >> 4, hn = un & 15;
#pragma unroll
            for (int i = 0; i < 4; ++i) { const int ch = F.tid + 512 * i, r = ch >> 4, cc = ch & 15; pa[i] = *(const v4u*)(QP + ((size_t)tn * 128 + r) * 2048 + hn * 128 + cc * 8); } } }
        f32x4 acc[8];
#pragma unroll
        for (int nt = 0; nt < 8; ++nt) acc[nt] = (f32x4){0.f, 0.f, 0.f, 0.f};
#pragma unroll
        for (int ks = 0; ks < 4; ++ks) { const bf16x8 a = lds_row_frag(Aimg, KS, 16 * w, 32 * ks, lane);
#pragma unroll
            for (int nt = 0; nt < 8; ++nt) { const bf16x8 bb = lds_row_frag(Bimg, KS, 16 * nt, 32 * ks, lane); acc[nt] = MFMA16(a, bb, acc[nt]); } }
#pragma unroll
        for (int nt = 0; nt < 8; ++nt)
#pragma unroll
            for (int ii = 0; ii < 4; ++ii) Sc[(16 * w + 4 * (lane >> 4) + ii) * 132 + 16 * nt + (lane & 15)] = acc[nt][ii];
        __syncthreads();
        { const int row = F.tid >> 2, q = F.tid & 3;
            float L[16], L2[16];
#pragma unroll
            for (int i = 0; i < 16; ++i) { const int n = 4 * i + q, n2 = 4 * (i + 16) + q;
                L[i] = __uint_as_float((__float_as_uint(Sc[row * 132 + n]) & 0xFFFFFF80u) | (unsigned)n);
                L2[i] = __uint_as_float((__float_as_uint(Sc[row * 132 + n2]) & 0xFFFFFF80u) | (unsigned)n2); }
            sort16_desc(L); sort16_desc(L2); merge_top16(L, L2);
            merge16<0xB1>(L); merge16<0x4E>(L);
            if (q == 0) { v4u* dst = (v4u*)((unsigned*)(F.ws + WS_SUB) + ((tok0 + row) * 16 + hp) * 16);
#pragma unroll
                for (int i = 0; i < 4; ++i) dst[i] = (v4u){__float_as_uint(L[4 * i]), __float_as_uint(L[4 * i + 1]), __float_as_uint(L[4 * i + 2]), __float_as_uint(L[4 * i + 3])}; } }
        __syncthreads();
    }
}

template <int CTRL> __device__ __forceinline__ float dpp_max(float v) { return __builtin_fmaxf(v, dpp_f<CTRL>(v)); }
template <int CTRL> __device__ __forceinline__ float dpp_add(float v) { return v + dpp_f<CTRL>(v); }
__device__ __forceinline__ float row_allmax(float v) { v = dpp_max<0x128>(v); v = dpp_max<0x124>(v); v = dpp_max<0x122>(v); v = dpp_max<0x121>(v); return v; }
__device__ __forceinline__ float row_allsum(float v) { v = dpp_add<0x128>(v); v = dpp_add<0x124>(v); v = dpp_add<0x122>(v); v = dpp_add<0x121>(v); return v; }
__device__ __forceinline__ void p6a(Frame& F) { F.fence_ids();
    const int lane = F.lane, row = lane >> 4, i = lane & 15, rowbase = lane & 48;
    LAS unsigned* Sel = (LAS unsigned*)(F.lds + F.wave * 1024);
    const unsigned* SUB = (const unsigned*)(F.ws + WS_SUB);
    unsigned* EID = (unsigned*)(F.ws + WS_EID); float* GWp = (float*)(F.ws + WS_GW);
    const int gw = F.bid * NWAVES + F.wave, NGW = F.G * NWAVES;
    unsigned nab[2], nbb[2];
    if (gw < MT) {
#pragma unroll
        for (int r = 0; r < 2; ++r) { const int h = 4 * r + row; nab[r] = SUB[((size_t)gw * 16 + 2 * h) * 16 + i]; nbb[r] = SUB[((size_t)gw * 16 + 2 * h + 1) * 16 + i]; } }
    for (int t = gw; t < MT; t += NGW) {
        unsigned abits[2], bbits[2], bcur[2]; float a[2], hv[2]; int ptr[2];
#pragma unroll
        for (int r = 0; r < 2; ++r) { abits[r] = nab[r]; bbits[r] = nbb[r]; a[r] = __uint_as_float(abits[r]); ptr[r] = 0; bcur[r] = (unsigned)__shfl((int)bbits[r], rowbase); hv[r] = a[r] + __uint_as_float(bcur[r]); }
        if (t + NGW < MT) {
#pragma unroll
            for (int r = 0; r < 2; ++r) { const int h = 4 * r + row; nab[r] = SUB[((size_t)(t + NGW) * 16 + 2 * h) * 16 + i]; nbb[r] = SUB[((size_t)(t + NGW) * 16 + 2 * h + 1) * 16 + i]; } }
        for (int k = 0; k < 16; ++k) {
#pragma unroll
            for (int r = 0; r < 2; ++r) {
                const float key = __uint_as_float((__float_as_uint(hv[r]) & 0xFFFFFFF0u) | (unsigned)i);
                const float m = row_allmax(key);
                const bool win = (key == m);
                if (win) { Sel[((r * 4 + row) * 16 + k) * 2] = (abits[r] & 127u) * 128u + (bcur[r] & 127u); Sel[((r * 4 + row) * 16 + k) * 2 + 1] = __float_as_uint(hv[r]); ptr[r]++; }
                const unsigned bnext = (unsigned)__shfl((int)bbits[r], rowbase + (ptr[r] < 15 ? ptr[r] : 15));
                if (win) { bcur[r] = bnext; hv[r] = (ptr[r] < 16) ? a[r] + __uint_as_float(bnext) : -3.0e38f; }
            }
        }
        LDS_WAIT(); asm volatile("" ::: "memory");
#pragma unroll
        for (int r = 0; r < 2; ++r) { const int h = 4 * r + row;
            const unsigned e = Sel[((r * 4 + row) * 16 + i) * 2]; const float sc = __uint_as_float(Sel[((r * 4 + row) * 16 + i) * 2 + 1]);
            const float mx = row_allmax(sc);
            const float ex = fexp2((sc - mx) * 1.44269504089f);
            const float sum = row_allsum(ex);
            EID[(size_t)t * 128 + h * 16 + i] = e; GWp[(size_t)t * 128 + h * 16 + i] = ex / sum; }
        LDS_WAIT(); asm volatile("" ::: "memory");
    }
}
typedef float f32x2c __attribute__((ext_vector_type(2)));
__device__ __forceinline__ long mk64(unsigned lo, unsigned hi) { return (long)(((unsigned long long)hi << 32) | lo); }
#if MK_U4
typedef int v8i_q __attribute__((ext_vector_type(8)));
__device__ __forceinline__ void p6b(Frame& F) { F.fence_ids();
    const int j = F.bid & 7, s2 = j >> 1, par = j & 1, nsb = F.G >> 3; if ((F.bid >> 3) >= nsb) return;
    const int wj = (F.bid >> 3) * NWAVES + F.wave, NW = nsb * NWAVES, NI = MT / 2;
    const int lane = F.lane, g = lane >> 4;
    const int pidx = (4 * (lane & 15) + (lane >> 4)) * 4;
    const unsigned char* H8 = F.ws + WS_H2F8 + (size_t)s2 * MT * 256 + 16 * g; const unsigned char* U4 = F.ws + WS_UE8 + (size_t)s2 * 16384 * 128 + 16 * (lane & 3); const unsigned* EID = (const unsigned*)(F.ws + WS_EID) + (lane >> 2);
    float* PD = (float*)(F.ws + WS_PD) + (size_t)s2 * MT * 128;
#define TOK(ix_) (2 * ((ix_) < NI ? (ix_) : NI - 1) + par)
#define P6B_LOAD_EID(E, ix_) do { const int tc_ = TOK(ix_); _Pragma("unroll") for (int h = 0; h < 8; ++h) E[h] = EID[(size_t)tc_ * 128 + 16 * h]; } while (0)
#define P6B_LOAD_AB(A_, B0_, B1_, E, ix_) do { const int tc_ = TOK(ix_); const unsigned char* hp_ = H8 + (size_t)tc_ * 256; A_[0] = *(const v4u*)hp_; A_[1] = *(const v4u*)(hp_ + 64); A_[2] = *(const v4u*)(hp_ + 128); A_[3] = *(const v4u*)(hp_ + 192); \
        _Pragma("unroll") for (int h = 0; h < 8; ++h) { const unsigned char* rp_ = U4 + (size_t)E[h] * 128; B0_[h] = *(const v4u*)rp_; B1_[h] = *(const v4u*)(rp_ + 64); } } while (0)
#define BPM(x_) ((int)__builtin_amdgcn_ds_bpermute(pidx, (int)(x_)))
#define P6B_COMPUTE(A_, B0_, B1_, ix_) do { if ((ix_) < NI) { const int tc_ = 2 * (ix_) + par; \
        const v8i_q a0_ = (v8i_q){(int)A_[0].x, (int)A_[0].y, (int)A_[0].z, (int)A_[0].w, (int)A_[1].x, (int)A_[1].y, (int)A_[1].z, (int)A_[1].w}, a1_ = (v8i_q){(int)A_[2].x, (int)A_[2].y, (int)A_[2].z, (int)A_[2].w, (int)A_[3].x, (int)A_[3].y, (int)A_[3].z, (int)A_[3].w}; \
        _Pragma("unroll") for (int h = 0; h < 8; ++h) { const v8i_q b0_ = (v8i_q){BPM(B0_[h].x), BPM(B0_[h].y), BPM(B0_[h].z), BPM(B0_[h].w), 0, 0, 0, 0}, b1_ = (v8i_q){BPM(B1_[h].x), BPM(B1_[h].y), BPM(B1_[h].z), BPM(B1_[h].w), 0, 0, 0, 0}; \
            f32x4 acc_ = __builtin_amdgcn_mfma_scale_f32_16x16x128_f8f6f4(a0_, b0_, (f32x4){0.f, 0.f, 0.f, 0.f}, 0, 4, 0, 0x7F7F7F7F, 0, 0x7F7F7F7F); \
            acc_ = __builtin_amdgcn_mfma_scale_f32_16x16x128_f8f6f4(a1_, b1_, acc_, 0, 4, 0, 0x7F7F7F7F, 0, 0x7F7F7F7F); \
            if (lane < 16) PD[(size_t)tc_ * 128 + 16 * h + lane] = acc_[0] * (1.0f / 1024.0f); } } } while (0)
    unsigned E0[8], E1[8]; v4u A0[4], A1[4], B00[8], B01[8], B10[8], B11[8];
    int ix = wj;
    P6B_LOAD_EID(E0, ix); P6B_LOAD_EID(E1, ix + NW);
    P6B_LOAD_AB(A0, B00, B01, E0, ix);
    for (; ix < NI; ix += 2 * NW) {
        P6B_LOAD_AB(A1, B10, B11, E1, ix + NW);
        P6B_LOAD_EID(E0, ix + 2 * NW);
        P6B_COMPUTE(A0, B00, B01, ix);
        P6B_LOAD_AB(A0, B00, B01, E0, ix + 2 * NW);
        P6B_LOAD_EID(E1, ix + 3 * NW);
        P6B_COMPUTE(A1, B10, B11, ix + NW);
    }
#undef TOK
#undef P6B_LOAD_EID
#undef P6B_LOAD_AB
#undef P6B_COMPUTE
#undef BPM
}
#else
__device__ __forceinline__ void p6b(Frame& F) { F.fence_ids();
    const int j = F.bid & 7, nsb = F.G >> 3; if ((F.bid >> 3) >= nsb) return;
    const int wj = (F.bid >> 3) * NWAVES + F.wave, NW = nsb * NWAVES;
    const int lane = F.lane, g = lane >> 4;
    const int pidx = (4 * (lane & 15) + (lane >> 4)) * 4;
    const unsigned char* H8 = F.ws + WS_H2F8 + (size_t)j * MT * 128 + 16 * g; const unsigned char* UE8 = F.ws + WS_UE8 + (size_t)j * 16384 * 128 + 16 * (lane & 3); const unsigned* EID = (const unsigned*)(F.ws + WS_EID) + (lane >> 2);
    float* PD = (float*)(F.ws + WS_PD) + (size_t)j * MT * 128;
#define P6B_LOAD_EID(E, tt) do { const int tc_ = (tt) < MT ? (tt) : MT - 1; _Pragma("unroll") for (int h = 0; h < 8; ++h) E[h] = EID[(size_t)tc_ * 128 + 16 * h]; } while (0)
#define P6B_LOAD_AB(A0_, A1_, B0_, B1_, E, tt) do { const int tc_ = (tt) < MT ? (tt) : MT - 1; const unsigned char* hp_ = H8 + (size_t)tc_ * 128; A0_ = *(const v4u*)hp_; A1_ = *(const v4u*)(hp_ + 64); \
        _Pragma("unroll") for (int h = 0; h < 8; ++h) { const unsigned char* rp_ = UE8 + (size_t)E[h] * 128; B0_[h] = *(const v4u*)rp_; B1_[h] = *(const v4u*)(rp_ + 64); } } while (0)
#define BPM(x_) ((unsigned)__builtin_amdgcn_ds_bpermute(pidx, (int)(x_)))
#define P6B_COMPUTE(A0_, A1_, B0_, B1_, tt) do { if ((tt) < MT) { _Pragma("unroll") for (int h = 0; h < 8; ++h) { f32x4 acc_ = (f32x4){0.f, 0.f, 0.f, 0.f}; \
            acc_ = __builtin_amdgcn_mfma_f32_16x16x32_fp8_fp8(mk64(A0_.x, A0_.y), mk64(BPM(B0_[h].x), BPM(B0_[h].y)), acc_, 0, 0, 0); \
            acc_ = __builtin_amdgcn_mfma_f32_16x16x32_fp8_fp8(mk64(A0_.z, A0_.w), mk64(BPM(B0_[h].z), BPM(B0_[h].w)), acc_, 0, 0, 0); \
            acc_ = __builtin_amdgcn_mfma_f32_16x16x32_fp8_fp8(mk64(A1_.x, A1_.y), mk64(BPM(B1_[h].x), BPM(B1_[h].y)), acc_, 0, 0, 0); \
            acc_ = __builtin_amdgcn_mfma_f32_16x16x32_fp8_fp8(mk64(A1_.z, A1_.w), mk64(BPM(B1_[h].z), BPM(B1_[h].w)), acc_, 0, 0, 0); \
            if (lane < 16) PD[(size_t)(tt) * 128 + 16 * h + lane] = acc_[0] * (1.0f / 8192.0f); } } } while (0)
    unsigned E0[8], E1[8]; v4u A00, A01, A10, A11, B00[8], B01[8], B10[8], B11[8];
    int t = wj;
    P6B_LOAD_EID(E0, t); P6B_LOAD_EID(E1, t + NW);
    P6B_LOAD_AB(A00, A01, B00, B01, E0, t);
    for (; t < MT; t += 2 * NW) {
        P6B_LOAD_AB(A10, A11, B10, B11, E1, t + NW);
        P6B_LOAD_EID(E0, t + 2 * NW);
        P6B_COMPUTE(A00, A01, B00, B01, t);
        P6B_LOAD_AB(A00, A01, B00, B01, E0, t + 2 * NW);
        P6B_LOAD_EID(E1, t + 3 * NW);
        P6B_COMPUTE(A10, A11, B10, B11, t + NW);
    }
#undef P6B_LOAD_EID
#undef P6B_LOAD_AB
#undef P6B_COMPUTE
#undef BPM
}
#endif
__device__ __forceinline__ void p6b2(Frame& F) { F.fence_ids();
    const float* PD = (const float*)(F.ws + WS_PD); const float* GWp = (const float*)(F.ws + WS_GW); float* ACT = (float*)(F.ws + WS_ACT);
    for (size_t i4 = (size_t)F.bid * 512 + F.tid; i4 < (size_t)MT * 32; i4 += (size_t)F.G * 512) {
        f32x4 s = *(const f32x4*)(PD + i4 * 4);
#pragma unroll
        for (int jj = 1; jj < (MK_U4 ? 4 : 8); ++jj) s += *(const f32x4*)(PD + (size_t)jj * MT * 128 + i4 * 4);
        const f32x4 gw = *(const f32x4*)(GWp + i4 * 4);
        *(f32x4*)(ACT + i4 * 4) = (f32x4){gelu1(s[0]) * gw[0], gelu1(s[1]) * gw[1], gelu1(s[2]) * gw[2], gelu1(s[3]) * gw[3]};
    }
}
__device__ __forceinline__ void p6c(Frame& F) { F.fence_ids();
    const int j = F.bid & 7, nsb = F.G >> 3; if ((F.bid >> 3) >= nsb) return;
    const int wj = (F.bid >> 3) * NWAVES + F.wave, NW = nsb * NWAVES;
    const int lane = F.lane, g8 = lane >> 3, s8 = lane & 7;
    LAS float* Act = (LAS float*)(F.lds + F.wave * 8192); LAS unsigned* Eidl = (LAS unsigned*)(F.lds + F.wave * 8192 + 4096);
    const unsigned char* VE8 = F.ws + WS_VE8 + (size_t)j * 16384 * 128 + 16 * s8; const unsigned* EID = (const unsigned*)(F.ws + WS_EID); const float* ACT = (const float*)(F.ws + WS_ACT);
    float* PEERS = (float*)(F.ws + WS_PEERS) + (size_t)j * MT * 128;
    for (int tg = wj; tg < MT / 8; tg += NW) {
        const size_t t0 = (size_t)tg * 8;
#pragma unroll
        for (int q = 0; q < 4; ++q) { const int idx = 4 * (lane + 64 * q);
            *(LAS f32x4*)(Act + idx) = *(const f32x4*)(ACT + t0 * 128 + idx); *(LAS v4u*)(Eidl + idx) = *(const v4u*)(EID + t0 * 128 + idx); }
        LDS_WAIT(); asm volatile("" ::: "memory");
        f32x2c acc2[8];
#pragma unroll
        for (int e = 0; e < 8; ++e) acc2[e] = (f32x2c){0.f, 0.f};
        LAS const float* ap = Act + g8 * 128; LAS const unsigned* ep = Eidl + g8 * 128;
        v4u va[8], vb[8]; f32x4 aa[2], ab[2];
#define P6C_LOAD(V_, A_, base) do { A_[0] = *(LAS const f32x4*)(ap + (base)); A_[1] = *(LAS const f32x4*)(ap + (base) + 4); const v4u e0_ = *(LAS const v4u*)(ep + (base)), e1_ = *(LAS const v4u*)(ep + (base) + 4); \
            _Pragma("unroll") for (int k = 0; k < 4; ++k) { V_[k] = *(const v4u*)(VE8 + (size_t)e0_[k] * 128); V_[4 + k] = *(const v4u*)(VE8 + (size_t)e1_[k] * 128); } } while (0)
#define P6C_FMA(V_, A_) do { _Pragma("unroll") for (int k = 0; k < 8; ++k) { const float a_ = A_[k >> 2][k & 3]; const f32x2c a2_ = (f32x2c){a_, a_}; _Pragma("unroll") for (int w = 0; w < 4; ++w) { \
            const f32x2c lo_ = __builtin_amdgcn_cvt_pk_f32_fp8((int)V_[k][w], false), hi_ = __builtin_amdgcn_cvt_pk_f32_fp8((int)V_[k][w], true); \
            acc2[2 * w] = __builtin_elementwise_fma(a2_, lo_, acc2[2 * w]); acc2[2 * w + 1] = __builtin_elementwise_fma(a2_, hi_, acc2[2 * w + 1]); } } } while (0)
        P6C_LOAD(va, aa, 0);
        for (int it = 0; it < 128; it += 16) {
            P6C_LOAD(vb, ab, it + 8);
            P6C_FMA(va, aa);
            if (it + 16 < 128) P6C_LOAD(va, aa, it + 16);
            P6C_FMA(vb, ab);
        }
#undef P6C_LOAD
#undef P6C_FMA
        float acc[16];
#pragma unroll
        for (int e = 0; e < 8; ++e) { acc[2 * e] = acc2[e][0]; acc[2 * e + 1] = acc2[e][1]; }
        { float* op = PEERS + (t0 + g8) * 128 + 16 * s8;
#pragma unroll
            for (int q = 0; q < 4; ++q) *(f32x4*)(op + 4 * q) = (f32x4){acc[4 * q] * 0.0625f, acc[4 * q + 1] * 0.0625f, acc[4 * q + 2] * 0.0625f, acc[4 * q + 3] * 0.0625f}; }
        LDS_WAIT(); asm volatile("" ::: "memory");
    }
}
__device__ __forceinline__ void p6d(Frame& F) { F.fence_ids();
    const int gw = F.bid * NWAVES + F.wave, NGW = F.G * NWAVES; const float* PEERS = (const float*)(F.ws + WS_PEERS); const float* gate2 = (const float*)(F.ws + WS_MOD) + 5120;
    f32x4 fg[4];
#pragma unroll
    for (int q = 0; q < 4; ++q) fg[q] = *((const f32x4*)F.final_g + F.lane + 64 * q);
    f32x4 nx[4], np[4];
#define P6D_LOAD(tt) do { _Pragma("unroll") for (int q = 0; q < 4; ++q) { const int d = 4 * F.lane + 256 * q; nx[q] = *((const f32x4*)((const float*)F.dout + (size_t)(tt) * DM) + F.lane + 64 * q); \
        np[q] = *(const f32x4*)(PEERS + ((size_t)(d >> 7) * MT + (tt)) * 128 + (d & 127)); } } while (0)
    if (gw < MT) P6D_LOAD(gw);
    for (int t = gw; t < MT; t += NGW) {
        const int b = t >> 12;
        f32x4* xr = (f32x4*)((float*)F.dout + (size_t)t * DM) + F.lane; f32x4 o[4]; float ss = 0.f;
#pragma unroll
        for (int q = 0; q < 4; ++q) { const int d = 4 * F.lane + 256 * q; const f32x4 g2 = *(const f32x4*)(gate2 + (size_t)b * 6144 + d);
            o[q] = nx[q] + g2 * np[q]; ss += (o[q][0] * o[q][0] + o[q][1] * o[q][1]) + (o[q][2] * o[q][2] + o[q][3] * o[q][3]); }
        if (t + NGW < MT) P6D_LOAD(t + NGW);
        const float rstd = __builtin_amdgcn_rsqf(wave_sum(ss) * (1.f / DM) + EPSN);
#pragma unroll
        for (int q = 0; q < 4; ++q) xr[64 * q] = o[q] * rstd * fg[q];
    }
#undef P6D_LOAD
}

struct Args { const float* in[20]; float* out; unsigned char* ws; int ph_lo, ph_hi, li, pad; };
__global__ void __launch_bounds__(NWAVES * 64, 2) mk_fwd(Args args) {
    extern __shared__ __attribute__((aligned(16))) unsigned char lds_raw[];
    Frame F;
    F.lds = (LAS unsigned char*)lds_raw;
    F.tid = threadIdx.x; F.lane = F.tid & 63; F.wave = __builtin_amdgcn_readfirstlane(F.tid >> 6); F.G = gridDim.x; F.bid = blockIdx.x;
    F.x = args.in[0]; F.c = args.in[1]; F.w_ada = args.in[2]; F.b_ada = args.in[3]; F.norm1_g = args.in[4]; F.w_in = args.in[5]; F.ret_gn_g = args.in[6]; F.sgu_ln_g = args.in[7];
    F.sgu_ln_b = args.in[8]; F.sgu_w = args.in[9]; F.sgu_b = args.in[10]; F.w_ret_out = args.in[11]; F.w_sgu_out = args.in[12]; F.w_out = args.in[13]; F.norm2_g = args.in[14];
    F.peer_w_q = args.in[15]; F.peer_sub_keys = args.in[16]; F.peer_u = args.in[17]; F.peer_v = args.in[18]; F.final_g = args.in[19];
    F.ws = args.ws; F.dout = (unsigned char*)args.out;
    volatile LAS unsigned* MISC = (volatile LAS unsigned*)(F.lds + MISC_OFF); F.misc = MISC;
    if (F.tid < 64) MISC[F.tid] = 0u;
    __syncthreads();
    XcdBarrier bar; bar.bar = (unsigned*)(F.ws + WS_CTL) + CW_BAR; bar.x = 0; bar.st = nullptr;
    if (N_LAUNCHES == 1) bar = xcd_barrier_post((unsigned*)(F.ws + WS_CTL) + CW_BAR, MISC + 8);
    const int lo = args.ph_lo, hi = args.ph_hi;
#define IN(k) (lo <= (k) && (k) < hi)
#if MK_PROBE_HI > 0
#define STAMP(k) do { if (F.bid == 0 && F.wave == 0 && F.lane == 0) { const unsigned long long _t = __builtin_amdgcn_s_memrealtime(); MISC[16 + 2 * (k)] = (unsigned)_t; MISC[17 + 2 * (k)] = (unsigned)(_t >> 32); } } while (0)
#else
#define STAMP(k) do { } while (0)
#endif
#define SEAM(k) do { if (IN(k) && IN((k) + 1)) xcd_barrier(bar); } while (0)
    const float* mod = (const float*)(F.ws + WS_MOD);
    STAMP(0);
    if (IN(0)) { p0a(F); SEAM(0); }
    STAMP(1);
    if (IN(1)) { norm_rows<2>(F, F.x, F.norm1_g, mod + 0, mod + 1024, nullptr, F.dout + DO_H); SEAM(1); }
    STAMP(2);
    if (IN(2)) {
        pg8::Gemm g{(const bf16*)(F.dout + DO_H), (const bf16*)(F.ws + WS_WIN), MT, NIN, 512}; pg8::StaticOrder S; S.init(MT, NIN, F.G, F.bid);
        pg8::EpiProj E{(bf16*)(F.dout + DO_Q), (bf16*)(F.dout + DO_K), (bf16*)(F.ws + WS_V), (bf16*)(F.ws + WS_G), (bf16*)(F.ws + WS_U), (bf16*)(F.ws + WS_SV), (bf16*)(F.ws + WS_GA), (bf16*)(F.ws + WS_GB),
                       (const float*)(F.ws + WS_COS), (const float*)(F.ws + WS_SIN), 1.0f / 4096.0f, (float*)(F.ws + WS_SVSTAT)};
        pg8::gemm_phase<pg8::EpiProj, pg8::StaticOrder, true, true, true>(F.lds, g, S, E);
        SEAM(2);
    }
    STAMP(3);
    if (IN(3)) { p2a(F); SEAM(3); }
    STAMP(4);
    if (IN(4)) { p2b(F); SEAM(4); }
    STAMP(5);
    if (IN(5)) { p2c(F); SEAM(5); }
    STAMP(6);
    if (IN(6)) {
        pg8::StaticOrder S; S.init(MT, DM, F.G, F.bid);
        { pg8::Gemm g{(const bf16*)(F.ws + WS_YG8), (const bf16*)(F.ws + WS_WRET), MT, DM, 512}; pg8::EpiGate<false> E{(const bf16*)(F.ws + WS_GA), (bf16*)(F.ws + WS_G), nullptr, 1.0f / 2048.0f};
          pg8::gemm_phase<pg8::EpiGate<false>, pg8::StaticOrder, true, true, true>(F.lds, g, S, E); }
        { pg8::Gemm g{(const bf16*)(F.ws + WS_YS8), (const bf16*)(F.ws + WS_WSGU), MT, DM, 512}; pg8::EpiGate<true> E{(const bf16*)(F.ws + WS_GB), (bf16*)(F.ws + WS_G), F.ws + WS_MRG8, 1.0f / 4096.0f};
          pg8::gemm_phase<pg8::EpiGate<true>, pg8::StaticOrder, true, true, true>(F.lds, g, S, E); }
        SEAM(6);
    }
    STAMP(7);
    if (IN(7)) {
        pg8::Gemm g{(const bf16*)(F.ws + WS_MRG8), (const bf16*)(F.ws + WS_WOUT), MT, DM, 512}; pg8::StaticOrder S; S.init(MT, DM, F.G, F.bid);
        pg8::EpiX1 E{F.x, mod + 2048, (float*)F.dout, 1.0f / 4096.0f};
        pg8::gemm_phase<pg8::EpiX1, pg8::StaticOrder, true, true, true>(F.lds, g, S, E);
        SEAM(7);
    }
    STAMP(8);
    if (IN(8)) { norm_rows<1>(F, (const float*)F.dout, F.norm2_g, mod + 3072, mod + 4096, (bf16*)(F.ws + WS_SV), F.ws + WS_H2F8); SEAM(8); }
    STAMP(9);
    if (IN(9)) {
        pg8::Gemm g{(const bf16*)(F.ws + WS_SV), (const bf16*)(F.ws + WS_WQ), MT, 2048, DM}; pg8::StaticOrder S; S.init(MT, 2048, F.G, F.bid);
        pg8::EpiPlain E{(bf16*)(F.ws + WS_GA), 2048};
        pg8::gemm_phase<pg8::EpiPlain, pg8::StaticOrder, true, true>(F.lds, g, S, E);
        SEAM(9);
    }
    STAMP(10);
    if (IN(10)) { p5b(F); SEAM(10); }
    STAMP(11);
    if (IN(11)) { p6a(F); SEAM(11); }
    STAMP(12);
    if (IN(12)) { p6b(F); SEAM(12); }
    STAMP(13);
    if (IN(13)) { p6b2(F); SEAM(13); }
    STAMP(14);
    if (IN(14)) { p6c(F); SEAM(14); }
    STAMP(15);
    if (IN(15)) { p6d(F); }
    STAMP(16);
#if MK_PROBE_HI > 0
    __syncthreads();
    if (F.bid == 0 && F.tid == 0) { const unsigned long long t0 = ((unsigned long long)MISC[17 + 2 * MK_PROBE_LO] << 32) | MISC[16 + 2 * MK_PROBE_LO], t1 = ((unsigned long long)MISC[17 + 2 * MK_PROBE_HI] << 32) | MISC[16 + 2 * MK_PROBE_HI];
#if MK_GPROBE == 1
        ((float*)F.dout)[0] += (float)MISC[56] * 1e-3f; }
#elif MK_GPROBE == 2
        ((float*)F.dout)[0] += (float)MISC[57] * 1e-3f; }
#else
        ((float*)F.dout)[0] += (float)(t1 - t0) * 1e-3f; }
#endif
#endif
#undef IN
#undef SEAM
}

extern "C" void kernel_launch(void* const* d_in, const int* in_sizes, int n_in, void* d_out, int out_size, void* d_ws, size_t ws_size, hipStream_t stream) {
    static int grid = 0;
    if (grid == 0) {
        if (n_in != 20 || out_size != MT * DM || ws_size < WS_END) { fprintf(stderr, "kernel_launch: unexpected shapes (n_in %d, out %d, ws %zu); nothing launched\n", n_in, out_size, ws_size); grid = -1; return; }
        int dev = 0, cus = 0, per_cu = 0;
        if (hipGetDevice(&dev) != hipSuccess || hipDeviceGetAttribute(&cus, hipDeviceAttributeMultiprocessorCount, dev) != hipSuccess) { grid = -1; return; }
        if (hipFuncSetAttribute((const void*)mk_fwd, hipFuncAttributeMaxDynamicSharedMemorySize, LDS_BYTES) != hipSuccess) { fprintf(stderr, "kernel_launch: hipFuncSetAttribute failed\n"); grid = -1; return; }
        if (hipOccupancyMaxActiveBlocksPerMultiprocessor(&per_cu, (const void*)mk_fwd, NWAVES * 64, LDS_BYTES) != hipSuccess || per_cu < 1)
            fprintf(stderr, "kernel_launch: note: occupancy query reports %d workgroups per CU\n", per_cu);
        (void)hipGetLastError();
        grid = cus;
    }
    if (grid < 0) return;
    if (hipMemsetAsync((char*)d_ws + WS_CTL, 0, CTL_ZERO_BYTES, stream) != hipSuccess) { fprintf(stderr, "kernel_launch: memset failed\n"); return; }
    Args a{};
    for (int i = 0; i < 20; ++i) a.in[i] = (const float*)d_in[i];
    a.out = (float*)d_out; a.ws = (unsigned char*)d_ws;
    static_assert(N_LAUNCHES == 1 || N_LAUNCHES == N_PHASES, "N_LAUNCHES is 1 or N_PHASES");
    for (int li = 0; li < N_LAUNCHES && li < MK_MAXPH; ++li) {
        a.ph_lo = (N_LAUNCHES == 1) ? 0 : li; a.ph_hi = (N_LAUNCHES == 1) ? N_PHASES : li + 1; a.li = li;
        hipLaunchKernelGGL(mk_fwd, dim3(grid), dim3(NWAVES * 64), LDS_BYTES, stream, a);
        const hipError_t le = hipPeekAtLastError();
        if (le != hipSuccess) { fprintf(stderr, "kernel_launch: launch %d failed: %s\n", li, hipGetErrorName(le)); break; }
    }
}
```

```cpp
#include <hip/hip_runtime.h>
#include <cstdio>
#include <cstdint>

#ifndef MK_PROBE_LO
#define MK_PROBE_LO 0
#define MK_PROBE_HI 0
#endif
#ifndef MK_GPROBE
#define MK_GPROBE 0
#endif
#define MK_MISC_OFF (147456 - 256)
#ifndef MK_U4
#define MK_U4 1
#endif
#ifndef MK_ALAY
#define MK_ALAY 2
#endif
#ifndef MK_MAXPH
#define MK_MAXPH 16
#endif
#ifndef MK_N_LAUNCHES
#define MK_N_LAUNCHES 1
#endif
namespace pg8 {
#define PG8_LAS __attribute__((address_space(3)))
typedef unsigned short bf16_t;
typedef short bf16x8 __attribute__((ext_vector_type(8)));
typedef float f32x4 __attribute__((ext_vector_type(4)));
typedef unsigned u32x4 __attribute__((ext_vector_type(4)));
constexpr int BM = 256, BK = 64, HALF = 128, HTB = HALF * BK * 2  , STAGE_BYTES = 8 * HTB, NXCD = 8, WGM = 8;

__host__ __device__ __forceinline__ int lds_byte(int r, int c) { const int st = (r >> 4) * 2 + (c >> 5), rr = r & 15, cc = c & 31, ob = rr * 64 + cc * 2; return st * 1024 + (ob ^ (((ob >> 9) & 1) << 5)); }
__host__ __device__ __forceinline__ void stage_rc(int b, int& R, int& C) { const int st = b / 1024, sb = b % 1024, swz = sb ^ (((sb >> 9) & 1) << 5); R = (st >> 1) * 16 + swz / 64; C = (st & 1) * 32 + (swz % 64) / 2; }
__host__ __device__ __forceinline__ int perm32(int rho) { const int n = rho >> 4, i = rho & 15; return 8 * (i >> 2) + 4 * n + (i & 3); }

struct Unit { int pm, pn; };
struct Gemm { const bf16_t* A; const bf16_t* Bt; int M, N, K; int ld = 0; const bf16_t* A2 = nullptr; const bf16_t* Bt2 = nullptr; int ksplit = 0; };

struct StaticOrder {
    int nM, nN, nwg, G, c;
    __host__ __device__ void init(int M, int N, int G_, int c_) { nM = M / BM; nN = N / BM; nwg = nM * nN; G = G_; c = c_; }
    __host__ __device__ bool next(int i, Unit& u) const {
        const long L = (long)i * G + c; if (L >= nwg) return false;
        int wgid = (int)L; { const int q = nwg / NXCD, r = nwg % NXCD, xcd = wgid % NXCD, off = wgid / NXCD; wgid = (xcd < r ? xcd * (q + 1) : r * (q + 1) + (xcd - r) * q) + off; }
        const int nig = WGM * nN, gid = wgid / nig, fm = gid * WGM, gsz = (nM - fm) < WGM ? (nM - fm) : WGM;
        u.pm = fm + ((wgid % nig) % gsz); u.pn = (wgid % nig) / gsz; return true;
    }
    __device__ __forceinline__ void a_ready(const Unit&) const {}
    __device__ __forceinline__ void done(const Unit&) const {}
};

__device__ __forceinline__ unsigned cvt_pk_bf16(float lo, float hi) { unsigned r; asm volatile("v_cvt_pk_bf16_f32 %0, %1, %2" : "=v"(r) : "v"(lo), "v"(hi)); return r; }
typedef float f32x2 __attribute__((ext_vector_type(2)));
__device__ __forceinline__ f32x2 gelu_pk(f32x2 v) {
    const f32x2 av = __builtin_elementwise_abs(v), d = av * 0.2316418882f + 1.0f;
    f32x2 t; t.x = __builtin_amdgcn_rcpf(d.x); t.y = __builtin_amdgcn_rcpf(d.y);
    f32x2 q = t * 0.5307027145f + (-0.7265760135f); q = q * t + 0.7107068705f; q = q * t + (-0.142248368f); q = q * t + 0.127414796f; q = q * t;
    const f32x2 s = (v * v) * (-0.72134752044f);
    f32x2 e; e.x = __builtin_amdgcn_exp2f(s.x); e.y = __builtin_amdgcn_exp2f(s.y);
    const f32x2 m = v * (q * e), r = v - m;
    f32x2 o; o.x = v.x < 0.f ? m.x : r.x; o.y = v.y < 0.f ? m.y : r.y; return o;
}


typedef unsigned u32x2 __attribute__((ext_vector_type(2)));
__device__ __forceinline__ float bflo(unsigned w) { return __uint_as_float(w << 16); }
__device__ __forceinline__ float bfhi(unsigned w) { return __uint_as_float(w & 0xffff0000u); }
__device__ __forceinline__ float gelu1(float v) {
    const float av = __builtin_fabsf(v), t = __builtin_amdgcn_rcpf(av * 0.2316418882f + 1.0f);
    float q = t * 0.5307027145f + (-0.7265760135f); q = q * t + 0.7107068705f; q = q * t + (-0.142248368f); q = q * t + 0.127414796f; q = q * t;
    const float e = __builtin_amdgcn_exp2f((v * v) * (-0.72134752044f));
    const float m = v * (q * e);
    return v < 0.f ? m : v - m;
}
__device__ __forceinline__ float sigm1(float v) { return __builtin_amdgcn_rcpf(1.0f + __builtin_amdgcn_exp2f(v * (-1.44269504089f))); }
__device__ __forceinline__ float silu1(float v) { return v * sigm1(v); }

__device__ __forceinline__ unsigned bperm(int idx, unsigned v) { return (unsigned)__builtin_amdgcn_ds_bpermute(idx, (int)v); }
__device__ __forceinline__ float bpermf(int idx, float v) { return __int_as_float(__builtin_amdgcn_ds_bpermute(idx, __float_as_int(v))); }
__device__ __forceinline__ f32x4 bperm4(int idx, const f32x4& v) { return (f32x4){bpermf(idx, v[0]), bpermf(idx, v[1]), bpermf(idx, v[2]), bpermf(idx, v[3])}; }
__device__ __forceinline__ u32x4 bperm4u(int idx, const u32x4& v) { u32x4 r; r.x = bperm(idx, v.x); r.y = bperm(idx, v.y); r.z = bperm(idx, v.z); r.w = bperm(idx, v.w); return r; }
#define PG8_REMAP() const int lane_ = 16 * fq + fr, pidx = (16 * (lane_ & 3) + (lane_ >> 2)) * 4, fr2 = lane_ >> 2, fq2 = lane_ & 3

struct EpiProj {
    static constexpr bool PERM = true, AFTER_DRAIN = false, HAS_MID = false;
    bf16_t *Q, *Kb, *V, *G, *U, *SV, *GA, *GB; const float *cosT, *sinT; float osc; float* svstat;
    __device__ __forceinline__ void operator()(const f32x4 (&acc)[2][2][4][2], const Unit& u, int wr, int wc, int fr, int fq) const {
        PG8_REMAP();
        const int colt = u.pn * BM; const int row0 = u.pm * BM + wr * 64 + fr2;
        if (colt < 1024) {
            const bool isk = colt >= 512; bf16_t* base = isk ? Kb : Q; const int lc0 = (colt & 511) + wc * 32 + 8 * fq2; const float sc = (isk ? 0.08838834764831845f : 1.0f) * osc;
            const int fi = wc * 16 + 4 * fq2;
#pragma unroll
            for (int ai = 0; ai < 2; ++ai) {
                f32x4 csv[4], snv[4];
#pragma unroll
                for (int m = 0; m < 4; ++m) { const int s = (row0 + ai * HALF + m * 16) & 4095; csv[m] = *(const f32x4*)(cosT + s * 64 + fi) * sc; snv[m] = *(const f32x4*)(sinT + s * 64 + fi) * sc; }
#pragma unroll
                for (int m = 0; m < 4; ++m) { const int row = row0 + ai * HALF + m * 16; const f32x4 cs = csv[m], sn = snv[m];
#pragma unroll
                    for (int bj = 0; bj < 2; ++bj) { const f32x4 v0 = bperm4(pidx, acc[ai][bj][m][0]), v1 = bperm4(pidx, acc[ai][bj][m][1]);
                        u32x4 w;
                        w.x = cvt_pk_bf16(v0[0] * cs[0] - v0[1] * sn[0], v0[0] * sn[0] + v0[1] * cs[0]);
                        w.y = cvt_pk_bf16(v0[2] * cs[1] - v0[3] * sn[1], v0[2] * sn[1] + v0[3] * cs[1]);
                        w.z = cvt_pk_bf16(v1[0] * cs[2] - v1[1] * sn[2], v1[0] * sn[2] + v1[1] * cs[2]);
                        w.w = cvt_pk_bf16(v1[2] * cs[3] - v1[3] * sn[3], v1[2] * sn[3] + v1[3] * cs[3]);
                        *(u32x4*)(base + (size_t)row * 512 + lc0 + bj * HALF) = w; } } }
        } else {
            const int seg = (colt - 1024) >> 10;
            bf16_t* base = seg == 0 ? V : seg == 1 ? G : seg == 2 ? U : seg == 3 ? SV : seg == 4 ? GA : GB;
            const int lc0 = ((colt - 1024) & 1023) + wc * 32 + 8 * fq2;
#pragma unroll
            for (int ai = 0; ai < 2; ++ai)
#pragma unroll
                for (int m = 0; m < 4; ++m) { const int row = row0 + ai * HALF + m * 16; float s1[2] = {0.f, 0.f}, s2[2] = {0.f, 0.f};
#pragma unroll
                    for (int bj = 0; bj < 2; ++bj) { f32x4 v0 = acc[ai][bj][m][0] * osc, v1 = acc[ai][bj][m][1] * osc;
                        if (seg == 1) {
#pragma unroll
                            for (int e = 0; e < 4; ++e) { v0[e] = silu1(v0[e]); v1[e] = silu1(v1[e]); }
                        } else if (seg == 2 || seg == 3) {
                            f32x2 a = gelu_pk((f32x2){v0[0], v0[1]}), b = gelu_pk((f32x2){v0[2], v0[3]}), c = gelu_pk((f32x2){v1[0], v1[1]}), d = gelu_pk((f32x2){v1[2], v1[3]});
                            v0 = (f32x4){a.x, a.y, b.x, b.y}; v1 = (f32x4){c.x, c.y, d.x, d.y};
                        } else if (seg >= 4) {
#pragma unroll
                            for (int e = 0; e < 4; ++e) { v0[e] = sigm1(v0[e]); v1[e] = sigm1(v1[e]); }
                        }
                        if (seg == 3) { s1[bj] = ((v0[0] + v0[1]) + (v0[2] + v0[3])) + ((v1[0] + v1[1]) + (v1[2] + v1[3]));
                            s2[bj] = ((v0[0] * v0[0] + v0[1] * v0[1]) + (v0[2] * v0[2] + v0[3] * v0[3])) + ((v1[0] * v1[0] + v1[1] * v1[1]) + (v1[2] * v1[2] + v1[3] * v1[3])); }
                        u32x4 w; w.x = cvt_pk_bf16(v0[0], v0[1]); w.y = cvt_pk_bf16(v0[2], v0[3]); w.z = cvt_pk_bf16(v1[0], v1[1]); w.w = cvt_pk_bf16(v1[2], v1[3]);
                        *(u32x4*)(base + (size_t)row * 1024 + lc0 + bj * HALF) = bperm4u(pidx, w); }
                    if (seg == 3) {
                        float a = s1[0] + s1[1], b = s2[0] + s2[1];
                        a += __shfl_xor(a, 16); b += __shfl_xor(b, 16); a += __shfl_xor(a, 32); b += __shfl_xor(b, 32);
                        if (fq == 0) { float* sp = svstat + (size_t)(u.pm * BM + wr * 64 + fr + ai * HALF + m * 16) * 2; atomicAdd(sp, a); atomicAdd(sp + 1, b); } } }
        }
    }
};
template <bool ACCUM> struct EpiGate {
    static constexpr bool PERM = true, AFTER_DRAIN = false, HAS_MID = false;
    const bf16_t* GT; bf16_t* TMP; unsigned char* OUT8; float osc;
    __device__ __forceinline__ void operator()(const f32x4 (&acc)[2][2][4][2], const Unit& u, int wr, int wc, int fr, int fq) const {
        PG8_REMAP();
        const int row0 = u.pm * BM + wr * 64 + fr2, col0 = u.pn * BM + wc * 32 + 8 * fq2;
#pragma unroll
        for (int ai = 0; ai < 2; ++ai)
#pragma unroll
            for (int mp = 0; mp < 2; ++mp) {
                u32x4 gv[2][2], pv[2][2];
#pragma unroll
                for (int mm = 0; mm < 2; ++mm)
#pragma unroll
                    for (int bj = 0; bj < 2; ++bj) { const size_t off = (size_t)(row0 + ai * HALF + (2 * mp + mm) * 16) * 1024 + col0 + bj * HALF;
                        gv[mm][bj] = *(const u32x4*)(GT + off); if (ACCUM) pv[mm][bj] = *(const u32x4*)(TMP + off); }
#pragma unroll
                for (int mm = 0; mm < 2; ++mm)
#pragma unroll
                    for (int bj = 0; bj < 2; ++bj) { const int m = 2 * mp + mm; const size_t off = (size_t)(row0 + ai * HALF + m * 16) * 1024 + col0 + bj * HALF;
                        const f32x4 v0 = bperm4(pidx, acc[ai][bj][m][0]) * osc, v1 = bperm4(pidx, acc[ai][bj][m][1]) * osc; const u32x4 g = gv[mm][bj];
                        float o[8] = {v0[0] * bflo(g.x), v0[1] * bfhi(g.x), v0[2] * bflo(g.y), v0[3] * bfhi(g.y), v1[0] * bflo(g.z), v1[1] * bfhi(g.z), v1[2] * bflo(g.w), v1[3] * bfhi(g.w)};
                        if (ACCUM) { const u32x4 p = pv[mm][bj];
                            o[0] += bflo(p.x); o[1] += bfhi(p.x); o[2] += bflo(p.y); o[3] += bfhi(p.y); o[4] += bflo(p.z); o[5] += bfhi(p.z); o[6] += bflo(p.w); o[7] += bfhi(p.w);
                            u32x2 w8; int t0 = __builtin_amdgcn_cvt_pk_fp8_f32(o[0] * 8.f, o[1] * 8.f, 0, false); t0 = __builtin_amdgcn_cvt_pk_fp8_f32(o[2] * 8.f, o[3] * 8.f, t0, true);
                            int t1 = __builtin_amdgcn_cvt_pk_fp8_f32(o[4] * 8.f, o[5] * 8.f, 0, false); t1 = __builtin_amdgcn_cvt_pk_fp8_f32(o[6] * 8.f, o[7] * 8.f, t1, true);
                            w8.x = (unsigned)t0; w8.y = (unsigned)t1; *(u32x2*)(OUT8 + off) = w8;
                        } else {
                            u32x4 w; w.x = cvt_pk_bf16(o[0], o[1]); w.y = cvt_pk_bf16(o[2], o[3]); w.z = cvt_pk_bf16(o[4], o[5]); w.w = cvt_pk_bf16(o[6], o[7]);
                            *(u32x4*)(TMP + off) = w; } }
            }
    }
};
struct EpiMerged {
    static constexpr bool PERM = true, AFTER_DRAIN = false, HAS_MID = true;
    const bf16_t* GA; const bf16_t* GB; unsigned char* OUT8; float osc;
    __device__ __forceinline__ void mid(f32x4 (&acc)[2][2][4][2], const Unit& u, int wr, int wc, int fr, int fq) const {
        int fr_ = fr, fq_ = fq; asm volatile("" : "+v"(fr_), "+v"(fq_));
        const int row0 = u.pm * BM + wr * 64 + fr_, col0 = u.pn * BM + wc * 32 + 8 * fq_;
#pragma unroll
        for (int ai = 0; ai < 2; ++ai)
#pragma unroll
            for (int mp = 0; mp < 2; ++mp) {
                u32x4 av[2][2], bv[2][2];
#pragma unroll
                for (int mm = 0; mm < 2; ++mm)
#pragma unroll
                    for (int bj = 0; bj < 2; ++bj) { const size_t off = (size_t)(row0 + ai * HALF + (2 * mp + mm) * 16) * 1024 + col0 + bj * HALF; av[mm][bj] = *(const u32x4*)(GA + off); bv[mm][bj] = *(const u32x4*)(GB + off); }
#pragma unroll
                for (int mm = 0; mm < 2; ++mm)
#pragma unroll
                    for (int bj = 0; bj < 2; ++bj) { const int m = 2 * mp + mm; const u32x4 a = av[mm][bj], b = bv[mm][bj];
                        acc[ai][bj][m][0][0] *= 2.f * bflo(a.x) * __builtin_amdgcn_rcpf(bflo(b.x)); acc[ai][bj][m][0][1] *= 2.f * bfhi(a.x) * __builtin_amdgcn_rcpf(bfhi(b.x));
                        acc[ai][bj][m][0][2] *= 2.f * bflo(a.y) * __builtin_amdgcn_rcpf(bflo(b.y)); acc[ai][bj][m][0][3] *= 2.f * bfhi(a.y) * __builtin_amdgcn_rcpf(bfhi(b.y));
                        acc[ai][bj][m][1][0] *= 2.f * bflo(a.z) * __builtin_amdgcn_rcpf(bflo(b.z)); acc[ai][bj][m][1][1] *= 2.f * bfhi(a.z) * __builtin_amdgcn_rcpf(bfhi(b.z));
                        acc[ai][bj][m][1][2] *= 2.f * bflo(a.w) * __builtin_amdgcn_rcpf(bflo(b.w)); acc[ai][bj][m][1][3] *= 2.f * bfhi(a.w) * __builtin_amdgcn_rcpf(bfhi(b.w)); }
            }
    }
    __device__ __forceinline__ void operator()(const f32x4 (&acc)[2][2][4][2], const Unit& u, int wr, int wc, int fr, int fq) const {
        PG8_REMAP();
        const int row0 = u.pm * BM + wr * 64 + fr2, col0 = u.pn * BM + wc * 32 + 8 * fq2; const float sc = osc * 8.f;
#pragma unroll
        for (int ai = 0; ai < 2; ++ai)
#pragma unroll
            for (int mp = 0; mp < 2; ++mp) {
                u32x4 gv[2][2];
#pragma unroll
                for (int mm = 0; mm < 2; ++mm)
#pragma unroll
                    for (int bj = 0; bj < 2; ++bj) gv[mm][bj] = *(const u32x4*)(GB + (size_t)(row0 + ai * HALF + (2 * mp + mm) * 16) * 1024 + col0 + bj * HALF);
#pragma unroll
                for (int mm = 0; mm < 2; ++mm)
#pragma unroll
                    for (int bj = 0; bj < 2; ++bj) { const int m = 2 * mp + mm; const size_t off = (size_t)(row0 + ai * HALF + m * 16) * 1024 + col0 + bj * HALF;
                        const f32x4 v0 = bperm4(pidx, acc[ai][bj][m][0]) * sc, v1 = bperm4(pidx, acc[ai][bj][m][1]) * sc; const u32x4 g = gv[mm][bj];
                        u32x2 w8; int t0 = __builtin_amdgcn_cvt_pk_fp8_f32(v0[0] * bflo(g.x), v0[1] * bfhi(g.x), 0, false); t0 = __builtin_amdgcn_cvt_pk_fp8_f32(v0[2] * bflo(g.y), v0[3] * bfhi(g.y), t0, true);
                        int t1 = __builtin_amdgcn_cvt_pk_fp8_f32(v1[0] * bflo(g.z), v1[1] * bfhi(g.z), 0, false); t1 = __builtin_amdgcn_cvt_pk_fp8_f32(v1[2] * bflo(g.w), v1[3] * bfhi(g.w), t1, true);
                        w8.x = (unsigned)t0; w8.y = (unsigned)t1; *(u32x2*)(OUT8 + off) = w8; }
            }
    }
};
struct EpiX1 {
    static constexpr bool PERM = false, AFTER_DRAIN = false, HAS_MID = false;
    const float* X; const float* gate1; float* X1; float osc;
    __device__ __forceinline__ void operator()(const f32x4 (&acc)[2][2][4][2], const Unit& u, int wr, int wc, int fr, int fq) const {
        PG8_REMAP();
        const int row0 = u.pm * BM + wr * 64 + fr2, col0 = u.pn * BM + wc * 32 + 4 * fq2;
        const float* gp = gate1 + (size_t)((u.pm * BM) >> 12) * 6144 + col0;
        f32x4 gv[2][2];
#pragma unroll
        for (int bj = 0; bj < 2; ++bj)
#pragma unroll
            for (int n = 0; n < 2; ++n) gv[bj][n] = *(const f32x4*)(gp + bj * HALF + n * 16) * osc;
#pragma unroll
        for (int ai = 0; ai < 2; ++ai)
#pragma unroll
            for (int mp = 0; mp < 2; ++mp) {
                f32x4 xv[2][2][2];
#pragma unroll
                for (int mm = 0; mm < 2; ++mm) { const size_t off = (size_t)(row0 + ai * HALF + (2 * mp + mm) * 16) * 1024 + col0;
#pragma unroll
                    for (int bj = 0; bj < 2; ++bj)
#pragma unroll
                        for (int n = 0; n < 2; ++n) xv[mm][bj][n] = *(const f32x4*)(X + off + bj * HALF + n * 16); }
#pragma unroll
                for (int mm = 0; mm < 2; ++mm) { const int m = 2 * mp + mm; const size_t off = (size_t)(row0 + ai * HALF + m * 16) * 1024 + col0;
#pragma unroll
                    for (int bj = 0; bj < 2; ++bj)
#pragma unroll
                        for (int n = 0; n < 2; ++n) *(f32x4*)(X1 + off + bj * HALF + n * 16) = xv[mm][bj][n] + gv[bj][n] * bperm4(pidx, acc[ai][bj][m][n]); }
            }
    }
};
struct EpiPlain {
    static constexpr bool PERM = true, AFTER_DRAIN = false, HAS_MID = false;
    bf16_t* O; int ldc;
    __device__ __forceinline__ void operator()(const f32x4 (&acc)[2][2][4][2], const Unit& u, int wr, int wc, int fr, int fq) const {
        PG8_REMAP();
        const int row0 = u.pm * BM + wr * 64 + fr2, col0 = u.pn * BM + wc * 32 + 8 * fq2;
#pragma unroll
        for (int ai = 0; ai < 2; ++ai)
#pragma unroll
            for (int m = 0; m < 4; ++m) { bf16_t* rowp = O + (size_t)(row0 + ai * HALF + m * 16) * ldc + col0;
#pragma unroll
                for (int bj = 0; bj < 2; ++bj) { const f32x4 v0 = acc[ai][bj][m][0], v1 = acc[ai][bj][m][1];
                    u32x4 w; w.x = cvt_pk_bf16(v0[0], v0[1]); w.y = cvt_pk_bf16(v0[2], v0[3]); w.z = cvt_pk_bf16(v1[0], v1[1]); w.w = cvt_pk_bf16(v1[2], v1[3]);
                    *(u32x4*)(rowp + bj * HALF) = bperm4u(pidx, w); } }
    }
};
typedef int v8i_t __attribute__((ext_vector_type(8)));
typedef int v4i_t __attribute__((ext_vector_type(4)));
template <bool F8> __device__ __forceinline__ void mma_block(f32x4 (&acc)[4][2], const bf16x8 (&At)[4][2], const bf16x8 (&Bt)[2][2]) {
    if constexpr (F8) {
        v8i_t bb[2];
#pragma unroll
        for (int n = 0; n < 2; ++n) bb[n] = __builtin_shufflevector(__builtin_bit_cast(v4i_t, Bt[n][0]), __builtin_bit_cast(v4i_t, Bt[n][1]), 0, 1, 2, 3, 4, 5, 6, 7);
#pragma unroll
        for (int m = 0; m < 4; ++m) { const v8i_t aa = __builtin_shufflevector(__builtin_bit_cast(v4i_t, At[m][0]), __builtin_bit_cast(v4i_t, At[m][1]), 0, 1, 2, 3, 4, 5, 6, 7);
#pragma unroll
            for (int n = 0; n < 2; ++n) asm volatile("v_mfma_scale_f32_16x16x128_f8f6f4 %0, %1, %2, %0, %3, %3 op_sel_hi:[0,0,0]" : "+v"(acc[m][n]) : "v"(bb[n]), "v"(aa), "v"(0x7F7F7F7F)); }
    } else {
#pragma unroll
        for (int m = 0; m < 4; ++m)
#pragma unroll
            for (int n = 0; n < 2; ++n)
#pragma unroll
                for (int k = 0; k < 2; ++k) acc[m][n] = __builtin_amdgcn_mfma_f32_16x16x32_bf16(Bt[n][k], At[m][k], acc[m][n], 0, 0, 0);
    }
}
template <class Epi, class Sched, bool ALIGN_EPI = false, bool SP2 = false, bool F8 = false>
__device__ __forceinline__ void gemm_phase(PG8_LAS unsigned char* lds, const Gemm g, const Sched& S, const Epi& E) {
    const int tid = threadIdx.x, wid = __builtin_amdgcn_readfirstlane(tid >> 6), lane = tid & 63, wr = wid >> 2, wc = wid & 3, fr = lane & 15, fq = lane >> 4;
    const int K = g.K, nt = K / BK, LD = g.ld ? g.ld : g.K, nh = g.ksplit ? g.ksplit : nt;
    unsigned voffA[2], voffB[2];
#pragma unroll
    for (int i = 0; i < 2; ++i) { int R, C; stage_rc(tid * 16 + i * 8192, R, C); const int Rb = Epi::PERM ? ((R & ~31) + perm32(R & 31)) : R;
        voffA[i] = (unsigned)(R * LD + C) * 2u; voffB[i] = (unsigned)(Rb * LD + C) * 2u; }
    const size_t kstep = (size_t)(BK * 2);
    const size_t hstep = (size_t)HALF * LD * 2;
    const size_t tstep = 2 * hstep;
    const unsigned ldsw = (unsigned)wid * 1024u;
    const int aoff = lds_byte(wr * 64 + fr, fq * 8), boff = lds_byte(wc * 32 + fr, fq * 8);
#define PG8_SA(b, h) (((b) * 2 + (h)) * HTB)
#define PG8_SB(b, h) ((4 + (b) * 2 + (h)) * HTB)
#define PG8_STAGE(bufoff, gbase, voff) do { _Pragma("unroll") for (int _i = 0; _i < 2; ++_i) \
        __builtin_amdgcn_global_load_lds((const unsigned*)((const char*)(gbase) + (voff)[_i]), (PG8_LAS unsigned*)(lds + (bufoff) + ldsw + _i * 8192), 16, 0, 0); } while (0)
#define PG8_LDA(dst, b, h) do { _Pragma("unroll") for (int m = 0; m < 4; ++m) _Pragma("unroll") for (int k = 0; k < 2; ++k) dst[m][k] = *(const PG8_LAS bf16x8*)(lds + PG8_SA(b, h) + aoff + m * 2048 + k * 1024); } while (0)
#define PG8_LDB(dst, b, h) do { _Pragma("unroll") for (int n = 0; n < 2; ++n) _Pragma("unroll") for (int k = 0; k < 2; ++k) dst[n][k] = *(const PG8_LAS bf16x8*)(lds + PG8_SB(b, h) + boff + n * 2048 + k * 1024); } while (0)
#define PG8_MMA(ai, bj, At, Bt) do { __builtin_amdgcn_s_setprio(1); mma_block<F8>(acc[ai][bj], At, Bt); __builtin_amdgcn_s_setprio(0); } while (0)
#define PG8_WAIT_V(n) asm volatile("s_waitcnt vmcnt(" #n ")" ::: "memory")
#define PG8_WAIT_L(n) asm volatile("s_waitcnt lgkmcnt(" #n ")" ::: "memory")
#define PG8_BAR __builtin_amdgcn_s_barrier()
#define PG8_SCHED __builtin_amdgcn_sched_barrier(0)
    Unit cur, nxt; int ui = 0;
#if MK_GPROBE
    unsigned long long gp_k = 0, gp_e = 0, gp_t = __builtin_amdgcn_s_memrealtime();
#endif
    if (!S.next(0, cur)) return;
    f32x4 acc[2][2][4][2];
#pragma unroll
    for (int a = 0; a < 2; ++a)
#pragma unroll
        for (int b = 0; b < 2; ++b)
#pragma unroll
            for (int m = 0; m < 4; ++m)
#pragma unroll
                for (int n = 0; n < 2; ++n) acc[a][b][m][n] = (f32x4){0.f, 0.f, 0.f, 0.f};
    bf16x8 At[4][2], B0[2][2], B1[2][2];
    const char* cA = (const char*)g.A + (size_t)cur.pm * tstep; const char* cB = (const char*)g.Bt + (size_t)cur.pn * tstep;
    const char* cA2 = g.A2 ? (const char*)g.A2 + (size_t)cur.pm * tstep : cA; const char* cB2 = g.Bt2 ? (const char*)g.Bt2 + (size_t)cur.pn * tstep : cB;
#define PG8_TA(tt) ((tt) < nh ? cA + (size_t)(tt) * kstep : cA2 + (size_t)((tt) - nh) * kstep)
#define PG8_TB(tt) ((tt) < nh ? cB + (size_t)(tt) * kstep : cB2 + (size_t)((tt) - nh) * kstep)
    S.a_ready(cur);
    if constexpr (SP2) {
        PG8_STAGE(PG8_SB(0, 0), cB, voffB); PG8_STAGE(PG8_SB(0, 1), cB + hstep, voffB); PG8_STAGE(PG8_SA(0, 0), cA, voffA); PG8_STAGE(PG8_SA(0, 1), cA + hstep, voffA);
        if (wr == 1) PG8_BAR;
        PG8_WAIT_V(2); PG8_BAR;
        PG8_STAGE(PG8_SB(1, 0), cB + kstep, voffB); PG8_STAGE(PG8_SA(1, 0), cA + kstep, voffA); PG8_STAGE(PG8_SB(1, 1), cB + hstep + kstep, voffB);
        PG8_WAIT_V(6); PG8_BAR;
    } else {
        PG8_STAGE(PG8_SB(0, 0), cB, voffB); PG8_STAGE(PG8_SA(0, 0), cA, voffA); PG8_STAGE(PG8_SB(0, 1), cB + hstep, voffB); PG8_STAGE(PG8_SA(0, 1), cA + hstep, voffA);
        if (wr == 1) PG8_BAR;
        PG8_WAIT_V(4); PG8_BAR;
        PG8_STAGE(PG8_SB(1, 0), cB + kstep, voffB); PG8_STAGE(PG8_SA(1, 0), cA + kstep, voffA); PG8_STAGE(PG8_SB(1, 1), cB + hstep + kstep, voffB);
        PG8_WAIT_V(6); PG8_BAR;
    }
    for (;;) {
        const bool has_next = S.next(ui + 1, nxt);
        const char* nA = has_next ? (const char*)g.A + (size_t)nxt.pm * tstep : cA; const char* nB = has_next ? (const char*)g.Bt + (size_t)nxt.pn * tstep : cB;
#pragma clang loop unroll(disable)
        for (int t = 0; t < nt; t += 2) {
            const bool last = (t == nt - 2);
            const char* a1 = PG8_TA(t + 1);
            const char* a2 = last ? nA : PG8_TA(t + 2); const char* b2 = last ? nB : PG8_TB(t + 2);
            const char* a3 = last ? nA + kstep : PG8_TA(t + 3); const char* b3 = last ? nB + kstep : PG8_TB(t + 3);
            if constexpr (Epi::HAS_MID) { if (t == nh) { if constexpr (F8) asm volatile("s_nop 15\n\ts_nop 15" ::: "memory"); E.mid(acc, cur, wr, wc, fr, fq); } }
            if (last && has_next) S.a_ready(nxt);
            if constexpr (SP2) {
            PG8_LDB(B0, 0, 0); PG8_LDB(B1, 0, 1); PG8_SCHED; PG8_LDA(At, 0, 0); PG8_STAGE(PG8_SA(1, 1), a1 + hstep, voffA);
            PG8_WAIT_V(8); PG8_WAIT_L(0); PG8_BAR; PG8_MMA(0, 0, At, B0); PG8_MMA(0, 1, At, B1); PG8_BAR; PG8_SCHED;
            PG8_LDA(At, 0, 1); PG8_STAGE(PG8_SB(0, 0), b2, voffB); PG8_STAGE(PG8_SB(0, 1), b2 + hstep, voffB); PG8_STAGE(PG8_SA(0, 0), a2, voffA);
            PG8_WAIT_V(8); PG8_WAIT_L(0); PG8_BAR; PG8_MMA(1, 0, At, B0); PG8_MMA(1, 1, At, B1); PG8_BAR; PG8_SCHED;
            PG8_LDB(B0, 1, 0); PG8_LDB(B1, 1, 1); PG8_SCHED; PG8_LDA(At, 1, 0); PG8_STAGE(PG8_SA(0, 1), a2 + hstep, voffA);
            PG8_WAIT_V(8); PG8_WAIT_L(0); PG8_BAR; PG8_MMA(0, 0, At, B0); PG8_MMA(0, 1, At, B1); PG8_BAR; PG8_SCHED;
            PG8_LDA(At, 1, 1); PG8_STAGE(PG8_SB(1, 0), b3, voffB); PG8_STAGE(PG8_SB(1, 1), b3 + hstep, voffB); PG8_STAGE(PG8_SA(1, 0), a3, voffA);
            PG8_WAIT_V(8); PG8_WAIT_L(0); PG8_BAR; PG8_MMA(1, 0, At, B0); PG8_MMA(1, 1, At, B1); PG8_BAR; PG8_SCHED;
            } else {
            PG8_LDB(B0, 0, 0); PG8_SCHED; PG8_LDA(At, 0, 0); PG8_STAGE(PG8_SA(1, 1), a1 + hstep, voffA);
            PG8_WAIT_L(8); PG8_BAR; PG8_WAIT_L(0); PG8_MMA(0, 0, At, B0); PG8_BAR; PG8_SCHED;
            PG8_LDB(B1, 0, 1); PG8_STAGE(PG8_SB(0, 0), b2, voffB);
            PG8_BAR; PG8_WAIT_L(0); PG8_MMA(0, 1, At, B1); PG8_BAR;
            PG8_LDA(At, 0, 1); PG8_STAGE(PG8_SA(0, 0), a2, voffA);
            PG8_BAR; PG8_WAIT_L(0); PG8_MMA(1, 0, At, B0); PG8_BAR; PG8_SCHED;
            PG8_STAGE(PG8_SB(0, 1), b2 + hstep, voffB);
            PG8_WAIT_V(6); PG8_BAR; PG8_MMA(1, 1, At, B1); PG8_BAR;
            PG8_LDB(B0, 1, 0); PG8_SCHED; PG8_LDA(At, 1, 0); PG8_STAGE(PG8_SA(0, 1), a2 + hstep, voffA);
            PG8_WAIT_L(8); PG8_BAR; PG8_WAIT_L(0); PG8_MMA(0, 0, At, B0); PG8_BAR; PG8_SCHED;
            PG8_LDB(B1, 1, 1); PG8_STAGE(PG8_SB(1, 0), b3, voffB);
            PG8_BAR; PG8_WAIT_L(0); PG8_MMA(0, 1, At, B1); PG8_BAR;
            PG8_LDA(At, 1, 1); PG8_STAGE(PG8_SA(1, 0), a3, voffA);
            PG8_BAR; PG8_WAIT_L(0); PG8_MMA(1, 0, At, B0); PG8_BAR; PG8_SCHED;
            PG8_STAGE(PG8_SB(1, 1), b3 + hstep, voffB);
            PG8_WAIT_V(6); PG8_BAR; PG8_MMA(1, 1, At, B1); PG8_BAR;
            }
        }
#if MK_GPROBE
        { const unsigned long long t_ = __builtin_amdgcn_s_memrealtime(); gp_k += t_ - gp_t; gp_t = t_; }
#endif
        if constexpr (F8) asm volatile("s_nop 15\n\ts_nop 15" ::: "memory");
        if constexpr (ALIGN_EPI) { if (wr == 0) PG8_BAR; }
        if constexpr (!Epi::AFTER_DRAIN) { E(acc, cur, wr, wc, fr, fq); S.done(cur); }
#if MK_GPROBE
        { asm volatile("s_waitcnt vmcnt(0)" ::: "memory"); const unsigned long long t_ = __builtin_amdgcn_s_memrealtime(); gp_e += t_ - gp_t; gp_t = t_; }
#endif
        if (!has_next) break;
#pragma unroll
        for (int a = 0; a < 2; ++a)
#pragma unroll
            for (int b = 0; b < 2; ++b)
#pragma unroll
                for (int m = 0; m < 4; ++m)
#pragma unroll
                    for (int n = 0; n < 2; ++n) acc[a][b][m][n] = (f32x4){0.f, 0.f, 0.f, 0.f};
        cur = nxt; cA = nA; cB = nB; ++ui;
        cA2 = g.A2 ? (const char*)g.A2 + (size_t)cur.pm * tstep : cA; cB2 = g.Bt2 ? (const char*)g.Bt2 + (size_t)cur.pn * tstep : cB;
        if constexpr (ALIGN_EPI) { if (wr == 1) PG8_BAR; }
    }
    PG8_WAIT_V(0);
    if constexpr (!ALIGN_EPI) { if (wr == 0) PG8_BAR; }
    PG8_BAR;
    if constexpr (Epi::AFTER_DRAIN) { E.fused(acc, cur, wr, wc, fr, fq, lds, wid, lane); S.done(cur); }
#if MK_GPROBE
    if (blockIdx.x == 0 && wid == 0 && lane == 0) { PG8_LAS unsigned* mq = (PG8_LAS unsigned*)(lds + MK_MISC_OFF); mq[56] += (unsigned)gp_k; mq[57] += (unsigned)gp_e; }
#endif
#undef PG8_SA
#undef PG8_SB
#undef PG8_TA
#undef PG8_TB
#undef PG8_STAGE
#undef PG8_LDA
#undef PG8_LDB
#undef PG8_MMA
#undef PG8_WAIT_V
#undef PG8_WAIT_L
#undef PG8_BAR
#undef PG8_SCHED
}
}

constexpr int NWAVES = 8;
constexpr int N_LAUNCHES = MK_N_LAUNCHES;
constexpr int N_PHASES = 16;
constexpr int NB = 8, SEQ = 4096, DM = 1024, MT = NB * SEQ, NIN = 7168;
constexpr float EPSN = 1e-6f;

constexpr size_t MiB = 1u << 20;
constexpr size_t WS_CTL = 0, CTL_ZERO_BYTES = 1 * MiB;
constexpr size_t WS_SVSTAT = 512 * 1024;
constexpr size_t WS_MOD = 1 * MiB;
constexpr size_t WS_COS = 2 * MiB, WS_SIN = 3 * MiB;
constexpr size_t WS_SK = 4 * MiB;
constexpr size_t WS_SGUW = 4 * MiB + 512 * 1024;
constexpr size_t WS_WRET = 6 * MiB, WS_WSGU = 8 * MiB, WS_WOUT = 10 * MiB, WS_WQ = 12 * MiB, WS_WIN = 16 * MiB;
constexpr size_t WS_UE8 = 32 * MiB, WS_VE8 = 48 * MiB;
constexpr size_t WS_YG8 = 288 * MiB;
constexpr size_t WS_YS8 = 480 * MiB;
constexpr size_t WS_MRG8 = 96 * MiB;
constexpr size_t WS_ACT = 288 * MiB;
constexpr size_t WS_PEERS = 352 * MiB;
constexpr size_t WS_H2F8 = 96 * MiB;
constexpr size_t WS_EID = 128 * MiB, WS_GW = 144 * MiB;
constexpr size_t WS_PD = 160 * MiB;
constexpr size_t WS_V = 96 * MiB;
constexpr size_t WS_G = 160 * MiB;
constexpr size_t WS_U = 224 * MiB;
constexpr size_t WS_SV = 288 * MiB;
constexpr size_t WS_GA = 352 * MiB, WS_GB = 416 * MiB;
constexpr size_t WS_SUB = 480 * MiB;
constexpr size_t WS_END = 512 * MiB;
constexpr size_t DO_H = 0, DO_Q = 64 * MiB, DO_K = 96 * MiB, DO_KVS = 0;

constexpr int CW_BAR = 4096;
constexpr int LDS_BYTES = 147456;
constexpr int MISC_OFF = LDS_BYTES - 256;

#define GAS __attribute__((address_space(1)))
#define LAS __attribute__((address_space(3)))
typedef unsigned short bf16;
typedef unsigned v4u __attribute__((ext_vector_type(4)));
typedef unsigned v2u __attribute__((ext_vector_type(2)));
typedef float f32x4 __attribute__((ext_vector_type(4)));
typedef float f32x2v __attribute__((ext_vector_type(2)));
typedef short bf16x8 __attribute__((ext_vector_type(8)));
typedef short s16x4 __attribute__((ext_vector_type(4)));
typedef __bf16 bf16x2_t __attribute__((ext_vector_type(2)));
typedef GAS unsigned gu32;
#define RLX_AGENT __ATOMIC_RELAXED, __HIP_MEMORY_SCOPE_AGENT
#define LDS_WAIT() asm volatile("s_waitcnt lgkmcnt(0)" ::: "memory")
using pg8::bflo; using pg8::bfhi; using pg8::gelu1;
__device__ __forceinline__ unsigned pk2(float lo, float hi) { f32x2v v = {lo, hi}; bf16x2_t b = __builtin_convertvector(v, bf16x2_t); return __builtin_bit_cast(unsigned, b); }
template <int CTRL> __device__ __forceinline__ float dpp_f(float v) { return __int_as_float(__builtin_amdgcn_update_dpp(0, __float_as_int(v), CTRL, 0xF, 0xF, false)); }
__device__ __forceinline__ float wave_sum(float v) {
    v += dpp_f<0xB1>(v); v += dpp_f<0x4E>(v); v += dpp_f<0x141>(v); v += dpp_f<0x140>(v);
    const int vi = __float_as_int(v);
    return (__int_as_float(__builtin_amdgcn_readlane(vi, 0)) + __int_as_float(__builtin_amdgcn_readlane(vi, 16))) + (__int_as_float(__builtin_amdgcn_readlane(vi, 32)) + __int_as_float(__builtin_amdgcn_readlane(vi, 48)));
}
__device__ __forceinline__ float fexp2(float x) { return __builtin_amdgcn_exp2f(x); }
__device__ __forceinline__ float clamp_f8(float x) { return __builtin_amdgcn_fmed3f(x, -448.0f, 448.0f); }
__device__ __forceinline__ unsigned pk4_fp8(float a, float b, float c, float d) { int w = __builtin_amdgcn_cvt_pk_fp8_f32(clamp_f8(a), clamp_f8(b), 0, false); w = __builtin_amdgcn_cvt_pk_fp8_f32(clamp_f8(c), clamp_f8(d), w, true); return (unsigned)w; }
__device__ __forceinline__ float rl_f(float v, int l) { return __int_as_float(__builtin_amdgcn_readlane(__float_as_int(v), l)); }
__device__ __forceinline__ unsigned rl_u(unsigned v, int l) { return (unsigned)__builtin_amdgcn_readlane((int)v, l); }

#define XB_TMO      128
#define XB_XCNT(j)  (256  + 64 * (j))
#define XB_XSUB(j)  (1280 + 64 * (j))
#define XB_XGEN(j)  (2304 + 64 * (j))
#define XB_TOP      3328
#define XB_TOPGEN   3392
#define XCD_BAR_WORDS 3456
#define XB_SPIN_CAP (1u << 22)
__device__ __forceinline__ unsigned xb_ld(unsigned* p)              { return __hip_atomic_load(p, __ATOMIC_RELAXED, __HIP_MEMORY_SCOPE_AGENT); }
__device__ __forceinline__ unsigned xb_add(unsigned* p, unsigned v) { return __hip_atomic_fetch_add(p, v, __ATOMIC_RELAXED, __HIP_MEMORY_SCOPE_AGENT); }
__device__ __forceinline__ unsigned xb_xcc_id() { return (unsigned)__builtin_amdgcn_s_getreg((3 << 11) | 20) & 0xFu; }
#define XB_SPIN(cond, bar) do { unsigned _sp = 0; while (cond) { __builtin_amdgcn_s_sleep(1); \
    if ((++_sp & 255u) == 0u) { if (xb_ld(&(bar)[XB_TMO])) break; if (_sp > XB_SPIN_CAP) { atomicAdd(&(bar)[XB_TMO], 1u); break; } } } } while (0)
struct XcdBarrier { unsigned* bar; unsigned x; volatile LAS unsigned* st; };
__device__ __forceinline__ XcdBarrier xcd_barrier_post(unsigned* bar, volatile LAS unsigned* st) {
    XcdBarrier b; b.bar = bar; b.x = xb_xcc_id(); b.st = st;
    if (threadIdx.x == 0) (void)xb_add(&bar[XB_XCNT(b.x)], 1u);
    return b;
}
__device__ __forceinline__ void xcd_barrier_complete(unsigned* bar, unsigned x, unsigned& nloc, unsigned& nx) {
    const unsigned G = gridDim.x * gridDim.y * gridDim.z;
    unsigned sum, cnt, mine, sp = 0u;
    for (;;) {
        sum = 0u; cnt = 0u; mine = 0u;
#pragma unroll
        for (unsigned j = 0; j < 16; ++j) { const unsigned c = xb_ld(&bar[XB_XCNT(j)]); sum += c; cnt += (c > 0u) ? 1u : 0u; mine = (j == x) ? c : mine; }
        if (sum == G) break;
        __builtin_amdgcn_s_sleep(1);
        if ((++sp & 255u) == 0u) { if (xb_ld(&bar[XB_TMO])) break; if (sp > XB_SPIN_CAP) { atomicAdd(&bar[XB_TMO], 1u); break; } }
    }
    nloc = mine > 0u ? mine : 1u; nx = cnt > 0u ? cnt : 1u;
}
__device__ __forceinline__ void xcd_barrier(const XcdBarrier& b) {
    asm volatile("s_waitcnt vmcnt(0)" ::: "memory");
    __syncthreads();
    if (threadIdx.x == 0) {
        unsigned* bar = b.bar;
        __builtin_amdgcn_s_waitcnt(0);
        unsigned nloc = b.st[0], nx = b.st[1];
        if (nloc == 0u) { xcd_barrier_complete(bar, b.x, nloc, nx); b.st[0] = nloc; b.st[1] = nx; }
        const unsigned old = xb_add(&bar[XB_XSUB(b.x)], 1u);
        const unsigned gen = old / nloc;
        if (old + 1u == (gen + 1u) * nloc) {
            __builtin_amdgcn_fence(__ATOMIC_RELEASE, "agent");
            asm volatile("s_waitcnt vmcnt(0)" ::: "memory");
            const unsigned og = xb_add(&bar[XB_TOP], 1u);
            const unsigned tg = og / nx;
            if (og + 1u == (tg + 1u) * nx) xb_add(&bar[XB_TOPGEN], 1u);
            else XB_SPIN(xb_ld(&bar[XB_TOPGEN]) == tg, bar);
            __builtin_amdgcn_fence(__ATOMIC_ACQUIRE, "agent");
            xb_add(&bar[XB_XGEN(b.x)], 1u);
            asm volatile("s_waitcnt vmcnt(0)" ::: "memory");
        } else {
            XB_SPIN(xb_ld(&bar[XB_XGEN(b.x)]) == gen, bar);
            __builtin_amdgcn_fence(__ATOMIC_ACQUIRE, "agent");
            asm volatile("s_waitcnt vmcnt(0)" ::: "memory");
        }
    }
    __syncthreads();
}

struct Frame {
    LAS unsigned char* lds;
    int tid, lane, wave, G, bid; volatile LAS unsigned* misc;
    __device__ __forceinline__ void fence_ids() { int t = threadIdx.x; asm volatile("" : "+v"(t)); tid = t; lane = t & 63; }
    const float *x, *c, *w_ada, *b_ada, *norm1_g, *w_in, *ret_gn_g, *sgu_ln_g, *sgu_ln_b, *sgu_w, *sgu_b, *w_ret_out, *w_sgu_out, *w_out, *norm2_g, *peer_w_q, *peer_sub_keys, *peer_u, *peer_v, *final_g;
    unsigned char* ws; unsigned char* dout;
};

__device__ __forceinline__ bf16x8 lds_row_frag(LAS const unsigned char* img, int stride, int r0, int k0, int lane) {
    return *(LAS const bf16x8*)(img + (r0 + (lane & 15)) * stride + (k0 + 8 * (lane >> 4)) * 2);
}
__device__ __forceinline__ s16x4 tr16(LAS const unsigned char* p) { return __builtin_bit_cast(s16x4, __builtin_amdgcn_ds_read_tr16_b64_v4i16((LAS s16x4*)p)); }
__device__ __forceinline__ bf16x8 lds_tr_frag(LAS const unsigned char* img, int stride, int k0, int n0, int lane) {
    const int g = lane >> 4, q = (lane >> 2) & 3, p = lane & 3;
    LAS const unsigned char* a = img + (k0 + 8 * g + q) * stride + (n0 + 4 * p) * 2;
    const s16x4 lo = tr16(a), hi = tr16(a + 4 * stride);
    return __builtin_shufflevector(lo, hi, 0, 1, 2, 3, 4, 5, 6, 7);
}
#define MFMA16(a, b, c) __builtin_amdgcn_mfma_f32_16x16x32_bf16((a), (b), (c), 0, 0, 0)
constexpr int KS = 272, VS = 528;

template <bool F8, class Map>
__device__ __forceinline__ void transpose_item(const float* W, int K, int N, bf16* WT, LAS float* scr, int item, int lane, Map srcmap) {
    const int nblk = N / 32, kb = item / nblk, nb = item % nblk, k0 = 64 * kb, n0 = 32 * nb;
    const int sc = srcmap(n0 + (lane & 31));
#pragma unroll 8
    for (int i = 0; i < 32; ++i) { const int kk = 2 * i + (lane >> 5); scr[kk * 33 + (lane & 31)] = W[(size_t)(k0 + kk) * N + sc]; }
    LDS_WAIT(); asm volatile("" ::: "memory");
    const int c = lane & 7;
#pragma unroll
    for (int j = 0; j < 4; ++j) { const int n = (lane >> 3) + 8 * j; const LAS float* s = scr + (8 * c) * 33 + n;
        if (F8) { v2u o8; o8.x = pk4_fp8(s[0 * 33] * 512.f, s[1 * 33] * 512.f, s[2 * 33] * 512.f, s[3 * 33] * 512.f); o8.y = pk4_fp8(s[4 * 33] * 512.f, s[5 * 33] * 512.f, s[6 * 33] * 512.f, s[7 * 33] * 512.f);
            *(v2u*)((unsigned char*)WT + (size_t)(n0 + n) * K + k0 + 8 * c) = o8; }
        else { v4u o; o.x = pk2(s[0 * 33], s[1 * 33]); o.y = pk2(s[2 * 33], s[3 * 33]); o.z = pk2(s[4 * 33], s[5 * 33]); o.w = pk2(s[6 * 33], s[7 * 33]);
            *(v4u*)(WT + (size_t)(n0 + n) * K + k0 + 8 * c) = o; } }
    LDS_WAIT(); asm volatile("" ::: "memory");
}
struct MapId { __device__ __forceinline__ int operator()(int n) const { return n; } };
struct MapWin { __device__ __forceinline__ int operator()(int n) const { if (n >= 1024) return n; const int ci = n & 127; return (n & ~127) + (ci >> 1) + 64 * (ci & 1); } };

__device__ __forceinline__ void cvt8(const float* src, bf16* dst, size_t chunk) {
    const f32x4 a = *(const f32x4*)(src + chunk * 8), b = *(const f32x4*)(src + chunk * 8 + 4);
    v4u o; o.x = pk2(a[0], a[1]); o.y = pk2(a[2], a[3]); o.z = pk2(b[0], b[1]); o.w = pk2(b[2], b[3]);
    *(v4u*)(dst + chunk * 8) = o;
}

__device__ __forceinline__ void p0a(Frame& F) { F.fence_ids();
    if (F.bid < 192) {
        LAS float* sc = (LAS float*)F.lds; LAS float* part = (LAS float*)(F.lds + 32768);
        for (int i = F.tid; i < 8192; i += 512) { const float cv = F.c[i]; sc[i] = pg8::silu1(cv); }
        __syncthreads();
        const int n0 = 32 * F.bid, ks = F.tid >> 3, c4 = F.tid & 7;
        f32x4 acc[8];
#pragma unroll
        for (int b = 0; b < 8; ++b) acc[b] = (f32x4){0.f, 0.f, 0.f, 0.f};
        for (int kk = ks; kk < 1024; kk += 64) { const f32x4 w = *(const f32x4*)(F.w_ada + (size_t)kk * 6144 + n0 + 4 * c4);
#pragma unroll
            for (int b = 0; b < 8; ++b) acc[b] += w * sc[b * 1024 + kk]; }
#pragma unroll
        for (int b = 0; b < 8; ++b) *(LAS f32x4*)(part + (ks * 8 + b) * 32 + 4 * c4) = acc[b];
        __syncthreads();
        if (F.tid < 256) { const int b = F.tid >> 5, col = F.tid & 31; float s = 0.f;
            for (int k2 = 0; k2 < 64; ++k2) s += part[(k2 * 8 + b) * 32 + col];
            ((float*)(F.ws + WS_MOD))[b * 6144 + n0 + col] = s + F.b_ada[n0 + col]; }
        __syncthreads();
    }
    {
        LAS float* scr = (LAS float*)(F.lds + F.wave * 16384);
        const int gw = F.bid * NWAVES + F.wave, NGW = F.G * NWAVES;
        constexpr int I_IN = 16 * (NIN / 32), I_SQ = 16 * 32, I_Q = 16 * 64, NITEMS = I_IN + 3 * I_SQ + I_Q;
        for (int it = gw; it < NITEMS; it += NGW) {
            int r = it;
            if (r < I_IN) { transpose_item<true>(F.w_in, 1024, NIN, (bf16*)(F.ws + WS_WIN), scr, r, F.lane, MapWin()); continue; } r -= I_IN;
            if (r < I_SQ) { transpose_item<true>(F.w_ret_out, 1024, 1024, (bf16*)(F.ws + WS_WRET), scr, r, F.lane, MapId()); continue; } r -= I_SQ;
            if (r < I_SQ) { transpose_item<true>(F.w_sgu_out, 1024, 1024, (bf16*)(F.ws + WS_WSGU), scr, r, F.lane, MapId()); continue; } r -= I_SQ;
            if (r < I_SQ) { transpose_item<true>(F.w_out, 1024, 1024, (bf16*)(F.ws + WS_WOUT), scr, r, F.lane, MapId()); continue; } r -= I_SQ;
            transpose_item<false>(F.peer_w_q, 1024, 2048, (bf16*)(F.ws + WS_WQ), scr, r, F.lane, MapId());
        }
    }
    const size_t gt = (size_t)F.bid * 512 + F.tid, NT = (size_t)F.G * 512;
    for (size_t ch = gt; ch < (size_t)16384 * 64; ch += NT) {
        const f32x4* up = (const f32x4*)(F.peer_u + ch * 16); const f32x4* vp = (const f32x4*)(F.peer_v + ch * 16);
        v4u ou, ov;
#pragma unroll
        for (int q = 0; q < 4; ++q) { const f32x4 a = up[q] * 512.0f, b = vp[q] * 16.0f; ou[q] = pk4_fp8(a[0], a[1], a[2], a[3]); ov[q] = pk4_fp8(b[0], b[1], b[2], b[3]); }
        const size_t e_ = ch >> 6, c16_ = ch & 63, dst_ = (c16_ >> 3) * ((size_t)16384 * 128) + e_ * 128 + (c16_ & 7) * 16;
        *(v4u*)(F.ws + WS_VE8 + dst_) = ov;
        if (MK_U4) {
            v2u o4; unsigned w0 = 0u, w1 = 0u;
            { const f32x4 a0 = up[0] * 64.0f, a1 = up[1] * 64.0f, a2 = up[2] * 64.0f, a3 = up[3] * 64.0f;
              w0 = __builtin_amdgcn_cvt_scalef32_pk_fp4_f32(w0, a0[0], a0[1], 1.0f, 0); w0 = __builtin_amdgcn_cvt_scalef32_pk_fp4_f32(w0, a0[2], a0[3], 1.0f, 1);
              w0 = __builtin_amdgcn_cvt_scalef32_pk_fp4_f32(w0, a1[0], a1[1], 1.0f, 2); w0 = __builtin_amdgcn_cvt_scalef32_pk_fp4_f32(w0, a1[2], a1[3], 1.0f, 3);
              w1 = __builtin_amdgcn_cvt_scalef32_pk_fp4_f32(w1, a2[0], a2[1], 1.0f, 0); w1 = __builtin_amdgcn_cvt_scalef32_pk_fp4_f32(w1, a2[2], a2[3], 1.0f, 1);
              w1 = __builtin_amdgcn_cvt_scalef32_pk_fp4_f32(w1, a3[0], a3[1], 1.0f, 2); w1 = __builtin_amdgcn_cvt_scalef32_pk_fp4_f32(w1, a3[2], a3[3], 1.0f, 3); }
            o4.x = w0; o4.y = w1;
            *(v2u*)(F.ws + WS_UE8 + (c16_ >> 4) * ((size_t)16384 * 128) + e_ * 128 + (c16_ & 15) * 8) = o4;
        } else *(v4u*)(F.ws + WS_UE8 + dst_) = ou; }
    for (size_t ch = gt; ch < (size_t)32768; ch += NT) cvt8(F.peer_sub_keys, (bf16*)(F.ws + WS_SK), ch);
    for (size_t ch = gt; ch < (size_t)8192; ch += NT) { const int t = (int)(ch >> 4) & 127, s0 = (int)(ch & 15) * 8;
        const f32x4 a = *(const f32x4*)(F.sgu_w + ch * 8), b = *(const f32x4*)(F.sgu_w + ch * 8 + 4);
        float v[8] = {a[0], a[1], a[2], a[3], b[0], b[1], b[2], b[3]};
#pragma unroll
        for (int e = 0; e < 8; ++e) v[e] = (s0 + e <= t) ? v[e] : 0.f;
        v4u o; o.x = pk2(v[0], v[1]); o.y = pk2(v[2], v[3]); o.z = pk2(v[4], v[5]); o.w = pk2(v[6], v[7]);
        *(v4u*)((bf16*)(F.ws + WS_SGUW) + ch * 8) = o; }
    for (size_t e = gt; e < (size_t)4096 * 64; e += NT) { const int s = (int)(e >> 6), i = (int)(e & 63);
        const float inv = fexp2(-(float)i * (13.287712379549449f / 64.0f));
        const float rev = ((float)s * inv) * 0.15915494309189535f; const float fr = rev - __builtin_floorf(rev);
        ((float*)(F.ws + WS_COS))[e] = __builtin_amdgcn_cosf(fr); ((float*)(F.ws + WS_SIN))[e] = __builtin_amdgcn_sinf(fr); }
}

template <int MODE  > __device__ __forceinline__ void norm_rows(Frame& F, const float* X, const float* gain, const float* shift, const float* scale, bf16* O, unsigned char* O8) { F.fence_ids();
    const int gw = F.bid * NWAVES + F.wave, NGW = F.G * NWAVES;
    f32x4 g[4];
#pragma unroll
    for (int j = 0; j < 4; ++j) g[j] = *(const f32x4*)(gain + 4 * F.lane + 256 * j);
    f32x4 nx[4];
    if (gw < MT) {
#pragma unroll
        for (int j = 0; j < 4; ++j) nx[j] = *((const f32x4*)(X + (size_t)gw * DM) + F.lane + 64 * j); }
    for (int m = gw; m < MT; m += NGW) {
        f32x4 v[4]; float s = 0.f;
#pragma unroll
        for (int j = 0; j < 4; ++j) { v[j] = nx[j]; s += (v[j][0] * v[j][0] + v[j][1] * v[j][1]) + (v[j][2] * v[j][2] + v[j][3] * v[j][3]); }
        const int b = m >> 12;
        f32x4 sh[4], sc[4];
#pragma unroll
        for (int j = 0; j < 4; ++j) { const int d = 4 * F.lane + 256 * j; sh[j] = *(const f32x4*)(shift + b * 6144 + d); sc[j] = *(const f32x4*)(scale + b * 6144 + d); }
        if (m + NGW < MT) {
#pragma unroll
            for (int j = 0; j < 4; ++j) nx[j] = *((const f32x4*)(X + (size_t)(m + NGW) * DM) + F.lane + 64 * j); }
        const float rstd = __builtin_amdgcn_rsqf(wave_sum(s) * (1.f / DM) + EPSN);
        v2u* o8 = (v2u*)(O + (size_t)m * DM) + F.lane;
#pragma unroll
        for (int j = 0; j < 4; ++j) { const int d = 4 * F.lane + 256 * j;
            const f32x4 h = v[j] * rstd * g[j] * (sc[j] + 1.0f) + sh[j];
            if (MODE == 2) { const f32x4 h8 = h * 8.0f; *(unsigned*)(O8 + (size_t)m * DM + d) = pk4_fp8(h8[0], h8[1], h8[2], h8[3]); }
            else { v2u w; w.x = pk2(h[0], h[1]); w.y = pk2(h[2], h[3]); o8[64 * j] = w; }
            if (MODE == 1) { const f32x4 hs = h * 16.0f; *(unsigned*)(O8 + (size_t)(d >> 8) * ((size_t)MT * 256) + (size_t)m * 256 + (d & 255)) = pk4_fp8(hs[0], hs[1], hs[2], hs[3]); } }
    }
}

__device__ __forceinline__ float lg_gamma(int h) { return __builtin_log2f(1.0f - fexp2((float)(-5 - h))); }
__device__ __forceinline__ v4u scale8(v4u w, float s) {
    v4u o; o.x = pk2(bflo(w.x) * s, bfhi(w.x) * s); o.y = pk2(bflo(w.y) * s, bfhi(w.y) * s); o.z = pk2(bflo(w.z) * s, bfhi(w.z) * s); o.w = pk2(bflo(w.w) * s, bfhi(w.w) * s); return o;
}
struct KvRegs { v4u k[4], v[8]; };
__device__ __forceinline__ void kv_load(Frame& F, int u, KvRegs& R) {
    const int b = u >> 7, h = (u >> 5) & 3, c = u & 31; const size_t tok0 = (size_t)b * SEQ + c * 128;
    const bf16* Kb = (const bf16*)(F.dout + DO_K); const bf16* Vb = (const bf16*)(F.ws + WS_V);
#pragma unroll
    for (int i = 0; i < 4; ++i) { const int ch = F.tid + 512 * i, j = ch >> 4, cc = ch & 15; R.k[i] = *(const v4u*)(Kb + (tok0 + j) * 512 + h * 128 + cc * 8); }
#pragma unroll
    for (int i = 0; i < 8; ++i) { const int ch = F.tid + 512 * i, j = ch >> 5, cc = ch & 31; R.v[i] = *(const v4u*)(Vb + (tok0 + j) * 1024 + h * 256 + cc * 8); }
}
__device__ __forceinline__ void kv_unit(Frame& F, int u, KvRegs& R, int unext) {
    const int b = u >> 7, h = (u >> 5) & 3, c = u & 31;
    LAS unsigned char* Kimg = F.lds; LAS unsigned char* Vimg = F.lds + 34816;
    const float lg = lg_gamma(h);
#pragma unroll
    for (int i = 0; i < 4; ++i) { const int ch = F.tid + 512 * i, j = ch >> 4, cc = ch & 15;
        *(LAS v4u*)(Kimg + j * KS + cc * 16) = scale8(R.k[i], fexp2((float)(127 - j) * lg)); }
#pragma unroll
    for (int i = 0; i < 8; ++i) { const int ch = F.tid + 512 * i, j = ch >> 5, cc = ch & 31; *(LAS v4u*)(Vimg + j * VS + cc * 16) = R.v[i]; }
    __syncthreads();
    if (unext >= 0) kv_load(F, unext, R);
    f32x4 acc[8][2];
#pragma unroll
    for (int dt = 0; dt < 8; ++dt) { acc[dt][0] = (f32x4){0.f, 0.f, 0.f, 0.f}; acc[dt][1] = (f32x4){0.f, 0.f, 0.f, 0.f}; }
#pragma unroll
    for (int js = 0; js < 4; ++js) {
        bf16x8 bv[2];
#pragma unroll
        for (int vt = 0; vt < 2; ++vt) bv[vt] = lds_tr_frag(Vimg, VS, 32 * js, 32 * F.wave + 16 * vt, F.lane);
#pragma unroll
        for (int dt = 0; dt < 8; ++dt) { const bf16x8 a = lds_tr_frag(Kimg, KS, 32 * js, 16 * dt, F.lane);
            acc[dt][0] = MFMA16(a, bv[0], acc[dt][0]); acc[dt][1] = MFMA16(a, bv[1], acc[dt][1]); }
    }
    bf16* dst = (bf16*)(F.dout + DO_KVS) + (size_t)(((b * 4 + h) * 32 + c)) * 32768;
#pragma unroll
    for (int dt = 0; dt < 8; ++dt)
#pragma unroll
        for (int vt = 0; vt < 2; ++vt) { const int v = 32 * F.wave + 16 * vt + (F.lane & 15), d0 = 16 * dt + 4 * (F.lane >> 4);
            v2u o; o.x = pk2(acc[dt][vt][0], acc[dt][vt][1]); o.y = pk2(acc[dt][vt][2], acc[dt][vt][3]);
            *(v2u*)(dst + v * 128 + d0) = o; }
    __syncthreads();
}
struct SguRegs { v4u sv[8]; f32x2v st[8]; };
__device__ __forceinline__ void sgu_load(Frame& F, int su, SguRegs& R) {
    const size_t tok0 = (size_t)(su >> 2) * 128; const int g = su & 3; const bf16* SVb = (const bf16*)(F.ws + WS_SV); const float* stat = (const float*)(F.ws + WS_SVSTAT);
    int tq = F.tid; asm volatile("" : "+v"(tq));
#pragma unroll
    for (int i = 0; i < 8; ++i) { const int ch = tq + 512 * i, sr = ch >> 5, cc = ch & 31;
        R.sv[i] = *(const v4u*)(SVb + (tok0 + sr) * 1024 + g * 256 + cc * 8); R.st[i] = *(const f32x2v*)(stat + (tok0 + sr) * 2); }
}
__device__ __forceinline__ void sgu_unit(Frame& F, int su, SguRegs& R, int snext, int& cur_g) {
    const size_t tok0 = (size_t)(su >> 2) * 128; const int g = su & 3;
    LAS unsigned char* Vn = F.lds; LAS unsigned char* Wimg = F.lds + 67584;
    const bf16* Ub = (const bf16*)(F.ws + WS_U); const bf16* Wm = (const bf16*)(F.ws + WS_SGUW);
    { const int cc = F.tid & 31; const int col = g * 256 + cc * 8;
        const f32x4 g0 = *(const f32x4*)(F.sgu_ln_g + col), g1 = *(const f32x4*)(F.sgu_ln_g + col + 4), b0 = *(const f32x4*)(F.sgu_ln_b + col), b1 = *(const f32x4*)(F.sgu_ln_b + col + 4);
#pragma unroll
        for (int i = 0; i < 8; ++i) { const int ch = F.tid + 512 * i, sr = ch >> 5; const v4u w = R.sv[i];
            const float mean = R.st[i].x * (1.f / 1024.f), var = R.st[i].y * (1.f / 1024.f) - mean * mean, rstd = __builtin_amdgcn_rsqf(var + EPSN);
            v4u o;
            o.x = pk2((bflo(w.x) - mean) * rstd * g0[0] + b0[0], (bfhi(w.x) - mean) * rstd * g0[1] + b0[1]);
            o.y = pk2((bflo(w.y) - mean) * rstd * g0[2] + b0[2], (bfhi(w.y) - mean) * rstd * g0[3] + b0[3]);
            o.z = pk2((bflo(w.z) - mean) * rstd * g1[0] + b1[0], (bfhi(w.z) - mean) * rstd * g1[1] + b1[1]);
            o.w = pk2((bflo(w.w) - mean) * rstd * g1[2] + b1[2], (bfhi(w.w) - mean) * rstd * g1[3] + b1[3]);
            *(LAS v4u*)(Vn + sr * VS + cc * 16) = o; } }
    if (g != cur_g) { cur_g = g;
#pragma unroll
        for (int i = 0; i < 4; ++i) { const int ch = F.tid + 512 * i, t = ch >> 4, cc = ch & 15;
            *(LAS v4u*)(Wimg + t * KS + cc * 16) = *(const v4u*)(Wm + (size_t)(g * 128 + t) * 128 + cc * 8); } }
    __syncthreads();
    if (snext >= 0) sgu_load(F, snext, R);
    v2u uv[8][2];
#pragma unroll
    for (int tt = 0; tt < 8; ++tt)
#pragma unroll
        for (int ct = 0; ct < 2; ++ct) uv[tt][ct] = *(const v2u*)(Ub + (tok0 + 16 * tt + (F.lane & 15)) * 1024 + g * 256 + 32 * F.wave + 16 * ct + 4 * (F.lane >> 4));
    f32x4 acc[2][8];
#pragma unroll
    for (int ct = 0; ct < 2; ++ct)
#pragma unroll
        for (int tt = 0; tt < 8; ++tt) acc[ct][tt] = (f32x4){0.f, 0.f, 0.f, 0.f};
#pragma unroll
    for (int ss = 0; ss < 4; ++ss) {
        bf16x8 av[2];
#pragma unroll
        for (int ct = 0; ct < 2; ++ct) av[ct] = lds_tr_frag(Vn, VS, 32 * ss, 32 * F.wave + 16 * ct, F.lane);
#pragma unroll
        for (int tt = 0; tt < 8; ++tt) if (tt >= 2 * ss) { const bf16x8 bw = lds_row_frag(Wimg, KS, 16 * tt, 32 * ss, F.lane);
            acc[0][tt] = MFMA16(av[0], bw, acc[0][tt]); acc[1][tt] = MFMA16(av[1], bw, acc[1][tt]); }
    }
#pragma unroll
    for (int tt = 0; tt < 8; ++tt) { const int t = 16 * tt + (F.lane & 15); const float bs = F.sgu_b[g * 128 + t];
#pragma unroll
        for (int ct = 0; ct < 2; ++ct) { const int cg = g * 256 + 32 * F.wave + 16 * ct + 4 * (F.lane >> 4); const v2u u2 = uv[tt][ct];
            *(unsigned*)(F.ws + WS_YS8 + (tok0 + t) * 1024 + cg) = pk4_fp8(8.f * bflo(u2.x) * (acc[ct][tt][0] + bs), 8.f * bfhi(u2.x) * (acc[ct][tt][1] + bs), 8.f * bflo(u2.y) * (acc[ct][tt][2] + bs), 8.f * bfhi(u2.y) * (acc[ct][tt][3] + bs)); } }
    __syncthreads();
}
__device__ __forceinline__ void p2a(Frame& F) { F.fence_ids();
    { KvRegs R; if (F.bid < 1024) kv_load(F, F.bid, R);
      for (int u = F.bid; u < 1024; u += F.G) kv_unit(F, u, R, (u + F.G < 1024) ? u + F.G : -1); }
#if MK_PROBE_HI > 0
    if (F.bid == 0 && threadIdx.x == 0) { const unsigned long long _t = __builtin_amdgcn_s_memrealtime(); F.misc[16 + 2 * 20] = (unsigned)_t; F.misc[17 + 2 * 20] = (unsigned)(_t >> 32); }
#endif
    { SguRegs R; int cur_g = -1; if (F.bid < 1024) sgu_load(F, F.bid, R);
      for (int su = F.bid; su < 1024; su += F.G) sgu_unit(F, su, R, (su + F.G < 1024) ? su + F.G : -1, cur_g); }
}
__device__ __forceinline__ void p2b(Frame& F) { F.fence_ids();
    bf16* KVS = (bf16*)(F.dout + DO_KVS);
    for (int item = F.bid * 512 + F.tid; item < 32 * 4096; item += F.G * 512) {
        const int bh = item >> 12, rem = item & 4095, h = bh & 3;
        const float dc = fexp2(128.0f * lg_gamma(h));
        float s[8];
#pragma unroll
        for (int e = 0; e < 8; ++e) s[e] = 0.f;
        bf16* p = KVS + (size_t)bh * 32 * 32768 + (size_t)rem * 8;
        for (int c0 = 0; c0 < 32; c0 += 8) {
            v4u kv[8];
#pragma unroll
            for (int i = 0; i < 8; ++i) kv[i] = *(const v4u*)(p + (size_t)(c0 + i) * 32768);
#pragma unroll
            for (int i = 0; i < 8; ++i) {
                v4u o; o.x = pk2(s[0], s[1]); o.y = pk2(s[2], s[3]); o.z = pk2(s[4], s[5]); o.w = pk2(s[6], s[7]);
                *(v4u*)(p + (size_t)(c0 + i) * 32768) = o;
                s[0] = s[0] * dc + bflo(kv[i].x); s[1] = s[1] * dc + bfhi(kv[i].x); s[2] = s[2] * dc + bflo(kv[i].y); s[3] = s[3] * dc + bfhi(kv[i].y);
                s[4] = s[4] * dc + bflo(kv[i].z); s[5] = s[5] * dc + bfhi(kv[i].z); s[6] = s[6] * dc + bflo(kv[i].w); s[7] = s[7] * dc + bfhi(kv[i].w);
            }
        }
    }
}
struct RetRegs { v4u q[4], k[4], v[8]; };
__device__ __forceinline__ void ret_load(Frame& F, int u, RetRegs& R) {
    const int b = u >> 7, h = (u >> 5) & 3, c = u & 31; const size_t tok0 = (size_t)b * SEQ + c * 128;
    const bf16* Qb = (const bf16*)(F.dout + DO_Q); const bf16* Kb = (const bf16*)(F.dout + DO_K); const bf16* Vb = (const bf16*)(F.ws + WS_V);
#pragma unroll
    for (int i = 0; i < 4; ++i) { const int ch = F.tid + 512 * i, j = ch >> 4, cc = ch & 15;
        R.q[i] = *(const v4u*)(Qb + (tok0 + j) * 512 + h * 128 + cc * 8); R.k[i] = *(const v4u*)(Kb + (tok0 + j) * 512 + h * 128 + cc * 8); }
#pragma unroll
    for (int i = 0; i < 8; ++i) { const int ch = F.tid + 512 * i, j = ch >> 5, cc = ch & 31; R.v[i] = *(const v4u*)(Vb + (tok0 + j) * 1024 + h * 256 + cc * 8); }
}
__device__ __forceinline__ void ret_unit(Frame& F, int u, RetRegs& R, int unext) {
    const int b = u >> 7, h = (u >> 5) & 3, c = u & 31;
    const size_t tok0 = (size_t)b * SEQ + c * 128;
    LAS unsigned char* Qimg = F.lds; LAS unsigned char* Kimg = F.lds + 34816; LAS unsigned char* Vimg = F.lds + 69632;
    LAS unsigned char* Sout = F.lds;
    const bf16* Gb = (const bf16*)(F.ws + WS_G);
    const bf16* ST = (const bf16*)(F.dout + DO_KVS) + (size_t)(((b * 4 + h) * 32 + c)) * 32768;
    const float lg = lg_gamma(h);
    const int lane = F.lane, w = F.wave, l15 = lane & 15, g4 = lane >> 4;
#pragma unroll
    for (int i = 0; i < 4; ++i) { const int ch = F.tid + 512 * i, j = ch >> 4, cc = ch & 15;
        *(LAS v4u*)(Qimg + j * KS + cc * 16) = R.q[i]; *(LAS v4u*)(Kimg + j * KS + cc * 16) = R.k[i]; }
#pragma unroll
    for (int i = 0; i < 8; ++i) { const int ch = F.tid + 512 * i, j = ch >> 5, cc = ch & 31; *(LAS v4u*)(Vimg + j * VS + cc * 16) = R.v[i]; }
    bf16x8 bs[4][2];
#pragma unroll
    for (int ds = 0; ds < 4; ++ds)
#pragma unroll
        for (int vt = 0; vt < 2; ++vt) bs[ds][vt] = *(const bf16x8*)(ST + (size_t)(32 * w + 16 * vt + l15) * 128 + 32 * ds + 8 * g4);
    __syncthreads();
    f32x4 st[8];
#pragma unroll
    for (int jt = 0; jt < 8; ++jt) st[jt] = (f32x4){0.f, 0.f, 0.f, 0.f};
#pragma unroll
    for (int ds = 0; ds < 4; ++ds) { const bf16x8 bq = lds_row_frag(Qimg, KS, 16 * w, 32 * ds, lane);
#pragma unroll
        for (int jt = 0; jt < 8; ++jt) if (jt <= w) { const bf16x8 ak = lds_row_frag(Kimg, KS, 16 * jt, 32 * ds, lane); st[jt] = MFMA16(ak, bq, st[jt]); } }
    __syncthreads();
    { const int i = 16 * w + l15;
#pragma unroll
        for (int jt = 0; jt < 8; ++jt) { float o[4];
#pragma unroll
            for (int ii = 0; ii < 4; ++ii) { const int j = 16 * jt + 4 * g4 + ii; o[ii] = (i >= j) ? st[jt][ii] * fexp2((float)(i - j) * lg) : 0.f; }
            v2u pk; pk.x = pk2(o[0], o[1]); pk.y = pk2(o[2], o[3]);
            *(LAS v2u*)(Kimg + i * KS + (16 * jt + 4 * g4) * 2) = pk; } }
    __syncthreads();
    f32x4 acc[8][2];
#pragma unroll
    for (int it = 0; it < 8; ++it) { acc[it][0] = (f32x4){0.f, 0.f, 0.f, 0.f}; acc[it][1] = (f32x4){0.f, 0.f, 0.f, 0.f}; }
#pragma unroll
    for (int ds = 0; ds < 4; ++ds) {
#pragma unroll
        for (int it = 0; it < 8; ++it) { const bf16x8 a = lds_row_frag(Qimg, KS, 16 * it, 32 * ds, lane);
            acc[it][0] = MFMA16(a, bs[ds][0], acc[it][0]); acc[it][1] = MFMA16(a, bs[ds][1], acc[it][1]); } }
#pragma unroll
    for (int it = 0; it < 8; ++it)
#pragma unroll
        for (int ii = 0; ii < 4; ++ii) { const float dq = fexp2((float)(16 * it + 4 * g4 + ii + 1) * lg); acc[it][0][ii] *= dq; acc[it][1][ii] *= dq; }
#pragma unroll
    for (int js = 0; js < 4; ++js) { bf16x8 bv[2];
#pragma unroll
        for (int vt = 0; vt < 2; ++vt) bv[vt] = lds_tr_frag(Vimg, VS, 32 * js, 32 * w + 16 * vt, lane);
#pragma unroll
        for (int it = 0; it < 8; ++it) if (it >= 2 * js) { const bf16x8 a = lds_row_frag(Kimg, KS, 16 * it, 32 * js, lane);
            acc[it][0] = MFMA16(a, bv[0], acc[it][0]); acc[it][1] = MFMA16(a, bv[1], acc[it][1]); } }
    int lane_h = lane; asm volatile("" : "+v"(lane_h));
    v2u gt[16];
#pragma unroll
    for (int rr = 0; rr < 16; ++rr) gt[rr] = *(const v2u*)(Gb + (tok0 + 16 * w + rr) * 1024 + h * 256 + 4 * lane_h);
    const f32x4 gn = *(const f32x4*)(F.ret_gn_g + h * 256 + 4 * lane_h);
    __syncthreads();
#pragma unroll
    for (int it = 0; it < 8; ++it)
#pragma unroll
        for (int vt = 0; vt < 2; ++vt)
#pragma unroll
            for (int ii = 0; ii < 4; ++ii) *(LAS float*)(Sout + (16 * it + 4 * g4 + ii) * 1040 + (32 * w + 16 * vt + l15) * 4) = acc[it][vt][ii];
    __syncthreads();
#pragma unroll
    for (int rr = 0; rr < 16; ++rr) { const int i = 16 * w + rr;
        const f32x4 y = *(LAS const f32x4*)(Sout + i * 1040 + lane_h * 16);
        const float mean = wave_sum((y[0] + y[1]) + (y[2] + y[3])) * (1.f / 256.f);
        const f32x4 d = y - mean;
        const float var = wave_sum((d[0] * d[0] + d[1] * d[1]) + (d[2] * d[2] + d[3] * d[3])) * (1.f / 256.f);
        const float r8 = __builtin_amdgcn_rsqf(var + EPSN) * 4.0f;
        const size_t off = (tok0 + i) * 1024 + h * 256 + 4 * lane_h;
        *(unsigned*)(F.ws + WS_YG8 + off) = pk4_fp8(d[0] * r8 * gn[0] * bflo(gt[rr].x), d[1] * r8 * gn[1] * bfhi(gt[rr].x), d[2] * r8 * gn[2] * bflo(gt[rr].y), d[3] * r8 * gn[3] * bfhi(gt[rr].y)); }
    __syncthreads();
}
__device__ __forceinline__ void p2c(Frame& F) { F.fence_ids(); for (int u = F.bid; u < 1024; u += F.G) { RetRegs R; ret_load(F, u, R); ret_unit(F, u, R, -1); } }

__device__ __forceinline__ float dppx(float v, int) { return v; }
template <int CTRL> __device__ __forceinline__ void merge16(float (&L)[16]) {
    float c[16];
#pragma unroll
    for (int i = 0; i < 16; ++i) c[i] = __builtin_fmaxf(L[i], dpp_f<CTRL>(L[15 - i]));
#pragma unroll
    for (int half = 8; half >= 1; half >>= 1)
#pragma unroll
        for (int i = 0; i < 16; ++i) if ((i & half) == 0) { const float hi = __builtin_fmaxf(c[i], c[i + half]), lo = __builtin_fminf(c[i], c[i + half]); c[i] = hi; c[i + half] = lo; }
#pragma unroll
    for (int i = 0; i < 16; ++i) L[i] = c[i];
}
__device__ __forceinline__ void sort16_desc(float (&v)[16]) {
#pragma unroll
    for (int k = 2; k <= 16; k <<= 1)
#pragma unroll
        for (int j = k >> 1; j >= 1; j >>= 1)
#pragma unroll
            for (int i = 0; i < 16; ++i) { const int l = i ^ j; if (l > i) { const bool desc = ((i & k) == 0) || (k == 16);
                const float hi = __builtin_fmaxf(v[i], v[l]), lo = __builtin_fminf(v[i], v[l]); v[i] = desc ? hi : lo; v[l] = desc ? lo : hi; } }
}
__device__ __forceinline__ void merge_top16(float (&A)[16], const float (&B)[16]) {
#pragma unroll
    for (int i = 0; i < 16; ++i) A[i] = __builtin_fmaxf(A[i], B[15 - i]);
#pragma unroll
    for (int half = 8; half >= 1; half >>= 1)
#pragma unroll
        for (int i = 0; i < 16; ++i) if ((i & half) == 0) { const float hi = __builtin_fmaxf(A[i], A[i + half]), lo = __builtin_fminf(A[i], A[i + half]); A[i] = hi; A[i + half] = lo; }
}
__device__ __forceinline__ void p5b(Frame& F) {
    F.fence_ids();
    LAS unsigned char* Aimg = F.lds; LAS unsigned char* Bimg = F.lds + 34816; LAS float* Sc = (LAS float*)(F.lds + 69632);
    const bf16* QP = (const bf16*)(F.ws + WS_GA);
    const int lane = F.lane, w = F.wave;
    int cur_hp = -1;
    v4u pa[4];
    if (F.bid < 4096) { const int tt = F.bid >> 4, hp = F.bid & 15;
#pragma unroll
        for (int i = 0; i < 4; ++i) { const int ch = F.tid + 512 * i, r = ch >> 4, cc = ch & 15; pa[i] = *(const v4u*)(QP + ((size_t)tt * 128 + r) * 2048 + hp * 128 + cc * 8); } }
    for (int u = F.bid; u < 4096; u += F.G) {
        const int tt = u >> 4, hp = u & 15; const size_t tok0 = (size_t)tt * 128;
#pragma unroll
        for (int i = 0; i < 4; ++i) { const int ch = F.tid + 512 * i, r = ch >> 4, cc = ch & 15; *(LAS v4u*)(Aimg + r * KS + cc * 16) = pa[i]; }
        if (hp != cur_hp) { const bf16* SK = (const bf16*)(F.ws + WS_SK) + (size_t)hp * 16384; cur_hp = hp;
#pragma unroll
            for (int i = 0; i < 4; ++i) { const int ch = F.tid + 512 * i, r = ch >> 4, cc = ch & 15; *(LAS v4u*)(Bimg + r * KS + cc * 16) = *(const v4u*)(SK + (size_t)r * 128 + cc * 8); } }
        __syncthreads();
        { const int un = u + F.G; if (un < 4096) { const int tn = un >> 4, hn = un & 15;
#pragma unroll
            for (int i = 0; i < 4; ++i) { const int ch = F.tid + 512 * i, r = ch >> 4, cc = ch & 15; pa[i] = *(const v4u*)(QP + ((size_t)tn * 128 + r) * 2048 + hn * 128 + cc * 8); } } }
        f32x4 acc[8];
#pragma unroll
        for (int nt = 0; nt < 8; ++nt) acc[nt] = (f32x4){0.f, 0.f, 0.f, 0.f};
#pragma unroll
        for (int ks = 0; ks < 4; ++ks) { const bf16x8 a = lds_row_frag(Aimg, KS, 16 * w, 32 * ks, lane);
#pragma unroll
            for (int nt = 0; nt < 8; ++nt) { const bf16x8 bb = lds_row_frag(Bimg, KS, 16 * nt, 32 * ks, lane); acc[nt] = MFMA16(a, bb, acc[nt]); } }
#pragma unroll
        for (int nt = 0; nt < 8; ++nt)
#pragma unroll
            for (int ii = 0; ii < 4; ++ii) Sc[(16 * w + 4 * (lane >> 4) + ii) * 132 + 16 * nt + (lane & 15)] = acc[nt][ii];
        __syncthreads();
        { const int row = F.tid >> 2, q = F.tid & 3;
            float L[16], L2[16];
#pragma unroll
            for (int i = 0; i < 16; ++i) { const int n = 4 * i + q, n2 = 4 * (i + 16) + q;
                L[i] = __uint_as_float((__float_as_uint(Sc[row * 132 + n]) & 0xFFFFFF80u) | (unsigned)n);
                L2[i] = __uint_as_float((__float_as_uint(Sc[row * 132 + n2]) & 0xFFFFFF80u) | (unsigned)n2); }
            sort16_desc(L); sort16_desc(L2); merge_top16(L, L2);
            merge16<0xB1>(L); merge16<0x4E>(L);
            if (q == 0) { v4u* dst = (v4u*)((unsigned*)(F.ws + WS_SUB) + ((tok0 + row) * 16 + hp) * 16);
#pragma unroll
                for (int i = 0; i < 4; ++i) dst[i] = (v4u){__float_as_uint(L[4 * i]), __float_as_uint(L[4 * i + 1]), __float_as_uint(L[4 * i + 2]), __float_as_uint(L[4 * i + 3])}; } }
        __syncthreads();
    }
}

template <int CTRL> __device__ __forceinline__ float dpp_max(float v) { return __builtin_fmaxf(v, dpp_f<CTRL>(v)); }
template <int CTRL> __device__ __forceinline__ float dpp_add(float v) { return v + dpp_f<CTRL>(v); }
__device__ __forceinline__ float row_allmax(float v) { v = dpp_max<0x128>(v); v = dpp_max<0x124>(v); v = dpp_max<0x122>(v); v = dpp_max<0x121>(v); return v; }
__device__ __forceinline__ float row_allsum(float v) { v = dpp_add<0x128>(v); v = dpp_add<0x124>(v); v = dpp_add<0x122>(v); v = dpp_add<0x121>(v); return v; }
__device__ __forceinline__ void p6a(Frame& F) { F.fence_ids();
    const int lane = F.lane, row = lane >> 4, i = lane & 15, rowbase = lane & 48;
    LAS unsigned* Sel = (LAS unsigned*)(F.lds + F.wave * 1024);
    const unsigned* SUB = (const unsigned*)(F.ws + WS_SUB);
    unsigned* EID = (unsigned*)(F.ws + WS_EID); float* GWp = (float*)(F.ws + WS_GW);
    const int gw = F.bid * NWAVES + F.wave, NGW = F.G * NWAVES;
    unsigned nab[2], nbb[2];
    if (gw < MT) {
#pragma unroll
        for (int r = 0; r < 2; ++r) { const int h = 4 * r + row; nab[r] = SUB[((size_t)gw * 16 + 2 * h) * 16 + i]; nbb[r] = SUB[((size_t)gw * 16 + 2 * h + 1) * 16 + i]; } }
    for (int t = gw; t < MT; t += NGW) {
        unsigned abits[2], bbits[2], bcur[2]; float a[2], hv[2]; int ptr[2];
#pragma unroll
        for (int r = 0; r < 2; ++r) { abits[r] = nab[r]; bbits[r] = nbb[r]; a[r] = __uint_as_float(abits[r]); ptr[r] = 0; bcur[r] = (unsigned)__shfl((int)bbits[r], rowbase); hv[r] = a[r] + __uint_as_float(bcur[r]); }
        if (t + NGW < MT) {
#pragma unroll
            for (int r = 0; r < 2; ++r) { const int h = 4 * r + row; nab[r] = SUB[((size_t)(t + NGW) * 16 + 2 * h) * 16 + i]; nbb[r] = SUB[((size_t)(t + NGW) * 16 + 2 * h + 1) * 16 + i]; } }
        for (int k = 0; k < 16; ++k) {
#pragma unroll
            for (int r = 0; r < 2; ++r) {
                const float key = __uint_as_float((__float_as_uint(hv[r]) & 0xFFFFFFF0u) | (unsigned)i);
                const float m = row_allmax(key);
                const bool win = (key == m);
                if (win) { Sel[((r * 4 + row) * 16 + k) * 2] = (abits[r] & 127u) * 128u + (bcur[r] & 127u); Sel[((r * 4 + row) * 16 + k) * 2 + 1] = __float_as_uint(hv[r]); ptr[r]++; }
                const unsigned bnext = (unsigned)__shfl((int)bbits[r], rowbase + (ptr[r] < 15 ? ptr[r] : 15));
                if (win) { bcur[r] = bnext; hv[r] = (ptr[r] < 16) ? a[r] + __uint_as_float(bnext) : -3.0e38f; }
            }
        }
        LDS_WAIT(); asm volatile("" ::: "memory");
#pragma unroll
        for (int r = 0; r < 2; ++r) { const int h = 4 * r + row;
            const unsigned e = Sel[((r * 4 + row) * 16 + i) * 2]; const float sc = __uint_as_float(Sel[((r * 4 + row) * 16 + i) * 2 + 1]);
            const float mx = row_allmax(sc);
            const float ex = fexp2((sc - mx) * 1.44269504089f);
            const float sum = row_allsum(ex);
            EID[(size_t)t * 128 + h * 16 + i] = e; GWp[(size_t)t * 128 + h * 16 + i] = ex / sum; }
        LDS_WAIT(); asm volatile("" ::: "memory");
    }
}
typedef float f32x2c __attribute__((ext_vector_type(2)));
__device__ __forceinline__ long mk64(unsigned lo, unsigned hi) { return (long)(((unsigned long long)hi << 32) | lo); }
#if MK_U4
typedef int v8i_q __attribute__((ext_vector_type(8)));
__device__ __forceinline__ void p6b(Frame& F) { F.fence_ids();
    const int j = F.bid & 7, s2 = j >> 1, par = j & 1, nsb = F.G >> 3; if ((F.bid >> 3) >= nsb) return;
    const int wj = (F.bid >> 3) * NWAVES + F.wave, NW = nsb * NWAVES, NI = MT / 2;
    const int lane = F.lane, g = lane >> 4;
    const int pidx = (4 * (lane & 15) + (lane >> 4)) * 4;
    const unsigned char* H8 = F.ws + WS_H2F8 + (size_t)s2 * MT * 256 + 16 * g; const unsigned char* U4 = F.ws + WS_UE8 + (size_t)s2 * 16384 * 128 + 16 * (lane & 3); const unsigned* EID = (const unsigned*)(F.ws + WS_EID) + (lane >> 2);
    float* PD = (float*)(F.ws + WS_PD) + (size_t)s2 * MT * 128;
#define TOK(ix_) (2 * ((ix_) < NI ? (ix_) : NI - 1) + par)
#define P6B_LOAD_EID(E, ix_) do { const int tc_ = TOK(ix_); _Pragma("unroll") for (int h = 0; h < 8; ++h) E[h] = EID[(size_t)tc_ * 128 + 16 * h]; } while (0)
#define P6B_LOAD_AB(A_, B0_, B1_, E, ix_) do { const int tc_ = TOK(ix_); const unsigned char* hp_ = H8 + (size_t)tc_ * 256; A_[0] = *(const v4u*)hp_; A_[1] = *(const v4u*)(hp_ + 64); A_[2] = *(const v4u*)(hp_ + 128); A_[3] = *(const v4u*)(hp_ + 192); \
        _Pragma("unroll") for (int h = 0; h < 8; ++h) { const unsigned char* rp_ = U4 + (size_t)E[h] * 128; B0_[h] = *(const v4u*)rp_; B1_[h] = *(const v4u*)(rp_ + 64); } } while (0)
#define BPM(x_) ((int)__builtin_amdgcn_ds_bpermute(pidx, (int)(x_)))
#define P6B_COMPUTE(A_, B0_, B1_, ix_) do { if ((ix_) < NI) { const int tc_ = 2 * (ix_) + par; \
        const v8i_q a0_ = (v8i_q){(int)A_[0].x, (int)A_[0].y, (int)A_[0].z, (int)A_[0].w, (int)A_[1].x, (int)A_[1].y, (int)A_[1].z, (int)A_[1].w}, a1_ = (v8i_q){(int)A_[2].x, (int)A_[2].y, (int)A_[2].z, (int)A_[2].w, (int)A_[3].x, (int)A_[3].y, (int)A_[3].z, (int)A_[3].w}; \
        _Pragma("unroll") for (int h = 0; h < 8; ++h) { const v8i_q b0_ = (v8i_q){BPM(B0_[h].x), BPM(B0_[h].y), BPM(B0_[h].z), BPM(B0_[h].w), 0, 0, 0, 0}, b1_ = (v8i_q){BPM(B1_[h].x), BPM(B1_[h].y), BPM(B1_[h].z), BPM(B1_[h].w), 0, 0, 0, 0}; \
            f32x4 acc_ = __builtin_amdgcn_mfma_scale_f32_16x16x128_f8f6f4(a0_, b0_, (f32x4){0.f, 0.f, 0.f, 0.f}, 0, 4, 0, 0x7F7F7F7F, 0, 0x7F7F7F7F); \
            acc_ = __builtin_amdgcn_mfma_scale_f32_16x16x128_f8f6f4(a1_, b1_, acc_, 0, 4, 0, 0x7F7F7F7F, 0, 0x7F7F7F7F); \
            if (lane < 16) PD[(size_t)tc_ * 128 + 16 * h + lane] = acc_[0] * (1.0f / 1024.0f); } } } while (0)
    unsigned E0[8], E1[8]; v4u A0[4], A1[4], B00[8], B01[8], B10[8], B11[8];
    int ix = wj;
    P6B_LOAD_EID(E0, ix); P6B_LOAD_EID(E1, ix + NW);
    P6B_LOAD_AB(A0, B00, B01, E0, ix);
    for (; ix < NI; ix += 2 * NW) {
        P6B_LOAD_AB(A1, B10, B11, E1, ix + NW);
        P6B_LOAD_EID(E0, ix + 2 * NW);
        P6B_COMPUTE(A0, B00, B01, ix);
        P6B_LOAD_AB(A0, B00, B01, E0, ix + 2 * NW);
        P6B_LOAD_EID(E1, ix + 3 * NW);
        P6B_COMPUTE(A1, B10, B11, ix + NW);
    }
#undef TOK
#undef P6B_LOAD_EID
#undef P6B_LOAD_AB
#undef P6B_COMPUTE
#undef BPM
}
#else
__device__ __forceinline__ void p6b(Frame& F) { F.fence_ids();
    const int j = F.bid & 7, nsb = F.G >> 3; if ((F.bid >> 3) >= nsb) return;
    const int wj = (F.bid >> 3) * NWAVES + F.wave, NW = nsb * NWAVES;
    const int lane = F.lane, g = lane >> 4;
    const int pidx = (4 * (lane & 15) + (lane >> 4)) * 4;
    const unsigned char* H8 = F.ws + WS_H2F8 + (size_t)j * MT * 128 + 16 * g; const unsigned char* UE8 = F.ws + WS_UE8 + (size_t)j * 16384 * 128 + 16 * (lane & 3); const unsigned* EID = (const unsigned*)(F.ws + WS_EID) + (lane >> 2);
    float* PD = (float*)(F.ws + WS_PD) + (size_t)j * MT * 128;
#define P6B_LOAD_EID(E, tt) do { const int tc_ = (tt) < MT ? (tt) : MT - 1; _Pragma("unroll") for (int h = 0; h < 8; ++h) E[h] = EID[(size_t)tc_ * 128 + 16 * h]; } while (0)
#define P6B_LOAD_AB(A0_, A1_, B0_, B1_, E, tt) do { const int tc_ = (tt) < MT ? (tt) : MT - 1; const unsigned char* hp_ = H8 + (size_t)tc_ * 128; A0_ = *(const v4u*)hp_; A1_ = *(const v4u*)(hp_ + 64); \
        _Pragma("unroll") for (int h = 0; h < 8; ++h) { const unsigned char* rp_ = UE8 + (size_t)E[h] * 128; B0_[h] = *(const v4u*)rp_; B1_[h] = *(const v4u*)(rp_ + 64); } } while (0)
#define BPM(x_) ((unsigned)__builtin_amdgcn_ds_bpermute(pidx, (int)(x_)))
#define P6B_COMPUTE(A0_, A1_, B0_, B1_, tt) do { if ((tt) < MT) { _Pragma("unroll") for (int h = 0; h < 8; ++h) { f32x4 acc_ = (f32x4){0.f, 0.f, 0.f, 0.f}; \
            acc_ = __builtin_amdgcn_mfma_f32_16x16x32_fp8_fp8(mk64(A0_.x, A0_.y), mk64(BPM(B0_[h].x), BPM(B0_[h].y)), acc_, 0, 0, 0); \
            acc_ = __builtin_amdgcn_mfma_f32_16x16x32_fp8_fp8(mk64(A0_.z, A0_.w), mk64(BPM(B0_[h].z), BPM(B0_[h].w)), acc_, 0, 0, 0); \
            acc_ = __builtin_amdgcn_mfma_f32_16x16x32_fp8_fp8(mk64(A1_.x, A1_.y), mk64(BPM(B1_[h].x), BPM(B1_[h].y)), acc_, 0, 0, 0); \
            acc_ = __builtin_amdgcn_mfma_f32_16x16x32_fp8_fp8(mk64(A1_.z, A1_.w), mk64(BPM(B1_[h].z), BPM(B1_[h].w)), acc_, 0, 0, 0); \
            if (lane < 16) PD[(size_t)(tt) * 128 + 16 * h + lane] = acc_[0] * (1.0f / 8192.0f); } } } while (0)
    unsigned E0[8], E1[8]; v4u A00, A01, A10, A11, B00[8], B01[8], B10[8], B11[8];
    int t = wj;
    P6B_LOAD_EID(E0, t); P6B_LOAD_EID(E1, t + NW);
    P6B_LOAD_AB(A00, A01, B00, B01, E0, t);
    for (; t < MT; t += 2 * NW) {
        P6B_LOAD_AB(A10, A11, B10, B11, E1, t + NW);
        P6B_LOAD_EID(E0, t + 2 * NW);
        P6B_COMPUTE(A00, A01, B00, B01, t);
        P6B_LOAD_AB(A00, A01, B00, B01, E0, t + 2 * NW);
        P6B_LOAD_EID(E1, t + 3 * NW);
        P6B_COMPUTE(A10, A11, B10, B11, t + NW);
    }
#undef P6B_LOAD_EID
#undef P6B_LOAD_AB
#undef P6B_COMPUTE
#undef BPM
}
#endif
__device__ __forceinline__ void p6b2(Frame& F) { F.fence_ids();
    const float* PD = (const float*)(F.ws + WS_PD); const float* GWp = (const float*)(F.ws + WS_GW); float* ACT = (float*)(F.ws + WS_ACT);
    for (size_t i4 = (size_t)F.bid * 512 + F.tid; i4 < (size_t)MT * 32; i4 += (size_t)F.G * 512) {
        f32x4 s = *(const f32x4*)(PD + i4 * 4);
#pragma unroll
        for (int jj = 1; jj < (MK_U4 ? 4 : 8); ++jj) s += *(const f32x4*)(PD + (size_t)jj * MT * 128 + i4 * 4);
        const f32x4 gw = *(const f32x4*)(GWp + i4 * 4);
        *(f32x4*)(ACT + i4 * 4) = (f32x4){gelu1(s[0]) * gw[0], gelu1(s[1]) * gw[1], gelu1(s[2]) * gw[2], gelu1(s[3]) * gw[3]};
    }
}
__device__ __forceinline__ void p6c(Frame& F) { F.fence_ids();
    const int j = F.bid & 7, nsb = F.G >> 3; if ((F.bid >> 3) >= nsb) return;
    const int wj = (F.bid >> 3) * NWAVES + F.wave, NW = nsb * NWAVES;
    const int lane = F.lane, g8 = lane >> 3, s8 = lane & 7;
    LAS float* Act = (LAS float*)(F.lds + F.wave * 8192); LAS unsigned* Eidl = (LAS unsigned*)(F.lds + F.wave * 8192 + 4096);
    const unsigned char* VE8 = F.ws + WS_VE8 + (size_t)j * 16384 * 128 + 16 * s8; const unsigned* EID = (const unsigned*)(F.ws + WS_EID); const float* ACT = (const float*)(F.ws + WS_ACT);
    float* PEERS = (float*)(F.ws + WS_PEERS) + (size_t)j * MT * 128;
    for (int tg = wj; tg < MT / 8; tg += NW) {
        const size_t t0 = (size_t)tg * 8;
#pragma unroll
        for (int q = 0; q < 4; ++q) { const int idx = 4 * (lane + 64 * q);
            *(LAS f32x4*)(Act + idx) = *(const f32x4*)(ACT + t0 * 128 + idx); *(LAS v4u*)(Eidl + idx) = *(const v4u*)(EID + t0 * 128 + idx); }
        LDS_WAIT(); asm volatile("" ::: "memory");
        f32x2c acc2[8];
#pragma unroll
        for (int e = 0; e < 8; ++e) acc2[e] = (f32x2c){0.f, 0.f};
        LAS const float* ap = Act + g8 * 128; LAS const unsigned* ep = Eidl + g8 * 128;
        v4u va[8], vb[8]; f32x4 aa[2], ab[2];
#define P6C_LOAD(V_, A_, base) do { A_[0] = *(LAS const f32x4*)(ap + (base)); A_[1] = *(LAS const f32x4*)(ap + (base) + 4); const v4u e0_ = *(LAS const v4u*)(ep + (base)), e1_ = *(LAS const v4u*)(ep + (base) + 4); \
            _Pragma("unroll") for (int k = 0; k < 4; ++k) { V_[k] = *(const v4u*)(VE8 + (size_t)e0_[k] * 128); V_[4 + k] = *(const v4u*)(VE8 + (size_t)e1_[k] * 128); } } while (0)
#define P6C_FMA(V_, A_) do { _Pragma("unroll") for (int k = 0; k < 8; ++k) { const float a_ = A_[k >> 2][k & 3]; const f32x2c a2_ = (f32x2c){a_, a_}; _Pragma("unroll") for (int w = 0; w < 4; ++w) { \
            const f32x2c lo_ = __builtin_amdgcn_cvt_pk_f32_fp8((int)V_[k][w], false), hi_ = __builtin_amdgcn_cvt_pk_f32_fp8((int)V_[k][w], true); \
            acc2[2 * w] = __builtin_elementwise_fma(a2_, lo_, acc2[2 * w]); acc2[2 * w + 1] = __builtin_elementwise_fma(a2_, hi_, acc2[2 * w + 1]); } } } while (0)
        P6C_LOAD(va, aa, 0);
        for (int it = 0; it < 128; it += 16) {
            P6C_LOAD(vb, ab, it + 8);
            P6C_FMA(va, aa);
            if (it + 16 < 128) P6C_LOAD(va, aa, it + 16);
            P6C_FMA(vb, ab);
        }
#undef P6C_LOAD
#undef P6C_FMA
        float acc[16];
#pragma unroll
        for (int e = 0; e < 8; ++e) { acc[2 * e] = acc2[e][0]; acc[2 * e + 1] = acc2[e][1]; }
        { float* op = PEERS + (t0 + g8) * 128 + 16 * s8;
#pragma unroll
            for (int q = 0; q < 4; ++q) *(f32x4*)(op + 4 * q) = (f32x4){acc[4 * q] * 0.0625f, acc[4 * q + 1] * 0.0625f, acc[4 * q + 2] * 0.0625f, acc[4 * q + 3] * 0.0625f}; }
        LDS_WAIT(); asm volatile("" ::: "memory");
    }
}
__device__ __forceinline__ void p6d(Frame& F) { F.fence_ids();
    const int gw = F.bid * NWAVES + F.wave, NGW = F.G * NWAVES; const float* PEERS = (const float*)(F.ws + WS_PEERS); const float* gate2 = (const float*)(F.ws + WS_MOD) + 5120;
    f32x4 fg[4];
#pragma unroll
    for (int q = 0; q < 4; ++q) fg[q] = *((const f32x4*)F.final_g + F.lane + 64 * q);
    f32x4 nx[4], np[4];
#define P6D_LOAD(tt) do { _Pragma("unroll") for (int q = 0; q < 4; ++q) { const int d = 4 * F.lane + 256 * q; nx[q] = *((const f32x4*)((const float*)F.dout + (size_t)(tt) * DM) + F.lane + 64 * q); \
        np[q] = *(const f32x4*)(PEERS + ((size_t)(d >> 7) * MT + (tt)) * 128 + (d & 127)); } } while (0)
    if (gw < MT) P6D_LOAD(gw);
    for (int t = gw; t < MT; t += NGW) {
        const int b = t >> 12;
        f32x4* xr = (f32x4*)((float*)F.dout + (size_t)t * DM) + F.lane; f32x4 o[4]; float ss = 0.f;
#pragma unroll
        for (int q = 0; q < 4; ++q) { const int d = 4 * F.lane + 256 * q; const f32x4 g2 = *(const f32x4*)(gate2 + (size_t)b * 6144 + d);
            o[q] = nx[q] + g2 * np[q]; ss += (o[q][0] * o[q][0] + o[q][1] * o[q][1]) + (o[q][2] * o[q][2] + o[q][3] * o[q][3]); }
        if (t + NGW < MT) P6D_LOAD(t + NGW);
        const float rstd = __builtin_amdgcn_rsqf(wave_sum(ss) * (1.f / DM) + EPSN);
#pragma unroll
        for (int q = 0; q < 4; ++q) xr[64 * q] = o[q] * rstd * fg[q];
    }
#undef P6D_LOAD
}

struct Args { const float* in[20]; float* out; unsigned char* ws; int ph_lo, ph_hi, li, pad; };
__global__ void __launch_bounds__(NWAVES * 64, 2) mk_fwd(Args args) {
    extern __shared__ __attribute__((aligned(16))) unsigned char lds_raw[];
    Frame F;
    F.lds = (LAS unsigned char*)lds_raw;
    F.tid = threadIdx.x; F.lane = F.tid & 63; F.wave = __builtin_amdgcn_readfirstlane(F.tid >> 6); F.G = gridDim.x; F.bid = blockIdx.x;
    F.x = args.in[0]; F.c = args.in[1]; F.w_ada = args.in[2]; F.b_ada = args.in[3]; F.norm1_g = args.in[4]; F.w_in = args.in[5]; F.ret_gn_g = args.in[6]; F.sgu_ln_g = args.in[7];
    F.sgu_ln_b = args.in[8]; F.sgu_w = args.in[9]; F.sgu_b = args.in[10]; F.w_ret_out = args.in[11]; F.w_sgu_out = args.in[12]; F.w_out = args.in[13]; F.norm2_g = args.in[14];
    F.peer_w_q = args.in[15]; F.peer_sub_keys = args.in[16]; F.peer_u = args.in[17]; F.peer_v = args.in[18]; F.final_g = args.in[19];
    F.ws = args.ws; F.dout = (unsigned char*)args.out;
    volatile LAS unsigned* MISC = (volatile LAS unsigned*)(F.lds + MISC_OFF); F.misc = MISC;
    if (F.tid < 64) MISC[F.tid] = 0u;
    __syncthreads();
    XcdBarrier bar; bar.bar = (unsigned*)(F.ws + WS_CTL) + CW_BAR; bar.x = 0; bar.st = nullptr;
    if (N_LAUNCHES == 1) bar = xcd_barrier_post((unsigned*)(F.ws + WS_CTL) + CW_BAR, MISC + 8);
    const int lo = args.ph_lo, hi = args.ph_hi;
#define IN(k) (lo <= (k) && (k) < hi)
#if MK_PROBE_HI > 0
#define STAMP(k) do { if (F.bid == 0 && F.wave == 0 && F.lane == 0) { const unsigned long long _t = __builtin_amdgcn_s_memrealtime(); MISC[16 + 2 * (k)] = (unsigned)_t; MISC[17 + 2 * (k)] = (unsigned)(_t >> 32); } } while (0)
#else
#define STAMP(k) do { } while (0)
#endif
#define SEAM(k) do { if (IN(k) && IN((k) + 1)) xcd_barrier(bar); } while (0)
    const float* mod = (const float*)(F.ws + WS_MOD);
    STAMP(0);
    if (IN(0)) { p0a(F); SEAM(0); }
    STAMP(1);
    if (IN(1)) { norm_rows<2>(F, F.x, F.norm1_g, mod + 0, mod + 1024, nullptr, F.dout + DO_H); SEAM(1); }
    STAMP(2);
    if (IN(2)) {
        pg8::Gemm g{(const bf16*)(F.dout + DO_H), (const bf16*)(F.ws + WS_WIN), MT, NIN, 512}; pg8::StaticOrder S; S.init(MT, NIN, F.G, F.bid);
        pg8::EpiProj E{(bf16*)(F.dout + DO_Q), (bf16*)(F.dout + DO_K), (bf16*)(F.ws + WS_V), (bf16*)(F.ws + WS_G), (bf16*)(F.ws + WS_U), (bf16*)(F.ws + WS_SV), (bf16*)(F.ws + WS_GA), (bf16*)(F.ws + WS_GB),
                       (const float*)(F.ws + WS_COS), (const float*)(F.ws + WS_SIN), 1.0f / 4096.0f, (float*)(F.ws + WS_SVSTAT)};
        pg8::gemm_phase<pg8::EpiProj, pg8::StaticOrder, true, true, true>(F.lds, g, S, E);
        SEAM(2);
    }
    STAMP(3);
    if (IN(3)) { p2a(F); SEAM(3); }
    STAMP(4);
    if (IN(4)) { p2b(F); SEAM(4); }
    STAMP(5);
    if (IN(5)) { p2c(F); SEAM(5); }
    STAMP(6);
    if (IN(6)) {
        pg8::StaticOrder S; S.init(MT, DM, F.G, F.bid);
        pg8::Gemm g{(const bf16*)(F.ws + WS_YG8), (const bf16*)(F.ws + WS_WRET), MT, DM, 1024, 512, (const bf16*)(F.ws + WS_YS8), (const bf16*)(F.ws + WS_WSGU), 8};
        pg8::EpiMerged E{(const bf16*)(F.ws + WS_GA), (const bf16*)(F.ws + WS_GB), F.ws + WS_MRG8, 1.0f / 4096.0f};
        pg8::gemm_phase<pg8::EpiMerged, pg8::StaticOrder, true, true, true>(F.lds, g, S, E);
        SEAM(6);
    }
    STAMP(7);
    if (IN(7)) {
        pg8::Gemm g{(const bf16*)(F.ws + WS_MRG8), (const bf16*)(F.ws + WS_WOUT), MT, DM, 512}; pg8::StaticOrder S; S.init(MT, DM, F.G, F.bid);
        pg8::EpiX1 E{F.x, mod + 2048, (float*)F.dout, 1.0f / 4096.0f};
        pg8::gemm_phase<pg8::EpiX1, pg8::StaticOrder, true, true, true>(F.lds, g, S, E);
        SEAM(7);
    }
    STAMP(8);
    if (IN(8)) { norm_rows<1>(F, (const float*)F.dout, F.norm2_g, mod + 3072, mod + 4096, (bf16*)(F.ws + WS_SV), F.ws + WS_H2F8); SEAM(8); }
    STAMP(9);
    if (IN(9)) {
        pg8::Gemm g{(const bf16*)(F.ws + WS_SV), (const bf16*)(F.ws + WS_WQ), MT, 2048, DM}; pg8::StaticOrder S; S.init(MT, 2048, F.G, F.bid);
        pg8::EpiPlain E{(bf16*)(F.ws + WS_GA), 2048};
        pg8::gemm_phase<pg8::EpiPlain, pg8::StaticOrder, true, true>(F.lds, g, S, E);
        SEAM(9);
    }
    STAMP(10);
    if (IN(10)) { p5b(F); SEAM(10); }
    STAMP(11);
    if (IN(11)) { p6a(F); SEAM(11); }
    STAMP(12);
    if (IN(12)) { p6b(F); SEAM(12); }
    STAMP(13);
    if (IN(13)) { p6b2(F); SEAM(13); }
    STAMP(14);
    if (IN(14)) { p6c(F); SEAM(14); }
    STAMP(15);
    if (IN(15)) { p6d(F); }
    STAMP(16);
#if MK_PROBE_HI > 0
    __syncthreads();
    if (F.bid == 0 && F.tid == 0) { const unsigned long long t0 = ((unsigned long long)MISC[17 + 2 * MK_PROBE_LO] << 32) | MISC[16 + 2 * MK_PROBE_LO], t1 = ((unsigned long long)MISC[17 + 2 * MK_PROBE_HI] << 32) | MISC[16 + 2 * MK_PROBE_HI];
#if MK_GPROBE == 1
        ((float*)F.dout)[0] += (float)MISC[56] * 1e-3f; }
#elif MK_GPROBE == 2
        ((float*)F.dout)[0] += (float)MISC[57] * 1e-3f; }
#else
        ((float*)F.dout)[0] += (float)(t1 - t0) * 1e-3f; }
#endif
#endif
#undef IN
#undef SEAM
}

extern "C" void kernel_launch(void* const* d_in, const int* in_sizes, int n_in, void* d_out, int out_size, void* d_ws, size_t ws_size, hipStream_t stream) {
    static int grid = 0;
    if (grid == 0) {
        if (n_in != 20 || out_size != MT * DM || ws_size < WS_END) { fprintf(stderr, "kernel_launch: unexpected shapes (n_in %d, out %d, ws %zu); nothing launched\n", n_in, out_size, ws_size); grid = -1; return; }
        int dev = 0, cus = 0, per_cu = 0;
        if (hipGetDevice(&dev) != hipSuccess || hipDeviceGetAttribute(&cus, hipDeviceAttributeMultiprocessorCount, dev) != hipSuccess) { grid = -1; return; }
        if (hipFuncSetAttribute((const void*)mk_fwd, hipFuncAttributeMaxDynamicSharedMemorySize, LDS_BYTES) != hipSuccess) { fprintf(stderr, "kernel_launch: hipFuncSetAttribute failed\n"); grid = -1; return; }
        if (hipOccupancyMaxActiveBlocksPerMultiprocessor(&per_cu, (const void*)mk_fwd, NWAVES * 64, LDS_BYTES) != hipSuccess || per_cu < 1)
            fprintf(stderr, "kernel_launch: note: occupancy query reports %d workgroups per CU\n", per_cu);
        (void)hipGetLastError();
        grid = cus;
    }
    if (grid < 0) return;
    if (hipMemsetAsync((char*)d_ws + WS_CTL, 0, CTL_ZERO_BYTES, stream) != hipSuccess) { fprintf(stderr, "kernel_launch: memset failed\n"); return; }
    Args a{};
    for (int i = 0; i < 20; ++i) a.in[i] = (const float*)d_in[i];
    a.out = (float*)d_out; a.ws = (unsigned char*)d_ws;
    static_assert(N_LAUNCHES == 1 || N_LAUNCHES == N_PHASES, "N_LAUNCHES is 1 or N_PHASES");
    for (int li = 0; li < N_LAUNCHES && li < MK_MAXPH; ++li) {
        a.ph_lo = (N_LAUNCHES == 1) ? 0 : li; a.ph_hi = (N_LAUNCHES == 1) ? N_PHASES : li + 1; a.li = li;
        hipLaunchKernelGGL(mk_fwd, dim3(grid), dim3(NWAVES * 64), LDS_BYTES, stream, a);
        const hipError_t le = hipPeekAtLastError();
        if (le != hipSuccess) { fprintf(stderr, "kernel_launch: launch %d failed: %s\n", li, hipGetErrorName(le)); break; }
    }
}
```

```cpp
#include <hip/hip_runtime.h>
#include <cstdio>
#include <cstdint>

#ifndef MK_PROBE_LO
#define MK_PROBE_LO 0
#define MK_PROBE_HI 0
#endif
#ifndef MK_GPROBE
#define MK_GPROBE 0
#endif
#define MK_MISC_OFF (147456 - 256)
#ifndef MK_U4
#define MK_U4 1
#endif
#ifndef MK_ALAY
#define MK_ALAY 2
#endif
#ifndef MK_MAXPH
#define MK_MAXPH 16
#endif
#ifndef MK_N_LAUNCHES
#define MK_N_LAUNCHES 1
#endif
namespace pg8 {
#define PG8_LAS __attribute__((address_space(3)))
typedef unsigned short bf16_t;
typedef short bf16x8 __attribute__((ext_vector_type(8)));
typedef float f32x4 __attribute__((ext_vector_type(4)));
typedef unsigned u32x4 __attribute__((ext_vector_type(4)));
constexpr int BM = 256, BK = 64, HALF = 128, HTB = HALF * BK * 2  , STAGE_BYTES = 8 * HTB, NXCD = 8, WGM = 2;

__host__ __device__ __forceinline__ int lds_byte(int r, int c) { const int st = (r >> 4) * 2 + (c >> 5), rr = r & 15, cc = c & 31, ob = rr * 64 + cc * 2; return st * 1024 + (ob ^ (((ob >> 9) & 1) << 5)); }
__host__ __device__ __forceinline__ void stage_rc(int b, int& R, int& C) { const int st = b / 1024, sb = b % 1024, swz = sb ^ (((sb >> 9) & 1) << 5); R = (st >> 1) * 16 + swz / 64; C = (st & 1) * 32 + (swz % 64) / 2; }
__host__ __device__ __forceinline__ int perm32(int rho) { const int n = rho >> 4, i = rho & 15; return 8 * (i >> 2) + 4 * n + (i & 3); }

struct Unit { int pm, pn; };
struct Gemm { const bf16_t* A; const bf16_t* Bt; int M, N, K; int ld = 0; const bf16_t* A2 = nullptr; const bf16_t* Bt2 = nullptr; int ksplit = 0; };

struct StaticOrder {
    int nM, nN, nwg, G, c;
    __host__ __device__ void init(int M, int N, int G_, int c_) { nM = M / BM; nN = N / BM; nwg = nM * nN; G = G_; c = c_; }
    __host__ __device__ bool next(int i, Unit& u) const {
        const long L = (long)i * G + c; if (L >= nwg) return false;
        int wgid = (int)L; { const int q = nwg / NXCD, r = nwg % NXCD, xcd = wgid % NXCD, off = wgid / NXCD; wgid = (xcd < r ? xcd * (q + 1) : r * (q + 1) + (xcd - r) * q) + off; }
        const int nig = WGM * nN, gid = wgid / nig, fm = gid * WGM, gsz = (nM - fm) < WGM ? (nM - fm) : WGM;
        u.pm = fm + ((wgid % nig) % gsz); u.pn = (wgid % nig) / gsz; return true;
    }
    __device__ __forceinline__ void a_ready(const Unit&) const {}
    __device__ __forceinline__ void done(const Unit&) const {}
};

__device__ __forceinline__ unsigned cvt_pk_bf16(float lo, float hi) { unsigned r; asm volatile("v_cvt_pk_bf16_f32 %0, %1, %2" : "=v"(r) : "v"(lo), "v"(hi)); return r; }
typedef float f32x2 __attribute__((ext_vector_type(2)));
__device__ __forceinline__ f32x2 gelu_pk(f32x2 v) {
    const f32x2 av = __builtin_elementwise_abs(v), d = av * 0.2316418882f + 1.0f;
    f32x2 t; t.x = __builtin_amdgcn_rcpf(d.x); t.y = __builtin_amdgcn_rcpf(d.y);
    f32x2 q = t * 0.5307027145f + (-0.7265760135f); q = q * t + 0.7107068705f; q = q * t + (-0.142248368f); q = q * t + 0.127414796f; q = q * t;
    const f32x2 s = (v * v) * (-0.72134752044f);
    f32x2 e; e.x = __builtin_amdgcn_exp2f(s.x); e.y = __builtin_amdgcn_exp2f(s.y);
    const f32x2 m = v * (q * e), r = v - m;
    f32x2 o; o.x = v.x < 0.f ? m.x : r.x; o.y = v.y < 0.f ? m.y : r.y; return o;
}


typedef unsigned u32x2 __attribute__((ext_vector_type(2)));
__device__ __forceinline__ float bflo(unsigned w) { return __uint_as_float(w << 16); }
__device__ __forceinline__ float bfhi(unsigned w) { return __uint_as_float(w & 0xffff0000u); }
__device__ __forceinline__ float gelu1(float v) {
    const float av = __builtin_fabsf(v), t = __builtin_amdgcn_rcpf(av * 0.2316418882f + 1.0f);
    float q = t * 0.5307027145f + (-0.7265760135f); q = q * t + 0.7107068705f; q = q * t + (-0.142248368f); q = q * t + 0.127414796f; q = q * t;
    const float e = __builtin_amdgcn_exp2f((v * v) * (-0.72134752044f));
    const float m = v * (q * e);
    return v < 0.f ? m : v - m;
}
__device__ __forceinline__ float sigm1(float v) { return __builtin_amdgcn_rcpf(1.0f + __builtin_amdgcn_exp2f(v * (-1.44269504089f))); }
__device__ __forceinline__ float silu1(float v) { return v * sigm1(v); }

__device__ __forceinline__ unsigned bperm(int idx, unsigned v) { return (unsigned)__builtin_amdgcn_ds_bpermute(idx, (int)v); }
__device__ __forceinline__ float bpermf(int idx, float v) { return __int_as_float(__builtin_amdgcn_ds_bpermute(idx, __float_as_int(v))); }
__device__ __forceinline__ f32x4 bperm4(int idx, const f32x4& v) { return (f32x4){bpermf(idx, v[0]), bpermf(idx, v[1]), bpermf(idx, v[2]), bpermf(idx, v[3])}; }
__device__ __forceinline__ u32x4 bperm4u(int idx, const u32x4& v) { u32x4 r; r.x = bperm(idx, v.x); r.y = bperm(idx, v.y); r.z = bperm(idx, v.z); r.w = bperm(idx, v.w); return r; }
#define PG8_REMAP() const int lane_ = 16 * fq + fr, pidx = (16 * (lane_ & 3) + (lane_ >> 2)) * 4, fr2 = lane_ >> 2, fq2 = lane_ & 3

struct EpiProj {
    static constexpr bool PERM = true, AFTER_DRAIN = false, HAS_MID = false;
    bf16_t *Q, *Kb, *V, *G, *U, *SV, *GA, *GB; const float *cosT, *sinT; float osc; float* svstat;
    __device__ __forceinline__ void operator()(const f32x4 (&acc)[2][2][4][2], const Unit& u, int wr, int wc, int fr, int fq) const {
        PG8_REMAP();
        const int colt = u.pn * BM; const int row0 = u.pm * BM + wr * 64 + fr2;
        if (colt < 1024) {
            const bool isk = colt >= 512; bf16_t* base = isk ? Kb : Q; const int lc0 = (colt & 511) + wc * 32 + 8 * fq2; const float sc = (isk ? 0.08838834764831845f : 1.0f) * osc;
            const int fi = wc * 16 + 4 * fq2;
#pragma unroll
            for (int ai = 0; ai < 2; ++ai) {
                f32x4 csv[4], snv[4];
#pragma unroll
                for (int m = 0; m < 4; ++m) { const int s = (row0 + ai * HALF + m * 16) & 4095; csv[m] = *(const f32x4*)(cosT + s * 64 + fi) * sc; snv[m] = *(const f32x4*)(sinT + s * 64 + fi) * sc; }
#pragma unroll
                for (int m = 0; m < 4; ++m) { const int row = row0 + ai * HALF + m * 16; const f32x4 cs = csv[m], sn = snv[m];
#pragma unroll
                    for (int bj = 0; bj < 2; ++bj) { const f32x4 v0 = bperm4(pidx, acc[ai][bj][m][0]), v1 = bperm4(pidx, acc[ai][bj][m][1]);
                        u32x4 w;
                        w.x = cvt_pk_bf16(v0[0] * cs[0] - v0[1] * sn[0], v0[0] * sn[0] + v0[1] * cs[0]);
                        w.y = cvt_pk_bf16(v0[2] * cs[1] - v0[3] * sn[1], v0[2] * sn[1] + v0[3] * cs[1]);
                        w.z = cvt_pk_bf16(v1[0] * cs[2] - v1[1] * sn[2], v1[0] * sn[2] + v1[1] * cs[2]);
                        w.w = cvt_pk_bf16(v1[2] * cs[3] - v1[3] * sn[3], v1[2] * sn[3] + v1[3] * cs[3]);
                        *(u32x4*)(base + (size_t)row * 512 + lc0 + bj * HALF) = w; } } }
        } else {
            const int seg = (colt - 1024) >> 10;
            bf16_t* base = seg == 0 ? V : seg == 1 ? G : seg == 2 ? U : seg == 3 ? SV : seg == 4 ? GA : GB;
            const int lc0 = ((colt - 1024) & 1023) + wc * 32 + 8 * fq2;
#pragma unroll
            for (int ai = 0; ai < 2; ++ai)
#pragma unroll
                for (int m = 0; m < 4; ++m) { const int row = row0 + ai * HALF + m * 16; float s1[2] = {0.f, 0.f}, s2[2] = {0.f, 0.f};
#pragma unroll
                    for (int bj = 0; bj < 2; ++bj) { f32x4 v0 = acc[ai][bj][m][0] * osc, v1 = acc[ai][bj][m][1] * osc;
                        if (seg == 1) {
#pragma unroll
                            for (int e = 0; e < 4; ++e) { v0[e] = silu1(v0[e]); v1[e] = silu1(v1[e]); }
                        } else if (seg == 2 || seg == 3) {
                            f32x2 a = gelu_pk((f32x2){v0[0], v0[1]}), b = gelu_pk((f32x2){v0[2], v0[3]}), c = gelu_pk((f32x2){v1[0], v1[1]}), d = gelu_pk((f32x2){v1[2], v1[3]});
                            v0 = (f32x4){a.x, a.y, b.x, b.y}; v1 = (f32x4){c.x, c.y, d.x, d.y};
                        } else if (seg >= 4) {
#pragma unroll
                            for (int e = 0; e < 4; ++e) { v0[e] = sigm1(v0[e]); v1[e] = sigm1(v1[e]); }
                        }
                        if (seg == 3) { s1[bj] = ((v0[0] + v0[1]) + (v0[2] + v0[3])) + ((v1[0] + v1[1]) + (v1[2] + v1[3]));
                            s2[bj] = ((v0[0] * v0[0] + v0[1] * v0[1]) + (v0[2] * v0[2] + v0[3] * v0[3])) + ((v1[0] * v1[0] + v1[1] * v1[1]) + (v1[2] * v1[2] + v1[3] * v1[3])); }
                        u32x4 w; w.x = cvt_pk_bf16(v0[0], v0[1]); w.y = cvt_pk_bf16(v0[2], v0[3]); w.z = cvt_pk_bf16(v1[0], v1[1]); w.w = cvt_pk_bf16(v1[2], v1[3]);
                        *(u32x4*)(base + (size_t)row * 1024 + lc0 + bj * HALF) = bperm4u(pidx, w); }
                    if (seg == 3) {
                        float a = s1[0] + s1[1], b = s2[0] + s2[1];
                        a += __shfl_xor(a, 16); b += __shfl_xor(b, 16); a += __shfl_xor(a, 32); b += __shfl_xor(b, 32);
                        if (fq == 0) { float* sp = svstat + (size_t)(u.pm * BM + wr * 64 + fr + ai * HALF + m * 16) * 2; atomicAdd(sp, a); atomicAdd(sp + 1, b); } } }
        }
    }
};
template <bool ACCUM> struct EpiGate {
    static constexpr bool PERM = true, AFTER_DRAIN = false, HAS_MID = false;
    const bf16_t* GT; bf16_t* TMP; unsigned char* OUT8; float osc;
    __device__ __forceinline__ void operator()(const f32x4 (&acc)[2][2][4][2], const Unit& u, int wr, int wc, int fr, int fq) const {
        PG8_REMAP();
        const int row0 = u.pm * BM + wr * 64 + fr2, col0 = u.pn * BM + wc * 32 + 8 * fq2;
#pragma unroll
        for (int ai = 0; ai < 2; ++ai)
#pragma unroll
            for (int mp = 0; mp < 2; ++mp) {
                u32x4 gv[2][2], pv[2][2];
#pragma unroll
                for (int mm = 0; mm < 2; ++mm)
#pragma unroll
                    for (int bj = 0; bj < 2; ++bj) { const size_t off = (size_t)(row0 + ai * HALF + (2 * mp + mm) * 16) * 1024 + col0 + bj * HALF;
                        gv[mm][bj] = *(const u32x4*)(GT + off); if (ACCUM) pv[mm][bj] = *(const u32x4*)(TMP + off); }
#pragma unroll
                for (int mm = 0; mm < 2; ++mm)
#pragma unroll
                    for (int bj = 0; bj < 2; ++bj) { const int m = 2 * mp + mm; const size_t off = (size_t)(row0 + ai * HALF + m * 16) * 1024 + col0 + bj * HALF;
                        const f32x4 v0 = bperm4(pidx, acc[ai][bj][m][0]) * osc, v1 = bperm4(pidx, acc[ai][bj][m][1]) * osc; const u32x4 g = gv[mm][bj];
                        float o[8] = {v0[0] * bflo(g.x), v0[1] * bfhi(g.x), v0[2] * bflo(g.y), v0[3] * bfhi(g.y), v1[0] * bflo(g.z), v1[1] * bfhi(g.z), v1[2] * bflo(g.w), v1[3] * bfhi(g.w)};
                        if (ACCUM) { const u32x4 p = pv[mm][bj];
                            o[0] += bflo(p.x); o[1] += bfhi(p.x); o[2] += bflo(p.y); o[3] += bfhi(p.y); o[4] += bflo(p.z); o[5] += bfhi(p.z); o[6] += bflo(p.w); o[7] += bfhi(p.w);
                            u32x2 w8; int t0 = __builtin_amdgcn_cvt_pk_fp8_f32(o[0] * 8.f, o[1] * 8.f, 0, false); t0 = __builtin_amdgcn_cvt_pk_fp8_f32(o[2] * 8.f, o[3] * 8.f, t0, true);
                            int t1 = __builtin_amdgcn_cvt_pk_fp8_f32(o[4] * 8.f, o[5] * 8.f, 0, false); t1 = __builtin_amdgcn_cvt_pk_fp8_f32(o[6] * 8.f, o[7] * 8.f, t1, true);
                            w8.x = (unsigned)t0; w8.y = (unsigned)t1; *(u32x2*)(OUT8 + off) = w8;
                        } else {
                            u32x4 w; w.x = cvt_pk_bf16(o[0], o[1]); w.y = cvt_pk_bf16(o[2], o[3]); w.z = cvt_pk_bf16(o[4], o[5]); w.w = cvt_pk_bf16(o[6], o[7]);
                            *(u32x4*)(TMP + off) = w; } }
            }
    }
};
struct EpiMerged {
    static constexpr bool PERM = true, AFTER_DRAIN = false, HAS_MID = true;
    const bf16_t* GA; const bf16_t* GB; unsigned char* OUT8; float osc;
    __device__ __forceinline__ void mid(f32x4 (&acc)[2][2][4][2], const Unit& u, int wr, int wc, int fr, int fq) const {
        int fr_ = fr, fq_ = fq; asm volatile("" : "+v"(fr_), "+v"(fq_));
        const int row0 = u.pm * BM + wr * 64 + fr_, col0 = u.pn * BM + wc * 32 + 8 * fq_;
#pragma unroll
        for (int ai = 0; ai < 2; ++ai)
#pragma unroll
            for (int mp = 0; mp < 2; ++mp) {
                u32x4 av[2][2], bv[2][2];
#pragma unroll
                for (int mm = 0; mm < 2; ++mm)
#pragma unroll
                    for (int bj = 0; bj < 2; ++bj) { const size_t off = (size_t)(row0 + ai * HALF + (2 * mp + mm) * 16) * 1024 + col0 + bj * HALF; av[mm][bj] = *(const u32x4*)(GA + off); bv[mm][bj] = *(const u32x4*)(GB + off); }
#pragma unroll
                for (int mm = 0; mm < 2; ++mm)
#pragma unroll
                    for (int bj = 0; bj < 2; ++bj) { const int m = 2 * mp + mm; const u32x4 a = av[mm][bj], b = bv[mm][bj];
                        acc[ai][bj][m][0][0] *= 2.f * bflo(a.x) * __builtin_amdgcn_rcpf(bflo(b.x)); acc[ai][bj][m][0][1] *= 2.f * bfhi(a.x) * __builtin_amdgcn_rcpf(bfhi(b.x));
                        acc[ai][bj][m][0][2] *= 2.f * bflo(a.y) * __builtin_amdgcn_rcpf(bflo(b.y)); acc[ai][bj][m][0][3] *= 2.f * bfhi(a.y) * __builtin_amdgcn_rcpf(bfhi(b.y));
                        acc[ai][bj][m][1][0] *= 2.f * bflo(a.z) * __builtin_amdgcn_rcpf(bflo(b.z)); acc[ai][bj][m][1][1] *= 2.f * bfhi(a.z) * __builtin_amdgcn_rcpf(bfhi(b.z));
                        acc[ai][bj][m][1][2] *= 2.f * bflo(a.w) * __builtin_amdgcn_rcpf(bflo(b.w)); acc[ai][bj][m][1][3] *= 2.f * bfhi(a.w) * __builtin_amdgcn_rcpf(bfhi(b.w)); }
            }
    }
    __device__ __forceinline__ void operator()(const f32x4 (&acc)[2][2][4][2], const Unit& u, int wr, int wc, int fr, int fq) const {
        PG8_REMAP();
        const int row0 = u.pm * BM + wr * 64 + fr2, col0 = u.pn * BM + wc * 32 + 8 * fq2; const float sc = osc * 8.f;
#pragma unroll
        for (int ai = 0; ai < 2; ++ai)
#pragma unroll
            for (int mp = 0; mp < 2; ++mp) {
                u32x4 gv[2][2];
#pragma unroll
                for (int mm = 0; mm < 2; ++mm)
#pragma unroll
                    for (int bj = 0; bj < 2; ++bj) gv[mm][bj] = *(const u32x4*)(GB + (size_t)(row0 + ai * HALF + (2 * mp + mm) * 16) * 1024 + col0 + bj * HALF);
#pragma unroll
                for (int mm = 0; mm < 2; ++mm)
#pragma unroll
                    for (int bj = 0; bj < 2; ++bj) { const int m = 2 * mp + mm; const size_t off = (size_t)(row0 + ai * HALF + m * 16) * 1024 + col0 + bj * HALF;
                        const f32x4 v0 = bperm4(pidx, acc[ai][bj][m][0]) * sc, v1 = bperm4(pidx, acc[ai][bj][m][1]) * sc; const u32x4 g = gv[mm][bj];
                        u32x2 w8; int t0 = __builtin_amdgcn_cvt_pk_fp8_f32(v0[0] * bflo(g.x), v0[1] * bfhi(g.x), 0, false); t0 = __builtin_amdgcn_cvt_pk_fp8_f32(v0[2] * bflo(g.y), v0[3] * bfhi(g.y), t0, true);
                        int t1 = __builtin_amdgcn_cvt_pk_fp8_f32(v1[0] * bflo(g.z), v1[1] * bfhi(g.z), 0, false); t1 = __builtin_amdgcn_cvt_pk_fp8_f32(v1[2] * bflo(g.w), v1[3] * bfhi(g.w), t1, true);
                        w8.x = (unsigned)t0; w8.y = (unsigned)t1; *(u32x2*)(OUT8 + off) = w8; }
            }
    }
};
struct EpiX1 {
    static constexpr bool PERM = false, AFTER_DRAIN = false, HAS_MID = false;
    const float* X; const float* gate1; float* X1; float osc;
    __device__ __forceinline__ void operator()(const f32x4 (&acc)[2][2][4][2], const Unit& u, int wr, int wc, int fr, int fq) const {
        PG8_REMAP();
        const int row0 = u.pm * BM + wr * 64 + fr2, col0 = u.pn * BM + wc * 32 + 4 * fq2;
        const float* gp = gate1 + (size_t)((u.pm * BM) >> 12) * 6144 + col0;
        f32x4 gv[2][2];
#pragma unroll
        for (int bj = 0; bj < 2; ++bj)
#pragma unroll
            for (int n = 0; n < 2; ++n) gv[bj][n] = *(const f32x4*)(gp + bj * HALF + n * 16) * osc;
#pragma unroll
        for (int ai = 0; ai < 2; ++ai)
#pragma unroll
            for (int mp = 0; mp < 2; ++mp) {
                f32x4 xv[2][2][2];
#pragma unroll
                for (int mm = 0; mm < 2; ++mm) { const size_t off = (size_t)(row0 + ai * HALF + (2 * mp + mm) * 16) * 1024 + col0;
#pragma unroll
                    for (int bj = 0; bj < 2; ++bj)
#pragma unroll
                        for (int n = 0; n < 2; ++n) xv[mm][bj][n] = *(const f32x4*)(X + off + bj * HALF + n * 16); }
#pragma unroll
                for (int mm = 0; mm < 2; ++mm) { const int m = 2 * mp + mm; const size_t off = (size_t)(row0 + ai * HALF + m * 16) * 1024 + col0;
#pragma unroll
                    for (int bj = 0; bj < 2; ++bj)
#pragma unroll
                        for (int n = 0; n < 2; ++n) *(f32x4*)(X1 + off + bj * HALF + n * 16) = xv[mm][bj][n] + gv[bj][n] * bperm4(pidx, acc[ai][bj][m][n]); }
            }
    }
};
struct EpiPlain {
    static constexpr bool PERM = true, AFTER_DRAIN = false, HAS_MID = false;
    bf16_t* O; int ldc;
    __device__ __forceinline__ void operator()(const f32x4 (&acc)[2][2][4][2], const Unit& u, int wr, int wc, int fr, int fq) const {
        PG8_REMAP();
        const int row0 = u.pm * BM + wr * 64 + fr2, col0 = u.pn * BM + wc * 32 + 8 * fq2;
#pragma unroll
        for (int ai = 0; ai < 2; ++ai)
#pragma unroll
            for (int m = 0; m < 4; ++m) { bf16_t* rowp = O + (size_t)(row0 + ai * HALF + m * 16) * ldc + col0;
#pragma unroll
                for (int bj = 0; bj < 2; ++bj) { const f32x4 v0 = acc[ai][bj][m][0], v1 = acc[ai][bj][m][1];
                    u32x4 w; w.x = cvt_pk_bf16(v0[0], v0[1]); w.y = cvt_pk_bf16(v0[2], v0[3]); w.z = cvt_pk_bf16(v1[0], v1[1]); w.w = cvt_pk_bf16(v1[2], v1[3]);
                    *(u32x4*)(rowp + bj * HALF) = bperm4u(pidx, w); } }
    }
};
typedef int v8i_t __attribute__((ext_vector_type(8)));
typedef int v4i_t __attribute__((ext_vector_type(4)));
template <bool F8> __device__ __forceinline__ void mma_block(f32x4 (&acc)[4][2], const bf16x8 (&At)[4][2], const bf16x8 (&Bt)[2][2]) {
    if constexpr (F8) {
        v8i_t bb[2];
#pragma unroll
        for (int n = 0; n < 2; ++n) bb[n] = __builtin_shufflevector(__builtin_bit_cast(v4i_t, Bt[n][0]), __builtin_bit_cast(v4i_t, Bt[n][1]), 0, 1, 2, 3, 4, 5, 6, 7);
#pragma unroll
        for (int m = 0; m < 4; ++m) { const v8i_t aa = __builtin_shufflevector(__builtin_bit_cast(v4i_t, At[m][0]), __builtin_bit_cast(v4i_t, At[m][1]), 0, 1, 2, 3, 4, 5, 6, 7);
#pragma unroll
            for (int n = 0; n < 2; ++n) asm volatile("v_mfma_scale_f32_16x16x128_f8f6f4 %0, %1, %2, %0, %3, %3 op_sel_hi:[0,0,0]" : "+v"(acc[m][n]) : "v"(bb[n]), "v"(aa), "v"(0x7F7F7F7F)); }
    } else {
#pragma unroll
        for (int m = 0; m < 4; ++m)
#pragma unroll
            for (int n = 0; n < 2; ++n)
#pragma unroll
                for (int k = 0; k < 2; ++k) acc[m][n] = __builtin_amdgcn_mfma_f32_16x16x32_bf16(Bt[n][k], At[m][k], acc[m][n], 0, 0, 0);
    }
}
template <class Epi, class Sched, bool ALIGN_EPI = false, bool SP2 = false, bool F8 = false>
__device__ __forceinline__ void gemm_phase(PG8_LAS unsigned char* lds, const Gemm g, const Sched& S, const Epi& E) {
    const int tid = threadIdx.x, wid = __builtin_amdgcn_readfirstlane(tid >> 6), lane = tid & 63, wr = wid >> 2, wc = wid & 3, fr = lane & 15, fq = lane >> 4;
    const int K = g.K, nt = K / BK, LD = g.ld ? g.ld : g.K, nh = g.ksplit ? g.ksplit : nt;
    unsigned voffA[2], voffB[2];
#pragma unroll
    for (int i = 0; i < 2; ++i) { int R, C; stage_rc(tid * 16 + i * 8192, R, C); const int Rb = Epi::PERM ? ((R & ~31) + perm32(R & 31)) : R;
        voffA[i] = (unsigned)(R * LD + C) * 2u; voffB[i] = (unsigned)(Rb * LD + C) * 2u; }
    const size_t kstep = (size_t)(BK * 2);
    const size_t hstep = (size_t)HALF * LD * 2;
    const size_t tstep = 2 * hstep;
    const unsigned ldsw = (unsigned)wid * 1024u;
    const int aoff = lds_byte(wr * 64 + fr, fq * 8), boff = lds_byte(wc * 32 + fr, fq * 8);
#define PG8_SA(b, h) (((b) * 2 + (h)) * HTB)
#define PG8_SB(b, h) ((4 + (b) * 2 + (h)) * HTB)
#define PG8_STAGE(bufoff, gbase, voff) do { _Pragma("unroll") for (int _i = 0; _i < 2; ++_i) \
        __builtin_amdgcn_global_load_lds((const unsigned*)((const char*)(gbase) + (voff)[_i]), (PG8_LAS unsigned*)(lds + (bufoff) + ldsw + _i * 8192), 16, 0, 0); } while (0)
#define PG8_LDA(dst, b, h) do { _Pragma("unroll") for (int m = 0; m < 4; ++m) _Pragma("unroll") for (int k = 0; k < 2; ++k) dst[m][k] = *(const PG8_LAS bf16x8*)(lds + PG8_SA(b, h) + aoff + m * 2048 + k * 1024); } while (0)
#define PG8_LDB(dst, b, h) do { _Pragma("unroll") for (int n = 0; n < 2; ++n) _Pragma("unroll") for (int k = 0; k < 2; ++k) dst[n][k] = *(const PG8_LAS bf16x8*)(lds + PG8_SB(b, h) + boff + n * 2048 + k * 1024); } while (0)
#define PG8_MMA(ai, bj, At, Bt) do { __builtin_amdgcn_s_setprio(1); mma_block<F8>(acc[ai][bj], At, Bt); __builtin_amdgcn_s_setprio(0); } while (0)
#define PG8_WAIT_V(n) asm volatile("s_waitcnt vmcnt(" #n ")" ::: "memory")
#define PG8_WAIT_L(n) asm volatile("s_waitcnt lgkmcnt(" #n ")" ::: "memory")
#define PG8_BAR __builtin_amdgcn_s_barrier()
#define PG8_SCHED __builtin_amdgcn_sched_barrier(0)
    Unit cur, nxt; int ui = 0;
#if MK_GPROBE
    unsigned long long gp_k = 0, gp_e = 0, gp_t = __builtin_amdgcn_s_memrealtime();
#endif
    if (!S.next(0, cur)) return;
    f32x4 acc[2][2][4][2];
#pragma unroll
    for (int a = 0; a < 2; ++a)
#pragma unroll
        for (int b = 0; b < 2; ++b)
#pragma unroll
            for (int m = 0; m < 4; ++m)
#pragma unroll
                for (int n = 0; n < 2; ++n) acc[a][b][m][n] = (f32x4){0.f, 0.f, 0.f, 0.f};
    bf16x8 At[4][2], B0[2][2], B1[2][2];
    const char* cA = (const char*)g.A + (size_t)cur.pm * tstep; const char* cB = (const char*)g.Bt + (size_t)cur.pn * tstep;
    const char* cA2 = g.A2 ? (const char*)g.A2 + (size_t)cur.pm * tstep : cA; const char* cB2 = g.Bt2 ? (const char*)g.Bt2 + (size_t)cur.pn * tstep : cB;
#define PG8_TA(tt) ((tt) < nh ? cA + (size_t)(tt) * kstep : cA2 + (size_t)((tt) - nh) * kstep)
#define PG8_TB(tt) ((tt) < nh ? cB + (size_t)(tt) * kstep : cB2 + (size_t)((tt) - nh) * kstep)
    S.a_ready(cur);
    if constexpr (SP2) {
        PG8_STAGE(PG8_SB(0, 0), cB, voffB); PG8_STAGE(PG8_SB(0, 1), cB + hstep, voffB); PG8_STAGE(PG8_SA(0, 0), cA, voffA); PG8_STAGE(PG8_SA(0, 1), cA + hstep, voffA);
        if (wr == 1) PG8_BAR;
        PG8_WAIT_V(2); PG8_BAR;
        PG8_STAGE(PG8_SB(1, 0), cB + kstep, voffB); PG8_STAGE(PG8_SA(1, 0), cA + kstep, voffA); PG8_STAGE(PG8_SB(1, 1), cB + hstep + kstep, voffB);
        PG8_WAIT_V(6); PG8_BAR;
    } else {
        PG8_STAGE(PG8_SB(0, 0), cB, voffB); PG8_STAGE(PG8_SA(0, 0), cA, voffA); PG8_STAGE(PG8_SB(0, 1), cB + hstep, voffB); PG8_STAGE(PG8_SA(0, 1), cA + hstep, voffA);
        if (wr == 1) PG8_BAR;
        PG8_WAIT_V(4); PG8_BAR;
        PG8_STAGE(PG8_SB(1, 0), cB + kstep, voffB); PG8_STAGE(PG8_SA(1, 0), cA + kstep, voffA); PG8_STAGE(PG8_SB(1, 1), cB + hstep + kstep, voffB);
        PG8_WAIT_V(6); PG8_BAR;
    }
    for (;;) {
        const bool has_next = S.next(ui + 1, nxt);
        const char* nA = has_next ? (const char*)g.A + (size_t)nxt.pm * tstep : cA; const char* nB = has_next ? (const char*)g.Bt + (size_t)nxt.pn * tstep : cB;
#pragma clang loop unroll(disable)
        for (int t = 0; t < nt; t += 2) {
            const bool last = (t == nt - 2);
            const char* a1 = PG8_TA(t + 1);
            const char* a2 = last ? nA : PG8_TA(t + 2); const char* b2 = last ? nB : PG8_TB(t + 2);
            const char* a3 = last ? nA + kstep : PG8_TA(t + 3); const char* b3 = last ? nB + kstep : PG8_TB(t + 3);
            if constexpr (Epi::HAS_MID) { if (t == nh) { if constexpr (F8) asm volatile("s_nop 15\n\ts_nop 15" ::: "memory"); E.mid(acc, cur, wr, wc, fr, fq); } }
            if (last && has_next) S.a_ready(nxt);
            if constexpr (SP2) {
            PG8_LDB(B0, 0, 0); PG8_LDB(B1, 0, 1); PG8_SCHED; PG8_LDA(At, 0, 0); PG8_STAGE(PG8_SA(1, 1), a1 + hstep, voffA);
            PG8_WAIT_V(8); PG8_WAIT_L(0); PG8_BAR; PG8_MMA(0, 0, At, B0); PG8_MMA(0, 1, At, B1); PG8_BAR; PG8_SCHED;
            PG8_LDA(At, 0, 1); PG8_STAGE(PG8_SB(0, 0), b2, voffB); PG8_STAGE(PG8_SB(0, 1), b2 + hstep, voffB); PG8_STAGE(PG8_SA(0, 0), a2, voffA);
            PG8_WAIT_V(8); PG8_WAIT_L(0); PG8_BAR; PG8_MMA(1, 0, At, B0); PG8_MMA(1, 1, At, B1); PG8_BAR; PG8_SCHED;
            PG8_LDB(B0, 1, 0); PG8_LDB(B1, 1, 1); PG8_SCHED; PG8_LDA(At, 1, 0); PG8_STAGE(PG8_SA(0, 1), a2 + hstep, voffA);
            PG8_WAIT_V(8); PG8_WAIT_L(0); PG8_BAR; PG8_MMA(0, 0, At, B0); PG8_MMA(0, 1, At, B1); PG8_BAR; PG8_SCHED;
            PG8_LDA(At, 1, 1); PG8_STAGE(PG8_SB(1, 0), b3, voffB); PG8_STAGE(PG8_SB(1, 1), b3 + hstep, voffB); PG8_STAGE(PG8_SA(1, 0), a3, voffA);
            PG8_WAIT_V(8); PG8_WAIT_L(0); PG8_BAR; PG8_MMA(1, 0, At, B0); PG8_MMA(1, 1, At, B1); PG8_BAR; PG8_SCHED;
            } else {
            PG8_LDB(B0, 0, 0); PG8_SCHED; PG8_LDA(At, 0, 0); PG8_STAGE(PG8_SA(1, 1), a1 + hstep, voffA);
            PG8_WAIT_L(8); PG8_BAR; PG8_WAIT_L(0); PG8_MMA(0, 0, At, B0); PG8_BAR; PG8_SCHED;
            PG8_LDB(B1, 0, 1); PG8_STAGE(PG8_SB(0, 0), b2, voffB);
            PG8_BAR; PG8_WAIT_L(0); PG8_MMA(0, 1, At, B1); PG8_BAR;
            PG8_LDA(At, 0, 1); PG8_STAGE(PG8_SA(0, 0), a2, voffA);
            PG8_BAR; PG8_WAIT_L(0); PG8_MMA(1, 0, At, B0); PG8_BAR; PG8_SCHED;
            PG8_STAGE(PG8_SB(0, 1), b2 + hstep, voffB);
            PG8_WAIT_V(6); PG8_BAR; PG8_MMA(1, 1, At, B1); PG8_BAR;
            PG8_LDB(B0, 1, 0); PG8_SCHED; PG8_LDA(At, 1, 0); PG8_STAGE(PG8_SA(0, 1), a2 + hstep, voffA);
            PG8_WAIT_L(8); PG8_BAR; PG8_WAIT_L(0); PG8_MMA(0, 0, At, B0); PG8_BAR; PG8_SCHED;
            PG8_LDB(B1, 1, 1); PG8_STAGE(PG8_SB(1, 0), b3, voffB);
            PG8_BAR; PG8_WAIT_L(0); PG8_MMA(0, 1, At, B1); PG8_BAR;
            PG8_LDA(At, 1, 1); PG8_STAGE(PG8_SA(1, 0), a3, voffA);
            PG8_BAR; PG8_WAIT_L(0); PG8_MMA(1, 0, At, B0); PG8_BAR; PG8_SCHED;
            PG8_STAGE(PG8_SB(1, 1), b3 + hstep, voffB);
            PG8_WAIT_V(6); PG8_BAR; PG8_MMA(1, 1, At, B1); PG8_BAR;
            }
        }
#if MK_GPROBE
        { const unsigned long long t_ = __builtin_amdgcn_s_memrealtime(); gp_k += t_ - gp_t; gp_t = t_; }
#endif
        if constexpr (F8) asm volatile("s_nop 15\n\ts_nop 15" ::: "memory");
        if constexpr (ALIGN_EPI) { if (wr == 0) PG8_BAR; }
        if constexpr (!Epi::AFTER_DRAIN) { E(acc, cur, wr, wc, fr, fq); S.done(cur); }
#if MK_GPROBE
        { asm volatile("s_waitcnt vmcnt(0)" ::: "memory"); const unsigned long long t_ = __builtin_amdgcn_s_memrealtime(); gp_e += t_ - gp_t; gp_t = t_; }
#endif
        if (!has_next) break;
#pragma unroll
        for (int a = 0; a < 2; ++a)
#pragma unroll
            for (int b = 0; b < 2; ++b)
#pragma unroll
                for (int m = 0; m < 4; ++m)
#pragma unroll
                    for (int n = 0; n < 2; ++n) acc[a][b][m][n] = (f32x4){0.f, 0.f, 0.f, 0.f};
        cur = nxt; cA = nA; cB = nB; ++ui;
        cA2 = g.A2 ? (const char*)g.A2 + (size_t)cur.pm * tstep : cA; cB2 = g.Bt2 ? (const char*)g.Bt2 + (size_t)cur.pn * tstep : cB;
        if constexpr (ALIGN_EPI) { if (wr == 1) PG8_BAR; }
    }
    PG8_WAIT_V(0);
    if constexpr (!ALIGN_EPI) { if (wr == 0) PG8_BAR; }
    PG8_BAR;
    if constexpr (Epi::AFTER_DRAIN) { E.fused(acc, cur, wr, wc, fr, fq, lds, wid, lane); S.done(cur); }
#if MK_GPROBE
    if (blockIdx.x == 0 && wid == 0 && lane == 0) { PG8_LAS unsigned* mq = (PG8_LAS unsigned*)(lds + MK_MISC_OFF); mq[56] += (unsigned)gp_k; mq[57] += (unsigned)gp_e; }
#endif
#undef PG8_SA
#undef PG8_SB
#undef PG8_TA
#undef PG8_TB
#undef PG8_STAGE
#undef PG8_LDA
#undef PG8_LDB
#undef PG8_MMA
#undef PG8_WAIT_V
#undef PG8_WAIT_L
#undef PG8_BAR
#undef PG8_SCHED
}
}

constexpr int NWAVES = 8;
constexpr int N_LAUNCHES = MK_N_LAUNCHES;
constexpr int N_PHASES = 16;
constexpr int NB = 8, SEQ = 4096, DM = 1024, MT = NB * SEQ, NIN = 7168;
constexpr float EPSN = 1e-6f;

constexpr size_t MiB = 1u << 20;
constexpr size_t WS_CTL = 0, CTL_ZERO_BYTES = 1 * MiB;
constexpr size_t WS_SVSTAT = 512 * 1024;
constexpr size_t WS_MOD = 1 * MiB;
constexpr size_t WS_COS = 2 * MiB, WS_SIN = 3 * MiB;
constexpr size_t WS_SK = 4 * MiB;
constexpr size_t WS_SGUW = 4 * MiB + 512 * 1024;
constexpr size_t WS_WRET = 6 * MiB, WS_WSGU = 8 * MiB, WS_WOUT = 10 * MiB, WS_WQ = 12 * MiB, WS_WIN = 16 * MiB;
constexpr size_t WS_UE8 = 32 * MiB, WS_VE8 = 48 * MiB;
constexpr size_t WS_YG8 = 288 * MiB;
constexpr size_t WS_YS8 = 480 * MiB;
constexpr size_t WS_MRG8 = 96 * MiB;
constexpr size_t WS_ACT = 288 * MiB;
constexpr size_t WS_PEERS = 352 * MiB;
constexpr size_t WS_H2F8 = 96 * MiB;
constexpr size_t WS_EID = 128 * MiB, WS_GW = 144 * MiB;
constexpr size_t WS_PD = 160 * MiB;
constexpr size_t WS_V = 96 * MiB;
constexpr size_t WS_G = 160 * MiB;
constexpr size_t WS_U = 224 * MiB;
constexpr size_t WS_SV = 288 * MiB;
constexpr size_t WS_GA = 352 * MiB, WS_GB = 416 * MiB;
constexpr size_t WS_SUB = 480 * MiB;
constexpr size_t WS_END = 512 * MiB;
constexpr size_t DO_H = 0, DO_Q = 64 * MiB, DO_K = 96 * MiB, DO_KVS = 0;

constexpr int CW_BAR = 4096;
constexpr int LDS_BYTES = 147456;
constexpr int MISC_OFF = LDS_BYTES - 256;

#define GAS __attribute__((address_space(1)))
#define LAS __attribute__((address_space(3)))
typedef unsigned short bf16;
typedef unsigned v4u __attribute__((ext_vector_type(4)));
typedef unsigned v2u __attribute__((ext_vector_type(2)));
typedef float f32x4 __attribute__((ext_vector_type(4)));
typedef float f32x2v __attribute__((ext_vector_type(2)));
typedef short bf16x8 __attribute__((ext_vector_type(8)));
typedef short s16x4 __attribute__((ext_vector_type(4)));
typedef __bf16 bf16x2_t __attribute__((ext_vector_type(2)));
typedef GAS unsigned gu32;
#define RLX_AGENT __ATOMIC_RELAXED, __HIP_MEMORY_SCOPE_AGENT
#define LDS_WAIT() asm volatile("s_waitcnt lgkmcnt(0)" ::: "memory")
using pg8::bflo; using pg8::bfhi; using pg8::gelu1;
__device__ __forceinline__ unsigned pk2(float lo, float hi) { f32x2v v = {lo, hi}; bf16x2_t b = __builtin_convertvector(v, bf16x2_t); return __builtin_bit_cast(unsigned, b); }
template <int CTRL> __device__ __forceinline__ float dpp_f(float v) { return __int_as_float(__builtin_amdgcn_update_dpp(0, __float_as_int(v), CTRL, 0xF, 0xF, false)); }
__device__ __forceinline__ float wave_sum(float v) {
    v += dpp_f<0xB1>(v); v += dpp_f<0x4E>(v); v += dpp_f<0x141>(v); v += dpp_f<0x140>(v);
    const int vi = __float_as_int(v);
    return (__int_as_float(__builtin_amdgcn_readlane(vi, 0)) + __int_as_float(__builtin_amdgcn_readlane(vi, 16))) + (__int_as_float(__builtin_amdgcn_readlane(vi, 32)) + __int_as_float(__builtin_amdgcn_readlane(vi, 48)));
}
__device__ __forceinline__ float fexp2(float x) { return __builtin_amdgcn_exp2f(x); }
__device__ __forceinline__ float clamp_f8(float x) { return __builtin_amdgcn_fmed3f(x, -448.0f, 448.0f); }
__device__ __forceinline__ unsigned pk4_fp8(float a, float b, float c, float d) { int w = __builtin_amdgcn_cvt_pk_fp8_f32(clamp_f8(a), clamp_f8(b), 0, false); w = __builtin_amdgcn_cvt_pk_fp8_f32(clamp_f8(c), clamp_f8(d), w, true); return (unsigned)w; }
__device__ __forceinline__ float rl_f(float v, int l) { return __int_as_float(__builtin_amdgcn_readlane(__float_as_int(v), l)); }
__device__ __forceinline__ unsigned rl_u(unsigned v, int l) { return (unsigned)__builtin_amdgcn_readlane((int)v, l); }

#define XB_TMO      128
#define XB_XCNT(j)  (256  + 64 * (j))
#define XB_XSUB(j)  (1280 + 64 * (j))
#define XB_XGEN(j)  (2304 + 64 * (j))
#define XB_TOP      3328
#define XB_TOPGEN   3392
#define XCD_BAR_WORDS 3456
#define XB_SPIN_CAP (1u << 22)
__device__ __forceinline__ unsigned xb_ld(unsigned* p)              { return __hip_atomic_load(p, __ATOMIC_RELAXED, __HIP_MEMORY_SCOPE_AGENT); }
__device__ __forceinline__ unsigned xb_add(unsigned* p, unsigned v) { return __hip_atomic_fetch_add(p, v, __ATOMIC_RELAXED, __HIP_MEMORY_SCOPE_AGENT); }
__device__ __forceinline__ unsigned xb_xcc_id() { return (unsigned)__builtin_amdgcn_s_getreg((3 << 11) | 20) & 0xFu; }
#define XB_SPIN(cond, bar) do { unsigned _sp = 0; while (cond) { __builtin_amdgcn_s_sleep(1); \
    if ((++_sp & 255u) == 0u) { if (xb_ld(&(bar)[XB_TMO])) break; if (_sp > XB_SPIN_CAP) { atomicAdd(&(bar)[XB_TMO], 1u); break; } } } } while (0)
struct XcdBarrier { unsigned* bar; unsigned x; volatile LAS unsigned* st; };
__device__ __forceinline__ XcdBarrier xcd_barrier_post(unsigned* bar, volatile LAS unsigned* st) {
    XcdBarrier b; b.bar = bar; b.x = xb_xcc_id(); b.st = st;
    if (threadIdx.x == 0) (void)xb_add(&bar[XB_XCNT(b.x)], 1u);
    return b;
}
__device__ __forceinline__ void xcd_barrier_complete(unsigned* bar, unsigned x, unsigned& nloc, unsigned& nx) {
    const unsigned G = gridDim.x * gridDim.y * gridDim.z;
    unsigned sum, cnt, mine, sp = 0u;
    for (;;) {
        sum = 0u; cnt = 0u; mine = 0u;
#pragma unroll
        for (unsigned j = 0; j < 16; ++j) { const unsigned c = xb_ld(&bar[XB_XCNT(j)]); sum += c; cnt += (c > 0u) ? 1u : 0u; mine = (j == x) ? c : mine; }
        if (sum == G) break;
        __builtin_amdgcn_s_sleep(1);
        if ((++sp & 255u) == 0u) { if (xb_ld(&bar[XB_TMO])) break; if (sp > XB_SPIN_CAP) { atomicAdd(&bar[XB_TMO], 1u); break; } }
    }
    nloc = mine > 0u ? mine : 1u; nx = cnt > 0u ? cnt : 1u;
}
__device__ __forceinline__ void xcd_barrier(const XcdBarrier& b) {
    asm volatile("s_waitcnt vmcnt(0)" ::: "memory");
    __syncthreads();
    if (threadIdx.x == 0) {
        unsigned* bar = b.bar;
        __builtin_amdgcn_s_waitcnt(0);
        unsigned nloc = b.st[0], nx = b.st[1];
        if (nloc == 0u) { xcd_barrier_complete(bar, b.x, nloc, nx); b.st[0] = nloc; b.st[1] = nx; }
        const unsigned old = xb_add(&bar[XB_XSUB(b.x)], 1u);
        const unsigned gen = old / nloc;
        if (old + 1u == (gen + 1u) * nloc) {
            __builtin_amdgcn_fence(__ATOMIC_RELEASE, "agent");
            asm volatile("s_waitcnt vmcnt(0)" ::: "memory");
            const unsigned og = xb_add(&bar[XB_TOP], 1u);
            const unsigned tg = og / nx;
            if (og + 1u == (tg + 1u) * nx) xb_add(&bar[XB_TOPGEN], 1u);
            else XB_SPIN(xb_ld(&bar[XB_TOPGEN]) == tg, bar);
            __builtin_amdgcn_fence(__ATOMIC_ACQUIRE, "agent");
            xb_add(&bar[XB_XGEN(b.x)], 1u);
            asm volatile("s_waitcnt vmcnt(0)" ::: "memory");
        } else {
            XB_SPIN(xb_ld(&bar[XB_XGEN(b.x)]) == gen, bar);
            __builtin_amdgcn_fence(__ATOMIC_ACQUIRE, "agent");
            asm volatile("s_waitcnt vmcnt(0)" ::: "memory");
        }
    }
    __syncthreads();
}

struct Frame {
    LAS unsigned char* lds;
    int tid, lane, wave, G, bid; volatile LAS unsigned* misc;
    __device__ __forceinline__ void fence_ids() { int t = threadIdx.x; asm volatile("" : "+v"(t)); tid = t; lane = t & 63; }
    const float *x, *c, *w_ada, *b_ada, *norm1_g, *w_in, *ret_gn_g, *sgu_ln_g, *sgu_ln_b, *sgu_w, *sgu_b, *w_ret_out, *w_sgu_out, *w_out, *norm2_g, *peer_w_q, *peer_sub_keys, *peer_u, *peer_v, *final_g;
    unsigned char* ws; unsigned char* dout;
};

__device__ __forceinline__ bf16x8 lds_row_frag(LAS const unsigned char* img, int stride, int r0, int k0, int lane) {
    return *(LAS const bf16x8*)(img + (r0 + (lane & 15)) * stride + (k0 + 8 * (lane >> 4)) * 2);
}
__device__ __forceinline__ s16x4 tr16(LAS const unsigned char* p) { return __builtin_bit_cast(s16x4, __builtin_amdgcn_ds_read_tr16_b64_v4i16((LAS s16x4*)p)); }
__device__ __forceinline__ bf16x8 lds_tr_frag(LAS const unsigned char* img, int stride, int k0, int n0, int lane) {
    const int g = lane >> 4, q = (lane >> 2) & 3, p = lane & 3;
    LAS const unsigned char* a = img + (k0 + 8 * g + q) * stride + (n0 + 4 * p) * 2;
    const s16x4 lo = tr16(a), hi = tr16(a + 4 * stride);
    return __builtin_shufflevector(lo, hi, 0, 1, 2, 3, 4, 5, 6, 7);
}
#define MFMA16(a, b, c) __builtin_amdgcn_mfma_f32_16x16x32_bf16((a), (b), (c), 0, 0, 0)
constexpr int KS = 272, VS = 528;

template <bool F8, class Map>
__device__ __forceinline__ void transpose_item(const float* W, int K, int N, bf16* WT, LAS float* scr, int item, int lane, Map srcmap) {
    const int nblk = N / 32, kb = item / nblk, nb = item % nblk, k0 = 64 * kb, n0 = 32 * nb;
    const int sc = srcmap(n0 + (lane & 31));
#pragma unroll 8
    for (int i = 0; i < 32; ++i) { const int kk = 2 * i + (lane >> 5); scr[kk * 33 + (lane & 31)] = W[(size_t)(k0 + kk) * N + sc]; }
    LDS_WAIT(); asm volatile("" ::: "memory");
    const int c = lane & 7;
#pragma unroll
    for (int j = 0; j < 4; ++j) { const int n = (lane >> 3) + 8 * j; const LAS float* s = scr + (8 * c) * 33 + n;
        if (F8) { v2u o8; o8.x = pk4_fp8(s[0 * 33] * 512.f, s[1 * 33] * 512.f, s[2 * 33] * 512.f, s[3 * 33] * 512.f); o8.y = pk4_fp8(s[4 * 33] * 512.f, s[5 * 33] * 512.f, s[6 * 33] * 512.f, s[7 * 33] * 512.f);
            *(v2u*)((unsigned char*)WT + (size_t)(n0 + n) * K + k0 + 8 * c) = o8; }
        else { v4u o; o.x = pk2(s[0 * 33], s[1 * 33]); o.y = pk2(s[2 * 33], s[3 * 33]); o.z = pk2(s[4 * 33], s[5 * 33]); o.w = pk2(s[6 * 33], s[7 * 33]);
            *(v4u*)(WT + (size_t)(n0 + n) * K + k0 + 8 * c) = o; } }
    LDS_WAIT(); asm volatile("" ::: "memory");
}
struct MapId { __device__ __forceinline__ int operator()(int n) const { return n; } };
struct MapWin { __device__ __forceinline__ int operator()(int n) const { if (n >= 1024) return n; const int ci = n & 127; return (n & ~127) + (ci >> 1) + 64 * (ci & 1); } };

__device__ __forceinline__ void cvt8(const float* src, bf16* dst, size_t chunk) {
    const f32x4 a = *(const f32x4*)(src + chunk * 8), b = *(const f32x4*)(src + chunk * 8 + 4);
    v4u o; o.x = pk2(a[0], a[1]); o.y = pk2(a[2], a[3]); o.z = pk2(b[0], b[1]); o.w = pk2(b[2], b[3]);
    *(v4u*)(dst + chunk * 8) = o;
}

__device__ __forceinline__ void p0a(Frame& F) { F.fence_ids();
    if (F.bid < 192) {
        LAS float* sc = (LAS float*)F.lds; LAS float* part = (LAS float*)(F.lds + 32768);
        for (int i = F.tid; i < 8192; i += 512) { const float cv = F.c[i]; sc[i] = pg8::silu1(cv); }
        __syncthreads();
        const int n0 = 32 * F.bid, ks = F.tid >> 3, c4 = F.tid & 7;
        f32x4 acc[8];
#pragma unroll
        for (int b = 0; b < 8; ++b) acc[b] = (f32x4){0.f, 0.f, 0.f, 0.f};
        for (int kk = ks; kk < 1024; kk += 64) { const f32x4 w = *(const f32x4*)(F.w_ada + (size_t)kk * 6144 + n0 + 4 * c4);
#pragma unroll
            for (int b = 0; b < 8; ++b) acc[b] += w * sc[b * 1024 + kk]; }
#pragma unroll
        for (int b = 0; b < 8; ++b) *(LAS f32x4*)(part + (ks * 8 + b) * 32 + 4 * c4) = acc[b];
        __syncthreads();
        if (F.tid < 256) { const int b = F.tid >> 5, col = F.tid & 31; float s = 0.f;
            for (int k2 = 0; k2 < 64; ++k2) s += part[(k2 * 8 + b) * 32 + col];
            ((float*)(F.ws + WS_MOD))[b * 6144 + n0 + col] = s + F.b_ada[n0 + col]; }
        __syncthreads();
    }
    {
        LAS float* scr = (LAS float*)(F.lds + F.wave * 16384);
        const int gw = F.bid * NWAVES + F.wave, NGW = F.G * NWAVES;
        constexpr int I_IN = 16 * (NIN / 32), I_SQ = 16 * 32, I_Q = 16 * 64, NITEMS = I_IN + 3 * I_SQ + I_Q;
        for (int it = gw; it < NITEMS; it += NGW) {
            int r = it;
            if (r < I_IN) { transpose_item<true>(F.w_in, 1024, NIN, (bf16*)(F.ws + WS_WIN), scr, r, F.lane, MapWin()); continue; } r -= I_IN;
            if (r < I_SQ) { transpose_item<true>(F.w_ret_out, 1024, 1024, (bf16*)(F.ws + WS_WRET), scr, r, F.lane, MapId()); continue; } r -= I_SQ;
            if (r < I_SQ) { transpose_item<true>(F.w_sgu_out, 1024, 1024, (bf16*)(F.ws + WS_WSGU), scr, r, F.lane, MapId()); continue; } r -= I_SQ;
            if (r < I_SQ) { transpose_item<true>(F.w_out, 1024, 1024, (bf16*)(F.ws + WS_WOUT), scr, r, F.lane, MapId()); continue; } r -= I_SQ;
            transpose_item<false>(F.peer_w_q, 1024, 2048, (bf16*)(F.ws + WS_WQ), scr, r, F.lane, MapId());
        }
    }
    const size_t gt = (size_t)F.bid * 512 + F.tid, NT = (size_t)F.G * 512;
    for (size_t ch = gt; ch < (size_t)16384 * 64; ch += NT) {
        const f32x4* up = (const f32x4*)(F.peer_u + ch * 16); const f32x4* vp = (const f32x4*)(F.peer_v + ch * 16);
        v4u ou, ov;
#pragma unroll
        for (int q = 0; q < 4; ++q) { const f32x4 a = up[q] * 512.0f, b = vp[q] * 16.0f; ou[q] = pk4_fp8(a[0], a[1], a[2], a[3]); ov[q] = pk4_fp8(b[0], b[1], b[2], b[3]); }
        const size_t e_ = ch >> 6, c16_ = ch & 63, dst_ = (c16_ >> 3) * ((size_t)16384 * 128) + e_ * 128 + (c16_ & 7) * 16;
        *(v4u*)(F.ws + WS_VE8 + dst_) = ov;
        if (MK_U4) {
            v2u o4; unsigned w0 = 0u, w1 = 0u;
            { const f32x4 a0 = up[0] * 64.0f, a1 = up[1] * 64.0f, a2 = up[2] * 64.0f, a3 = up[3] * 64.0f;
              w0 = __builtin_amdgcn_cvt_scalef32_pk_fp4_f32(w0, a0[0], a0[1], 1.0f, 0); w0 = __builtin_amdgcn_cvt_scalef32_pk_fp4_f32(w0, a0[2], a0[3], 1.0f, 1);
              w0 = __builtin_amdgcn_cvt_scalef32_pk_fp4_f32(w0, a1[0], a1[1], 1.0f, 2); w0 = __builtin_amdgcn_cvt_scalef32_pk_fp4_f32(w0, a1[2], a1[3], 1.0f, 3);
              w1 = __builtin_amdgcn_cvt_scalef32_pk_fp4_f32(w1, a2[0], a2[1], 1.0f, 0); w1 = __builtin_amdgcn_cvt_scalef32_pk_fp4_f32(w1, a2[2], a2[3], 1.0f, 1);
              w1 = __builtin_amdgcn_cvt_scalef32_pk_fp4_f32(w1, a3[0], a3[1], 1.0f, 2); w1 = __builtin_amdgcn_cvt_scalef32_pk_fp4_f32(w1, a3[2], a3[3], 1.0f, 3); }
            o4.x = w0; o4.y = w1;
            *(v2u*)(F.ws + WS_UE8 + (c16_ >> 4) * ((size_t)16384 * 128) + e_ * 128 + (c16_ & 15) * 8) = o4;
        } else *(v4u*)(F.ws + WS_UE8 + dst_) = ou; }
    for (size_t ch = gt; ch < (size_t)32768; ch += NT) cvt8(F.peer_sub_keys, (bf16*)(F.ws + WS_SK), ch);
    for (size_t ch = gt; ch < (size_t)8192; ch += NT) { const int t = (int)(ch >> 4) & 127, s0 = (int)(ch & 15) * 8;
        const f32x4 a = *(const f32x4*)(F.sgu_w + ch * 8), b = *(const f32x4*)(F.sgu_w + ch * 8 + 4);
        float v[8] = {a[0], a[1], a[2], a[3], b[0], b[1], b[2], b[3]};
#pragma unroll
        for (int e = 0; e < 8; ++e) v[e] = (s0 + e <= t) ? v[e] : 0.f;
        v4u o; o.x = pk2(v[0], v[1]); o.y = pk2(v[2], v[3]); o.z = pk2(v[4], v[5]); o.w = pk2(v[6], v[7]);
        *(v4u*)((bf16*)(F.ws + WS_SGUW) + ch * 8) = o; }
    for (size_t e = gt; e < (size_t)4096 * 64; e += NT) { const int s = (int)(e >> 6), i = (int)(e & 63);
        const float inv = fexp2(-(float)i * (13.287712379549449f / 64.0f));
        const float rev = ((float)s * inv) * 0.15915494309189535f; const float fr = rev - __builtin_floorf(rev);
        ((float*)(F.ws + WS_COS))[e] = __builtin_amdgcn_cosf(fr); ((float*)(F.ws + WS_SIN))[e] = __builtin_amdgcn_sinf(fr); }
}

template <int MODE  > __device__ __forceinline__ void norm_rows(Frame& F, const float* X, const float* gain, const float* shift, const float* scale, bf16* O, unsigned char* O8) { F.fence_ids();
    const int gw = F.bid * NWAVES + F.wave, NGW = F.G * NWAVES;
    f32x4 g[4];
#pragma unroll
    for (int j = 0; j < 4; ++j) g[j] = *(const f32x4*)(gain + 4 * F.lane + 256 * j);
    f32x4 nx[4];
    if (gw < MT) {
#pragma unroll
        for (int j = 0; j < 4; ++j) nx[j] = *((const f32x4*)(X + (size_t)gw * DM) + F.lane + 64 * j); }
    for (int m = gw; m < MT; m += NGW) {
        f32x4 v[4]; float s = 0.f;
#pragma unroll
        for (int j = 0; j < 4; ++j) { v[j] = nx[j]; s += (v[j][0] * v[j][0] + v[j][1] * v[j][1]) + (v[j][2] * v[j][2] + v[j][3] * v[j][3]); }
        const int b = m >> 12;
        f32x4 sh[4], sc[4];
#pragma unroll
        for (int j = 0; j < 4; ++j) { const int d = 4 * F.lane + 256 * j; sh[j] = *(const f32x4*)(shift + b * 6144 + d); sc[j] = *(const f32x4*)(scale + b * 6144 + d); }
        if (m + NGW < MT) {
#pragma unroll
            for (int j = 0; j < 4; ++j) nx[j] = *((const f32x4*)(X + (size_t)(m + NGW) * DM) + F.lane + 64 * j); }
        const float rstd = __builtin_amdgcn_rsqf(wave_sum(s) * (1.f / DM) + EPSN);
        v2u* o8 = (v2u*)(O + (size_t)m * DM) + F.lane;
#pragma unroll
        for (int j = 0; j < 4; ++j) { const int d = 4 * F.lane + 256 * j;
            const f32x4 h = v[j] * rstd * g[j] * (sc[j] + 1.0f) + sh[j];
            if (MODE == 2) { const f32x4 h8 = h * 8.0f; *(unsigned*)(O8 + (size_t)m * DM + d) = pk4_fp8(h8[0], h8[1], h8[2], h8[3]); }
            else { v2u w; w.x = pk2(h[0], h[1]); w.y = pk2(h[2], h[3]); o8[64 * j] = w; }
            if (MODE == 1) { const f32x4 hs = h * 16.0f; *(unsigned*)(O8 + (size_t)(d >> 8) * ((size_t)MT * 256) + (size_t)m * 256 + (d & 255)) = pk4_fp8(hs[0], hs[1], hs[2], hs[3]); } }
    }
}

__device__ __forceinline__ float lg_gamma(int h) { return __builtin_log2f(1.0f - fexp2((float)(-5 - h))); }
__device__ __forceinline__ v4u scale8(v4u w, float s) {
    v4u o; o.x = pk2(bflo(w.x) * s, bfhi(w.x) * s); o.y = pk2(bflo(w.y) * s, bfhi(w.y) * s); o.z = pk2(bflo(w.z) * s, bfhi(w.z) * s); o.w = pk2(bflo(w.w) * s, bfhi(w.w) * s); return o;
}
struct KvRegs { v4u k[4], v[8]; };
__device__ __forceinline__ void kv_load(Frame& F, int u, KvRegs& R) {
    const int b = u >> 7, h = (u >> 5) & 3, c = u & 31; const size_t tok0 = (size_t)b * SEQ + c * 128;
    const bf16* Kb = (const bf16*)(F.dout + DO_K); const bf16* Vb = (const bf16*)(F.ws + WS_V);
#pragma unroll
    for (int i = 0; i < 4; ++i) { const int ch = F.tid + 512 * i, j = ch >> 4, cc = ch & 15; R.k[i] = *(const v4u*)(Kb + (tok0 + j) * 512 + h * 128 + cc * 8); }
#pragma unroll
    for (int i = 0; i < 8; ++i) { const int ch = F.tid + 512 * i, j = ch >> 5, cc = ch & 31; R.v[i] = *(const v4u*)(Vb + (tok0 + j) * 1024 + h * 256 + cc * 8); }
}
__device__ __forceinline__ void kv_unit(Frame& F, int u, KvRegs& R, int unext) {
    const int b = u >> 7, h = (u >> 5) & 3, c = u & 31;
    LAS unsigned char* Kimg = F.lds; LAS unsigned char* Vimg = F.lds + 34816;
    const float lg = lg_gamma(h);
#pragma unroll
    for (int i = 0; i < 4; ++i) { const int ch = F.tid + 512 * i, j = ch >> 4, cc = ch & 15;
        *(LAS v4u*)(Kimg + j * KS + cc * 16) = scale8(R.k[i], fexp2((float)(127 - j) * lg)); }
#pragma unroll
    for (int i = 0; i < 8; ++i) { const int ch = F.tid + 512 * i, j = ch >> 5, cc = ch & 31; *(LAS v4u*)(Vimg + j * VS + cc * 16) = R.v[i]; }
    __syncthreads();
    if (unext >= 0) kv_load(F, unext, R);
    f32x4 acc[8][2];
#pragma unroll
    for (int dt = 0; dt < 8; ++dt) { acc[dt][0] = (f32x4){0.f, 0.f, 0.f, 0.f}; acc[dt][1] = (f32x4){0.f, 0.f, 0.f, 0.f}; }
#pragma unroll
    for (int js = 0; js < 4; ++js) {
        bf16x8 bv[2];
#pragma unroll
        for (int vt = 0; vt < 2; ++vt) bv[vt] = lds_tr_frag(Vimg, VS, 32 * js, 32 * F.wave + 16 * vt, F.lane);
#pragma unroll
        for (int dt = 0; dt < 8; ++dt) { const bf16x8 a = lds_tr_frag(Kimg, KS, 32 * js, 16 * dt, F.lane);
            acc[dt][0] = MFMA16(a, bv[0], acc[dt][0]); acc[dt][1] = MFMA16(a, bv[1], acc[dt][1]); }
    }
    bf16* dst = (bf16*)(F.dout + DO_KVS) + (size_t)(((b * 4 + h) * 32 + c)) * 32768;
#pragma unroll
    for (int dt = 0; dt < 8; ++dt)
#pragma unroll
        for (int vt = 0; vt < 2; ++vt) { const int v = 32 * F.wave + 16 * vt + (F.lane & 15), d0 = 16 * dt + 4 * (F.lane >> 4);
            v2u o; o.x = pk2(acc[dt][vt][0], acc[dt][vt][1]); o.y = pk2(acc[dt][vt][2], acc[dt][vt][3]);
            *(v2u*)(dst + v * 128 + d0) = o; }
    __syncthreads();
}
struct SguRegs { v4u sv[8]; f32x2v st[8]; };
__device__ __forceinline__ void sgu_load(Frame& F, int su, SguRegs& R) {
    const size_t tok0 = (size_t)(su >> 2) * 128; const int g = su & 3; const bf16* SVb = (const bf16*)(F.ws + WS_SV); const float* stat = (const float*)(F.ws + WS_SVSTAT);
    int tq = F.tid; asm volatile("" : "+v"(tq));
#pragma unroll
    for (int i = 0; i < 8; ++i) { const int ch = tq + 512 * i, sr = ch >> 5, cc = ch & 31;
        R.sv[i] = *(const v4u*)(SVb + (tok0 + sr) * 1024 + g * 256 + cc * 8); R.st[i] = *(const f32x2v*)(stat + (tok0 + sr) * 2); }
}
__device__ __forceinline__ void sgu_unit(Frame& F, int su, SguRegs& R, int snext, int& cur_g) {
    const size_t tok0 = (size_t)(su >> 2) * 128; const int g = su & 3;
    LAS unsigned char* Vn = F.lds; LAS unsigned char* Wimg = F.lds + 67584;
    const bf16* Ub = (const bf16*)(F.ws + WS_U); const bf16* Wm = (const bf16*)(F.ws + WS_SGUW);
    { const int cc = F.tid & 31; const int col = g * 256 + cc * 8;
        const f32x4 g0 = *(const f32x4*)(F.sgu_ln_g + col), g1 = *(const f32x4*)(F.sgu_ln_g + col + 4), b0 = *(const f32x4*)(F.sgu_ln_b + col), b1 = *(const f32x4*)(F.sgu_ln_b + col + 4);
#pragma unroll
        for (int i = 0; i < 8; ++i) { const int ch = F.tid + 512 * i, sr = ch >> 5; const v4u w = R.sv[i];
            const float mean = R.st[i].x * (1.f / 1024.f), var = R.st[i].y * (1.f / 1024.f) - mean * mean, rstd = __builtin_amdgcn_rsqf(var + EPSN);
            v4u o;
            o.x = pk2((bflo(w.x) - mean) * rstd * g0[0] + b0[0], (bfhi(w.x) - mean) * rstd * g0[1] + b0[1]);
            o.y = pk2((bflo(w.y) - mean) * rstd * g0[2] + b0[2], (bfhi(w.y) - mean) * rstd * g0[3] + b0[3]);
            o.z = pk2((bflo(w.z) - mean) * rstd * g1[0] + b1[0], (bfhi(w.z) - mean) * rstd * g1[1] + b1[1]);
            o.w = pk2((bflo(w.w) - mean) * rstd * g1[2] + b1[2], (bfhi(w.w) - mean) * rstd * g1[3] + b1[3]);
            *(LAS v4u*)(Vn + sr * VS + cc * 16) = o; } }
    if (g != cur_g) { cur_g = g;
#pragma unroll
        for (int i = 0; i < 4; ++i) { const int ch = F.tid + 512 * i, t = ch >> 4, cc = ch & 15;
            *(LAS v4u*)(Wimg + t * KS + cc * 16) = *(const v4u*)(Wm + (size_t)(g * 128 + t) * 128 + cc * 8); } }
    __syncthreads();
    if (snext >= 0) sgu_load(F, snext, R);
    v2u uv[8][2];
#pragma unroll
    for (int tt = 0; tt < 8; ++tt)
#pragma unroll
        for (int ct = 0; ct < 2; ++ct) uv[tt][ct] = *(const v2u*)(Ub + (tok0 + 16 * tt + (F.lane & 15)) * 1024 + g * 256 + 32 * F.wave + 16 * ct + 4 * (F.lane >> 4));
    f32x4 acc[2][8];
#pragma unroll
    for (int ct = 0; ct < 2; ++ct)
#pragma unroll
        for (int tt = 0; tt < 8; ++tt) acc[ct][tt] = (f32x4){0.f, 0.f, 0.f, 0.f};
#pragma unroll
    for (int ss = 0; ss < 4; ++ss) {
        bf16x8 av[2];
#pragma unroll
        for (int ct = 0; ct < 2; ++ct) av[ct] = lds_tr_frag(Vn, VS, 32 * ss, 32 * F.wave + 16 * ct, F.lane);
#pragma unroll
        for (int tt = 0; tt < 8; ++tt) if (tt >= 2 * ss) { const bf16x8 bw = lds_row_frag(Wimg, KS, 16 * tt, 32 * ss, F.lane);
            acc[0][tt] = MFMA16(av[0], bw, acc[0][tt]); acc[1][tt] = MFMA16(av[1], bw, acc[1][tt]); }
    }
#pragma unroll
    for (int tt = 0; tt < 8; ++tt) { const int t = 16 * tt + (F.lane & 15); const float bs = F.sgu_b[g * 128 + t];
#pragma unroll
        for (int ct = 0; ct < 2; ++ct) { const int cg = g * 256 + 32 * F.wave + 16 * ct + 4 * (F.lane >> 4); const v2u u2 = uv[tt][ct];
            *(unsigned*)(F.ws + WS_YS8 + (tok0 + t) * 1024 + cg) = pk4_fp8(8.f * bflo(u2.x) * (acc[ct][tt][0] + bs), 8.f * bfhi(u2.x) * (acc[ct][tt][1] + bs), 8.f * bflo(u2.y) * (acc[ct][tt][2] + bs), 8.f * bfhi(u2.y) * (acc[ct][tt][3] + bs)); } }
    __syncthreads();
}
__device__ __forceinline__ void p2a(Frame& F) { F.fence_ids();
    { KvRegs R; if (F.bid < 1024) kv_load(F, F.bid, R);
      for (int u = F.bid; u < 1024; u += F.G) kv_unit(F, u, R, (u + F.G < 1024) ? u + F.G : -1); }
#if MK_PROBE_HI > 0
    if (F.bid == 0 && threadIdx.x == 0) { const unsigned long long _t = __builtin_amdgcn_s_memrealtime(); F.misc[16 + 2 * 20] = (unsigned)_t; F.misc[17 + 2 * 20] = (unsigned)(_t >> 32); }
#endif
    { SguRegs R; int cur_g = -1; if (F.bid < 1024) sgu_load(F, F.bid, R);
      for (int su = F.bid; su < 1024; su += F.G) sgu_unit(F, su, R, (su + F.G < 1024) ? su + F.G : -1, cur_g); }
}
__device__ __forceinline__ void p2b(Frame& F) { F.fence_ids();
    bf16* KVS = (bf16*)(F.dout + DO_KVS);
    for (int item = F.bid * 512 + F.tid; item < 32 * 4096; item += F.G * 512) {
        const int bh = item >> 12, rem = item & 4095, h = bh & 3;
        const float dc = fexp2(128.0f * lg_gamma(h));
        float s[8];
#pragma unroll
        for (int e = 0; e < 8; ++e) s[e] = 0.f;
        bf16* p = KVS + (size_t)bh * 32 * 32768 + (size_t)rem * 8;
        for (int c0 = 0; c0 < 32; c0 += 8) {
            v4u kv[8];
#pragma unroll
            for (int i = 0; i < 8; ++i) kv[i] = *(const v4u*)(p + (size_t)(c0 + i) * 32768);
#pragma unroll
            for (int i = 0; i < 8; ++i) {
                v4u o; o.x = pk2(s[0], s[1]); o.y = pk2(s[2], s[3]); o.z = pk2(s[4], s[5]); o.w = pk2(s[6], s[7]);
                *(v4u*)(p + (size_t)(c0 + i) * 32768) = o;
                s[0] = s[0] * dc + bflo(kv[i].x); s[1] = s[1] * dc + bfhi(kv[i].x); s[2] = s[2] * dc + bflo(kv[i].y); s[3] = s[3] * dc + bfhi(kv[i].y);
                s[4] = s[4] * dc + bflo(kv[i].z); s[5] = s[5] * dc + bfhi(kv[i].z); s[6] = s[6] * dc + bflo(kv[i].w); s[7] = s[7] * dc + bfhi(kv[i].w);
            }
        }
    }
}
struct RetRegs { v4u q[4], k[4], v[8]; };
__device__ __forceinline__ void ret_load(Frame& F, int u, RetRegs& R) {
    const int b = u >> 7, h = (u >> 5) & 3, c = u & 31; const size_t tok0 = (size_t)b * SEQ + c * 128;
    const bf16* Qb = (const bf16*)(F.dout + DO_Q); const bf16* Kb = (const bf16*)(F.dout + DO_K); const bf16* Vb = (const bf16*)(F.ws + WS_V);
#pragma unroll
    for (int i = 0; i < 4; ++i) { const int ch = F.tid + 512 * i, j = ch >> 4, cc = ch & 15;
        R.q[i] = *(const v4u*)(Qb + (tok0 + j) * 512 + h * 128 + cc * 8); R.k[i] = *(const v4u*)(Kb + (tok0 + j) * 512 + h * 128 + cc * 8); }
#pragma unroll
    for (int i = 0; i < 8; ++i) { const int ch = F.tid + 512 * i, j = ch >> 5, cc = ch & 31; R.v[i] = *(const v4u*)(Vb + (tok0 + j) * 1024 + h * 256 + cc * 8); }
}
__device__ __forceinline__ void ret_unit(Frame& F, int u, RetRegs& R, int unext) {
    const int b = u >> 7, h = (u >> 5) & 3, c = u & 31;
    const size_t tok0 = (size_t)b * SEQ + c * 128;
    LAS unsigned char* Qimg = F.lds; LAS unsigned char* Kimg = F.lds + 34816; LAS unsigned char* Vimg = F.lds + 69632;
    LAS unsigned char* Sout = F.lds;
    const bf16* Gb = (const bf16*)(F.ws + WS_G);
    const bf16* ST = (const bf16*)(F.dout + DO_KVS) + (size_t)(((b * 4 + h) * 32 + c)) * 32768;
    const float lg = lg_gamma(h);
    const int lane = F.lane, w = F.wave, l15 = lane & 15, g4 = lane >> 4;
#pragma unroll
    for (int i = 0; i < 4; ++i) { const int ch = F.tid + 512 * i, j = ch >> 4, cc = ch & 15;
        *(LAS v4u*)(Qimg + j * KS + cc * 16) = R.q[i]; *(LAS v4u*)(Kimg + j * KS + cc * 16) = R.k[i]; }
#pragma unroll
    for (int i = 0; i < 8; ++i) { const int ch = F.tid + 512 * i, j = ch >> 5, cc = ch & 31; *(LAS v4u*)(Vimg + j * VS + cc * 16) = R.v[i]; }
    bf16x8 bs[4][2];
#pragma unroll
    for (int ds = 0; ds < 4; ++ds)
#pragma unroll
        for (int vt = 0; vt < 2; ++vt) bs[ds][vt] = *(const bf16x8*)(ST + (size_t)(32 * w + 16 * vt + l15) * 128 + 32 * ds + 8 * g4);
    __syncthreads();
    f32x4 st[8];
#pragma unroll
    for (int jt = 0; jt < 8; ++jt) st[jt] = (f32x4){0.f, 0.f, 0.f, 0.f};
#pragma unroll
    for (int ds = 0; ds < 4; ++ds) { const bf16x8 bq = lds_row_frag(Qimg, KS, 16 * w, 32 * ds, lane);
#pragma unroll
        for (int jt = 0; jt < 8; ++jt) if (jt <= w) { const bf16x8 ak = lds_row_frag(Kimg, KS, 16 * jt, 32 * ds, lane); st[jt] = MFMA16(ak, bq, st[jt]); } }
    __syncthreads();
    { const int i = 16 * w + l15;
#pragma unroll
        for (int jt = 0; jt < 8; ++jt) { float o[4];
#pragma unroll
            for (int ii = 0; ii < 4; ++ii) { const int j = 16 * jt + 4 * g4 + ii; o[ii] = (i >= j) ? st[jt][ii] * fexp2((float)(i - j) * lg) : 0.f; }
            v2u pk; pk.x = pk2(o[0], o[1]); pk.y = pk2(o[2], o[3]);
            *(LAS v2u*)(Kimg + i * KS + (16 * jt + 4 * g4) * 2) = pk; } }
    __syncthreads();
    f32x4 acc[8][2];
#pragma unroll
    for (int it = 0; it < 8; ++it) { acc[it][0] = (f32x4){0.f, 0.f, 0.f, 0.f}; acc[it][1] = (f32x4){0.f, 0.f, 0.f, 0.f}; }
#pragma unroll
    for (int ds = 0; ds < 4; ++ds) {
#pragma unroll
        for (int it = 0; it < 8; ++it) { const bf16x8 a = lds_row_frag(Qimg, KS, 16 * it, 32 * ds, lane);
            acc[it][0] = MFMA16(a, bs[ds][0], acc[it][0]); acc[it][1] = MFMA16(a, bs[ds][1], acc[it][1]); } }
#pragma unroll
    for (int it = 0; it < 8; ++it)
#pragma unroll
        for (int ii = 0; ii < 4; ++ii) { const float dq = fexp2((float)(16 * it + 4 * g4 + ii + 1) * lg); acc[it][0][ii] *= dq; acc[it][1][ii] *= dq; }
#pragma unroll
    for (int js = 0; js < 4; ++js) { bf16x8 bv[2];
#pragma unroll
        for (int vt = 0; vt < 2; ++vt) bv[vt] = lds_tr_frag(Vimg, VS, 32 * js, 32 * w + 16 * vt, lane);
#pragma unroll
        for (int it = 0; it < 8; ++it) if (it >= 2 * js) { const bf16x8 a = lds_row_frag(Kimg, KS, 16 * it, 32 * js, lane);
            acc[it][0] = MFMA16(a, bv[0], acc[it][0]); acc[it][1] = MFMA16(a, bv[1], acc[it][1]); } }
    int lane_h = lane; asm volatile("" : "+v"(lane_h));
    v2u gt[16];
#pragma unroll
    for (int rr = 0; rr < 16; ++rr) gt[rr] = *(const v2u*)(Gb + (tok0 + 16 * w + rr) * 1024 + h * 256 + 4 * lane_h);
    const f32x4 gn = *(const f32x4*)(F.ret_gn_g + h * 256 + 4 * lane_h);
    __syncthreads();
#pragma unroll
    for (int it = 0; it < 8; ++it)
#pragma unroll
        for (int vt = 0; vt < 2; ++vt)
#pragma unroll
            for (int ii = 0; ii < 4; ++ii) *(LAS float*)(Sout + (16 * it + 4 * g4 + ii) * 1040 + (32 * w + 16 * vt + l15) * 4) = acc[it][vt][ii];
    __syncthreads();
#pragma unroll
    for (int rr = 0; rr < 16; ++rr) { const int i = 16 * w + rr;
        const f32x4 y = *(LAS const f32x4*)(Sout + i * 1040 + lane_h * 16);
        const float mean = wave_sum((y[0] + y[1]) + (y[2] + y[3])) * (1.f / 256.f);
        const f32x4 d = y - mean;
        const float var = wave_sum((d[0] * d[0] + d[1] * d[1]) + (d[2] * d[2] + d[3] * d[3])) * (1.f / 256.f);
        const float r8 = __builtin_amdgcn_rsqf(var + EPSN) * 4.0f;
        const size_t off = (tok0 + i) * 1024 + h * 256 + 4 * lane_h;
        *(unsigned*)(F.ws + WS_YG8 + off) = pk4_fp8(d[0] * r8 * gn[0] * bflo(gt[rr].x), d[1] * r8 * gn[1] * bfhi(gt[rr].x), d[2] * r8 * gn[2] * bflo(gt[rr].y), d[3] * r8 * gn[3] * bfhi(gt[rr].y)); }
    __syncthreads();
}
__device__ __forceinline__ void p2c(Frame& F) { F.fence_ids(); for (int u = F.bid; u < 1024; u += F.G) { RetRegs R; ret_load(F, u, R); ret_unit(F, u, R, -1); } }

__device__ __forceinline__ float dppx(float v, int) { return v; }
template <int CTRL> __device__ __forceinline__ void merge16(float (&L)[16]) {
    float c[16];
#pragma unroll
    for (int i = 0; i < 16; ++i) c[i] = __builtin_fmaxf(L[i], dpp_f<CTRL>(L[15 - i]));
#pragma unroll
    for (int half = 8; half >= 1; half >>= 1)
#pragma unroll
        for (int i = 0; i < 16; ++i) if ((i & half) == 0) { const float hi = __builtin_fmaxf(c[i], c[i + half]), lo = __builtin_fminf(c[i], c[i + half]); c[i] = hi; c[i + half] = lo; }
#pragma unroll
    for (int i = 0; i < 16; ++i) L[i] = c[i];
}
__device__ __forceinline__ void sort16_desc(float (&v)[16]) {
#pragma unroll
    for (int k = 2; k <= 16; k <<= 1)
#pragma unroll
        for (int j = k >> 1; j >= 1; j >>= 1)
#pragma unroll
            for (int i = 0; i < 16; ++i) { const int l = i ^ j; if (l > i) { const bool desc = ((i & k) == 0) || (k == 16);
                const float hi = __builtin_fmaxf(v[i], v[l]), lo = __builtin_fminf(v[i], v[l]); v[i] = desc ? hi : lo; v[l] = desc ? lo : hi; } }
}
__device__ __forceinline__ void merge_top16(float (&A)[16], const float (&B)[16]) {
#pragma unroll
    for (int i = 0; i < 16; ++i) A[i] = __builtin_fmaxf(A[i], B[15 - i]);
#pragma unroll
    for (int half = 8; half >= 1; half >>= 1)
#pragma unroll
        for (int i = 0; i < 16; ++i) if ((i & half) == 0) { const float hi = __builtin_fmaxf(A[i], A[i + half]), lo = __builtin_fminf(A[i], A[i + half]); A[i] = hi; A[i + half] = lo; }
}
__device__ __forceinline__ void p5b(Frame& F) {
    F.fence_ids();
    LAS unsigned char* Aimg = F.lds; LAS unsigned char* Bimg = F.lds + 34816; LAS float* Sc = (LAS float*)(F.lds + 69632);
    const bf16* QP = (const bf16*)(F.ws + WS_GA);
    const int lane = F.lane, w = F.wave;
    int cur_hp = -1;
    v4u pa[4];
    if (F.bid < 4096) { const int tt = F.bid >> 4, hp = F.bid & 15;
#pragma unroll
        for (int i = 0; i < 4; ++i) { const int ch = F.tid + 512 * i, r = ch >> 4, cc = ch & 15; pa[i] = *(const v4u*)(QP + ((size_t)tt * 128 + r) * 2048 + hp * 128 + cc * 8); } }
    for (int u = F.bid; u < 4096; u += F.G) {
        const int tt = u >> 4, hp = u & 15; const size_t tok0 = (size_t)tt * 128;
#pragma unroll
        for (int i = 0; i < 4; ++i) { const int ch = F.tid + 512 * i, r = ch >> 4, cc = ch & 15; *(LAS v4u*)(Aimg + r * KS + cc * 16) = pa[i]; }
        if (hp != cur_hp) { const bf16* SK = (const bf16*)(F.ws + WS_SK) + (size_t)hp * 16384; cur_hp = hp;
#pragma unroll
            for (int i = 0; i < 4; ++i) { const int ch = F.tid + 512 * i, r = ch >> 4, cc = ch & 15; *(LAS v4u*)(Bimg + r * KS + cc * 16) = *(const v4u*)(SK + (size_t)r * 128 + cc * 8); } }
        __syncthreads();
        { const int un = u + F.G; if (un < 4096) { const int tn = un >> 4, hn = un & 15;
#pragma unroll
            for (int i = 0; i < 4; ++i) { const int ch = F.tid + 512 * i, r = ch >> 4, cc = ch & 15; pa[i] = *(const v4u*)(QP + ((size_t)tn * 128 + r) * 2048 + hn * 128 + cc * 8); } } }
        f32x4 acc[8];
#pragma unroll
        for (int nt = 0; nt < 8; ++nt) acc[nt] = (f32x4){0.f, 0.f, 0.f, 0.f};
#pragma unroll
        for (int ks = 0; ks < 4; ++ks) { const bf16x8 a = lds_row_frag(Aimg, KS, 16 * w, 32 * ks, lane);
#pragma unroll
            for (int nt = 0; nt < 8; ++nt) { const bf16x8 bb = lds_row_frag(Bimg, KS, 16 * nt, 32 * ks, lane); acc[nt] = MFMA16(a, bb, acc[nt]); } }
#pragma unroll
        for (int nt = 0; nt < 8; ++nt)
#pragma unroll
            for (int ii = 0; ii < 4; ++ii) Sc[(16 * w + 4 * (lane >> 4) + ii) * 132 + 16 * nt + (lane & 15)] = acc[nt][ii];
        __syncthreads();
        { const int row = F.tid >> 2, q = F.tid & 3;
            float L[16], L2[16];
#pragma unroll
            for (int i = 0; i < 16; ++i) { const int n = 4 * i + q, n2 = 4 * (i + 16) + q;
                L[i] = __uint_as_float((__float_as_uint(Sc[row * 132 + n]) & 0xFFFFFF80u) | (unsigned)n);
                L2[i] = __uint_as_float((__float_as_uint(Sc[row * 132 + n2]) & 0xFFFFFF80u) | (unsigned)n2); }
            sort16_desc(L); sort16_desc(L2); merge_top16(L, L2);
            merge16<0xB1>(L); merge16<0x4E>(L);
            if (q == 0) { v4u* dst = (v4u*)((unsigned*)(F.ws + WS_SUB) + ((tok0 + row) * 16 + hp) * 16);
#pragma unroll
                for (int i = 0; i < 4; ++i) dst[i] = (v4u){__float_as_uint(L[4 * i]), __float_as_uint(L[4 * i + 1]), __float_as_uint(L[4 * i + 2]), __float_as_uint(L[4 * i + 3])}; } }
        __syncthreads();
    }
}

template <int CTRL> __device__ __forceinline__ float dpp_max(float v) { return __builtin_fmaxf(v, dpp_f<CTRL>(v)); }
template <int CTRL> __device__ __forceinline__ float dpp_add(float v) { return v + dpp_f<CTRL>(v); }
__device__ __forceinline__ float row_allmax(float v) { v = dpp_max<0x128>(v); v = dpp_max<0x124>(v); v = dpp_max<0x122>(v); v = dpp_max<0x121>(v); return v; }
__device__ __forceinline__ float row_allsum(float v) { v = dpp_add<0x128>(v); v = dpp_add<0x124>(v); v = dpp_add<0x122>(v); v = dpp_add<0x121>(v); return v; }
__device__ __forceinline__ void p6a(Frame& F) { F.fence_ids();
    const int lane = F.lane, row = lane >> 4, i = lane & 15, rowbase = lane & 48;
    LAS unsigned* Sel = (LAS unsigned*)(F.lds + F.wave * 1024);
    const unsigned* SUB = (const unsigned*)(F.ws + WS_SUB);
    unsigned* EID = (unsigned*)(F.ws + WS_EID); float* GWp = (float*)(F.ws + WS_GW);
    const int gw = F.bid * NWAVES + F.wave, NGW = F.G * NWAVES;
    unsigned nab[2], nbb[2];
    if (gw < MT) {
#pragma unroll
        for (int r = 0; r < 2; ++r) { const int h = 4 * r + row; nab[r] = SUB[((size_t)gw * 16 + 2 * h) * 16 + i]; nbb[r] = SUB[((size_t)gw * 16 + 2 * h + 1) * 16 + i]; } }
    for (int t = gw; t < MT; t += NGW) {
        unsigned abits[2], bbits[2], bcur[2]; float a[2], hv[2]; int ptr[2];
#pragma unroll
        for (int r = 0; r < 2; ++r) { abits[r] = nab[r]; bbits[r] = nbb[r]; a[r] = __uint_as_float(abits[r]); ptr[r] = 0; bcur[r] = (unsigned)__shfl((int)bbits[r], rowbase); hv[r] = a[r] + __uint_as_float(bcur[r]); }
        if (t + NGW < MT) {
#pragma unroll
            for (int r = 0; r < 2; ++r) { const int h = 4 * r + row; nab[r] = SUB[((size_t)(t + NGW) * 16 + 2 * h) * 16 + i]; nbb[r] = SUB[((size_t)(t + NGW) * 16 + 2 * h + 1) * 16 + i]; } }
        for (int k = 0; k < 16; ++k) {
#pragma unroll
            for (int r = 0; r < 2; ++r) {
                const float key = __uint_as_float((__float_as_uint(hv[r]) & 0xFFFFFFF0u) | (unsigned)i);
                const float m = row_allmax(key);
                const bool win = (key == m);
                if (win) { Sel[((r * 4 + row) * 16 + k) * 2] = (abits[r] & 127u) * 128u + (bcur[r] & 127u); Sel[((r * 4 + row) * 16 + k) * 2 + 1] = __float_as_uint(hv[r]); ptr[r]++; }
                const unsigned bnext = (unsigned)__shfl((int)bbits[r], rowbase + (ptr[r] < 15 ? ptr[r] : 15));
                if (win) { bcur[r] = bnext; hv[r] = (ptr[r] < 16) ? a[r] + __uint_as_float(bnext) : -3.0e38f; }
            }
        }
        LDS_WAIT(); asm volatile("" ::: "memory");
#pragma unroll
        for (int r = 0; r < 2; ++r) { const int h = 4 * r + row;
            const unsigned e = Sel[((r * 4 + row) * 16 + i) * 2]; const float sc = __uint_as_float(Sel[((r * 4 + row) * 16 + i) * 2 + 1]);
            const float mx = row_allmax(sc);
            const float ex = fexp2((sc - mx) * 1.44269504089f);
            const float sum = row_allsum(ex);
            EID[(size_t)t * 128 + h * 16 + i] = e; GWp[(size_t)t * 128 + h * 16 + i] = ex / sum; }
        LDS_WAIT(); asm volatile("" ::: "memory");
    }
}
typedef float f32x2c __attribute__((ext_vector_type(2)));
__device__ __forceinline__ long mk64(unsigned lo, unsigned hi) { return (long)(((unsigned long long)hi << 32) | lo); }
#if MK_U4
typedef int v8i_q __attribute__((ext_vector_type(8)));
__device__ __forceinline__ void p6b(Frame& F) { F.fence_ids();
    const int j = F.bid & 7, s2 = j >> 1, par = j & 1, nsb = F.G >> 3; if ((F.bid >> 3) >= nsb) return;
    const int wj = (F.bid >> 3) * NWAVES + F.wave, NW = nsb * NWAVES, NI = MT / 2;
    const int lane = F.lane, g = lane >> 4;
    const int pidx = (4 * (lane & 15) + (lane >> 4)) * 4;
    const unsigned char* H8 = F.ws + WS_H2F8 + (size_t)s2 * MT * 256 + 16 * g; const unsigned char* U4 = F.ws + WS_UE8 + (size_t)s2 * 16384 * 128 + 16 * (lane & 3); const unsigned* EID = (const unsigned*)(F.ws + WS_EID) + (lane >> 2);
    float* PD = (float*)(F.ws + WS_PD) + (size_t)s2 * MT * 128;
#define TOK(ix_) (2 * ((ix_) < NI ? (ix_) : NI - 1) + par)
#define P6B_LOAD_EID(E, ix_) do { const int tc_ = TOK(ix_); _Pragma("unroll") for (int h = 0; h < 8; ++h) E[h] = EID[(size_t)tc_ * 128 + 16 * h]; } while (0)
#define P6B_LOAD_AB(A_, B0_, B1_, E, ix_) do { const int tc_ = TOK(ix_); const unsigned char* hp_ = H8 + (size_t)tc_ * 256; A_[0] = *(const v4u*)hp_; A_[1] = *(const v4u*)(hp_ + 64); A_[2] = *(const v4u*)(hp_ + 128); A_[3] = *(const v4u*)(hp_ + 192); \
        _Pragma("unroll") for (int h = 0; h < 8; ++h) { const unsigned char* rp_ = U4 + (size_t)E[h] * 128; B0_[h] = *(const v4u*)rp_; B1_[h] = *(const v4u*)(rp_ + 64); } } while (0)
#define BPM(x_) ((int)__builtin_amdgcn_ds_bpermute(pidx, (int)(x_)))
#define P6B_COMPUTE(A_, B0_, B1_, ix_) do { if ((ix_) < NI) { const int tc_ = 2 * (ix_) + par; \
        const v8i_q a0_ = (v8i_q){(int)A_[0].x, (int)A_[0].y, (int)A_[0].z, (int)A_[0].w, (int)A_[1].x, (int)A_[1].y, (int)A_[1].z, (int)A_[1].w}, a1_ = (v8i_q){(int)A_[2].x, (int)A_[2].y, (int)A_[2].z, (int)A_[2].w, (int)A_[3].x, (int)A_[3].y, (int)A_[3].z, (int)A_[3].w}; \
        _Pragma("unroll") for (int h = 0; h < 8; ++h) { const v8i_q b0_ = (v8i_q){BPM(B0_[h].x), BPM(B0_[h].y), BPM(B0_[h].z), BPM(B0_[h].w), 0, 0, 0, 0}, b1_ = (v8i_q){BPM(B1_[h].x), BPM(B1_[h].y), BPM(B1_[h].z), BPM(B1_[h].w), 0, 0, 0, 0}; \
            f32x4 acc_ = __builtin_amdgcn_mfma_scale_f32_16x16x128_f8f6f4(a0_, b0_, (f32x4){0.f, 0.f, 0.f, 0.f}, 0, 4, 0, 0x7F7F7F7F, 0, 0x7F7F7F7F); \
            acc_ = __builtin_amdgcn_mfma_scale_f32_16x16x128_f8f6f4(a1_, b1_, acc_, 0, 4, 0, 0x7F7F7F7F, 0, 0x7F7F7F7F); \
            if (lane < 16) PD[(size_t)tc_ * 128 + 16 * h + lane] = acc_[0] * (1.0f / 1024.0f); } } } while (0)
    unsigned E0[8], E1[8]; v4u A0[4], A1[4], B00[8], B01[8], B10[8], B11[8];
    int ix = wj;
    P6B_LOAD_EID(E0, ix); P6B_LOAD_EID(E1, ix + NW);
    P6B_LOAD_AB(A0, B00, B01, E0, ix);
    for (; ix < NI; ix += 2 * NW) {
        P6B_LOAD_AB(A1, B10, B11, E1, ix + NW);
        P6B_LOAD_EID(E0, ix + 2 * NW);
        P6B_COMPUTE(A0, B00, B01, ix);
        P6B_LOAD_AB(A0, B00, B01, E0, ix + 2 * NW);
        P6B_LOAD_EID(E1, ix + 3 * NW);
        P6B_COMPUTE(A1, B10, B11, ix + NW);
    }
#undef TOK
#undef P6B_LOAD_EID
#undef P6B_LOAD_AB
#undef P6B_COMPUTE
#undef BPM
}
#else
__device__ __forceinline__ void p6b(Frame& F) { F.fence_ids();
    const int j = F.bid & 7, nsb = F.G >> 3; if ((F.bid >> 3) >= nsb) return;
    const int wj = (F.bid >> 3) * NWAVES + F.wave, NW = nsb * NWAVES;
    const int lane = F.lane, g = lane >> 4;
    const int pidx = (4 * (lane & 15) + (lane >> 4)) * 4;
    const unsigned char* H8 = F.ws + WS_H2F8 + (size_t)j * MT * 128 + 16 * g; const unsigned char* UE8 = F.ws + WS_UE8 + (size_t)j * 16384 * 128 + 16 * (lane & 3); const unsigned* EID = (const unsigned*)(F.ws + WS_EID) + (lane >> 2);
    float* PD = (float*)(F.ws + WS_PD) + (size_t)j * MT * 128;
#define P6B_LOAD_EID(E, tt) do { const int tc_ = (tt) < MT ? (tt) : MT - 1; _Pragma("unroll") for (int h = 0; h < 8; ++h) E[h] = EID[(size_t)tc_ * 128 + 16 * h]; } while (0)
#define P6B_LOAD_AB(A0_, A1_, B0_, B1_, E, tt) do { const int tc_ = (tt) < MT ? (tt) : MT - 1; const unsigned char* hp_ = H8 + (size_t)tc_ * 128; A0_ = *(const v4u*)hp_; A1_ = *(const v4u*)(hp_ + 64); \
        _Pragma("unroll") for (int h = 0; h < 8; ++h) { const unsigned char* rp_ = UE8 + (size_t)E[h] * 128; B0_[h] = *(const v4u*)rp_; B1_[h] = *(const v4u*)(rp_ + 64); } } while (0)
#define BPM(x_) ((unsigned)__builtin_amdgcn_ds_bpermute(pidx, (int)(x_)))
#define P6B_COMPUTE(A0_, A1_, B0_, B1_, tt) do { if ((tt) < MT) { _Pragma("unroll") for (int h = 0; h < 8; ++h) { f32x4 acc_ = (f32x4){0.f, 0.f, 0.f, 0.f}; \
            acc_ = __builtin_amdgcn_mfma_f32_16x16x32_fp8_fp8(mk64(A0_.x, A0_.y), mk64(BPM(B0_[h].x), BPM(B0_[h].y)), acc_, 0, 0, 0); \
            acc_ = __builtin_amdgcn_mfma_f32_16x16x32_fp8_fp8(mk64(A0_.z, A0_.w), mk64(BPM(B0_[h].z), BPM(B0_[h].w)), acc_, 0, 0, 0); \
            acc_ = __builtin_amdgcn_mfma_f32_16x16x32_fp8_fp8(mk64(A1_.x, A1_.y), mk64(BPM(B1_[h].x), BPM(B1_[h].y)), acc_, 0, 0, 0); \
            acc_ = __builtin_amdgcn_mfma_f32_16x16x32_fp8_fp8(mk64(A1_.z, A1_.w), mk64(BPM(B1_[h].z), BPM(B1_[h].w)), acc_, 0, 0, 0); \
            if (lane < 16) PD[(size_t)(tt) * 128 + 16 * h + lane] = acc_[0] * (1.0f / 8192.0f); } } } while (0)
    unsigned E0[8], E1[8]; v4u A00, A01, A10, A11, B00[8], B01[8], B10[8], B11[8];
    int t = wj;
    P6B_LOAD_EID(E0, t); P6B_LOAD_EID(E1, t + NW);
    P6B_LOAD_AB(A00, A01, B00, B01, E0, t);
    for (; t < MT; t += 2 * NW) {
        P6B_LOAD_AB(A10, A11, B10, B11, E1, t + NW);
        P6B_LOAD_EID(E0, t + 2 * NW);
        P6B_COMPUTE(A00, A01, B00, B01, t);
        P6B_LOAD_AB(A00, A01, B00, B01, E0, t + 2 * NW);
        P6B_LOAD_EID(E1, t + 3 * NW);
        P6B_COMPUTE(A10, A11, B10, B11, t + NW);
    }
#undef P6B_LOAD_EID
#undef P6B_LOAD_AB
#undef P6B_COMPUTE
#undef BPM
}
#endif
__device__ __forceinline__ void p6b2(Frame& F) { F.fence_ids();
    const float* PD = (const float*)(F.ws + WS_PD); const float* GWp = (const float*)(F.ws + WS_GW); float* ACT = (float*)(F.ws + WS_ACT);
    for (size_t i4 = (size_t)F.bid * 512 + F.tid; i4 < (size_t)MT * 32; i4 += (size_t)F.G * 512) {
        f32x4 s = *(const f32x4*)(PD + i4 * 4);
#pragma unroll
        for (int jj = 1; jj < (MK_U4 ? 4 : 8); ++jj) s += *(const f32x4*)(PD + (size_t)jj * MT * 128 + i4 * 4);
        const f32x4 gw = *(const f32x4*)(GWp + i4 * 4);
        *(f32x4*)(ACT + i4 * 4) = (f32x4){gelu1(s[0]) * gw[0], gelu1(s[1]) * gw[1], gelu1(s[2]) * gw[2], gelu1(s[3]) * gw[3]};
    }
}
__device__ __forceinline__ void p6c(Frame& F) { F.fence_ids();
    const int j = F.bid & 7, nsb = F.G >> 3; if ((F.bid >> 3) >= nsb) return;
    const int wj = (F.bid >> 3) * NWAVES + F.wave, NW = nsb * NWAVES;
    const int lane = F.lane, g8 = lane >> 3, s8 = lane & 7;
    LAS float* Act = (LAS float*)(F.lds + F.wave * 8192); LAS unsigned* Eidl = (LAS unsigned*)(F.lds + F.wave * 8192 + 4096);
    const unsigned char* VE8 = F.ws + WS_VE8 + (size_t)j * 16384 * 128 + 16 * s8; const unsigned* EID = (const unsigned*)(F.ws + WS_EID); const float* ACT = (const float*)(F.ws + WS_ACT);
    float* PEERS = (float*)(F.ws + WS_PEERS) + (size_t)j * MT * 128;
    for (int tg = wj; tg < MT / 8; tg += NW) {
        const size_t t0 = (size_t)tg * 8;
#pragma unroll
        for (int q = 0; q < 4; ++q) { const int idx = 4 * (lane + 64 * q);
            *(LAS f32x4*)(Act + idx) = *(const f32x4*)(ACT + t0 * 128 + idx); *(LAS v4u*)(Eidl + idx) = *(const v4u*)(EID + t0 * 128 + idx); }
        LDS_WAIT(); asm volatile("" ::: "memory");
        f32x2c acc2[8];
#pragma unroll
        for (int e = 0; e < 8; ++e) acc2[e] = (f32x2c){0.f, 0.f};
        LAS const float* ap = Act + g8 * 128; LAS const unsigned* ep = Eidl + g8 * 128;
        v4u va[8], vb[8]; f32x4 aa[2], ab[2];
#define P6C_LOAD(V_, A_, base) do { A_[0] = *(LAS const f32x4*)(ap + (base)); A_[1] = *(LAS const f32x4*)(ap + (base) + 4); const v4u e0_ = *(LAS const v4u*)(ep + (base)), e1_ = *(LAS const v4u*)(ep + (base) + 4); \
            _Pragma("unroll") for (int k = 0; k < 4; ++k) { V_[k] = *(const v4u*)(VE8 + (size_t)e0_[k] * 128); V_[4 + k] = *(const v4u*)(VE8 + (size_t)e1_[k] * 128); } } while (0)
#define P6C_FMA(V_, A_) do { _Pragma("unroll") for (int k = 0; k < 8; ++k) { const float a_ = A_[k >> 2][k & 3]; const f32x2c a2_ = (f32x2c){a_, a_}; _Pragma("unroll") for (int w = 0; w < 4; ++w) { \
            const f32x2c lo_ = __builtin_amdgcn_cvt_pk_f32_fp8((int)V_[k][w], false), hi_ = __builtin_amdgcn_cvt_pk_f32_fp8((int)V_[k][w], true); \
            acc2[2 * w] = __builtin_elementwise_fma(a2_, lo_, acc2[2 * w]); acc2[2 * w + 1] = __builtin_elementwise_fma(a2_, hi_, acc2[2 * w + 1]); } } } while (0)
        P6C_LOAD(va, aa, 0);
        for (int it = 0; it < 128; it += 16) {
            P6C_LOAD(vb, ab, it + 8);
            P6C_FMA(va, aa);
            if (it + 16 < 128) P6C_LOAD(va, aa, it + 16);
            P6C_FMA(vb, ab);
        }
#undef P6C_LOAD
#undef P6C_FMA
        float acc[16];
#pragma unroll
        for (int e = 0; e < 8; ++e) { acc[2 * e] = acc2[e][0]; acc[2 * e + 1] = acc2[e][1]; }
        { float* op = PEERS + (t0 + g8) * 128 + 16 * s8;
#pragma unroll
            for (int q = 0; q < 4; ++q) *(f32x4*)(op + 4 * q) = (f32x4){acc[4 * q] * 0.0625f, acc[4 * q + 1] * 0.0625f, acc[4 * q + 2] * 0.0625f, acc[4 * q + 3] * 0.0625f}; }
        LDS_WAIT(); asm volatile("" ::: "memory");
    }
}
__device__ __forceinline__ void p6d(Frame& F) { F.fence_ids();
    const int gw = F.bid * NWAVES + F.wave, NGW = F.G * NWAVES; const float* PEERS = (const float*)(F.ws + WS_PEERS); const float* gate2 = (const float*)(F.ws + WS_MOD) + 5120;
    f32x4 fg[4];
#pragma unroll
    for (int q = 0; q < 4; ++q) fg[q] = *((const f32x4*)F.final_g + F.lane + 64 * q);
    f32x4 nx[4], np[4];
#define P6D_LOAD(tt) do { _Pragma("unroll") for (int q = 0; q < 4; ++q) { const int d = 4 * F.lane + 256 * q; nx[q] = *((const f32x4*)((const float*)F.dout + (size_t)(tt) * DM) + F.lane + 64 * q); \
        np[q] = *(const f32x4*)(PEERS + ((size_t)(d >> 7) * MT + (tt)) * 128 + (d & 127)); } } while (0)
    if (gw < MT) P6D_LOAD(gw);
    for (int t = gw; t < MT; t += NGW) {
        const int b = t >> 12;
        f32x4* xr = (f32x4*)((float*)F.dout + (size_t)t * DM) + F.lane; f32x4 o[4]; float ss = 0.f;
#pragma unroll
        for (int q = 0; q < 4; ++q) { const int d = 4 * F.lane + 256 * q; const f32x4 g2 = *(const f32x4*)(gate2 + (size_t)b * 6144 + d);
            o[q] = nx[q] + g2 * np[q]; ss += (o[q][0] * o[q][0] + o[q][1] * o[q][1]) + (o[q][2] * o[q][2] + o[q][3] * o[q][3]); }
        if (t + NGW < MT) P6D_LOAD(t + NGW);
        const float rstd = __builtin_amdgcn_rsqf(wave_sum(ss) * (1.f / DM) + EPSN);
#pragma unroll
        for (int q = 0; q < 4; ++q) xr[64 * q] = o[q] * rstd * fg[q];
    }
#undef P6D_LOAD
}

struct Args { const float* in[20]; float* out; unsigned char* ws; int ph_lo, ph_hi, li, pad; };
__global__ void __launch_bounds__(NWAVES * 64, 2) mk_fwd(Args args) {
    extern __shared__ __attribute__((aligned(16))) unsigned char lds_raw[];
    Frame F;
    F.lds = (LAS unsigned char*)lds_raw;
    F.tid = threadIdx.x; F.lane = F.tid & 63; F.wave = __builtin_amdgcn_readfirstlane(F.tid >> 6); F.G = gridDim.x; F.bid = blockIdx.x;
    F.x = args.in[0]; F.c = args.in[1]; F.w_ada = args.in[2]; F.b_ada = args.in[3]; F.norm1_g = args.in[4]; F.w_in = args.in[5]; F.ret_gn_g = args.in[6]; F.sgu_ln_g = args.in[7];
    F.sgu_ln_b = args.in[8]; F.sgu_w = args.in[9]; F.sgu_b = args.in[10]; F.w_ret_out = args.in[11]; F.w_sgu_out = args.in[12]; F.w_out = args.in[13]; F.norm2_g = args.in[14];
    F.peer_w_q = args.in[15]; F.peer_sub_keys = args.in[16]; F.peer_u = args.in[17]; F.peer_v = args.in[18]; F.final_g = args.in[19];
    F.ws = args.ws; F.dout = (unsigned char*)args.out;
    volatile LAS unsigned* MISC = (volatile LAS unsigned*)(F.lds + MISC_OFF); F.misc = MISC;
    if (F.tid < 64) MISC[F.tid] = 0u;
    __syncthreads();
    XcdBarrier bar; bar.bar = (unsigned*)(F.ws + WS_CTL) + CW_BAR; bar.x = 0; bar.st = nullptr;
    if (N_LAUNCHES == 1) bar = xcd_barrier_post((unsigned*)(F.ws + WS_CTL) + CW_BAR, MISC + 8);
    const int lo = args.ph_lo, hi = args.ph_hi;
#define IN(k) (lo <= (k) && (k) < hi)
#if MK_PROBE_HI > 0
#define STAMP(k) do { if (F.bid == 0 && F.wave == 0 && F.lane == 0) { const unsigned long long _t = __builtin_amdgcn_s_memrealtime(); MISC[16 + 2 * (k)] = (unsigned)_t; MISC[17 + 2 * (k)] = (unsigned)(_t >> 32); } } while (0)
#else
#define STAMP(k) do { } while (0)
#endif
#define SEAM(k) do { if (IN(k) && IN((k) + 1)) xcd_barrier(bar); } while (0)
    const float* mod = (const float*)(F.ws + WS_MOD);
    STAMP(0);
    if (IN(0)) { p0a(F); SEAM(0); }
    STAMP(1);
    if (IN(1)) { norm_rows<2>(F, F.x, F.norm1_g, mod + 0, mod + 1024, nullptr, F.dout + DO_H); SEAM(1); }
    STAMP(2);
    if (IN(2)) {
        pg8::Gemm g{(const bf16*)(F.dout + DO_H), (const bf16*)(F.ws + WS_WIN), MT, NIN, 512}; pg8::StaticOrder S; S.init(MT, NIN, F.G, F.bid);
        pg8::EpiProj E{(bf16*)(F.dout + DO_Q), (bf16*)(F.dout + DO_K), (bf16*)(F.ws + WS_V), (bf16*)(F.ws + WS_G), (bf16*)(F.ws + WS_U), (bf16*)(F.ws + WS_SV), (bf16*)(F.ws + WS_GA), (bf16*)(F.ws + WS_GB),
                       (const float*)(F.ws + WS_COS), (const float*)(F.ws + WS_SIN), 1.0f / 4096.0f, (float*)(F.ws + WS_SVSTAT)};
        pg8::gemm_phase<pg8::EpiProj, pg8::StaticOrder, true, true, true>(F.lds, g, S, E);
        SEAM(2);
    }
    STAMP(3);
    if (IN(3)) { p2a(F); SEAM(3); }
    STAMP(4);
    if (IN(4)) { p2b(F); SEAM(4); }
    STAMP(5);
    if (IN(5)) { p2c(F); SEAM(5); }
    STAMP(6);
    if (IN(6)) {
        pg8::StaticOrder S; S.init(MT, DM, F.G, F.bid);
        pg8::Gemm g{(const bf16*)(F.ws + WS_YG8), (const bf16*)(F.ws + WS_WRET), MT, DM, 1024, 512, (const bf16*)(F.ws + WS_YS8), (const bf16*)(F.ws + WS_WSGU), 8};
        pg8::EpiMerged E{(const bf16*)(F.ws + WS_GA), (const bf16*)(F.ws + WS_GB), F.ws + WS_MRG8, 1.0f / 4096.0f};
        pg8::gemm_phase<pg8::EpiMerged, pg8::StaticOrder, true, true, true>(F.lds, g, S, E);
        SEAM(6);
    }
    STAMP(7);
    if (IN(7)) {
        pg8::Gemm g{(const bf16*)(F.ws + WS_MRG8), (const bf16*)(F.ws + WS_WOUT), MT, DM, 512}; pg8::StaticOrder S; S.init(MT, DM, F.G, F.bid);
        pg8::EpiX1 E{F.x, mod + 2048, (float*)F.dout, 1.0f / 4096.0f};
        pg8::gemm_phase<pg8::EpiX1, pg8::StaticOrder, true, true, true>(F.lds, g, S, E);
        SEAM(7);
    }
    STAMP(8);
    if (IN(8)) { norm_rows<1>(F, (const float*)F.dout, F.norm2_g, mod + 3072, mod + 4096, (bf16*)(F.ws + WS_SV), F.ws + WS_H2F8); SEAM(8); }
    STAMP(9);
    if (IN(9)) {
        pg8::Gemm g{(const bf16*)(F.ws + WS_SV), (const bf16*)(F.ws + WS_WQ), MT, 2048, DM}; pg8::StaticOrder S; S.init(MT, 2048, F.G, F.bid);
        pg8::EpiPlain E{(bf16*)(F.ws + WS_GA), 2048};
        pg8::gemm_phase<pg8::EpiPlain, pg8::StaticOrder, true, true>(F.lds, g, S, E);
        SEAM(9);
    }
    STAMP(10);
    if (IN(10)) { p5b(F); SEAM(10); }
    STAMP(11);
    if (IN(11)) { p6a(F); SEAM(11); }
    STAMP(12);
    if (IN(12)) { p6b(F); SEAM(12); }
    STAMP(13);
    if (IN(13)) { p6b2(F); SEAM(13); }
    STAMP(14);
    if (IN(14)) { p6c(F); SEAM(14); }
    STAMP(15);
    if (IN(15)) { p6d(F); }
    STAMP(16);
#if MK_PROBE_HI > 0
    __syncthreads();
    if (F.bid == 0 && F.tid == 0) { const unsigned long long t0 = ((unsigned long long)MISC[17 + 2 * MK_PROBE_LO] << 32) | MISC[16 + 2 * MK_PROBE_LO], t1 = ((unsigned long long)MISC[17 + 2 * MK_PROBE_HI] << 32) | MISC[16 + 2 * MK_PROBE_HI];
#if MK_GPROBE == 1
        ((float*)F.dout)[0] += (float)MISC[56] * 1e-3f; }
#elif MK_GPROBE == 2
        ((float*)F.dout)[0] += (float)MISC[57] * 1e-3f; }
#else
        ((float*)F.dout)[0] += (float)(t1 - t0) * 1e-3f; }
#endif
#endif
#undef IN
#undef SEAM
}

extern "C" void kernel_launch(void* const* d_in, const int* in_sizes, int n_in, void* d_out, int out_size, void* d_ws, size_t ws_size, hipStream_t stream) {
    static int grid = 0;
    if (grid == 0) {
        if (n_in != 20 || out_size != MT * DM || ws_size < WS_END) { fprintf(stderr, "kernel_launch: unexpected shapes (n_in %d, out %d, ws %zu); nothing launched\n", n_in, out_size, ws_size); grid = -1; return; }
        int dev = 0, cus = 0, per_cu = 0;
        if (hipGetDevice(&dev) != hipSuccess || hipDeviceGetAttribute(&cus, hipDeviceAttributeMultiprocessorCount, dev) != hipSuccess) { grid = -1; return; }
        if (hipFuncSetAttribute((const void*)mk_fwd, hipFuncAttributeMaxDynamicSharedMemorySize, LDS_BYTES) != hipSuccess) { fprintf(stderr, "kernel_launch: hipFuncSetAttribute failed\n"); grid = -1; return; }
        if (hipOccupancyMaxActiveBlocksPerMultiprocessor(&per_cu, (const void*)mk_fwd, NWAVES * 64, LDS_BYTES) != hipSuccess || per_cu < 1)
            fprintf(stderr, "kernel_launch: note: occupancy query reports %d workgroups per CU\n", per_cu);
        (void)hipGetLastError();
        grid = cus;
    }
    if (grid < 0) return;
    if (hipMemsetAsync((char*)d_ws + WS_CTL, 0, CTL_ZERO_BYTES, stream) != hipSuccess) { fprintf(stderr, "kernel_launch: memset failed\n"); return; }
    Args a{};
    for (int i = 0; i < 20; ++i) a.in[i] = (const float*)d_in[i];
    a.out = (float*)d_out; a.ws = (unsigned char*)d_ws;
    static_assert(N_LAUNCHES == 1 || N_LAUNCHES == N_PHASES, "N_LAUNCHES is 1 or N_PHASES");
    for (int li = 0; li < N_LAUNCHES && li < MK_MAXPH; ++li) {
        a.ph_lo = (N_LAUNCHES == 1) ? 0 : li; a.ph_hi = (N_LAUNCHES == 1) ? N_PHASES : li + 1; a.li = li;
        hipLaunchKernelGGL(mk_fwd, dim3(grid), dim3(NWAVES * 64), LDS_BYTES, stream, a);
        const hipError_t le = hipPeekAtLastError();
        if (le != hipSuccess) { fprintf(stderr, "kernel_launch: launch %d failed: %s\n", li, hipGetErrorName(le)); break; }
    }
}
```

```cpp
#include <hip/hip_runtime.h>
#include <cstdio>
#include <cstdint>

#ifndef MK_PROBE_LO
#define MK_PROBE_LO 0
#define MK_PROBE_HI 0
#endif
#ifndef MK_GPROBE
#define MK_GPROBE 0
#endif
#define MK_MISC_OFF (147456 - 256)
#ifndef MK_U4
#define MK_U4 1
#endif
#ifndef MK_ALAY
#define MK_ALAY 2
#endif
#ifndef MK_MAXPH
#define MK_MAXPH 16
#endif
#ifndef MK_N_LAUNCHES
#define MK_N_LAUNCHES 1
#endif
namespace pg8 {
#define PG8_LAS __attribute__((address_space(3)))
typedef unsigned short bf16_t;
typedef short bf16x8 __attribute__((ext_vector_type(8)));
typedef float f32x4 __attribute__((ext_vector_type(4)));
typedef unsigned u32x4 __attribute__((ext_vector_type(4)));
constexpr int BM = 256, BK = 64, HALF = 128, HTB = HALF * BK * 2  , STAGE_BYTES = 8 * HTB, NXCD = 8, WGM = 2;

__host__ __device__ __forceinline__ int lds_byte(int r, int c) { const int st = (r >> 4) * 2 + (c >> 5), rr = r & 15, cc = c & 31, ob = rr * 64 + cc * 2; return st * 1024 + (ob ^ (((ob >> 9) & 1) << 5)); }
__host__ __device__ __forceinline__ void stage_rc(int b, int& R, int& C) { const int st = b / 1024, sb = b % 1024, swz = sb ^ (((sb >> 9) & 1) << 5); R = (st >> 1) * 16 + swz / 64; C = (st & 1) * 32 + (swz % 64) / 2; }
__host__ __device__ __forceinline__ int perm32(int rho) { const int n = rho >> 4, i = rho & 15; return 8 * (i >> 2) + 4 * n + (i & 3); }

struct Unit { int pm, pn; };
struct Gemm { const bf16_t* A; const bf16_t* Bt; int M, N, K; int ld = 0; const bf16_t* A2 = nullptr; const bf16_t* Bt2 = nullptr; int ksplit = 0; };

struct StaticOrder {
    int nM, nN, nwg, G, c;
    __host__ __device__ void init(int M, int N, int G_, int c_) { nM = M / BM; nN = N / BM; nwg = nM * nN; G = G_; c = c_; }
    __host__ __device__ bool next(int i, Unit& u) const {
        const long L = (long)i * G + c; if (L >= nwg) return false;
        int wgid = (int)L; { const int q = nwg / NXCD, r = nwg % NXCD, xcd = wgid % NXCD, off = wgid / NXCD; wgid = (xcd < r ? xcd * (q + 1) : r * (q + 1) + (xcd - r) * q) + off; }
        const int nig = WGM * nN, gid = wgid / nig, fm = gid * WGM, gsz = (nM - fm) < WGM ? (nM - fm) : WGM;
        u.pm = fm + ((wgid % nig) % gsz); u.pn = (wgid % nig) / gsz; return true;
    }
    __device__ __forceinline__ void a_ready(const Unit&) const {}
    __device__ __forceinline__ void done(const Unit&) const {}
};

__device__ __forceinline__ unsigned cvt_pk_bf16(float lo, float hi) { unsigned r; asm volatile("v_cvt_pk_bf16_f32 %0, %1, %2" : "=v"(r) : "v"(lo), "v"(hi)); return r; }
typedef float f32x2 __attribute__((ext_vector_type(2)));
__device__ __forceinline__ f32x2 gelu_pk(f32x2 v) {
    const f32x2 av = __builtin_elementwise_abs(v), d = av * 0.2316418882f + 1.0f;
    f32x2 t; t.x = __builtin_amdgcn_rcpf(d.x); t.y = __builtin_amdgcn_rcpf(d.y);
    f32x2 q = t * 0.5307027145f + (-0.7265760135f); q = q * t + 0.7107068705f; q = q * t + (-0.142248368f); q = q * t + 0.127414796f; q = q * t;
    const f32x2 s = (v * v) * (-0.72134752044f);
    f32x2 e; e.x = __builtin_amdgcn_exp2f(s.x); e.y = __builtin_amdgcn_exp2f(s.y);
    const f32x2 m = v * (q * e), r = v - m;
    f32x2 o; o.x = v.x < 0.f ? m.x : r.x; o.y = v.y < 0.f ? m.y : r.y; return o;
}


typedef unsigned u32x2 __attribute__((ext_vector_type(2)));
__device__ __forceinline__ float bflo(unsigned w) { return __uint_as_float(w << 16); }
__device__ __forceinline__ float bfhi(unsigned w) { return __uint_as_float(w & 0xffff0000u); }
__device__ __forceinline__ float gelu1(float v) {
    const float av = __builtin_fabsf(v), t = __builtin_amdgcn_rcpf(av * 0.2316418882f + 1.0f);
    float q = t * 0.5307027145f + (-0.7265760135f); q = q * t + 0.7107068705f; q = q * t + (-0.142248368f); q = q * t + 0.127414796f; q = q * t;
    const float e = __builtin_amdgcn_exp2f((v * v) * (-0.72134752044f));
    const float m = v * (q * e);
    return v < 0.f ? m : v - m;
}
__device__ __forceinline__ float sigm1(float v) { return __builtin_amdgcn_rcpf(1.0f + __builtin_amdgcn_exp2f(v * (-1.44269504089f))); }
__device__ __forceinline__ float silu1(float v) { return v * sigm1(v); }

__device__ __forceinline__ unsigned bperm(int idx, unsigned v) { return (unsigned)__builtin_amdgcn_ds_bpermute(idx, (int)v); }
__device__ __forceinline__ float bpermf(int idx, float v) { return __int_as_float(__builtin_amdgcn_ds_bpermute(idx, __float_as_int(v))); }
__device__ __forceinline__ f32x4 bperm4(int idx, const f32x4& v) { return (f32x4){bpermf(idx, v[0]), bpermf(idx, v[1]), bpermf(idx, v[2]), bpermf(idx, v[3])}; }
__device__ __forceinline__ u32x4 bperm4u(int idx, const u32x4& v) { u32x4 r; r.x = bperm(idx, v.x); r.y = bperm(idx, v.y); r.z = bperm(idx, v.z); r.w = bperm(idx, v.w); return r; }
#define PG8_REMAP() const int lane_ = 16 * fq + fr, pidx = (16 * (lane_ & 3) + (lane_ >> 2)) * 4, fr2 = lane_ >> 2, fq2 = lane_ & 3

struct EpiProj {
    static constexpr bool PERM = true, AFTER_DRAIN = false, HAS_MID = false;
    bf16_t *Q, *Kb, *V, *G, *U, *SV, *GA, *GB; const float *cosT, *sinT; float osc; float* svstat;
    __device__ __forceinline__ void operator()(const f32x4 (&acc)[2][2][4][2], const Unit& u, int wr, int wc, int fr, int fq) const {
        PG8_REMAP();
        const int colt = u.pn * BM; const int row0 = u.pm * BM + wr * 64 + fr2;
        if (colt < 1024) {
            const bool isk = colt >= 512; bf16_t* base = isk ? Kb : Q; const int lc0 = (colt & 511) + wc * 32 + 8 * fq2; const float sc = (isk ? 0.08838834764831845f : 1.0f) * osc;
            const int fi = wc * 16 + 4 * fq2;
#pragma unroll
            for (int ai = 0; ai < 2; ++ai) {
                f32x4 csv[4], snv[4];
#pragma unroll
                for (int m = 0; m < 4; ++m) { const int s = (row0 + ai * HALF + m * 16) & 4095; csv[m] = *(const f32x4*)(cosT + s * 64 + fi) * sc; snv[m] = *(const f32x4*)(sinT + s * 64 + fi) * sc; }
#pragma unroll
                for (int m = 0; m < 4; ++m) { const int row = row0 + ai * HALF + m * 16; const f32x4 cs = csv[m], sn = snv[m];
#pragma unroll
                    for (int bj = 0; bj < 2; ++bj) { const f32x4 v0 = bperm4(pidx, acc[ai][bj][m][0]), v1 = bperm4(pidx, acc[ai][bj][m][1]);
                        u32x4 w;
                        w.x = cvt_pk_bf16(v0[0] * cs[0] - v0[1] * sn[0], v0[0] * sn[0] + v0[1] * cs[0]);
                        w.y = cvt_pk_bf16(v0[2] * cs[1] - v0[3] * sn[1], v0[2] * sn[1] + v0[3] * cs[1]);
                        w.z = cvt_pk_bf16(v1[0] * cs[2] - v1[1] * sn[2], v1[0] * sn[2] + v1[1] * cs[2]);
                        w.w = cvt_pk_bf16(v1[2] * cs[3] - v1[3] * sn[3], v1[2] * sn[3] + v1[3] * cs[3]);
                        *(u32x4*)(base + (size_t)row * 512 + lc0 + bj * HALF) = w; } } }
        } else {
            const int seg = (colt - 1024) >> 10;
            bf16_t* base = seg == 0 ? V : seg == 1 ? G : seg == 2 ? U : seg == 3 ? SV : seg == 4 ? GA : GB;
            const int lc0 = ((colt - 1024) & 1023) + wc * 32 + 8 * fq2;
#pragma unroll
            for (int ai = 0; ai < 2; ++ai)
#pragma unroll
                for (int m = 0; m < 4; ++m) { const int row = row0 + ai * HALF + m * 16; float s1[2] = {0.f, 0.f}, s2[2] = {0.f, 0.f};
#pragma unroll
                    for (int bj = 0; bj < 2; ++bj) { f32x4 v0 = acc[ai][bj][m][0] * osc, v1 = acc[ai][bj][m][1] * osc;
                        if (seg == 1) {
#pragma unroll
                            for (int e = 0; e < 4; ++e) { v0[e] = silu1(v0[e]); v1[e] = silu1(v1[e]); }
                        } else if (seg == 2 || seg == 3) {
                            f32x2 a = gelu_pk((f32x2){v0[0], v0[1]}), b = gelu_pk((f32x2){v0[2], v0[3]}), c = gelu_pk((f32x2){v1[0], v1[1]}), d = gelu_pk((f32x2){v1[2], v1[3]});
                            v0 = (f32x4){a.x, a.y, b.x, b.y}; v1 = (f32x4){c.x, c.y, d.x, d.y};
                        } else if (seg >= 4) {
#pragma unroll
                            for (int e = 0; e < 4; ++e) { v0[e] = sigm1(v0[e]); v1[e] = sigm1(v1[e]); }
                        }
                        if (seg == 3) { s1[bj] = ((v0[0] + v0[1]) + (v0[2] + v0[3])) + ((v1[0] + v1[1]) + (v1[2] + v1[3]));
                            s2[bj] = ((v0[0] * v0[0] + v0[1] * v0[1]) + (v0[2] * v0[2] + v0[3] * v0[3])) + ((v1[0] * v1[0] + v1[1] * v1[1]) + (v1[2] * v1[2] + v1[3] * v1[3])); }
                        u32x4 w; w.x = cvt_pk_bf16(v0[0], v0[1]); w.y = cvt_pk_bf16(v0[2], v0[3]); w.z = cvt_pk_bf16(v1[0], v1[1]); w.w = cvt_pk_bf16(v1[2], v1[3]);
                        *(u32x4*)(base + (size_t)row * 1024 + lc0 + bj * HALF) = bperm4u(pidx, w); }
                    if (seg == 3) {
                        float a = s1[0] + s1[1], b = s2[0] + s2[1];
                        a += __shfl_xor(a, 16); b += __shfl_xor(b, 16); a += __shfl_xor(a, 32); b += __shfl_xor(b, 32);
                        if (fq == 0) { float* sp = svstat + (size_t)(u.pm * BM + wr * 64 + fr + ai * HALF + m * 16) * 2; atomicAdd(sp, a); atomicAdd(sp + 1, b); } } }
        }
    }
};
template <bool ACCUM> struct EpiGate {
    static constexpr bool PERM = true, AFTER_DRAIN = false, HAS_MID = false;
    const bf16_t* GT; bf16_t* TMP; unsigned char* OUT8; float osc;
    __device__ __forceinline__ void operator()(const f32x4 (&acc)[2][2][4][2], const Unit& u, int wr, int wc, int fr, int fq) const {
        PG8_REMAP();
        const int row0 = u.pm * BM + wr * 64 + fr2, col0 = u.pn * BM + wc * 32 + 8 * fq2;
#pragma unroll
        for (int ai = 0; ai < 2; ++ai)
#pragma unroll
            for (int mp = 0; mp < 2; ++mp) {
                u32x4 gv[2][2], pv[2][2];
#pragma unroll
                for (int mm = 0; mm < 2; ++mm)
#pragma unroll
                    for (int bj = 0; bj < 2; ++bj) { const size_t off = (size_t)(row0 + ai * HALF + (2 * mp + mm) * 16) * 1024 + col0 + bj * HALF;
                        gv[mm][bj] = *(const u32x4*)(GT + off); if (ACCUM) pv[mm][bj] = *(const u32x4*)(TMP + off); }
#pragma unroll
                for (int mm = 0; mm < 2; ++mm)
#pragma unroll
                    for (int bj = 0; bj < 2; ++bj) { const int m = 2 * mp + mm; const size_t off = (size_t)(row0 + ai * HALF + m * 16) * 1024 + col0 + bj * HALF;
                        const f32x4 v0 = bperm4(pidx, acc[ai][bj][m][0]) * osc, v1 = bperm4(pidx, acc[ai][bj][m][1]) * osc; const u32x4 g = gv[mm][bj];
                        float o[8] = {v0[0] * bflo(g.x), v0[1] * bfhi(g.x), v0[2] * bflo(g.y), v0[3] * bfhi(g.y), v1[0] * bflo(g.z), v1[1] * bfhi(g.z), v1[2] * bflo(g.w), v1[3] * bfhi(g.w)};
                        if (ACCUM) { const u32x4 p = pv[mm][bj];
                            o[0] += bflo(p.x); o[1] += bfhi(p.x); o[2] += bflo(p.y); o[3] += bfhi(p.y); o[4] += bflo(p.z); o[5] += bfhi(p.z); o[6] += bflo(p.w); o[7] += bfhi(p.w);
                            u32x2 w8; int t0 = __builtin_amdgcn_cvt_pk_fp8_f32(o[0] * 8.f, o[1] * 8.f, 0, false); t0 = __builtin_amdgcn_cvt_pk_fp8_f32(o[2] * 8.f, o[3] * 8.f, t0, true);
                            int t1 = __builtin_amdgcn_cvt_pk_fp8_f32(o[4] * 8.f, o[5] * 8.f, 0, false); t1 = __builtin_amdgcn_cvt_pk_fp8_f32(o[6] * 8.f, o[7] * 8.f, t1, true);
                            w8.x = (unsigned)t0; w8.y = (unsigned)t1; *(u32x2*)(OUT8 + off) = w8;
                        } else {
                            u32x4 w; w.x = cvt_pk_bf16(o[0], o[1]); w.y = cvt_pk_bf16(o[2], o[3]); w.z = cvt_pk_bf16(o[4], o[5]); w.w = cvt_pk_bf16(o[6], o[7]);
                            *(u32x4*)(TMP + off) = w; } }
            }
    }
};
struct EpiMerged {
    static constexpr bool PERM = true, AFTER_DRAIN = false, HAS_MID = true;
    const bf16_t* GA; const bf16_t* GB; unsigned char* OUT8; float osc;
    __device__ __forceinline__ void mid(f32x4 (&acc)[2][2][4][2], const Unit& u, int wr, int wc, int fr, int fq) const {
        int fr_ = fr, fq_ = fq; asm volatile("" : "+v"(fr_), "+v"(fq_));
        const int row0 = u.pm * BM + wr * 64 + fr_, col0 = u.pn * BM + wc * 32 + 8 * fq_;
#pragma unroll
        for (int ai = 0; ai < 2; ++ai)
#pragma unroll
            for (int mp = 0; mp < 2; ++mp) {
                u32x4 av[2][2], bv[2][2];
#pragma unroll
                for (int mm = 0; mm < 2; ++mm)
#pragma unroll
                    for (int bj = 0; bj < 2; ++bj) { const size_t off = (size_t)(row0 + ai * HALF + (2 * mp + mm) * 16) * 1024 + col0 + bj * HALF; av[mm][bj] = *(const u32x4*)(GA + off); bv[mm][bj] = *(const u32x4*)(GB + off); }
#pragma unroll
                for (int mm = 0; mm < 2; ++mm)
#pragma unroll
                    for (int bj = 0; bj < 2; ++bj) { const int m = 2 * mp + mm; const u32x4 a = av[mm][bj], b = bv[mm][bj];
                        acc[ai][bj][m][0][0] *= 2.f * bflo(a.x) * __builtin_amdgcn_rcpf(bflo(b.x)); acc[ai][bj][m][0][1] *= 2.f * bfhi(a.x) * __builtin_amdgcn_rcpf(bfhi(b.x));
                        acc[ai][bj][m][0][2] *= 2.f * bflo(a.y) * __builtin_amdgcn_rcpf(bflo(b.y)); acc[ai][bj][m][0][3] *= 2.f * bfhi(a.y) * __builtin_amdgcn_rcpf(bfhi(b.y));
                        acc[ai][bj][m][1][0] *= 2.f * bflo(a.z) * __builtin_amdgcn_rcpf(bflo(b.z)); acc[ai][bj][m][1][1] *= 2.f * bfhi(a.z) * __builtin_amdgcn_rcpf(bfhi(b.z));
                        acc[ai][bj][m][1][2] *= 2.f * bflo(a.w) * __builtin_amdgcn_rcpf(bflo(b.w)); acc[ai][bj][m][1][3] *= 2.f * bfhi(a.w) * __builtin_amdgcn_rcpf(bfhi(b.w)); }
            }
    }
    __device__ __forceinline__ void operator()(const f32x4 (&acc)[2][2][4][2], const Unit& u, int wr, int wc, int fr, int fq) const {
        PG8_REMAP();
        const int row0 = u.pm * BM + wr * 64 + fr2, col0 = u.pn * BM + wc * 32 + 8 * fq2; const float sc = osc * 8.f;
#pragma unroll
        for (int ai = 0; ai < 2; ++ai)
#pragma unroll
            for (int mp = 0; mp < 2; ++mp) {
                u32x4 gv[2][2];
#pragma unroll
                for (int mm = 0; mm < 2; ++mm)
#pragma unroll
                    for (int bj = 0; bj < 2; ++bj) gv[mm][bj] = *(const u32x4*)(GB + (size_t)(row0 + ai * HALF + (2 * mp + mm) * 16) * 1024 + col0 + bj * HALF);
#pragma unroll
                for (int mm = 0; mm < 2; ++mm)
#pragma unroll
                    for (int bj = 0; bj < 2; ++bj) { const int m = 2 * mp + mm; const size_t off = (size_t)(row0 + ai * HALF + m * 16) * 1024 + col0 + bj * HALF;
                        const f32x4 v0 = bperm4(pidx, acc[ai][bj][m][0]) * sc, v1 = bperm4(pidx, acc[ai][bj][m][1]) * sc; const u32x4 g = gv[mm][bj];
                        u32x2 w8; int t0 = __builtin_amdgcn_cvt_pk_fp8_f32(v0[0] * bflo(g.x), v0[1] * bfhi(g.x), 0, false); t0 = __builtin_amdgcn_cvt_pk_fp8_f32(v0[2] * bflo(g.y), v0[3] * bfhi(g.y), t0, true);
                        int t1 = __builtin_amdgcn_cvt_pk_fp8_f32(v1[0] * bflo(g.z), v1[1] * bfhi(g.z), 0, false); t1 = __builtin_amdgcn_cvt_pk_fp8_f32(v1[2] * bflo(g.w), v1[3] * bfhi(g.w), t1, true);
                        w8.x = (unsigned)t0; w8.y = (unsigned)t1; *(u32x2*)(OUT8 + off) = w8; }
            }
    }
};
struct EpiX1 {
    static constexpr bool PERM = false, AFTER_DRAIN = false, HAS_MID = false;
    const float* X; const float* gate1; float* X1; float osc;
    __device__ __forceinline__ void operator()(const f32x4 (&acc)[2][2][4][2], const Unit& u, int wr, int wc, int fr, int fq) const {
        PG8_REMAP();
        const int row0 = u.pm * BM + wr * 64 + fr2, col0 = u.pn * BM + wc * 32 + 4 * fq2;
        const float* gp = gate1 + (size_t)((u.pm * BM) >> 12) * 6144 + col0;
        f32x4 gv[2][2];
#pragma unroll
        for (int bj = 0; bj < 2; ++bj)
#pragma unroll
            for (int n = 0; n < 2; ++n) gv[bj][n] = *(const f32x4*)(gp + bj * HALF + n * 16) * osc;
#pragma unroll
        for (int ai = 0; ai < 2; ++ai)
#pragma unroll
            for (int mp = 0; mp < 2; ++mp) {
                f32x4 xv[2][2][2];
#pragma unroll
                for (int mm = 0; mm < 2; ++mm) { const size_t off = (size_t)(row0 + ai * HALF + (2 * mp + mm) * 16) * 1024 + col0;
#pragma unroll
                    for (int bj = 0; bj < 2; ++bj)
#pragma unroll
                        for (int n = 0; n < 2; ++n) xv[mm][bj][n] = *(const f32x4*)(X + off + bj * HALF + n * 16); }
#pragma unroll
                for (int mm = 0; mm < 2; ++mm) { const int m = 2 * mp + mm; const size_t off = (size_t)(row0 + ai * HALF + m * 16) * 1024 + col0;
#pragma unroll
                    for (int bj = 0; bj < 2; ++bj)
#pragma unroll
                        for (int n = 0; n < 2; ++n) *(f32x4*)(X1 + off + bj * HALF + n * 16) = xv[mm][bj][n] + gv[bj][n] * bperm4(pidx, acc[ai][bj][m][n]); }
            }
    }
};
struct EpiPlain {
    static constexpr bool PERM = true, AFTER_DRAIN = false, HAS_MID = false;
    bf16_t* O; int ldc;
    __device__ __forceinline__ void operator()(const f32x4 (&acc)[2][2][4][2], const Unit& u, int wr, int wc, int fr, int fq) const {
        PG8_REMAP();
        const int row0 = u.pm * BM + wr * 64 + fr2, col0 = u.pn * BM + wc * 32 + 8 * fq2;
#pragma unroll
        for (int ai = 0; ai < 2; ++ai)
#pragma unroll
            for (int m = 0; m < 4; ++m) { bf16_t* rowp = O + (size_t)(row0 + ai * HALF + m * 16) * ldc + col0;
#pragma unroll
                for (int bj = 0; bj < 2; ++bj) { const f32x4 v0 = acc[ai][bj][m][0], v1 = acc[ai][bj][m][1];
                    u32x4 w; w.x = cvt_pk_bf16(v0[0], v0[1]); w.y = cvt_pk_bf16(v0[2], v0[3]); w.z = cvt_pk_bf16(v1[0], v1[1]); w.w = cvt_pk_bf16(v1[2], v1[3]);
                    *(u32x4*)(rowp + bj * HALF) = bperm4u(pidx, w); } }
    }
};
typedef int v8i_t __attribute__((ext_vector_type(8)));
typedef int v4i_t __attribute__((ext_vector_type(4)));
template <bool F8> __device__ __forceinline__ void mma_block(f32x4 (&acc)[4][2], const bf16x8 (&At)[4][2], const bf16x8 (&Bt)[2][2]) {
    if constexpr (F8) {
        v8i_t bb[2];
#pragma unroll
        for (int n = 0; n < 2; ++n) bb[n] = __builtin_shufflevector(__builtin_bit_cast(v4i_t, Bt[n][0]), __builtin_bit_cast(v4i_t, Bt[n][1]), 0, 1, 2, 3, 4, 5, 6, 7);
#pragma unroll
        for (int m = 0; m < 4; ++m) { const v8i_t aa = __builtin_shufflevector(__builtin_bit_cast(v4i_t, At[m][0]), __builtin_bit_cast(v4i_t, At[m][1]), 0, 1, 2, 3, 4, 5, 6, 7);
#pragma unroll
            for (int n = 0; n < 2; ++n) asm volatile("v_mfma_scale_f32_16x16x128_f8f6f4 %0, %1, %2, %0, %3, %3 op_sel_hi:[0,0,0]" : "+v"(acc[m][n]) : "v"(bb[n]), "v"(aa), "v"(0x7F7F7F7F)); }
    } else {
#pragma unroll
        for (int m = 0; m < 4; ++m)
#pragma unroll
            for (int n = 0; n < 2; ++n)
#pragma unroll
                for (int k = 0; k < 2; ++k) acc[m][n] = __builtin_amdgcn_mfma_f32_16x16x32_bf16(Bt[n][k], At[m][k], acc[m][n], 0, 0, 0);
    }
}
template <class Epi, class Sched, bool ALIGN_EPI = false, bool SP2 = false, bool F8 = false>
__device__ __forceinline__ void gemm_phase(PG8_LAS unsigned char* lds, const Gemm g, const Sched& S, const Epi& E) {
    const int tid = threadIdx.x, wid = __builtin_amdgcn_readfirstlane(tid >> 6), lane = tid & 63, wr = wid >> 2, wc = wid & 3, fr = lane & 15, fq = lane >> 4;
    const int K = g.K, nt = K / BK, LD = g.ld ? g.ld : g.K, nh = g.ksplit ? g.ksplit : nt;
    unsigned voffA[2], voffB[2];
#pragma unroll
    for (int i = 0; i < 2; ++i) { int R, C; stage_rc(tid * 16 + i * 8192, R, C); const int Rb = Epi::PERM ? ((R & ~31) + perm32(R & 31)) : R;
        voffA[i] = (unsigned)(R * LD + C) * 2u; voffB[i] = (unsigned)(Rb * LD + C) * 2u; }
    const size_t kstep = (size_t)(BK * 2);
    const size_t hstep = (size_t)HALF * LD * 2;
    const size_t tstep = 2 * hstep;
    const unsigned ldsw = (unsigned)wid * 1024u;
    const int aoff = lds_byte(wr * 64 + fr, fq * 8), boff = lds_byte(wc * 32 + fr, fq * 8);
#define PG8_SA(b, h) (((b) * 2 + (h)) * HTB)
#define PG8_SB(b, h) ((4 + (b) * 2 + (h)) * HTB)
#define PG8_STAGE(bufoff, gbase, voff) do { _Pragma("unroll") for (int _i = 0; _i < 2; ++_i) \
        __builtin_amdgcn_global_load_lds((const unsigned*)((const char*)(gbase) + (voff)[_i]), (PG8_LAS unsigned*)(lds + (bufoff) + ldsw + _i * 8192), 16, 0, 0); } while (0)
#define PG8_LDA(dst, b, h) do { _Pragma("unroll") for (int m = 0; m < 4; ++m) _Pragma("unroll") for (int k = 0; k < 2; ++k) dst[m][k] = *(const PG8_LAS bf16x8*)(lds + PG8_SA(b, h) + aoff + m * 2048 + k * 1024); } while (0)
#define PG8_LDB(dst, b, h) do { _Pragma("unroll") for (int n = 0; n < 2; ++n) _Pragma("unroll") for (int k = 0; k < 2; ++k) dst[n][k] = *(const PG8_LAS bf16x8*)(lds + PG8_SB(b, h) + boff + n * 2048 + k * 1024); } while (0)
#define PG8_MMA(ai, bj, At, Bt) do { __builtin_amdgcn_s_setprio(1); mma_block<F8>(acc[ai][bj], At, Bt); __builtin_amdgcn_s_setprio(0); } while (0)
#define PG8_WAIT_V(n) asm volatile("s_waitcnt vmcnt(" #n ")" ::: "memory")
#define PG8_WAIT_L(n) asm volatile("s_waitcnt lgkmcnt(" #n ")" ::: "memory")
#define PG8_BAR __builtin_amdgcn_s_barrier()
#define PG8_SCHED __builtin_amdgcn_sched_barrier(0)
    Unit cur, nxt; int ui = 0;
#if MK_GPROBE
    unsigned long long gp_k = 0, gp_e = 0, gp_t = __builtin_amdgcn_s_memrealtime();
#endif
    if (!S.next(0, cur)) return;
    f32x4 acc[2][2][4][2];
#pragma unroll
    for (int a = 0; a < 2; ++a)
#pragma unroll
        for (int b = 0; b < 2; ++b)
#pragma unroll
            for (int m = 0; m < 4; ++m)
#pragma unroll
                for (int n = 0; n < 2; ++n) acc[a][b][m][n] = (f32x4){0.f, 0.f, 0.f, 0.f};
    bf16x8 At[4][2], B0[2][2], B1[2][2];
    const char* cA = (const char*)g.A + (size_t)cur.pm * tstep; const char* cB = (const char*)g.Bt + (size_t)cur.pn * tstep;
    const char* cA2 = g.A2 ? (const char*)g.A2 + (size_t)cur.pm * tstep : cA; const char* cB2 = g.Bt2 ? (const char*)g.Bt2 + (size_t)cur.pn * tstep : cB;
#define PG8_TA(tt) ((tt) < nh ? cA + (size_t)(tt) * kstep : cA2 + (size_t)((tt) - nh) * kstep)
#define PG8_TB(tt) ((tt) < nh ? cB + (size_t)(tt) * kstep : cB2 + (size_t)((tt) - nh) * kstep)
    S.a_ready(cur);
    if constexpr (SP2) {
        PG8_STAGE(PG8_SB(0, 0), cB, voffB); PG8_STAGE(PG8_SB(0, 1), cB + hstep, voffB); PG8_STAGE(PG8_SA(0, 0), cA, voffA); PG8_STAGE(PG8_SA(0, 1), cA + hstep, voffA);
        if (wr == 1) PG8_BAR;
        PG8_WAIT_V(2); PG8_BAR;
        PG8_STAGE(PG8_SB(1, 0), cB + kstep, voffB); PG8_STAGE(PG8_SA(1, 0), cA + kstep, voffA); PG8_STAGE(PG8_SB(1, 1), cB + hstep + kstep, voffB);
        PG8_WAIT_V(6); PG8_BAR;
    } else {
        PG8_STAGE(PG8_SB(0, 0), cB, voffB); PG8_STAGE(PG8_SA(0, 0), cA, voffA); PG8_STAGE(PG8_SB(0, 1), cB + hstep, voffB); PG8_STAGE(PG8_SA(0, 1), cA + hstep, voffA);
        if (wr == 1) PG8_BAR;
        PG8_WAIT_V(4); PG8_BAR;
        PG8_STAGE(PG8_SB(1, 0), cB + kstep, voffB); PG8_STAGE(PG8_SA(1, 0), cA + kstep, voffA); PG8_STAGE(PG8_SB(1, 1), cB + hstep + kstep, voffB);
        PG8_WAIT_V(6); PG8_BAR;
    }
    for (;;) {
        const bool has_next = S.next(ui + 1, nxt);
        const char* nA = has_next ? (const char*)g.A + (size_t)nxt.pm * tstep : cA; const char* nB = has_next ? (const char*)g.Bt + (size_t)nxt.pn * tstep : cB;
#pragma clang loop unroll(disable)
        for (int t = 0; t < nt; t += 2) {
            const bool last = (t == nt - 2);
            const char* a1 = PG8_TA(t + 1);
            const char* a2 = last ? nA : PG8_TA(t + 2); const char* b2 = last ? nB : PG8_TB(t + 2);
            const char* a3 = last ? nA + kstep : PG8_TA(t + 3); const char* b3 = last ? nB + kstep : PG8_TB(t + 3);
            if constexpr (Epi::HAS_MID) { if (t == nh) { if constexpr (F8) asm volatile("s_nop 15\n\ts_nop 15" ::: "memory"); E.mid(acc, cur, wr, wc, fr, fq); } }
            if (last && has_next) S.a_ready(nxt);
            if constexpr (SP2) {
            PG8_LDB(B0, 0, 0); PG8_LDB(B1, 0, 1); PG8_SCHED; PG8_LDA(At, 0, 0); PG8_STAGE(PG8_SA(1, 1), a1 + hstep, voffA);
            PG8_WAIT_V(8); PG8_WAIT_L(0); PG8_BAR; PG8_MMA(0, 0, At, B0); PG8_MMA(0, 1, At, B1); PG8_BAR; PG8_SCHED;
            PG8_LDA(At, 0, 1); PG8_STAGE(PG8_SB(0, 0), b2, voffB); PG8_STAGE(PG8_SB(0, 1), b2 + hstep, voffB); PG8_STAGE(PG8_SA(0, 0), a2, voffA);
            PG8_WAIT_V(8); PG8_WAIT_L(0); PG8_BAR; PG8_MMA(1, 0, At, B0); PG8_MMA(1, 1, At, B1); PG8_BAR; PG8_SCHED;
            PG8_LDB(B0, 1, 0); PG8_LDB(B1, 1, 1); PG8_SCHED; PG8_LDA(At, 1, 0); PG8_STAGE(PG8_SA(0, 1), a2 + hstep, voffA);
            PG8_WAIT_V(8); PG8_WAIT_L(0); PG8_BAR; PG8_MMA(0, 0, At, B0); PG8_MMA(0, 1, At, B1); PG8_BAR; PG8_SCHED;
            PG8_LDA(At, 1, 1); PG8_STAGE(PG8_SB(1, 0), b3, voffB); PG8_STAGE(PG8_SB(1, 1), b3 + hstep, voffB); PG8_STAGE(PG8_SA(1, 0), a3, voffA);
            PG8_WAIT_V(8); PG8_WAIT_L(0); PG8_BAR; PG8_MMA(1, 0, At, B0); PG8_MMA(1, 1, At, B1); PG8_BAR; PG8_SCHED;
            } else {
            PG8_LDB(B0, 0, 0); PG8_SCHED; PG8_LDA(At, 0, 0); PG8_STAGE(PG8_SA(1, 1), a1 + hstep, voffA);
            PG8_WAIT_L(8); PG8_BAR; PG8_WAIT_L(0); PG8_MMA(0, 0, At, B0); PG8_BAR; PG8_SCHED;
            PG8_LDB(B1, 0, 1); PG8_STAGE(PG8_SB(0, 0), b2, voffB);
            PG8_BAR; PG8_WAIT_L(0); PG8_MMA(0, 1, At, B1); PG8_BAR;
            PG8_LDA(At, 0, 1); PG8_STAGE(PG8_SA(0, 0), a2, voffA);
            PG8_BAR; PG8_WAIT_L(0); PG8_MMA(1, 0, At, B0); PG8_BAR; PG8_SCHED;
            PG8_STAGE(PG8_SB(0, 1), b2 + hstep, voffB);
            PG8_WAIT_V(6); PG8_BAR; PG8_MMA(1, 1, At, B1); PG8_BAR;
            PG8_LDB(B0, 1, 0); PG8_SCHED; PG8_LDA(At, 1, 0); PG8_STAGE(PG8_SA(0, 1), a2 + hstep, voffA);
            PG8_WAIT_L(8); PG8_BAR; PG8_WAIT_L(0); PG8_MMA(0, 0, At, B0); PG8_BAR; PG8_SCHED;
            PG8_LDB(B1, 1, 1); PG8_STAGE(PG8_SB(1, 0), b3, voffB);
            PG8_BAR; PG8_WAIT_L(0); PG8_MMA(0, 1, At, B1); PG8_BAR;
            PG8_LDA(At, 1, 1); PG8_STAGE(PG8_SA(1, 0), a3, voffA);
            PG8_BAR; PG8_WAIT_L(0); PG8_MMA(1, 0, At, B0); PG8_BAR; PG8_SCHED;
            PG8_STAGE(PG8_SB(1, 1), b3 + hstep, voffB);
            PG8_WAIT_V(6); PG8_BAR; PG8_MMA(1, 1, At, B1); PG8_BAR;
            }
        }
#if MK_GPROBE
        { const unsigned long long t_ = __builtin_amdgcn_s_memrealtime(); gp_k += t_ - gp_t; gp_t = t_; }
#endif
        if constexpr (F8) asm volatile("s_nop 15\n\ts_nop 15" ::: "memory");
        if constexpr (ALIGN_EPI) { if (wr == 0) PG8_BAR; }
        if constexpr (!Epi::AFTER_DRAIN) { E(acc, cur, wr, wc, fr, fq); S.done(cur); }
#if MK_GPROBE
        { asm volatile("s_waitcnt vmcnt(0)" ::: "memory"); const unsigned long long t_ = __builtin_amdgcn_s_memrealtime(); gp_e += t_ - gp_t; gp_t = t_; }
#endif
        if (!has_next) break;
#pragma unroll
        for (int a = 0; a < 2; ++a)
#pragma unroll
            for (int b = 0; b < 2; ++b)
#pragma unroll
                for (int m = 0; m < 4; ++m)
#pragma unroll
                    for (int n = 0; n < 2; ++n) acc[a][b][m][n] = (f32x4){0.f, 0.f, 0.f, 0.f};
        cur = nxt; cA = nA; cB = nB; ++ui;
        cA2 = g.A2 ? (const char*)g.A2 + (size_t)cur.pm * tstep : cA; cB2 = g.Bt2 ? (const char*)g.Bt2 + (size_t)cur.pn * tstep : cB;
        if constexpr (ALIGN_EPI) { if (wr == 1) PG8_BAR; }
    }
    PG8_WAIT_V(0);
    if constexpr (!ALIGN_EPI) { if (wr == 0) PG8_BAR; }
    PG8_BAR;
    if constexpr (Epi::AFTER_DRAIN) { E.fused(acc, cur, wr, wc, fr, fq, lds, wid, lane); S.done(cur); }
#if MK_GPROBE
    if (blockIdx.x == 0 && wid == 0 && lane == 0) { PG8_LAS unsigned* mq = (PG8_LAS unsigned*)(lds + MK_MISC_OFF); mq[56] += (unsigned)gp_k; mq[57] += (unsigned)gp_e; }
#endif
#undef PG8_SA
#undef PG8_SB
#undef PG8_TA
#undef PG8_TB
#undef PG8_STAGE
#undef PG8_LDA
#undef PG8_LDB
#undef PG8_MMA
#undef PG8_WAIT_V
#undef PG8_WAIT_L
#undef PG8_BAR
#undef PG8_SCHED
}
}

constexpr int NWAVES = 8;
constexpr int N_LAUNCHES = MK_N_LAUNCHES;
constexpr int N_PHASES = 16;
constexpr int NB = 8, SEQ = 4096, DM = 1024, MT = NB * SEQ, NIN = 7168;
constexpr float EPSN = 1e-6f;

constexpr size_t MiB = 1u << 20;
constexpr size_t WS_CTL = 0, CTL_ZERO_BYTES = 1 * MiB;
constexpr size_t WS_SVSTAT = 512 * 1024;
constexpr size_t WS_MOD = 1 * MiB;
constexpr size_t WS_COS = 2 * MiB, WS_SIN = 3 * MiB;
constexpr size_t WS_SK = 4 * MiB;
constexpr size_t WS_SGUW = 4 * MiB + 512 * 1024;
constexpr size_t WS_WRET = 6 * MiB, WS_WSGU = 8 * MiB, WS_WOUT = 10 * MiB, WS_WQ = 12 * MiB, WS_WIN = 16 * MiB;
constexpr size_t WS_UE8 = 32 * MiB, WS_VE8 = 48 * MiB;
constexpr size_t WS_YG8 = 288 * MiB;
constexpr size_t WS_YS8 = 480 * MiB;
constexpr size_t WS_MRG8 = 96 * MiB;
constexpr size_t WS_ACT = 288 * MiB;
constexpr size_t WS_PEERS = 352 * MiB;
constexpr size_t WS_H2F8 = 96 * MiB;
constexpr size_t WS_EID = 128 * MiB, WS_GW = 144 * MiB;
constexpr size_t WS_PD = 160 * MiB;
constexpr size_t WS_V = 96 * MiB;
constexpr size_t WS_G = 160 * MiB;
constexpr size_t WS_U = 224 * MiB;
constexpr size_t WS_SV = 288 * MiB;
constexpr size_t WS_GA = 352 * MiB, WS_GB = 416 * MiB;
constexpr size_t WS_SUB = 480 * MiB;
constexpr size_t WS_END = 512 * MiB;
constexpr size_t DO_H = 0, DO_Q = 64 * MiB, DO_K = 96 * MiB, DO_KVS = 0;

constexpr int CW_BAR = 4096;
constexpr int LDS_BYTES = 147456;
constexpr int MISC_OFF = LDS_BYTES - 256;

#define GAS __attribute__((address_space(1)))
#define LAS __attribute__((address_space(3)))
typedef unsigned short bf16;
typedef unsigned v4u __attribute__((ext_vector_type(4)));
typedef unsigned v2u __attribute__((ext_vector_type(2)));
typedef float f32x4 __attribute__((ext_vector_type(4)));
typedef float f32x2v __attribute__((ext_vector_type(2)));
typedef short bf16x8 __attribute__((ext_vector_type(8)));
typedef short s16x4 __attribute__((ext_vector_type(4)));
typedef __bf16 bf16x2_t __attribute__((ext_vector_type(2)));
typedef GAS unsigned gu32;
#define RLX_AGENT __ATOMIC_RELAXED, __HIP_MEMORY_SCOPE_AGENT
#define LDS_WAIT() asm volatile("s_waitcnt lgkmcnt(0)" ::: "memory")
using pg8::bflo; using pg8::bfhi; using pg8::gelu1;
__device__ __forceinline__ unsigned pk2(float lo, float hi) { f32x2v v = {lo, hi}; bf16x2_t b = __builtin_convertvector(v, bf16x2_t); return __builtin_bit_cast(unsigned, b); }
template <int CTRL> __device__ __forceinline__ float dpp_f(float v) { return __int_as_float(__builtin_amdgcn_update_dpp(0, __float_as_int(v), CTRL, 0xF, 0xF, false)); }
__device__ __forceinline__ float wave_sum(float v) {
    v += dpp_f<0xB1>(v); v += dpp_f<0x4E>(v); v += dpp_f<0x141>(v); v += dpp_f<0x140>(v);
    const int vi = __float_as_int(v);
    return (__int_as_float(__builtin_amdgcn_readlane(vi, 0)) + __int_as_float(__builtin_amdgcn_readlane(vi, 16))) + (__int_as_float(__builtin_amdgcn_readlane(vi, 32)) + __int_as_float(__builtin_amdgcn_readlane(vi, 48)));
}
__device__ __forceinline__ float fexp2(float x) { return __builtin_amdgcn_exp2f(x); }
__device__ __forceinline__ float clamp_f8(float x) { return __builtin_amdgcn_fmed3f(x, -448.0f, 448.0f); }
__device__ __forceinline__ unsigned pk4_fp8(float a, float b, float c, float d) { int w = __builtin_amdgcn_cvt_pk_fp8_f32(clamp_f8(a), clamp_f8(b), 0, false); w = __builtin_amdgcn_cvt_pk_fp8_f32(clamp_f8(c), clamp_f8(d), w, true); return (unsigned)w; }
__device__ __forceinline__ float rl_f(float v, int l) { return __int_as_float(__builtin_amdgcn_readlane(__float_as_int(v), l)); }
__device__ __forceinline__ unsigned rl_u(unsigned v, int l) { return (unsigned)__builtin_amdgcn_readlane((int)v, l); }

#define XB_TMO      128
#define XB_XCNT(j)  (256  + 64 * (j))
#define XB_XSUB(j)  (1280 + 64 * (j))
#define XB_XGEN(j)  (2304 + 64 * (j))
#define XB_TOP      3328
#define XB_TOPGEN   3392
#define XCD_BAR_WORDS 3456
#define XB_SPIN_CAP (1u << 22)
__device__ __forceinline__ unsigned xb_ld(unsigned* p)              { return __hip_atomic_load(p, __ATOMIC_RELAXED, __HIP_MEMORY_SCOPE_AGENT); }
__device__ __forceinline__ unsigned xb_add(unsigned* p, unsigned v) { return __hip_atomic_fetch_add(p, v, __ATOMIC_RELAXED, __HIP_MEMORY_SCOPE_AGENT); }
__device__ __forceinline__ unsigned xb_xcc_id() { return (unsigned)__builtin_amdgcn_s_getreg((3 << 11) | 20) & 0xFu; }
#define XB_SPIN(cond, bar) do { unsigned _sp = 0; while (cond) { __builtin_amdgcn_s_sleep(1); \
    if ((++_sp & 255u) == 0u) { if (xb_ld(&(bar)[XB_TMO])) break; if (_sp > XB_SPIN_CAP) { atomicAdd(&(bar)[XB_TMO], 1u); break; } } } } while (0)
struct XcdBarrier { unsigned* bar; unsigned x; volatile LAS unsigned* st; };
__device__ __forceinline__ XcdBarrier xcd_barrier_post(unsigned* bar, volatile LAS unsigned* st) {
    XcdBarrier b; b.bar = bar; b.x = xb_xcc_id(); b.st = st;
    if (threadIdx.x == 0) (void)xb_add(&bar[XB_XCNT(b.x)], 1u);
    return b;
}
__device__ __forceinline__ void xcd_barrier_complete(unsigned* bar, unsigned x, unsigned& nloc, unsigned& nx) {
    const unsigned G = gridDim.x * gridDim.y * gridDim.z;
    unsigned sum, cnt, mine, sp = 0u;
    for (;;) {
        sum = 0u; cnt = 0u; mine = 0u;
#pragma unroll
        for (unsigned j = 0; j < 16; ++j) { const unsigned c = xb_ld(&bar[XB_XCNT(j)]); sum += c; cnt += (c > 0u) ? 1u : 0u; mine = (j == x) ? c : mine; }
        if (sum == G) break;
        __builtin_amdgcn_s_sleep(1);
        if ((++sp & 255u) == 0u) { if (xb_ld(&bar[XB_TMO])) break; if (sp > XB_SPIN_CAP) { atomicAdd(&bar[XB_TMO], 1u); break; } }
    }
    nloc = mine > 0u ? mine : 1u; nx = cnt > 0u ? cnt : 1u;
}
__device__ __forceinline__ void xcd_barrier(const XcdBarrier& b) {
    asm volatile("s_waitcnt vmcnt(0)" ::: "memory");
    __syncthreads();
    if (threadIdx.x == 0) {
        unsigned* bar = b.bar;
        __builtin_amdgcn_s_waitcnt(0);
        unsigned nloc = b.st[0], nx = b.st[1];
        if (nloc == 0u) { xcd_barrier_complete(bar, b.x, nloc, nx); b.st[0] = nloc; b.st[1] = nx; }
        const unsigned old = xb_add(&bar[XB_XSUB(b.x)], 1u);
        const unsigned gen = old / nloc;
        if (old + 1u == (gen + 1u) * nloc) {
            __builtin_amdgcn_fence(__ATOMIC_RELEASE, "agent");
            asm volatile("s_waitcnt vmcnt(0)" ::: "memory");
            const unsigned og = xb_add(&bar[XB_TOP], 1u);
            const unsigned tg = og / nx;
            if (og + 1u == (tg + 1u) * nx) xb_add(&bar[XB_TOPGEN], 1u);
            else XB_SPIN(xb_ld(&bar[XB_TOPGEN]) == tg, bar);
            __builtin_amdgcn_fence(__ATOMIC_ACQUIRE, "agent");
            xb_add(&bar[XB_XGEN(b.x)], 1u);
            asm volatile("s_waitcnt vmcnt(0)" ::: "memory");
        } else {
            XB_SPIN(xb_ld(&bar[XB_XGEN(b.x)]) == gen, bar);
            __builtin_amdgcn_fence(__ATOMIC_ACQUIRE, "agent");
            asm volatile("s_waitcnt vmcnt(0)" ::: "memory");
        }
    }
    __syncthreads();
}

struct Frame {
    LAS unsigned char* lds;
    int tid, lane, wave, G, bid; volatile LAS unsigned* misc;
    __device__ __forceinline__ void fence_ids() { int t = threadIdx.x; asm volatile("" : "+v"(t)); tid = t; lane = t & 63; }
    const float *x, *c, *w_ada, *b_ada, *norm1_g, *w_in, *ret_gn_g, *sgu_ln_g, *sgu_ln_b, *sgu_w, *sgu_b, *w_ret_out, *w_sgu_out, *w_out, *norm2_g, *peer_w_q, *peer_sub_keys, *peer_u, *peer_v, *final_g;
    unsigned char* ws; unsigned char* dout;
};

__device__ __forceinline__ bf16x8 lds_row_frag(LAS const unsigned char* img, int stride, int r0, int k0, int lane) {
    return *(LAS const bf16x8*)(img + (r0 + (lane & 15)) * stride + (k0 + 8 * (lane >> 4)) * 2);
}
__device__ __forceinline__ s16x4 tr16(LAS const unsigned char* p) { return __builtin_bit_cast(s16x4, __builtin_amdgcn_ds_read_tr16_b64_v4i16((LAS s16x4*)p)); }
__device__ __forceinline__ bf16x8 lds_tr_frag(LAS const unsigned char* img, int stride, int k0, int n0, int lane) {
    const int g = lane >> 4, q = (lane >> 2) & 3, p = lane & 3;
    LAS const unsigned char* a = img + (k0 + 8 * g + q) * stride + (n0 + 4 * p) * 2;
    const s16x4 lo = tr16(a), hi = tr16(a + 4 * stride);
    return __builtin_shufflevector(lo, hi, 0, 1, 2, 3, 4, 5, 6, 7);
}
#define MFMA16(a, b, c) __builtin_amdgcn_mfma_f32_16x16x32_bf16((a), (b), (c), 0, 0, 0)
constexpr int KS = 272, VS = 528;

template <bool F8, class Map>
__device__ __forceinline__ void transpose_item(const float* W, int K, int N, bf16* WT, LAS float* scr, int item, int lane, Map srcmap) {
    const int nblk = N / 32, kb = item / nblk, nb = item % nblk, k0 = 64 * kb, n0 = 32 * nb;
    const int sc = srcmap(n0 + (lane & 31));
#pragma unroll 8
    for (int i = 0; i < 32; ++i) { const int kk = 2 * i + (lane >> 5); scr[kk * 33 + (lane & 31)] = W[(size_t)(k0 + kk) * N + sc]; }
    LDS_WAIT(); asm volatile("" ::: "memory");
    const int c = lane & 7;
#pragma unroll
    for (int j = 0; j < 4; ++j) { const int n = (lane >> 3) + 8 * j; const LAS float* s = scr + (8 * c) * 33 + n;
        if (F8) { v2u o8; o8.x = pk4_fp8(s[0 * 33] * 512.f, s[1 * 33] * 512.f, s[2 * 33] * 512.f, s[3 * 33] * 512.f); o8.y = pk4_fp8(s[4 * 33] * 512.f, s[5 * 33] * 512.f, s[6 * 33] * 512.f, s[7 * 33] * 512.f);
            *(v2u*)((unsigned char*)WT + (size_t)(n0 + n) * K + k0 + 8 * c) = o8; }
        else { v4u o; o.x = pk2(s[0 * 33], s[1 * 33]); o.y = pk2(s[2 * 33], s[3 * 33]); o.z = pk2(s[4 * 33], s[5 * 33]); o.w = pk2(s[6 * 33], s[7 * 33]);
            *(v4u*)(WT + (size_t)(n0 + n) * K + k0 + 8 * c) = o; } }
    LDS_WAIT(); asm volatile("" ::: "memory");
}
struct MapId { __device__ __forceinline__ int operator()(int n) const { return n; } };
struct MapWin { __device__ __forceinline__ int operator()(int n) const { if (n >= 1024) return n; const int ci = n & 127; return (n & ~127) + (ci >> 1) + 64 * (ci & 1); } };

__device__ __forceinline__ void cvt8(const float* src, bf16* dst, size_t chunk) {
    const f32x4 a = *(const f32x4*)(src + chunk * 8), b = *(const f32x4*)(src + chunk * 8 + 4);
    v4u o; o.x = pk2(a[0], a[1]); o.y = pk2(a[2], a[3]); o.z = pk2(b[0], b[1]); o.w = pk2(b[2], b[3]);
    *(v4u*)(dst + chunk * 8) = o;
}

__device__ __forceinline__ void p0a(Frame& F) { F.fence_ids();
    if (F.bid < 192) {
        LAS float* sc = (LAS float*)F.lds; LAS float* part = (LAS float*)(F.lds + 32768);
        for (int i = F.tid; i < 8192; i += 512) { const float cv = F.c[i]; sc[i] = pg8::silu1(cv); }
        __syncthreads();
        const int n0 = 32 * F.bid, ks = F.tid >> 3, c4 = F.tid & 7;
        f32x4 acc[8];
#pragma unroll
        for (int b = 0; b < 8; ++b) acc[b] = (f32x4){0.f, 0.f, 0.f, 0.f};
        for (int kk = ks; kk < 1024; kk += 64) { const f32x4 w = *(const f32x4*)(F.w_ada + (size_t)kk * 6144 + n0 + 4 * c4);
#pragma unroll
            for (int b = 0; b < 8; ++b) acc[b] += w * sc[b * 1024 + kk]; }
#pragma unroll
        for (int b = 0; b < 8; ++b) *(LAS f32x4*)(part + (ks * 8 + b) * 32 + 4 * c4) = acc[b];
        __syncthreads();
        if (F.tid < 256) { const int b = F.tid >> 5, col = F.tid & 31; float s = 0.f;
            for (int k2 = 0; k2 < 64; ++k2) s += part[(k2 * 8 + b) * 32 + col];
            ((float*)(F.ws + WS_MOD))[b * 6144 + n0 + col] = s + F.b_ada[n0 + col]; }
        __syncthreads();
    }
    {
        LAS float* scr = (LAS float*)(F.lds + F.wave * 16384);
        const int gw = F.bid * NWAVES + F.wave, NGW = F.G * NWAVES;
        constexpr int I_IN = 16 * (NIN / 32), I_SQ = 16 * 32, I_Q = 16 * 64, NITEMS = I_IN + 3 * I_SQ + I_Q;
        for (int it = gw; it < NITEMS; it += NGW) {
            int r = it;
            if (r < I_IN) { transpose_item<true>(F.w_in, 1024, NIN, (bf16*)(F.ws + WS_WIN), scr, r, F.lane, MapWin()); continue; } r -= I_IN;
            if (r < I_SQ) { transpose_item<true>(F.w_ret_out, 1024, 1024, (bf16*)(F.ws + WS_WRET), scr, r, F.lane, MapId()); continue; } r -= I_SQ;
            if (r < I_SQ) { transpose_item<true>(F.w_sgu_out, 1024, 1024, (bf16*)(F.ws + WS_WSGU), scr, r, F.lane, MapId()); continue; } r -= I_SQ;
            if (r < I_SQ) { transpose_item<true>(F.w_out, 1024, 1024, (bf16*)(F.ws + WS_WOUT), scr, r, F.lane, MapId()); continue; } r -= I_SQ;
            transpose_item<false>(F.peer_w_q, 1024, 2048, (bf16*)(F.ws + WS_WQ), scr, r, F.lane, MapId());
        }
    }
    const size_t gt = (size_t)F.bid * 512 + F.tid, NT = (size_t)F.G * 512;
    for (size_t ch = gt; ch < (size_t)16384 * 64; ch += NT) {
        const f32x4* up = (const f32x4*)(F.peer_u + ch * 16); const f32x4* vp = (const f32x4*)(F.peer_v + ch * 16);
        v4u ou, ov;
#pragma unroll
        for (int q = 0; q < 4; ++q) { const f32x4 a = up[q] * 512.0f, b = vp[q] * 16.0f; ou[q] = pk4_fp8(a[0], a[1], a[2], a[3]); ov[q] = pk4_fp8(b[0], b[1], b[2], b[3]); }
        const size_t e_ = ch >> 6, c16_ = ch & 63, dst_ = (c16_ >> 3) * ((size_t)16384 * 128) + e_ * 128 + (c16_ & 7) * 16;
        *(v4u*)(F.ws + WS_VE8 + dst_) = ov;
        if (MK_U4) {
            v2u o4; unsigned w0 = 0u, w1 = 0u;
            { const f32x4 a0 = up[0] * 64.0f, a1 = up[1] * 64.0f, a2 = up[2] * 64.0f, a3 = up[3] * 64.0f;
              w0 = __builtin_amdgcn_cvt_scalef32_pk_fp4_f32(w0, a0[0], a0[1], 1.0f, 0); w0 = __builtin_amdgcn_cvt_scalef32_pk_fp4_f32(w0, a0[2], a0[3], 1.0f, 1);
              w0 = __builtin_amdgcn_cvt_scalef32_pk_fp4_f32(w0, a1[0], a1[1], 1.0f, 2); w0 = __builtin_amdgcn_cvt_scalef32_pk_fp4_f32(w0, a1[2], a1[3], 1.0f, 3);
              w1 = __builtin_amdgcn_cvt_scalef32_pk_fp4_f32(w1, a2[0], a2[1], 1.0f, 0); w1 = __builtin_amdgcn_cvt_scalef32_pk_fp4_f32(w1, a2[2], a2[3], 1.0f, 1);
              w1 = __builtin_amdgcn_cvt_scalef32_pk_fp4_f32(w1, a3[0], a3[1], 1.0f, 2); w1 = __builtin_amdgcn_cvt_scalef32_pk_fp4_f32(w1, a3[2], a3[3], 1.0f, 3); }
            o4.x = w0; o4.y = w1;
            *(v2u*)(F.ws + WS_UE8 + (c16_ >> 4) * ((size_t)16384 * 128) + e_ * 128 + (c16_ & 15) * 8) = o4;
        } else *(v4u*)(F.ws + WS_UE8 + dst_) = ou; }
    for (size_t ch = gt; ch < (size_t)32768; ch += NT) cvt8(F.peer_sub_keys, (bf16*)(F.ws + WS_SK), ch);
    for (size_t ch = gt; ch < (size_t)8192; ch += NT) { const int t = (int)(ch >> 4) & 127, s0 = (int)(ch & 15) * 8;
        const f32x4 a = *(const f32x4*)(F.sgu_w + ch * 8), b = *(const f32x4*)(F.sgu_w + ch * 8 + 4);
        float v[8] = {a[0], a[1], a[2], a[3], b[0], b[1], b[2], b[3]};
#pragma unroll
        for (int e = 0; e < 8; ++e) v[e] = (s0 + e <= t) ? v[e] : 0.f;
        v4u o; o.x = pk2(v[0], v[1]); o.y = pk2(v[2], v[3]); o.z = pk2(v[4], v[5]); o.w = pk2(v[6], v[7]);
        *(v4u*)((bf16*)(F.ws + WS_SGUW) + ch * 8) = o; }
    for (size_t e = gt; e < (size_t)4096 * 64; e += NT) { const int s = (int)(e >> 6), i = (int)(e & 63);
        const float inv = fexp2(-(float)i * (13.287712379549449f / 64.0f));
        const float rev = ((float)s * inv) * 0.15915494309189535f; const float fr = rev - __builtin_floorf(rev);
        ((float*)(F.ws + WS_COS))[e] = __builtin_amdgcn_cosf(fr); ((float*)(F.ws + WS_SIN))[e] = __builtin_amdgcn_sinf(fr); }
}

template <int MODE  > __device__ __forceinline__ void norm_rows(Frame& F, const float* X, const float* gain, const float* shift, const float* scale, bf16* O, unsigned char* O8) { F.fence_ids();
    const int gw = F.bid * NWAVES + F.wave, NGW = F.G * NWAVES;
    f32x4 g[4];
#pragma unroll
    for (int j = 0; j < 4; ++j) g[j] = *(const f32x4*)(gain + 4 * F.lane + 256 * j);
    f32x4 nx[4];
    if (gw < MT) {
#pragma unroll
        for (int j = 0; j < 4; ++j) nx[j] = *((const f32x4*)(X + (size_t)gw * DM) + F.lane + 64 * j); }
    for (int m = gw; m < MT; m += NGW) {
        f32x4 v[4]; float s = 0.f;
#pragma unroll
        for (int j = 0; j < 4; ++j) { v[j] = nx[j]; s += (v[j][0] * v[j][0] + v[j][1] * v[j][1]) + (v[j][2] * v[j][2] + v[j][3] * v[j][3]); }
        const int b = m >> 12;
        f32x4 sh[4], sc[4];
#pragma unroll
        for (int j = 0; j < 4; ++j) { const int d = 4 * F.lane + 256 * j; sh[j] = *(const f32x4*)(shift + b * 6144 + d); sc[j] = *(const f32x4*)(scale + b * 6144 + d); }
        if (m + NGW < MT) {
#pragma unroll
            for (int j = 0; j < 4; ++j) nx[j] = *((const f32x4*)(X + (size_t)(m + NGW) * DM) + F.lane + 64 * j); }
        const float rstd = __builtin_amdgcn_rsqf(wave_sum(s) * (1.f / DM) + EPSN);
        v2u* o8 = (v2u*)(O + (size_t)m * DM) + F.lane;
#pragma unroll
        for (int j = 0; j < 4; ++j) { const int d = 4 * F.lane + 256 * j;
            const f32x4 h = v[j] * rstd * g[j] * (sc[j] + 1.0f) + sh[j];
            if (MODE == 2) { const f32x4 h8 = h * 8.0f; *(unsigned*)(O8 + (size_t)m * DM + d) = pk4_fp8(h8[0], h8[1], h8[2], h8[3]); }
            else { v2u w; w.x = pk2(h[0], h[1]); w.y = pk2(h[2], h[3]); o8[64 * j] = w; }
            if (MODE == 1) { const f32x4 hs = h * 16.0f; *(unsigned*)(O8 + (size_t)(d >> 8) * ((size_t)MT * 256) + (size_t)m * 256 + (d & 255)) = pk4_fp8(hs[0], hs[1], hs[2], hs[3]); } }
    }
}

__device__ __forceinline__ float lg_gamma(int h) { return __builtin_log2f(1.0f - fexp2((float)(-5 - h))); }
__device__ __forceinline__ v4u scale8(v4u w, float s) {
    v4u o; o.x = pk2(bflo(w.x) * s, bfhi(w.x) * s); o.y = pk2(bflo(w.y) * s, bfhi(w.y) * s); o.z = pk2(bflo(w.z) * s, bfhi(w.z) * s); o.w = pk2(bflo(w.w) * s, bfhi(w.w) * s); return o;
}
struct KvRegs { v4u k[4], v[8]; };
__device__ __forceinline__ void kv_load(Frame& F, int u, KvRegs& R) {
    const int b = u >> 7, h = (u >> 5) & 3, c = u & 31; const size_t tok0 = (size_t)b * SEQ + c * 128;
    const bf16* Kb = (const bf16*)(F.dout + DO_K); const bf16* Vb = (const bf16*)(F.ws + WS_V);
#pragma unroll
    for (int i = 0; i < 4; ++i) { const int ch = F.tid + 512 * i, j = ch >> 4, cc = ch & 15; R.k[i] = *(const v4u*)(Kb + (tok0 + j) * 512 + h * 128 + cc * 8); }
#pragma unroll
    for (int i = 0; i < 8; ++i) { const int ch = F.tid + 512 * i, j = ch >> 5, cc = ch & 31; R.v[i] = *(const v4u*)(Vb + (tok0 + j) * 1024 + h * 256 + cc * 8); }
}
__device__ __forceinline__ void kv_unit(Frame& F, int u, KvRegs& R, int unext) {
    const int b = u >> 7, h = (u >> 5) & 3, c = u & 31;
    LAS unsigned char* Kimg = F.lds; LAS unsigned char* Vimg = F.lds + 34816;
    const float lg = lg_gamma(h);
#pragma unroll
    for (int i = 0; i < 4; ++i) { const int ch = F.tid + 512 * i, j = ch >> 4, cc = ch & 15;
        *(LAS v4u*)(Kimg + j * KS + cc * 16) = scale8(R.k[i], fexp2((float)(127 - j) * lg)); }
#pragma unroll
    for (int i = 0; i < 8; ++i) { const int ch = F.tid + 512 * i, j = ch >> 5, cc = ch & 31; *(LAS v4u*)(Vimg + j * VS + cc * 16) = R.v[i]; }
    __syncthreads();
    if (unext >= 0) kv_load(F, unext, R);
    f32x4 acc[8][2];
#pragma unroll
    for (int dt = 0; dt < 8; ++dt) { acc[dt][0] = (f32x4){0.f, 0.f, 0.f, 0.f}; acc[dt][1] = (f32x4){0.f, 0.f, 0.f, 0.f}; }
#pragma unroll
    for (int js = 0; js < 4; ++js) {
        bf16x8 bv[2];
#pragma unroll
        for (int vt = 0; vt < 2; ++vt) bv[vt] = lds_tr_frag(Vimg, VS, 32 * js, 32 * F.wave + 16 * vt, F.lane);
#pragma unroll
        for (int dt = 0; dt < 8; ++dt) { const bf16x8 a = lds_tr_frag(Kimg, KS, 32 * js, 16 * dt, F.lane);
            acc[dt][0] = MFMA16(a, bv[0], acc[dt][0]); acc[dt][1] = MFMA16(a, bv[1], acc[dt][1]); }
    }
    bf16* dst = (bf16*)(F.dout + DO_KVS) + (size_t)(((b * 4 + h) * 32 + c)) * 32768;
#pragma unroll
    for (int dt = 0; dt < 8; ++dt)
#pragma unroll
        for (int vt = 0; vt < 2; ++vt) { const int v = 32 * F.wave + 16 * vt + (F.lane & 15), d0 = 16 * dt + 4 * (F.lane >> 4);
            v2u o; o.x = pk2(acc[dt][vt][0], acc[dt][vt][1]); o.y = pk2(acc[dt][vt][2], acc[dt][vt][3]);
            *(v2u*)(dst + v * 128 + d0) = o; }
    __syncthreads();
}
struct SguRegs { v4u sv[8]; f32x2v st[8]; };
__device__ __forceinline__ void sgu_load(Frame& F, int su, SguRegs& R) {
    const size_t tok0 = (size_t)(su >> 2) * 128; const int g = su & 3; const bf16* SVb = (const bf16*)(F.ws + WS_SV); const float* stat = (const float*)(F.ws + WS_SVSTAT);
    int tq = F.tid; asm volatile("" : "+v"(tq));
#pragma unroll
    for (int i = 0; i < 8; ++i) { const int ch = tq + 512 * i, sr = ch >> 5, cc = ch & 31;
        R.sv[i] = *(const v4u*)(SVb + (tok0 + sr) * 1024 + g * 256 + cc * 8); R.st[i] = *(const f32x2v*)(stat + (tok0 + sr) * 2); }
}
__device__ __forceinline__ void sgu_unit(Frame& F, int su, SguRegs& R, int snext, int& cur_g) {
    const size_t tok0 = (size_t)(su >> 2) * 128; const int g = su & 3;
    LAS unsigned char* Vn = F.lds; LAS unsigned char* Wimg = F.lds + 67584;
    const bf16* Ub = (const bf16*)(F.ws + WS_U); const bf16* Wm = (const bf16*)(F.ws + WS_SGUW);
    { const int cc = F.tid & 31; const int col = g * 256 + cc * 8;
        const f32x4 g0 = *(const f32x4*)(F.sgu_ln_g + col), g1 = *(const f32x4*)(F.sgu_ln_g + col + 4), b0 = *(const f32x4*)(F.sgu_ln_b + col), b1 = *(const f32x4*)(F.sgu_ln_b + col + 4);
#pragma unroll
        for (int i = 0; i < 8; ++i) { const int ch = F.tid + 512 * i, sr = ch >> 5; const v4u w = R.sv[i];
            const float mean = R.st[i].x * (1.f / 1024.f), var = R.st[i].y * (1.f / 1024.f) - mean * mean, rstd = __builtin_amdgcn_rsqf(var + EPSN);
            v4u o;
            o.x = pk2((bflo(w.x) - mean) * rstd * g0[0] + b0[0], (bfhi(w.x) - mean) * rstd * g0[1] + b0[1]);
            o.y = pk2((bflo(w.y) - mean) * rstd * g0[2] + b0[2], (bfhi(w.y) - mean) * rstd * g0[3] + b0[3]);
            o.z = pk2((bflo(w.z) - mean) * rstd * g1[0] + b1[0], (bfhi(w.z) - mean) * rstd * g1[1] + b1[1]);
            o.w = pk2((bflo(w.w) - mean) * rstd * g1[2] + b1[2], (bfhi(w.w) - mean) * rstd * g1[3] + b1[3]);
            *(LAS v4u*)(Vn + sr * VS + cc * 16) = o; } }
    if (g != cur_g) { cur_g = g;
#pragma unroll
        for (int i = 0; i < 4; ++i) { const int ch = F.tid + 512 * i, t = ch >> 4, cc = ch & 15;
            *(LAS v4u*)(Wimg + t * KS + cc * 16) = *(const v4u*)(Wm + (size_t)(g * 128 + t) * 128 + cc * 8); } }
    __syncthreads();
    if (snext >= 0) sgu_load(F, snext, R);
    v2u uv[8][2];
#pragma unroll
    for (int tt = 0; tt < 8; ++tt)
#pragma unroll
        for (int ct = 0; ct < 2; ++ct) uv[tt][ct] = *(const v2u*)(Ub + (tok0 + 16 * tt + (F.lane & 15)) * 1024 + g * 256 + 32 * F.wave + 16 * ct + 4 * (F.lane >> 4));
    f32x4 acc[2][8];
#pragma unroll
    for (int ct = 0; ct < 2; ++ct)
#pragma unroll
        for (int tt = 0; tt < 8; ++tt) acc[ct][tt] = (f32x4){0.f, 0.f, 0.f, 0.f};
#pragma unroll
    for (int ss = 0; ss < 4; ++ss) {
        bf16x8 av[2];
#pragma unroll
        for (int ct = 0; ct < 2; ++ct) av[ct] = lds_tr_frag(Vn, VS, 32 * ss, 32 * F.wave + 16 * ct, F.lane);
#pragma unroll
        for (int tt = 0; tt < 8; ++tt) if (tt >= 2 * ss) { const bf16x8 bw = lds_row_frag(Wimg, KS, 16 * tt, 32 * ss, F.lane);
            acc[0][tt] = MFMA16(av[0], bw, acc[0][tt]); acc[1][tt] = MFMA16(av[1], bw, acc[1][tt]); }
    }
#pragma unroll
    for (int tt = 0; tt < 8; ++tt) { const int t = 16 * tt + (F.lane & 15); const float bs = F.sgu_b[g * 128 + t];
#pragma unroll
        for (int ct = 0; ct < 2; ++ct) { const int cg = g * 256 + 32 * F.wave + 16 * ct + 4 * (F.lane >> 4); const v2u u2 = uv[tt][ct];
            *(unsigned*)(F.ws + WS_YS8 + (tok0 + t) * 1024 + cg) = pk4_fp8(8.f * bflo(u2.x) * (acc[ct][tt][0] + bs), 8.f * bfhi(u2.x) * (acc[ct][tt][1] + bs), 8.f * bflo(u2.y) * (acc[ct][tt][2] + bs), 8.f * bfhi(u2.y) * (acc[ct][tt][3] + bs)); } }
    __syncthreads();
}
__device__ __forceinline__ void p2a(Frame& F) { F.fence_ids();
    { KvRegs R; if (F.bid < 1024) kv_load(F, F.bid, R);
      for (int u = F.bid; u < 1024; u += F.G) kv_unit(F, u, R, (u + F.G < 1024) ? u + F.G : -1); }
#if MK_PROBE_HI > 0
    if (F.bid == 0 && threadIdx.x == 0) { const unsigned long long _t = __builtin_amdgcn_s_memrealtime(); F.misc[16 + 2 * 20] = (unsigned)_t; F.misc[17 + 2 * 20] = (unsigned)(_t >> 32); }
#endif
    { SguRegs R; int cur_g = -1; if (F.bid < 1024) sgu_load(F, F.bid, R);
      for (int su = F.bid; su < 1024; su += F.G) sgu_unit(F, su, R, (su + F.G < 1024) ? su + F.G : -1, cur_g); }
}
__device__ __forceinline__ void p2b(Frame& F) { F.fence_ids();
    bf16* KVS = (bf16*)(F.dout + DO_KVS);
    for (int item = F.bid * 512 + F.tid; item < 32 * 4096; item += F.G * 512) {
        const int bh = item >> 12, rem = item & 4095, h = bh & 3;
        const float dc = fexp2(128.0f * lg_gamma(h));
        float s[8];
#pragma unroll
        for (int e = 0; e < 8; ++e) s[e] = 0.f;
        bf16* p = KVS + (size_t)bh * 32 * 32768 + (size_t)rem * 8;
        for (int c0 = 0; c0 < 32; c0 += 8) {
            v4u kv[8];
#pragma unroll
            for (int i = 0; i < 8; ++i) kv[i] = *(const v4u*)(p + (size_t)(c0 + i) * 32768);
#pragma unroll
            for (int i = 0; i < 8; ++i) {
                v4u o; o.x = pk2(s[0], s[1]); o.y = pk2(s[2], s[3]); o.z = pk2(s[4], s[5]); o.w = pk2(s[6], s[7]);
                *(v4u*)(p + (size_t)(c0 + i) * 32768) = o;
                s[0] = s[0] * dc + bflo(kv[i].x); s[1] = s[1] * dc + bfhi(kv[i].x); s[2] = s[2] * dc + bflo(kv[i].y); s[3] = s[3] * dc + bfhi(kv[i].y);
                s[4] = s[4] * dc + bflo(kv[i].z); s[5] = s[5] * dc + bfhi(kv[i].z); s[6] = s[6] * dc + bflo(kv[i].w); s[7] = s[7] * dc + bfhi(kv[i].w);
            }
        }
    }
}
struct RetRegs { v4u q[4], k[4], v[8]; };
__device__ __forceinline__ void ret_load(Frame& F, int u, RetRegs& R) {
    const int b = u >> 7, h = (u >> 5) & 3, c = u & 31; const size_t tok0 = (size_t)b * SEQ + c * 128;
    const bf16* Qb = (const bf16*)(F.dout + DO_Q); const bf16* Kb = (const bf16*)(F.dout + DO_K); const bf16* Vb = (const bf16*)(F.ws + WS_V);
#pragma unroll
    for (int i = 0; i < 4; ++i) { const int ch = F.tid + 512 * i, j = ch >> 4, cc = ch & 15;
        R.q[i] = *(const v4u*)(Qb + (tok0 + j) * 512 + h * 128 + cc * 8); R.k[i] = *(const v4u*)(Kb + (tok0 + j) * 512 + h * 128 + cc * 8); }
#pragma unroll
    for (int i = 0; i < 8; ++i) { const int ch = F.tid + 512 * i, j = ch >> 5, cc = ch & 31; R.v[i] = *(const v4u*)(Vb + (tok0 + j) * 1024 + h * 256 + cc * 8); }
}
__device__ __forceinline__ void ret_unit(Frame& F, int u, RetRegs& R, int unext) {
    const int b = u >> 7, h = (u >> 5) & 3, c = u & 31;
    const size_t tok0 = (size_t)b * SEQ + c * 128;
    LAS unsigned char* Qimg = F.lds; LAS unsigned char* Kimg = F.lds + 34816; LAS unsigned char* Vimg = F.lds + 69632;
    LAS unsigned char* Sout = F.lds;
    const bf16* Gb = (const bf16*)(F.ws + WS_G);
    const bf16* ST = (const bf16*)(F.dout + DO_KVS) + (size_t)(((b * 4 + h) * 32 + c)) * 32768;
    const float lg = lg_gamma(h);
    const int lane = F.lane, w = F.wave, l15 = lane & 15, g4 = lane >> 4;
#pragma unroll
    for (int i = 0; i < 4; ++i) { const int ch = F.tid + 512 * i, j = ch >> 4, cc = ch & 15;
        *(LAS v4u*)(Qimg + j * KS + cc * 16) = R.q[i]; *(LAS v4u*)(Kimg + j * KS + cc * 16) = R.k[i]; }
#pragma unroll
    for (int i = 0; i < 8; ++i) { const int ch = F.tid + 512 * i, j = ch >> 5, cc = ch & 31; *(LAS v4u*)(Vimg + j * VS + cc * 16) = R.v[i]; }
    bf16x8 bs[4][2];
#pragma unroll
    for (int ds = 0; ds < 4; ++ds)
#pragma unroll
        for (int vt = 0; vt < 2; ++vt) bs[ds][vt] = *(const bf16x8*)(ST + (size_t)(32 * w + 16 * vt + l15) * 128 + 32 * ds + 8 * g4);
    __syncthreads();
    f32x4 st[8];
#pragma unroll
    for (int jt = 0; jt < 8; ++jt) st[jt] = (f32x4){0.f, 0.f, 0.f, 0.f};
#pragma unroll
    for (int ds = 0; ds < 4; ++ds) { const bf16x8 bq = lds_row_frag(Qimg, KS, 16 * w, 32 * ds, lane);
#pragma unroll
        for (int jt = 0; jt < 8; ++jt) if (jt <= w) { const bf16x8 ak = lds_row_frag(Kimg, KS, 16 * jt, 32 * ds, lane); st[jt] = MFMA16(ak, bq, st[jt]); } }
    __syncthreads();
    { const int i = 16 * w + l15;
#pragma unroll
        for (int jt = 0; jt < 8; ++jt) { float o[4];
#pragma unroll
            for (int ii = 0; ii < 4; ++ii) { const int j = 16 * jt + 4 * g4 + ii; o[ii] = (i >= j) ? st[jt][ii] * fexp2((float)(i - j) * lg) : 0.f; }
            v2u pk; pk.x = pk2(o[0], o[1]); pk.y = pk2(o[2], o[3]);
            *(LAS v2u*)(Kimg + i * KS + (16 * jt + 4 * g4) * 2) = pk; } }
    __syncthreads();
    f32x4 acc[8][2];
#pragma unroll
    for (int it = 0; it < 8; ++it) { acc[it][0] = (f32x4){0.f, 0.f, 0.f, 0.f}; acc[it][1] = (f32x4){0.f, 0.f, 0.f, 0.f}; }
#pragma unroll
    for (int ds = 0; ds < 4; ++ds) {
#pragma unroll
        for (int it = 0; it < 8; ++it) { const bf16x8 a = lds_row_frag(Qimg, KS, 16 * it, 32 * ds, lane);
            acc[it][0] = MFMA16(a, bs[ds][0], acc[it][0]); acc[it][1] = MFMA16(a, bs[ds][1], acc[it][1]); } }
#pragma unroll
    for (int it = 0; it < 8; ++it)
#pragma unroll
        for (int ii = 0; ii < 4; ++ii) { const float dq = fexp2((float)(16 * it + 4 * g4 + ii + 1) * lg); acc[it][0][ii] *= dq; acc[it][1][ii] *= dq; }
#pragma unroll
    for (int js = 0; js < 4; ++js) { bf16x8 bv[2];
#pragma unroll
        for (int vt = 0; vt < 2; ++vt) bv[vt] = lds_tr_frag(Vimg, VS, 32 * js, 32 * w + 16 * vt, lane);
#pragma unroll
        for (int it = 0; it < 8; ++it) if (it >= 2 * js) { const bf16x8 a = lds_row_frag(Kimg, KS, 16 * it, 32 * js, lane);
            acc[it][0] = MFMA16(a, bv[0], acc[it][0]); acc[it][1] = MFMA16(a, bv[1], acc[it][1]); } }
    int lane_h = lane; asm volatile("" : "+v"(lane_h));
    v2u gt[16];
#pragma unroll
    for (int rr = 0; rr < 16; ++rr) gt[rr] = *(const v2u*)(Gb + (tok0 + 16 * w + rr) * 1024 + h * 256 + 4 * lane_h);
    const f32x4 gn = *(const f32x4*)(F.ret_gn_g + h * 256 + 4 * lane_h);
    __syncthreads();
#pragma unroll
    for (int it = 0; it < 8; ++it)
#pragma unroll
        for (int vt = 0; vt < 2; ++vt)
#pragma unroll
            for (int ii = 0; ii < 4; ++ii) *(LAS float*)(Sout + (16 * it + 4 * g4 + ii) * 1040 + (32 * w + 16 * vt + l15) * 4) = acc[it][vt][ii];
    __syncthreads();
#pragma unroll
    for (int rr = 0; rr < 16; ++rr) { const int i = 16 * w + rr;
        const f32x4 y = *(LAS const f32x4*)(Sout + i * 1040 + lane_h * 16);
        const float mean = wave_sum((y[0] + y[1]) + (y[2] + y[3])) * (1.f / 256.f);
        const f32x4 d = y - mean;
        const float var = wave_sum((d[0] * d[0] + d[1] * d[1]) + (d[2] * d[2] + d[3] * d[3])) * (1.f / 256.f);
        const float r8 = __builtin_amdgcn_rsqf(var + EPSN) * 4.0f;
        const size_t off = (tok0 + i) * 1024 + h * 256 + 4 * lane_h;
        *(unsigned*)(F.ws + WS_YG8 + off) = pk4_fp8(d[0] * r8 * gn[0] * bflo(gt[rr].x), d[1] * r8 * gn[1] * bfhi(gt[rr].x), d[2] * r8 * gn[2] * bflo(gt[rr].y), d[3] * r8 * gn[3] * bfhi(gt[rr].y)); }
    __syncthreads();
}
__device__ __forceinline__ void p2c(Frame& F) { F.fence_ids(); for (int u = F.bid; u < 1024; u += F.G) { RetRegs R; ret_load(F, u, R); ret_unit(F, u, R, -1); } }

__device__ __forceinline__ float dppx(float v, int) { return v; }
template <int CTRL> __device__ __forceinline__ void merge16(float (&L)[16]) {
    float c[16];
#pragma unroll
    for (int i = 0; i < 16; ++i) c[i] = __builtin_fmaxf(L[i], dpp_f<CTRL>(L[15 - i]));
#pragma unroll
    for (int half = 8; half >= 1; half >>= 1)
#pragma unroll
        for (int i = 0; i < 16; ++i) if ((i & half) == 0) { const float hi = __builtin_fmaxf(c[i], c[i + half]), lo = __builtin_fminf(c[i], c[i + half]); c[i] = hi; c[i + half] = lo; }
#pragma unroll
    for (int i = 0; i < 16; ++i) L[i] = c[i];
}
__device__ __forceinline__ void sort16_desc(float (&v)[16]) {
#pragma unroll
    for (int k = 2; k <= 16; k <<= 1)
#pragma unroll
        for (int j = k >> 1; j >= 1; j >>= 1)
#pragma unroll
            for (int i = 0; i < 16; ++i) { const int l = i ^ j; if (l > i) { const bool desc = ((i & k) == 0) || (k == 16);
                const float hi = __builtin_fmaxf(v[i], v[l]), lo = __builtin_fminf(v[i], v[l]); v[i] = desc ? hi : lo; v[l] = desc ? lo : hi; } }
}
__device__ __forceinline__ void merge_top16(float (&A)[16], const float (&B)[16]) {
#pragma unroll
    for (int i = 0; i < 16; ++i) A[i] = __builtin_fmaxf(A[i], B[15 - i]);
#pragma unroll
    for (int half = 8; half >= 1; half >>= 1)
#pragma unroll
        for (int i = 0; i < 16; ++i) if ((i & half) == 0) { const float hi = __builtin_fmaxf(A[i], A[i + half]), lo = __builtin_fminf(A[i], A[i + half]); A[i] = hi; A[i + half] = lo; }
}
__device__ __forceinline__ void p5b(Frame& F) {
    F.fence_ids();
    LAS unsigned char* Aimg = F.lds; LAS unsigned char* Bimg = F.lds + 34816; LAS float* Sc = (LAS float*)(F.lds + 69632);
    const bf16* QP = (const bf16*)(F.ws + WS_GA);
    const int lane = F.lane, w = F.wave;
    int cur_hp = -1;
    v4u pa[4];
    if (F.bid < 4096) { const int tt = F.bid >> 4, hp = F.bid & 15;
#pragma unroll
        for (int i = 0; i < 4; ++i) { const int ch = F.tid + 512 * i, r = ch >> 4, cc = ch & 15; pa[i] = *(const v4u*)(QP + ((size_t)tt * 128 + r) * 2048 + hp * 128 + cc * 8); } }
    for (int u = F.bid; u < 4096; u += F.G) {
        const int tt = u >> 4, hp = u & 15; const size_t tok0 = (size_t)tt * 128;
#pragma unroll
        for (int i = 0; i < 4; ++i) { const int ch = F.tid + 512 * i, r = ch >> 4, cc = ch & 15; *(LAS v4u*)(Aimg + r * KS + cc * 16) = pa[i]; }
        if (hp != cur_hp) { const bf16* SK = (const bf16*)(F.ws + WS_SK) + (size_t)hp * 16384; cur_hp = hp;
#pragma unroll
            for (int i = 0; i < 4; ++i) { const int ch = F.tid + 512 * i, r = ch >> 4, cc = ch & 15; *(LAS v4u*)(Bimg + r * KS + cc * 16) = *(const v4u*)(SK + (size_t)r * 128 + cc * 8); } }
        __syncthreads();
        { const int un = u + F.G; if (un < 4096) { const int tn = un >> 4, hn = un & 15;
#pragma unroll
            for (int i = 0; i < 4; ++i) { const int ch = F.tid + 512 * i, r = ch >> 4, cc = ch & 15; pa[i] = *(const v4u*)(QP + ((size_t)tn * 128 + r) * 2048 + hn * 128 + cc * 8); } } }
        f32x4 acc[8];
#pragma unroll
        for (int nt = 0; nt < 8; ++nt) acc[nt] = (f32x4){0.f, 0.f, 0.f, 0.f};
#pragma unroll
        for (int ks = 0; ks < 4; ++ks) { const bf16x8 a = lds_row_frag(Aimg, KS, 16 * w, 32 * ks, lane);
#pragma unroll
            for (int nt = 0; nt < 8; ++nt) { const bf16x8 bb = lds_row_frag(Bimg, KS, 16 * nt, 32 * ks, lane); acc[nt] = MFMA16(a, bb, acc[nt]); } }
#pragma unroll
        for (int nt = 0; nt < 8; ++nt)
#pragma unroll
            for (int ii = 0; ii < 4; ++ii) Sc[(16 * w + 4 * (lane >> 4) + ii) * 132 + 16 * nt + (lane & 15)] = acc[nt][ii];
        __syncthreads();
        { const int row = F.tid >> 2, q = F.tid & 3;
            float L[16], L2[16];
#pragma unroll
            for (int i = 0; i < 16; ++i) { const int n = 4 * i + q, n2 = 4 * (i + 16) + q;
                L[i] = __uint_as_float((__float_as_uint(Sc[row * 132 + n]) & 0xFFFFFF80u) | (unsigned)n);
                L2[i] = __uint_as_float((__float_as_uint(Sc[row * 132 + n2]) & 0xFFFFFF80u) | (unsigned)n2); }
            sort16_desc(L); sort16_desc(L2); merge_top16(L, L2);
            merge16<0xB1>(L); merge16<0x4E>(L);
            if (q == 0) { v4u* dst = (v4u*)((unsigned*)(F.ws + WS_SUB) + ((tok0 + row) * 16 + hp) * 16);
#pragma unroll
                for (int i = 0; i < 4; ++i) dst[i] = (v4u){__float_as_uint(L[4 * i]), __float_as_uint(L[4 * i + 1]), __float_as_uint(L[4 * i + 2]), __float_as_uint(L[4 * i + 3])}; } }
        __syncthreads();
    }
}

template <int CTRL> __device__ __forceinline__ float dpp_max(float v) { return __builtin_fmaxf(v, dpp_f<CTRL>(v)); }
template <int CTRL> __device__ __forceinline__ float dpp_add(float v) { return v + dpp_f<CTRL>(v); }
__device__ __forceinline__ float row_allmax(float v) { v = dpp_max<0x128>(v); v = dpp_max<0x124>(v); v = dpp_max<0x122>(v); v = dpp_max<0x121>(v); return v; }
__device__ __forceinline__ float row_allsum(float v) { v = dpp_add<0x128>(v); v = dpp_add<0x124>(v); v = dpp_add<0x122>(v); v = dpp_add<0x121>(v); return v; }
__device__ __forceinline__ void p6a(Frame& F) { F.fence_ids();
    const int lane = F.lane, row = lane >> 4, i = lane & 15, rowbase = lane & 48;
    LAS unsigned* Sel = (LAS unsigned*)(F.lds + F.wave * 1024);
    const unsigned* SUB = (const unsigned*)(F.ws + WS_SUB);
    unsigned* EID = (unsigned*)(F.ws + WS_EID); float* GWp = (float*)(F.ws + WS_GW);
    const int gw = F.bid * NWAVES + F.wave, NGW = F.G * NWAVES;
    unsigned nab[2], nbb[2];
    if (gw < MT) {
#pragma unroll
        for (int r = 0; r < 2; ++r) { const int h = 4 * r + row; nab[r] = SUB[((size_t)gw * 16 + 2 * h) * 16 + i]; nbb[r] = SUB[((size_t)gw * 16 + 2 * h + 1) * 16 + i]; } }
    for (int t = gw; t < MT; t += NGW) {
        unsigned abits[2], bbits[2], bcur[2]; float a[2], hv[2]; int ptr[2];
#pragma unroll
        for (int r = 0; r < 2; ++r) { abits[r] = nab[r]; bbits[r] = nbb[r]; a[r] = __uint_as_float(abits[r]); ptr[r] = 0; bcur[r] = (unsigned)__shfl((int)bbits[r], rowbase); hv[r] = a[r] + __uint_as_float(bcur[r]); }
        if (t + NGW < MT) {
#pragma unroll
            for (int r = 0; r < 2; ++r) { const int h = 4 * r + row; nab[r] = SUB[((size_t)(t + NGW) * 16 + 2 * h) * 16 + i]; nbb[r] = SUB[((size_t)(t + NGW) * 16 + 2 * h + 1) * 16 + i]; } }
        for (int k = 0; k < 16; ++k) {
#pragma unroll
            for (int r = 0; r < 2; ++r) {
                const float key = __uint_as_float((__float_as_uint(hv[r]) & 0xFFFFFFF0u) | (unsigned)i);
                const float m = row_allmax(key);
                const bool win = (key == m);
                if (win) { Sel[((r * 4 + row) * 16 + k) * 2] = (abits[r] & 127u) * 128u + (bcur[r] & 127u); Sel[((r * 4 + row) * 16 + k) * 2 + 1] = __float_as_uint(hv[r]); ptr[r]++; }
                const unsigned bnext = (unsigned)__shfl((int)bbits[r], rowbase + (ptr[r] < 15 ? ptr[r] : 15));
                if (win) { bcur[r] = bnext; hv[r] = (ptr[r] < 16) ? a[r] + __uint_as_float(bnext) : -3.0e38f; }
            }
        }
        LDS_WAIT(); asm volatile("" ::: "memory");
#pragma unroll
        for (int r = 0; r < 2; ++r) { const int h = 4 * r + row;
            const unsigned e = Sel[((r * 4 + row) * 16 + i) * 2]; const float sc = __uint_as_float(Sel[((r * 4 + row) * 16 + i) * 2 + 1]);
            const float mx = row_allmax(sc);
            const float ex = fexp2((sc - mx) * 1.44269504089f);
            const float sum = row_allsum(ex);
            EID[(size_t)t * 128 + h * 16 + i] = e; GWp[(size_t)t * 128 + h * 16 + i] = ex / sum; }
        LDS_WAIT(); asm volatile("" ::: "memory");
    }
}
typedef float f32x2c __attribute__((ext_vector_type(2)));
__device__ __forceinline__ long mk64(unsigned lo, unsigned hi) { return (long)(((unsigned long long)hi << 32) | lo); }
#if MK_U4
typedef int v8i_q __attribute__((ext_vector_type(8)));
__device__ __forceinline__ void p6b(Frame& F) { F.fence_ids();
    const int j = F.bid & 7, s2 = j >> 1, par = j & 1, nsb = F.G >> 3; if ((F.bid >> 3) >= nsb) return;
    const int wj = (F.bid >> 3) * NWAVES + F.wave, NW = nsb * NWAVES, NI = MT / 2;
    const int lane = F.lane, g = lane >> 4;
    const int pidx = (4 * (lane & 15) + (lane >> 4)) * 4;
    const unsigned char* H8 = F.ws + WS_H2F8 + (size_t)s2 * MT * 256 + 16 * g; const unsigned char* U4 = F.ws + WS_UE8 + (size_t)s2 * 16384 * 128 + 16 * (lane & 3); const unsigned* EID = (const unsigned*)(F.ws + WS_EID) + (lane >> 2);
    float* PD = (float*)(F.ws + WS_PD) + (size_t)s2 * MT * 128;
#define TOK(ix_) (2 * ((ix_) < NI ? (ix_) : NI - 1) + par)
#define P6B_LOAD_EID(E, ix_) do { const int tc_ = TOK(ix_); _Pragma("unroll") for (int h = 0; h < 8; ++h) E[h] = EID[(size_t)tc_ * 128 + 16 * h]; } while (0)
#define P6B_LOAD_AB(A_, B0_, B1_, E, ix_) do { const int tc_ = TOK(ix_); const unsigned char* hp_ = H8 + (size_t)tc_ * 256; A_[0] = *(const v4u*)hp_; A_[1] = *(const v4u*)(hp_ + 64); A_[2] = *(const v4u*)(hp_ + 128); A_[3] = *(const v4u*)(hp_ + 192); \
        _Pragma("unroll") for (int h = 0; h < 8; ++h) { const unsigned char* rp_ = U4 + (size_t)E[h] * 128; B0_[h] = *(const v4u*)rp_; B1_[h] = *(const v4u*)(rp_ + 64); } } while (0)
#define BPM(x_) ((int)__builtin_amdgcn_ds_bpermute(pidx, (int)(x_)))
#define P6B_COMPUTE(A_, B0_, B1_, ix_) do { if ((ix_) < NI) { const int tc_ = 2 * (ix_) + par; \
        const v8i_q a0_ = (v8i_q){(int)A_[0].x, (int)A_[0].y, (int)A_[0].z, (int)A_[0].w, (int)A_[1].x, (int)A_[1].y, (int)A_[1].z, (int)A_[1].w}, a1_ = (v8i_q){(int)A_[2].x, (int)A_[2].y, (int)A_[2].z, (int)A_[2].w, (int)A_[3].x, (int)A_[3].y, (int)A_[3].z, (int)A_[3].w}; \
        _Pragma("unroll") for (int h = 0; h < 8; ++h) { const v8i_q b0_ = (v8i_q){BPM(B0_[h].x), BPM(B0_[h].y), BPM(B0_[h].z), BPM(B0_[h].w), 0, 0, 0, 0}, b1_ = (v8i_q){BPM(B1_[h].x), BPM(B1_[h].y), BPM(B1_[h].z), BPM(B1_[h].w), 0, 0, 0, 0}; \
            f32x4 acc_ = __builtin_amdgcn_mfma_scale_f32_16x16x128_f8f6f4(a0_, b0_, (f32x4){0.f, 0.f, 0.f, 0.f}, 0, 4, 0, 0x7F7F7F7F, 0, 0x7F7F7F7F); \
            acc_ = __builtin_amdgcn_mfma_scale_f32_16x16x128_f8f6f4(a1_, b1_, acc_, 0, 4, 0, 0x7F7F7F7F, 0, 0x7F7F7F7F); \
            if (lane < 16) PD[(size_t)tc_ * 128 + 16 * h + lane] = acc_[0] * (1.0f / 1024.0f); } } } while (0)
    unsigned E0[8], E1[8]; v4u A0[4], A1[4], B00[8], B01[8], B10[8], B11[8];
    int ix = wj;
    P6B_LOAD_EID(E0, ix); P6B_LOAD_EID(E1, ix + NW);
    P6B_LOAD_AB(A0, B00, B01, E0, ix);
    for (; ix < NI; ix += 2 * NW) {
        P6B_LOAD_AB(A1, B10, B11, E1, ix + NW);
        P6B_LOAD_EID(E0, ix + 2 * NW);
        P6B_COMPUTE(A0, B00, B01, ix);
        P6B_LOAD_AB(A0, B00, B01, E0, ix + 2 * NW);
        P6B_LOAD_EID(E1, ix + 3 * NW);
        P6B_COMPUTE(A1, B10, B11, ix + NW);
    }
#undef TOK
#undef P6B_LOAD_EID
#undef P6B_LOAD_AB
#undef P6B_COMPUTE
#undef BPM
}
#else
__device__ __forceinline__ void p6b(Frame& F) { F.fence_ids();
    const int j = F.bid & 7, nsb = F.G >> 3; if ((F.bid >> 3) >= nsb) return;
    const int wj = (F.bid >> 3) * NWAVES + F.wave, NW = nsb * NWAVES;
    const int lane = F.lane, g = lane >> 4;
    const int pidx = (4 * (lane & 15) + (lane >> 4)) * 4;
    const unsigned char* H8 = F.ws + WS_H2F8 + (size_t)j * MT * 128 + 16 * g; const unsigned char* UE8 = F.ws + WS_UE8 + (size_t)j * 16384 * 128 + 16 * (lane & 3); const unsigned* EID = (const unsigned*)(F.ws + WS_EID) + (lane >> 2);
    float* PD = (float*)(F.ws + WS_PD) + (size_t)j * MT * 128;
#define P6B_LOAD_EID(E, tt) do { const int tc_ = (tt) < MT ? (tt) : MT - 1; _Pragma("unroll") for (int h = 0; h < 8; ++h) E[h] = EID[(size_t)tc_ * 128 + 16 * h]; } while (0)
#define P6B_LOAD_AB(A0_, A1_, B0_, B1_, E, tt) do { const int tc_ = (tt) < MT ? (tt) : MT - 1; const unsigned char* hp_ = H8 + (size_t)tc_ * 128; A0_ = *(const v4u*)hp_; A1_ = *(const v4u*)(hp_ + 64); \
        _Pragma("unroll") for (int h = 0; h < 8; ++h) { const unsigned char* rp_ = UE8 + (size_t)E[h] * 128; B0_[h] = *(const v4u*)rp_; B1_[h] = *(const v4u*)(rp_ + 64); } } while (0)
#define BPM(x_) ((unsigned)__builtin_amdgcn_ds_bpermute(pidx, (int)(x_)))
#define P6B_COMPUTE(A0_, A1_, B0_, B1_, tt) do { if ((tt) < MT) { _Pragma("unroll") for (int h = 0; h < 8; ++h) { f32x4 acc_ = (f32x4){0.f, 0.f, 0.f, 0.f}; \
            acc_ = __builtin_amdgcn_mfma_f32_16x16x32_fp8_fp8(mk64(A0_.x, A0_.y), mk64(BPM(B0_[h].x), BPM(B0_[h].y)), acc_, 0, 0, 0); \
            acc_ = __builtin_amdgcn_mfma_f32_16x16x32_fp8_fp8(mk64(A0_.z, A0_.w), mk64(BPM(B0_[h].z), BPM(B0_[h].w)), acc_, 0, 0, 0); \
            acc_ = __builtin_amdgcn_mfma_f32_16x16x32_fp8_fp8(mk64(A1_.x, A1_.y), mk64(BPM(B1_[h].x), BPM(B1_[h].y)), acc_, 0, 0, 0); \
            acc_ = __builtin_amdgcn_mfma_f32_16x16x32_fp8_fp8(mk64(A1_.z, A1_.w), mk64(BPM(B1_[h].z), BPM(B1_[h].w)), acc_, 0, 0, 0); \
            if (lane < 16) PD[(size_t)(tt) * 128 + 16 * h + lane] = acc_[0] * (1.0f / 8192.0f); } } } while (0)
    unsigned E0[8], E1[8]; v4u A00, A01, A10, A11, B00[8], B01[8], B10[8], B11[8];
    int t = wj;
    P6B_LOAD_EID(E0, t); P6B_LOAD_EID(E1, t + NW);
    P6B_LOAD_AB(A00, A01, B00, B01, E0, t);
    for (; t < MT; t += 2 * NW) {
        P6B_LOAD_AB(A10, A11, B10, B11, E1, t + NW);
        P6B_LOAD_EID(E0, t + 2 * NW);
        P6B_COMPUTE(A00, A01, B00, B01, t);
        P6B_LOAD_AB(A00, A01, B00, B01, E0, t + 2 * NW);
        P6B_LOAD_EID(E1, t + 3 * NW);
        P6B_COMPUTE(A10, A11, B10, B11, t + NW);
    }
#undef P6B_LOAD_EID
#undef P6B_LOAD_AB
#undef P6B_COMPUTE
#undef BPM
}
#endif
__device__ __forceinline__ void p6b2(Frame& F) { F.fence_ids();
    const float* PD = (const float*)(F.ws + WS_PD); const float* GWp = (const float*)(F.ws + WS_GW); float* ACT = (float*)(F.ws + WS_ACT);
    for (size_t i4 = (size_t)F.bid * 512 + F.tid; i4 < (size_t)MT * 32; i4 += (size_t)F.G * 512) {
        f32x4 s = *(const f32x4*)(PD + i4 * 4);
#pragma unroll
        for (int jj = 1; jj < (MK_U4 ? 4 : 8); ++jj) s += *(const f32x4*)(PD + (size_t)jj * MT * 128 + i4 * 4);
        const f32x4 gw = *(const f32x4*)(GWp + i4 * 4);
        *(f32x4*)(ACT + i4 * 4) = (f32x4){gelu1(s[0]) * gw[0], gelu1(s[1]) * gw[1], gelu1(s[2]) * gw[2], gelu1(s[3]) * gw[3]};
    }
}
__device__ __forceinline__ void p6c(Frame& F) { F.fence_ids();
    const int j = F.bid & 7, nsb = F.G >> 3; if ((F.bid >> 3) >= nsb) return;
    const int wj = (F.bid >> 3) * NWAVES + F.wave, NW = nsb * NWAVES;
    const int lane = F.lane, g8 = lane >> 3, s8 = lane & 7;
    LAS float* Act = (LAS float*)(F.lds + F.wave * 8192); LAS unsigned* Eidl = (LAS unsigned*)(F.lds + F.wave * 8192 + 4096);
    const unsigned char* VE8 = F.ws + WS_VE8 + (size_t)j * 16384 * 128 + 16 * s8; const unsigned* EID = (const unsigned*)(F.ws + WS_EID); const float* ACT = (const float*)(F.ws + WS_ACT);
    bf16* PEERS = (bf16*)(F.ws + WS_PEERS) + (size_t)j * MT * 128;
    for (int tg = wj; tg < MT / 8; tg += NW) {
        const size_t t0 = (size_t)tg * 8;
#pragma unroll
        for (int q = 0; q < 4; ++q) { const int idx = 4 * (lane + 64 * q);
            *(LAS f32x4*)(Act + idx) = *(const f32x4*)(ACT + t0 * 128 + idx); *(LAS v4u*)(Eidl + idx) = *(const v4u*)(EID + t0 * 128 + idx); }
        LDS_WAIT(); asm volatile("" ::: "memory");
        f32x2c acc2[8];
#pragma unroll
        for (int e = 0; e < 8; ++e) acc2[e] = (f32x2c){0.f, 0.f};
        LAS const float* ap = Act + g8 * 128; LAS const unsigned* ep = Eidl + g8 * 128;
        v4u va[8], vb[8]; f32x4 aa[2], ab[2];
#define P6C_LOAD(V_, A_, base) do { A_[0] = *(LAS const f32x4*)(ap + (base)); A_[1] = *(LAS const f32x4*)(ap + (base) + 4); const v4u e0_ = *(LAS const v4u*)(ep + (base)), e1_ = *(LAS const v4u*)(ep + (base) + 4); \
            _Pragma("unroll") for (int k = 0; k < 4; ++k) { V_[k] = *(const v4u*)(VE8 + (size_t)e0_[k] * 128); V_[4 + k] = *(const v4u*)(VE8 + (size_t)e1_[k] * 128); } } while (0)
#define P6C_FMA(V_, A_) do { _Pragma("unroll") for (int k = 0; k < 8; ++k) { const float a_ = A_[k >> 2][k & 3]; const f32x2c a2_ = (f32x2c){a_, a_}; _Pragma("unroll") for (int w = 0; w < 4; ++w) { \
            const f32x2c lo_ = __builtin_amdgcn_cvt_pk_f32_fp8((int)V_[k][w], false), hi_ = __builtin_amdgcn_cvt_pk_f32_fp8((int)V_[k][w], true); \
            acc2[2 * w] = __builtin_elementwise_fma(a2_, lo_, acc2[2 * w]); acc2[2 * w + 1] = __builtin_elementwise_fma(a2_, hi_, acc2[2 * w + 1]); } } } while (0)
        P6C_LOAD(va, aa, 0);
        for (int it = 0; it < 128; it += 16) {
            P6C_LOAD(vb, ab, it + 8);
            P6C_FMA(va, aa);
            if (it + 16 < 128) P6C_LOAD(va, aa, it + 16);
            P6C_FMA(vb, ab);
        }
#undef P6C_LOAD
#undef P6C_FMA
        float acc[16];
#pragma unroll
        for (int e = 0; e < 8; ++e) { acc[2 * e] = acc2[e][0]; acc[2 * e + 1] = acc2[e][1]; }
        { bf16* op = PEERS + (t0 + g8) * 128 + 16 * s8;
            v4u o0, o1;
            o0.x = pk2(acc[0] * 0.0625f, acc[1] * 0.0625f); o0.y = pk2(acc[2] * 0.0625f, acc[3] * 0.0625f); o0.z = pk2(acc[4] * 0.0625f, acc[5] * 0.0625f); o0.w = pk2(acc[6] * 0.0625f, acc[7] * 0.0625f);
            o1.x = pk2(acc[8] * 0.0625f, acc[9] * 0.0625f); o1.y = pk2(acc[10] * 0.0625f, acc[11] * 0.0625f); o1.z = pk2(acc[12] * 0.0625f, acc[13] * 0.0625f); o1.w = pk2(acc[14] * 0.0625f, acc[15] * 0.0625f);
            *(v4u*)op = o0; *(v4u*)(op + 8) = o1; }
        LDS_WAIT(); asm volatile("" ::: "memory");
    }
}
__device__ __forceinline__ void p6d(Frame& F) { F.fence_ids();
    const int gw = F.bid * NWAVES + F.wave, NGW = F.G * NWAVES; const bf16* PEERS = (const bf16*)(F.ws + WS_PEERS); const float* gate2 = (const float*)(F.ws + WS_MOD) + 5120;
    f32x4 fg[4];
#pragma unroll
    for (int q = 0; q < 4; ++q) fg[q] = *((const f32x4*)F.final_g + F.lane + 64 * q);
    f32x4 nx[4]; v2u np[4];
#define P6D_LOAD(tt) do { _Pragma("unroll") for (int q = 0; q < 4; ++q) { const int d = 4 * F.lane + 256 * q; nx[q] = *((const f32x4*)((const float*)F.dout + (size_t)(tt) * DM) + F.lane + 64 * q); \
        np[q] = *(const v2u*)(PEERS + ((size_t)(d >> 7) * MT + (tt)) * 128 + (d & 127)); } } while (0)
    if (gw < MT) P6D_LOAD(gw);
    for (int t = gw; t < MT; t += NGW) {
        const int b = t >> 12;
        f32x4* xr = (f32x4*)((float*)F.dout + (size_t)t * DM) + F.lane; f32x4 o[4]; float ss = 0.f;
#pragma unroll
        for (int q = 0; q < 4; ++q) { const int d = 4 * F.lane + 256 * q; const f32x4 g2 = *(const f32x4*)(gate2 + (size_t)b * 6144 + d);
            o[q] = nx[q] + g2 * (f32x4){bflo(np[q].x), bfhi(np[q].x), bflo(np[q].y), bfhi(np[q].y)}; ss += (o[q][0] * o[q][0] + o[q][1] * o[q][1]) + (o[q][2] * o[q][2] + o[q][3] * o[q][3]); }
        if (t + NGW < MT) P6D_LOAD(t + NGW);
        const float rstd = __builtin_amdgcn_rsqf(wave_sum(ss) * (1.f / DM) + EPSN);
#pragma unroll
        for (int q = 0; q < 4; ++q) xr[64 * q] = o[q] * rstd * fg[q];
    }
#undef P6D_LOAD
}

struct Args { const float* in[20]; float* out; unsigned char* ws; int ph_lo, ph_hi, li, pad; };
__global__ void __launch_bounds__(NWAVES * 64, 2) mk_fwd(Args args) {
    extern __shared__ __attribute__((aligned(16))) unsigned char lds_raw[];
    Frame F;
    F.lds = (LAS unsigned char*)lds_raw;
    F.tid = threadIdx.x; F.lane = F.tid & 63; F.wave = __builtin_amdgcn_readfirstlane(F.tid >> 6); F.G = gridDim.x; F.bid = blockIdx.x;
    F.x = args.in[0]; F.c = args.in[1]; F.w_ada = args.in[2]; F.b_ada = args.in[3]; F.norm1_g = args.in[4]; F.w_in = args.in[5]; F.ret_gn_g = args.in[6]; F.sgu_ln_g = args.in[7];
    F.sgu_ln_b = args.in[8]; F.sgu_w = args.in[9]; F.sgu_b = args.in[10]; F.w_ret_out = args.in[11]; F.w_sgu_out = args.in[12]; F.w_out = args.in[13]; F.norm2_g = args.in[14];
    F.peer_w_q = args.in[15]; F.peer_sub_keys = args.in[16]; F.peer_u = args.in[17]; F.peer_v = args.in[18]; F.final_g = args.in[19];
    F.ws = args.ws; F.dout = (unsigned char*)args.out;
    volatile LAS unsigned* MISC = (volatile LAS unsigned*)(F.lds + MISC_OFF); F.misc = MISC;
    if (F.tid < 64) MISC[F.tid] = 0u;
    __syncthreads();
    XcdBarrier bar; bar.bar = (unsigned*)(F.ws + WS_CTL) + CW_BAR; bar.x = 0; bar.st = nullptr;
    if (N_LAUNCHES == 1) bar = xcd_barrier_post((unsigned*)(F.ws + WS_CTL) + CW_BAR, MISC + 8);
    const int lo = args.ph_lo, hi = args.ph_hi;
#define IN(k) (lo <= (k) && (k) < hi)
#if MK_PROBE_HI > 0
#define STAMP(k) do { if (F.bid == 0 && F.wave == 0 && F.lane == 0) { const unsigned long long _t = __builtin_amdgcn_s_memrealtime(); MISC[16 + 2 * (k)] = (unsigned)_t; MISC[17 + 2 * (k)] = (unsigned)(_t >> 32); } } while (0)
#else
#define STAMP(k) do { } while (0)
#endif
#define SEAM(k) do { if (IN(k) && IN((k) + 1)) xcd_barrier(bar); } while (0)
    const float* mod = (const float*)(F.ws + WS_MOD);
    STAMP(0);
    if (IN(0)) { p0a(F); SEAM(0); }
    STAMP(1);
    if (IN(1)) { norm_rows<2>(F, F.x, F.norm1_g, mod + 0, mod + 1024, nullptr, F.dout + DO_H); SEAM(1); }
    STAMP(2);
    if (IN(2)) {
        pg8::Gemm g{(const bf16*)(F.dout + DO_H), (const bf16*)(F.ws + WS_WIN), MT, NIN, 512}; pg8::StaticOrder S; S.init(MT, NIN, F.G, F.bid);
        pg8::EpiProj E{(bf16*)(F.dout + DO_Q), (bf16*)(F.dout + DO_K), (bf16*)(F.ws + WS_V), (bf16*)(F.ws + WS_G), (bf16*)(F.ws + WS_U), (bf16*)(F.ws + WS_SV), (bf16*)(F.ws + WS_GA), (bf16*)(F.ws + WS_GB),
                       (const float*)(F.ws + WS_COS), (const float*)(F.ws + WS_SIN), 1.0f / 4096.0f, (float*)(F.ws + WS_SVSTAT)};
        pg8::gemm_phase<pg8::EpiProj, pg8::StaticOrder, true, true, true>(F.lds, g, S, E);
        SEAM(2);
    }
    STAMP(3);
    if (IN(3)) { p2a(F); SEAM(3); }
    STAMP(4);
    if (IN(4)) { p2b(F); SEAM(4); }
    STAMP(5);
    if (IN(5)) { p2c(F); SEAM(5); }
    STAMP(6);
    if (IN(6)) {
        pg8::StaticOrder S; S.init(MT, DM, F.G, F.bid);
        pg8::Gemm g{(const bf16*)(F.ws + WS_YG8), (const bf16*)(F.ws + WS_WRET), MT, DM, 1024, 512, (const bf16*)(F.ws + WS_YS8), (const bf16*)(F.ws + WS_WSGU), 8};
        pg8::EpiMerged E{(const bf16*)(F.ws + WS_GA), (const bf16*)(F.ws + WS_GB), F.ws + WS_MRG8, 1.0f / 4096.0f};
        pg8::gemm_phase<pg8::EpiMerged, pg8::StaticOrder, true, true, true>(F.lds, g, S, E);
        SEAM(6);
    }
    STAMP(7);
    if (IN(7)) {
        pg8::Gemm g{(const bf16*)(F.ws + WS_MRG8), (const bf16*)(F.ws + WS_WOUT), MT, DM, 512}; pg8::StaticOrder S; S.init(MT, DM, F.G, F.bid);
        pg8::EpiX1 E{F.x, mod + 2048, (float*)F.dout, 1.0f / 4096.0f};
        pg8::gemm_phase<pg8::EpiX1, pg8::StaticOrder, true, true, true>(F.lds, g, S, E);
        SEAM(7);
    }
    STAMP(8);
    if (IN(8)) { norm_rows<1>(F, (const float*)F.dout, F.norm2_g, mod + 3072, mod + 4096, (bf16*)(F.ws + WS_SV), F.ws + WS_H2F8); SEAM(8); }
    STAMP(9);
    if (IN(9)) {
        pg8::Gemm g{(const bf16*)(F.ws + WS_SV), (const bf16*)(F.ws + WS_WQ), MT, 2048, DM}; pg8::StaticOrder S; S.init(MT, 2048, F.G, F.bid);
        pg8::EpiPlain E{(bf16*)(F.ws + WS_GA), 2048};
        pg8::gemm_phase<pg8::EpiPlain, pg8::StaticOrder, true, true>(F.lds, g, S, E);
        SEAM(9);
    }
    STAMP(10);
    if (IN(10)) { p5b(F); SEAM(10); }
    STAMP(11);
    if (IN(11)) { p6a(F); SEAM(11); }
    STAMP(12);
    if (IN(12)) { p6b(F); SEAM(12); }
    STAMP(13);
    if (IN(13)) { p6b2(F); SEAM(13); }
    STAMP(14);
    if (IN(14)) { p6c(F); SEAM(14); }
    STAMP(15);
    if (IN(15)) { p6d(F); }
    STAMP(16);
#if MK_PROBE_HI > 0
    __syncthreads();
    if (F.bid == 0 && F.tid == 0) { const unsigned long long t0 = ((unsigned long long)MISC[17 + 2 * MK_PROBE_LO] << 32) | MISC[16 + 2 * MK_PROBE_LO], t1 = ((unsigned long long)MISC[17 + 2 * MK_PROBE_HI] << 32) | MISC[16 + 2 * MK_PROBE_HI];
#if MK_GPROBE == 1
        ((float*)F.dout)[0] += (float)MISC[56] * 1e-3f; }
#elif MK_GPROBE == 2
        ((float*)F.dout)[0] += (float)MISC[57] * 1e-3f; }
#else
        ((float*)F.dout)[0] += (float)(t1 - t0) * 1e-3f; }
#endif
#endif
#undef IN
#undef SEAM
}

extern "C" void kernel_launch(void* const* d_in, const int* in_sizes, int n_in, void* d_out, int out_size, void* d_ws, size_t ws_size, hipStream_t stream) {
    static int grid = 0;
    if (grid == 0) {
        if (n_in != 20 || out_size != MT * DM || ws_size < WS_END) { fprintf(stderr, "kernel_launch: unexpected shapes (n_in %d, out %d, ws %zu); nothing launched\n", n_in, out_size, ws_size); grid = -1; return; }
        int dev = 0, cus = 0, per_cu = 0;
        if (hipGetDevice(&dev) != hipSuccess || hipDeviceGetAttribute(&cus, hipDeviceAttributeMultiprocessorCount, dev) != hipSuccess) { grid = -1; return; }
        if (hipFuncSetAttribute((const void*)mk_fwd, hipFuncAttributeMaxDynamicSharedMemorySize, LDS_BYTES) != hipSuccess) { fprintf(stderr, "kernel_launch: hipFuncSetAttribute failed\n"); grid = -1; return; }
        if (hipOccupancyMaxActiveBlocksPerMultiprocessor(&per_cu, (const void*)mk_fwd, NWAVES * 64, LDS_BYTES) != hipSuccess || per_cu < 1)
            fprintf(stderr, "kernel_launch: note: occupancy query reports %d workgroups per CU\n", per_cu);
        (void)hipGetLastError();
        grid = cus;
    }
    if (grid < 0) return;
    if (hipMemsetAsync((char*)d_ws + WS_CTL, 0, CTL_ZERO_BYTES, stream) != hipSuccess) { fprintf(stderr, "kernel_launch: memset failed\n"); return; }
    Args a{};
    for (int i = 0; i < 20; ++i) a.in[i] = (const float*)d_in[i];
    a.out = (float*)d_out; a.ws = (unsigned char*)d_ws;
    static_assert(N_LAUNCHES == 1 || N_LAUNCHES == N_PHASES, "N_LAUNCHES is 1 or N_PHASES");
    for (int li = 0; li < N_LAUNCHES && li < MK_MAXPH; ++li) {
        a.ph_lo = (N_LAUNCHES == 1) ? 0 : li; a.ph_hi = (N_LAUNCHES == 1) ? N_PHASES : li + 1; a.li = li;
        hipLaunchKernelGGL(mk_fwd, dim3(grid), dim3(NWAVES * 64), LDS_BYTES, stream, a);
        const hipError_t le = hipPeekAtLastError();
        if (le != hipSuccess) { fprintf(stderr, "kernel_launch: launch %d failed: %s\n", li, hipGetErrorName(le)); break; }
    }
}
```

```cpp
#include <hip/hip_runtime.h>
#include <cstdio>
#include <cstdint>

#ifndef MK_PROBE_LO
#define MK_PROBE_LO 0
#define MK_PROBE_HI 0
#endif
#ifndef MK_GPROBE
#define MK_GPROBE 0
#endif
#define MK_MISC_OFF (147456 - 256)
#ifndef MK_U4
#define MK_U4 1
#endif
#ifndef MK_ALAY
#define MK_ALAY 2
#endif
#ifndef MK_MAXPH
#define MK_MAXPH 16
#endif
#ifndef MK_N_LAUNCHES
#define MK_N_LAUNCHES 1
#endif
namespace pg8 {
#define PG8_LAS __attribute__((address_space(3)))
typedef unsigned short bf16_t;
typedef short bf16x8 __attribute__((ext_vector_type(8)));
typedef float f32x4 __attribute__((ext_vector_type(4)));
typedef unsigned u32x4 __attribute__((ext_vector_type(4)));
constexpr int BM = 256, BK = 64, HALF = 128, HTB = HALF * BK * 2  , STAGE_BYTES = 8 * HTB, NXCD = 8, WGM = 2;

__host__ __device__ __forceinline__ int lds_byte(int r, int c) { const int st = (r >> 4) * 2 + (c >> 5), rr = r & 15, cc = c & 31, ob = rr * 64 + cc * 2; return st * 1024 + (ob ^ (((ob >> 9) & 1) << 5)); }
__host__ __device__ __forceinline__ void stage_rc(int b, int& R, int& C) { const int st = b / 1024, sb = b % 1024, swz = sb ^ (((sb >> 9) & 1) << 5); R = (st >> 1) * 16 + swz / 64; C = (st & 1) * 32 + (swz % 64) / 2; }
__host__ __device__ __forceinline__ int perm32(int rho) { const int n = rho >> 4, i = rho & 15; return 8 * (i >> 2) + 4 * n + (i & 3); }

struct Unit { int pm, pn; };
struct Gemm { const bf16_t* A; const bf16_t* Bt; int M, N, K; int ld = 0; const bf16_t* A2 = nullptr; const bf16_t* Bt2 = nullptr; int ksplit = 0; };

struct StaticOrder {
    int nM, nN, nwg, G, c;
    __host__ __device__ void init(int M, int N, int G_, int c_) { nM = M / BM; nN = N / BM; nwg = nM * nN; G = G_; c = c_; }
    __host__ __device__ bool next(int i, Unit& u) const {
        const long L = (long)i * G + c; if (L >= nwg) return false;
        int wgid = (int)L; { const int q = nwg / NXCD, r = nwg % NXCD, xcd = wgid % NXCD, off = wgid / NXCD; wgid = (xcd < r ? xcd * (q + 1) : r * (q + 1) + (xcd - r) * q) + off; }
        const int nig = WGM * nN, gid = wgid / nig, fm = gid * WGM, gsz = (nM - fm) < WGM ? (nM - fm) : WGM;
        u.pm = fm + ((wgid % nig) % gsz); u.pn = (wgid % nig) / gsz; return true;
    }
    __device__ __forceinline__ void a_ready(const Unit&) const {}
    __device__ __forceinline__ void done(const Unit&) const {}
};

__device__ __forceinline__ unsigned cvt_pk_bf16(float lo, float hi) { unsigned r; asm volatile("v_cvt_pk_bf16_f32 %0, %1, %2" : "=v"(r) : "v"(lo), "v"(hi)); return r; }
typedef float f32x2 __attribute__((ext_vector_type(2)));
__device__ __forceinline__ f32x2 gelu_pk(f32x2 v) {
    const f32x2 av = __builtin_elementwise_abs(v), d = av * 0.2316418882f + 1.0f;
    f32x2 t; t.x = __builtin_amdgcn_rcpf(d.x); t.y = __builtin_amdgcn_rcpf(d.y);
    f32x2 q = t * 0.5307027145f + (-0.7265760135f); q = q * t + 0.7107068705f; q = q * t + (-0.142248368f); q = q * t + 0.127414796f; q = q * t;
    const f32x2 s = (v * v) * (-0.72134752044f);
    f32x2 e; e.x = __builtin_amdgcn_exp2f(s.x); e.y = __builtin_amdgcn_exp2f(s.y);
    const f32x2 m = v * (q * e), r = v - m;
    f32x2 o; o.x = v.x < 0.f ? m.x : r.x; o.y = v.y < 0.f ? m.y : r.y; return o;
}


typedef unsigned u32x2 __attribute__((ext_vector_type(2)));
__device__ __forceinline__ float bflo(unsigned w) { return __uint_as_float(w << 16); }
__device__ __forceinline__ float bfhi(unsigned w) { return __uint_as_float(w & 0xffff0000u); }
typedef float f32x2q __attribute__((ext_vector_type(2)));
__device__ __forceinline__ f32x4 f8x4(unsigned w) { const f32x2q lo = __builtin_amdgcn_cvt_pk_f32_fp8((int)w, false), hi = __builtin_amdgcn_cvt_pk_f32_fp8((int)w, true); return (f32x4){lo[0], lo[1], hi[0], hi[1]}; }
__device__ __forceinline__ float gelu1(float v) {
    const float av = __builtin_fabsf(v), t = __builtin_amdgcn_rcpf(av * 0.2316418882f + 1.0f);
    float q = t * 0.5307027145f + (-0.7265760135f); q = q * t + 0.7107068705f; q = q * t + (-0.142248368f); q = q * t + 0.127414796f; q = q * t;
    const float e = __builtin_amdgcn_exp2f((v * v) * (-0.72134752044f));
    const float m = v * (q * e);
    return v < 0.f ? m : v - m;
}
__device__ __forceinline__ float sigm1(float v) { return __builtin_amdgcn_rcpf(1.0f + __builtin_amdgcn_exp2f(v * (-1.44269504089f))); }
__device__ __forceinline__ float silu1(float v) { return v * sigm1(v); }

__device__ __forceinline__ unsigned bperm(int idx, unsigned v) { return (unsigned)__builtin_amdgcn_ds_bpermute(idx, (int)v); }
__device__ __forceinline__ float bpermf(int idx, float v) { return __int_as_float(__builtin_amdgcn_ds_bpermute(idx, __float_as_int(v))); }
__device__ __forceinline__ f32x4 bperm4(int idx, const f32x4& v) { return (f32x4){bpermf(idx, v[0]), bpermf(idx, v[1]), bpermf(idx, v[2]), bpermf(idx, v[3])}; }
__device__ __forceinline__ u32x4 bperm4u(int idx, const u32x4& v) { u32x4 r; r.x = bperm(idx, v.x); r.y = bperm(idx, v.y); r.z = bperm(idx, v.z); r.w = bperm(idx, v.w); return r; }
#define PG8_REMAP() const int lane_ = 16 * fq + fr, pidx = (16 * (lane_ & 3) + (lane_ >> 2)) * 4, fr2 = lane_ >> 2, fq2 = lane_ & 3

struct EpiProj {
    static constexpr bool PERM = true, AFTER_DRAIN = false, HAS_MID = false;
    bf16_t *Q, *Kb, *V, *G, *U, *SV, *GA, *GB; const float *cosT, *sinT; float osc; float* svstat;
    __device__ __forceinline__ void operator()(const f32x4 (&acc)[2][2][4][2], const Unit& u, int wr, int wc, int fr, int fq) const {
        PG8_REMAP();
        const int colt = u.pn * BM; const int row0 = u.pm * BM + wr * 64 + fr2;
        if (colt < 1024) {
            const bool isk = colt >= 512; bf16_t* base = isk ? Kb : Q; const int lc0 = (colt & 511) + wc * 32 + 8 * fq2; const float sc = (isk ? 0.08838834764831845f : 1.0f) * osc;
            const int fi = wc * 16 + 4 * fq2;
#pragma unroll
            for (int ai = 0; ai < 2; ++ai) {
                f32x4 csv[4], snv[4];
#pragma unroll
                for (int m = 0; m < 4; ++m) { const int s = (row0 + ai * HALF + m * 16) & 4095; csv[m] = *(const f32x4*)(cosT + s * 64 + fi) * sc; snv[m] = *(const f32x4*)(sinT + s * 64 + fi) * sc; }
#pragma unroll
                for (int m = 0; m < 4; ++m) { const int row = row0 + ai * HALF + m * 16; const f32x4 cs = csv[m], sn = snv[m];
#pragma unroll
                    for (int bj = 0; bj < 2; ++bj) { const f32x4 v0 = bperm4(pidx, acc[ai][bj][m][0]), v1 = bperm4(pidx, acc[ai][bj][m][1]);
                        u32x4 w;
                        w.x = cvt_pk_bf16(v0[0] * cs[0] - v0[1] * sn[0], v0[0] * sn[0] + v0[1] * cs[0]);
                        w.y = cvt_pk_bf16(v0[2] * cs[1] - v0[3] * sn[1], v0[2] * sn[1] + v0[3] * cs[1]);
                        w.z = cvt_pk_bf16(v1[0] * cs[2] - v1[1] * sn[2], v1[0] * sn[2] + v1[1] * cs[2]);
                        w.w = cvt_pk_bf16(v1[2] * cs[3] - v1[3] * sn[3], v1[2] * sn[3] + v1[3] * cs[3]);
                        *(u32x4*)(base + (size_t)row * 512 + lc0 + bj * HALF) = w; } } }
        } else {
            const int seg = (colt - 1024) >> 10;
            bf16_t* base = seg == 0 ? V : seg == 1 ? G : seg == 2 ? U : seg == 3 ? SV : seg == 4 ? GA : GB;
            const int lc0 = ((colt - 1024) & 1023) + wc * 32 + 8 * fq2;
#pragma unroll
            for (int ai = 0; ai < 2; ++ai)
#pragma unroll
                for (int m = 0; m < 4; ++m) { const int row = row0 + ai * HALF + m * 16; float s1[2] = {0.f, 0.f}, s2[2] = {0.f, 0.f};
#pragma unroll
                    for (int bj = 0; bj < 2; ++bj) { f32x4 v0 = acc[ai][bj][m][0] * osc, v1 = acc[ai][bj][m][1] * osc;
                        if (seg == 1) {
#pragma unroll
                            for (int e = 0; e < 4; ++e) { v0[e] = silu1(v0[e]); v1[e] = silu1(v1[e]); }
                        } else if (seg == 2 || seg == 3) {
                            f32x2 a = gelu_pk((f32x2){v0[0], v0[1]}), b = gelu_pk((f32x2){v0[2], v0[3]}), c = gelu_pk((f32x2){v1[0], v1[1]}), d = gelu_pk((f32x2){v1[2], v1[3]});
                            v0 = (f32x4){a.x, a.y, b.x, b.y}; v1 = (f32x4){c.x, c.y, d.x, d.y};
                        } else if (seg >= 4) {
#pragma unroll
                            for (int e = 0; e < 4; ++e) { v0[e] = sigm1(v0[e]); v1[e] = sigm1(v1[e]); }
                        }
                        if (seg == 3) { s1[bj] = ((v0[0] + v0[1]) + (v0[2] + v0[3])) + ((v1[0] + v1[1]) + (v1[2] + v1[3]));
                            s2[bj] = ((v0[0] * v0[0] + v0[1] * v0[1]) + (v0[2] * v0[2] + v0[3] * v0[3])) + ((v1[0] * v1[0] + v1[1] * v1[1]) + (v1[2] * v1[2] + v1[3] * v1[3])); }
                        if (seg == 0) { u32x4 w; w.x = cvt_pk_bf16(v0[0], v0[1]); w.y = cvt_pk_bf16(v0[2], v0[3]); w.z = cvt_pk_bf16(v1[0], v1[1]); w.w = cvt_pk_bf16(v1[2], v1[3]);
                            *(u32x4*)(base + (size_t)row * 1024 + lc0 + bj * HALF) = bperm4u(pidx, w); }
                        else { const float fs = seg >= 4 ? 256.0f : 16.0f;
                            int t0 = __builtin_amdgcn_cvt_pk_fp8_f32(v0[0] * fs, v0[1] * fs, 0, false); t0 = __builtin_amdgcn_cvt_pk_fp8_f32(v0[2] * fs, v0[3] * fs, t0, true);
                            int t1 = __builtin_amdgcn_cvt_pk_fp8_f32(v1[0] * fs, v1[1] * fs, 0, false); t1 = __builtin_amdgcn_cvt_pk_fp8_f32(v1[2] * fs, v1[3] * fs, t1, true);
                            u32x2 w8; w8.x = bperm(pidx, (unsigned)t0); w8.y = bperm(pidx, (unsigned)t1);
                            *(u32x2*)((unsigned char*)base + (size_t)row * 1024 + lc0 + bj * HALF) = w8; } }
                    if (seg == 3) {
                        float a = s1[0] + s1[1], b = s2[0] + s2[1];
                        a += __shfl_xor(a, 16); b += __shfl_xor(b, 16); a += __shfl_xor(a, 32); b += __shfl_xor(b, 32);
                        if (fq == 0) { float* sp = svstat + (size_t)(u.pm * BM + wr * 64 + fr + ai * HALF + m * 16) * 2; atomicAdd(sp, a); atomicAdd(sp + 1, b); } } }
        }
    }
};
template <bool ACCUM> struct EpiGate {
    static constexpr bool PERM = true, AFTER_DRAIN = false, HAS_MID = false;
    const bf16_t* GT; bf16_t* TMP; unsigned char* OUT8; float osc;
    __device__ __forceinline__ void operator()(const f32x4 (&acc)[2][2][4][2], const Unit& u, int wr, int wc, int fr, int fq) const {
        PG8_REMAP();
        const int row0 = u.pm * BM + wr * 64 + fr2, col0 = u.pn * BM + wc * 32 + 8 * fq2;
#pragma unroll
        for (int ai = 0; ai < 2; ++ai)
#pragma unroll
            for (int mp = 0; mp < 2; ++mp) {
                u32x4 gv[2][2], pv[2][2];
#pragma unroll
                for (int mm = 0; mm < 2; ++mm)
#pragma unroll
                    for (int bj = 0; bj < 2; ++bj) { const size_t off = (size_t)(row0 + ai * HALF + (2 * mp + mm) * 16) * 1024 + col0 + bj * HALF;
                        gv[mm][bj] = *(const u32x4*)(GT + off); if (ACCUM) pv[mm][bj] = *(const u32x4*)(TMP + off); }
#pragma unroll
                for (int mm = 0; mm < 2; ++mm)
#pragma unroll
                    for (int bj = 0; bj < 2; ++bj) { const int m = 2 * mp + mm; const size_t off = (size_t)(row0 + ai * HALF + m * 16) * 1024 + col0 + bj * HALF;
                        const f32x4 v0 = bperm4(pidx, acc[ai][bj][m][0]) * osc, v1 = bperm4(pidx, acc[ai][bj][m][1]) * osc; const u32x4 g = gv[mm][bj];
                        float o[8] = {v0[0] * bflo(g.x), v0[1] * bfhi(g.x), v0[2] * bflo(g.y), v0[3] * bfhi(g.y), v1[0] * bflo(g.z), v1[1] * bfhi(g.z), v1[2] * bflo(g.w), v1[3] * bfhi(g.w)};
                        if (ACCUM) { const u32x4 p = pv[mm][bj];
                            o[0] += bflo(p.x); o[1] += bfhi(p.x); o[2] += bflo(p.y); o[3] += bfhi(p.y); o[4] += bflo(p.z); o[5] += bfhi(p.z); o[6] += bflo(p.w); o[7] += bfhi(p.w);
                            u32x2 w8; int t0 = __builtin_amdgcn_cvt_pk_fp8_f32(o[0] * 8.f, o[1] * 8.f, 0, false); t0 = __builtin_amdgcn_cvt_pk_fp8_f32(o[2] * 8.f, o[3] * 8.f, t0, true);
                            int t1 = __builtin_amdgcn_cvt_pk_fp8_f32(o[4] * 8.f, o[5] * 8.f, 0, false); t1 = __builtin_amdgcn_cvt_pk_fp8_f32(o[6] * 8.f, o[7] * 8.f, t1, true);
                            w8.x = (unsigned)t0; w8.y = (unsigned)t1; *(u32x2*)(OUT8 + off) = w8;
                        } else {
                            u32x4 w; w.x = cvt_pk_bf16(o[0], o[1]); w.y = cvt_pk_bf16(o[2], o[3]); w.z = cvt_pk_bf16(o[4], o[5]); w.w = cvt_pk_bf16(o[6], o[7]);
                            *(u32x4*)(TMP + off) = w; } }
            }
    }
};
struct EpiMerged {
    static constexpr bool PERM = true, AFTER_DRAIN = false, HAS_MID = true;
    const unsigned char* GA; const unsigned char* GB; unsigned char* OUT8; float osc;
    __device__ __forceinline__ void mid(f32x4 (&acc)[2][2][4][2], const Unit& u, int wr, int wc, int fr, int fq) const {
        int fr_ = fr, fq_ = fq; asm volatile("" : "+v"(fr_), "+v"(fq_));
        const int row0 = u.pm * BM + wr * 64 + fr_, col0 = u.pn * BM + wc * 32 + 8 * fq_;
#pragma unroll
        for (int ai = 0; ai < 2; ++ai)
#pragma unroll
            for (int mp = 0; mp < 2; ++mp) {
                u32x2 av[2][2], bv[2][2];
#pragma unroll
                for (int mm = 0; mm < 2; ++mm)
#pragma unroll
                    for (int bj = 0; bj < 2; ++bj) { const size_t off = (size_t)(row0 + ai * HALF + (2 * mp + mm) * 16) * 1024 + col0 + bj * HALF; av[mm][bj] = *(const u32x2*)(GA + off); bv[mm][bj] = *(const u32x2*)(GB + off); }
#pragma unroll
                for (int mm = 0; mm < 2; ++mm)
#pragma unroll
                    for (int bj = 0; bj < 2; ++bj) { const int m = 2 * mp + mm; const f32x4 a0 = f8x4(av[mm][bj].x), a1 = f8x4(av[mm][bj].y), b0 = f8x4(bv[mm][bj].x), b1 = f8x4(bv[mm][bj].y);
#pragma unroll
                        for (int e = 0; e < 4; ++e) { acc[ai][bj][m][0][e] *= 2.f * a0[e] * __builtin_amdgcn_rcpf(__builtin_fmaxf(b0[e], 0.001953125f)); acc[ai][bj][m][1][e] *= 2.f * a1[e] * __builtin_amdgcn_rcpf(__builtin_fmaxf(b1[e], 0.001953125f)); } }
            }
    }
    __device__ __forceinline__ void operator()(const f32x4 (&acc)[2][2][4][2], const Unit& u, int wr, int wc, int fr, int fq) const {
        PG8_REMAP();
        const int row0 = u.pm * BM + wr * 64 + fr2, col0 = u.pn * BM + wc * 32 + 8 * fq2; const float sc = osc * 8.f * (1.0f / 256.0f);
#pragma unroll
        for (int ai = 0; ai < 2; ++ai)
#pragma unroll
            for (int mp = 0; mp < 2; ++mp) {
                u32x2 gv[2][2];
#pragma unroll
                for (int mm = 0; mm < 2; ++mm)
#pragma unroll
                    for (int bj = 0; bj < 2; ++bj) gv[mm][bj] = *(const u32x2*)(GB + (size_t)(row0 + ai * HALF + (2 * mp + mm) * 16) * 1024 + col0 + bj * HALF);
#pragma unroll
                for (int mm = 0; mm < 2; ++mm)
#pragma unroll
                    for (int bj = 0; bj < 2; ++bj) { const int m = 2 * mp + mm; const size_t off = (size_t)(row0 + ai * HALF + m * 16) * 1024 + col0 + bj * HALF;
                        const f32x4 v0 = bperm4(pidx, acc[ai][bj][m][0]) * sc * f8x4(gv[mm][bj].x), v1 = bperm4(pidx, acc[ai][bj][m][1]) * sc * f8x4(gv[mm][bj].y);
                        u32x2 w8; int t0 = __builtin_amdgcn_cvt_pk_fp8_f32(v0[0], v0[1], 0, false); t0 = __builtin_amdgcn_cvt_pk_fp8_f32(v0[2], v0[3], t0, true);
                        int t1 = __builtin_amdgcn_cvt_pk_fp8_f32(v1[0], v1[1], 0, false); t1 = __builtin_amdgcn_cvt_pk_fp8_f32(v1[2], v1[3], t1, true);
                        w8.x = (unsigned)t0; w8.y = (unsigned)t1; *(u32x2*)(OUT8 + off) = w8; }
            }
    }
};
struct EpiX1 {
    static constexpr bool PERM = false, AFTER_DRAIN = false, HAS_MID = false;
    const float* X; const float* gate1; float* X1; float osc;
    __device__ __forceinline__ void operator()(const f32x4 (&acc)[2][2][4][2], const Unit& u, int wr, int wc, int fr, int fq) const {
        PG8_REMAP();
        const int row0 = u.pm * BM + wr * 64 + fr2, col0 = u.pn * BM + wc * 32 + 4 * fq2;
        const float* gp = gate1 + (size_t)((u.pm * BM) >> 12) * 6144 + col0;
        f32x4 gv[2][2];
#pragma unroll
        for (int bj = 0; bj < 2; ++bj)
#pragma unroll
            for (int n = 0; n < 2; ++n) gv[bj][n] = *(const f32x4*)(gp + bj * HALF + n * 16) * osc;
#pragma unroll
        for (int ai = 0; ai < 2; ++ai)
#pragma unroll
            for (int mp = 0; mp < 2; ++mp) {
                f32x4 xv[2][2][2];
#pragma unroll
                for (int mm = 0; mm < 2; ++mm) { const size_t off = (size_t)(row0 + ai * HALF + (2 * mp + mm) * 16) * 1024 + col0;
#pragma unroll
                    for (int bj = 0; bj < 2; ++bj)
#pragma unroll
                        for (int n = 0; n < 2; ++n) xv[mm][bj][n] = *(const f32x4*)(X + off + bj * HALF + n * 16); }
#pragma unroll
                for (int mm = 0; mm < 2; ++mm) { const int m = 2 * mp + mm; const size_t off = (size_t)(row0 + ai * HALF + m * 16) * 1024 + col0;
#pragma unroll
                    for (int bj = 0; bj < 2; ++bj)
#pragma unroll
                        for (int n = 0; n < 2; ++n) *(f32x4*)(X1 + off + bj * HALF + n * 16) = xv[mm][bj][n] + gv[bj][n] * bperm4(pidx, acc[ai][bj][m][n]); }
            }
    }
};
struct EpiPlain {
    static constexpr bool PERM = true, AFTER_DRAIN = false, HAS_MID = false;
    bf16_t* O; int ldc;
    __device__ __forceinline__ void operator()(const f32x4 (&acc)[2][2][4][2], const Unit& u, int wr, int wc, int fr, int fq) const {
        PG8_REMAP();
        const int row0 = u.pm * BM + wr * 64 + fr2, col0 = u.pn * BM + wc * 32 + 8 * fq2;
#pragma unroll
        for (int ai = 0; ai < 2; ++ai)
#pragma unroll
            for (int m = 0; m < 4; ++m) { bf16_t* rowp = O + (size_t)(row0 + ai * HALF + m * 16) * ldc + col0;
#pragma unroll
                for (int bj = 0; bj < 2; ++bj) { const f32x4 v0 = acc[ai][bj][m][0], v1 = acc[ai][bj][m][1];
                    u32x4 w; w.x = cvt_pk_bf16(v0[0], v0[1]); w.y = cvt_pk_bf16(v0[2], v0[3]); w.z = cvt_pk_bf16(v1[0], v1[1]); w.w = cvt_pk_bf16(v1[2], v1[3]);
                    *(u32x4*)(rowp + bj * HALF) = bperm4u(pidx, w); } }
    }
};
typedef int v8i_t __attribute__((ext_vector_type(8)));
typedef int v4i_t __attribute__((ext_vector_type(4)));
template <bool F8> __device__ __forceinline__ void mma_block(f32x4 (&acc)[4][2], const bf16x8 (&At)[4][2], const bf16x8 (&Bt)[2][2]) {
    if constexpr (F8) {
        v8i_t bb[2];
#pragma unroll
        for (int n = 0; n < 2; ++n) bb[n] = __builtin_shufflevector(__builtin_bit_cast(v4i_t, Bt[n][0]), __builtin_bit_cast(v4i_t, Bt[n][1]), 0, 1, 2, 3, 4, 5, 6, 7);
#pragma unroll
        for (int m = 0; m < 4; ++m) { const v8i_t aa = __builtin_shufflevector(__builtin_bit_cast(v4i_t, At[m][0]), __builtin_bit_cast(v4i_t, At[m][1]), 0, 1, 2, 3, 4, 5, 6, 7);
#pragma unroll
            for (int n = 0; n < 2; ++n) asm volatile("v_mfma_scale_f32_16x16x128_f8f6f4 %0, %1, %2, %0, %3, %3 op_sel_hi:[0,0,0]" : "+v"(acc[m][n]) : "v"(bb[n]), "v"(aa), "v"(0x7F7F7F7F)); }
    } else {
#pragma unroll
        for (int m = 0; m < 4; ++m)
#pragma unroll
            for (int n = 0; n < 2; ++n)
#pragma unroll
                for (int k = 0; k < 2; ++k) acc[m][n] = __builtin_amdgcn_mfma_f32_16x16x32_bf16(Bt[n][k], At[m][k], acc[m][n], 0, 0, 0);
    }
}
template <class Epi, class Sched, bool ALIGN_EPI = false, bool SP2 = false, bool F8 = false>
__device__ __forceinline__ void gemm_phase(PG8_LAS unsigned char* lds, const Gemm g, const Sched& S, const Epi& E) {
    const int tid = threadIdx.x, wid = __builtin_amdgcn_readfirstlane(tid >> 6), lane = tid & 63, wr = wid >> 2, wc = wid & 3, fr = lane & 15, fq = lane >> 4;
    const int K = g.K, nt = K / BK, LD = g.ld ? g.ld : g.K, nh = g.ksplit ? g.ksplit : nt;
    unsigned voffA[2], voffB[2];
#pragma unroll
    for (int i = 0; i < 2; ++i) { int R, C; stage_rc(tid * 16 + i * 8192, R, C); const int Rb = Epi::PERM ? ((R & ~31) + perm32(R & 31)) : R;
        voffA[i] = (unsigned)(R * LD + C) * 2u; voffB[i] = (unsigned)(Rb * LD + C) * 2u; }
    const size_t kstep = (size_t)(BK * 2);
    const size_t hstep = (size_t)HALF * LD * 2;
    const size_t tstep = 2 * hstep;
    const unsigned ldsw = (unsigned)wid * 1024u;
    const int aoff = lds_byte(wr * 64 + fr, fq * 8), boff = lds_byte(wc * 32 + fr, fq * 8);
#define PG8_SA(b, h) (((b) * 2 + (h)) * HTB)
#define PG8_SB(b, h) ((4 + (b) * 2 + (h)) * HTB)
#define PG8_STAGE(bufoff, gbase, voff) do { _Pragma("unroll") for (int _i = 0; _i < 2; ++_i) \
        __builtin_amdgcn_global_load_lds((const unsigned*)((const char*)(gbase) + (voff)[_i]), (PG8_LAS unsigned*)(lds + (bufoff) + ldsw + _i * 8192), 16, 0, 0); } while (0)
#define PG8_LDA(dst, b, h) do { _Pragma("unroll") for (int m = 0; m < 4; ++m) _Pragma("unroll") for (int k = 0; k < 2; ++k) dst[m][k] = *(const PG8_LAS bf16x8*)(lds + PG8_SA(b, h) + aoff + m * 2048 + k * 1024); } while (0)
#define PG8_LDB(dst, b, h) do { _Pragma("unroll") for (int n = 0; n < 2; ++n) _Pragma("unroll") for (int k = 0; k < 2; ++k) dst[n][k] = *(const PG8_LAS bf16x8*)(lds + PG8_SB(b, h) + boff + n * 2048 + k * 1024); } while (0)
#define PG8_MMA(ai, bj, At, Bt) do { __builtin_amdgcn_s_setprio(1); mma_block<F8>(acc[ai][bj], At, Bt); __builtin_amdgcn_s_setprio(0); } while (0)
#define PG8_WAIT_V(n) asm volatile("s_waitcnt vmcnt(" #n ")" ::: "memory")
#define PG8_WAIT_L(n) asm volatile("s_waitcnt lgkmcnt(" #n ")" ::: "memory")
#define PG8_BAR __builtin_amdgcn_s_barrier()
#define PG8_SCHED __builtin_amdgcn_sched_barrier(0)
    Unit cur, nxt; int ui = 0;
#if MK_GPROBE
    unsigned long long gp_k = 0, gp_e = 0, gp_t = __builtin_amdgcn_s_memrealtime();
#endif
    if (!S.next(0, cur)) return;
    f32x4 acc[2][2][4][2];
#pragma unroll
    for (int a = 0; a < 2; ++a)
#pragma unroll
        for (int b = 0; b < 2; ++b)
#pragma unroll
            for (int m = 0; m < 4; ++m)
#pragma unroll
                for (int n = 0; n < 2; ++n) acc[a][b][m][n] = (f32x4){0.f, 0.f, 0.f, 0.f};
    bf16x8 At[4][2], B0[2][2], B1[2][2];
    const char* cA = (const char*)g.A + (size_t)cur.pm * tstep; const char* cB = (const char*)g.Bt + (size_t)cur.pn * tstep;
    const char* cA2 = g.A2 ? (const char*)g.A2 + (size_t)cur.pm * tstep : cA; const char* cB2 = g.Bt2 ? (const char*)g.Bt2 + (size_t)cur.pn * tstep : cB;
#define PG8_TA(tt) ((tt) < nh ? cA + (size_t)(tt) * kstep : cA2 + (size_t)((tt) - nh) * kstep)
#define PG8_TB(tt) ((tt) < nh ? cB + (size_t)(tt) * kstep : cB2 + (size_t)((tt) - nh) * kstep)
    S.a_ready(cur);
    if constexpr (SP2) {
        PG8_STAGE(PG8_SB(0, 0), cB, voffB); PG8_STAGE(PG8_SB(0, 1), cB + hstep, voffB); PG8_STAGE(PG8_SA(0, 0), cA, voffA); PG8_STAGE(PG8_SA(0, 1), cA + hstep, voffA);
        if (wr == 1) PG8_BAR;
        PG8_WAIT_V(2); PG8_BAR;
        PG8_STAGE(PG8_SB(1, 0), cB + kstep, voffB); PG8_STAGE(PG8_SA(1, 0), cA + kstep, voffA); PG8_STAGE(PG8_SB(1, 1), cB + hstep + kstep, voffB);
        PG8_WAIT_V(6); PG8_BAR;
    } else {
        PG8_STAGE(PG8_SB(0, 0), cB, voffB); PG8_STAGE(PG8_SA(0, 0), cA, voffA); PG8_STAGE(PG8_SB(0, 1), cB + hstep, voffB); PG8_STAGE(PG8_SA(0, 1), cA + hstep, voffA);
        if (wr == 1) PG8_BAR;
        PG8_WAIT_V(4); PG8_BAR;
        PG8_STAGE(PG8_SB(1, 0), cB + kstep, voffB); PG8_STAGE(PG8_SA(1, 0), cA + kstep, voffA); PG8_STAGE(PG8_SB(1, 1), cB + hstep + kstep, voffB);
        PG8_WAIT_V(6); PG8_BAR;
    }
    for (;;) {
        const bool has_next = S.next(ui + 1, nxt);
        const char* nA = has_next ? (const char*)g.A + (size_t)nxt.pm * tstep : cA; const char* nB = has_next ? (const char*)g.Bt + (size_t)nxt.pn * tstep : cB;
#pragma clang loop unroll(disable)
        for (int t = 0; t < nt; t += 2) {
            const bool last = (t == nt - 2);
            const char* a1 = PG8_TA(t + 1);
            const char* a2 = last ? nA : PG8_TA(t + 2); const char* b2 = last ? nB : PG8_TB(t + 2);
            const char* a3 = last ? nA + kstep : PG8_TA(t + 3); const char* b3 = last ? nB + kstep : PG8_TB(t + 3);
            if constexpr (Epi::HAS_MID) { if (t == nh) { if constexpr (F8) asm volatile("s_nop 15\n\ts_nop 15" ::: "memory"); E.mid(acc, cur, wr, wc, fr, fq); } }
            if (last && has_next) S.a_ready(nxt);
            if constexpr (SP2) {
            PG8_LDB(B0, 0, 0); PG8_LDB(B1, 0, 1); PG8_SCHED; PG8_LDA(At, 0, 0); PG8_STAGE(PG8_SA(1, 1), a1 + hstep, voffA);
            PG8_WAIT_V(8); PG8_WAIT_L(0); PG8_BAR; PG8_MMA(0, 0, At, B0); PG8_MMA(0, 1, At, B1); PG8_BAR; PG8_SCHED;
            PG8_LDA(At, 0, 1); PG8_STAGE(PG8_SB(0, 0), b2, voffB); PG8_STAGE(PG8_SB(0, 1), b2 + hstep, voffB); PG8_STAGE(PG8_SA(0, 0), a2, voffA);
            PG8_WAIT_V(8); PG8_WAIT_L(0); PG8_BAR; PG8_MMA(1, 0, At, B0); PG8_MMA(1, 1, At, B1); PG8_BAR; PG8_SCHED;
            PG8_LDB(B0, 1, 0); PG8_LDB(B1, 1, 1); PG8_SCHED; PG8_LDA(At, 1, 0); PG8_STAGE(PG8_SA(0, 1), a2 + hstep, voffA);
            PG8_WAIT_V(8); PG8_WAIT_L(0); PG8_BAR; PG8_MMA(0, 0, At, B0); PG8_MMA(0, 1, At, B1); PG8_BAR; PG8_SCHED;
            PG8_LDA(At, 1, 1); PG8_STAGE(PG8_SB(1, 0), b3, voffB); PG8_STAGE(PG8_SB(1, 1), b3 + hstep, voffB); PG8_STAGE(PG8_SA(1, 0), a3, voffA);
            PG8_WAIT_V(8); PG8_WAIT_L(0); PG8_BAR; PG8_MMA(1, 0, At, B0); PG8_MMA(1, 1, At, B1); PG8_BAR; PG8_SCHED;
            } else {
            PG8_LDB(B0, 0, 0); PG8_SCHED; PG8_LDA(At, 0, 0); PG8_STAGE(PG8_SA(1, 1), a1 + hstep, voffA);
            PG8_WAIT_L(8); PG8_BAR; PG8_WAIT_L(0); PG8_MMA(0, 0, At, B0); PG8_BAR; PG8_SCHED;
            PG8_LDB(B1, 0, 1); PG8_STAGE(PG8_SB(0, 0), b2, voffB);
            PG8_BAR; PG8_WAIT_L(0); PG8_MMA(0, 1, At, B1); PG8_BAR;
            PG8_LDA(At, 0, 1); PG8_STAGE(PG8_SA(0, 0), a2, voffA);
            PG8_BAR; PG8_WAIT_L(0); PG8_MMA(1, 0, At, B0); PG8_BAR; PG8_SCHED;
            PG8_STAGE(PG8_SB(0, 1), b2 + hstep, voffB);
            PG8_WAIT_V(6); PG8_BAR; PG8_MMA(1, 1, At, B1); PG8_BAR;
            PG8_LDB(B0, 1, 0); PG8_SCHED; PG8_LDA(At, 1, 0); PG8_STAGE(PG8_SA(0, 1), a2 + hstep, voffA);
            PG8_WAIT_L(8); PG8_BAR; PG8_WAIT_L(0); PG8_MMA(0, 0, At, B0); PG8_BAR; PG8_SCHED;
            PG8_LDB(B1, 1, 1); PG8_STAGE(PG8_SB(1, 0), b3, voffB);
            PG8_BAR; PG8_WAIT_L(0); PG8_MMA(0, 1, At, B1); PG8_BAR;
            PG8_LDA(At, 1, 1); PG8_STAGE(PG8_SA(1, 0), a3, voffA);
            PG8_BAR; PG8_WAIT_L(0); PG8_MMA(1, 0, At, B0); PG8_BAR; PG8_SCHED;
            PG8_STAGE(PG8_SB(1, 1), b3 + hstep, voffB);
            PG8_WAIT_V(6); PG8_BAR; PG8_MMA(1, 1, At, B1); PG8_BAR;
            }
        }
#if MK_GPROBE
        { const unsigned long long t_ = __builtin_amdgcn_s_memrealtime(); gp_k += t_ - gp_t; gp_t = t_; }
#endif
        if constexpr (F8) asm volatile("s_nop 15\n\ts_nop 15" ::: "memory");
        if constexpr (ALIGN_EPI) { if (wr == 0) PG8_BAR; }
        if constexpr (!Epi::AFTER_DRAIN) { E(acc, cur, wr, wc, fr, fq); S.done(cur); }
#if MK_GPROBE
        { asm volatile("s_waitcnt vmcnt(0)" ::: "memory"); const unsigned long long t_ = __builtin_amdgcn_s_memrealtime(); gp_e += t_ - gp_t; gp_t = t_; }
#endif
        if (!has_next) break;
#pragma unroll
        for (int a = 0; a < 2; ++a)
#pragma unroll
            for (int b = 0; b < 2; ++b)
#pragma unroll
                for (int m = 0; m < 4; ++m)
#pragma unroll
                    for (int n = 0; n < 2; ++n) acc[a][b][m][n] = (f32x4){0.f, 0.f, 0.f, 0.f};
        cur = nxt; cA = nA; cB = nB; ++ui;
        cA2 = g.A2 ? (const char*)g.A2 + (size_t)cur.pm * tstep : cA; cB2 = g.Bt2 ? (const char*)g.Bt2 + (size_t)cur.pn * tstep : cB;
        if constexpr (ALIGN_EPI) { if (wr == 1) PG8_BAR; }
    }
    PG8_WAIT_V(0);
    if constexpr (!ALIGN_EPI) { if (wr == 0) PG8_BAR; }
    PG8_BAR;
    if constexpr (Epi::AFTER_DRAIN) { E.fused(acc, cur, wr, wc, fr, fq, lds, wid, lane); S.done(cur); }
#if MK_GPROBE
    if (blockIdx.x == 0 && wid == 0 && lane == 0) { PG8_LAS unsigned* mq = (PG8_LAS unsigned*)(lds + MK_MISC_OFF); mq[56] += (unsigned)gp_k; mq[57] += (unsigned)gp_e; }
#endif
#undef PG8_SA
#undef PG8_SB
#undef PG8_TA
#undef PG8_TB
#undef PG8_STAGE
#undef PG8_LDA
#undef PG8_LDB
#undef PG8_MMA
#undef PG8_WAIT_V
#undef PG8_WAIT_L
#undef PG8_BAR
#undef PG8_SCHED
}
}

constexpr int NWAVES = 8;
constexpr int N_LAUNCHES = MK_N_LAUNCHES;
constexpr int N_PHASES = 16;
constexpr int NB = 8, SEQ = 4096, DM = 1024, MT = NB * SEQ, NIN = 7168;
constexpr float EPSN = 1e-6f;

constexpr size_t MiB = 1u << 20;
constexpr size_t WS_CTL = 0, CTL_ZERO_BYTES = 1 * MiB;
constexpr size_t WS_SVSTAT = 512 * 1024;
constexpr size_t WS_MOD = 1 * MiB;
constexpr size_t WS_COS = 2 * MiB, WS_SIN = 3 * MiB;
constexpr size_t WS_SK = 4 * MiB;
constexpr size_t WS_SGUW = 4 * MiB + 512 * 1024;
constexpr size_t WS_WRET = 6 * MiB, WS_WSGU = 8 * MiB, WS_WOUT = 10 * MiB, WS_WQ = 12 * MiB, WS_WIN = 16 * MiB;
constexpr size_t WS_UE8 = 32 * MiB, WS_VE8 = 48 * MiB;
constexpr size_t WS_YG8 = 288 * MiB;
constexpr size_t WS_YS8 = 480 * MiB;
constexpr size_t WS_MRG8 = 96 * MiB;
constexpr size_t WS_ACT = 288 * MiB;
constexpr size_t WS_PEERS = 352 * MiB;
constexpr size_t WS_H2F8 = 96 * MiB;
constexpr size_t WS_EID = 128 * MiB, WS_GW = 144 * MiB;
constexpr size_t WS_PD = 160 * MiB;
constexpr size_t WS_V = 96 * MiB;
constexpr size_t WS_G = 160 * MiB;
constexpr size_t WS_U = 224 * MiB;
constexpr size_t WS_SV = 288 * MiB;
constexpr size_t WS_GA = 352 * MiB, WS_GB = 416 * MiB;
constexpr size_t WS_SUB = 480 * MiB;
constexpr size_t WS_END = 512 * MiB;
constexpr size_t DO_H = 0, DO_Q = 64 * MiB, DO_K = 96 * MiB, DO_KVS = 0;

constexpr int CW_BAR = 4096;
constexpr int LDS_BYTES = 147456;
constexpr int MISC_OFF = LDS_BYTES - 256;

#define GAS __attribute__((address_space(1)))
#define LAS __attribute__((address_space(3)))
typedef unsigned short bf16;
typedef unsigned v4u __attribute__((ext_vector_type(4)));
typedef unsigned v2u __attribute__((ext_vector_type(2)));
typedef float f32x4 __attribute__((ext_vector_type(4)));
typedef float f32x2v __attribute__((ext_vector_type(2)));
typedef short bf16x8 __attribute__((ext_vector_type(8)));
typedef short s16x4 __attribute__((ext_vector_type(4)));
typedef __bf16 bf16x2_t __attribute__((ext_vector_type(2)));
typedef GAS unsigned gu32;
#define RLX_AGENT __ATOMIC_RELAXED, __HIP_MEMORY_SCOPE_AGENT
#define LDS_WAIT() asm volatile("s_waitcnt lgkmcnt(0)" ::: "memory")
using pg8::bflo; using pg8::bfhi; using pg8::gelu1;
__device__ __forceinline__ unsigned pk2(float lo, float hi) { f32x2v v = {lo, hi}; bf16x2_t b = __builtin_convertvector(v, bf16x2_t); return __builtin_bit_cast(unsigned, b); }
template <int CTRL> __device__ __forceinline__ float dpp_f(float v) { return __int_as_float(__builtin_amdgcn_update_dpp(0, __float_as_int(v), CTRL, 0xF, 0xF, false)); }
__device__ __forceinline__ float wave_sum(float v) {
    v += dpp_f<0xB1>(v); v += dpp_f<0x4E>(v); v += dpp_f<0x141>(v); v += dpp_f<0x140>(v);
    const int vi = __float_as_int(v);
    return (__int_as_float(__builtin_amdgcn_readlane(vi, 0)) + __int_as_float(__builtin_amdgcn_readlane(vi, 16))) + (__int_as_float(__builtin_amdgcn_readlane(vi, 32)) + __int_as_float(__builtin_amdgcn_readlane(vi, 48)));
}
__device__ __forceinline__ float fexp2(float x) { return __builtin_amdgcn_exp2f(x); }
__device__ __forceinline__ float clamp_f8(float x) { return __builtin_amdgcn_fmed3f(x, -448.0f, 448.0f); }
__device__ __forceinline__ unsigned pk4_fp8(float a, float b, float c, float d) { int w = __builtin_amdgcn_cvt_pk_fp8_f32(clamp_f8(a), clamp_f8(b), 0, false); w = __builtin_amdgcn_cvt_pk_fp8_f32(clamp_f8(c), clamp_f8(d), w, true); return (unsigned)w; }
__device__ __forceinline__ float rl_f(float v, int l) { return __int_as_float(__builtin_amdgcn_readlane(__float_as_int(v), l)); }
__device__ __forceinline__ unsigned rl_u(unsigned v, int l) { return (unsigned)__builtin_amdgcn_readlane((int)v, l); }

#define XB_TMO      128
#define XB_XCNT(j)  (256  + 64 * (j))
#define XB_XSUB(j)  (1280 + 64 * (j))
#define XB_XGEN(j)  (2304 + 64 * (j))
#define XB_TOP      3328
#define XB_TOPGEN   3392
#define XCD_BAR_WORDS 3456
#define XB_SPIN_CAP (1u << 22)
__device__ __forceinline__ unsigned xb_ld(unsigned* p)              { return __hip_atomic_load(p, __ATOMIC_RELAXED, __HIP_MEMORY_SCOPE_AGENT); }
__device__ __forceinline__ unsigned xb_add(unsigned* p, unsigned v) { return __hip_atomic_fetch_add(p, v, __ATOMIC_RELAXED, __HIP_MEMORY_SCOPE_AGENT); }
__device__ __forceinline__ unsigned xb_xcc_id() { return (unsigned)__builtin_amdgcn_s_getreg((3 << 11) | 20) & 0xFu; }
#define XB_SPIN(cond, bar) do { unsigned _sp = 0; while (cond) { __builtin_amdgcn_s_sleep(1); \
    if ((++_sp & 255u) == 0u) { if (xb_ld(&(bar)[XB_TMO])) break; if (_sp > XB_SPIN_CAP) { atomicAdd(&(bar)[XB_TMO], 1u); break; } } } } while (0)
struct XcdBarrier { unsigned* bar; unsigned x; volatile LAS unsigned* st; };
__device__ __forceinline__ XcdBarrier xcd_barrier_post(unsigned* bar, volatile LAS unsigned* st) {
    XcdBarrier b; b.bar = bar; b.x = xb_xcc_id(); b.st = st;
    if (threadIdx.x == 0) (void)xb_add(&bar[XB_XCNT(b.x)], 1u);
    return b;
}
__device__ __forceinline__ void xcd_barrier_complete(unsigned* bar, unsigned x, unsigned& nloc, unsigned& nx) {
    const unsigned G = gridDim.x * gridDim.y * gridDim.z;
    unsigned sum, cnt, mine, sp = 0u;
    for (;;) {
        sum = 0u; cnt = 0u; mine = 0u;
#pragma unroll
        for (unsigned j = 0; j < 16; ++j) { const unsigned c = xb_ld(&bar[XB_XCNT(j)]); sum += c; cnt += (c > 0u) ? 1u : 0u; mine = (j == x) ? c : mine; }
        if (sum == G) break;
        __builtin_amdgcn_s_sleep(1);
        if ((++sp & 255u) == 0u) { if (xb_ld(&bar[XB_TMO])) break; if (sp > XB_SPIN_CAP) { atomicAdd(&bar[XB_TMO], 1u); break; } }
    }
    nloc = mine > 0u ? mine : 1u; nx = cnt > 0u ? cnt : 1u;
}
__device__ __forceinline__ void xcd_barrier(const XcdBarrier& b) {
    asm volatile("s_waitcnt vmcnt(0)" ::: "memory");
    __syncthreads();
    if (threadIdx.x == 0) {
        unsigned* bar = b.bar;
        __builtin_amdgcn_s_waitcnt(0);
        unsigned nloc = b.st[0], nx = b.st[1];
        if (nloc == 0u) { xcd_barrier_complete(bar, b.x, nloc, nx); b.st[0] = nloc; b.st[1] = nx; }
        const unsigned old = xb_add(&bar[XB_XSUB(b.x)], 1u);
        const unsigned gen = old / nloc;
        if (old + 1u == (gen + 1u) * nloc) {
            __builtin_amdgcn_fence(__ATOMIC_RELEASE, "agent");
            asm volatile("s_waitcnt vmcnt(0)" ::: "memory");
            const unsigned og = xb_add(&bar[XB_TOP], 1u);
            const unsigned tg = og / nx;
            if (og + 1u == (tg + 1u) * nx) xb_add(&bar[XB_TOPGEN], 1u);
            else XB_SPIN(xb_ld(&bar[XB_TOPGEN]) == tg, bar);
            __builtin_amdgcn_fence(__ATOMIC_ACQUIRE, "agent");
            xb_add(&bar[XB_XGEN(b.x)], 1u);
            asm volatile("s_waitcnt vmcnt(0)" ::: "memory");
        } else {
            XB_SPIN(xb_ld(&bar[XB_XGEN(b.x)]) == gen, bar);
            __builtin_amdgcn_fence(__ATOMIC_ACQUIRE, "agent");
            asm volatile("s_waitcnt vmcnt(0)" ::: "memory");
        }
    }
    __syncthreads();
}

struct Frame {
    LAS unsigned char* lds;
    int tid, lane, wave, G, bid; volatile LAS unsigned* misc;
    __device__ __forceinline__ void fence_ids() { int t = threadIdx.x; asm volatile("" : "+v"(t)); tid = t; lane = t & 63; }
    const float *x, *c, *w_ada, *b_ada, *norm1_g, *w_in, *ret_gn_g, *sgu_ln_g, *sgu_ln_b, *sgu_w, *sgu_b, *w_ret_out, *w_sgu_out, *w_out, *norm2_g, *peer_w_q, *peer_sub_keys, *peer_u, *peer_v, *final_g;
    unsigned char* ws; unsigned char* dout;
};

__device__ __forceinline__ bf16x8 lds_row_frag(LAS const unsigned char* img, int stride, int r0, int k0, int lane) {
    return *(LAS const bf16x8*)(img + (r0 + (lane & 15)) * stride + (k0 + 8 * (lane >> 4)) * 2);
}
__device__ __forceinline__ s16x4 tr16(LAS const unsigned char* p) { return __builtin_bit_cast(s16x4, __builtin_amdgcn_ds_read_tr16_b64_v4i16((LAS s16x4*)p)); }
__device__ __forceinline__ bf16x8 lds_tr_frag(LAS const unsigned char* img, int stride, int k0, int n0, int lane) {
    const int g = lane >> 4, q = (lane >> 2) & 3, p = lane & 3;
    LAS const unsigned char* a = img + (k0 + 8 * g + q) * stride + (n0 + 4 * p) * 2;
    const s16x4 lo = tr16(a), hi = tr16(a + 4 * stride);
    return __builtin_shufflevector(lo, hi, 0, 1, 2, 3, 4, 5, 6, 7);
}
#define MFMA16(a, b, c) __builtin_amdgcn_mfma_f32_16x16x32_bf16((a), (b), (c), 0, 0, 0)
constexpr int KS = 272, VS = 528;

template <bool F8, class Map>
__device__ __forceinline__ void transpose_item(const float* W, int K, int N, bf16* WT, LAS float* scr, int item, int lane, Map srcmap) {
    const int nblk = N / 32, kb = item / nblk, nb = item % nblk, k0 = 64 * kb, n0 = 32 * nb;
    const int sc = srcmap(n0 + (lane & 31));
#pragma unroll 8
    for (int i = 0; i < 32; ++i) { const int kk = 2 * i + (lane >> 5); scr[kk * 33 + (lane & 31)] = W[(size_t)(k0 + kk) * N + sc]; }
    LDS_WAIT(); asm volatile("" ::: "memory");
    const int c = lane & 7;
#pragma unroll
    for (int j = 0; j < 4; ++j) { const int n = (lane >> 3) + 8 * j; const LAS float* s = scr + (8 * c) * 33 + n;
        if (F8) { v2u o8; o8.x = pk4_fp8(s[0 * 33] * 512.f, s[1 * 33] * 512.f, s[2 * 33] * 512.f, s[3 * 33] * 512.f); o8.y = pk4_fp8(s[4 * 33] * 512.f, s[5 * 33] * 512.f, s[6 * 33] * 512.f, s[7 * 33] * 512.f);
            *(v2u*)((unsigned char*)WT + (size_t)(n0 + n) * K + k0 + 8 * c) = o8; }
        else { v4u o; o.x = pk2(s[0 * 33], s[1 * 33]); o.y = pk2(s[2 * 33], s[3 * 33]); o.z = pk2(s[4 * 33], s[5 * 33]); o.w = pk2(s[6 * 33], s[7 * 33]);
            *(v4u*)(WT + (size_t)(n0 + n) * K + k0 + 8 * c) = o; } }
    LDS_WAIT(); asm volatile("" ::: "memory");
}
struct MapId { __device__ __forceinline__ int operator()(int n) const { return n; } };
struct MapWin { __device__ __forceinline__ int operator()(int n) const { if (n >= 1024) return n; const int ci = n & 127; return (n & ~127) + (ci >> 1) + 64 * (ci & 1); } };

__device__ __forceinline__ void cvt8(const float* src, bf16* dst, size_t chunk) {
    const f32x4 a = *(const f32x4*)(src + chunk * 8), b = *(const f32x4*)(src + chunk * 8 + 4);
    v4u o; o.x = pk2(a[0], a[1]); o.y = pk2(a[2], a[3]); o.z = pk2(b[0], b[1]); o.w = pk2(b[2], b[3]);
    *(v4u*)(dst + chunk * 8) = o;
}

__device__ __forceinline__ void p0a(Frame& F) { F.fence_ids();
    if (F.bid < 192) {
        LAS float* sc = (LAS float*)F.lds; LAS float* part = (LAS float*)(F.lds + 32768);
        for (int i = F.tid; i < 8192; i += 512) { const float cv = F.c[i]; sc[i] = pg8::silu1(cv); }
        __syncthreads();
        const int n0 = 32 * F.bid, ks = F.tid >> 3, c4 = F.tid & 7;
        f32x4 acc[8];
#pragma unroll
        for (int b = 0; b < 8; ++b) acc[b] = (f32x4){0.f, 0.f, 0.f, 0.f};
        for (int kk = ks; kk < 1024; kk += 64) { const f32x4 w = *(const f32x4*)(F.w_ada + (size_t)kk * 6144 + n0 + 4 * c4);
#pragma unroll
            for (int b = 0; b < 8; ++b) acc[b] += w * sc[b * 1024 + kk]; }
#pragma unroll
        for (int b = 0; b < 8; ++b) *(LAS f32x4*)(part + (ks * 8 + b) * 32 + 4 * c4) = acc[b];
        __syncthreads();
        if (F.tid < 256) { const int b = F.tid >> 5, col = F.tid & 31; float s = 0.f;
            for (int k2 = 0; k2 < 64; ++k2) s += part[(k2 * 8 + b) * 32 + col];
            ((float*)(F.ws + WS_MOD))[b * 6144 + n0 + col] = s + F.b_ada[n0 + col]; }
        __syncthreads();
    }
    {
        LAS float* scr = (LAS float*)(F.lds + F.wave * 16384);
        const int gw = F.bid * NWAVES + F.wave, NGW = F.G * NWAVES;
        constexpr int I_IN = 16 * (NIN / 32), I_SQ = 16 * 32, I_Q = 16 * 64, NITEMS = I_IN + 3 * I_SQ + I_Q;
        for (int it = gw; it < NITEMS; it += NGW) {
            int r = it;
            if (r < I_IN) { transpose_item<true>(F.w_in, 1024, NIN, (bf16*)(F.ws + WS_WIN), scr, r, F.lane, MapWin()); continue; } r -= I_IN;
            if (r < I_SQ) { transpose_item<true>(F.w_ret_out, 1024, 1024, (bf16*)(F.ws + WS_WRET), scr, r, F.lane, MapId()); continue; } r -= I_SQ;
            if (r < I_SQ) { transpose_item<true>(F.w_sgu_out, 1024, 1024, (bf16*)(F.ws + WS_WSGU), scr, r, F.lane, MapId()); continue; } r -= I_SQ;
            if (r < I_SQ) { transpose_item<true>(F.w_out, 1024, 1024, (bf16*)(F.ws + WS_WOUT), scr, r, F.lane, MapId()); continue; } r -= I_SQ;
            transpose_item<false>(F.peer_w_q, 1024, 2048, (bf16*)(F.ws + WS_WQ), scr, r, F.lane, MapId());
        }
    }
    const size_t gt = (size_t)F.bid * 512 + F.tid, NT = (size_t)F.G * 512;
    for (size_t ch = gt; ch < (size_t)16384 * 64; ch += NT) {
        const f32x4* up = (const f32x4*)(F.peer_u + ch * 16); const f32x4* vp = (const f32x4*)(F.peer_v + ch * 16);
        v4u ou, ov;
#pragma unroll
        for (int q = 0; q < 4; ++q) { const f32x4 a = up[q] * 512.0f, b = vp[q] * 16.0f; ou[q] = pk4_fp8(a[0], a[1], a[2], a[3]); ov[q] = pk4_fp8(b[0], b[1], b[2], b[3]); }
        const size_t e_ = ch >> 6, c16_ = ch & 63, dst_ = (c16_ >> 3) * ((size_t)16384 * 128) + e_ * 128 + (c16_ & 7) * 16;
        *(v4u*)(F.ws + WS_VE8 + dst_) = ov;
        if (MK_U4) {
            v2u o4; unsigned w0 = 0u, w1 = 0u;
            { const f32x4 a0 = up[0] * 64.0f, a1 = up[1] * 64.0f, a2 = up[2] * 64.0f, a3 = up[3] * 64.0f;
              w0 = __builtin_amdgcn_cvt_scalef32_pk_fp4_f32(w0, a0[0], a0[1], 1.0f, 0); w0 = __builtin_amdgcn_cvt_scalef32_pk_fp4_f32(w0, a0[2], a0[3], 1.0f, 1);
              w0 = __builtin_amdgcn_cvt_scalef32_pk_fp4_f32(w0, a1[0], a1[1], 1.0f, 2); w0 = __builtin_amdgcn_cvt_scalef32_pk_fp4_f32(w0, a1[2], a1[3], 1.0f, 3);
              w1 = __builtin_amdgcn_cvt_scalef32_pk_fp4_f32(w1, a2[0], a2[1], 1.0f, 0); w1 = __builtin_amdgcn_cvt_scalef32_pk_fp4_f32(w1, a2[2], a2[3], 1.0f, 1);
              w1 = __builtin_amdgcn_cvt_scalef32_pk_fp4_f32(w1, a3[0], a3[1], 1.0f, 2); w1 = __builtin_amdgcn_cvt_scalef32_pk_fp4_f32(w1, a3[2], a3[3], 1.0f, 3); }
            o4.x = w0; o4.y = w1;
            *(v2u*)(F.ws + WS_UE8 + (c16_ >> 4) * ((size_t)16384 * 128) + e_ * 128 + (c16_ & 15) * 8) = o4;
        } else *(v4u*)(F.ws + WS_UE8 + dst_) = ou; }
    for (size_t ch = gt; ch < (size_t)32768; ch += NT) cvt8(F.peer_sub_keys, (bf16*)(F.ws + WS_SK), ch);
    for (size_t ch = gt; ch < (size_t)8192; ch += NT) { const int t = (int)(ch >> 4) & 127, s0 = (int)(ch & 15) * 8;
        const f32x4 a = *(const f32x4*)(F.sgu_w + ch * 8), b = *(const f32x4*)(F.sgu_w + ch * 8 + 4);
        float v[8] = {a[0], a[1], a[2], a[3], b[0], b[1], b[2], b[3]};
#pragma unroll
        for (int e = 0; e < 8; ++e) v[e] = (s0 + e <= t) ? v[e] : 0.f;
        v4u o; o.x = pk2(v[0], v[1]); o.y = pk2(v[2], v[3]); o.z = pk2(v[4], v[5]); o.w = pk2(v[6], v[7]);
        *(v4u*)((bf16*)(F.ws + WS_SGUW) + ch * 8) = o; }
    for (size_t e = gt; e < (size_t)4096 * 64; e += NT) { const int s = (int)(e >> 6), i = (int)(e & 63);
        const float inv = fexp2(-(float)i * (13.287712379549449f / 64.0f));
        const float rev = ((float)s * inv) * 0.15915494309189535f; const float fr = rev - __builtin_floorf(rev);
        ((float*)(F.ws + WS_COS))[e] = __builtin_amdgcn_cosf(fr); ((float*)(F.ws + WS_SIN))[e] = __builtin_amdgcn_sinf(fr); }
}

template <int MODE  > __device__ __forceinline__ void norm_rows(Frame& F, const float* X, const float* gain, const float* shift, const float* scale, bf16* O, unsigned char* O8) { F.fence_ids();
    const int gw = F.bid * NWAVES + F.wave, NGW = F.G * NWAVES;
    f32x4 g[4];
#pragma unroll
    for (int j = 0; j < 4; ++j) g[j] = *(const f32x4*)(gain + 4 * F.lane + 256 * j);
    f32x4 nx[4];
    if (gw < MT) {
#pragma unroll
        for (int j = 0; j < 4; ++j) nx[j] = *((const f32x4*)(X + (size_t)gw * DM) + F.lane + 64 * j); }
    for (int m = gw; m < MT; m += NGW) {
        f32x4 v[4]; float s = 0.f;
#pragma unroll
        for (int j = 0; j < 4; ++j) { v[j] = nx[j]; s += (v[j][0] * v[j][0] + v[j][1] * v[j][1]) + (v[j][2] * v[j][2] + v[j][3] * v[j][3]); }
        const int b = m >> 12;
        f32x4 sh[4], sc[4];
#pragma unroll
        for (int j = 0; j < 4; ++j) { const int d = 4 * F.lane + 256 * j; sh[j] = *(const f32x4*)(shift + b * 6144 + d); sc[j] = *(const f32x4*)(scale + b * 6144 + d); }
        if (m + NGW < MT) {
#pragma unroll
            for (int j = 0; j < 4; ++j) nx[j] = *((const f32x4*)(X + (size_t)(m + NGW) * DM) + F.lane + 64 * j); }
        const float rstd = __builtin_amdgcn_rsqf(wave_sum(s) * (1.f / DM) + EPSN);
        v2u* o8 = (v2u*)(O + (size_t)m * DM) + F.lane;
#pragma unroll
        for (int j = 0; j < 4; ++j) { const int d = 4 * F.lane + 256 * j;
            const f32x4 h = v[j] * rstd * g[j] * (sc[j] + 1.0f) + sh[j];
            if (MODE == 2) { const f32x4 h8 = h * 8.0f; *(unsigned*)(O8 + (size_t)m * DM + d) = pk4_fp8(h8[0], h8[1], h8[2], h8[3]); }
            else { v2u w; w.x = pk2(h[0], h[1]); w.y = pk2(h[2], h[3]); o8[64 * j] = w; }
            if (MODE == 1) { const f32x4 hs = h * 16.0f; *(unsigned*)(O8 + (size_t)(d >> 8) * ((size_t)MT * 256) + (size_t)m * 256 + (d & 255)) = pk4_fp8(hs[0], hs[1], hs[2], hs[3]); } }
    }
}

__device__ __forceinline__ float lg_gamma(int h) { return __builtin_log2f(1.0f - fexp2((float)(-5 - h))); }
__device__ __forceinline__ v4u scale8(v4u w, float s) {
    v4u o; o.x = pk2(bflo(w.x) * s, bfhi(w.x) * s); o.y = pk2(bflo(w.y) * s, bfhi(w.y) * s); o.z = pk2(bflo(w.z) * s, bfhi(w.z) * s); o.w = pk2(bflo(w.w) * s, bfhi(w.w) * s); return o;
}
struct KvRegs { v4u k[4], v[8]; };
__device__ __forceinline__ void kv_load(Frame& F, int u, KvRegs& R) {
    const int b = u >> 7, h = (u >> 5) & 3, c = u & 31; const size_t tok0 = (size_t)b * SEQ + c * 128;
    const bf16* Kb = (const bf16*)(F.dout + DO_K); const bf16* Vb = (const bf16*)(F.ws + WS_V);
#pragma unroll
    for (int i = 0; i < 4; ++i) { const int ch = F.tid + 512 * i, j = ch >> 4, cc = ch & 15; R.k[i] = *(const v4u*)(Kb + (tok0 + j) * 512 + h * 128 + cc * 8); }
#pragma unroll
    for (int i = 0; i < 8; ++i) { const int ch = F.tid + 512 * i, j = ch >> 5, cc = ch & 31; R.v[i] = *(const v4u*)(Vb + (tok0 + j) * 1024 + h * 256 + cc * 8); }
}
__device__ __forceinline__ void kv_unit(Frame& F, int u, KvRegs& R, int unext) {
    const int b = u >> 7, h = (u >> 5) & 3, c = u & 31;
    LAS unsigned char* Kimg = F.lds; LAS unsigned char* Vimg = F.lds + 34816;
    const float lg = lg_gamma(h);
#pragma unroll
    for (int i = 0; i < 4; ++i) { const int ch = F.tid + 512 * i, j = ch >> 4, cc = ch & 15;
        *(LAS v4u*)(Kimg + j * KS + cc * 16) = scale8(R.k[i], fexp2((float)(127 - j) * lg)); }
#pragma unroll
    for (int i = 0; i < 8; ++i) { const int ch = F.tid + 512 * i, j = ch >> 5, cc = ch & 31; *(LAS v4u*)(Vimg + j * VS + cc * 16) = R.v[i]; }
    __syncthreads();
    if (unext >= 0) kv_load(F, unext, R);
    f32x4 acc[8][2];
#pragma unroll
    for (int dt = 0; dt < 8; ++dt) { acc[dt][0] = (f32x4){0.f, 0.f, 0.f, 0.f}; acc[dt][1] = (f32x4){0.f, 0.f, 0.f, 0.f}; }
#pragma unroll
    for (int js = 0; js < 4; ++js) {
        bf16x8 bv[2];
#pragma unroll
        for (int vt = 0; vt < 2; ++vt) bv[vt] = lds_tr_frag(Vimg, VS, 32 * js, 32 * F.wave + 16 * vt, F.lane);
#pragma unroll
        for (int dt = 0; dt < 8; ++dt) { const bf16x8 a = lds_tr_frag(Kimg, KS, 32 * js, 16 * dt, F.lane);
            acc[dt][0] = MFMA16(a, bv[0], acc[dt][0]); acc[dt][1] = MFMA16(a, bv[1], acc[dt][1]); }
    }
    bf16* dst = (bf16*)(F.dout + DO_KVS) + (size_t)(((b * 4 + h) * 32 + c)) * 32768;
#pragma unroll
    for (int dt = 0; dt < 8; ++dt)
#pragma unroll
        for (int vt = 0; vt < 2; ++vt) { const int v = 32 * F.wave + 16 * vt + (F.lane & 15), d0 = 16 * dt + 4 * (F.lane >> 4);
            v2u o; o.x = pk2(acc[dt][vt][0], acc[dt][vt][1]); o.y = pk2(acc[dt][vt][2], acc[dt][vt][3]);
            *(v2u*)(dst + v * 128 + d0) = o; }
    __syncthreads();
}
struct SguRegs { v2u sv[8]; f32x2v st[8]; };
__device__ __forceinline__ void sgu_load(Frame& F, int su, SguRegs& R) {
    const size_t tok0 = (size_t)(su >> 2) * 128; const int g = su & 3; const unsigned char* SVb = F.ws + WS_SV; const float* stat = (const float*)(F.ws + WS_SVSTAT);
    int tq = F.tid; asm volatile("" : "+v"(tq));
#pragma unroll
    for (int i = 0; i < 8; ++i) { const int ch = tq + 512 * i, sr = ch >> 5, cc = ch & 31;
        R.sv[i] = *(const v2u*)(SVb + (tok0 + sr) * 1024 + g * 256 + cc * 8); R.st[i] = *(const f32x2v*)(stat + (tok0 + sr) * 2); }
}
__device__ __forceinline__ void sgu_unit(Frame& F, int su, SguRegs& R, int snext, int& cur_g) {
    const size_t tok0 = (size_t)(su >> 2) * 128; const int g = su & 3;
    LAS unsigned char* Vn = F.lds; LAS unsigned char* Wimg = F.lds + 67584;
    const unsigned char* Ub = F.ws + WS_U; const bf16* Wm = (const bf16*)(F.ws + WS_SGUW);
    { const int cc = F.tid & 31; const int col = g * 256 + cc * 8;
        const f32x4 g0 = *(const f32x4*)(F.sgu_ln_g + col), g1 = *(const f32x4*)(F.sgu_ln_g + col + 4), b0 = *(const f32x4*)(F.sgu_ln_b + col), b1 = *(const f32x4*)(F.sgu_ln_b + col + 4);
#pragma unroll
        for (int i = 0; i < 8; ++i) { const int ch = F.tid + 512 * i, sr = ch >> 5; const f32x4 w0 = pg8::f8x4(R.sv[i].x) * 0.0625f, w1 = pg8::f8x4(R.sv[i].y) * 0.0625f;
            const float mean = R.st[i].x * (1.f / 1024.f), var = R.st[i].y * (1.f / 1024.f) - mean * mean, rstd = __builtin_amdgcn_rsqf(var + EPSN);
            v4u o;
            o.x = pk2((w0[0] - mean) * rstd * g0[0] + b0[0], (w0[1] - mean) * rstd * g0[1] + b0[1]);
            o.y = pk2((w0[2] - mean) * rstd * g0[2] + b0[2], (w0[3] - mean) * rstd * g0[3] + b0[3]);
            o.z = pk2((w1[0] - mean) * rstd * g1[0] + b1[0], (w1[1] - mean) * rstd * g1[1] + b1[1]);
            o.w = pk2((w1[2] - mean) * rstd * g1[2] + b1[2], (w1[3] - mean) * rstd * g1[3] + b1[3]);
            *(LAS v4u*)(Vn + sr * VS + cc * 16) = o; } }
    if (g != cur_g) { cur_g = g;
#pragma unroll
        for (int i = 0; i < 4; ++i) { const int ch = F.tid + 512 * i, t = ch >> 4, cc = ch & 15;
            *(LAS v4u*)(Wimg + t * KS + cc * 16) = *(const v4u*)(Wm + (size_t)(g * 128 + t) * 128 + cc * 8); } }
    __syncthreads();
    if (snext >= 0) sgu_load(F, snext, R);
    unsigned uv[8][2];
#pragma unroll
    for (int tt = 0; tt < 8; ++tt)
#pragma unroll
        for (int ct = 0; ct < 2; ++ct) uv[tt][ct] = *(const unsigned*)(Ub + (tok0 + 16 * tt + (F.lane & 15)) * 1024 + g * 256 + 32 * F.wave + 16 * ct + 4 * (F.lane >> 4));
    f32x4 acc[2][8];
#pragma unroll
    for (int ct = 0; ct < 2; ++ct)
#pragma unroll
        for (int tt = 0; tt < 8; ++tt) acc[ct][tt] = (f32x4){0.f, 0.f, 0.f, 0.f};
#pragma unroll
    for (int ss = 0; ss < 4; ++ss) {
        bf16x8 av[2];
#pragma unroll
        for (int ct = 0; ct < 2; ++ct) av[ct] = lds_tr_frag(Vn, VS, 32 * ss, 32 * F.wave + 16 * ct, F.lane);
#pragma unroll
        for (int tt = 0; tt < 8; ++tt) if (tt >= 2 * ss) { const bf16x8 bw = lds_row_frag(Wimg, KS, 16 * tt, 32 * ss, F.lane);
            acc[0][tt] = MFMA16(av[0], bw, acc[0][tt]); acc[1][tt] = MFMA16(av[1], bw, acc[1][tt]); }
    }
#pragma unroll
    for (int tt = 0; tt < 8; ++tt) { const int t = 16 * tt + (F.lane & 15); const float bs = F.sgu_b[g * 128 + t];
#pragma unroll
        for (int ct = 0; ct < 2; ++ct) { const int cg = g * 256 + 32 * F.wave + 16 * ct + 4 * (F.lane >> 4); const f32x4 u4 = pg8::f8x4(uv[tt][ct]) * 0.5f;
            *(unsigned*)(F.ws + WS_YS8 + (tok0 + t) * 1024 + cg) = pk4_fp8(u4[0] * (acc[ct][tt][0] + bs), u4[1] * (acc[ct][tt][1] + bs), u4[2] * (acc[ct][tt][2] + bs), u4[3] * (acc[ct][tt][3] + bs)); } }
    __syncthreads();
}
__device__ __forceinline__ void p2a(Frame& F) { F.fence_ids();
    { KvRegs R; if (F.bid < 1024) kv_load(F, F.bid, R);
      for (int u = F.bid; u < 1024; u += F.G) kv_unit(F, u, R, (u + F.G < 1024) ? u + F.G : -1); }
#if MK_PROBE_HI > 0
    if (F.bid == 0 && threadIdx.x == 0) { const unsigned long long _t = __builtin_amdgcn_s_memrealtime(); F.misc[16 + 2 * 20] = (unsigned)_t; F.misc[17 + 2 * 20] = (unsigned)(_t >> 32); }
#endif
    { SguRegs R; int cur_g = -1; if (F.bid < 1024) sgu_load(F, F.bid, R);
      for (int su = F.bid; su < 1024; su += F.G) sgu_unit(F, su, R, (su + F.G < 1024) ? su + F.G : -1, cur_g); }
}
__device__ __forceinline__ void p2b(Frame& F) { F.fence_ids();
    bf16* KVS = (bf16*)(F.dout + DO_KVS);
    for (int item = F.bid * 512 + F.tid; item < 32 * 4096; item += F.G * 512) {
        const int bh = item >> 12, rem = item & 4095, h = bh & 3;
        const float dc = fexp2(128.0f * lg_gamma(h));
        float s[8];
#pragma unroll
        for (int e = 0; e < 8; ++e) s[e] = 0.f;
        bf16* p = KVS + (size_t)bh * 32 * 32768 + (size_t)rem * 8;
        for (int c0 = 0; c0 < 32; c0 += 8) {
            v4u kv[8];
#pragma unroll
            for (int i = 0; i < 8; ++i) kv[i] = *(const v4u*)(p + (size_t)(c0 + i) * 32768);
#pragma unroll
            for (int i = 0; i < 8; ++i) {
                v4u o; o.x = pk2(s[0], s[1]); o.y = pk2(s[2], s[3]); o.z = pk2(s[4], s[5]); o.w = pk2(s[6], s[7]);
                *(v4u*)(p + (size_t)(c0 + i) * 32768) = o;
                s[0] = s[0] * dc + bflo(kv[i].x); s[1] = s[1] * dc + bfhi(kv[i].x); s[2] = s[2] * dc + bflo(kv[i].y); s[3] = s[3] * dc + bfhi(kv[i].y);
                s[4] = s[4] * dc + bflo(kv[i].z); s[5] = s[5] * dc + bfhi(kv[i].z); s[6] = s[6] * dc + bflo(kv[i].w); s[7] = s[7] * dc + bfhi(kv[i].w);
            }
        }
    }
}
struct RetRegs { v4u q[4], k[4], v[8]; };
__device__ __forceinline__ void ret_load(Frame& F, int u, RetRegs& R) {
    const int b = u >> 7, h = (u >> 5) & 3, c = u & 31; const size_t tok0 = (size_t)b * SEQ + c * 128;
    const bf16* Qb = (const bf16*)(F.dout + DO_Q); const bf16* Kb = (const bf16*)(F.dout + DO_K); const bf16* Vb = (const bf16*)(F.ws + WS_V);
#pragma unroll
    for (int i = 0; i < 4; ++i) { const int ch = F.tid + 512 * i, j = ch >> 4, cc = ch & 15;
        R.q[i] = *(const v4u*)(Qb + (tok0 + j) * 512 + h * 128 + cc * 8); R.k[i] = *(const v4u*)(Kb + (tok0 + j) * 512 + h * 128 + cc * 8); }
#pragma unroll
    for (int i = 0; i < 8; ++i) { const int ch = F.tid + 512 * i, j = ch >> 5, cc = ch & 31; R.v[i] = *(const v4u*)(Vb + (tok0 + j) * 1024 + h * 256 + cc * 8); }
}
__device__ __forceinline__ void ret_unit(Frame& F, int u, RetRegs& R, int unext) {
    const int b = u >> 7, h = (u >> 5) & 3, c = u & 31;
    const size_t tok0 = (size_t)b * SEQ + c * 128;
    LAS unsigned char* Qimg = F.lds; LAS unsigned char* Kimg = F.lds + 34816; LAS unsigned char* Vimg = F.lds + 69632;
    LAS unsigned char* Sout = F.lds;
    const unsigned char* Gb = F.ws + WS_G;
    const bf16* ST = (const bf16*)(F.dout + DO_KVS) + (size_t)(((b * 4 + h) * 32 + c)) * 32768;
    const float lg = lg_gamma(h);
    const int lane = F.lane, w = F.wave, l15 = lane & 15, g4 = lane >> 4;
#pragma unroll
    for (int i = 0; i < 4; ++i) { const int ch = F.tid + 512 * i, j = ch >> 4, cc = ch & 15;
        *(LAS v4u*)(Qimg + j * KS + cc * 16) = R.q[i]; *(LAS v4u*)(Kimg + j * KS + cc * 16) = R.k[i]; }
#pragma unroll
    for (int i = 0; i < 8; ++i) { const int ch = F.tid + 512 * i, j = ch >> 5, cc = ch & 31; *(LAS v4u*)(Vimg + j * VS + cc * 16) = R.v[i]; }
    bf16x8 bs[4][2];
#pragma unroll
    for (int ds = 0; ds < 4; ++ds)
#pragma unroll
        for (int vt = 0; vt < 2; ++vt) bs[ds][vt] = *(const bf16x8*)(ST + (size_t)(32 * w + 16 * vt + l15) * 128 + 32 * ds + 8 * g4);
    __syncthreads();
    f32x4 st[8];
#pragma unroll
    for (int jt = 0; jt < 8; ++jt) st[jt] = (f32x4){0.f, 0.f, 0.f, 0.f};
#pragma unroll
    for (int ds = 0; ds < 4; ++ds) { const bf16x8 bq = lds_row_frag(Qimg, KS, 16 * w, 32 * ds, lane);
#pragma unroll
        for (int jt = 0; jt < 8; ++jt) if (jt <= w) { const bf16x8 ak = lds_row_frag(Kimg, KS, 16 * jt, 32 * ds, lane); st[jt] = MFMA16(ak, bq, st[jt]); } }
    __syncthreads();
    { const int i = 16 * w + l15;
#pragma unroll
        for (int jt = 0; jt < 8; ++jt) { float o[4];
#pragma unroll
            for (int ii = 0; ii < 4; ++ii) { const int j = 16 * jt + 4 * g4 + ii; o[ii] = (i >= j) ? st[jt][ii] * fexp2((float)(i - j) * lg) : 0.f; }
            v2u pk; pk.x = pk2(o[0], o[1]); pk.y = pk2(o[2], o[3]);
            *(LAS v2u*)(Kimg + i * KS + (16 * jt + 4 * g4) * 2) = pk; } }
    __syncthreads();
    f32x4 acc[8][2];
#pragma unroll
    for (int it = 0; it < 8; ++it) { acc[it][0] = (f32x4){0.f, 0.f, 0.f, 0.f}; acc[it][1] = (f32x4){0.f, 0.f, 0.f, 0.f}; }
#pragma unroll
    for (int ds = 0; ds < 4; ++ds) {
#pragma unroll
        for (int it = 0; it < 8; ++it) { const bf16x8 a = lds_row_frag(Qimg, KS, 16 * it, 32 * ds, lane);
            acc[it][0] = MFMA16(a, bs[ds][0], acc[it][0]); acc[it][1] = MFMA16(a, bs[ds][1], acc[it][1]); } }
#pragma unroll
    for (int it = 0; it < 8; ++it)
#pragma unroll
        for (int ii = 0; ii < 4; ++ii) { const float dq = fexp2((float)(16 * it + 4 * g4 + ii + 1) * lg); acc[it][0][ii] *= dq; acc[it][1][ii] *= dq; }
#pragma unroll
    for (int js = 0; js < 4; ++js) { bf16x8 bv[2];
#pragma unroll
        for (int vt = 0; vt < 2; ++vt) bv[vt] = lds_tr_frag(Vimg, VS, 32 * js, 32 * w + 16 * vt, lane);
#pragma unroll
        for (int it = 0; it < 8; ++it) if (it >= 2 * js) { const bf16x8 a = lds_row_frag(Kimg, KS, 16 * it, 32 * js, lane);
            acc[it][0] = MFMA16(a, bv[0], acc[it][0]); acc[it][1] = MFMA16(a, bv[1], acc[it][1]); } }
    int lane_h = lane; asm volatile("" : "+v"(lane_h));
    unsigned gt[16];
#pragma unroll
    for (int rr = 0; rr < 16; ++rr) gt[rr] = *(const unsigned*)(Gb + (tok0 + 16 * w + rr) * 1024 + h * 256 + 4 * lane_h);
    const f32x4 gn = *(const f32x4*)(F.ret_gn_g + h * 256 + 4 * lane_h);
    __syncthreads();
#pragma unroll
    for (int it = 0; it < 8; ++it)
#pragma unroll
        for (int vt = 0; vt < 2; ++vt)
#pragma unroll
            for (int ii = 0; ii < 4; ++ii) *(LAS float*)(Sout + (16 * it + 4 * g4 + ii) * 1040 + (32 * w + 16 * vt + l15) * 4) = acc[it][vt][ii];
    __syncthreads();
#pragma unroll
    for (int rr = 0; rr < 16; ++rr) { const int i = 16 * w + rr;
        const f32x4 y = *(LAS const f32x4*)(Sout + i * 1040 + lane_h * 16);
        const float mean = wave_sum((y[0] + y[1]) + (y[2] + y[3])) * (1.f / 256.f);
        const f32x4 d = y - mean;
        const float var = wave_sum((d[0] * d[0] + d[1] * d[1]) + (d[2] * d[2] + d[3] * d[3])) * (1.f / 256.f);
        const float r8 = __builtin_amdgcn_rsqf(var + EPSN) * (4.0f / 16.0f);
        const size_t off = (tok0 + i) * 1024 + h * 256 + 4 * lane_h; const f32x4 gq = pg8::f8x4(gt[rr]);
        *(unsigned*)(F.ws + WS_YG8 + off) = pk4_fp8(d[0] * r8 * gn[0] * gq[0], d[1] * r8 * gn[1] * gq[1], d[2] * r8 * gn[2] * gq[2], d[3] * r8 * gn[3] * gq[3]); }
    __syncthreads();
}
__device__ __forceinline__ void p2c(Frame& F) { F.fence_ids(); for (int u = F.bid; u < 1024; u += F.G) { RetRegs R; ret_load(F, u, R); ret_unit(F, u, R, -1); } }

__device__ __forceinline__ float dppx(float v, int) { return v; }
template <int CTRL> __device__ __forceinline__ void merge16(float (&L)[16]) {
    float c[16];
#pragma unroll
    for (int i = 0; i < 16; ++i) c[i] = __builtin_fmaxf(L[i], dpp_f<CTRL>(L[15 - i]));
#pragma unroll
    for (int half = 8; half >= 1; half >>= 1)
#pragma unroll
        for (int i = 0; i < 16; ++i) if ((i & half) == 0) { const float hi = __builtin_fmaxf(c[i], c[i + half]), lo = __builtin_fminf(c[i], c[i + half]); c[i] = hi; c[i + half] = lo; }
#pragma unroll
    for (int i = 0; i < 16; ++i) L[i] = c[i];
}
__device__ __forceinline__ void sort16_desc(float (&v)[16]) {
#pragma unroll
    for (int k = 2; k <= 16; k <<= 1)
#pragma unroll
        for (int j = k >> 1; j >= 1; j >>= 1)
#pragma unroll
            for (int i = 0; i < 16; ++i) { const int l = i ^ j; if (l > i) { const bool desc = ((i & k) == 0) || (k == 16);
                const float hi = __builtin_fmaxf(v[i], v[l]), lo = __builtin_fminf(v[i], v[l]); v[i] = desc ? hi : lo; v[l] = desc ? lo : hi; } }
}
__device__ __forceinline__ void merge_top16(float (&A)[16], const float (&B)[16]) {
#pragma unroll
    for (int i = 0; i < 16; ++i) A[i] = __builtin_fmaxf(A[i], B[15 - i]);
#pragma unroll
    for (int half = 8; half >= 1; half >>= 1)
#pragma unroll
        for (int i = 0; i < 16; ++i) if ((i & half) == 0) { const float hi = __builtin_fmaxf(A[i], A[i + half]), lo = __builtin_fminf(A[i], A[i + half]); A[i] = hi; A[i + half] = lo; }
}
__device__ __forceinline__ void p5b(Frame& F) {
    F.fence_ids();
    LAS unsigned char* Aimg = F.lds; LAS unsigned char* Bimg = F.lds + 34816; LAS float* Sc = (LAS float*)(F.lds + 69632);
    const bf16* QP = (const bf16*)(F.ws + WS_GA);
    const int lane = F.lane, w = F.wave;
    int cur_hp = -1;
    v4u pa[4];
    if (F.bid < 4096) { const int tt = F.bid >> 4, hp = F.bid & 15;
#pragma unroll
        for (int i = 0; i < 4; ++i) { const int ch = F.tid + 512 * i, r = ch >> 4, cc = ch & 15; pa[i] = *(const v4u*)(QP + ((size_t)tt * 128 + r) * 2048 + hp * 128 + cc * 8); } }
    for (int u = F.bid; u < 4096; u += F.G) {
        const int tt = u >> 4, hp = u & 15; const size_t tok0 = (size_t)tt * 128;
#pragma unroll
        for (int i = 0; i < 4; ++i) { const int ch = F.tid + 512 * i, r = ch >> 4, cc = ch & 15; *(LAS v4u*)(Aimg + r * KS + cc * 16) = pa[i]; }
        if (hp != cur_hp) { const bf16* SK = (const bf16*)(F.ws + WS_SK) + (size_t)hp * 16384; cur_hp = hp;
#pragma unroll
            for (int i = 0; i < 4; ++i) { const int ch = F.tid + 512 * i, r = ch >> 4, cc = ch & 15; *(LAS v4u*)(Bimg + r * KS + cc * 16) = *(const v4u*)(SK + (size_t)r * 128 + cc * 8); } }
        __syncthreads();
        { const int un = u + F.G; if (un < 4096) { const int tn = un >> 4, hn = un & 15;
#pragma unroll
            for (int i = 0; i < 4; ++i) { const int ch = F.tid + 512 * i, r = ch >> 4, cc = ch & 15; pa[i] = *(const v4u*)(QP + ((size_t)tn * 128 + r) * 2048 + hn * 128 + cc * 8); } } }
        f32x4 acc[8];
#pragma unroll
        for (int nt = 0; nt < 8; ++nt) acc[nt] = (f32x4){0.f, 0.f, 0.f, 0.f};
#pragma unroll
        for (int ks = 0; ks < 4; ++ks) { const bf16x8 a = lds_row_frag(Aimg, KS, 16 * w, 32 * ks, lane);
#pragma unroll
            for (int nt = 0; nt < 8; ++nt) { const bf16x8 bb = lds_row_frag(Bimg, KS, 16 * nt, 32 * ks, lane); acc[nt] = MFMA16(a, bb, acc[nt]); } }
#pragma unroll
        for (int nt = 0; nt < 8; ++nt)
#pragma unroll
            for (int ii = 0; ii < 4; ++ii) Sc[(16 * w + 4 * (lane >> 4) + ii) * 132 + 16 * nt + (lane & 15)] = acc[nt][ii];
        __syncthreads();
        { const int row = F.tid >> 2, q = F.tid & 3;
            float L[16], L2[16];
#pragma unroll
            for (int i = 0; i < 16; ++i) { const int n = 4 * i + q, n2 = 4 * (i + 16) + q;
                L[i] = __uint_as_float((__float_as_uint(Sc[row * 132 + n]) & 0xFFFFFF80u) | (unsigned)n);
                L2[i] = __uint_as_float((__float_as_uint(Sc[row * 132 + n2]) & 0xFFFFFF80u) | (unsigned)n2); }
            sort16_desc(L); sort16_desc(L2); merge_top16(L, L2);
            merge16<0xB1>(L); merge16<0x4E>(L);
            if (q == 0) { v4u* dst = (v4u*)((unsigned*)(F.ws + WS_SUB) + ((tok0 + row) * 16 + hp) * 16);
#pragma unroll
                for (int i = 0; i < 4; ++i) dst[i] = (v4u){__float_as_uint(L[4 * i]), __float_as_uint(L[4 * i + 1]), __float_as_uint(L[4 * i + 2]), __float_as_uint(L[4 * i + 3])}; } }
        __syncthreads();
    }
}

template <int CTRL> __device__ __forceinline__ float dpp_max(float v) { return __builtin_fmaxf(v, dpp_f<CTRL>(v)); }
template <int CTRL> __device__ __forceinline__ float dpp_add(float v) { return v + dpp_f<CTRL>(v); }
__device__ __forceinline__ float row_allmax(float v) { v = dpp_max<0x128>(v); v = dpp_max<0x124>(v); v = dpp_max<0x122>(v); v = dpp_max<0x121>(v); return v; }
__device__ __forceinline__ float row_allsum(float v) { v = dpp_add<0x128>(v); v = dpp_add<0x124>(v); v = dpp_add<0x122>(v); v = dpp_add<0x121>(v); return v; }
__device__ __forceinline__ void p6a(Frame& F) { F.fence_ids();
    const int lane = F.lane, row = lane >> 4, i = lane & 15, rowbase = lane & 48;
    LAS unsigned* Sel = (LAS unsigned*)(F.lds + F.wave * 1024);
    const unsigned* SUB = (const unsigned*)(F.ws + WS_SUB);
    unsigned* EID = (unsigned*)(F.ws + WS_EID); float* GWp = (float*)(F.ws + WS_GW);
    const int gw = F.bid * NWAVES + F.wave, NGW = F.G * NWAVES;
    unsigned nab[2], nbb[2];
    if (gw < MT) {
#pragma unroll
        for (int r = 0; r < 2; ++r) { const int h = 4 * r + row; nab[r] = SUB[((size_t)gw * 16 + 2 * h) * 16 + i]; nbb[r] = SUB[((size_t)gw * 16 + 2 * h + 1) * 16 + i]; } }
    for (int t = gw; t < MT; t += NGW) {
        unsigned abits[2], bbits[2], bcur[2]; float a[2], hv[2]; int ptr[2];
#pragma unroll
        for (int r = 0; r < 2; ++r) { abits[r] = nab[r]; bbits[r] = nbb[r]; a[r] = __uint_as_float(abits[r]); ptr[r] = 0; bcur[r] = (unsigned)__shfl((int)bbits[r], rowbase); hv[r] = a[r] + __uint_as_float(bcur[r]); }
        if (t + NGW < MT) {
#pragma unroll
            for (int r = 0; r < 2; ++r) { const int h = 4 * r + row; nab[r] = SUB[((size_t)(t + NGW) * 16 + 2 * h) * 16 + i]; nbb[r] = SUB[((size_t)(t + NGW) * 16 + 2 * h + 1) * 16 + i]; } }
        for (int k = 0; k < 16; ++k) {
#pragma unroll
            for (int r = 0; r < 2; ++r) {
                const float key = __uint_as_float((__float_as_uint(hv[r]) & 0xFFFFFFF0u) | (unsigned)i);
                const float m = row_allmax(key);
                const bool win = (key == m);
                if (win) { Sel[((r * 4 + row) * 16 + k) * 2] = (abits[r] & 127u) * 128u + (bcur[r] & 127u); Sel[((r * 4 + row) * 16 + k) * 2 + 1] = __float_as_uint(hv[r]); ptr[r]++; }
                const unsigned bnext = (unsigned)__shfl((int)bbits[r], rowbase + (ptr[r] < 15 ? ptr[r] : 15));
                if (win) { bcur[r] = bnext; hv[r] = (ptr[r] < 16) ? a[r] + __uint_as_float(bnext) : -3.0e38f; }
            }
        }
        LDS_WAIT(); asm volatile("" ::: "memory");
#pragma unroll
        for (int r = 0; r < 2; ++r) { const int h = 4 * r + row;
            const unsigned e = Sel[((r * 4 + row) * 16 + i) * 2]; const float sc = __uint_as_float(Sel[((r * 4 + row) * 16 + i) * 2 + 1]);
            const float mx = row_allmax(sc);
            const float ex = fexp2((sc - mx) * 1.44269504089f);
            const float sum = row_allsum(ex);
            EID[(size_t)t * 128 + h * 16 + i] = e; GWp[(size_t)t * 128 + h * 16 + i] = ex / sum; }
        LDS_WAIT(); asm volatile("" ::: "memory");
    }
}
typedef float f32x2c __attribute__((ext_vector_type(2)));
__device__ __forceinline__ long mk64(unsigned lo, unsigned hi) { return (long)(((unsigned long long)hi << 32) | lo); }
#if MK_U4
typedef int v8i_q __attribute__((ext_vector_type(8)));
__device__ __forceinline__ void p6b(Frame& F) { F.fence_ids();
    const int j = F.bid & 7, s2 = j >> 1, par = j & 1, nsb = F.G >> 3; if ((F.bid >> 3) >= nsb) return;
    const int wj = (F.bid >> 3) * NWAVES + F.wave, NW = nsb * NWAVES, NI = MT / 2;
    const int lane = F.lane, g = lane >> 4;
    const int pidx = (4 * (lane & 15) + (lane >> 4)) * 4;
    const unsigned char* H8 = F.ws + WS_H2F8 + (size_t)s2 * MT * 256 + 16 * g; const unsigned char* U4 = F.ws + WS_UE8 + (size_t)s2 * 16384 * 128 + 16 * (lane & 3); const unsigned* EID = (const unsigned*)(F.ws + WS_EID) + (lane >> 2);
    float* PD = (float*)(F.ws + WS_PD) + (size_t)s2 * MT * 128;
#define TOK(ix_) (2 * ((ix_) < NI ? (ix_) : NI - 1) + par)
#define P6B_LOAD_EID(E, ix_) do { const int tc_ = TOK(ix_); _Pragma("unroll") for (int h = 0; h < 8; ++h) E[h] = EID[(size_t)tc_ * 128 + 16 * h]; } while (0)
#define P6B_LOAD_AB(A_, B0_, B1_, E, ix_) do { const int tc_ = TOK(ix_); const unsigned char* hp_ = H8 + (size_t)tc_ * 256; A_[0] = *(const v4u*)hp_; A_[1] = *(const v4u*)(hp_ + 64); A_[2] = *(const v4u*)(hp_ + 128); A_[3] = *(const v4u*)(hp_ + 192); \
        _Pragma("unroll") for (int h = 0; h < 8; ++h) { const unsigned char* rp_ = U4 + (size_t)E[h] * 128; B0_[h] = *(const v4u*)rp_; B1_[h] = *(const v4u*)(rp_ + 64); } } while (0)
#define BPM(x_) ((int)__builtin_amdgcn_ds_bpermute(pidx, (int)(x_)))
#define P6B_COMPUTE(A_, B0_, B1_, ix_) do { if ((ix_) < NI) { const int tc_ = 2 * (ix_) + par; \
        const v8i_q a0_ = (v8i_q){(int)A_[0].x, (int)A_[0].y, (int)A_[0].z, (int)A_[0].w, (int)A_[1].x, (int)A_[1].y, (int)A_[1].z, (int)A_[1].w}, a1_ = (v8i_q){(int)A_[2].x, (int)A_[2].y, (int)A_[2].z, (int)A_[2].w, (int)A_[3].x, (int)A_[3].y, (int)A_[3].z, (int)A_[3].w}; \
        _Pragma("unroll") for (int h = 0; h < 8; ++h) { const v8i_q b0_ = (v8i_q){BPM(B0_[h].x), BPM(B0_[h].y), BPM(B0_[h].z), BPM(B0_[h].w), 0, 0, 0, 0}, b1_ = (v8i_q){BPM(B1_[h].x), BPM(B1_[h].y), BPM(B1_[h].z), BPM(B1_[h].w), 0, 0, 0, 0}; \
            f32x4 acc_ = __builtin_amdgcn_mfma_scale_f32_16x16x128_f8f6f4(a0_, b0_, (f32x4){0.f, 0.f, 0.f, 0.f}, 0, 4, 0, 0x7F7F7F7F, 0, 0x7F7F7F7F); \
            acc_ = __builtin_amdgcn_mfma_scale_f32_16x16x128_f8f6f4(a1_, b1_, acc_, 0, 4, 0, 0x7F7F7F7F, 0, 0x7F7F7F7F); \
            if (lane < 16) PD[(size_t)tc_ * 128 + 16 * h + lane] = acc_[0] * (1.0f / 1024.0f); } } } while (0)
    unsigned E0[8], E1[8]; v4u A0[4], A1[4], B00[8], B01[8], B10[8], B11[8];
    int ix = wj;
    P6B_LOAD_EID(E0, ix); P6B_LOAD_EID(E1, ix + NW);
    P6B_LOAD_AB(A0, B00, B01, E0, ix);
    for (; ix < NI; ix += 2 * NW) {
        P6B_LOAD_AB(A1, B10, B11, E1, ix + NW);
        P6B_LOAD_EID(E0, ix + 2 * NW);
        P6B_COMPUTE(A0, B00, B01, ix);
        P6B_LOAD_AB(A0, B00, B01, E0, ix + 2 * NW);
        P6B_LOAD_EID(E1, ix + 3 * NW);
        P6B_COMPUTE(A1, B10, B11, ix + NW);
    }
#undef TOK
#undef P6B_LOAD_EID
#undef P6B_LOAD_AB
#undef P6B_COMPUTE
#undef BPM
}
#else
__device__ __forceinline__ void p6b(Frame& F) { F.fence_ids();
    const int j = F.bid & 7, nsb = F.G >> 3; if ((F.bid >> 3) >= nsb) return;
    const int wj = (F.bid >> 3) * NWAVES + F.wave, NW = nsb * NWAVES;
    const int lane = F.lane, g = lane >> 4;
    const int pidx = (4 * (lane & 15) + (lane >> 4)) * 4;
    const unsigned char* H8 = F.ws + WS_H2F8 + (size_t)j * MT * 128 + 16 * g; const unsigned char* UE8 = F.ws + WS_UE8 + (size_t)j * 16384 * 128 + 16 * (lane & 3); const unsigned* EID = (const unsigned*)(F.ws + WS_EID) + (lane >> 2);
    float* PD = (float*)(F.ws + WS_PD) + (size_t)j * MT * 128;
#define P6B_LOAD_EID(E, tt) do { const int tc_ = (tt) < MT ? (tt) : MT - 1; _Pragma("unroll") for (int h = 0; h < 8; ++h) E[h] = EID[(size_t)tc_ * 128 + 16 * h]; } while (0)
#define P6B_LOAD_AB(A0_, A1_, B0_, B1_, E, tt) do { const int tc_ = (tt) < MT ? (tt) : MT - 1; const unsigned char* hp_ = H8 + (size_t)tc_ * 128; A0_ = *(const v4u*)hp_; A1_ = *(const v4u*)(hp_ + 64); \
        _Pragma("unroll") for (int h = 0; h < 8; ++h) { const unsigned char* rp_ = UE8 + (size_t)E[h] * 128; B0_[h] = *(const v4u*)rp_; B1_[h] = *(const v4u*)(rp_ + 64); } } while (0)
#define BPM(x_) ((unsigned)__builtin_amdgcn_ds_bpermute(pidx, (int)(x_)))
#define P6B_COMPUTE(A0_, A1_, B0_, B1_, tt) do { if ((tt) < MT) { _Pragma("unroll") for (int h = 0; h < 8; ++h) { f32x4 acc_ = (f32x4){0.f, 0.f, 0.f, 0.f}; \
            acc_ = __builtin_amdgcn_mfma_f32_16x16x32_fp8_fp8(mk64(A0_.x, A0_.y), mk64(BPM(B0_[h].x), BPM(B0_[h].y)), acc_, 0, 0, 0); \
            acc_ = __builtin_amdgcn_mfma_f32_16x16x32_fp8_fp8(mk64(A0_.z, A0_.w), mk64(BPM(B0_[h].z), BPM(B0_[h].w)), acc_, 0, 0, 0); \
            acc_ = __builtin_amdgcn_mfma_f32_16x16x32_fp8_fp8(mk64(A1_.x, A1_.y), mk64(BPM(B1_[h].x), BPM(B1_[h].y)), acc_, 0, 0, 0); \
            acc_ = __builtin_amdgcn_mfma_f32_16x16x32_fp8_fp8(mk64(A1_.z, A1_.w), mk64(BPM(B1_[h].z), BPM(B1_[h].w)), acc_, 0, 0, 0); \
            if (lane < 16) PD[(size_t)(tt) * 128 + 16 * h + lane] = acc_[0] * (1.0f / 8192.0f); } } } while (0)
    unsigned E0[8], E1[8]; v4u A00, A01, A10, A11, B00[8], B01[8], B10[8], B11[8];
    int t = wj;
    P6B_LOAD_EID(E0, t); P6B_LOAD_EID(E1, t + NW);
    P6B_LOAD_AB(A00, A01, B00, B01, E0, t);
    for (; t < MT; t += 2 * NW) {
        P6B_LOAD_AB(A10, A11, B10, B11, E1, t + NW);
        P6B_LOAD_EID(E0, t + 2 * NW);
        P6B_COMPUTE(A00, A01, B00, B01, t);
        P6B_LOAD_AB(A00, A01, B00, B01, E0, t + 2 * NW);
        P6B_LOAD_EID(E1, t + 3 * NW);
        P6B_COMPUTE(A10, A11, B10, B11, t + NW);
    }
#undef P6B_LOAD_EID
#undef P6B_LOAD_AB
#undef P6B_COMPUTE
#undef BPM
}
#endif
__device__ __forceinline__ void p6b2(Frame& F) { F.fence_ids();
    const float* PD = (const float*)(F.ws + WS_PD); const float* GWp = (const float*)(F.ws + WS_GW); float* ACT = (float*)(F.ws + WS_ACT);
    for (size_t i4 = (size_t)F.bid * 512 + F.tid; i4 < (size_t)MT * 32; i4 += (size_t)F.G * 512) {
        f32x4 s = *(const f32x4*)(PD + i4 * 4);
#pragma unroll
        for (int jj = 1; jj < (MK_U4 ? 4 : 8); ++jj) s += *(const f32x4*)(PD + (size_t)jj * MT * 128 + i4 * 4);
        const f32x4 gw = *(const f32x4*)(GWp + i4 * 4);
        *(f32x4*)(ACT + i4 * 4) = (f32x4){gelu1(s[0]) * gw[0], gelu1(s[1]) * gw[1], gelu1(s[2]) * gw[2], gelu1(s[3]) * gw[3]};
    }
}
__device__ __forceinline__ void p6c(Frame& F) { F.fence_ids();
    const int j = F.bid & 7, nsb = F.G >> 3; if ((F.bid >> 3) >= nsb) return;
    const int wj = (F.bid >> 3) * NWAVES + F.wave, NW = nsb * NWAVES;
    const int lane = F.lane, g8 = lane >> 3, s8 = lane & 7;
    LAS float* Act = (LAS float*)(F.lds + F.wave * 8192); LAS unsigned* Eidl = (LAS unsigned*)(F.lds + F.wave * 8192 + 4096);
    const unsigned char* VE8 = F.ws + WS_VE8 + (size_t)j * 16384 * 128 + 16 * s8; const unsigned* EID = (const unsigned*)(F.ws + WS_EID); const float* ACT = (const float*)(F.ws + WS_ACT);
    bf16* PEERS = (bf16*)(F.ws + WS_PEERS) + (size_t)j * MT * 128;
    for (int tg = wj; tg < MT / 8; tg += NW) {
        const size_t t0 = (size_t)tg * 8;
#pragma unroll
        for (int q = 0; q < 4; ++q) { const int idx = 4 * (lane + 64 * q);
            *(LAS f32x4*)(Act + idx) = *(const f32x4*)(ACT + t0 * 128 + idx); *(LAS v4u*)(Eidl + idx) = *(const v4u*)(EID + t0 * 128 + idx); }
        LDS_WAIT(); asm volatile("" ::: "memory");
        f32x2c acc2[8];
#pragma unroll
        for (int e = 0; e < 8; ++e) acc2[e] = (f32x2c){0.f, 0.f};
        LAS const float* ap = Act + g8 * 128; LAS const unsigned* ep = Eidl + g8 * 128;
        v4u va[8], vb[8]; f32x4 aa[2], ab[2];
#define P6C_LOAD(V_, A_, base) do { A_[0] = *(LAS const f32x4*)(ap + (base)); A_[1] = *(LAS const f32x4*)(ap + (base) + 4); const v4u e0_ = *(LAS const v4u*)(ep + (base)), e1_ = *(LAS const v4u*)(ep + (base) + 4); \
            _Pragma("unroll") for (int k = 0; k < 4; ++k) { V_[k] = *(const v4u*)(VE8 + (size_t)e0_[k] * 128); V_[4 + k] = *(const v4u*)(VE8 + (size_t)e1_[k] * 128); } } while (0)
#define P6C_FMA(V_, A_) do { _Pragma("unroll") for (int k = 0; k < 8; ++k) { const float a_ = A_[k >> 2][k & 3]; const f32x2c a2_ = (f32x2c){a_, a_}; _Pragma("unroll") for (int w = 0; w < 4; ++w) { \
            const f32x2c lo_ = __builtin_amdgcn_cvt_pk_f32_fp8((int)V_[k][w], false), hi_ = __builtin_amdgcn_cvt_pk_f32_fp8((int)V_[k][w], true); \
            acc2[2 * w] = __builtin_elementwise_fma(a2_, lo_, acc2[2 * w]); acc2[2 * w + 1] = __builtin_elementwise_fma(a2_, hi_, acc2[2 * w + 1]); } } } while (0)
        P6C_LOAD(va, aa, 0);
        for (int it = 0; it < 128; it += 16) {
            P6C_LOAD(vb, ab, it + 8);
            P6C_FMA(va, aa);
            if (it + 16 < 128) P6C_LOAD(va, aa, it + 16);
            P6C_FMA(vb, ab);
        }
#undef P6C_LOAD
#undef P6C_FMA
        float acc[16];
#pragma unroll
        for (int e = 0; e < 8; ++e) { acc[2 * e] = acc2[e][0]; acc[2 * e + 1] = acc2[e][1]; }
        { bf16* op = PEERS + (t0 + g8) * 128 + 16 * s8;
            v4u o0, o1;
            o0.x = pk2(acc[0] * 0.0625f, acc[1] * 0.0625f); o0.y = pk2(acc[2] * 0.0625f, acc[3] * 0.0625f); o0.z = pk2(acc[4] * 0.0625f, acc[5] * 0.0625f); o0.w = pk2(acc[6] * 0.0625f, acc[7] * 0.0625f);
            o1.x = pk2(acc[8] * 0.0625f, acc[9] * 0.0625f); o1.y = pk2(acc[10] * 0.0625f, acc[11] * 0.0625f); o1.z = pk2(acc[12] * 0.0625f, acc[13] * 0.0625f); o1.w = pk2(acc[14] * 0.0625f, acc[15] * 0.0625f);
            *(v4u*)op = o0; *(v4u*)(op + 8) = o1; }
        LDS_WAIT(); asm volatile("" ::: "memory");
    }
}
__device__ __forceinline__ void p6d(Frame& F) { F.fence_ids();
    const int gw = F.bid * NWAVES + F.wave, NGW = F.G * NWAVES; const bf16* PEERS = (const bf16*)(F.ws + WS_PEERS); const float* gate2 = (const float*)(F.ws + WS_MOD) + 5120;
    f32x4 fg[4];
#pragma unroll
    for (int q = 0; q < 4; ++q) fg[q] = *((const f32x4*)F.final_g + F.lane + 64 * q);
    f32x4 nx[4]; v2u np[4];
#define P6D_LOAD(tt) do { _Pragma("unroll") for (int q = 0; q < 4; ++q) { const int d = 4 * F.lane + 256 * q; nx[q] = *((const f32x4*)((const float*)F.dout + (size_t)(tt) * DM) + F.lane + 64 * q); \
        np[q] = *(const v2u*)(PEERS + ((size_t)(d >> 7) * MT + (tt)) * 128 + (d & 127)); } } while (0)
    if (gw < MT) P6D_LOAD(gw);
    for (int t = gw; t < MT; t += NGW) {
        const int b = t >> 12;
        f32x4* xr = (f32x4*)((float*)F.dout + (size_t)t * DM) + F.lane; f32x4 o[4]; float ss = 0.f;
#pragma unroll
        for (int q = 0; q < 4; ++q) { const int d = 4 * F.lane + 256 * q; const f32x4 g2 = *(const f32x4*)(gate2 + (size_t)b * 6144 + d);
            o[q] = nx[q] + g2 * (f32x4){bflo(np[q].x), bfhi(np[q].x), bflo(np[q].y), bfhi(np[q].y)}; ss += (o[q][0] * o[q][0] + o[q][1] * o[q][1]) + (o[q][2] * o[q][2] + o[q][3] * o[q][3]); }
        if (t + NGW < MT) P6D_LOAD(t + NGW);
        const float rstd = __builtin_amdgcn_rsqf(wave_sum(ss) * (1.f / DM) + EPSN);
#pragma unroll
        for (int q = 0; q < 4; ++q) xr[64 * q] = o[q] * rstd * fg[q];
    }
#undef P6D_LOAD
}

struct Args { const float* in[20]; float* out; unsigned char* ws; int ph_lo, ph_hi, li, pad; };
__global__ void __launch_bounds__(NWAVES * 64, 2) mk_fwd(Args args) {
    extern __shared__ __attribute__((aligned(16))) unsigned char lds_raw[];
    Frame F;
    F.lds = (LAS unsigned char*)lds_raw;
    F.tid = threadIdx.x; F.lane = F.tid & 63; F.wave = __builtin_amdgcn_readfirstlane(F.tid >> 6); F.G = gridDim.x; F.bid = blockIdx.x;
    F.x = args.in[0]; F.c = args.in[1]; F.w_ada = args.in[2]; F.b_ada = args.in[3]; F.norm1_g = args.in[4]; F.w_in = args.in[5]; F.ret_gn_g = args.in[6]; F.sgu_ln_g = args.in[7];
    F.sgu_ln_b = args.in[8]; F.sgu_w = args.in[9]; F.sgu_b = args.in[10]; F.w_ret_out = args.in[11]; F.w_sgu_out = args.in[12]; F.w_out = args.in[13]; F.norm2_g = args.in[14];
    F.peer_w_q = args.in[15]; F.peer_sub_keys = args.in[16]; F.peer_u = args.in[17]; F.peer_v = args.in[18]; F.final_g = args.in[19];
    F.ws = args.ws; F.dout = (unsigned char*)args.out;
    volatile LAS unsigned* MISC = (volatile LAS unsigned*)(F.lds + MISC_OFF); F.misc = MISC;
    if (F.tid < 64) MISC[F.tid] = 0u;
    __syncthreads();
    XcdBarrier bar; bar.bar = (unsigned*)(F.ws + WS_CTL) + CW_BAR; bar.x = 0; bar.st = nullptr;
    if (N_LAUNCHES == 1) bar = xcd_barrier_post((unsigned*)(F.ws + WS_CTL) + CW_BAR, MISC + 8);
    const int lo = args.ph_lo, hi = args.ph_hi;
#define IN(k) (lo <= (k) && (k) < hi)
#if MK_PROBE_HI > 0
#define STAMP(k) do { if (F.bid == 0 && F.wave == 0 && F.lane == 0) { const unsigned long long _t = __builtin_amdgcn_s_memrealtime(); MISC[16 + 2 * (k)] = (unsigned)_t; MISC[17 + 2 * (k)] = (unsigned)(_t >> 32); } } while (0)
#else
#define STAMP(k) do { } while (0)
#endif
#define SEAM(k) do { if (IN(k) && IN((k) + 1)) xcd_barrier(bar); } while (0)
    const float* mod = (const float*)(F.ws + WS_MOD);
    STAMP(0);
    if (IN(0)) { p0a(F); SEAM(0); }
    STAMP(1);
    if (IN(1)) { norm_rows<2>(F, F.x, F.norm1_g, mod + 0, mod + 1024, nullptr, F.dout + DO_H); SEAM(1); }
    STAMP(2);
    if (IN(2)) {
        pg8::Gemm g{(const bf16*)(F.dout + DO_H), (const bf16*)(F.ws + WS_WIN), MT, NIN, 512}; pg8::StaticOrder S; S.init(MT, NIN, F.G, F.bid);
        pg8::EpiProj E{(bf16*)(F.dout + DO_Q), (bf16*)(F.dout + DO_K), (bf16*)(F.ws + WS_V), (bf16*)(F.ws + WS_G), (bf16*)(F.ws + WS_U), (bf16*)(F.ws + WS_SV), (bf16*)(F.ws + WS_GA), (bf16*)(F.ws + WS_GB),
                       (const float*)(F.ws + WS_COS), (const float*)(F.ws + WS_SIN), 1.0f / 4096.0f, (float*)(F.ws + WS_SVSTAT)};
        pg8::gemm_phase<pg8::EpiProj, pg8::StaticOrder, true, true, true>(F.lds, g, S, E);
        SEAM(2);
    }
    STAMP(3);
    if (IN(3)) { p2a(F); SEAM(3); }
    STAMP(4);
    if (IN(4)) { p2b(F); SEAM(4); }
    STAMP(5);
    if (IN(5)) { p2c(F); SEAM(5); }
    STAMP(6);
    if (IN(6)) {
        pg8::StaticOrder S; S.init(MT, DM, F.G, F.bid);
        pg8::Gemm g{(const bf16*)(F.ws + WS_YG8), (const bf16*)(F.ws + WS_WRET), MT, DM, 1024, 512, (const bf16*)(F.ws + WS_YS8), (const bf16*)(F.ws + WS_WSGU), 8};
        pg8::EpiMerged E{F.ws + WS_GA, F.ws + WS_GB, F.ws + WS_MRG8, 1.0f / 4096.0f};
        pg8::gemm_phase<pg8::EpiMerged, pg8::StaticOrder, true, true, true>(F.lds, g, S, E);
        SEAM(6);
    }
    STAMP(7);
    if (IN(7)) {
        pg8::Gemm g{(const bf16*)(F.ws + WS_MRG8), (const bf16*)(F.ws + WS_WOUT), MT, DM, 512}; pg8::StaticOrder S; S.init(MT, DM, F.G, F.bid);
        pg8::EpiX1 E{F.x, mod + 2048, (float*)F.dout, 1.0f / 4096.0f};
        pg8::gemm_phase<pg8::EpiX1, pg8::StaticOrder, true, true, true>(F.lds, g, S, E);
        SEAM(7);
    }
    STAMP(8);
    if (IN(8)) { norm_rows<1>(F, (const float*)F.dout, F.norm2_g, mod + 3072, mod + 4096, (bf16*)(F.ws + WS_SV), F.ws + WS_H2F8); SEAM(8); }
    STAMP(9);
    if (IN(9)) {
        pg8::Gemm g{(const bf16*)(F.ws + WS_SV), (const bf16*)(F.ws + WS_WQ), MT, 2048, DM}; pg8::StaticOrder S; S.init(MT, 2048, F.G, F.bid);
        pg8::EpiPlain E{(bf16*)(F.ws + WS_GA), 2048};
        pg8::gemm_phase<pg8::EpiPlain, pg8::StaticOrder, true, true>(F.lds, g, S, E);
        SEAM(9);
    }
    STAMP(10);
    if (IN(10)) { p5b(F); SEAM(10); }
    STAMP(11);
    if (IN(11)) { p6a(F); SEAM(11); }
    STAMP(12);
    if (IN(12)) { p6b(F); SEAM(12); }
    STAMP(13);
    if (IN(13)) { p6b2(F); SEAM(13); }
    STAMP(14);
    if (IN(14)) { p6c(F); SEAM(14); }
    STAMP(15);
    if (IN(15)) { p6d(F); }
    STAMP(16);
#if MK_PROBE_HI > 0
    __syncthreads();
    if (F.bid == 0 && F.tid == 0) { const unsigned long long t0 = ((unsigned long long)MISC[17 + 2 * MK_PROBE_LO] << 32) | MISC[16 + 2 * MK_PROBE_LO], t1 = ((unsigned long long)MISC[17 + 2 * MK_PROBE_HI] << 32) | MISC[16 + 2 * MK_PROBE_HI];
#if MK_GPROBE == 1
        ((float*)F.dout)[0] += (float)MISC[56] * 1e-3f; }
#elif MK_GPROBE == 2
        ((float*)F.dout)[0] += (float)MISC[57] * 1e-3f; }
#else
        ((float*)F.dout)[0] += (float)(t1 - t0) * 1e-3f; }
#endif
#endif
#undef IN
#undef SEAM
}

extern "C" void kernel_launch(void* const* d_in, const int* in_sizes, int n_in, void* d_out, int out_size, void* d_ws, size_t ws_size, hipStream_t stream) {
    static int grid = 0;
    if (grid == 0) {
        if (n_in != 20 || out_size != MT * DM || ws_size < WS_END) { fprintf(stderr, "kernel_launch: unexpected shapes (n_in %d, out %d, ws %zu); nothing launched\n", n_in, out_size, ws_size); grid = -1; return; }
        int dev = 0, cus = 0, per_cu = 0;
        if (hipGetDevice(&dev) != hipSuccess || hipDeviceGetAttribute(&cus, hipDeviceAttributeMultiprocessorCount, dev) != hipSuccess) { grid = -1; return; }
        if (hipFuncSetAttribute((const void*)mk_fwd, hipFuncAttributeMaxDynamicSharedMemorySize, LDS_BYTES) != hipSuccess) { fprintf(stderr, "kernel_launch: hipFuncSetAttribute failed\n"); grid = -1; return; }
        if (hipOccupancyMaxActiveBlocksPerMultiprocessor(&per_cu, (const void*)mk_fwd, NWAVES * 64, LDS_BYTES) != hipSuccess || per_cu < 1)
            fprintf(stderr, "kernel_launch: note: occupancy query reports %d workgroups per CU\n", per_cu);
        (void)hipGetLastError();
        grid = cus;
    }
    if (grid < 0) return;
    if (hipMemsetAsync((char*)d_ws + WS_CTL, 0, CTL_ZERO_BYTES, stream) != hipSuccess) { fprintf(stderr, "kernel_launch: memset failed\n"); return; }
    Args a{};
    for (int i = 0; i < 20; ++i) a.in[i] = (const float*)d_in[i];
    a.out = (float*)d_out; a.ws = (unsigned char*)d_ws;
    static_assert(N_LAUNCHES == 1 || N_LAUNCHES == N_PHASES, "N_LAUNCHES is 1 or N_PHASES");
    for (int li = 0; li < N_LAUNCHES && li < MK_MAXPH; ++li) {
        a.ph_lo = (N_LAUNCHES == 1) ? 0 : li; a.ph_hi = (N_LAUNCHES == 1) ? N_PHASES : li + 1; a.li = li;
        hipLaunchKernelGGL(mk_fwd, dim3(grid), dim3(NWAVES * 64), LDS_BYTES, stream, a);
        const hipError_t le = hipPeekAtLastError();
        if (le != hipSuccess) { fprintf(stderr, "kernel_launch: launch %d failed: %s\n", li, hipGetErrorName(le)); break; }
    }
}
```

```cpp
#include <hip/hip_runtime.h>
#include <cstdio>
#include <cstdint>

#ifndef MK_PROBE_LO
#define MK_PROBE_LO 0
#define MK_PROBE_HI 0
#endif
#ifndef MK_GPROBE
#define MK_GPROBE 0
#endif
#define MK_MISC_OFF (147456 - 256)
#ifndef MK_U4
#define MK_U4 1
#endif
#ifndef MK_ALAY
#define MK_ALAY 2
#endif
#ifndef MK_MAXPH
#define MK_MAXPH 16
#endif
#ifndef MK_N_LAUNCHES
#define MK_N_LAUNCHES 1
#endif
namespace pg8 {
#define PG8_LAS __attribute__((address_space(3)))
typedef unsigned short bf16_t;
typedef short bf16x8 __attribute__((ext_vector_type(8)));
typedef float f32x4 __attribute__((ext_vector_type(4)));
typedef unsigned u32x4 __attribute__((ext_vector_type(4)));
constexpr int BM = 256, BK = 64, HALF = 128, HTB = HALF * BK * 2  , STAGE_BYTES = 8 * HTB, NXCD = 8, WGM = 2;

__host__ __device__ __forceinline__ int lds_byte(int r, int c) { const int st = (r >> 4) * 2 + (c >> 5), rr = r & 15, cc = c & 31, ob = rr * 64 + cc * 2; return st * 1024 + (ob ^ (((ob >> 9) & 1) << 5)); }
__host__ __device__ __forceinline__ void stage_rc(int b, int& R, int& C) { const int st = b / 1024, sb = b % 1024, swz = sb ^ (((sb >> 9) & 1) << 5); R = (st >> 1) * 16 + swz / 64; C = (st & 1) * 32 + (swz % 64) / 2; }
__host__ __device__ __forceinline__ int perm32(int rho) { const int n = rho >> 4, i = rho & 15; return 8 * (i >> 2) + 4 * n + (i & 3); }

struct Unit { int pm, pn; };
struct Gemm { const bf16_t* A; const bf16_t* Bt; int M, N, K; int ld = 0; const bf16_t* A2 = nullptr; const bf16_t* Bt2 = nullptr; int ksplit = 0; };

struct StaticOrder {
    int nM, nN, nwg, G, c;
    __host__ __device__ void init(int M, int N, int G_, int c_) { nM = M / BM; nN = N / BM; nwg = nM * nN; G = G_; c = c_; }
    __host__ __device__ bool next(int i, Unit& u) const {
        const long L = (long)i * G + c; if (L >= nwg) return false;
        int wgid = (int)L; { const int q = nwg / NXCD, r = nwg % NXCD, xcd = wgid % NXCD, off = wgid / NXCD; wgid = (xcd < r ? xcd * (q + 1) : r * (q + 1) + (xcd - r) * q) + off; }
        const int nig = WGM * nN, gid = wgid / nig, fm = gid * WGM, gsz = (nM - fm) < WGM ? (nM - fm) : WGM;
        u.pm = fm + ((wgid % nig) % gsz); u.pn = (wgid % nig) / gsz; return true;
    }
    __device__ __forceinline__ void a_ready(const Unit&) const {}
    __device__ __forceinline__ void done(const Unit&) const {}
};

__device__ __forceinline__ unsigned cvt_pk_bf16(float lo, float hi) { unsigned r; asm volatile("v_cvt_pk_bf16_f32 %0, %1, %2" : "=v"(r) : "v"(lo), "v"(hi)); return r; }
typedef float f32x2 __attribute__((ext_vector_type(2)));
__device__ __forceinline__ f32x2 gelu_pk(f32x2 v) {
    const f32x2 av = __builtin_elementwise_abs(v), d = av * 0.2316418882f + 1.0f;
    f32x2 t; t.x = __builtin_amdgcn_rcpf(d.x); t.y = __builtin_amdgcn_rcpf(d.y);
    f32x2 q = t * 0.5307027145f + (-0.7265760135f); q = q * t + 0.7107068705f; q = q * t + (-0.142248368f); q = q * t + 0.127414796f; q = q * t;
    const f32x2 s = (v * v) * (-0.72134752044f);
    f32x2 e; e.x = __builtin_amdgcn_exp2f(s.x); e.y = __builtin_amdgcn_exp2f(s.y);
    const f32x2 m = v * (q * e), r = v - m;
    f32x2 o; o.x = v.x < 0.f ? m.x : r.x; o.y = v.y < 0.f ? m.y : r.y; return o;
}


typedef unsigned u32x2 __attribute__((ext_vector_type(2)));
__device__ __forceinline__ float bflo(unsigned w) { return __uint_as_float(w << 16); }
__device__ __forceinline__ float bfhi(unsigned w) { return __uint_as_float(w & 0xffff0000u); }
typedef float f32x2q __attribute__((ext_vector_type(2)));
__device__ __forceinline__ f32x4 f8x4(unsigned w) { const f32x2q lo = __builtin_amdgcn_cvt_pk_f32_fp8((int)w, false), hi = __builtin_amdgcn_cvt_pk_f32_fp8((int)w, true); return (f32x4){lo[0], lo[1], hi[0], hi[1]}; }
__device__ __forceinline__ float gelu1(float v) {
    const float av = __builtin_fabsf(v), t = __builtin_amdgcn_rcpf(av * 0.2316418882f + 1.0f);
    float q = t * 0.5307027145f + (-0.7265760135f); q = q * t + 0.7107068705f; q = q * t + (-0.142248368f); q = q * t + 0.127414796f; q = q * t;
    const float e = __builtin_amdgcn_exp2f((v * v) * (-0.72134752044f));
    const float m = v * (q * e);
    return v < 0.f ? m : v - m;
}
__device__ __forceinline__ float sigm1(float v) { return __builtin_amdgcn_rcpf(1.0f + __builtin_amdgcn_exp2f(v * (-1.44269504089f))); }
__device__ __forceinline__ float silu1(float v) { return v * sigm1(v); }

__device__ __forceinline__ unsigned bperm(int idx, unsigned v) { return (unsigned)__builtin_amdgcn_ds_bpermute(idx, (int)v); }
__device__ __forceinline__ float bpermf(int idx, float v) { return __int_as_float(__builtin_amdgcn_ds_bpermute(idx, __float_as_int(v))); }
__device__ __forceinline__ f32x4 bperm4(int idx, const f32x4& v) { return (f32x4){bpermf(idx, v[0]), bpermf(idx, v[1]), bpermf(idx, v[2]), bpermf(idx, v[3])}; }
__device__ __forceinline__ u32x4 bperm4u(int idx, const u32x4& v) { u32x4 r; r.x = bperm(idx, v.x); r.y = bperm(idx, v.y); r.z = bperm(idx, v.z); r.w = bperm(idx, v.w); return r; }
#define PG8_REMAP() const int lane_ = 16 * fq + fr, pidx = (16 * (lane_ & 3) + (lane_ >> 2)) * 4, fr2 = lane_ >> 2, fq2 = lane_ & 3

struct EpiProj {
    static constexpr bool PERM = true, AFTER_DRAIN = false, HAS_MID = false;
    bf16_t *Q, *Kb, *V, *G, *U, *SV, *GA, *GB; const float *cosT, *sinT; float osc; float* svstat;
    __device__ __forceinline__ void operator()(const f32x4 (&acc)[2][2][4][2], const Unit& u, int wr, int wc, int fr, int fq) const {
        PG8_REMAP();
        const int colt = u.pn * BM; const int row0 = u.pm * BM + wr * 64 + fr2;
        if (colt < 1024) {
            const bool isk = colt >= 512; bf16_t* base = isk ? Kb : Q; const int lc0 = (colt & 511) + wc * 32 + 8 * fq2; const float sc = (isk ? 0.08838834764831845f : 1.0f) * osc;
            const int fi = wc * 16 + 4 * fq2;
#pragma unroll
            for (int ai = 0; ai < 2; ++ai) {
                f32x4 csv[4], snv[4];
#pragma unroll
                for (int m = 0; m < 4; ++m) { const int s = (row0 + ai * HALF + m * 16) & 4095; csv[m] = *(const f32x4*)(cosT + s * 64 + fi) * sc; snv[m] = *(const f32x4*)(sinT + s * 64 + fi) * sc; }
#pragma unroll
                for (int m = 0; m < 4; ++m) { const int row = row0 + ai * HALF + m * 16; const f32x4 cs = csv[m], sn = snv[m];
#pragma unroll
                    for (int bj = 0; bj < 2; ++bj) { const f32x4 v0 = bperm4(pidx, acc[ai][bj][m][0]), v1 = bperm4(pidx, acc[ai][bj][m][1]);
                        u32x4 w;
                        w.x = cvt_pk_bf16(v0[0] * cs[0] - v0[1] * sn[0], v0[0] * sn[0] + v0[1] * cs[0]);
                        w.y = cvt_pk_bf16(v0[2] * cs[1] - v0[3] * sn[1], v0[2] * sn[1] + v0[3] * cs[1]);
                        w.z = cvt_pk_bf16(v1[0] * cs[2] - v1[1] * sn[2], v1[0] * sn[2] + v1[1] * cs[2]);
                        w.w = cvt_pk_bf16(v1[2] * cs[3] - v1[3] * sn[3], v1[2] * sn[3] + v1[3] * cs[3]);
                        *(u32x4*)(base + (size_t)row * 512 + lc0 + bj * HALF) = w; } } }
        } else {
            const int seg = (colt - 1024) >> 10;
            bf16_t* base = seg == 0 ? V : seg == 1 ? G : seg == 2 ? U : seg == 3 ? SV : seg == 4 ? GA : GB;
            const int lc0 = ((colt - 1024) & 1023) + wc * 32 + 8 * fq2;
#pragma unroll
            for (int ai = 0; ai < 2; ++ai)
#pragma unroll
                for (int m = 0; m < 4; ++m) { const int row = row0 + ai * HALF + m * 16; float s1[2] = {0.f, 0.f}, s2[2] = {0.f, 0.f};
#pragma unroll
                    for (int bj = 0; bj < 2; ++bj) { f32x4 v0 = acc[ai][bj][m][0] * osc, v1 = acc[ai][bj][m][1] * osc;
                        if (seg == 1) {
#pragma unroll
                            for (int e = 0; e < 4; ++e) { v0[e] = silu1(v0[e]); v1[e] = silu1(v1[e]); }
                        } else if (seg == 2 || seg == 3) {
                            f32x2 a = gelu_pk((f32x2){v0[0], v0[1]}), b = gelu_pk((f32x2){v0[2], v0[3]}), c = gelu_pk((f32x2){v1[0], v1[1]}), d = gelu_pk((f32x2){v1[2], v1[3]});
                            v0 = (f32x4){a.x, a.y, b.x, b.y}; v1 = (f32x4){c.x, c.y, d.x, d.y};
                        } else if (seg >= 4) {
#pragma unroll
                            for (int e = 0; e < 4; ++e) { v0[e] = sigm1(v0[e]); v1[e] = sigm1(v1[e]); }
                        }
                        if (seg == 3) { s1[bj] = ((v0[0] + v0[1]) + (v0[2] + v0[3])) + ((v1[0] + v1[1]) + (v1[2] + v1[3]));
                            s2[bj] = ((v0[0] * v0[0] + v0[1] * v0[1]) + (v0[2] * v0[2] + v0[3] * v0[3])) + ((v1[0] * v1[0] + v1[1] * v1[1]) + (v1[2] * v1[2] + v1[3] * v1[3])); }
                        if (seg == 0) { u32x4 w; w.x = cvt_pk_bf16(v0[0], v0[1]); w.y = cvt_pk_bf16(v0[2], v0[3]); w.z = cvt_pk_bf16(v1[0], v1[1]); w.w = cvt_pk_bf16(v1[2], v1[3]);
                            *(u32x4*)(base + (size_t)row * 1024 + lc0 + bj * HALF) = bperm4u(pidx, w); }
                        else { const float fs = seg >= 4 ? 256.0f : 16.0f;
                            int t0 = __builtin_amdgcn_cvt_pk_fp8_f32(v0[0] * fs, v0[1] * fs, 0, false); t0 = __builtin_amdgcn_cvt_pk_fp8_f32(v0[2] * fs, v0[3] * fs, t0, true);
                            int t1 = __builtin_amdgcn_cvt_pk_fp8_f32(v1[0] * fs, v1[1] * fs, 0, false); t1 = __builtin_amdgcn_cvt_pk_fp8_f32(v1[2] * fs, v1[3] * fs, t1, true);
                            u32x2 w8; w8.x = bperm(pidx, (unsigned)t0); w8.y = bperm(pidx, (unsigned)t1);
                            *(u32x2*)((unsigned char*)base + (size_t)row * 1024 + lc0 + bj * HALF) = w8; } }
                    if (seg == 3) {
                        float a = s1[0] + s1[1], b = s2[0] + s2[1];
                        a += __shfl_xor(a, 16); b += __shfl_xor(b, 16); a += __shfl_xor(a, 32); b += __shfl_xor(b, 32);
                        if (fq == 0) { float* sp = svstat + (size_t)(u.pm * BM + wr * 64 + fr + ai * HALF + m * 16) * 2; atomicAdd(sp, a); atomicAdd(sp + 1, b); } } }
        }
    }
};
template <bool ACCUM> struct EpiGate {
    static constexpr bool PERM = true, AFTER_DRAIN = false, HAS_MID = false;
    const bf16_t* GT; bf16_t* TMP; unsigned char* OUT8; float osc;
    __device__ __forceinline__ void operator()(const f32x4 (&acc)[2][2][4][2], const Unit& u, int wr, int wc, int fr, int fq) const {
        PG8_REMAP();
        const int row0 = u.pm * BM + wr * 64 + fr2, col0 = u.pn * BM + wc * 32 + 8 * fq2;
#pragma unroll
        for (int ai = 0; ai < 2; ++ai)
#pragma unroll
            for (int mp = 0; mp < 2; ++mp) {
                u32x4 gv[2][2], pv[2][2];
#pragma unroll
                for (int mm = 0; mm < 2; ++mm)
#pragma unroll
                    for (int bj = 0; bj < 2; ++bj) { const size_t off = (size_t)(row0 + ai * HALF + (2 * mp + mm) * 16) * 1024 + col0 + bj * HALF;
                        gv[mm][bj] = *(const u32x4*)(GT + off); if (ACCUM) pv[mm][bj] = *(const u32x4*)(TMP + off); }
#pragma unroll
                for (int mm = 0; mm < 2; ++mm)
#pragma unroll
                    for (int bj = 0; bj < 2; ++bj) { const int m = 2 * mp + mm; const size_t off = (size_t)(row0 + ai * HALF + m * 16) * 1024 + col0 + bj * HALF;
                        const f32x4 v0 = bperm4(pidx, acc[ai][bj][m][0]) * osc, v1 = bperm4(pidx, acc[ai][bj][m][1]) * osc; const u32x4 g = gv[mm][bj];
                        float o[8] = {v0[0] * bflo(g.x), v0[1] * bfhi(g.x), v0[2] * bflo(g.y), v0[3] * bfhi(g.y), v1[0] * bflo(g.z), v1[1] * bfhi(g.z), v1[2] * bflo(g.w), v1[3] * bfhi(g.w)};
                        if (ACCUM) { const u32x4 p = pv[mm][bj];
                            o[0] += bflo(p.x); o[1] += bfhi(p.x); o[2] += bflo(p.y); o[3] += bfhi(p.y); o[4] += bflo(p.z); o[5] += bfhi(p.z); o[6] += bflo(p.w); o[7] += bfhi(p.w);
                            u32x2 w8; int t0 = __builtin_amdgcn_cvt_pk_fp8_f32(o[0] * 8.f, o[1] * 8.f, 0, false); t0 = __builtin_amdgcn_cvt_pk_fp8_f32(o[2] * 8.f, o[3] * 8.f, t0, true);
                            int t1 = __builtin_amdgcn_cvt_pk_fp8_f32(o[4] * 8.f, o[5] * 8.f, 0, false); t1 = __builtin_amdgcn_cvt_pk_fp8_f32(o[6] * 8.f, o[7] * 8.f, t1, true);
                            w8.x = (unsigned)t0; w8.y = (unsigned)t1; *(u32x2*)(OUT8 + off) = w8;
                        } else {
                            u32x4 w; w.x = cvt_pk_bf16(o[0], o[1]); w.y = cvt_pk_bf16(o[2], o[3]); w.z = cvt_pk_bf16(o[4], o[5]); w.w = cvt_pk_bf16(o[6], o[7]);
                            *(u32x4*)(TMP + off) = w; } }
            }
    }
};
struct EpiMerged {
    static constexpr bool PERM = true, AFTER_DRAIN = false, HAS_MID = true;
    const unsigned char* GA; const unsigned char* GB; unsigned char* OUT8; float osc;
    __device__ __forceinline__ void mid(f32x4 (&acc)[2][2][4][2], const Unit& u, int wr, int wc, int fr, int fq) const {
        int fr_ = fr, fq_ = fq; asm volatile("" : "+v"(fr_), "+v"(fq_));
        const int row0 = u.pm * BM + wr * 64 + fr_, col0 = u.pn * BM + wc * 32 + 8 * fq_;
#pragma unroll
        for (int ai = 0; ai < 2; ++ai)
#pragma unroll
            for (int mp = 0; mp < 2; ++mp) {
                u32x2 av[2][2], bv[2][2];
#pragma unroll
                for (int mm = 0; mm < 2; ++mm)
#pragma unroll
                    for (int bj = 0; bj < 2; ++bj) { const size_t off = (size_t)(row0 + ai * HALF + (2 * mp + mm) * 16) * 1024 + col0 + bj * HALF; av[mm][bj] = *(const u32x2*)(GA + off); bv[mm][bj] = *(const u32x2*)(GB + off); }
#pragma unroll
                for (int mm = 0; mm < 2; ++mm)
#pragma unroll
                    for (int bj = 0; bj < 2; ++bj) { const int m = 2 * mp + mm; const f32x4 a0 = f8x4(av[mm][bj].x), a1 = f8x4(av[mm][bj].y), b0 = f8x4(bv[mm][bj].x), b1 = f8x4(bv[mm][bj].y);
#pragma unroll
                        for (int e = 0; e < 4; ++e) { acc[ai][bj][m][0][e] *= 2.f * a0[e] * __builtin_amdgcn_rcpf(__builtin_fmaxf(b0[e], 0.001953125f)); acc[ai][bj][m][1][e] *= 2.f * a1[e] * __builtin_amdgcn_rcpf(__builtin_fmaxf(b1[e], 0.001953125f)); } }
            }
    }
    __device__ __forceinline__ void operator()(const f32x4 (&acc)[2][2][4][2], const Unit& u, int wr, int wc, int fr, int fq) const {
        PG8_REMAP();
        const int row0 = u.pm * BM + wr * 64 + fr2, col0 = u.pn * BM + wc * 32 + 8 * fq2; const float sc = osc * 8.f * (1.0f / 256.0f);
#pragma unroll
        for (int ai = 0; ai < 2; ++ai)
#pragma unroll
            for (int mp = 0; mp < 2; ++mp) {
                u32x2 gv[2][2];
#pragma unroll
                for (int mm = 0; mm < 2; ++mm)
#pragma unroll
                    for (int bj = 0; bj < 2; ++bj) gv[mm][bj] = *(const u32x2*)(GB + (size_t)(row0 + ai * HALF + (2 * mp + mm) * 16) * 1024 + col0 + bj * HALF);
#pragma unroll
                for (int mm = 0; mm < 2; ++mm)
#pragma unroll
                    for (int bj = 0; bj < 2; ++bj) { const int m = 2 * mp + mm; const size_t off = (size_t)(row0 + ai * HALF + m * 16) * 1024 + col0 + bj * HALF;
                        const f32x4 v0 = bperm4(pidx, acc[ai][bj][m][0]) * sc * f8x4(gv[mm][bj].x), v1 = bperm4(pidx, acc[ai][bj][m][1]) * sc * f8x4(gv[mm][bj].y);
                        u32x2 w8; int t0 = __builtin_amdgcn_cvt_pk_fp8_f32(v0[0], v0[1], 0, false); t0 = __builtin_amdgcn_cvt_pk_fp8_f32(v0[2], v0[3], t0, true);
                        int t1 = __builtin_amdgcn_cvt_pk_fp8_f32(v1[0], v1[1], 0, false); t1 = __builtin_amdgcn_cvt_pk_fp8_f32(v1[2], v1[3], t1, true);
                        w8.x = (unsigned)t0; w8.y = (unsigned)t1; *(u32x2*)(OUT8 + off) = w8; }
            }
    }
};
struct EpiX1 {
    static constexpr bool PERM = false, AFTER_DRAIN = false, HAS_MID = false;
    const float* X; const float* gate1; bf16_t* X1; float osc;
    __device__ __forceinline__ void operator()(const f32x4 (&acc)[2][2][4][2], const Unit& u, int wr, int wc, int fr, int fq) const {
        PG8_REMAP();
        const int row0 = u.pm * BM + wr * 64 + fr2, col0 = u.pn * BM + wc * 32 + 4 * fq2;
        const float* gp = gate1 + (size_t)((u.pm * BM) >> 12) * 6144 + col0;
        f32x4 gv[2][2];
#pragma unroll
        for (int bj = 0; bj < 2; ++bj)
#pragma unroll
            for (int n = 0; n < 2; ++n) gv[bj][n] = *(const f32x4*)(gp + bj * HALF + n * 16) * osc;
#pragma unroll
        for (int ai = 0; ai < 2; ++ai)
#pragma unroll
            for (int mp = 0; mp < 2; ++mp) {
                f32x4 xv[2][2][2];
#pragma unroll
                for (int mm = 0; mm < 2; ++mm) { const size_t off = (size_t)(row0 + ai * HALF + (2 * mp + mm) * 16) * 1024 + col0;
#pragma unroll
                    for (int bj = 0; bj < 2; ++bj)
#pragma unroll
                        for (int n = 0; n < 2; ++n) xv[mm][bj][n] = *(const f32x4*)(X + off + bj * HALF + n * 16); }
#pragma unroll
                for (int mm = 0; mm < 2; ++mm) { const int m = 2 * mp + mm; const size_t off = (size_t)(row0 + ai * HALF + m * 16) * 1024 + col0;
#pragma unroll
                    for (int bj = 0; bj < 2; ++bj)
#pragma unroll
                        for (int n = 0; n < 2; ++n) { const f32x4 x1 = xv[mm][bj][n] + gv[bj][n] * bperm4(pidx, acc[ai][bj][m][n]); u32x2 w; w.x = cvt_pk_bf16(x1[0], x1[1]); w.y = cvt_pk_bf16(x1[2], x1[3]); *(u32x2*)(X1 + off + bj * HALF + n * 16) = w; } }
            }
    }
};
struct EpiPlain {
    static constexpr bool PERM = true, AFTER_DRAIN = false, HAS_MID = false;
    bf16_t* O; int ldc;
    __device__ __forceinline__ void operator()(const f32x4 (&acc)[2][2][4][2], const Unit& u, int wr, int wc, int fr, int fq) const {
        PG8_REMAP();
        const int row0 = u.pm * BM + wr * 64 + fr2, col0 = u.pn * BM + wc * 32 + 8 * fq2;
#pragma unroll
        for (int ai = 0; ai < 2; ++ai)
#pragma unroll
            for (int m = 0; m < 4; ++m) { bf16_t* rowp = O + (size_t)(row0 + ai * HALF + m * 16) * ldc + col0;
#pragma unroll
                for (int bj = 0; bj < 2; ++bj) { const f32x4 v0 = acc[ai][bj][m][0], v1 = acc[ai][bj][m][1];
                    u32x4 w; w.x = cvt_pk_bf16(v0[0], v0[1]); w.y = cvt_pk_bf16(v0[2], v0[3]); w.z = cvt_pk_bf16(v1[0], v1[1]); w.w = cvt_pk_bf16(v1[2], v1[3]);
                    *(u32x4*)(rowp + bj * HALF) = bperm4u(pidx, w); } }
    }
};
typedef int v8i_t __attribute__((ext_vector_type(8)));
typedef int v4i_t __attribute__((ext_vector_type(4)));
template <bool F8> __device__ __forceinline__ void mma_block(f32x4 (&acc)[4][2], const bf16x8 (&At)[4][2], const bf16x8 (&Bt)[2][2]) {
    if constexpr (F8) {
        v8i_t bb[2];
#pragma unroll
        for (int n = 0; n < 2; ++n) bb[n] = __builtin_shufflevector(__builtin_bit_cast(v4i_t, Bt[n][0]), __builtin_bit_cast(v4i_t, Bt[n][1]), 0, 1, 2, 3, 4, 5, 6, 7);
#pragma unroll
        for (int m = 0; m < 4; ++m) { const v8i_t aa = __builtin_shufflevector(__builtin_bit_cast(v4i_t, At[m][0]), __builtin_bit_cast(v4i_t, At[m][1]), 0, 1, 2, 3, 4, 5, 6, 7);
#pragma unroll
            for (int n = 0; n < 2; ++n) asm volatile("v_mfma_scale_f32_16x16x128_f8f6f4 %0, %1, %2, %0, %3, %3 op_sel_hi:[0,0,0]" : "+v"(acc[m][n]) : "v"(bb[n]), "v"(aa), "v"(0x7F7F7F7F)); }
    } else {
#pragma unroll
        for (int m = 0; m < 4; ++m)
#pragma unroll
            for (int n = 0; n < 2; ++n)
#pragma unroll
                for (int k = 0; k < 2; ++k) acc[m][n] = __builtin_amdgcn_mfma_f32_16x16x32_bf16(Bt[n][k], At[m][k], acc[m][n], 0, 0, 0);
    }
}
template <class Epi, class Sched, bool ALIGN_EPI = false, bool SP2 = false, bool F8 = false>
__device__ __forceinline__ void gemm_phase(PG8_LAS unsigned char* lds, const Gemm g, const Sched& S, const Epi& E) {
    const int tid = threadIdx.x, wid = __builtin_amdgcn_readfirstlane(tid >> 6), lane = tid & 63, wr = wid >> 2, wc = wid & 3, fr = lane & 15, fq = lane >> 4;
    const int K = g.K, nt = K / BK, LD = g.ld ? g.ld : g.K, nh = g.ksplit ? g.ksplit : nt;
    unsigned voffA[2], voffB[2];
#pragma unroll
    for (int i = 0; i < 2; ++i) { int R, C; stage_rc(tid * 16 + i * 8192, R, C); const int Rb = Epi::PERM ? ((R & ~31) + perm32(R & 31)) : R;
        voffA[i] = (unsigned)(R * LD + C) * 2u; voffB[i] = (unsigned)(Rb * LD + C) * 2u; }
    const size_t kstep = (size_t)(BK * 2);
    const size_t hstep = (size_t)HALF * LD * 2;
    const size_t tstep = 2 * hstep;
    const unsigned ldsw = (unsigned)wid * 1024u;
    const int aoff = lds_byte(wr * 64 + fr, fq * 8), boff = lds_byte(wc * 32 + fr, fq * 8);
#define PG8_SA(b, h) (((b) * 2 + (h)) * HTB)
#define PG8_SB(b, h) ((4 + (b) * 2 + (h)) * HTB)
#define PG8_STAGE(bufoff, gbase, voff) do { _Pragma("unroll") for (int _i = 0; _i < 2; ++_i) \
        __builtin_amdgcn_global_load_lds((const unsigned*)((const char*)(gbase) + (voff)[_i]), (PG8_LAS unsigned*)(lds + (bufoff) + ldsw + _i * 8192), 16, 0, 0); } while (0)
#define PG8_LDA(dst, b, h) do { _Pragma("unroll") for (int m = 0; m < 4; ++m) _Pragma("unroll") for (int k = 0; k < 2; ++k) dst[m][k] = *(const PG8_LAS bf16x8*)(lds + PG8_SA(b, h) + aoff + m * 2048 + k * 1024); } while (0)
#define PG8_LDB(dst, b, h) do { _Pragma("unroll") for (int n = 0; n < 2; ++n) _Pragma("unroll") for (int k = 0; k < 2; ++k) dst[n][k] = *(const PG8_LAS bf16x8*)(lds + PG8_SB(b, h) + boff + n * 2048 + k * 1024); } while (0)
#define PG8_MMA(ai, bj, At, Bt) do { __builtin_amdgcn_s_setprio(1); mma_block<F8>(acc[ai][bj], At, Bt); __builtin_amdgcn_s_setprio(0); } while (0)
#define PG8_WAIT_V(n) asm volatile("s_waitcnt vmcnt(" #n ")" ::: "memory")
#define PG8_WAIT_L(n) asm volatile("s_waitcnt lgkmcnt(" #n ")" ::: "memory")
#define PG8_BAR __builtin_amdgcn_s_barrier()
#define PG8_SCHED __builtin_amdgcn_sched_barrier(0)
    Unit cur, nxt; int ui = 0;
#if MK_GPROBE
    unsigned long long gp_k = 0, gp_e = 0, gp_t = __builtin_amdgcn_s_memrealtime();
#endif
    if (!S.next(0, cur)) return;
    f32x4 acc[2][2][4][2];
#pragma unroll
    for (int a = 0; a < 2; ++a)
#pragma unroll
        for (int b = 0; b < 2; ++b)
#pragma unroll
            for (int m = 0; m < 4; ++m)
#pragma unroll
                for (int n = 0; n < 2; ++n) acc[a][b][m][n] = (f32x4){0.f, 0.f, 0.f, 0.f};
    bf16x8 At[4][2], B0[2][2], B1[2][2];
    const char* cA = (const char*)g.A + (size_t)cur.pm * tstep; const char* cB = (const char*)g.Bt + (size_t)cur.pn * tstep;
    const char* cA2 = g.A2 ? (const char*)g.A2 + (size_t)cur.pm * tstep : cA; const char* cB2 = g.Bt2 ? (const char*)g.Bt2 + (size_t)cur.pn * tstep : cB;
#define PG8_TA(tt) ((tt) < nh ? cA + (size_t)(tt) * kstep : cA2 + (size_t)((tt) - nh) * kstep)
#define PG8_TB(tt) ((tt) < nh ? cB + (size_t)(tt) * kstep : cB2 + (size_t)((tt) - nh) * kstep)
    S.a_ready(cur);
    if constexpr (SP2) {
        PG8_STAGE(PG8_SB(0, 0), cB, voffB); PG8_STAGE(PG8_SB(0, 1), cB + hstep, voffB); PG8_STAGE(PG8_SA(0, 0), cA, voffA); PG8_STAGE(PG8_SA(0, 1), cA + hstep, voffA);
        if (wr == 1) PG8_BAR;
        PG8_WAIT_V(2); PG8_BAR;
        PG8_STAGE(PG8_SB(1, 0), cB + kstep, voffB); PG8_STAGE(PG8_SA(1, 0), cA + kstep, voffA); PG8_STAGE(PG8_SB(1, 1), cB + hstep + kstep, voffB);
        PG8_WAIT_V(6); PG8_BAR;
    } else {
        PG8_STAGE(PG8_SB(0, 0), cB, voffB); PG8_STAGE(PG8_SA(0, 0), cA, voffA); PG8_STAGE(PG8_SB(0, 1), cB + hstep, voffB); PG8_STAGE(PG8_SA(0, 1), cA + hstep, voffA);
        if (wr == 1) PG8_BAR;
        PG8_WAIT_V(4); PG8_BAR;
        PG8_STAGE(PG8_SB(1, 0), cB + kstep, voffB); PG8_STAGE(PG8_SA(1, 0), cA + kstep, voffA); PG8_STAGE(PG8_SB(1, 1), cB + hstep + kstep, voffB);
        PG8_WAIT_V(6); PG8_BAR;
    }
    for (;;) {
        const bool has_next = S.next(ui + 1, nxt);
        const char* nA = has_next ? (const char*)g.A + (size_t)nxt.pm * tstep : cA; const char* nB = has_next ? (const char*)g.Bt + (size_t)nxt.pn * tstep : cB;
#pragma clang loop unroll(disable)
        for (int t = 0; t < nt; t += 2) {
            const bool last = (t == nt - 2);
            const char* a1 = PG8_TA(t + 1);
            const char* a2 = last ? nA : PG8_TA(t + 2); const char* b2 = last ? nB : PG8_TB(t + 2);
            const char* a3 = last ? nA + kstep : PG8_TA(t + 3); const char* b3 = last ? nB + kstep : PG8_TB(t + 3);
            if constexpr (Epi::HAS_MID) { if (t == nh) { if constexpr (F8) asm volatile("s_nop 15\n\ts_nop 15" ::: "memory"); E.mid(acc, cur, wr, wc, fr, fq); } }
            if (last && has_next) S.a_ready(nxt);
            if constexpr (SP2) {
            PG8_LDB(B0, 0, 0); PG8_LDB(B1, 0, 1); PG8_SCHED; PG8_LDA(At, 0, 0); PG8_STAGE(PG8_SA(1, 1), a1 + hstep, voffA);
            PG8_WAIT_V(8); PG8_WAIT_L(0); PG8_BAR; PG8_MMA(0, 0, At, B0); PG8_MMA(0, 1, At, B1); PG8_BAR; PG8_SCHED;
            PG8_LDA(At, 0, 1); PG8_STAGE(PG8_SB(0, 0), b2, voffB); PG8_STAGE(PG8_SB(0, 1), b2 + hstep, voffB); PG8_STAGE(PG8_SA(0, 0), a2, voffA);
            PG8_WAIT_V(8); PG8_WAIT_L(0); PG8_BAR; PG8_MMA(1, 0, At, B0); PG8_MMA(1, 1, At, B1); PG8_BAR; PG8_SCHED;
            PG8_LDB(B0, 1, 0); PG8_LDB(B1, 1, 1); PG8_SCHED; PG8_LDA(At, 1, 0); PG8_STAGE(PG8_SA(0, 1), a2 + hstep, voffA);
            PG8_WAIT_V(8); PG8_WAIT_L(0); PG8_BAR; PG8_MMA(0, 0, At, B0); PG8_MMA(0, 1, At, B1); PG8_BAR; PG8_SCHED;
            PG8_LDA(At, 1, 1); PG8_STAGE(PG8_SB(1, 0), b3, voffB); PG8_STAGE(PG8_SB(1, 1), b3 + hstep, voffB); PG8_STAGE(PG8_SA(1, 0), a3, voffA);
            PG8_WAIT_V(8); PG8_WAIT_L(0); PG8_BAR; PG8_MMA(1, 0, At, B0); PG8_MMA(1, 1, At, B1); PG8_BAR; PG8_SCHED;
            } else {
            PG8_LDB(B0, 0, 0); PG8_SCHED; PG8_LDA(At, 0, 0); PG8_STAGE(PG8_SA(1, 1), a1 + hstep, voffA);
            PG8_WAIT_L(8); PG8_BAR; PG8_WAIT_L(0); PG8_MMA(0, 0, At, B0); PG8_BAR; PG8_SCHED;
            PG8_LDB(B1, 0, 1); PG8_STAGE(PG8_SB(0, 0), b2, voffB);
            PG8_BAR; PG8_WAIT_L(0); PG8_MMA(0, 1, At, B1); PG8_BAR;
            PG8_LDA(At, 0, 1); PG8_STAGE(PG8_SA(0, 0), a2, voffA);
            PG8_BAR; PG8_WAIT_L(0); PG8_MMA(1, 0, At, B0); PG8_BAR; PG8_SCHED;
            PG8_STAGE(PG8_SB(0, 1), b2 + hstep, voffB);
            PG8_WAIT_V(6); PG8_BAR; PG8_MMA(1, 1, At, B1); PG8_BAR;
            PG8_LDB(B0, 1, 0); PG8_SCHED; PG8_LDA(At, 1, 0); PG8_STAGE(PG8_SA(0, 1), a2 + hstep, voffA);
            PG8_WAIT_L(8); PG8_BAR; PG8_WAIT_L(0); PG8_MMA(0, 0, At, B0); PG8_BAR; PG8_SCHED;
            PG8_LDB(B1, 1, 1); PG8_STAGE(PG8_SB(1, 0), b3, voffB);
            PG8_BAR; PG8_WAIT_L(0); PG8_MMA(0, 1, At, B1); PG8_BAR;
            PG8_LDA(At, 1, 1); PG8_STAGE(PG8_SA(1, 0), a3, voffA);
            PG8_BAR; PG8_WAIT_L(0); PG8_MMA(1, 0, At, B0); PG8_BAR; PG8_SCHED;
            PG8_STAGE(PG8_SB(1, 1), b3 + hstep, voffB);
            PG8_WAIT_V(6); PG8_BAR; PG8_MMA(1, 1, At, B1); PG8_BAR;
            }
        }
#if MK_GPROBE
        { const unsigned long long t_ = __builtin_amdgcn_s_memrealtime(); gp_k += t_ - gp_t; gp_t = t_; }
#endif
        if constexpr (F8) asm volatile("s_nop 15\n\ts_nop 15" ::: "memory");
        if constexpr (ALIGN_EPI) { if (wr == 0) PG8_BAR; }
        if constexpr (!Epi::AFTER_DRAIN) { E(acc, cur, wr, wc, fr, fq); S.done(cur); }
#if MK_GPROBE
        { asm volatile("s_waitcnt vmcnt(0)" ::: "memory"); const unsigned long long t_ = __builtin_amdgcn_s_memrealtime(); gp_e += t_ - gp_t; gp_t = t_; }
#endif
        if (!has_next) break;
#pragma unroll
        for (int a = 0; a < 2; ++a)
#pragma unroll
            for (int b = 0; b < 2; ++b)
#pragma unroll
                for (int m = 0; m < 4; ++m)
#pragma unroll
                    for (int n = 0; n < 2; ++n) acc[a][b][m][n] = (f32x4){0.f, 0.f, 0.f, 0.f};
        cur = nxt; cA = nA; cB = nB; ++ui;
        cA2 = g.A2 ? (const char*)g.A2 + (size_t)cur.pm * tstep : cA; cB2 = g.Bt2 ? (const char*)g.Bt2 + (size_t)cur.pn * tstep : cB;
        if constexpr (ALIGN_EPI) { if (wr == 1) PG8_BAR; }
    }
    PG8_WAIT_V(0);
    if constexpr (!ALIGN_EPI) { if (wr == 0) PG8_BAR; }
    PG8_BAR;
    if constexpr (Epi::AFTER_DRAIN) { E.fused(acc, cur, wr, wc, fr, fq, lds, wid, lane); S.done(cur); }
#if MK_GPROBE
    if (blockIdx.x == 0 && wid == 0 && lane == 0) { PG8_LAS unsigned* mq = (PG8_LAS unsigned*)(lds + MK_MISC_OFF); mq[56] += (unsigned)gp_k; mq[57] += (unsigned)gp_e; }
#endif
#undef PG8_SA
#undef PG8_SB
#undef PG8_TA
#undef PG8_TB
#undef PG8_STAGE
#undef PG8_LDA
#undef PG8_LDB
#undef PG8_MMA
#undef PG8_WAIT_V
#undef PG8_WAIT_L
#undef PG8_BAR
#undef PG8_SCHED
}
}

constexpr int NWAVES = 8;
constexpr int N_LAUNCHES = MK_N_LAUNCHES;
constexpr int N_PHASES = 16;
constexpr int NB = 8, SEQ = 4096, DM = 1024, MT = NB * SEQ, NIN = 7168;
constexpr float EPSN = 1e-6f;

constexpr size_t MiB = 1u << 20;
constexpr size_t WS_CTL = 0, CTL_ZERO_BYTES = 1 * MiB;
constexpr size_t WS_SVSTAT = 512 * 1024;
constexpr size_t WS_MOD = 1 * MiB;
constexpr size_t WS_COS = 2 * MiB, WS_SIN = 3 * MiB;
constexpr size_t WS_SK = 4 * MiB;
constexpr size_t WS_SGUW = 4 * MiB + 512 * 1024;
constexpr size_t WS_WRET = 6 * MiB, WS_WSGU = 8 * MiB, WS_WOUT = 10 * MiB, WS_WQ = 12 * MiB, WS_WIN = 16 * MiB;
constexpr size_t WS_UE8 = 32 * MiB, WS_VE8 = 48 * MiB;
constexpr size_t WS_YG8 = 288 * MiB;
constexpr size_t WS_YS8 = 480 * MiB;
constexpr size_t WS_MRG8 = 96 * MiB;
constexpr size_t WS_ACT = 288 * MiB;
constexpr size_t WS_PEERS = 352 * MiB;
constexpr size_t WS_H2F8 = 96 * MiB;
constexpr size_t WS_EID = 128 * MiB, WS_GW = 144 * MiB;
constexpr size_t WS_PD = 160 * MiB;
constexpr size_t WS_V = 96 * MiB;
constexpr size_t WS_G = 160 * MiB;
constexpr size_t WS_X1B = 224 * MiB;
constexpr size_t WS_U = 224 * MiB;
constexpr size_t WS_SV = 288 * MiB;
constexpr size_t WS_GA = 352 * MiB, WS_GB = 416 * MiB;
constexpr size_t WS_SUB = 480 * MiB;
constexpr size_t WS_END = 512 * MiB;
constexpr size_t DO_H = 0, DO_Q = 64 * MiB, DO_K = 96 * MiB, DO_KVS = 0;

constexpr int CW_BAR = 4096;
constexpr int LDS_BYTES = 147456;
constexpr int MISC_OFF = LDS_BYTES - 256;

#define GAS __attribute__((address_space(1)))
#define LAS __attribute__((address_space(3)))
typedef unsigned short bf16;
typedef unsigned v4u __attribute__((ext_vector_type(4)));
typedef unsigned v2u __attribute__((ext_vector_type(2)));
typedef float f32x4 __attribute__((ext_vector_type(4)));
typedef float f32x2v __attribute__((ext_vector_type(2)));
typedef short bf16x8 __attribute__((ext_vector_type(8)));
typedef short s16x4 __attribute__((ext_vector_type(4)));
typedef __bf16 bf16x2_t __attribute__((ext_vector_type(2)));
typedef GAS unsigned gu32;
#define RLX_AGENT __ATOMIC_RELAXED, __HIP_MEMORY_SCOPE_AGENT
#define LDS_WAIT() asm volatile("s_waitcnt lgkmcnt(0)" ::: "memory")
using pg8::bflo; using pg8::bfhi; using pg8::gelu1;
__device__ __forceinline__ unsigned pk2(float lo, float hi) { f32x2v v = {lo, hi}; bf16x2_t b = __builtin_convertvector(v, bf16x2_t); return __builtin_bit_cast(unsigned, b); }
template <int CTRL> __device__ __forceinline__ float dpp_f(float v) { return __int_as_float(__builtin_amdgcn_update_dpp(0, __float_as_int(v), CTRL, 0xF, 0xF, false)); }
__device__ __forceinline__ float wave_sum(float v) {
    v += dpp_f<0xB1>(v); v += dpp_f<0x4E>(v); v += dpp_f<0x141>(v); v += dpp_f<0x140>(v);
    const int vi = __float_as_int(v);
    return (__int_as_float(__builtin_amdgcn_readlane(vi, 0)) + __int_as_float(__builtin_amdgcn_readlane(vi, 16))) + (__int_as_float(__builtin_amdgcn_readlane(vi, 32)) + __int_as_float(__builtin_amdgcn_readlane(vi, 48)));
}
__device__ __forceinline__ float fexp2(float x) { return __builtin_amdgcn_exp2f(x); }
__device__ __forceinline__ float clamp_f8(float x) { return __builtin_amdgcn_fmed3f(x, -448.0f, 448.0f); }
__device__ __forceinline__ unsigned pk4_fp8(float a, float b, float c, float d) { int w = __builtin_amdgcn_cvt_pk_fp8_f32(clamp_f8(a), clamp_f8(b), 0, false); w = __builtin_amdgcn_cvt_pk_fp8_f32(clamp_f8(c), clamp_f8(d), w, true); return (unsigned)w; }
__device__ __forceinline__ float rl_f(float v, int l) { return __int_as_float(__builtin_amdgcn_readlane(__float_as_int(v), l)); }
__device__ __forceinline__ unsigned rl_u(unsigned v, int l) { return (unsigned)__builtin_amdgcn_readlane((int)v, l); }

#define XB_TMO      128
#define XB_XCNT(j)  (256  + 64 * (j))
#define XB_XSUB(j)  (1280 + 64 * (j))
#define XB_XGEN(j)  (2304 + 64 * (j))
#define XB_TOP      3328
#define XB_TOPGEN   3392
#define XCD_BAR_WORDS 3456
#define XB_SPIN_CAP (1u << 22)
__device__ __forceinline__ unsigned xb_ld(unsigned* p)              { return __hip_atomic_load(p, __ATOMIC_RELAXED, __HIP_MEMORY_SCOPE_AGENT); }
__device__ __forceinline__ unsigned xb_add(unsigned* p, unsigned v) { return __hip_atomic_fetch_add(p, v, __ATOMIC_RELAXED, __HIP_MEMORY_SCOPE_AGENT); }
__device__ __forceinline__ unsigned xb_xcc_id() { return (unsigned)__builtin_amdgcn_s_getreg((3 << 11) | 20) & 0xFu; }
#define XB_SPIN(cond, bar) do { unsigned _sp = 0; while (cond) { __builtin_amdgcn_s_sleep(1); \
    if ((++_sp & 255u) == 0u) { if (xb_ld(&(bar)[XB_TMO])) break; if (_sp > XB_SPIN_CAP) { atomicAdd(&(bar)[XB_TMO], 1u); break; } } } } while (0)
struct XcdBarrier { unsigned* bar; unsigned x; volatile LAS unsigned* st; };
__device__ __forceinline__ XcdBarrier xcd_barrier_post(unsigned* bar, volatile LAS unsigned* st) {
    XcdBarrier b; b.bar = bar; b.x = xb_xcc_id(); b.st = st;
    if (threadIdx.x == 0) (void)xb_add(&bar[XB_XCNT(b.x)], 1u);
    return b;
}
__device__ __forceinline__ void xcd_barrier_complete(unsigned* bar, unsigned x, unsigned& nloc, unsigned& nx) {
    const unsigned G = gridDim.x * gridDim.y * gridDim.z;
    unsigned sum, cnt, mine, sp = 0u;
    for (;;) {
        sum = 0u; cnt = 0u; mine = 0u;
#pragma unroll
        for (unsigned j = 0; j < 16; ++j) { const unsigned c = xb_ld(&bar[XB_XCNT(j)]); sum += c; cnt += (c > 0u) ? 1u : 0u; mine = (j == x) ? c : mine; }
        if (sum == G) break;
        __builtin_amdgcn_s_sleep(1);
        if ((++sp & 255u) == 0u) { if (xb_ld(&bar[XB_TMO])) break; if (sp > XB_SPIN_CAP) { atomicAdd(&bar[XB_TMO], 1u); break; } }
    }
    nloc = mine > 0u ? mine : 1u; nx = cnt > 0u ? cnt : 1u;
}
__device__ __forceinline__ void xcd_barrier(const XcdBarrier& b) {
    asm volatile("s_waitcnt vmcnt(0)" ::: "memory");
    __syncthreads();
    if (threadIdx.x == 0) {
        unsigned* bar = b.bar;
        __builtin_amdgcn_s_waitcnt(0);
        unsigned nloc = b.st[0], nx = b.st[1];
        if (nloc == 0u) { xcd_barrier_complete(bar, b.x, nloc, nx); b.st[0] = nloc; b.st[1] = nx; }
        const unsigned old = xb_add(&bar[XB_XSUB(b.x)], 1u);
        const unsigned gen = old / nloc;
        if (old + 1u == (gen + 1u) * nloc) {
            __builtin_amdgcn_fence(__ATOMIC_RELEASE, "agent");
            asm volatile("s_waitcnt vmcnt(0)" ::: "memory");
            const unsigned og = xb_add(&bar[XB_TOP], 1u);
            const unsigned tg = og / nx;
            if (og + 1u == (tg + 1u) * nx) xb_add(&bar[XB_TOPGEN], 1u);
            else XB_SPIN(xb_ld(&bar[XB_TOPGEN]) == tg, bar);
            __builtin_amdgcn_fence(__ATOMIC_ACQUIRE, "agent");
            xb_add(&bar[XB_XGEN(b.x)], 1u);
            asm volatile("s_waitcnt vmcnt(0)" ::: "memory");
        } else {
            XB_SPIN(xb_ld(&bar[XB_XGEN(b.x)]) == gen, bar);
            __builtin_amdgcn_fence(__ATOMIC_ACQUIRE, "agent");
            asm volatile("s_waitcnt vmcnt(0)" ::: "memory");
        }
    }
    __syncthreads();
}

struct Frame {
    LAS unsigned char* lds;
    int tid, lane, wave, G, bid; volatile LAS unsigned* misc;
    __device__ __forceinline__ void fence_ids() { int t = threadIdx.x; asm volatile("" : "+v"(t)); tid = t; lane = t & 63; }
    const float *x, *c, *w_ada, *b_ada, *norm1_g, *w_in, *ret_gn_g, *sgu_ln_g, *sgu_ln_b, *sgu_w, *sgu_b, *w_ret_out, *w_sgu_out, *w_out, *norm2_g, *peer_w_q, *peer_sub_keys, *peer_u, *peer_v, *final_g;
    unsigned char* ws; unsigned char* dout;
};

__device__ __forceinline__ bf16x8 lds_row_frag(LAS const unsigned char* img, int stride, int r0, int k0, int lane) {
    return *(LAS const bf16x8*)(img + (r0 + (lane & 15)) * stride + (k0 + 8 * (lane >> 4)) * 2);
}
__device__ __forceinline__ s16x4 tr16(LAS const unsigned char* p) { return __builtin_bit_cast(s16x4, __builtin_amdgcn_ds_read_tr16_b64_v4i16((LAS s16x4*)p)); }
__device__ __forceinline__ bf16x8 lds_tr_frag(LAS const unsigned char* img, int stride, int k0, int n0, int lane) {
    const int g = lane >> 4, q = (lane >> 2) & 3, p = lane & 3;
    LAS const unsigned char* a = img + (k0 + 8 * g + q) * stride + (n0 + 4 * p) * 2;
    const s16x4 lo = tr16(a), hi = tr16(a + 4 * stride);
    return __builtin_shufflevector(lo, hi, 0, 1, 2, 3, 4, 5, 6, 7);
}
#define MFMA16(a, b, c) __builtin_amdgcn_mfma_f32_16x16x32_bf16((a), (b), (c), 0, 0, 0)
constexpr int KS = 272, VS = 528;

template <bool F8, class Map>
__device__ __forceinline__ void transpose_item(const float* W, int K, int N, bf16* WT, LAS float* scr, int item, int lane, Map srcmap) {
    const int nblk = N / 32, kb = item / nblk, nb = item % nblk, k0 = 64 * kb, n0 = 32 * nb;
    const int sc = srcmap(n0 + (lane & 31));
#pragma unroll 8
    for (int i = 0; i < 32; ++i) { const int kk = 2 * i + (lane >> 5); scr[kk * 33 + (lane & 31)] = W[(size_t)(k0 + kk) * N + sc]; }
    LDS_WAIT(); asm volatile("" ::: "memory");
    const int c = lane & 7;
#pragma unroll
    for (int j = 0; j < 4; ++j) { const int n = (lane >> 3) + 8 * j; const LAS float* s = scr + (8 * c) * 33 + n;
        if (F8) { v2u o8; o8.x = pk4_fp8(s[0 * 33] * 512.f, s[1 * 33] * 512.f, s[2 * 33] * 512.f, s[3 * 33] * 512.f); o8.y = pk4_fp8(s[4 * 33] * 512.f, s[5 * 33] * 512.f, s[6 * 33] * 512.f, s[7 * 33] * 512.f);
            *(v2u*)((unsigned char*)WT + (size_t)(n0 + n) * K + k0 + 8 * c) = o8; }
        else { v4u o; o.x = pk2(s[0 * 33], s[1 * 33]); o.y = pk2(s[2 * 33], s[3 * 33]); o.z = pk2(s[4 * 33], s[5 * 33]); o.w = pk2(s[6 * 33], s[7 * 33]);
            *(v4u*)(WT + (size_t)(n0 + n) * K + k0 + 8 * c) = o; } }
    LDS_WAIT(); asm volatile("" ::: "memory");
}
struct MapId { __device__ __forceinline__ int operator()(int n) const { return n; } };
struct MapWin { __device__ __forceinline__ int operator()(int n) const { if (n >= 1024) return n; const int ci = n & 127; return (n & ~127) + (ci >> 1) + 64 * (ci & 1); } };

__device__ __forceinline__ void cvt8(const float* src, bf16* dst, size_t chunk) {
    const f32x4 a = *(const f32x4*)(src + chunk * 8), b = *(const f32x4*)(src + chunk * 8 + 4);
    v4u o; o.x = pk2(a[0], a[1]); o.y = pk2(a[2], a[3]); o.z = pk2(b[0], b[1]); o.w = pk2(b[2], b[3]);
    *(v4u*)(dst + chunk * 8) = o;
}

__device__ __forceinline__ void p0a(Frame& F) { F.fence_ids();
    if (F.bid < 192) {
        LAS float* sc = (LAS float*)F.lds; LAS float* part = (LAS float*)(F.lds + 32768);
        for (int i = F.tid; i < 8192; i += 512) { const float cv = F.c[i]; sc[i] = pg8::silu1(cv); }
        __syncthreads();
        const int n0 = 32 * F.bid, ks = F.tid >> 3, c4 = F.tid & 7;
        f32x4 acc[8];
#pragma unroll
        for (int b = 0; b < 8; ++b) acc[b] = (f32x4){0.f, 0.f, 0.f, 0.f};
        for (int kk = ks; kk < 1024; kk += 64) { const f32x4 w = *(const f32x4*)(F.w_ada + (size_t)kk * 6144 + n0 + 4 * c4);
#pragma unroll
            for (int b = 0; b < 8; ++b) acc[b] += w * sc[b * 1024 + kk]; }
#pragma unroll
        for (int b = 0; b < 8; ++b) *(LAS f32x4*)(part + (ks * 8 + b) * 32 + 4 * c4) = acc[b];
        __syncthreads();
        if (F.tid < 256) { const int b = F.tid >> 5, col = F.tid & 31; float s = 0.f;
            for (int k2 = 0; k2 < 64; ++k2) s += part[(k2 * 8 + b) * 32 + col];
            ((float*)(F.ws + WS_MOD))[b * 6144 + n0 + col] = s + F.b_ada[n0 + col]; }
        __syncthreads();
    }
    {
        LAS float* scr = (LAS float*)(F.lds + F.wave * 16384);
        const int gw = F.bid * NWAVES + F.wave, NGW = F.G * NWAVES;
        constexpr int I_IN = 16 * (NIN / 32), I_SQ = 16 * 32, I_Q = 16 * 64, NITEMS = I_IN + 3 * I_SQ + I_Q;
        for (int it = gw; it < NITEMS; it += NGW) {
            int r = it;
            if (r < I_IN) { transpose_item<true>(F.w_in, 1024, NIN, (bf16*)(F.ws + WS_WIN), scr, r, F.lane, MapWin()); continue; } r -= I_IN;
            if (r < I_SQ) { transpose_item<true>(F.w_ret_out, 1024, 1024, (bf16*)(F.ws + WS_WRET), scr, r, F.lane, MapId()); continue; } r -= I_SQ;
            if (r < I_SQ) { transpose_item<true>(F.w_sgu_out, 1024, 1024, (bf16*)(F.ws + WS_WSGU), scr, r, F.lane, MapId()); continue; } r -= I_SQ;
            if (r < I_SQ) { transpose_item<true>(F.w_out, 1024, 1024, (bf16*)(F.ws + WS_WOUT), scr, r, F.lane, MapId()); continue; } r -= I_SQ;
            transpose_item<false>(F.peer_w_q, 1024, 2048, (bf16*)(F.ws + WS_WQ), scr, r, F.lane, MapId());
        }
    }
    const size_t gt = (size_t)F.bid * 512 + F.tid, NT = (size_t)F.G * 512;
    for (size_t ch = gt; ch < (size_t)16384 * 64; ch += NT) {
        const f32x4* up = (const f32x4*)(F.peer_u + ch * 16); const f32x4* vp = (const f32x4*)(F.peer_v + ch * 16);
        v4u ou, ov;
#pragma unroll
        for (int q = 0; q < 4; ++q) { const f32x4 a = up[q] * 512.0f, b = vp[q] * 16.0f; ou[q] = pk4_fp8(a[0], a[1], a[2], a[3]); ov[q] = pk4_fp8(b[0], b[1], b[2], b[3]); }
        const size_t e_ = ch >> 6, c16_ = ch & 63, dst_ = (c16_ >> 3) * ((size_t)16384 * 128) + e_ * 128 + (c16_ & 7) * 16;
        *(v4u*)(F.ws + WS_VE8 + dst_) = ov;
        if (MK_U4) {
            v2u o4; unsigned w0 = 0u, w1 = 0u;
            { const f32x4 a0 = up[0] * 64.0f, a1 = up[1] * 64.0f, a2 = up[2] * 64.0f, a3 = up[3] * 64.0f;
              w0 = __builtin_amdgcn_cvt_scalef32_pk_fp4_f32(w0, a0[0], a0[1], 1.0f, 0); w0 = __builtin_amdgcn_cvt_scalef32_pk_fp4_f32(w0, a0[2], a0[3], 1.0f, 1);
              w0 = __builtin_amdgcn_cvt_scalef32_pk_fp4_f32(w0, a1[0], a1[1], 1.0f, 2); w0 = __builtin_amdgcn_cvt_scalef32_pk_fp4_f32(w0, a1[2], a1[3], 1.0f, 3);
              w1 = __builtin_amdgcn_cvt_scalef32_pk_fp4_f32(w1, a2[0], a2[1], 1.0f, 0); w1 = __builtin_amdgcn_cvt_scalef32_pk_fp4_f32(w1, a2[2], a2[3], 1.0f, 1);
              w1 = __builtin_amdgcn_cvt_scalef32_pk_fp4_f32(w1, a3[0], a3[1], 1.0f, 2); w1 = __builtin_amdgcn_cvt_scalef32_pk_fp4_f32(w1, a3[2], a3[3], 1.0f, 3); }
            o4.x = w0; o4.y = w1;
            *(v2u*)(F.ws + WS_UE8 + (c16_ >> 4) * ((size_t)16384 * 128) + e_ * 128 + (c16_ & 15) * 8) = o4;
        } else *(v4u*)(F.ws + WS_UE8 + dst_) = ou; }
    for (size_t ch = gt; ch < (size_t)32768; ch += NT) cvt8(F.peer_sub_keys, (bf16*)(F.ws + WS_SK), ch);
    for (size_t ch = gt; ch < (size_t)8192; ch += NT) { const int t = (int)(ch >> 4) & 127, s0 = (int)(ch & 15) * 8;
        const f32x4 a = *(const f32x4*)(F.sgu_w + ch * 8), b = *(const f32x4*)(F.sgu_w + ch * 8 + 4);
        float v[8] = {a[0], a[1], a[2], a[3], b[0], b[1], b[2], b[3]};
#pragma unroll
        for (int e = 0; e < 8; ++e) v[e] = (s0 + e <= t) ? v[e] : 0.f;
        v4u o; o.x = pk2(v[0], v[1]); o.y = pk2(v[2], v[3]); o.z = pk2(v[4], v[5]); o.w = pk2(v[6], v[7]);
        *(v4u*)((bf16*)(F.ws + WS_SGUW) + ch * 8) = o; }
    for (size_t e = gt; e < (size_t)4096 * 64; e += NT) { const int s = (int)(e >> 6), i = (int)(e & 63);
        const float inv = fexp2(-(float)i * (13.287712379549449f / 64.0f));
        const float rev = ((float)s * inv) * 0.15915494309189535f; const float fr = rev - __builtin_floorf(rev);
        ((float*)(F.ws + WS_COS))[e] = __builtin_amdgcn_cosf(fr); ((float*)(F.ws + WS_SIN))[e] = __builtin_amdgcn_sinf(fr); }
}

template <int MODE  > __device__ __forceinline__ void norm_rows(Frame& F, const float* X, const float* gain, const float* shift, const float* scale, bf16* O, unsigned char* O8) { F.fence_ids();
    const int gw = F.bid * NWAVES + F.wave, NGW = F.G * NWAVES;
    f32x4 g[4];
#pragma unroll
    for (int j = 0; j < 4; ++j) g[j] = *(const f32x4*)(gain + 4 * F.lane + 256 * j);
    f32x4 nx[4];
#define NR_LOAD(mm_) do { _Pragma("unroll") for (int j = 0; j < 4; ++j) { if (MODE == 1) { const v2u w_ = *((const v2u*)((const bf16*)X + (size_t)(mm_) * DM) + F.lane + 64 * j); nx[j] = (f32x4){bflo(w_.x), bfhi(w_.x), bflo(w_.y), bfhi(w_.y)}; } \
        else nx[j] = *((const f32x4*)(X + (size_t)(mm_) * DM) + F.lane + 64 * j); } } while (0)
    if (gw < MT) NR_LOAD(gw);
    for (int m = gw; m < MT; m += NGW) {
        f32x4 v[4]; float s = 0.f;
#pragma unroll
        for (int j = 0; j < 4; ++j) { v[j] = nx[j]; s += (v[j][0] * v[j][0] + v[j][1] * v[j][1]) + (v[j][2] * v[j][2] + v[j][3] * v[j][3]); }
        const int b = m >> 12;
        f32x4 sh[4], sc[4];
#pragma unroll
        for (int j = 0; j < 4; ++j) { const int d = 4 * F.lane + 256 * j; sh[j] = *(const f32x4*)(shift + b * 6144 + d); sc[j] = *(const f32x4*)(scale + b * 6144 + d); }
        if (m + NGW < MT) NR_LOAD(m + NGW);
        const float rstd = __builtin_amdgcn_rsqf(wave_sum(s) * (1.f / DM) + EPSN);
        v2u* o8 = (v2u*)(O + (size_t)m * DM) + F.lane;
#pragma unroll
        for (int j = 0; j < 4; ++j) { const int d = 4 * F.lane + 256 * j;
            const f32x4 h = v[j] * rstd * g[j] * (sc[j] + 1.0f) + sh[j];
            if (MODE == 2) { const f32x4 h8 = h * 8.0f; *(unsigned*)(O8 + (size_t)m * DM + d) = pk4_fp8(h8[0], h8[1], h8[2], h8[3]); }
            else { v2u w; w.x = pk2(h[0], h[1]); w.y = pk2(h[2], h[3]); o8[64 * j] = w; }
            if (MODE == 1) { const f32x4 hs = h * 16.0f; *(unsigned*)(O8 + (size_t)(d >> 8) * ((size_t)MT * 256) + (size_t)m * 256 + (d & 255)) = pk4_fp8(hs[0], hs[1], hs[2], hs[3]); } }
    }
}

__device__ __forceinline__ float lg_gamma(int h) { return __builtin_log2f(1.0f - fexp2((float)(-5 - h))); }
__device__ __forceinline__ v4u scale8(v4u w, float s) {
    v4u o; o.x = pk2(bflo(w.x) * s, bfhi(w.x) * s); o.y = pk2(bflo(w.y) * s, bfhi(w.y) * s); o.z = pk2(bflo(w.z) * s, bfhi(w.z) * s); o.w = pk2(bflo(w.w) * s, bfhi(w.w) * s); return o;
}
struct KvRegs { v4u k[4], v[8]; };
__device__ __forceinline__ void kv_load(Frame& F, int u, KvRegs& R) {
    const int b = u >> 7, h = (u >> 5) & 3, c = u & 31; const size_t tok0 = (size_t)b * SEQ + c * 128;
    const bf16* Kb = (const bf16*)(F.dout + DO_K); const bf16* Vb = (const bf16*)(F.ws + WS_V);
#pragma unroll
    for (int i = 0; i < 4; ++i) { const int ch = F.tid + 512 * i, j = ch >> 4, cc = ch & 15; R.k[i] = *(const v4u*)(Kb + (tok0 + j) * 512 + h * 128 + cc * 8); }
#pragma unroll
    for (int i = 0; i < 8; ++i) { const int ch = F.tid + 512 * i, j = ch >> 5, cc = ch & 31; R.v[i] = *(const v4u*)(Vb + (tok0 + j) * 1024 + h * 256 + cc * 8); }
}
__device__ __forceinline__ void kv_unit(Frame& F, int u, KvRegs& R, int unext) {
    const int b = u >> 7, h = (u >> 5) & 3, c = u & 31;
    LAS unsigned char* Kimg = F.lds; LAS unsigned char* Vimg = F.lds + 34816;
    const float lg = lg_gamma(h);
#pragma unroll
    for (int i = 0; i < 4; ++i) { const int ch = F.tid + 512 * i, j = ch >> 4, cc = ch & 15;
        *(LAS v4u*)(Kimg + j * KS + cc * 16) = scale8(R.k[i], fexp2((float)(127 - j) * lg)); }
#pragma unroll
    for (int i = 0; i < 8; ++i) { const int ch = F.tid + 512 * i, j = ch >> 5, cc = ch & 31; *(LAS v4u*)(Vimg + j * VS + cc * 16) = R.v[i]; }
    __syncthreads();
    if (unext >= 0) kv_load(F, unext, R);
    f32x4 acc[8][2];
#pragma unroll
    for (int dt = 0; dt < 8; ++dt) { acc[dt][0] = (f32x4){0.f, 0.f, 0.f, 0.f}; acc[dt][1] = (f32x4){0.f, 0.f, 0.f, 0.f}; }
#pragma unroll
    for (int js = 0; js < 4; ++js) {
        bf16x8 bv[2];
#pragma unroll
        for (int vt = 0; vt < 2; ++vt) bv[vt] = lds_tr_frag(Vimg, VS, 32 * js, 32 * F.wave + 16 * vt, F.lane);
#pragma unroll
        for (int dt = 0; dt < 8; ++dt) { const bf16x8 a = lds_tr_frag(Kimg, KS, 32 * js, 16 * dt, F.lane);
            acc[dt][0] = MFMA16(a, bv[0], acc[dt][0]); acc[dt][1] = MFMA16(a, bv[1], acc[dt][1]); }
    }
    bf16* dst = (bf16*)(F.dout + DO_KVS) + (size_t)(((b * 4 + h) * 32 + c)) * 32768;
#pragma unroll
    for (int dt = 0; dt < 8; ++dt)
#pragma unroll
        for (int vt = 0; vt < 2; ++vt) { const int v = 32 * F.wave + 16 * vt + (F.lane & 15), d0 = 16 * dt + 4 * (F.lane >> 4);
            v2u o; o.x = pk2(acc[dt][vt][0], acc[dt][vt][1]); o.y = pk2(acc[dt][vt][2], acc[dt][vt][3]);
            *(v2u*)(dst + v * 128 + d0) = o; }
    __syncthreads();
}
struct SguRegs { v2u sv[8]; f32x2v st[8]; };
__device__ __forceinline__ void sgu_load(Frame& F, int su, SguRegs& R) {
    const size_t tok0 = (size_t)(su >> 2) * 128; const int g = su & 3; const unsigned char* SVb = F.ws + WS_SV; const float* stat = (const float*)(F.ws + WS_SVSTAT);
    int tq = F.tid; asm volatile("" : "+v"(tq));
#pragma unroll
    for (int i = 0; i < 8; ++i) { const int ch = tq + 512 * i, sr = ch >> 5, cc = ch & 31;
        R.sv[i] = *(const v2u*)(SVb + (tok0 + sr) * 1024 + g * 256 + cc * 8); R.st[i] = *(const f32x2v*)(stat + (tok0 + sr) * 2); }
}
__device__ __forceinline__ void sgu_unit(Frame& F, int su, SguRegs& R, int snext, int& cur_g) {
    const size_t tok0 = (size_t)(su >> 2) * 128; const int g = su & 3;
    LAS unsigned char* Vn = F.lds; LAS unsigned char* Wimg = F.lds + 67584;
    const unsigned char* Ub = F.ws + WS_U; const bf16* Wm = (const bf16*)(F.ws + WS_SGUW);
    { const int cc = F.tid & 31; const int col = g * 256 + cc * 8;
        const f32x4 g0 = *(const f32x4*)(F.sgu_ln_g + col), g1 = *(const f32x4*)(F.sgu_ln_g + col + 4), b0 = *(const f32x4*)(F.sgu_ln_b + col), b1 = *(const f32x4*)(F.sgu_ln_b + col + 4);
#pragma unroll
        for (int i = 0; i < 8; ++i) { const int ch = F.tid + 512 * i, sr = ch >> 5; const f32x4 w0 = pg8::f8x4(R.sv[i].x) * 0.0625f, w1 = pg8::f8x4(R.sv[i].y) * 0.0625f;
            const float mean = R.st[i].x * (1.f / 1024.f), var = R.st[i].y * (1.f / 1024.f) - mean * mean, rstd = __builtin_amdgcn_rsqf(var + EPSN);
            v4u o;
            o.x = pk2((w0[0] - mean) * rstd * g0[0] + b0[0], (w0[1] - mean) * rstd * g0[1] + b0[1]);
            o.y = pk2((w0[2] - mean) * rstd * g0[2] + b0[2], (w0[3] - mean) * rstd * g0[3] + b0[3]);
            o.z = pk2((w1[0] - mean) * rstd * g1[0] + b1[0], (w1[1] - mean) * rstd * g1[1] + b1[1]);
            o.w = pk2((w1[2] - mean) * rstd * g1[2] + b1[2], (w1[3] - mean) * rstd * g1[3] + b1[3]);
            *(LAS v4u*)(Vn + sr * VS + cc * 16) = o; } }
    if (g != cur_g) { cur_g = g;
#pragma unroll
        for (int i = 0; i < 4; ++i) { const int ch = F.tid + 512 * i, t = ch >> 4, cc = ch & 15;
            *(LAS v4u*)(Wimg + t * KS + cc * 16) = *(const v4u*)(Wm + (size_t)(g * 128 + t) * 128 + cc * 8); } }
    __syncthreads();
    if (snext >= 0) sgu_load(F, snext, R);
    unsigned uv[8][2];
#pragma unroll
    for (int tt = 0; tt < 8; ++tt)
#pragma unroll
        for (int ct = 0; ct < 2; ++ct) uv[tt][ct] = *(const unsigned*)(Ub + (tok0 + 16 * tt + (F.lane & 15)) * 1024 + g * 256 + 32 * F.wave + 16 * ct + 4 * (F.lane >> 4));
    f32x4 acc[2][8];
#pragma unroll
    for (int ct = 0; ct < 2; ++ct)
#pragma unroll
        for (int tt = 0; tt < 8; ++tt) acc[ct][tt] = (f32x4){0.f, 0.f, 0.f, 0.f};
#pragma unroll
    for (int ss = 0; ss < 4; ++ss) {
        bf16x8 av[2];
#pragma unroll
        for (int ct = 0; ct < 2; ++ct) av[ct] = lds_tr_frag(Vn, VS, 32 * ss, 32 * F.wave + 16 * ct, F.lane);
#pragma unroll
        for (int tt = 0; tt < 8; ++tt) if (tt >= 2 * ss) { const bf16x8 bw = lds_row_frag(Wimg, KS, 16 * tt, 32 * ss, F.lane);
            acc[0][tt] = MFMA16(av[0], bw, acc[0][tt]); acc[1][tt] = MFMA16(av[1], bw, acc[1][tt]); }
    }
#pragma unroll
    for (int tt = 0; tt < 8; ++tt) { const int t = 16 * tt + (F.lane & 15); const float bs = F.sgu_b[g * 128 + t];
#pragma unroll
        for (int ct = 0; ct < 2; ++ct) { const int cg = g * 256 + 32 * F.wave + 16 * ct + 4 * (F.lane >> 4); const f32x4 u4 = pg8::f8x4(uv[tt][ct]) * 0.5f;
            *(unsigned*)(F.ws + WS_YS8 + (tok0 + t) * 1024 + cg) = pk4_fp8(u4[0] * (acc[ct][tt][0] + bs), u4[1] * (acc[ct][tt][1] + bs), u4[2] * (acc[ct][tt][2] + bs), u4[3] * (acc[ct][tt][3] + bs)); } }
    __syncthreads();
}
__device__ __forceinline__ void p2a(Frame& F) { F.fence_ids();
    { KvRegs R; if (F.bid < 1024) kv_load(F, F.bid, R);
      for (int u = F.bid; u < 1024; u += F.G) kv_unit(F, u, R, (u + F.G < 1024) ? u + F.G : -1); }
#if MK_PROBE_HI > 0
    if (F.bid == 0 && threadIdx.x == 0) { const unsigned long long _t = __builtin_amdgcn_s_memrealtime(); F.misc[16 + 2 * 20] = (unsigned)_t; F.misc[17 + 2 * 20] = (unsigned)(_t >> 32); }
#endif
    { SguRegs R; int cur_g = -1; if (F.bid < 1024) sgu_load(F, F.bid, R);
      for (int su = F.bid; su < 1024; su += F.G) sgu_unit(F, su, R, (su + F.G < 1024) ? su + F.G : -1, cur_g); }
}
__device__ __forceinline__ void p2b(Frame& F) { F.fence_ids();
    bf16* KVS = (bf16*)(F.dout + DO_KVS);
    for (int item = F.bid * 512 + F.tid; item < 32 * 4096; item += F.G * 512) {
        const int bh = item >> 12, rem = item & 4095, h = bh & 3;
        const float dc = fexp2(128.0f * lg_gamma(h));
        float s[8];
#pragma unroll
        for (int e = 0; e < 8; ++e) s[e] = 0.f;
        bf16* p = KVS + (size_t)bh * 32 * 32768 + (size_t)rem * 8;
        for (int c0 = 0; c0 < 32; c0 += 8) {
            v4u kv[8];
#pragma unroll
            for (int i = 0; i < 8; ++i) kv[i] = *(const v4u*)(p + (size_t)(c0 + i) * 32768);
#pragma unroll
            for (int i = 0; i < 8; ++i) {
                v4u o; o.x = pk2(s[0], s[1]); o.y = pk2(s[2], s[3]); o.z = pk2(s[4], s[5]); o.w = pk2(s[6], s[7]);
                *(v4u*)(p + (size_t)(c0 + i) * 32768) = o;
                s[0] = s[0] * dc + bflo(kv[i].x); s[1] = s[1] * dc + bfhi(kv[i].x); s[2] = s[2] * dc + bflo(kv[i].y); s[3] = s[3] * dc + bfhi(kv[i].y);
                s[4] = s[4] * dc + bflo(kv[i].z); s[5] = s[5] * dc + bfhi(kv[i].z); s[6] = s[6] * dc + bflo(kv[i].w); s[7] = s[7] * dc + bfhi(kv[i].w);
            }
        }
    }
}
struct RetRegs { v4u q[4], k[4], v[8]; };
__device__ __forceinline__ void ret_load(Frame& F, int u, RetRegs& R) {
    const int b = u >> 7, h = (u >> 5) & 3, c = u & 31; const size_t tok0 = (size_t)b * SEQ + c * 128;
    const bf16* Qb = (const bf16*)(F.dout + DO_Q); const bf16* Kb = (const bf16*)(F.dout + DO_K); const bf16* Vb = (const bf16*)(F.ws + WS_V);
#pragma unroll
    for (int i = 0; i < 4; ++i) { const int ch = F.tid + 512 * i, j = ch >> 4, cc = ch & 15;
        R.q[i] = *(const v4u*)(Qb + (tok0 + j) * 512 + h * 128 + cc * 8); R.k[i] = *(const v4u*)(Kb + (tok0 + j) * 512 + h * 128 + cc * 8); }
#pragma unroll
    for (int i = 0; i < 8; ++i) { const int ch = F.tid + 512 * i, j = ch >> 5, cc = ch & 31; R.v[i] = *(const v4u*)(Vb + (tok0 + j) * 1024 + h * 256 + cc * 8); }
}
__device__ __forceinline__ void ret_unit(Frame& F, int u, RetRegs& R, int unext) {
    const int b = u >> 7, h = (u >> 5) & 3, c = u & 31;
    const size_t tok0 = (size_t)b * SEQ + c * 128;
    LAS unsigned char* Qimg = F.lds; LAS unsigned char* Kimg = F.lds + 34816; LAS unsigned char* Vimg = F.lds + 69632;
    LAS unsigned char* Sout = F.lds;
    const unsigned char* Gb = F.ws + WS_G;
    const bf16* ST = (const bf16*)(F.dout + DO_KVS) + (size_t)(((b * 4 + h) * 32 + c)) * 32768;
    const float lg = lg_gamma(h);
    const int lane = F.lane, w = F.wave, l15 = lane & 15, g4 = lane >> 4;
#pragma unroll
    for (int i = 0; i < 4; ++i) { const int ch = F.tid + 512 * i, j = ch >> 4, cc = ch & 15;
        *(LAS v4u*)(Qimg + j * KS + cc * 16) = R.q[i]; *(LAS v4u*)(Kimg + j * KS + cc * 16) = R.k[i]; }
#pragma unroll
    for (int i = 0; i < 8; ++i) { const int ch = F.tid + 512 * i, j = ch >> 5, cc = ch & 31; *(LAS v4u*)(Vimg + j * VS + cc * 16) = R.v[i]; }
    bf16x8 bs[4][2];
#pragma unroll
    for (int ds = 0; ds < 4; ++ds)
#pragma unroll
        for (int vt = 0; vt < 2; ++vt) bs[ds][vt] = *(const bf16x8*)(ST + (size_t)(32 * w + 16 * vt + l15) * 128 + 32 * ds + 8 * g4);
    __syncthreads();
    f32x4 st[8];
#pragma unroll
    for (int jt = 0; jt < 8; ++jt) st[jt] = (f32x4){0.f, 0.f, 0.f, 0.f};
#pragma unroll
    for (int ds = 0; ds < 4; ++ds) { const bf16x8 bq = lds_row_frag(Qimg, KS, 16 * w, 32 * ds, lane);
#pragma unroll
        for (int jt = 0; jt < 8; ++jt) if (jt <= w) { const bf16x8 ak = lds_row_frag(Kimg, KS, 16 * jt, 32 * ds, lane); st[jt] = MFMA16(ak, bq, st[jt]); } }
    __syncthreads();
    { const int i = 16 * w + l15;
#pragma unroll
        for (int jt = 0; jt < 8; ++jt) { float o[4];
#pragma unroll
            for (int ii = 0; ii < 4; ++ii) { const int j = 16 * jt + 4 * g4 + ii; o[ii] = (i >= j) ? st[jt][ii] * fexp2((float)(i - j) * lg) : 0.f; }
            v2u pk; pk.x = pk2(o[0], o[1]); pk.y = pk2(o[2], o[3]);
            *(LAS v2u*)(Kimg + i * KS + (16 * jt + 4 * g4) * 2) = pk; } }
    __syncthreads();
    f32x4 acc[8][2];
#pragma unroll
    for (int it = 0; it < 8; ++it) { acc[it][0] = (f32x4){0.f, 0.f, 0.f, 0.f}; acc[it][1] = (f32x4){0.f, 0.f, 0.f, 0.f}; }
#pragma unroll
    for (int ds = 0; ds < 4; ++ds) {
#pragma unroll
        for (int it = 0; it < 8; ++it) { const bf16x8 a = lds_row_frag(Qimg, KS, 16 * it, 32 * ds, lane);
            acc[it][0] = MFMA16(a, bs[ds][0], acc[it][0]); acc[it][1] = MFMA16(a, bs[ds][1], acc[it][1]); } }
#pragma unroll
    for (int it = 0; it < 8; ++it)
#pragma unroll
        for (int ii = 0; ii < 4; ++ii) { const float dq = fexp2((float)(16 * it + 4 * g4 + ii + 1) * lg); acc[it][0][ii] *= dq; acc[it][1][ii] *= dq; }
#pragma unroll
    for (int js = 0; js < 4; ++js) { bf16x8 bv[2];
#pragma unroll
        for (int vt = 0; vt < 2; ++vt) bv[vt] = lds_tr_frag(Vimg, VS, 32 * js, 32 * w + 16 * vt, lane);
#pragma unroll
        for (int it = 0; it < 8; ++it) if (it >= 2 * js) { const bf16x8 a = lds_row_frag(Kimg, KS, 16 * it, 32 * js, lane);
            acc[it][0] = MFMA16(a, bv[0], acc[it][0]); acc[it][1] = MFMA16(a, bv[1], acc[it][1]); } }
    int lane_h = lane; asm volatile("" : "+v"(lane_h));
    unsigned gt[16];
#pragma unroll
    for (int rr = 0; rr < 16; ++rr) gt[rr] = *(const unsigned*)(Gb + (tok0 + 16 * w + rr) * 1024 + h * 256 + 4 * lane_h);
    const f32x4 gn = *(const f32x4*)(F.ret_gn_g + h * 256 + 4 * lane_h);
    __syncthreads();
#pragma unroll
    for (int it = 0; it < 8; ++it)
#pragma unroll
        for (int vt = 0; vt < 2; ++vt)
#pragma unroll
            for (int ii = 0; ii < 4; ++ii) *(LAS float*)(Sout + (16 * it + 4 * g4 + ii) * 1040 + (32 * w + 16 * vt + l15) * 4) = acc[it][vt][ii];
    __syncthreads();
#pragma unroll
    for (int rr = 0; rr < 16; ++rr) { const int i = 16 * w + rr;
        const f32x4 y = *(LAS const f32x4*)(Sout + i * 1040 + lane_h * 16);
        const float mean = wave_sum((y[0] + y[1]) + (y[2] + y[3])) * (1.f / 256.f);
        const f32x4 d = y - mean;
        const float var = wave_sum((d[0] * d[0] + d[1] * d[1]) + (d[2] * d[2] + d[3] * d[3])) * (1.f / 256.f);
        const float r8 = __builtin_amdgcn_rsqf(var + EPSN) * (4.0f / 16.0f);
        const size_t off = (tok0 + i) * 1024 + h * 256 + 4 * lane_h; const f32x4 gq = pg8::f8x4(gt[rr]);
        *(unsigned*)(F.ws + WS_YG8 + off) = pk4_fp8(d[0] * r8 * gn[0] * gq[0], d[1] * r8 * gn[1] * gq[1], d[2] * r8 * gn[2] * gq[2], d[3] * r8 * gn[3] * gq[3]); }
    __syncthreads();
}
__device__ __forceinline__ void p2c(Frame& F) { F.fence_ids(); for (int u = F.bid; u < 1024; u += F.G) { RetRegs R; ret_load(F, u, R); ret_unit(F, u, R, -1); } }

__device__ __forceinline__ float dppx(float v, int) { return v; }
template <int CTRL> __device__ __forceinline__ void merge16(float (&L)[16]) {
    float c[16];
#pragma unroll
    for (int i = 0; i < 16; ++i) c[i] = __builtin_fmaxf(L[i], dpp_f<CTRL>(L[15 - i]));
#pragma unroll
    for (int half = 8; half >= 1; half >>= 1)
#pragma unroll
        for (int i = 0; i < 16; ++i) if ((i & half) == 0) { const float hi = __builtin_fmaxf(c[i], c[i + half]), lo = __builtin_fminf(c[i], c[i + half]); c[i] = hi; c[i + half] = lo; }
#pragma unroll
    for (int i = 0; i < 16; ++i) L[i] = c[i];
}
__device__ __forceinline__ void sort16_desc(float (&v)[16]) {
#pragma unroll
    for (int k = 2; k <= 16; k <<= 1)
#pragma unroll
        for (int j = k >> 1; j >= 1; j >>= 1)
#pragma unroll
            for (int i = 0; i < 16; ++i) { const int l = i ^ j; if (l > i) { const bool desc = ((i & k) == 0) || (k == 16);
                const float hi = __builtin_fmaxf(v[i], v[l]), lo = __builtin_fminf(v[i], v[l]); v[i] = desc ? hi : lo; v[l] = desc ? lo : hi; } }
}
__device__ __forceinline__ void merge_top16(float (&A)[16], const float (&B)[16]) {
#pragma unroll
    for (int i = 0; i < 16; ++i) A[i] = __builtin_fmaxf(A[i], B[15 - i]);
#pragma unroll
    for (int half = 8; half >= 1; half >>= 1)
#pragma unroll
        for (int i = 0; i < 16; ++i) if ((i & half) == 0) { const float hi = __builtin_fmaxf(A[i], A[i + half]), lo = __builtin_fminf(A[i], A[i + half]); A[i] = hi; A[i + half] = lo; }
}
__device__ __forceinline__ void p5b(Frame& F) {
    F.fence_ids();
    LAS unsigned char* Aimg = F.lds; LAS unsigned char* Bimg = F.lds + 34816; LAS float* Sc = (LAS float*)(F.lds + 69632);
    const bf16* QP = (const bf16*)(F.ws + WS_GA);
    const int lane = F.lane, w = F.wave;
    int cur_hp = -1;
    v4u pa[4];
    if (F.bid < 4096) { const int tt = F.bid >> 4, hp = F.bid & 15;
#pragma unroll
        for (int i = 0; i < 4; ++i) { const int ch = F.tid + 512 * i, r = ch >> 4, cc = ch & 15; pa[i] = *(const v4u*)(QP + ((size_t)tt * 128 + r) * 2048 + hp * 128 + cc * 8); } }
    for (int u = F.bid; u < 4096; u += F.G) {
        const int tt = u >> 4, hp = u & 15; const size_t tok0 = (size_t)tt * 128;
#pragma unroll
        for (int i = 0; i < 4; ++i) { const int ch = F.tid + 512 * i, r = ch >> 4, cc = ch & 15; *(LAS v4u*)(Aimg + r * KS + cc * 16) = pa[i]; }
        if (hp != cur_hp) { const bf16* SK = (const bf16*)(F.ws + WS_SK) + (size_t)hp * 16384; cur_hp = hp;
#pragma unroll
            for (int i = 0; i < 4; ++i) { const int ch = F.tid + 512 * i, r = ch >> 4, cc = ch & 15; *(LAS v4u*)(Bimg + r * KS + cc * 16) = *(const v4u*)(SK + (size_t)r * 128 + cc * 8); } }
        __syncthreads();
        { const int un = u + F.G; if (un < 4096) { const int tn = un >> 4, hn = un & 15;
#pragma unroll
            for (int i = 0; i < 4; ++i) { const int ch = F.tid + 512 * i, r = ch >> 4, cc = ch & 15; pa[i] = *(const v4u*)(QP + ((size_t)tn * 128 + r) * 2048 + hn * 128 + cc * 8); } } }
        f32x4 acc[8];
#pragma unroll
        for (int nt = 0; nt < 8; ++nt) acc[nt] = (f32x4){0.f, 0.f, 0.f, 0.f};
#pragma unroll
        for (int ks = 0; ks < 4; ++ks) { const bf16x8 a = lds_row_frag(Aimg, KS, 16 * w, 32 * ks, lane);
#pragma unroll
            for (int nt = 0; nt < 8; ++nt) { const bf16x8 bb = lds_row_frag(Bimg, KS, 16 * nt, 32 * ks, lane); acc[nt] = MFMA16(a, bb, acc[nt]); } }
#pragma unroll
        for (int nt = 0; nt < 8; ++nt)
#pragma unroll
            for (int ii = 0; ii < 4; ++ii) Sc[(16 * w + 4 * (lane >> 4) + ii) * 132 + 16 * nt + (lane & 15)] = acc[nt][ii];
        __syncthreads();
        { const int row = F.tid >> 2, q = F.tid & 3;
            float L[16], L2[16];
#pragma unroll
            for (int i = 0; i < 16; ++i) { const int n = 4 * i + q, n2 = 4 * (i + 16) + q;
                L[i] = __uint_as_float((__float_as_uint(Sc[row * 132 + n]) & 0xFFFFFF80u) | (unsigned)n);
                L2[i] = __uint_as_float((__float_as_uint(Sc[row * 132 + n2]) & 0xFFFFFF80u) | (unsigned)n2); }
            sort16_desc(L); sort16_desc(L2); merge_top16(L, L2);
            merge16<0xB1>(L); merge16<0x4E>(L);
            if (q == 0) { v4u* dst = (v4u*)((unsigned*)(F.ws + WS_SUB) + ((tok0 + row) * 16 + hp) * 16);
#pragma unroll
                for (int i = 0; i < 4; ++i) dst[i] = (v4u){__float_as_uint(L[4 * i]), __float_as_uint(L[4 * i + 1]), __float_as_uint(L[4 * i + 2]), __float_as_uint(L[4 * i + 3])}; } }
        __syncthreads();
    }
}

template <int CTRL> __device__ __forceinline__ float dpp_max(float v) { return __builtin_fmaxf(v, dpp_f<CTRL>(v)); }
template <int CTRL> __device__ __forceinline__ float dpp_add(float v) { return v + dpp_f<CTRL>(v); }
__device__ __forceinline__ float row_allmax(float v) { v = dpp_max<0x128>(v); v = dpp_max<0x124>(v); v = dpp_max<0x122>(v); v = dpp_max<0x121>(v); return v; }
__device__ __forceinline__ float row_allsum(float v) { v = dpp_add<0x128>(v); v = dpp_add<0x124>(v); v = dpp_add<0x122>(v); v = dpp_add<0x121>(v); return v; }
__device__ __forceinline__ void p6a(Frame& F) { F.fence_ids();
    const int lane = F.lane, row = lane >> 4, i = lane & 15, rowbase = lane & 48;
    LAS unsigned* Sel = (LAS unsigned*)(F.lds + F.wave * 1024);
    const unsigned* SUB = (const unsigned*)(F.ws + WS_SUB);
    unsigned* EID = (unsigned*)(F.ws + WS_EID); float* GWp = (float*)(F.ws + WS_GW);
    const int gw = F.bid * NWAVES + F.wave, NGW = F.G * NWAVES;
    unsigned nab[2], nbb[2];
    if (gw < MT) {
#pragma unroll
        for (int r = 0; r < 2; ++r) { const int h = 4 * r + row; nab[r] = SUB[((size_t)gw * 16 + 2 * h) * 16 + i]; nbb[r] = SUB[((size_t)gw * 16 + 2 * h + 1) * 16 + i]; } }
    for (int t = gw; t < MT; t += NGW) {
        unsigned abits[2], bbits[2], bcur[2]; float a[2], hv[2]; int ptr[2];
#pragma unroll
        for (int r = 0; r < 2; ++r) { abits[r] = nab[r]; bbits[r] = nbb[r]; a[r] = __uint_as_float(abits[r]); ptr[r] = 0; bcur[r] = (unsigned)__shfl((int)bbits[r], rowbase); hv[r] = a[r] + __uint_as_float(bcur[r]); }
        if (t + NGW < MT) {
#pragma unroll
            for (int r = 0; r < 2; ++r) { const int h = 4 * r + row; nab[r] = SUB[((size_t)(t + NGW) * 16 + 2 * h) * 16 + i]; nbb[r] = SUB[((size_t)(t + NGW) * 16 + 2 * h + 1) * 16 + i]; } }
        for (int k = 0; k < 16; ++k) {
#pragma unroll
            for (int r = 0; r < 2; ++r) {
                const float key = __uint_as_float((__float_as_uint(hv[r]) & 0xFFFFFFF0u) | (unsigned)i);
                const float m = row_allmax(key);
                const bool win = (key == m);
                if (win) { Sel[((r * 4 + row) * 16 + k) * 2] = (abits[r] & 127u) * 128u + (bcur[r] & 127u); Sel[((r * 4 + row) * 16 + k) * 2 + 1] = __float_as_uint(hv[r]); ptr[r]++; }
                const unsigned bnext = (unsigned)__shfl((int)bbits[r], rowbase + (ptr[r] < 15 ? ptr[r] : 15));
                if (win) { bcur[r] = bnext; hv[r] = (ptr[r] < 16) ? a[r] + __uint_as_float(bnext) : -3.0e38f; }
            }
        }
        LDS_WAIT(); asm volatile("" ::: "memory");
#pragma unroll
        for (int r = 0; r < 2; ++r) { const int h = 4 * r + row;
            const unsigned e = Sel[((r * 4 + row) * 16 + i) * 2]; const float sc = __uint_as_float(Sel[((r * 4 + row) * 16 + i) * 2 + 1]);
            const float mx = row_allmax(sc);
            const float ex = fexp2((sc - mx) * 1.44269504089f);
            const float sum = row_allsum(ex);
            EID[(size_t)t * 128 + h * 16 + i] = e; GWp[(size_t)t * 128 + h * 16 + i] = ex / sum; }
        LDS_WAIT(); asm volatile("" ::: "memory");
    }
}
typedef float f32x2c __attribute__((ext_vector_type(2)));
__device__ __forceinline__ long mk64(unsigned lo, unsigned hi) { return (long)(((unsigned long long)hi << 32) | lo); }
#if MK_U4
typedef int v8i_q __attribute__((ext_vector_type(8)));
__device__ __forceinline__ void p6b(Frame& F) { F.fence_ids();
    const int j = F.bid & 7, s2 = j >> 1, par = j & 1, nsb = F.G >> 3; if ((F.bid >> 3) >= nsb) return;
    const int wj = (F.bid >> 3) * NWAVES + F.wave, NW = nsb * NWAVES, NI = MT / 2;
    const int lane = F.lane, g = lane >> 4;
    const int pidx = (4 * (lane & 15) + (lane >> 4)) * 4;
    const unsigned char* H8 = F.ws + WS_H2F8 + (size_t)s2 * MT * 256 + 16 * g; const unsigned char* U4 = F.ws + WS_UE8 + (size_t)s2 * 16384 * 128 + 16 * (lane & 3); const unsigned* EID = (const unsigned*)(F.ws + WS_EID) + (lane >> 2);
    float* PD = (float*)(F.ws + WS_PD) + (size_t)s2 * MT * 128;
#define TOK(ix_) (2 * ((ix_) < NI ? (ix_) : NI - 1) + par)
#define P6B_LOAD_EID(E, ix_) do { const int tc_ = TOK(ix_); _Pragma("unroll") for (int h = 0; h < 8; ++h) E[h] = EID[(size_t)tc_ * 128 + 16 * h]; } while (0)
#define P6B_LOAD_AB(A_, B0_, B1_, E, ix_) do { const int tc_ = TOK(ix_); const unsigned char* hp_ = H8 + (size_t)tc_ * 256; A_[0] = *(const v4u*)hp_; A_[1] = *(const v4u*)(hp_ + 64); A_[2] = *(const v4u*)(hp_ + 128); A_[3] = *(const v4u*)(hp_ + 192); \
        _Pragma("unroll") for (int h = 0; h < 8; ++h) { const unsigned char* rp_ = U4 + (size_t)E[h] * 128; B0_[h] = *(const v4u*)rp_; B1_[h] = *(const v4u*)(rp_ + 64); } } while (0)
#define BPM(x_) ((int)__builtin_amdgcn_ds_bpermute(pidx, (int)(x_)))
#define P6B_COMPUTE(A_, B0_, B1_, ix_) do { if ((ix_) < NI) { const int tc_ = 2 * (ix_) + par; \
        const v8i_q a0_ = (v8i_q){(int)A_[0].x, (int)A_[0].y, (int)A_[0].z, (int)A_[0].w, (int)A_[1].x, (int)A_[1].y, (int)A_[1].z, (int)A_[1].w}, a1_ = (v8i_q){(int)A_[2].x, (int)A_[2].y, (int)A_[2].z, (int)A_[2].w, (int)A_[3].x, (int)A_[3].y, (int)A_[3].z, (int)A_[3].w}; \
        _Pragma("unroll") for (int h = 0; h < 8; ++h) { const v8i_q b0_ = (v8i_q){BPM(B0_[h].x), BPM(B0_[h].y), BPM(B0_[h].z), BPM(B0_[h].w), 0, 0, 0, 0}, b1_ = (v8i_q){BPM(B1_[h].x), BPM(B1_[h].y), BPM(B1_[h].z), BPM(B1_[h].w), 0, 0, 0, 0}; \
            f32x4 acc_ = __builtin_amdgcn_mfma_scale_f32_16x16x128_f8f6f4(a0_, b0_, (f32x4){0.f, 0.f, 0.f, 0.f}, 0, 4, 0, 0x7F7F7F7F, 0, 0x7F7F7F7F); \
            acc_ = __builtin_amdgcn_mfma_scale_f32_16x16x128_f8f6f4(a1_, b1_, acc_, 0, 4, 0, 0x7F7F7F7F, 0, 0x7F7F7F7F); \
            if (lane < 16) PD[(size_t)tc_ * 128 + 16 * h + lane] = acc_[0] * (1.0f / 1024.0f); } } } while (0)
    unsigned E0[8], E1[8]; v4u A0[4], A1[4], B00[8], B01[8], B10[8], B11[8];
    int ix = wj;
    P6B_LOAD_EID(E0, ix); P6B_LOAD_EID(E1, ix + NW);
    P6B_LOAD_AB(A0, B00, B01, E0, ix);
    for (; ix < NI; ix += 2 * NW) {
        P6B_LOAD_AB(A1, B10, B11, E1, ix + NW);
        P6B_LOAD_EID(E0, ix + 2 * NW);
        P6B_COMPUTE(A0, B00, B01, ix);
        P6B_LOAD_AB(A0, B00, B01, E0, ix + 2 * NW);
        P6B_LOAD_EID(E1, ix + 3 * NW);
        P6B_COMPUTE(A1, B10, B11, ix + NW);
    }
#undef TOK
#undef P6B_LOAD_EID
#undef P6B_LOAD_AB
#undef P6B_COMPUTE
#undef BPM
}
#else
__device__ __forceinline__ void p6b(Frame& F) { F.fence_ids();
    const int j = F.bid & 7, nsb = F.G >> 3; if ((F.bid >> 3) >= nsb) return;
    const int wj = (F.bid >> 3) * NWAVES + F.wave, NW = nsb * NWAVES;
    const int lane = F.lane, g = lane >> 4;
    const int pidx = (4 * (lane & 15) + (lane >> 4)) * 4;
    const unsigned char* H8 = F.ws + WS_H2F8 + (size_t)j * MT * 128 + 16 * g; const unsigned char* UE8 = F.ws + WS_UE8 + (size_t)j * 16384 * 128 + 16 * (lane & 3); const unsigned* EID = (const unsigned*)(F.ws + WS_EID) + (lane >> 2);
    float* PD = (float*)(F.ws + WS_PD) + (size_t)j * MT * 128;
#define P6B_LOAD_EID(E, tt) do { const int tc_ = (tt) < MT ? (tt) : MT - 1; _Pragma("unroll") for (int h = 0; h < 8; ++h) E[h] = EID[(size_t)tc_ * 128 + 16 * h]; } while (0)
#define P6B_LOAD_AB(A0_, A1_, B0_, B1_, E, tt) do { const int tc_ = (tt) < MT ? (tt) : MT - 1; const unsigned char* hp_ = H8 + (size_t)tc_ * 128; A0_ = *(const v4u*)hp_; A1_ = *(const v4u*)(hp_ + 64); \
        _Pragma("unroll") for (int h = 0; h < 8; ++h) { const unsigned char* rp_ = UE8 + (size_t)E[h] * 128; B0_[h] = *(const v4u*)rp_; B1_[h] = *(const v4u*)(rp_ + 64); } } while (0)
#define BPM(x_) ((unsigned)__builtin_amdgcn_ds_bpermute(pidx, (int)(x_)))
#define P6B_COMPUTE(A0_, A1_, B0_, B1_, tt) do { if ((tt) < MT) { _Pragma("unroll") for (int h = 0; h < 8; ++h) { f32x4 acc_ = (f32x4){0.f, 0.f, 0.f, 0.f}; \
            acc_ = __builtin_amdgcn_mfma_f32_16x16x32_fp8_fp8(mk64(A0_.x, A0_.y), mk64(BPM(B0_[h].x), BPM(B0_[h].y)), acc_, 0, 0, 0); \
            acc_ = __builtin_amdgcn_mfma_f32_16x16x32_fp8_fp8(mk64(A0_.z, A0_.w), mk64(BPM(B0_[h].z), BPM(B0_[h].w)), acc_, 0, 0, 0); \
            acc_ = __builtin_amdgcn_mfma_f32_16x16x32_fp8_fp8(mk64(A1_.x, A1_.y), mk64(BPM(B1_[h].x), BPM(B1_[h].y)), acc_, 0, 0, 0); \
            acc_ = __builtin_amdgcn_mfma_f32_16x16x32_fp8_fp8(mk64(A1_.z, A1_.w), mk64(BPM(B1_[h].z), BPM(B1_[h].w)), acc_, 0, 0, 0); \
            if (lane < 16) PD[(size_t)(tt) * 128 + 16 * h + lane] = acc_[0] * (1.0f / 8192.0f); } } } while (0)
    unsigned E0[8], E1[8]; v4u A00, A01, A10, A11, B00[8], B01[8], B10[8], B11[8];
    int t = wj;
    P6B_LOAD_EID(E0, t); P6B_LOAD_EID(E1, t + NW);
    P6B_LOAD_AB(A00, A01, B00, B01, E0, t);
    for (; t < MT; t += 2 * NW) {
        P6B_LOAD_AB(A10, A11, B10, B11, E1, t + NW);
        P6B_LOAD_EID(E0, t + 2 * NW);
        P6B_COMPUTE(A00, A01, B00, B01, t);
        P6B_LOAD_AB(A00, A01, B00, B01, E0, t + 2 * NW);
        P6B_LOAD_EID(E1, t + 3 * NW);
        P6B_COMPUTE(A10, A11, B10, B11, t + NW);
    }
#undef P6B_LOAD_EID
#undef P6B_LOAD_AB
#undef P6B_COMPUTE
#undef BPM
}
#endif
__device__ __forceinline__ void p6b2(Frame& F) { F.fence_ids();
    const float* PD = (const float*)(F.ws + WS_PD); const float* GWp = (const float*)(F.ws + WS_GW); float* ACT = (float*)(F.ws + WS_ACT);
    for (size_t i4 = (size_t)F.bid * 512 + F.tid; i4 < (size_t)MT * 32; i4 += (size_t)F.G * 512) {
        f32x4 s = *(const f32x4*)(PD + i4 * 4);
#pragma unroll
        for (int jj = 1; jj < (MK_U4 ? 4 : 8); ++jj) s += *(const f32x4*)(PD + (size_t)jj * MT * 128 + i4 * 4);
        const f32x4 gw = *(const f32x4*)(GWp + i4 * 4);
        *(f32x4*)(ACT + i4 * 4) = (f32x4){gelu1(s[0]) * gw[0], gelu1(s[1]) * gw[1], gelu1(s[2]) * gw[2], gelu1(s[3]) * gw[3]};
    }
}
__device__ __forceinline__ void p6c(Frame& F) { F.fence_ids();
    const int j = F.bid & 7, nsb = F.G >> 3; if ((F.bid >> 3) >= nsb) return;
    const int wj = (F.bid >> 3) * NWAVES + F.wave, NW = nsb * NWAVES;
    const int lane = F.lane, g8 = lane >> 3, s8 = lane & 7;
    LAS float* Act = (LAS float*)(F.lds + F.wave * 8192); LAS unsigned* Eidl = (LAS unsigned*)(F.lds + F.wave * 8192 + 4096);
    const unsigned char* VE8 = F.ws + WS_VE8 + (size_t)j * 16384 * 128 + 16 * s8; const unsigned* EID = (const unsigned*)(F.ws + WS_EID); const float* ACT = (const float*)(F.ws + WS_ACT);
    bf16* PEERS = (bf16*)(F.ws + WS_PEERS) + (size_t)j * MT * 128;
    for (int tg = wj; tg < MT / 8; tg += NW) {
        const size_t t0 = (size_t)tg * 8;
#pragma unroll
        for (int q = 0; q < 4; ++q) { const int idx = 4 * (lane + 64 * q);
            *(LAS f32x4*)(Act + idx) = *(const f32x4*)(ACT + t0 * 128 + idx); *(LAS v4u*)(Eidl + idx) = *(const v4u*)(EID + t0 * 128 + idx); }
        LDS_WAIT(); asm volatile("" ::: "memory");
        f32x2c acc2[8];
#pragma unroll
        for (int e = 0; e < 8; ++e) acc2[e] = (f32x2c){0.f, 0.f};
        LAS const float* ap = Act + g8 * 128; LAS const unsigned* ep = Eidl + g8 * 128;
        v4u va[8], vb[8]; f32x4 aa[2], ab[2];
#define P6C_LOAD(V_, A_, base) do { A_[0] = *(LAS const f32x4*)(ap + (base)); A_[1] = *(LAS const f32x4*)(ap + (base) + 4); const v4u e0_ = *(LAS const v4u*)(ep + (base)), e1_ = *(LAS const v4u*)(ep + (base) + 4); \
            _Pragma("unroll") for (int k = 0; k < 4; ++k) { V_[k] = *(const v4u*)(VE8 + (size_t)e0_[k] * 128); V_[4 + k] = *(const v4u*)(VE8 + (size_t)e1_[k] * 128); } } while (0)
#define P6C_FMA(V_, A_) do { _Pragma("unroll") for (int k = 0; k < 8; ++k) { const float a_ = A_[k >> 2][k & 3]; const f32x2c a2_ = (f32x2c){a_, a_}; _Pragma("unroll") for (int w = 0; w < 4; ++w) { \
            const f32x2c lo_ = __builtin_amdgcn_cvt_pk_f32_fp8((int)V_[k][w], false), hi_ = __builtin_amdgcn_cvt_pk_f32_fp8((int)V_[k][w], true); \
            acc2[2 * w] = __builtin_elementwise_fma(a2_, lo_, acc2[2 * w]); acc2[2 * w + 1] = __builtin_elementwise_fma(a2_, hi_, acc2[2 * w + 1]); } } } while (0)
        P6C_LOAD(va, aa, 0);
        for (int it = 0; it < 128; it += 16) {
            P6C_LOAD(vb, ab, it + 8);
            P6C_FMA(va, aa);
            if (it + 16 < 128) P6C_LOAD(va, aa, it + 16);
            P6C_FMA(vb, ab);
        }
#undef P6C_LOAD
#undef P6C_FMA
        float acc[16];
#pragma unroll
        for (int e = 0; e < 8; ++e) { acc[2 * e] = acc2[e][0]; acc[2 * e + 1] = acc2[e][1]; }
        { bf16* op = PEERS + (t0 + g8) * 128 + 16 * s8;
            v4u o0, o1;
            o0.x = pk2(acc[0] * 0.0625f, acc[1] * 0.0625f); o0.y = pk2(acc[2] * 0.0625f, acc[3] * 0.0625f); o0.z = pk2(acc[4] * 0.0625f, acc[5] * 0.0625f); o0.w = pk2(acc[6] * 0.0625f, acc[7] * 0.0625f);
            o1.x = pk2(acc[8] * 0.0625f, acc[9] * 0.0625f); o1.y = pk2(acc[10] * 0.0625f, acc[11] * 0.0625f); o1.z = pk2(acc[12] * 0.0625f, acc[13] * 0.0625f); o1.w = pk2(acc[14] * 0.0625f, acc[15] * 0.0625f);
            *(v4u*)op = o0; *(v4u*)(op + 8) = o1; }
        LDS_WAIT(); asm volatile("" ::: "memory");
    }
}
__device__ __forceinline__ void p6d(Frame& F) { F.fence_ids();
    const int gw = F.bid * NWAVES + F.wave, NGW = F.G * NWAVES; const bf16* PEERS = (const bf16*)(F.ws + WS_PEERS); const float* gate2 = (const float*)(F.ws + WS_MOD) + 5120;
    f32x4 fg[4];
#pragma unroll
    for (int q = 0; q < 4; ++q) fg[q] = *((const f32x4*)F.final_g + F.lane + 64 * q);
    f32x4 nx[4]; v2u np[4];
#define P6D_LOAD(tt) do { _Pragma("unroll") for (int q = 0; q < 4; ++q) { const int d = 4 * F.lane + 256 * q; { const v2u w_ = *((const v2u*)((const bf16*)(F.ws + WS_X1B) + (size_t)(tt) * DM) + F.lane + 64 * q); nx[q] = (f32x4){bflo(w_.x), bfhi(w_.x), bflo(w_.y), bfhi(w_.y)}; } \
        np[q] = *(const v2u*)(PEERS + ((size_t)(d >> 7) * MT + (tt)) * 128 + (d & 127)); } } while (0)
    if (gw < MT) P6D_LOAD(gw);
    for (int t = gw; t < MT; t += NGW) {
        const int b = t >> 12;
        f32x4* xr = (f32x4*)((float*)F.dout + (size_t)t * DM) + F.lane; f32x4 o[4]; float ss = 0.f;
#pragma unroll
        for (int q = 0; q < 4; ++q) { const int d = 4 * F.lane + 256 * q; const f32x4 g2 = *(const f32x4*)(gate2 + (size_t)b * 6144 + d);
            o[q] = nx[q] + g2 * (f32x4){bflo(np[q].x), bfhi(np[q].x), bflo(np[q].y), bfhi(np[q].y)}; ss += (o[q][0] * o[q][0] + o[q][1] * o[q][1]) + (o[q][2] * o[q][2] + o[q][3] * o[q][3]); }
        if (t + NGW < MT) P6D_LOAD(t + NGW);
        const float rstd = __builtin_amdgcn_rsqf(wave_sum(ss) * (1.f / DM) + EPSN);
#pragma unroll
        for (int q = 0; q < 4; ++q) xr[64 * q] = o[q] * rstd * fg[q];
    }
#undef P6D_LOAD
}

struct Args { const float* in[20]; float* out; unsigned char* ws; int ph_lo, ph_hi, li, pad; };
__global__ void __launch_bounds__(NWAVES * 64, 2) mk_fwd(Args args) {
    extern __shared__ __attribute__((aligned(16))) unsigned char lds_raw[];
    Frame F;
    F.lds = (LAS unsigned char*)lds_raw;
    F.tid = threadIdx.x; F.lane = F.tid & 63; F.wave = __builtin_amdgcn_readfirstlane(F.tid >> 6); F.G = gridDim.x; F.bid = blockIdx.x;
    F.x = args.in[0]; F.c = args.in[1]; F.w_ada = args.in[2]; F.b_ada = args.in[3]; F.norm1_g = args.in[4]; F.w_in = args.in[5]; F.ret_gn_g = args.in[6]; F.sgu_ln_g = args.in[7];
    F.sgu_ln_b = args.in[8]; F.sgu_w = args.in[9]; F.sgu_b = args.in[10]; F.w_ret_out = args.in[11]; F.w_sgu_out = args.in[12]; F.w_out = args.in[13]; F.norm2_g = args.in[14];
    F.peer_w_q = args.in[15]; F.peer_sub_keys = args.in[16]; F.peer_u = args.in[17]; F.peer_v = args.in[18]; F.final_g = args.in[19];
    F.ws = args.ws; F.dout = (unsigned char*)args.out;
    volatile LAS unsigned* MISC = (volatile LAS unsigned*)(F.lds + MISC_OFF); F.misc = MISC;
    if (F.tid < 64) MISC[F.tid] = 0u;
    __syncthreads();
    XcdBarrier bar; bar.bar = (unsigned*)(F.ws + WS_CTL) + CW_BAR; bar.x = 0; bar.st = nullptr;
    if (N_LAUNCHES == 1) bar = xcd_barrier_post((unsigned*)(F.ws + WS_CTL) + CW_BAR, MISC + 8);
    const int lo = args.ph_lo, hi = args.ph_hi;
#define IN(k) (lo <= (k) && (k) < hi)
#if MK_PROBE_HI > 0
#define STAMP(k) do { if (F.bid == 0 && F.wave == 0 && F.lane == 0) { const unsigned long long _t = __builtin_amdgcn_s_memrealtime(); MISC[16 + 2 * (k)] = (unsigned)_t; MISC[17 + 2 * (k)] = (unsigned)(_t >> 32); } } while (0)
#else
#define STAMP(k) do { } while (0)
#endif
#define SEAM(k) do { if (IN(k) && IN((k) + 1)) xcd_barrier(bar); } while (0)
    const float* mod = (const float*)(F.ws + WS_MOD);
    STAMP(0);
    if (IN(0)) { p0a(F); SEAM(0); }
    STAMP(1);
    if (IN(1)) { norm_rows<2>(F, F.x, F.norm1_g, mod + 0, mod + 1024, nullptr, F.dout + DO_H); SEAM(1); }
    STAMP(2);
    if (IN(2)) {
        pg8::Gemm g{(const bf16*)(F.dout + DO_H), (const bf16*)(F.ws + WS_WIN), MT, NIN, 512}; pg8::StaticOrder S; S.init(MT, NIN, F.G, F.bid);
        pg8::EpiProj E{(bf16*)(F.dout + DO_Q), (bf16*)(F.dout + DO_K), (bf16*)(F.ws + WS_V), (bf16*)(F.ws + WS_G), (bf16*)(F.ws + WS_U), (bf16*)(F.ws + WS_SV), (bf16*)(F.ws + WS_GA), (bf16*)(F.ws + WS_GB),
                       (const float*)(F.ws + WS_COS), (const float*)(F.ws + WS_SIN), 1.0f / 4096.0f, (float*)(F.ws + WS_SVSTAT)};
        pg8::gemm_phase<pg8::EpiProj, pg8::StaticOrder, true, true, true>(F.lds, g, S, E);
        SEAM(2);
    }
    STAMP(3);
    if (IN(3)) { p2a(F); SEAM(3); }
    STAMP(4);
    if (IN(4)) { p2b(F); SEAM(4); }
    STAMP(5);
    if (IN(5)) { p2c(F); SEAM(5); }
    STAMP(6);
    if (IN(6)) {
        pg8::StaticOrder S; S.init(MT, DM, F.G, F.bid);
        pg8::Gemm g{(const bf16*)(F.ws + WS_YG8), (const bf16*)(F.ws + WS_WRET), MT, DM, 1024, 512, (const bf16*)(F.ws + WS_YS8), (const bf16*)(F.ws + WS_WSGU), 8};
        pg8::EpiMerged E{F.ws + WS_GA, F.ws + WS_GB, F.ws + WS_MRG8, 1.0f / 4096.0f};
        pg8::gemm_phase<pg8::EpiMerged, pg8::StaticOrder, true, true, true>(F.lds, g, S, E);
        SEAM(6);
    }
    STAMP(7);
    if (IN(7)) {
        pg8::Gemm g{(const bf16*)(F.ws + WS_MRG8), (const bf16*)(F.ws + WS_WOUT), MT, DM, 512}; pg8::StaticOrder S; S.init(MT, DM, F.G, F.bid);
        pg8::EpiX1 E{F.x, mod + 2048, (bf16*)(F.ws + WS_X1B), 1.0f / 4096.0f};
        pg8::gemm_phase<pg8::EpiX1, pg8::StaticOrder, true, true, true>(F.lds, g, S, E);
        SEAM(7);
    }
    STAMP(8);
    if (IN(8)) { norm_rows<1>(F, (const float*)(F.ws + WS_X1B), F.norm2_g, mod + 3072, mod + 4096, (bf16*)(F.ws + WS_SV), F.ws + WS_H2F8); SEAM(8); }
    STAMP(9);
    if (IN(9)) {
        pg8::Gemm g{(const bf16*)(F.ws + WS_SV), (const bf16*)(F.ws + WS_WQ), MT, 2048, DM}; pg8::StaticOrder S; S.init(MT, 2048, F.G, F.bid);
        pg8::EpiPlain E{(bf16*)(F.ws + WS_GA), 2048};
        pg8::gemm_phase<pg8::EpiPlain, pg8::StaticOrder, true, true>(F.lds, g, S, E);
        SEAM(9);
    }
    STAMP(10);
    if (IN(10)) { p5b(F); SEAM(10); }
    STAMP(11);
    if (IN(11)) { p6a(F); SEAM(11); }
    STAMP(12);
    if (IN(12)) { p6b(F); SEAM(12); }
    STAMP(13);
    if (IN(13)) { p6b2(F); SEAM(13); }
    STAMP(14);
    if (IN(14)) { p6c(F); SEAM(14); }
    STAMP(15);
    if (IN(15)) { p6d(F); }
    STAMP(16);
#if MK_PROBE_HI > 0
    __syncthreads();
    if (F.bid == 0 && F.tid == 0) { const unsigned long long t0 = ((unsigned long long)MISC[17 + 2 * MK_PROBE_LO] << 32) | MISC[16 + 2 * MK_PROBE_LO], t1 = ((unsigned long long)MISC[17 + 2 * MK_PROBE_HI] << 32) | MISC[16 + 2 * MK_PROBE_HI];
#if MK_GPROBE == 1
        ((float*)F.dout)[0] += (float)MISC[56] * 1e-3f; }
#elif MK_GPROBE == 2
        ((float*)F.dout)[0] += (float)MISC[57] * 1e-3f; }
#else
        ((float*)F.dout)[0] += (float)(t1 - t0) * 1e-3f; }
#endif
#endif
#undef IN
#undef SEAM
}

extern "C" void kernel_launch(void* const* d_in, const int* in_sizes, int n_in, void* d_out, int out_size, void* d_ws, size_t ws_size, hipStream_t stream) {
    static int grid = 0;
    if (grid == 0) {
        if (n_in != 20 || out_size != MT * DM || ws_size < WS_END) { fprintf(stderr, "kernel_launch: unexpected shapes (n_in %d, out %d, ws %zu); nothing launched\n", n_in, out_size, ws_size); grid = -1; return; }
        int dev = 0, cus = 0, per_cu = 0;
        if (hipGetDevice(&dev) != hipSuccess || hipDeviceGetAttribute(&cus, hipDeviceAttributeMultiprocessorCount, dev) != hipSuccess) { grid = -1; return; }
        if (hipFuncSetAttribute((const void*)mk_fwd, hipFuncAttributeMaxDynamicSharedMemorySize, LDS_BYTES) != hipSuccess) { fprintf(stderr, "kernel_launch: hipFuncSetAttribute failed\n"); grid = -1; return; }
        if (hipOccupancyMaxActiveBlocksPerMultiprocessor(&per_cu, (const void*)mk_fwd, NWAVES * 64, LDS_BYTES) != hipSuccess || per_cu < 1)
            fprintf(stderr, "kernel_launch: note: occupancy query reports %d workgroups per CU\n", per_cu);
        (void)hipGetLastError();
        grid = cus;
    }
    if (grid < 0) return;
    if (hipMemsetAsync((char*)d_ws + WS_CTL, 0, CTL_ZERO_BYTES, stream) != hipSuccess) { fprintf(stderr, "kernel_launch: memset failed\n"); return; }
    Args a{};
    for (int i = 0; i < 20; ++i) a.in[i] = (const float*)d_in[i];
    a.out = (float*)d_out; a.ws = (unsigned char*)d_ws;
    static_assert(N_LAUNCHES == 1 || N_LAUNCHES == N_PHASES, "N_LAUNCHES is 1 or N_PHASES");
    for (int li = 0; li < N_LAUNCHES && li < MK_MAXPH; ++li) {
        a.ph_lo = (N_LAUNCHES == 1) ? 0 : li; a.ph_hi = (N_LAUNCHES == 1) ? N_PHASES : li + 1; a.li = li;
        hipLaunchKernelGGL(mk_fwd, dim3(grid), dim3(NWAVES * 64), LDS_BYTES, stream, a);
        const hipError_t le = hipPeekAtLastError();
        if (le != hipSuccess) { fprintf(stderr, "kernel_launch: launch %d failed: %s\n", li, hipGetErrorName(le)); break; }
    }
}
```

```cpp
#include <hip/hip_runtime.h>
#include <cstdio>
#include <cstdint>

#ifndef MK_PROBE_LO
#define MK_PROBE_LO 0
#define MK_PROBE_HI 0
#endif
#ifndef MK_GPROBE
#define MK_GPROBE 0
#endif
#define MK_MISC_OFF (147456 - 256)
#ifndef MK_U4
#define MK_U4 1
#endif
#ifndef MK_ALAY
#define MK_ALAY 2
#endif
#ifndef MK_MAXPH
#define MK_MAXPH 16
#endif
#ifndef MK_N_LAUNCHES
#define MK_N_LAUNCHES 1
#endif
namespace pg8 {
#define PG8_LAS __attribute__((address_space(3)))
typedef unsigned short bf16_t;
typedef short bf16x8 __attribute__((ext_vector_type(8)));
typedef float f32x4 __attribute__((ext_vector_type(4)));
typedef unsigned u32x4 __attribute__((ext_vector_type(4)));
constexpr int BM = 256, BK = 64, HALF = 128, HTB = HALF * BK * 2  , STAGE_BYTES = 8 * HTB, NXCD = 8, WGM = 2;

__host__ __device__ __forceinline__ int lds_byte(int r, int c) { const int st = (r >> 4) * 2 + (c >> 5), rr = r & 15, cc = c & 31, ob = rr * 64 + cc * 2; return st * 1024 + (ob ^ (((ob >> 9) & 1) << 5)); }
__host__ __device__ __forceinline__ void stage_rc(int b, int& R, int& C) { const int st = b / 1024, sb = b % 1024, swz = sb ^ (((sb >> 9) & 1) << 5); R = (st >> 1) * 16 + swz / 64; C = (st & 1) * 32 + (swz % 64) / 2; }
__host__ __device__ __forceinline__ int perm32(int rho) { const int n = rho >> 4, i = rho & 15; return 8 * (i >> 2) + 4 * n + (i & 3); }

struct Unit { int pm, pn; };
struct Gemm { const bf16_t* A; const bf16_t* Bt; int M, N, K; int ld = 0; const bf16_t* A2 = nullptr; const bf16_t* Bt2 = nullptr; int ksplit = 0; };

struct StaticOrder {
    int nM, nN, nwg, G, c;
    __host__ __device__ void init(int M, int N, int G_, int c_) { nM = M / BM; nN = N / BM; nwg = nM * nN; G = G_; c = c_; }
    __host__ __device__ bool next(int i, Unit& u) const {
        const long L = (long)i * G + c; if (L >= nwg) return false;
        int wgid = (int)L; { const int q = nwg / NXCD, r = nwg % NXCD, xcd = wgid % NXCD, off = wgid / NXCD; wgid = (xcd < r ? xcd * (q + 1) : r * (q + 1) + (xcd - r) * q) + off; }
        const int nig = WGM * nN, gid = wgid / nig, fm = gid * WGM, gsz = (nM - fm) < WGM ? (nM - fm) : WGM;
        u.pm = fm + ((wgid % nig) % gsz); u.pn = (wgid % nig) / gsz; return true;
    }
    __device__ __forceinline__ void a_ready(const Unit&) const {}
    __device__ __forceinline__ void done(const Unit&) const {}
};

__device__ __forceinline__ unsigned cvt_pk_bf16(float lo, float hi) { unsigned r; asm volatile("v_cvt_pk_bf16_f32 %0, %1, %2" : "=v"(r) : "v"(lo), "v"(hi)); return r; }
typedef float f32x2 __attribute__((ext_vector_type(2)));
__device__ __forceinline__ f32x2 gelu_pk(f32x2 v) {
    const f32x2 av = __builtin_elementwise_abs(v), d = av * 0.2316418882f + 1.0f;
    f32x2 t; t.x = __builtin_amdgcn_rcpf(d.x); t.y = __builtin_amdgcn_rcpf(d.y);
    f32x2 q = t * 0.5307027145f + (-0.7265760135f); q = q * t + 0.7107068705f; q = q * t + (-0.142248368f); q = q * t + 0.127414796f; q = q * t;
    const f32x2 s = (v * v) * (-0.72134752044f);
    f32x2 e; e.x = __builtin_amdgcn_exp2f(s.x); e.y = __builtin_amdgcn_exp2f(s.y);
    const f32x2 m = v * (q * e), r = v - m;
    f32x2 o; o.x = v.x < 0.f ? m.x : r.x; o.y = v.y < 0.f ? m.y : r.y; return o;
}


typedef unsigned u32x2 __attribute__((ext_vector_type(2)));
__device__ __forceinline__ float bflo(unsigned w) { return __uint_as_float(w << 16); }
__device__ __forceinline__ float bfhi(unsigned w) { return __uint_as_float(w & 0xffff0000u); }
typedef float f32x2q __attribute__((ext_vector_type(2)));
__device__ __forceinline__ f32x4 f8x4(unsigned w) { const f32x2q lo = __builtin_amdgcn_cvt_pk_f32_fp8((int)w, false), hi = __builtin_amdgcn_cvt_pk_f32_fp8((int)w, true); return (f32x4){lo[0], lo[1], hi[0], hi[1]}; }
__device__ __forceinline__ float gelu1(float v) {
    const float av = __builtin_fabsf(v), t = __builtin_amdgcn_rcpf(av * 0.2316418882f + 1.0f);
    float q = t * 0.5307027145f + (-0.7265760135f); q = q * t + 0.7107068705f; q = q * t + (-0.142248368f); q = q * t + 0.127414796f; q = q * t;
    const float e = __builtin_amdgcn_exp2f((v * v) * (-0.72134752044f));
    const float m = v * (q * e);
    return v < 0.f ? m : v - m;
}
__device__ __forceinline__ float sigm1(float v) { return __builtin_amdgcn_rcpf(1.0f + __builtin_amdgcn_exp2f(v * (-1.44269504089f))); }
__device__ __forceinline__ float silu1(float v) { return v * sigm1(v); }

__device__ __forceinline__ unsigned bperm(int idx, unsigned v) { return (unsigned)__builtin_amdgcn_ds_bpermute(idx, (int)v); }
__device__ __forceinline__ float bpermf(int idx, float v) { return __int_as_float(__builtin_amdgcn_ds_bpermute(idx, __float_as_int(v))); }
__device__ __forceinline__ f32x4 bperm4(int idx, const f32x4& v) { return (f32x4){bpermf(idx, v[0]), bpermf(idx, v[1]), bpermf(idx, v[2]), bpermf(idx, v[3])}; }
__device__ __forceinline__ u32x4 bperm4u(int idx, const u32x4& v) { u32x4 r; r.x = bperm(idx, v.x); r.y = bperm(idx, v.y); r.z = bperm(idx, v.z); r.w = bperm(idx, v.w); return r; }
#define PG8_REMAP() const int lane_ = 16 * fq + fr, pidx = (16 * (lane_ & 3) + (lane_ >> 2)) * 4, fr2 = lane_ >> 2, fq2 = lane_ & 3

struct EpiProj {
    static constexpr bool PERM = true, AFTER_DRAIN = false, HAS_MID = false;
    bf16_t *Q, *Kb, *V, *G, *U, *SV, *GA, *GB; const float *cosT, *sinT; float osc; float* svstat;
    __device__ __forceinline__ void operator()(const f32x4 (&acc)[2][2][4][2], const Unit& u, int wr, int wc, int fr, int fq) const {
        PG8_REMAP();
        const int colt = u.pn * BM; const int row0 = u.pm * BM + wr * 64 + fr2;
        if (colt < 1024) {
            const bool isk = colt >= 512; bf16_t* base = isk ? Kb : Q; const int lc0 = (colt & 511) + wc * 32 + 8 * fq2; const float sc = (isk ? 0.08838834764831845f : 1.0f) * osc;
            const int fi = wc * 16 + 4 * fq2;
#pragma unroll
            for (int ai = 0; ai < 2; ++ai) {
                f32x4 csv[4], snv[4];
#pragma unroll
                for (int m = 0; m < 4; ++m) { const int s = (row0 + ai * HALF + m * 16) & 4095; csv[m] = *(const f32x4*)(cosT + s * 64 + fi) * sc; snv[m] = *(const f32x4*)(sinT + s * 64 + fi) * sc; }
#pragma unroll
                for (int m = 0; m < 4; ++m) { const int row = row0 + ai * HALF + m * 16; const f32x4 cs = csv[m], sn = snv[m];
#pragma unroll
                    for (int bj = 0; bj < 2; ++bj) { const f32x4 v0 = bperm4(pidx, acc[ai][bj][m][0]), v1 = bperm4(pidx, acc[ai][bj][m][1]);
                        u32x4 w;
                        w.x = cvt_pk_bf16(v0[0] * cs[0] - v0[1] * sn[0], v0[0] * sn[0] + v0[1] * cs[0]);
                        w.y = cvt_pk_bf16(v0[2] * cs[1] - v0[3] * sn[1], v0[2] * sn[1] + v0[3] * cs[1]);
                        w.z = cvt_pk_bf16(v1[0] * cs[2] - v1[1] * sn[2], v1[0] * sn[2] + v1[1] * cs[2]);
                        w.w = cvt_pk_bf16(v1[2] * cs[3] - v1[3] * sn[3], v1[2] * sn[3] + v1[3] * cs[3]);
                        *(u32x4*)(base + (size_t)row * 512 + lc0 + bj * HALF) = w; } } }
        } else {
            const int seg = (colt - 1024) >> 10;
            bf16_t* base = seg == 0 ? V : seg == 1 ? G : seg == 2 ? U : seg == 3 ? SV : seg == 4 ? GA : GB;
            const int lc0 = ((colt - 1024) & 1023) + wc * 32 + 8 * fq2;
#pragma unroll
            for (int ai = 0; ai < 2; ++ai)
#pragma unroll
                for (int m = 0; m < 4; ++m) { const int row = row0 + ai * HALF + m * 16; float s1[2] = {0.f, 0.f}, s2[2] = {0.f, 0.f};
#pragma unroll
                    for (int bj = 0; bj < 2; ++bj) { f32x4 v0 = acc[ai][bj][m][0] * osc, v1 = acc[ai][bj][m][1] * osc;
                        if (seg == 1) {
#pragma unroll
                            for (int e = 0; e < 4; ++e) { v0[e] = silu1(v0[e]); v1[e] = silu1(v1[e]); }
                        } else if (seg == 2 || seg == 3) {
                            f32x2 a = gelu_pk((f32x2){v0[0], v0[1]}), b = gelu_pk((f32x2){v0[2], v0[3]}), c = gelu_pk((f32x2){v1[0], v1[1]}), d = gelu_pk((f32x2){v1[2], v1[3]});
                            v0 = (f32x4){a.x, a.y, b.x, b.y}; v1 = (f32x4){c.x, c.y, d.x, d.y};
                        } else if (seg >= 4) {
#pragma unroll
                            for (int e = 0; e < 4; ++e) { v0[e] = sigm1(v0[e]); v1[e] = sigm1(v1[e]); }
                        }
                        if (seg == 3) { s1[bj] = ((v0[0] + v0[1]) + (v0[2] + v0[3])) + ((v1[0] + v1[1]) + (v1[2] + v1[3]));
                            s2[bj] = ((v0[0] * v0[0] + v0[1] * v0[1]) + (v0[2] * v0[2] + v0[3] * v0[3])) + ((v1[0] * v1[0] + v1[1] * v1[1]) + (v1[2] * v1[2] + v1[3] * v1[3])); }
                        if (seg == 0) { u32x4 w; w.x = cvt_pk_bf16(v0[0], v0[1]); w.y = cvt_pk_bf16(v0[2], v0[3]); w.z = cvt_pk_bf16(v1[0], v1[1]); w.w = cvt_pk_bf16(v1[2], v1[3]);
                            *(u32x4*)(base + (size_t)row * 1024 + lc0 + bj * HALF) = bperm4u(pidx, w); }
                        else { const float fs = seg >= 4 ? 256.0f : 16.0f;
                            int t0 = __builtin_amdgcn_cvt_pk_fp8_f32(v0[0] * fs, v0[1] * fs, 0, false); t0 = __builtin_amdgcn_cvt_pk_fp8_f32(v0[2] * fs, v0[3] * fs, t0, true);
                            int t1 = __builtin_amdgcn_cvt_pk_fp8_f32(v1[0] * fs, v1[1] * fs, 0, false); t1 = __builtin_amdgcn_cvt_pk_fp8_f32(v1[2] * fs, v1[3] * fs, t1, true);
                            u32x2 w8; w8.x = bperm(pidx, (unsigned)t0); w8.y = bperm(pidx, (unsigned)t1);
                            *(u32x2*)((unsigned char*)base + (size_t)row * 1024 + lc0 + bj * HALF) = w8; } }
                    if (seg == 3) {
                        float a = s1[0] + s1[1], b = s2[0] + s2[1];
                        a += __shfl_xor(a, 16); b += __shfl_xor(b, 16); a += __shfl_xor(a, 32); b += __shfl_xor(b, 32);
                        if (fq == 0) { float* sp = svstat + (size_t)(u.pm * BM + wr * 64 + fr + ai * HALF + m * 16) * 2; atomicAdd(sp, a); atomicAdd(sp + 1, b); } } }
        }
    }
};
template <bool ACCUM> struct EpiGate {
    static constexpr bool PERM = true, AFTER_DRAIN = false, HAS_MID = false;
    const bf16_t* GT; bf16_t* TMP; unsigned char* OUT8; float osc;
    __device__ __forceinline__ void operator()(const f32x4 (&acc)[2][2][4][2], const Unit& u, int wr, int wc, int fr, int fq) const {
        PG8_REMAP();
        const int row0 = u.pm * BM + wr * 64 + fr2, col0 = u.pn * BM + wc * 32 + 8 * fq2;
#pragma unroll
        for (int ai = 0; ai < 2; ++ai)
#pragma unroll
            for (int mp = 0; mp < 2; ++mp) {
                u32x4 gv[2][2], pv[2][2];
#pragma unroll
                for (int mm = 0; mm < 2; ++mm)
#pragma unroll
                    for (int bj = 0; bj < 2; ++bj) { const size_t off = (size_t)(row0 + ai * HALF + (2 * mp + mm) * 16) * 1024 + col0 + bj * HALF;
                        gv[mm][bj] = *(const u32x4*)(GT + off); if (ACCUM) pv[mm][bj] = *(const u32x4*)(TMP + off); }
#pragma unroll
                for (int mm = 0; mm < 2; ++mm)
#pragma unroll
                    for (int bj = 0; bj < 2; ++bj) { const int m = 2 * mp + mm; const size_t off = (size_t)(row0 + ai * HALF + m * 16) * 1024 + col0 + bj * HALF;
                        const f32x4 v0 = bperm4(pidx, acc[ai][bj][m][0]) * osc, v1 = bperm4(pidx, acc[ai][bj][m][1]) * osc; const u32x4 g = gv[mm][bj];
                        float o[8] = {v0[0] * bflo(g.x), v0[1] * bfhi(g.x), v0[2] * bflo(g.y), v0[3] * bfhi(g.y), v1[0] * bflo(g.z), v1[1] * bfhi(g.z), v1[2] * bflo(g.w), v1[3] * bfhi(g.w)};
                        if (ACCUM) { const u32x4 p = pv[mm][bj];
                            o[0] += bflo(p.x); o[1] += bfhi(p.x); o[2] += bflo(p.y); o[3] += bfhi(p.y); o[4] += bflo(p.z); o[5] += bfhi(p.z); o[6] += bflo(p.w); o[7] += bfhi(p.w);
                            u32x2 w8; int t0 = __builtin_amdgcn_cvt_pk_fp8_f32(o[0] * 8.f, o[1] * 8.f, 0, false); t0 = __builtin_amdgcn_cvt_pk_fp8_f32(o[2] * 8.f, o[3] * 8.f, t0, true);
                            int t1 = __builtin_amdgcn_cvt_pk_fp8_f32(o[4] * 8.f, o[5] * 8.f, 0, false); t1 = __builtin_amdgcn_cvt_pk_fp8_f32(o[6] * 8.f, o[7] * 8.f, t1, true);
                            w8.x = (unsigned)t0; w8.y = (unsigned)t1; *(u32x2*)(OUT8 + off) = w8;
                        } else {
                            u32x4 w; w.x = cvt_pk_bf16(o[0], o[1]); w.y = cvt_pk_bf16(o[2], o[3]); w.z = cvt_pk_bf16(o[4], o[5]); w.w = cvt_pk_bf16(o[6], o[7]);
                            *(u32x4*)(TMP + off) = w; } }
            }
    }
};
struct EpiMerged {
    static constexpr bool PERM = true, AFTER_DRAIN = false, HAS_MID = true;
    const unsigned char* GA; const unsigned char* GB; unsigned char* OUT8; float osc;
    __device__ __forceinline__ void mid(f32x4 (&acc)[2][2][4][2], const Unit& u, int wr, int wc, int fr, int fq) const {
        int fr_ = fr, fq_ = fq; asm volatile("" : "+v"(fr_), "+v"(fq_));
        const int row0 = u.pm * BM + wr * 64 + fr_, col0 = u.pn * BM + wc * 32 + 8 * fq_;
#pragma unroll
        for (int ai = 0; ai < 2; ++ai)
#pragma unroll
            for (int mp = 0; mp < 2; ++mp) {
                u32x2 av[2][2], bv[2][2];
#pragma unroll
                for (int mm = 0; mm < 2; ++mm)
#pragma unroll
                    for (int bj = 0; bj < 2; ++bj) { const size_t off = (size_t)(row0 + ai * HALF + (2 * mp + mm) * 16) * 1024 + col0 + bj * HALF; av[mm][bj] = *(const u32x2*)(GA + off); bv[mm][bj] = *(const u32x2*)(GB + off); }
#pragma unroll
                for (int mm = 0; mm < 2; ++mm)
#pragma unroll
                    for (int bj = 0; bj < 2; ++bj) { const int m = 2 * mp + mm; const f32x4 a0 = f8x4(av[mm][bj].x), a1 = f8x4(av[mm][bj].y), b0 = f8x4(bv[mm][bj].x), b1 = f8x4(bv[mm][bj].y);
#pragma unroll
                        for (int e = 0; e < 4; ++e) { acc[ai][bj][m][0][e] *= 2.f * a0[e] * __builtin_amdgcn_rcpf(__builtin_fmaxf(b0[e], 0.001953125f)); acc[ai][bj][m][1][e] *= 2.f * a1[e] * __builtin_amdgcn_rcpf(__builtin_fmaxf(b1[e], 0.001953125f)); } }
            }
    }
    __device__ __forceinline__ void operator()(const f32x4 (&acc)[2][2][4][2], const Unit& u, int wr, int wc, int fr, int fq) const {
        PG8_REMAP();
        const int row0 = u.pm * BM + wr * 64 + fr2, col0 = u.pn * BM + wc * 32 + 8 * fq2; const float sc = osc * 8.f * (1.0f / 256.0f);
#pragma unroll
        for (int ai = 0; ai < 2; ++ai)
#pragma unroll
            for (int mp = 0; mp < 2; ++mp) {
                u32x2 gv[2][2];
#pragma unroll
                for (int mm = 0; mm < 2; ++mm)
#pragma unroll
                    for (int bj = 0; bj < 2; ++bj) gv[mm][bj] = *(const u32x2*)(GB + (size_t)(row0 + ai * HALF + (2 * mp + mm) * 16) * 1024 + col0 + bj * HALF);
#pragma unroll
                for (int mm = 0; mm < 2; ++mm)
#pragma unroll
                    for (int bj = 0; bj < 2; ++bj) { const int m = 2 * mp + mm; const size_t off = (size_t)(row0 + ai * HALF + m * 16) * 1024 + col0 + bj * HALF;
                        const f32x4 v0 = bperm4(pidx, acc[ai][bj][m][0]) * sc * f8x4(gv[mm][bj].x), v1 = bperm4(pidx, acc[ai][bj][m][1]) * sc * f8x4(gv[mm][bj].y);
                        u32x2 w8; int t0 = __builtin_amdgcn_cvt_pk_fp8_f32(v0[0], v0[1], 0, false); t0 = __builtin_amdgcn_cvt_pk_fp8_f32(v0[2], v0[3], t0, true);
                        int t1 = __builtin_amdgcn_cvt_pk_fp8_f32(v1[0], v1[1], 0, false); t1 = __builtin_amdgcn_cvt_pk_fp8_f32(v1[2], v1[3], t1, true);
                        w8.x = (unsigned)t0; w8.y = (unsigned)t1; *(u32x2*)(OUT8 + off) = w8; }
            }
    }
};
struct EpiX1 {
    static constexpr bool PERM = false, AFTER_DRAIN = false, HAS_MID = false;
    const float* X; const float* gate1; bf16_t* X1; float osc;
    __device__ __forceinline__ void operator()(const f32x4 (&acc)[2][2][4][2], const Unit& u, int wr, int wc, int fr, int fq) const {
        PG8_REMAP();
        const int row0 = u.pm * BM + wr * 64 + fr2, col0 = u.pn * BM + wc * 32 + 4 * fq2;
        const float* gp = gate1 + (size_t)((u.pm * BM) >> 12) * 6144 + col0;
        f32x4 gv[2][2];
#pragma unroll
        for (int bj = 0; bj < 2; ++bj)
#pragma unroll
            for (int n = 0; n < 2; ++n) gv[bj][n] = *(const f32x4*)(gp + bj * HALF + n * 16) * osc;
#pragma unroll
        for (int ai = 0; ai < 2; ++ai)
#pragma unroll
            for (int mp = 0; mp < 2; ++mp) {
                f32x4 xv[2][2][2];
#pragma unroll
                for (int mm = 0; mm < 2; ++mm) { const size_t off = (size_t)(row0 + ai * HALF + (2 * mp + mm) * 16) * 1024 + col0;
#pragma unroll
                    for (int bj = 0; bj < 2; ++bj)
#pragma unroll
                        for (int n = 0; n < 2; ++n) xv[mm][bj][n] = *(const f32x4*)(X + off + bj * HALF + n * 16); }
#pragma unroll
                for (int mm = 0; mm < 2; ++mm) { const int m = 2 * mp + mm; const size_t off = (size_t)(row0 + ai * HALF + m * 16) * 1024 + col0;
#pragma unroll
                    for (int bj = 0; bj < 2; ++bj)
#pragma unroll
                        for (int n = 0; n < 2; ++n) { const f32x4 x1 = xv[mm][bj][n] + gv[bj][n] * bperm4(pidx, acc[ai][bj][m][n]); u32x2 w; w.x = cvt_pk_bf16(x1[0], x1[1]); w.y = cvt_pk_bf16(x1[2], x1[3]); *(u32x2*)(X1 + off + bj * HALF + n * 16) = w; } }
            }
    }
};
struct EpiPlain {
    static constexpr bool PERM = true, AFTER_DRAIN = false, HAS_MID = false;
    bf16_t* O; int ldc;
    __device__ __forceinline__ void operator()(const f32x4 (&acc)[2][2][4][2], const Unit& u, int wr, int wc, int fr, int fq) const {
        PG8_REMAP();
        const int row0 = u.pm * BM + wr * 64 + fr2, col0 = u.pn * BM + wc * 32 + 8 * fq2;
#pragma unroll
        for (int ai = 0; ai < 2; ++ai)
#pragma unroll
            for (int m = 0; m < 4; ++m) { bf16_t* rowp = O + (size_t)(row0 + ai * HALF + m * 16) * ldc + col0;
#pragma unroll
                for (int bj = 0; bj < 2; ++bj) { const f32x4 v0 = acc[ai][bj][m][0], v1 = acc[ai][bj][m][1];
                    u32x4 w; w.x = cvt_pk_bf16(v0[0], v0[1]); w.y = cvt_pk_bf16(v0[2], v0[3]); w.z = cvt_pk_bf16(v1[0], v1[1]); w.w = cvt_pk_bf16(v1[2], v1[3]);
                    *(u32x4*)(rowp + bj * HALF) = bperm4u(pidx, w); } }
    }
};
typedef int v8i_t __attribute__((ext_vector_type(8)));
typedef int v4i_t __attribute__((ext_vector_type(4)));
template <bool F8> __device__ __forceinline__ void mma_block(f32x4 (&acc)[4][2], const bf16x8 (&At)[4][2], const bf16x8 (&Bt)[2][2]) {
    if constexpr (F8) {
        v8i_t bb[2];
#pragma unroll
        for (int n = 0; n < 2; ++n) bb[n] = __builtin_shufflevector(__builtin_bit_cast(v4i_t, Bt[n][0]), __builtin_bit_cast(v4i_t, Bt[n][1]), 0, 1, 2, 3, 4, 5, 6, 7);
#pragma unroll
        for (int m = 0; m < 4; ++m) { const v8i_t aa = __builtin_shufflevector(__builtin_bit_cast(v4i_t, At[m][0]), __builtin_bit_cast(v4i_t, At[m][1]), 0, 1, 2, 3, 4, 5, 6, 7);
#pragma unroll
            for (int n = 0; n < 2; ++n) asm volatile("v_mfma_scale_f32_16x16x128_f8f6f4 %0, %1, %2, %0, %3, %3 op_sel_hi:[0,0,0]" : "+v"(acc[m][n]) : "v"(bb[n]), "v"(aa), "v"(0x7F7F7F7F)); }
    } else {
#pragma unroll
        for (int m = 0; m < 4; ++m)
#pragma unroll
            for (int n = 0; n < 2; ++n)
#pragma unroll
                for (int k = 0; k < 2; ++k) acc[m][n] = __builtin_amdgcn_mfma_f32_16x16x32_bf16(Bt[n][k], At[m][k], acc[m][n], 0, 0, 0);
    }
}
template <class Epi, class Sched, bool ALIGN_EPI = false, bool SP2 = false, bool F8 = false>
__device__ __forceinline__ void gemm_phase(PG8_LAS unsigned char* lds, const Gemm g, const Sched& S, const Epi& E) {
    const int tid = threadIdx.x, wid = __builtin_amdgcn_readfirstlane(tid >> 6), lane = tid & 63, wr = wid >> 2, wc = wid & 3, fr = lane & 15, fq = lane >> 4;
    const int K = g.K, nt = K / BK, LD = g.ld ? g.ld : g.K, nh = g.ksplit ? g.ksplit : nt;
    unsigned voffA[2], voffB[2];
#pragma unroll
    for (int i = 0; i < 2; ++i) { int R, C; stage_rc(tid * 16 + i * 8192, R, C); const int Rb = Epi::PERM ? ((R & ~31) + perm32(R & 31)) : R;
        voffA[i] = (unsigned)(R * LD + C) * 2u; voffB[i] = (unsigned)(Rb * LD + C) * 2u; }
    const size_t kstep = (size_t)(BK * 2);
    const size_t hstep = (size_t)HALF * LD * 2;
    const size_t tstep = 2 * hstep;
    const unsigned ldsw = (unsigned)wid * 1024u;
    const int aoff = lds_byte(wr * 64 + fr, fq * 8), boff = lds_byte(wc * 32 + fr, fq * 8);
#define PG8_SA(b, h) (((b) * 2 + (h)) * HTB)
#define PG8_SB(b, h) ((4 + (b) * 2 + (h)) * HTB)
#define PG8_STAGE(bufoff, gbase, voff) do { _Pragma("unroll") for (int _i = 0; _i < 2; ++_i) \
        __builtin_amdgcn_global_load_lds((const unsigned*)((const char*)(gbase) + (voff)[_i]), (PG8_LAS unsigned*)(lds + (bufoff) + ldsw + _i * 8192), 16, 0, 0); } while (0)
#define PG8_LDA(dst, b, h) do { _Pragma("unroll") for (int m = 0; m < 4; ++m) _Pragma("unroll") for (int k = 0; k < 2; ++k) dst[m][k] = *(const PG8_LAS bf16x8*)(lds + PG8_SA(b, h) + aoff + m * 2048 + k * 1024); } while (0)
#define PG8_LDB(dst, b, h) do { _Pragma("unroll") for (int n = 0; n < 2; ++n) _Pragma("unroll") for (int k = 0; k < 2; ++k) dst[n][k] = *(const PG8_LAS bf16x8*)(lds + PG8_SB(b, h) + boff + n * 2048 + k * 1024); } while (0)
#define PG8_MMA(ai, bj, At, Bt) do { __builtin_amdgcn_s_setprio(1); mma_block<F8>(acc[ai][bj], At, Bt); __builtin_amdgcn_s_setprio(0); } while (0)
#define PG8_WAIT_V(n) asm volatile("s_waitcnt vmcnt(" #n ")" ::: "memory")
#define PG8_WAIT_L(n) asm volatile("s_waitcnt lgkmcnt(" #n ")" ::: "memory")
#define PG8_BAR __builtin_amdgcn_s_barrier()
#define PG8_SCHED __builtin_amdgcn_sched_barrier(0)
    Unit cur, nxt; int ui = 0;
#if MK_GPROBE
    unsigned long long gp_k = 0, gp_e = 0, gp_t = __builtin_amdgcn_s_memrealtime();
#endif
    if (!S.next(0, cur)) return;
    f32x4 acc[2][2][4][2];
#pragma unroll
    for (int a = 0; a < 2; ++a)
#pragma unroll
        for (int b = 0; b < 2; ++b)
#pragma unroll
            for (int m = 0; m < 4; ++m)
#pragma unroll
                for (int n = 0; n < 2; ++n) acc[a][b][m][n] = (f32x4){0.f, 0.f, 0.f, 0.f};
    bf16x8 At[4][2], B0[2][2], B1[2][2];
    const char* cA = (const char*)g.A + (size_t)cur.pm * tstep; const char* cB = (const char*)g.Bt + (size_t)cur.pn * tstep;
    const char* cA2 = g.A2 ? (const char*)g.A2 + (size_t)cur.pm * tstep : cA; const char* cB2 = g.Bt2 ? (const char*)g.Bt2 + (size_t)cur.pn * tstep : cB;
#define PG8_TA(tt) ((tt) < nh ? cA + (size_t)(tt) * kstep : cA2 + (size_t)((tt) - nh) * kstep)
#define PG8_TB(tt) ((tt) < nh ? cB + (size_t)(tt) * kstep : cB2 + (size_t)((tt) - nh) * kstep)
    S.a_ready(cur);
    if constexpr (SP2) {
        PG8_STAGE(PG8_SB(0, 0), cB, voffB); PG8_STAGE(PG8_SB(0, 1), cB + hstep, voffB); PG8_STAGE(PG8_SA(0, 0), cA, voffA); PG8_STAGE(PG8_SA(0, 1), cA + hstep, voffA);
        if (wr == 1) PG8_BAR;
        PG8_WAIT_V(2); PG8_BAR;
        PG8_STAGE(PG8_SB(1, 0), cB + kstep, voffB); PG8_STAGE(PG8_SA(1, 0), cA + kstep, voffA); PG8_STAGE(PG8_SB(1, 1), cB + hstep + kstep, voffB);
        PG8_WAIT_V(6); PG8_BAR;
    } else {
        PG8_STAGE(PG8_SB(0, 0), cB, voffB); PG8_STAGE(PG8_SA(0, 0), cA, voffA); PG8_STAGE(PG8_SB(0, 1), cB + hstep, voffB); PG8_STAGE(PG8_SA(0, 1), cA + hstep, voffA);
        if (wr == 1) PG8_BAR;
        PG8_WAIT_V(4); PG8_BAR;
        PG8_STAGE(PG8_SB(1, 0), cB + kstep, voffB); PG8_STAGE(PG8_SA(1, 0), cA + kstep, voffA); PG8_STAGE(PG8_SB(1, 1), cB + hstep + kstep, voffB);
        PG8_WAIT_V(6); PG8_BAR;
    }
    for (;;) {
        const bool has_next = S.next(ui + 1, nxt);
        const char* nA = has_next ? (const char*)g.A + (size_t)nxt.pm * tstep : cA; const char* nB = has_next ? (const char*)g.Bt + (size_t)nxt.pn * tstep : cB;
#pragma clang loop unroll(disable)
        for (int t = 0; t < nt; t += 2) {
            const bool last = (t == nt - 2);
            const char* a1 = PG8_TA(t + 1);
            const char* a2 = last ? nA : PG8_TA(t + 2); const char* b2 = last ? nB : PG8_TB(t + 2);
            const char* a3 = last ? nA + kstep : PG8_TA(t + 3); const char* b3 = last ? nB + kstep : PG8_TB(t + 3);
            if constexpr (Epi::HAS_MID) { if (t == nh) { if constexpr (F8) asm volatile("s_nop 15\n\ts_nop 15" ::: "memory"); E.mid(acc, cur, wr, wc, fr, fq); } }
            if (last && has_next) S.a_ready(nxt);
            if constexpr (SP2) {
            PG8_LDB(B0, 0, 0); PG8_LDB(B1, 0, 1); PG8_SCHED; PG8_LDA(At, 0, 0); PG8_STAGE(PG8_SA(1, 1), a1 + hstep, voffA);
            PG8_WAIT_V(8); PG8_WAIT_L(0); PG8_BAR; PG8_MMA(0, 0, At, B0); PG8_MMA(0, 1, At, B1); PG8_BAR; PG8_SCHED;
            PG8_LDA(At, 0, 1); PG8_STAGE(PG8_SB(0, 0), b2, voffB); PG8_STAGE(PG8_SB(0, 1), b2 + hstep, voffB); PG8_STAGE(PG8_SA(0, 0), a2, voffA);
            PG8_WAIT_V(8); PG8_WAIT_L(0); PG8_BAR; PG8_MMA(1, 0, At, B0); PG8_MMA(1, 1, At, B1); PG8_BAR; PG8_SCHED;
            PG8_LDB(B0, 1, 0); PG8_LDB(B1, 1, 1); PG8_SCHED; PG8_LDA(At, 1, 0); PG8_STAGE(PG8_SA(0, 1), a2 + hstep, voffA);
            PG8_WAIT_V(8); PG8_WAIT_L(0); PG8_BAR; PG8_MMA(0, 0, At, B0); PG8_MMA(0, 1, At, B1); PG8_BAR; PG8_SCHED;
            PG8_LDA(At, 1, 1); PG8_STAGE(PG8_SB(1, 0), b3, voffB); PG8_STAGE(PG8_SB(1, 1), b3 + hstep, voffB); PG8_STAGE(PG8_SA(1, 0), a3, voffA);
            PG8_WAIT_V(8); PG8_WAIT_L(0); PG8_BAR; PG8_MMA(1, 0, At, B0); PG8_MMA(1, 1, At, B1); PG8_BAR; PG8_SCHED;
            } else {
            PG8_LDB(B0, 0, 0); PG8_SCHED; PG8_LDA(At, 0, 0); PG8_STAGE(PG8_SA(1, 1), a1 + hstep, voffA);
            PG8_WAIT_L(8); PG8_BAR; PG8_WAIT_L(0); PG8_MMA(0, 0, At, B0); PG8_BAR; PG8_SCHED;
            PG8_LDB(B1, 0, 1); PG8_STAGE(PG8_SB(0, 0), b2, voffB);
            PG8_BAR; PG8_WAIT_L(0); PG8_MMA(0, 1, At, B1); PG8_BAR;
            PG8_LDA(At, 0, 1); PG8_STAGE(PG8_SA(0, 0), a2, voffA);
            PG8_BAR; PG8_WAIT_L(0); PG8_MMA(1, 0, At, B0); PG8_BAR; PG8_SCHED;
            PG8_STAGE(PG8_SB(0, 1), b2 + hstep, voffB);
            PG8_WAIT_V(6); PG8_BAR; PG8_MMA(1, 1, At, B1); PG8_BAR;
            PG8_LDB(B0, 1, 0); PG8_SCHED; PG8_LDA(At, 1, 0); PG8_STAGE(PG8_SA(0, 1), a2 + hstep, voffA);
            PG8_WAIT_L(8); PG8_BAR; PG8_WAIT_L(0); PG8_MMA(0, 0, At, B0); PG8_BAR; PG8_SCHED;
            PG8_LDB(B1, 1, 1); PG8_STAGE(PG8_SB(1, 0), b3, voffB);
            PG8_BAR; PG8_WAIT_L(0); PG8_MMA(0, 1, At, B1); PG8_BAR;
            PG8_LDA(At, 1, 1); PG8_STAGE(PG8_SA(1, 0), a3, voffA);
            PG8_BAR; PG8_WAIT_L(0); PG8_MMA(1, 0, At, B0); PG8_BAR; PG8_SCHED;
            PG8_STAGE(PG8_SB(1, 1), b3 + hstep, voffB);
            PG8_WAIT_V(6); PG8_BAR; PG8_MMA(1, 1, At, B1); PG8_BAR;
            }
        }
#if MK_GPROBE
        { const unsigned long long t_ = __builtin_amdgcn_s_memrealtime(); gp_k += t_ - gp_t; gp_t = t_; }
#endif
        if constexpr (F8) asm volatile("s_nop 15\n\ts_nop 15" ::: "memory");
        if constexpr (ALIGN_EPI) { if (wr == 0) PG8_BAR; }
        if constexpr (!Epi::AFTER_DRAIN) { E(acc, cur, wr, wc, fr, fq); S.done(cur); }
#if MK_GPROBE
        { asm volatile("s_waitcnt vmcnt(0)" ::: "memory"); const unsigned long long t_ = __builtin_amdgcn_s_memrealtime(); gp_e += t_ - gp_t; gp_t = t_; }
#endif
        if (!has_next) break;
#pragma unroll
        for (int a = 0; a < 2; ++a)
#pragma unroll
            for (int b = 0; b < 2; ++b)
#pragma unroll
                for (int m = 0; m < 4; ++m)
#pragma unroll
                    for (int n = 0; n < 2; ++n) acc[a][b][m][n] = (f32x4){0.f, 0.f, 0.f, 0.f};
        cur = nxt; cA = nA; cB = nB; ++ui;
        cA2 = g.A2 ? (const char*)g.A2 + (size_t)cur.pm * tstep : cA; cB2 = g.Bt2 ? (const char*)g.Bt2 + (size_t)cur.pn * tstep : cB;
        if constexpr (ALIGN_EPI) { if (wr == 1) PG8_BAR; }
    }
    PG8_WAIT_V(0);
    if constexpr (!ALIGN_EPI) { if (wr == 0) PG8_BAR; }
    PG8_BAR;
    if constexpr (Epi::AFTER_DRAIN) { E.fused(acc, cur, wr, wc, fr, fq, lds, wid, lane); S.done(cur); }
#if MK_GPROBE
    if (blockIdx.x == 0 && wid == 0 && lane == 0) { PG8_LAS unsigned* mq = (PG8_LAS unsigned*)(lds + MK_MISC_OFF); mq[56] += (unsigned)gp_k; mq[57] += (unsigned)gp_e; }
#endif
#undef PG8_SA
#undef PG8_SB
#undef PG8_TA
#undef PG8_TB
#undef PG8_STAGE
#undef PG8_LDA
#undef PG8_LDB
#undef PG8_MMA
#undef PG8_WAIT_V
#undef PG8_WAIT_L
#undef PG8_BAR
#undef PG8_SCHED
}
}

constexpr int NWAVES = 8;
constexpr int N_LAUNCHES = MK_N_LAUNCHES;
constexpr int N_PHASES = 16;
constexpr int NB = 8, SEQ = 4096, DM = 1024, MT = NB * SEQ, NIN = 7168;
constexpr float EPSN = 1e-6f;

constexpr size_t MiB = 1u << 20;
constexpr size_t WS_CTL = 0, CTL_ZERO_BYTES = 1 * MiB;
constexpr size_t WS_SVSTAT = 512 * 1024;
constexpr size_t WS_MOD = 1 * MiB;
constexpr size_t WS_COS = 2 * MiB, WS_SIN = 3 * MiB;
constexpr size_t WS_SK = 4 * MiB;
constexpr size_t WS_SGUW = 4 * MiB + 512 * 1024;
constexpr size_t WS_WRET = 6 * MiB, WS_WSGU = 8 * MiB, WS_WOUT = 10 * MiB, WS_WQ = 12 * MiB, WS_WIN = 16 * MiB;
constexpr size_t WS_UE8 = 32 * MiB, WS_VE8 = 48 * MiB;
constexpr size_t WS_YG8 = 288 * MiB;
constexpr size_t WS_YS8 = 480 * MiB;
constexpr size_t WS_MRG8 = 96 * MiB;
constexpr size_t WS_ACT = 288 * MiB;
constexpr size_t WS_PEERS = 352 * MiB;
constexpr size_t WS_H2F8 = 96 * MiB;
constexpr size_t WS_EID = 128 * MiB, WS_GW = 144 * MiB;
constexpr size_t WS_PD = 160 * MiB;
constexpr size_t WS_V = 96 * MiB;
constexpr size_t WS_G = 160 * MiB;
constexpr size_t WS_X1B = 224 * MiB;
constexpr size_t WS_U = 224 * MiB;
constexpr size_t WS_SV = 288 * MiB;
constexpr size_t WS_GA = 352 * MiB, WS_GB = 416 * MiB;
constexpr size_t WS_SUB = 480 * MiB;
constexpr size_t WS_END = 512 * MiB;
constexpr size_t DO_H = 0, DO_Q = 64 * MiB, DO_K = 96 * MiB, DO_KVS = 0;

constexpr int CW_BAR = 4096;
constexpr int LDS_BYTES = 147456;
constexpr int MISC_OFF = LDS_BYTES - 256;

#define GAS __attribute__((address_space(1)))
#define LAS __attribute__((address_space(3)))
typedef unsigned short bf16;
typedef unsigned v4u __attribute__((ext_vector_type(4)));
typedef unsigned v2u __attribute__((ext_vector_type(2)));
typedef float f32x4 __attribute__((ext_vector_type(4)));
typedef float f32x2v __attribute__((ext_vector_type(2)));
typedef short bf16x8 __attribute__((ext_vector_type(8)));
typedef short s16x4 __attribute__((ext_vector_type(4)));
typedef __bf16 bf16x2_t __attribute__((ext_vector_type(2)));
typedef GAS unsigned gu32;
#define RLX_AGENT __ATOMIC_RELAXED, __HIP_MEMORY_SCOPE_AGENT
#define LDS_WAIT() asm volatile("s_waitcnt lgkmcnt(0)" ::: "memory")
using pg8::bflo; using pg8::bfhi; using pg8::gelu1;
__device__ __forceinline__ unsigned pk2(float lo, float hi) { f32x2v v = {lo, hi}; bf16x2_t b = __builtin_convertvector(v, bf16x2_t); return __builtin_bit_cast(unsigned, b); }
template <int CTRL> __device__ __forceinline__ float dpp_f(float v) { return __int_as_float(__builtin_amdgcn_update_dpp(0, __float_as_int(v), CTRL, 0xF, 0xF, false)); }
__device__ __forceinline__ float wave_sum(float v) {
    v += dpp_f<0xB1>(v); v += dpp_f<0x4E>(v); v += dpp_f<0x141>(v); v += dpp_f<0x140>(v);
    const int vi = __float_as_int(v);
    return (__int_as_float(__builtin_amdgcn_readlane(vi, 0)) + __int_as_float(__builtin_amdgcn_readlane(vi, 16))) + (__int_as_float(__builtin_amdgcn_readlane(vi, 32)) + __int_as_float(__builtin_amdgcn_readlane(vi, 48)));
}
__device__ __forceinline__ float fexp2(float x) { return __builtin_amdgcn_exp2f(x); }
__device__ __forceinline__ float clamp_f8(float x) { return __builtin_amdgcn_fmed3f(x, -448.0f, 448.0f); }
__device__ __forceinline__ unsigned pk4_fp8(float a, float b, float c, float d) { int w = __builtin_amdgcn_cvt_pk_fp8_f32(clamp_f8(a), clamp_f8(b), 0, false); w = __builtin_amdgcn_cvt_pk_fp8_f32(clamp_f8(c), clamp_f8(d), w, true); return (unsigned)w; }
__device__ __forceinline__ float rl_f(float v, int l) { return __int_as_float(__builtin_amdgcn_readlane(__float_as_int(v), l)); }
__device__ __forceinline__ unsigned rl_u(unsigned v, int l) { return (unsigned)__builtin_amdgcn_readlane((int)v, l); }

#define XB_TMO      128
#define XB_XCNT(j)  (256  + 64 * (j))
#define XB_XSUB(j)  (1280 + 64 * (j))
#define XB_XGEN(j)  (2304 + 64 * (j))
#define XB_TOP      3328
#define XB_TOPGEN   3392
#define XCD_BAR_WORDS 3456
#define XB_SPIN_CAP (1u << 22)
__device__ __forceinline__ unsigned xb_ld(unsigned* p)              { return __hip_atomic_load(p, __ATOMIC_RELAXED, __HIP_MEMORY_SCOPE_AGENT); }
__device__ __forceinline__ unsigned xb_add(unsigned* p, unsigned v) { return __hip_atomic_fetch_add(p, v, __ATOMIC_RELAXED, __HIP_MEMORY_SCOPE_AGENT); }
__device__ __forceinline__ unsigned xb_xcc_id() { return (unsigned)__builtin_amdgcn_s_getreg((3 << 11) | 20) & 0xFu; }
#define XB_SPIN(cond, bar) do { unsigned _sp = 0; while (cond) { __builtin_amdgcn_s_sleep(1); \
    if ((++_sp & 255u) == 0u) { if (xb_ld(&(bar)[XB_TMO])) break; if (_sp > XB_SPIN_CAP) { atomicAdd(&(bar)[XB_TMO], 1u); break; } } } } while (0)
struct XcdBarrier { unsigned* bar; unsigned x; volatile LAS unsigned* st; };
__device__ __forceinline__ XcdBarrier xcd_barrier_post(unsigned* bar, volatile LAS unsigned* st) {
    XcdBarrier b; b.bar = bar; b.x = xb_xcc_id(); b.st = st;
    if (threadIdx.x == 0) (void)xb_add(&bar[XB_XCNT(b.x)], 1u);
    return b;
}
__device__ __forceinline__ void xcd_barrier_complete(unsigned* bar, unsigned x, unsigned& nloc, unsigned& nx) {
    const unsigned G = gridDim.x * gridDim.y * gridDim.z;
    unsigned sum, cnt, mine, sp = 0u;
    for (;;) {
        sum = 0u; cnt = 0u; mine = 0u;
#pragma unroll
        for (unsigned j = 0; j < 16; ++j) { const unsigned c = xb_ld(&bar[XB_XCNT(j)]); sum += c; cnt += (c > 0u) ? 1u : 0u; mine = (j == x) ? c : mine; }
        if (sum == G) break;
        __builtin_amdgcn_s_sleep(1);
        if ((++sp & 255u) == 0u) { if (xb_ld(&bar[XB_TMO])) break; if (sp > XB_SPIN_CAP) { atomicAdd(&bar[XB_TMO], 1u); break; } }
    }
    nloc = mine > 0u ? mine : 1u; nx = cnt > 0u ? cnt : 1u;
}
__device__ __forceinline__ void xcd_barrier(const XcdBarrier& b) {
    asm volatile("s_waitcnt vmcnt(0)" ::: "memory");
    __syncthreads();
    if (threadIdx.x == 0) {
        unsigned* bar = b.bar;
        __builtin_amdgcn_s_waitcnt(0);
        unsigned nloc = b.st[0], nx = b.st[1];
        if (nloc == 0u) { xcd_barrier_complete(bar, b.x, nloc, nx); b.st[0] = nloc; b.st[1] = nx; }
        const unsigned old = xb_add(&bar[XB_XSUB(b.x)], 1u);
        const unsigned gen = old / nloc;
        if (old + 1u == (gen + 1u) * nloc) {
            __builtin_amdgcn_fence(__ATOMIC_RELEASE, "agent");
            asm volatile("s_waitcnt vmcnt(0)" ::: "memory");
            const unsigned og = xb_add(&bar[XB_TOP], 1u);
            const unsigned tg = og / nx;
            if (og + 1u == (tg + 1u) * nx) xb_add(&bar[XB_TOPGEN], 1u);
            else XB_SPIN(xb_ld(&bar[XB_TOPGEN]) == tg, bar);
            __builtin_amdgcn_fence(__ATOMIC_ACQUIRE, "agent");
            xb_add(&bar[XB_XGEN(b.x)], 1u);
            asm volatile("s_waitcnt vmcnt(0)" ::: "memory");
        } else {
            XB_SPIN(xb_ld(&bar[XB_XGEN(b.x)]) == gen, bar);
            __builtin_amdgcn_fence(__ATOMIC_ACQUIRE, "agent");
            asm volatile("s_waitcnt vmcnt(0)" ::: "memory");
        }
    }
    __syncthreads();
}

struct Frame {
    LAS unsigned char* lds;
    int tid, lane, wave, G, bid; volatile LAS unsigned* misc;
    __device__ __forceinline__ void fence_ids() { int t = threadIdx.x; asm volatile("" : "+v"(t)); tid = t; lane = t & 63; }
    const float *x, *c, *w_ada, *b_ada, *norm1_g, *w_in, *ret_gn_g, *sgu_ln_g, *sgu_ln_b, *sgu_w, *sgu_b, *w_ret_out, *w_sgu_out, *w_out, *norm2_g, *peer_w_q, *peer_sub_keys, *peer_u, *peer_v, *final_g;
    unsigned char* ws; unsigned char* dout;
};

__device__ __forceinline__ bf16x8 lds_row_frag(LAS const unsigned char* img, int stride, int r0, int k0, int lane) {
    return *(LAS const bf16x8*)(img + (r0 + (lane & 15)) * stride + (k0 + 8 * (lane >> 4)) * 2);
}
__device__ __forceinline__ s16x4 tr16(LAS const unsigned char* p) { return __builtin_bit_cast(s16x4, __builtin_amdgcn_ds_read_tr16_b64_v4i16((LAS s16x4*)p)); }
__device__ __forceinline__ bf16x8 lds_tr_frag(LAS const unsigned char* img, int stride, int k0, int n0, int lane) {
    const int g = lane >> 4, q = (lane >> 2) & 3, p = lane & 3;
    LAS const unsigned char* a = img + (k0 + 8 * g + q) * stride + (n0 + 4 * p) * 2;
    const s16x4 lo = tr16(a), hi = tr16(a + 4 * stride);
    return __builtin_shufflevector(lo, hi, 0, 1, 2, 3, 4, 5, 6, 7);
}
#define MFMA16(a, b, c) __builtin_amdgcn_mfma_f32_16x16x32_bf16((a), (b), (c), 0, 0, 0)
constexpr int KS = 272, VS = 528;

template <bool F8, class Map>
__device__ __forceinline__ void transpose_item(const float* W, int K, int N, bf16* WT, LAS float* scr, int item, int lane, Map srcmap) {
    const int nblk = N / 32, kb = item / nblk, nb = item % nblk, k0 = 64 * kb, n0 = 32 * nb;
    const int sc = srcmap(n0 + (lane & 31));
#pragma unroll 8
    for (int i = 0; i < 32; ++i) { const int kk = 2 * i + (lane >> 5); scr[kk * 33 + (lane & 31)] = W[(size_t)(k0 + kk) * N + sc]; }
    LDS_WAIT(); asm volatile("" ::: "memory");
    const int c = lane & 7;
#pragma unroll
    for (int j = 0; j < 4; ++j) { const int n = (lane >> 3) + 8 * j; const LAS float* s = scr + (8 * c) * 33 + n;
        if (F8) { v2u o8; o8.x = pk4_fp8(s[0 * 33] * 512.f, s[1 * 33] * 512.f, s[2 * 33] * 512.f, s[3 * 33] * 512.f); o8.y = pk4_fp8(s[4 * 33] * 512.f, s[5 * 33] * 512.f, s[6 * 33] * 512.f, s[7 * 33] * 512.f);
            *(v2u*)((unsigned char*)WT + (size_t)(n0 + n) * K + k0 + 8 * c) = o8; }
        else { v4u o; o.x = pk2(s[0 * 33], s[1 * 33]); o.y = pk2(s[2 * 33], s[3 * 33]); o.z = pk2(s[4 * 33], s[5 * 33]); o.w = pk2(s[6 * 33], s[7 * 33]);
            *(v4u*)(WT + (size_t)(n0 + n) * K + k0 + 8 * c) = o; } }
    LDS_WAIT(); asm volatile("" ::: "memory");
}
struct MapId { __device__ __forceinline__ int operator()(int n) const { return n; } };
struct MapWin { __device__ __forceinline__ int operator()(int n) const { if (n >= 1024) return n; const int ci = n & 127; return (n & ~127) + (ci >> 1) + 64 * (ci & 1); } };

__device__ __forceinline__ void cvt8(const float* src, bf16* dst, size_t chunk) {
    const f32x4 a = *(const f32x4*)(src + chunk * 8), b = *(const f32x4*)(src + chunk * 8 + 4);
    v4u o; o.x = pk2(a[0], a[1]); o.y = pk2(a[2], a[3]); o.z = pk2(b[0], b[1]); o.w = pk2(b[2], b[3]);
    *(v4u*)(dst + chunk * 8) = o;
}

__device__ __forceinline__ void p0a(Frame& F) { F.fence_ids();
    if (F.bid < 192) {
        LAS float* sc = (LAS float*)F.lds; LAS float* part = (LAS float*)(F.lds + 32768);
        for (int i = F.tid; i < 8192; i += 512) { const float cv = F.c[i]; sc[i] = pg8::silu1(cv); }
        __syncthreads();
        const int n0 = 32 * F.bid, ks = F.tid >> 3, c4 = F.tid & 7;
        f32x4 acc[8];
#pragma unroll
        for (int b = 0; b < 8; ++b) acc[b] = (f32x4){0.f, 0.f, 0.f, 0.f};
        for (int kk = ks; kk < 1024; kk += 64) { const f32x4 w = *(const f32x4*)(F.w_ada + (size_t)kk * 6144 + n0 + 4 * c4);
#pragma unroll
            for (int b = 0; b < 8; ++b) acc[b] += w * sc[b * 1024 + kk]; }
#pragma unroll
        for (int b = 0; b < 8; ++b) *(LAS f32x4*)(part + (ks * 8 + b) * 32 + 4 * c4) = acc[b];
        __syncthreads();
        if (F.tid < 256) { const int b = F.tid >> 5, col = F.tid & 31; float s = 0.f;
            for (int k2 = 0; k2 < 64; ++k2) s += part[(k2 * 8 + b) * 32 + col];
            ((float*)(F.ws + WS_MOD))[b * 6144 + n0 + col] = s + F.b_ada[n0 + col]; }
        __syncthreads();
    }
    {
        LAS float* scr = (LAS float*)(F.lds + F.wave * 16384);
        const int gw = F.bid * NWAVES + F.wave, NGW = F.G * NWAVES;
        constexpr int I_IN = 16 * (NIN / 32), I_SQ = 16 * 32, I_Q = 16 * 64, NITEMS = I_IN + 3 * I_SQ + I_Q;
        for (int it = gw; it < NITEMS; it += NGW) {
            int r = it;
            if (r < I_IN) { transpose_item<true>(F.w_in, 1024, NIN, (bf16*)(F.ws + WS_WIN), scr, r, F.lane, MapWin()); continue; } r -= I_IN;
            if (r < I_SQ) { transpose_item<true>(F.w_ret_out, 1024, 1024, (bf16*)(F.ws + WS_WRET), scr, r, F.lane, MapId()); continue; } r -= I_SQ;
            if (r < I_SQ) { transpose_item<true>(F.w_sgu_out, 1024, 1024, (bf16*)(F.ws + WS_WSGU), scr, r, F.lane, MapId()); continue; } r -= I_SQ;
            if (r < I_SQ) { transpose_item<true>(F.w_out, 1024, 1024, (bf16*)(F.ws + WS_WOUT), scr, r, F.lane, MapId()); continue; } r -= I_SQ;
            transpose_item<false>(F.peer_w_q, 1024, 2048, (bf16*)(F.ws + WS_WQ), scr, r, F.lane, MapId());
        }
    }
    const size_t gt = (size_t)F.bid * 512 + F.tid, NT = (size_t)F.G * 512;
    for (size_t ch = gt; ch < (size_t)16384 * 64; ch += NT) {
        const f32x4* up = (const f32x4*)(F.peer_u + ch * 16); const f32x4* vp = (const f32x4*)(F.peer_v + ch * 16);
        v4u ou, ov;
#pragma unroll
        for (int q = 0; q < 4; ++q) { const f32x4 a = up[q] * 512.0f, b = vp[q] * 16.0f; ou[q] = pk4_fp8(a[0], a[1], a[2], a[3]); ov[q] = pk4_fp8(b[0], b[1], b[2], b[3]); }
        const size_t e_ = ch >> 6, c16_ = ch & 63, dst_ = (c16_ >> 3) * ((size_t)16384 * 128) + e_ * 128 + (c16_ & 7) * 16;
        *(v4u*)(F.ws + WS_VE8 + dst_) = ov;
        if (MK_U4) {
            v2u o4; unsigned w0 = 0u, w1 = 0u;
            { const f32x4 a0 = up[0] * 64.0f, a1 = up[1] * 64.0f, a2 = up[2] * 64.0f, a3 = up[3] * 64.0f;
              w0 = __builtin_amdgcn_cvt_scalef32_pk_fp4_f32(w0, a0[0], a0[1], 1.0f, 0); w0 = __builtin_amdgcn_cvt_scalef32_pk_fp4_f32(w0, a0[2], a0[3], 1.0f, 1);
              w0 = __builtin_amdgcn_cvt_scalef32_pk_fp4_f32(w0, a1[0], a1[1], 1.0f, 2); w0 = __builtin_amdgcn_cvt_scalef32_pk_fp4_f32(w0, a1[2], a1[3], 1.0f, 3);
              w1 = __builtin_amdgcn_cvt_scalef32_pk_fp4_f32(w1, a2[0], a2[1], 1.0f, 0); w1 = __builtin_amdgcn_cvt_scalef32_pk_fp4_f32(w1, a2[2], a2[3], 1.0f, 1);
              w1 = __builtin_amdgcn_cvt_scalef32_pk_fp4_f32(w1, a3[0], a3[1], 1.0f, 2); w1 = __builtin_amdgcn_cvt_scalef32_pk_fp4_f32(w1, a3[2], a3[3], 1.0f, 3); }
            o4.x = w0; o4.y = w1;
            *(v2u*)(F.ws + WS_UE8 + (c16_ >> 4) * ((size_t)16384 * 128) + e_ * 128 + (c16_ & 15) * 8) = o4;
        } else *(v4u*)(F.ws + WS_UE8 + dst_) = ou; }
    for (size_t ch = gt; ch < (size_t)32768; ch += NT) cvt8(F.peer_sub_keys, (bf16*)(F.ws + WS_SK), ch);
    for (size_t ch = gt; ch < (size_t)8192; ch += NT) { const int t = (int)(ch >> 4) & 127, s0 = (int)(ch & 15) * 8;
        const f32x4 a = *(const f32x4*)(F.sgu_w + ch * 8), b = *(const f32x4*)(F.sgu_w + ch * 8 + 4);
        float v[8] = {a[0], a[1], a[2], a[3], b[0], b[1], b[2], b[3]};
#pragma unroll
        for (int e = 0; e < 8; ++e) v[e] = (s0 + e <= t) ? v[e] : 0.f;
        v4u o; o.x = pk2(v[0], v[1]); o.y = pk2(v[2], v[3]); o.z = pk2(v[4], v[5]); o.w = pk2(v[6], v[7]);
        *(v4u*)((bf16*)(F.ws + WS_SGUW) + ch * 8) = o; }
    for (size_t e = gt; e < (size_t)4096 * 64; e += NT) { const int s = (int)(e >> 6), i = (int)(e & 63);
        const float inv = fexp2(-(float)i * (13.287712379549449f / 64.0f));
        const float rev = ((float)s * inv) * 0.15915494309189535f; const float fr = rev - __builtin_floorf(rev);
        ((float*)(F.ws + WS_COS))[e] = __builtin_amdgcn_cosf(fr); ((float*)(F.ws + WS_SIN))[e] = __builtin_amdgcn_sinf(fr); }
}

template <int MODE  > __device__ __forceinline__ void norm_rows(Frame& F, const float* X, const float* gain, const float* shift, const float* scale, bf16* O, unsigned char* O8) { F.fence_ids();
    const int gw = F.bid * NWAVES + F.wave, NGW = F.G * NWAVES;
    f32x4 g[4];
#pragma unroll
    for (int j = 0; j < 4; ++j) g[j] = *(const f32x4*)(gain + 4 * F.lane + 256 * j);
    f32x4 nx[4];
#define NR_LOAD(mm_) do { _Pragma("unroll") for (int j = 0; j < 4; ++j) { if (MODE == 1) { const v2u w_ = *((const v2u*)((const bf16*)X + (size_t)(mm_) * DM) + F.lane + 64 * j); nx[j] = (f32x4){bflo(w_.x), bfhi(w_.x), bflo(w_.y), bfhi(w_.y)}; } \
        else nx[j] = *((const f32x4*)(X + (size_t)(mm_) * DM) + F.lane + 64 * j); } } while (0)
    if (gw < MT) NR_LOAD(gw);
    for (int m = gw; m < MT; m += NGW) {
        f32x4 v[4]; float s = 0.f;
#pragma unroll
        for (int j = 0; j < 4; ++j) { v[j] = nx[j]; s += (v[j][0] * v[j][0] + v[j][1] * v[j][1]) + (v[j][2] * v[j][2] + v[j][3] * v[j][3]); }
        const int b = m >> 12;
        f32x4 sh[4], sc[4];
#pragma unroll
        for (int j = 0; j < 4; ++j) { const int d = 4 * F.lane + 256 * j; sh[j] = *(const f32x4*)(shift + b * 6144 + d); sc[j] = *(const f32x4*)(scale + b * 6144 + d); }
        if (m + NGW < MT) NR_LOAD(m + NGW);
        const float rstd = __builtin_amdgcn_rsqf(wave_sum(s) * (1.f / DM) + EPSN);
        v2u* o8 = (v2u*)(O + (size_t)m * DM) + F.lane;
#pragma unroll
        for (int j = 0; j < 4; ++j) { const int d = 4 * F.lane + 256 * j;
            const f32x4 h = v[j] * rstd * g[j] * (sc[j] + 1.0f) + sh[j];
            if (MODE == 2) { const f32x4 h8 = h * 8.0f; *(unsigned*)(O8 + (size_t)m * DM + d) = pk4_fp8(h8[0], h8[1], h8[2], h8[3]); }
            else { v2u w; w.x = pk2(h[0], h[1]); w.y = pk2(h[2], h[3]); o8[64 * j] = w; }
            if (MODE == 1) { const f32x4 hs = h * 16.0f; *(unsigned*)(O8 + (size_t)(d >> 8) * ((size_t)MT * 256) + (size_t)m * 256 + (d & 255)) = pk4_fp8(hs[0], hs[1], hs[2], hs[3]); } }
    }
}

__device__ __forceinline__ float lg_gamma(int h) { return __builtin_log2f(1.0f - fexp2((float)(-5 - h))); }
__device__ __forceinline__ v4u scale8(v4u w, float s) {
    v4u o; o.x = pk2(bflo(w.x) * s, bfhi(w.x) * s); o.y = pk2(bflo(w.y) * s, bfhi(w.y) * s); o.z = pk2(bflo(w.z) * s, bfhi(w.z) * s); o.w = pk2(bflo(w.w) * s, bfhi(w.w) * s); return o;
}
struct KvRegs { v4u k[4], v[8]; };
__device__ __forceinline__ void kv_load(Frame& F, int u, KvRegs& R) {
    const int b = u >> 7, h = (u >> 5) & 3, c = u & 31; const size_t tok0 = (size_t)b * SEQ + c * 128;
    const bf16* Kb = (const bf16*)(F.dout + DO_K); const bf16* Vb = (const bf16*)(F.ws + WS_V);
#pragma unroll
    for (int i = 0; i < 4; ++i) { const int ch = F.tid + 512 * i, j = ch >> 4, cc = ch & 15; R.k[i] = *(const v4u*)(Kb + (tok0 + j) * 512 + h * 128 + cc * 8); }
#pragma unroll
    for (int i = 0; i < 8; ++i) { const int ch = F.tid + 512 * i, j = ch >> 5, cc = ch & 31; R.v[i] = *(const v4u*)(Vb + (tok0 + j) * 1024 + h * 256 + cc * 8); }
}
__device__ __forceinline__ void kv_unit(Frame& F, int u, KvRegs& R, int unext) {
    const int b = u >> 7, h = (u >> 5) & 3, c = u & 31;
    LAS unsigned char* Kimg = F.lds; LAS unsigned char* Vimg = F.lds + 34816;
    const float lg = lg_gamma(h);
#pragma unroll
    for (int i = 0; i < 4; ++i) { const int ch = F.tid + 512 * i, j = ch >> 4, cc = ch & 15;
        *(LAS v4u*)(Kimg + j * KS + cc * 16) = scale8(R.k[i], fexp2((float)(127 - j) * lg)); }
#pragma unroll
    for (int i = 0; i < 8; ++i) { const int ch = F.tid + 512 * i, j = ch >> 5, cc = ch & 31; *(LAS v4u*)(Vimg + j * VS + cc * 16) = R.v[i]; }
    __syncthreads();
    if (unext >= 0) kv_load(F, unext, R);
    f32x4 acc[8][2];
#pragma unroll
    for (int dt = 0; dt < 8; ++dt) { acc[dt][0] = (f32x4){0.f, 0.f, 0.f, 0.f}; acc[dt][1] = (f32x4){0.f, 0.f, 0.f, 0.f}; }
#pragma unroll
    for (int js = 0; js < 4; ++js) {
        bf16x8 bv[2];
#pragma unroll
        for (int vt = 0; vt < 2; ++vt) bv[vt] = lds_tr_frag(Vimg, VS, 32 * js, 32 * F.wave + 16 * vt, F.lane);
#pragma unroll
        for (int dt = 0; dt < 8; ++dt) { const bf16x8 a = lds_tr_frag(Kimg, KS, 32 * js, 16 * dt, F.lane);
            acc[dt][0] = MFMA16(a, bv[0], acc[dt][0]); acc[dt][1] = MFMA16(a, bv[1], acc[dt][1]); }
    }
    bf16* dst = (bf16*)(F.dout + DO_KVS) + (size_t)(((b * 4 + h) * 32 + c)) * 32768;
#pragma unroll
    for (int dt = 0; dt < 8; ++dt)
#pragma unroll
        for (int vt = 0; vt < 2; ++vt) { const int v = 32 * F.wave + 16 * vt + (F.lane & 15), d0 = 16 * dt + 4 * (F.lane >> 4);
            v2u o; o.x = pk2(acc[dt][vt][0], acc[dt][vt][1]); o.y = pk2(acc[dt][vt][2], acc[dt][vt][3]);
            *(v2u*)(dst + v * 128 + d0) = o; }
    __syncthreads();
}
struct SguRegs { v2u sv[8]; f32x2v st[8]; };
__device__ __forceinline__ void sgu_load(Frame& F, int su, SguRegs& R) {
    const size_t tok0 = (size_t)(su >> 2) * 128; const int g = su & 3; const unsigned char* SVb = F.ws + WS_SV; const float* stat = (const float*)(F.ws + WS_SVSTAT);
    int tq = F.tid; asm volatile("" : "+v"(tq));
#pragma unroll
    for (int i = 0; i < 8; ++i) { const int ch = tq + 512 * i, sr = ch >> 5, cc = ch & 31;
        R.sv[i] = *(const v2u*)(SVb + (tok0 + sr) * 1024 + g * 256 + cc * 8); R.st[i] = *(const f32x2v*)(stat + (tok0 + sr) * 2); }
}
__device__ __forceinline__ void sgu_unit(Frame& F, int su, SguRegs& R, int snext, int& cur_g) {
    const size_t tok0 = (size_t)(su >> 2) * 128; const int g = su & 3;
    LAS unsigned char* Vn = F.lds; LAS unsigned char* Wimg = F.lds + 67584;
    const unsigned char* Ub = F.ws + WS_U; const bf16* Wm = (const bf16*)(F.ws + WS_SGUW);
    { const int cc = F.tid & 31; const int col = g * 256 + cc * 8;
        const f32x4 g0 = *(const f32x4*)(F.sgu_ln_g + col), g1 = *(const f32x4*)(F.sgu_ln_g + col + 4), b0 = *(const f32x4*)(F.sgu_ln_b + col), b1 = *(const f32x4*)(F.sgu_ln_b + col + 4);
#pragma unroll
        for (int i = 0; i < 8; ++i) { const int ch = F.tid + 512 * i, sr = ch >> 5; const f32x4 w0 = pg8::f8x4(R.sv[i].x) * 0.0625f, w1 = pg8::f8x4(R.sv[i].y) * 0.0625f;
            const float mean = R.st[i].x * (1.f / 1024.f), var = R.st[i].y * (1.f / 1024.f) - mean * mean, rstd = __builtin_amdgcn_rsqf(var + EPSN);
            v4u o;
            o.x = pk2((w0[0] - mean) * rstd * g0[0] + b0[0], (w0[1] - mean) * rstd * g0[1] + b0[1]);
            o.y = pk2((w0[2] - mean) * rstd * g0[2] + b0[2], (w0[3] - mean) * rstd * g0[3] + b0[3]);
            o.z = pk2((w1[0] - mean) * rstd * g1[0] + b1[0], (w1[1] - mean) * rstd * g1[1] + b1[1]);
            o.w = pk2((w1[2] - mean) * rstd * g1[2] + b1[2], (w1[3] - mean) * rstd * g1[3] + b1[3]);
            *(LAS v4u*)(Vn + sr * VS + cc * 16) = o; } }
    if (g != cur_g) { cur_g = g;
#pragma unroll
        for (int i = 0; i < 4; ++i) { const int ch = F.tid + 512 * i, t = ch >> 4, cc = ch & 15;
            *(LAS v4u*)(Wimg + t * KS + cc * 16) = *(const v4u*)(Wm + (size_t)(g * 128 + t) * 128 + cc * 8); } }
    __syncthreads();
    if (snext >= 0) sgu_load(F, snext, R);
    unsigned uv[8][2];
#pragma unroll
    for (int tt = 0; tt < 8; ++tt)
#pragma unroll
        for (int ct = 0; ct < 2; ++ct) uv[tt][ct] = *(const unsigned*)(Ub + (tok0 + 16 * tt + (F.lane & 15)) * 1024 + g * 256 + 32 * F.wave + 16 * ct + 4 * (F.lane >> 4));
    f32x4 acc[2][8];
#pragma unroll
    for (int ct = 0; ct < 2; ++ct)
#pragma unroll
        for (int tt = 0; tt < 8; ++tt) acc[ct][tt] = (f32x4){0.f, 0.f, 0.f, 0.f};
#pragma unroll
    for (int ss = 0; ss < 4; ++ss) {
        bf16x8 av[2];
#pragma unroll
        for (int ct = 0; ct < 2; ++ct) av[ct] = lds_tr_frag(Vn, VS, 32 * ss, 32 * F.wave + 16 * ct, F.lane);
#pragma unroll
        for (int tt = 0; tt < 8; ++tt) if (tt >= 2 * ss) { const bf16x8 bw = lds_row_frag(Wimg, KS, 16 * tt, 32 * ss, F.lane);
            acc[0][tt] = MFMA16(av[0], bw, acc[0][tt]); acc[1][tt] = MFMA16(av[1], bw, acc[1][tt]); }
    }
#pragma unroll
    for (int tt = 0; tt < 8; ++tt) { const int t = 16 * tt + (F.lane & 15); const float bs = F.sgu_b[g * 128 + t];
#pragma unroll
        for (int ct = 0; ct < 2; ++ct) { const int cg = g * 256 + 32 * F.wave + 16 * ct + 4 * (F.lane >> 4); const f32x4 u4 = pg8::f8x4(uv[tt][ct]) * 0.5f;
            *(unsigned*)(F.ws + WS_YS8 + (tok0 + t) * 1024 + cg) = pk4_fp8(u4[0] * (acc[ct][tt][0] + bs), u4[1] * (acc[ct][tt][1] + bs), u4[2] * (acc[ct][tt][2] + bs), u4[3] * (acc[ct][tt][3] + bs)); } }
    __syncthreads();
}
__device__ __forceinline__ void p2a(Frame& F) { F.fence_ids();
    { KvRegs R; if (F.bid < 1024) kv_load(F, F.bid, R);
      for (int u = F.bid; u < 1024; u += F.G) kv_unit(F, u, R, (u + F.G < 1024) ? u + F.G : -1); }
#if MK_PROBE_HI > 0
    if (F.bid == 0 && threadIdx.x == 0) { const unsigned long long _t = __builtin_amdgcn_s_memrealtime(); F.misc[16 + 2 * 20] = (unsigned)_t; F.misc[17 + 2 * 20] = (unsigned)(_t >> 32); }
#endif
    { SguRegs R; int cur_g = -1; if (F.bid < 1024) sgu_load(F, F.bid, R);
      for (int su = F.bid; su < 1024; su += F.G) sgu_unit(F, su, R, (su + F.G < 1024) ? su + F.G : -1, cur_g); }
}
__device__ __forceinline__ void p2b(Frame& F) { F.fence_ids();
    bf16* KVS = (bf16*)(F.dout + DO_KVS);
    for (int item = F.bid * 512 + F.tid; item < 32 * 4096; item += F.G * 512) {
        const int bh = item >> 12, rem = item & 4095, h = bh & 3;
        const float dc = fexp2(128.0f * lg_gamma(h));
        float s[8];
#pragma unroll
        for (int e = 0; e < 8; ++e) s[e] = 0.f;
        bf16* p = KVS + (size_t)bh * 32 * 32768 + (size_t)rem * 8;
        for (int c0 = 0; c0 < 32; c0 += 8) {
            v4u kv[8];
#pragma unroll
            for (int i = 0; i < 8; ++i) kv[i] = *(const v4u*)(p + (size_t)(c0 + i) * 32768);
#pragma unroll
            for (int i = 0; i < 8; ++i) {
                v4u o; o.x = pk2(s[0], s[1]); o.y = pk2(s[2], s[3]); o.z = pk2(s[4], s[5]); o.w = pk2(s[6], s[7]);
                *(v4u*)(p + (size_t)(c0 + i) * 32768) = o;
                s[0] = s[0] * dc + bflo(kv[i].x); s[1] = s[1] * dc + bfhi(kv[i].x); s[2] = s[2] * dc + bflo(kv[i].y); s[3] = s[3] * dc + bfhi(kv[i].y);
                s[4] = s[4] * dc + bflo(kv[i].z); s[5] = s[5] * dc + bfhi(kv[i].z); s[6] = s[6] * dc + bflo(kv[i].w); s[7] = s[7] * dc + bfhi(kv[i].w);
            }
        }
    }
}
struct RetRegs { v4u q[4], k[4], v[8]; };
__device__ __forceinline__ void ret_load(Frame& F, int u, RetRegs& R) {
    const int b = u >> 7, h = (u >> 5) & 3, c = u & 31; const size_t tok0 = (size_t)b * SEQ + c * 128;
    const bf16* Qb = (const bf16*)(F.dout + DO_Q); const bf16* Kb = (const bf16*)(F.dout + DO_K); const bf16* Vb = (const bf16*)(F.ws + WS_V);
#pragma unroll
    for (int i = 0; i < 4; ++i) { const int ch = F.tid + 512 * i, j = ch >> 4, cc = ch & 15;
        R.q[i] = *(const v4u*)(Qb + (tok0 + j) * 512 + h * 128 + cc * 8); R.k[i] = *(const v4u*)(Kb + (tok0 + j) * 512 + h * 128 + cc * 8); }
#pragma unroll
    for (int i = 0; i < 8; ++i) { const int ch = F.tid + 512 * i, j = ch >> 5, cc = ch & 31; R.v[i] = *(const v4u*)(Vb + (tok0 + j) * 1024 + h * 256 + cc * 8); }
}
__device__ __forceinline__ void ret_unit(Frame& F, int u, RetRegs& R, int unext) {
    const int b = u >> 7, h = (u >> 5) & 3, c = u & 31;
    const size_t tok0 = (size_t)b * SEQ + c * 128;
    LAS unsigned char* Qimg = F.lds; LAS unsigned char* Kimg = F.lds + 34816; LAS unsigned char* Vimg = F.lds + 69632;
    LAS unsigned char* Sout = F.lds;
    const unsigned char* Gb = F.ws + WS_G;
    const bf16* ST = (const bf16*)(F.dout + DO_KVS) + (size_t)(((b * 4 + h) * 32 + c)) * 32768;
    const float lg = lg_gamma(h);
    const int lane = F.lane, w = F.wave, l15 = lane & 15, g4 = lane >> 4;
#pragma unroll
    for (int i = 0; i < 4; ++i) { const int ch = F.tid + 512 * i, j = ch >> 4, cc = ch & 15;
        *(LAS v4u*)(Qimg + j * KS + cc * 16) = R.q[i]; *(LAS v4u*)(Kimg + j * KS + cc * 16) = R.k[i]; }
#pragma unroll
    for (int i = 0; i < 8; ++i) { const int ch = F.tid + 512 * i, j = ch >> 5, cc = ch & 31; *(LAS v4u*)(Vimg + j * VS + cc * 16) = R.v[i]; }
    bf16x8 bs[4][2];
#pragma unroll
    for (int ds = 0; ds < 4; ++ds)
#pragma unroll
        for (int vt = 0; vt < 2; ++vt) bs[ds][vt] = *(const bf16x8*)(ST + (size_t)(32 * w + 16 * vt + l15) * 128 + 32 * ds + 8 * g4);
    __syncthreads();
    f32x4 st[8];
#pragma unroll
    for (int jt = 0; jt < 8; ++jt) st[jt] = (f32x4){0.f, 0.f, 0.f, 0.f};
#pragma unroll
    for (int ds = 0; ds < 4; ++ds) { const bf16x8 bq = lds_row_frag(Qimg, KS, 16 * w, 32 * ds, lane);
#pragma unroll
        for (int jt = 0; jt < 8; ++jt) if (jt <= w) { const bf16x8 ak = lds_row_frag(Kimg, KS, 16 * jt, 32 * ds, lane); st[jt] = MFMA16(ak, bq, st[jt]); } }
    __syncthreads();
    { const int i = 16 * w + l15;
#pragma unroll
        for (int jt = 0; jt < 8; ++jt) { float o[4];
#pragma unroll
            for (int ii = 0; ii < 4; ++ii) { const int j = 16 * jt + 4 * g4 + ii; o[ii] = (i >= j) ? st[jt][ii] * fexp2((float)(i - j) * lg) : 0.f; }
            v2u pk; pk.x = pk2(o[0], o[1]); pk.y = pk2(o[2], o[3]);
            *(LAS v2u*)(Kimg + i * KS + (16 * jt + 4 * g4) * 2) = pk; } }
    __syncthreads();
    f32x4 acc[8][2];
#pragma unroll
    for (int it = 0; it < 8; ++it) { acc[it][0] = (f32x4){0.f, 0.f, 0.f, 0.f}; acc[it][1] = (f32x4){0.f, 0.f, 0.f, 0.f}; }
#pragma unroll
    for (int ds = 0; ds < 4; ++ds) {
#pragma unroll
        for (int it = 0; it < 8; ++it) { const bf16x8 a = lds_row_frag(Qimg, KS, 16 * it, 32 * ds, lane);
            acc[it][0] = MFMA16(a, bs[ds][0], acc[it][0]); acc[it][1] = MFMA16(a, bs[ds][1], acc[it][1]); } }
#pragma unroll
    for (int it = 0; it < 8; ++it)
#pragma unroll
        for (int ii = 0; ii < 4; ++ii) { const float dq = fexp2((float)(16 * it + 4 * g4 + ii + 1) * lg); acc[it][0][ii] *= dq; acc[it][1][ii] *= dq; }
#pragma unroll
    for (int js = 0; js < 4; ++js) { bf16x8 bv[2];
#pragma unroll
        for (int vt = 0; vt < 2; ++vt) bv[vt] = lds_tr_frag(Vimg, VS, 32 * js, 32 * w + 16 * vt, lane);
#pragma unroll
        for (int it = 0; it < 8; ++it) if (it >= 2 * js) { const bf16x8 a = lds_row_frag(Kimg, KS, 16 * it, 32 * js, lane);
            acc[it][0] = MFMA16(a, bv[0], acc[it][0]); acc[it][1] = MFMA16(a, bv[1], acc[it][1]); } }
    int lane_h = lane; asm volatile("" : "+v"(lane_h));
    unsigned gt[16];
#pragma unroll
    for (int rr = 0; rr < 16; ++rr) gt[rr] = *(const unsigned*)(Gb + (tok0 + 16 * w + rr) * 1024 + h * 256 + 4 * lane_h);
    const f32x4 gn = *(const f32x4*)(F.ret_gn_g + h * 256 + 4 * lane_h);
    __syncthreads();
#pragma unroll
    for (int it = 0; it < 8; ++it)
#pragma unroll
        for (int vt = 0; vt < 2; ++vt)
#pragma unroll
            for (int ii = 0; ii < 4; ++ii) *(LAS float*)(Sout + (16 * it + 4 * g4 + ii) * 1040 + (32 * w + 16 * vt + l15) * 4) = acc[it][vt][ii];
    __syncthreads();
#pragma unroll
    for (int rr = 0; rr < 16; ++rr) { const int i = 16 * w + rr;
        const f32x4 y = *(LAS const f32x4*)(Sout + i * 1040 + lane_h * 16);
        const float mean = wave_sum((y[0] + y[1]) + (y[2] + y[3])) * (1.f / 256.f);
        const f32x4 d = y - mean;
        const float var = wave_sum((d[0] * d[0] + d[1] * d[1]) + (d[2] * d[2] + d[3] * d[3])) * (1.f / 256.f);
        const float r8 = __builtin_amdgcn_rsqf(var + EPSN) * (4.0f / 16.0f);
        const size_t off = (tok0 + i) * 1024 + h * 256 + 4 * lane_h; const f32x4 gq = pg8::f8x4(gt[rr]);
        *(unsigned*)(F.ws + WS_YG8 + off) = pk4_fp8(d[0] * r8 * gn[0] * gq[0], d[1] * r8 * gn[1] * gq[1], d[2] * r8 * gn[2] * gq[2], d[3] * r8 * gn[3] * gq[3]); }
    __syncthreads();
}
__device__ __forceinline__ void p2c(Frame& F) { F.fence_ids(); for (int u = F.bid; u < 1024; u += F.G) { RetRegs R; ret_load(F, u, R); ret_unit(F, u, R, -1); } }

__device__ __forceinline__ float dppx(float v, int) { return v; }
template <int CTRL> __device__ __forceinline__ void merge16(float (&L)[16]) {
    float c[16];
#pragma unroll
    for (int i = 0; i < 16; ++i) c[i] = __builtin_fmaxf(L[i], dpp_f<CTRL>(L[15 - i]));
#pragma unroll
    for (int half = 8; half >= 1; half >>= 1)
#pragma unroll
        for (int i = 0; i < 16; ++i) if ((i & half) == 0) { const float hi = __builtin_fmaxf(c[i], c[i + half]), lo = __builtin_fminf(c[i], c[i + half]); c[i] = hi; c[i + half] = lo; }
#pragma unroll
    for (int i = 0; i < 16; ++i) L[i] = c[i];
}
__device__ __forceinline__ void sort16_desc(float (&v)[16]) {
#pragma unroll
    for (int k = 2; k <= 16; k <<= 1)
#pragma unroll
        for (int j = k >> 1; j >= 1; j >>= 1)
#pragma unroll
            for (int i = 0; i < 16; ++i) { const int l = i ^ j; if (l > i) { const bool desc = ((i & k) == 0) || (k == 16);
                const float hi = __builtin_fmaxf(v[i], v[l]), lo = __builtin_fminf(v[i], v[l]); v[i] = desc ? hi : lo; v[l] = desc ? lo : hi; } }
}
__device__ __forceinline__ void merge_top16(float (&A)[16], const float (&B)[16]) {
#pragma unroll
    for (int i = 0; i < 16; ++i) A[i] = __builtin_fmaxf(A[i], B[15 - i]);
#pragma unroll
    for (int half = 8; half >= 1; half >>= 1)
#pragma unroll
        for (int i = 0; i < 16; ++i) if ((i & half) == 0) { const float hi = __builtin_fmaxf(A[i], A[i + half]), lo = __builtin_fminf(A[i], A[i + half]); A[i] = hi; A[i + half] = lo; }
}
__device__ __forceinline__ void p5b(Frame& F) {
    F.fence_ids();
    LAS unsigned char* Aimg = F.lds; LAS unsigned char* Bimg = F.lds + 34816; LAS float* Sc = (LAS float*)(F.lds + 69632);
    const bf16* QP = (const bf16*)(F.ws + WS_GA);
    const int lane = F.lane, w = F.wave;
    int cur_hp = -1;
    v4u pa[4];
    if (F.bid < 4096) { const int tt = F.bid >> 4, hp = F.bid & 15;
#pragma unroll
        for (int i = 0; i < 4; ++i) { const int ch = F.tid + 512 * i, r = ch >> 4, cc = ch & 15; pa[i] = *(const v4u*)(QP + ((size_t)tt * 128 + r) * 2048 + hp * 128 + cc * 8); } }
    for (int u = F.bid; u < 4096; u += F.G) {
        const int tt = u >> 4, hp = u & 15; const size_t tok0 = (size_t)tt * 128;
#pragma unroll
        for (int i = 0; i < 4; ++i) { const int ch = F.tid + 512 * i, r = ch >> 4, cc = ch & 15; *(LAS v4u*)(Aimg + r * KS + cc * 16) = pa[i]; }
        if (hp != cur_hp) { const bf16* SK = (const bf16*)(F.ws + WS_SK) + (size_t)hp * 16384; cur_hp = hp;
#pragma unroll
            for (int i = 0; i < 4; ++i) { const int ch = F.tid + 512 * i, r = ch >> 4, cc = ch & 15; *(LAS v4u*)(Bimg + r * KS + cc * 16) = *(const v4u*)(SK + (size_t)r * 128 + cc * 8); } }
        __syncthreads();
        { const int un = u + F.G; if (un < 4096) { const int tn = un >> 4, hn = un & 15;
#pragma unroll
            for (int i = 0; i < 4; ++i) { const int ch = F.tid + 512 * i, r = ch >> 4, cc = ch & 15; pa[i] = *(const v4u*)(QP + ((size_t)tn * 128 + r) * 2048 + hn * 128 + cc * 8); } } }
        f32x4 acc[8];
#pragma unroll
        for (int nt = 0; nt < 8; ++nt) acc[nt] = (f32x4){0.f, 0.f, 0.f, 0.f};
#pragma unroll
        for (int ks = 0; ks < 4; ++ks) { const bf16x8 a = lds_row_frag(Aimg, KS, 16 * w, 32 * ks, lane);
#pragma unroll
            for (int nt = 0; nt < 8; ++nt) { const bf16x8 bb = lds_row_frag(Bimg, KS, 16 * nt, 32 * ks, lane); acc[nt] = MFMA16(a, bb, acc[nt]); } }
#pragma unroll
        for (int nt = 0; nt < 8; ++nt)
#pragma unroll
            for (int ii = 0; ii < 4; ++ii) Sc[(16 * w + 4 * (lane >> 4) + ii) * 132 + 16 * nt + (lane & 15)] = acc[nt][ii];
        __syncthreads();
        { const int row = F.tid >> 2, q = F.tid & 3;
            float L[16], L2[16];
#pragma unroll
            for (int i = 0; i < 16; ++i) { const int n = 4 * i + q, n2 = 4 * (i + 16) + q;
                L[i] = __uint_as_float((__float_as_uint(Sc[row * 132 + n]) & 0xFFFFFF80u) | (unsigned)n);
                L2[i] = __uint_as_float((__float_as_uint(Sc[row * 132 + n2]) & 0xFFFFFF80u) | (unsigned)n2); }
            sort16_desc(L); sort16_desc(L2); merge_top16(L, L2);
            merge16<0xB1>(L); merge16<0x4E>(L);
            if (q == 0) { v4u* dst = (v4u*)((unsigned*)(F.ws + WS_SUB) + ((tok0 + row) * 16 + hp) * 16);
#pragma unroll
                for (int i = 0; i < 4; ++i) dst[i] = (v4u){__float_as_uint(L[4 * i]), __float_as_uint(L[4 * i + 1]), __float_as_uint(L[4 * i + 2]), __float_as_uint(L[4 * i + 3])}; } }
        __syncthreads();
    }
}

template <int CTRL> __device__ __forceinline__ float dpp_max(float v) { return __builtin_fmaxf(v, dpp_f<CTRL>(v)); }
template <int CTRL> __device__ __forceinline__ float dpp_add(float v) { return v + dpp_f<CTRL>(v); }
__device__ __forceinline__ float row_allmax(float v) { v = dpp_max<0x128>(v); v = dpp_max<0x124>(v); v = dpp_max<0x122>(v); v = dpp_max<0x121>(v); return v; }
__device__ __forceinline__ float row_allsum(float v) { v = dpp_add<0x128>(v); v = dpp_add<0x124>(v); v = dpp_add<0x122>(v); v = dpp_add<0x121>(v); return v; }
__device__ __forceinline__ void p6a(Frame& F) { F.fence_ids();
    const int lane = F.lane, row = lane >> 4, i = lane & 15, rowbase = lane & 48;
    LAS unsigned* Sel = (LAS unsigned*)(F.lds + F.wave * 1024);
    const unsigned* SUB = (const unsigned*)(F.ws + WS_SUB);
    unsigned short* EID = (unsigned short*)(F.ws + WS_EID); float* GWp = (float*)(F.ws + WS_GW);
    const int gw = F.bid * NWAVES + F.wave, NGW = F.G * NWAVES;
    unsigned nab[2], nbb[2];
    if (gw < MT) {
#pragma unroll
        for (int r = 0; r < 2; ++r) { const int h = 4 * r + row; nab[r] = SUB[((size_t)gw * 16 + 2 * h) * 16 + i]; nbb[r] = SUB[((size_t)gw * 16 + 2 * h + 1) * 16 + i]; } }
    for (int t = gw; t < MT; t += NGW) {
        unsigned abits[2], bbits[2], bcur[2]; float a[2], hv[2]; int ptr[2];
#pragma unroll
        for (int r = 0; r < 2; ++r) { abits[r] = nab[r]; bbits[r] = nbb[r]; a[r] = __uint_as_float(abits[r]); ptr[r] = 0; bcur[r] = (unsigned)__shfl((int)bbits[r], rowbase); hv[r] = a[r] + __uint_as_float(bcur[r]); }
        if (t + NGW < MT) {
#pragma unroll
            for (int r = 0; r < 2; ++r) { const int h = 4 * r + row; nab[r] = SUB[((size_t)(t + NGW) * 16 + 2 * h) * 16 + i]; nbb[r] = SUB[((size_t)(t + NGW) * 16 + 2 * h + 1) * 16 + i]; } }
        for (int k = 0; k < 16; ++k) {
#pragma unroll
            for (int r = 0; r < 2; ++r) {
                const float key = __uint_as_float((__float_as_uint(hv[r]) & 0xFFFFFFF0u) | (unsigned)i);
                const float m = row_allmax(key);
                const bool win = (key == m);
                if (win) { Sel[((r * 4 + row) * 16 + k) * 2] = (abits[r] & 127u) * 128u + (bcur[r] & 127u); Sel[((r * 4 + row) * 16 + k) * 2 + 1] = __float_as_uint(hv[r]); ptr[r]++; }
                const unsigned bnext = (unsigned)__shfl((int)bbits[r], rowbase + (ptr[r] < 15 ? ptr[r] : 15));
                if (win) { bcur[r] = bnext; hv[r] = (ptr[r] < 16) ? a[r] + __uint_as_float(bnext) : -3.0e38f; }
            }
        }
        LDS_WAIT(); asm volatile("" ::: "memory");
#pragma unroll
        for (int r = 0; r < 2; ++r) { const int h = 4 * r + row;
            const unsigned e = Sel[((r * 4 + row) * 16 + i) * 2]; const float sc = __uint_as_float(Sel[((r * 4 + row) * 16 + i) * 2 + 1]);
            const float mx = row_allmax(sc);
            const float ex = fexp2((sc - mx) * 1.44269504089f);
            const float sum = row_allsum(ex);
            EID[(size_t)t * 128 + h * 16 + i] = (unsigned short)e; GWp[(size_t)t * 128 + h * 16 + i] = ex / sum; }
        LDS_WAIT(); asm volatile("" ::: "memory");
    }
}
typedef float f32x2c __attribute__((ext_vector_type(2)));
__device__ __forceinline__ long mk64(unsigned lo, unsigned hi) { return (long)(((unsigned long long)hi << 32) | lo); }
#if MK_U4
typedef int v8i_q __attribute__((ext_vector_type(8)));
__device__ __forceinline__ void p6b(Frame& F) { F.fence_ids();
    const int j = F.bid & 7, s2 = j >> 1, par = j & 1, nsb = F.G >> 3; if ((F.bid >> 3) >= nsb) return;
    const int wj = (F.bid >> 3) * NWAVES + F.wave, NW = nsb * NWAVES, NI = MT / 2;
    const int lane = F.lane, g = lane >> 4;
    const int pidx = (4 * (lane & 15) + (lane >> 4)) * 4;
    const unsigned char* H8 = F.ws + WS_H2F8 + (size_t)s2 * MT * 256 + 16 * g; const unsigned char* U4 = F.ws + WS_UE8 + (size_t)s2 * 16384 * 128 + 16 * (lane & 3); const unsigned short* EID = (const unsigned short*)(F.ws + WS_EID) + (lane >> 2);
    unsigned* PDp = (unsigned*)(F.ws + WS_PD) + (size_t)s2 * MT * 64;
#define TOK(ix_) (2 * ((ix_) < NI ? (ix_) : NI - 1) + par)
#define P6B_LOAD_EID(E, ix_) do { const int tc_ = TOK(ix_); _Pragma("unroll") for (int h = 0; h < 8; ++h) E[h] = EID[(size_t)tc_ * 128 + 16 * h]; } while (0)
#define P6B_LOAD_AB(A_, B0_, B1_, E, ix_) do { const int tc_ = TOK(ix_); const unsigned char* hp_ = H8 + (size_t)tc_ * 256; A_[0] = *(const v4u*)hp_; A_[1] = *(const v4u*)(hp_ + 64); A_[2] = *(const v4u*)(hp_ + 128); A_[3] = *(const v4u*)(hp_ + 192); \
        _Pragma("unroll") for (int h = 0; h < 8; ++h) { const unsigned char* rp_ = U4 + (size_t)E[h] * 128; B0_[h] = *(const v4u*)rp_; B1_[h] = *(const v4u*)(rp_ + 64); } } while (0)
#define BPM(x_) ((int)__builtin_amdgcn_ds_bpermute(pidx, (int)(x_)))
#define P6B_COMPUTE(A_, B0_, B1_, ix_) do { if ((ix_) < NI) { const int tc_ = 2 * (ix_) + par; \
        const v8i_q a0_ = (v8i_q){(int)A_[0].x, (int)A_[0].y, (int)A_[0].z, (int)A_[0].w, (int)A_[1].x, (int)A_[1].y, (int)A_[1].z, (int)A_[1].w}, a1_ = (v8i_q){(int)A_[2].x, (int)A_[2].y, (int)A_[2].z, (int)A_[2].w, (int)A_[3].x, (int)A_[3].y, (int)A_[3].z, (int)A_[3].w}; \
        float pv_[8]; \
        _Pragma("unroll") for (int h = 0; h < 8; ++h) { const v8i_q b0_ = (v8i_q){BPM(B0_[h].x), BPM(B0_[h].y), BPM(B0_[h].z), BPM(B0_[h].w), 0, 0, 0, 0}, b1_ = (v8i_q){BPM(B1_[h].x), BPM(B1_[h].y), BPM(B1_[h].z), BPM(B1_[h].w), 0, 0, 0, 0}; \
            f32x4 acc_ = __builtin_amdgcn_mfma_scale_f32_16x16x128_f8f6f4(a0_, b0_, (f32x4){0.f, 0.f, 0.f, 0.f}, 0, 4, 0, 0x7F7F7F7F, 0, 0x7F7F7F7F); \
            acc_ = __builtin_amdgcn_mfma_scale_f32_16x16x128_f8f6f4(a1_, b1_, acc_, 0, 4, 0, 0x7F7F7F7F, 0, 0x7F7F7F7F); pv_[h] = acc_[0] * (1.0f / 1024.0f); } \
        if (lane < 16) { _Pragma("unroll") for (int hp = 0; hp < 4; ++hp) PDp[(size_t)tc_ * 64 + 16 * hp + lane] = pk2(pv_[2 * hp], pv_[2 * hp + 1]); } } } while (0)
    unsigned E0[8], E1[8]; v4u A0[4], A1[4], B00[8], B01[8], B10[8], B11[8];
    int ix = wj;
    P6B_LOAD_EID(E0, ix); P6B_LOAD_EID(E1, ix + NW);
    P6B_LOAD_AB(A0, B00, B01, E0, ix);
    for (; ix < NI; ix += 2 * NW) {
        P6B_LOAD_AB(A1, B10, B11, E1, ix + NW);
        P6B_LOAD_EID(E0, ix + 2 * NW);
        P6B_COMPUTE(A0, B00, B01, ix);
        P6B_LOAD_AB(A0, B00, B01, E0, ix + 2 * NW);
        P6B_LOAD_EID(E1, ix + 3 * NW);
        P6B_COMPUTE(A1, B10, B11, ix + NW);
    }
#undef TOK
#undef P6B_LOAD_EID
#undef P6B_LOAD_AB
#undef P6B_COMPUTE
#undef BPM
}
#else
__device__ __forceinline__ void p6b(Frame& F) { F.fence_ids();
    const int j = F.bid & 7, nsb = F.G >> 3; if ((F.bid >> 3) >= nsb) return;
    const int wj = (F.bid >> 3) * NWAVES + F.wave, NW = nsb * NWAVES;
    const int lane = F.lane, g = lane >> 4;
    const int pidx = (4 * (lane & 15) + (lane >> 4)) * 4;
    const unsigned char* H8 = F.ws + WS_H2F8 + (size_t)j * MT * 128 + 16 * g; const unsigned char* UE8 = F.ws + WS_UE8 + (size_t)j * 16384 * 128 + 16 * (lane & 3); const unsigned* EID = (const unsigned*)(F.ws + WS_EID) + (lane >> 2);
    float* PD = (float*)(F.ws + WS_PD) + (size_t)j * MT * 128;
#define P6B_LOAD_EID(E, tt) do { const int tc_ = (tt) < MT ? (tt) : MT - 1; _Pragma("unroll") for (int h = 0; h < 8; ++h) E[h] = EID[(size_t)tc_ * 128 + 16 * h]; } while (0)
#define P6B_LOAD_AB(A0_, A1_, B0_, B1_, E, tt) do { const int tc_ = (tt) < MT ? (tt) : MT - 1; const unsigned char* hp_ = H8 + (size_t)tc_ * 128; A0_ = *(const v4u*)hp_; A1_ = *(const v4u*)(hp_ + 64); \
        _Pragma("unroll") for (int h = 0; h < 8; ++h) { const unsigned char* rp_ = UE8 + (size_t)E[h] * 128; B0_[h] = *(const v4u*)rp_; B1_[h] = *(const v4u*)(rp_ + 64); } } while (0)
#define BPM(x_) ((unsigned)__builtin_amdgcn_ds_bpermute(pidx, (int)(x_)))
#define P6B_COMPUTE(A0_, A1_, B0_, B1_, tt) do { if ((tt) < MT) { _Pragma("unroll") for (int h = 0; h < 8; ++h) { f32x4 acc_ = (f32x4){0.f, 0.f, 0.f, 0.f}; \
            acc_ = __builtin_amdgcn_mfma_f32_16x16x32_fp8_fp8(mk64(A0_.x, A0_.y), mk64(BPM(B0_[h].x), BPM(B0_[h].y)), acc_, 0, 0, 0); \
            acc_ = __builtin_amdgcn_mfma_f32_16x16x32_fp8_fp8(mk64(A0_.z, A0_.w), mk64(BPM(B0_[h].z), BPM(B0_[h].w)), acc_, 0, 0, 0); \
            acc_ = __builtin_amdgcn_mfma_f32_16x16x32_fp8_fp8(mk64(A1_.x, A1_.y), mk64(BPM(B1_[h].x), BPM(B1_[h].y)), acc_, 0, 0, 0); \
            acc_ = __builtin_amdgcn_mfma_f32_16x16x32_fp8_fp8(mk64(A1_.z, A1_.w), mk64(BPM(B1_[h].z), BPM(B1_[h].w)), acc_, 0, 0, 0); \
            if (lane < 16) PD[(size_t)(tt) * 128 + 16 * h + lane] = acc_[0] * (1.0f / 8192.0f); } } } while (0)
    unsigned E0[8], E1[8]; v4u A00, A01, A10, A11, B00[8], B01[8], B10[8], B11[8];
    int t = wj;
    P6B_LOAD_EID(E0, t); P6B_LOAD_EID(E1, t + NW);
    P6B_LOAD_AB(A00, A01, B00, B01, E0, t);
    for (; t < MT; t += 2 * NW) {
        P6B_LOAD_AB(A10, A11, B10, B11, E1, t + NW);
        P6B_LOAD_EID(E0, t + 2 * NW);
        P6B_COMPUTE(A00, A01, B00, B01, t);
        P6B_LOAD_AB(A00, A01, B00, B01, E0, t + 2 * NW);
        P6B_LOAD_EID(E1, t + 3 * NW);
        P6B_COMPUTE(A10, A11, B10, B11, t + NW);
    }
#undef P6B_LOAD_EID
#undef P6B_LOAD_AB
#undef P6B_COMPUTE
#undef BPM
}
#endif
__device__ __forceinline__ void p6b2(Frame& F) { F.fence_ids();
    const unsigned* PDp = (const unsigned*)(F.ws + WS_PD); const float* GWp = (const float*)(F.ws + WS_GW); bf16* ACT = (bf16*)(F.ws + WS_ACT);
    for (size_t i4 = (size_t)F.bid * 512 + F.tid; i4 < (size_t)MT * 32; i4 += (size_t)F.G * 512) { const size_t t = i4 >> 5; const int p0 = (int)(i4 & 31) * 4, h = p0 >> 4, l0 = p0 & 15;
        f32x4 s = (f32x4){0.f, 0.f, 0.f, 0.f};
#pragma unroll
        for (int jj = 0; jj < 4; ++jj) { const v4u w = *(const v4u*)(PDp + ((size_t)jj * MT + t) * 64 + (h >> 1) * 16 + l0);
            s += (h & 1) ? (f32x4){bfhi(w.x), bfhi(w.y), bfhi(w.z), bfhi(w.w)} : (f32x4){bflo(w.x), bflo(w.y), bflo(w.z), bflo(w.w)}; }
        const f32x4 gw = *(const f32x4*)(GWp + i4 * 4);
        v2u o; o.x = pk2(gelu1(s[0]) * gw[0], gelu1(s[1]) * gw[1]); o.y = pk2(gelu1(s[2]) * gw[2], gelu1(s[3]) * gw[3]);
        *(v2u*)(ACT + i4 * 4) = o;
    }
}
__device__ __forceinline__ void p6c(Frame& F) { F.fence_ids();
    const int j = F.bid & 7, nsb = F.G >> 3; if ((F.bid >> 3) >= nsb) return;
    const int wj = (F.bid >> 3) * NWAVES + F.wave, NW = nsb * NWAVES;
    const int lane = F.lane, g8 = lane >> 3, s8 = lane & 7;
    LAS float* Act = (LAS float*)(F.lds + F.wave * 8192); LAS unsigned* Eidl = (LAS unsigned*)(F.lds + F.wave * 8192 + 4096);
    const unsigned char* VE8 = F.ws + WS_VE8 + (size_t)j * 16384 * 128 + 16 * s8; const unsigned short* EID = (const unsigned short*)(F.ws + WS_EID); const bf16* ACT = (const bf16*)(F.ws + WS_ACT);
    bf16* PEERS = (bf16*)(F.ws + WS_PEERS) + (size_t)j * MT * 128;
    for (int tg = wj; tg < MT / 8; tg += NW) {
        const size_t t0 = (size_t)tg * 8;
#pragma unroll
        for (int q = 0; q < 4; ++q) { const int idx = 4 * (lane + 64 * q);
            const v2u aw = *(const v2u*)(ACT + t0 * 128 + idx), ew = *(const v2u*)(EID + t0 * 128 + idx);
            *(LAS f32x4*)(Act + idx) = (f32x4){bflo(aw.x), bfhi(aw.x), bflo(aw.y), bfhi(aw.y)}; *(LAS v4u*)(Eidl + idx) = (v4u){ew.x & 0xFFFFu, ew.x >> 16, ew.y & 0xFFFFu, ew.y >> 16}; }
        LDS_WAIT(); asm volatile("" ::: "memory");
        f32x2c acc2[8];
#pragma unroll
        for (int e = 0; e < 8; ++e) acc2[e] = (f32x2c){0.f, 0.f};
        LAS const float* ap = Act + g8 * 128; LAS const unsigned* ep = Eidl + g8 * 128;
        v4u va[8], vb[8]; f32x4 aa[2], ab[2];
#define P6C_LOAD(V_, A_, base) do { A_[0] = *(LAS const f32x4*)(ap + (base)); A_[1] = *(LAS const f32x4*)(ap + (base) + 4); const v4u e0_ = *(LAS const v4u*)(ep + (base)), e1_ = *(LAS const v4u*)(ep + (base) + 4); \
            _Pragma("unroll") for (int k = 0; k < 4; ++k) { V_[k] = *(const v4u*)(VE8 + (size_t)e0_[k] * 128); V_[4 + k] = *(const v4u*)(VE8 + (size_t)e1_[k] * 128); } } while (0)
#define P6C_FMA(V_, A_) do { _Pragma("unroll") for (int k = 0; k < 8; ++k) { const float a_ = A_[k >> 2][k & 3]; const f32x2c a2_ = (f32x2c){a_, a_}; _Pragma("unroll") for (int w = 0; w < 4; ++w) { \
            const f32x2c lo_ = __builtin_amdgcn_cvt_pk_f32_fp8((int)V_[k][w], false), hi_ = __builtin_amdgcn_cvt_pk_f32_fp8((int)V_[k][w], true); \
            acc2[2 * w] = __builtin_elementwise_fma(a2_, lo_, acc2[2 * w]); acc2[2 * w + 1] = __builtin_elementwise_fma(a2_, hi_, acc2[2 * w + 1]); } } } while (0)
        P6C_LOAD(va, aa, 0);
        for (int it = 0; it < 128; it += 16) {
            P6C_LOAD(vb, ab, it + 8);
            P6C_FMA(va, aa);
            if (it + 16 < 128) P6C_LOAD(va, aa, it + 16);
            P6C_FMA(vb, ab);
        }
#undef P6C_LOAD
#undef P6C_FMA
        float acc[16];
#pragma unroll
        for (int e = 0; e < 8; ++e) { acc[2 * e] = acc2[e][0]; acc[2 * e + 1] = acc2[e][1]; }
        { bf16* op = PEERS + (t0 + g8) * 128 + 16 * s8;
            v4u o0, o1;
            o0.x = pk2(acc[0] * 0.0625f, acc[1] * 0.0625f); o0.y = pk2(acc[2] * 0.0625f, acc[3] * 0.0625f); o0.z = pk2(acc[4] * 0.0625f, acc[5] * 0.0625f); o0.w = pk2(acc[6] * 0.0625f, acc[7] * 0.0625f);
            o1.x = pk2(acc[8] * 0.0625f, acc[9] * 0.0625f); o1.y = pk2(acc[10] * 0.0625f, acc[11] * 0.0625f); o1.z = pk2(acc[12] * 0.0625f, acc[13] * 0.0625f); o1.w = pk2(acc[14] * 0.0625f, acc[15] * 0.0625f);
            *(v4u*)op = o0; *(v4u*)(op + 8) = o1; }
        LDS_WAIT(); asm volatile("" ::: "memory");
    }
}
__device__ __forceinline__ void p6d(Frame& F) { F.fence_ids();
    const int gw = F.bid * NWAVES + F.wave, NGW = F.G * NWAVES; const bf16* PEERS = (const bf16*)(F.ws + WS_PEERS); const float* gate2 = (const float*)(F.ws + WS_MOD) + 5120;
    f32x4 fg[4];
#pragma unroll
    for (int q = 0; q < 4; ++q) fg[q] = *((const f32x4*)F.final_g + F.lane + 64 * q);
    f32x4 nx[4]; v2u np[4];
#define P6D_LOAD(tt) do { _Pragma("unroll") for (int q = 0; q < 4; ++q) { const int d = 4 * F.lane + 256 * q; { const v2u w_ = *((const v2u*)((const bf16*)(F.ws + WS_X1B) + (size_t)(tt) * DM) + F.lane + 64 * q); nx[q] = (f32x4){bflo(w_.x), bfhi(w_.x), bflo(w_.y), bfhi(w_.y)}; } \
        np[q] = *(const v2u*)(PEERS + ((size_t)(d >> 7) * MT + (tt)) * 128 + (d & 127)); } } while (0)
    if (gw < MT) P6D_LOAD(gw);
    for (int t = gw; t < MT; t += NGW) {
        const int b = t >> 12;
        f32x4* xr = (f32x4*)((float*)F.dout + (size_t)t * DM) + F.lane; f32x4 o[4]; float ss = 0.f;
#pragma unroll
        for (int q = 0; q < 4; ++q) { const int d = 4 * F.lane + 256 * q; const f32x4 g2 = *(const f32x4*)(gate2 + (size_t)b * 6144 + d);
            o[q] = nx[q] + g2 * (f32x4){bflo(np[q].x), bfhi(np[q].x), bflo(np[q].y), bfhi(np[q].y)}; ss += (o[q][0] * o[q][0] + o[q][1] * o[q][1]) + (o[q][2] * o[q][2] + o[q][3] * o[q][3]); }
        if (t + NGW < MT) P6D_LOAD(t + NGW);
        const float rstd = __builtin_amdgcn_rsqf(wave_sum(ss) * (1.f / DM) + EPSN);
#pragma unroll
        for (int q = 0; q < 4; ++q) xr[64 * q] = o[q] * rstd * fg[q];
    }
#undef P6D_LOAD
}

struct Args { const float* in[20]; float* out; unsigned char* ws; int ph_lo, ph_hi, li, pad; };
__global__ void __launch_bounds__(NWAVES * 64, 2) mk_fwd(Args args) {
    extern __shared__ __attribute__((aligned(16))) unsigned char lds_raw[];
    Frame F;
    F.lds = (LAS unsigned char*)lds_raw;
    F.tid = threadIdx.x; F.lane = F.tid & 63; F.wave = __builtin_amdgcn_readfirstlane(F.tid >> 6); F.G = gridDim.x; F.bid = blockIdx.x;
    F.x = args.in[0]; F.c = args.in[1]; F.w_ada = args.in[2]; F.b_ada = args.in[3]; F.norm1_g = args.in[4]; F.w_in = args.in[5]; F.ret_gn_g = args.in[6]; F.sgu_ln_g = args.in[7];
    F.sgu_ln_b = args.in[8]; F.sgu_w = args.in[9]; F.sgu_b = args.in[10]; F.w_ret_out = args.in[11]; F.w_sgu_out = args.in[12]; F.w_out = args.in[13]; F.norm2_g = args.in[14];
    F.peer_w_q = args.in[15]; F.peer_sub_keys = args.in[16]; F.peer_u = args.in[17]; F.peer_v = args.in[18]; F.final_g = args.in[19];
    F.ws = args.ws; F.dout = (unsigned char*)args.out;
    volatile LAS unsigned* MISC = (volatile LAS unsigned*)(F.lds + MISC_OFF); F.misc = MISC;
    if (F.tid < 64) MISC[F.tid] = 0u;
    __syncthreads();
    XcdBarrier bar; bar.bar = (unsigned*)(F.ws + WS_CTL) + CW_BAR; bar.x = 0; bar.st = nullptr;
    if (N_LAUNCHES == 1) bar = xcd_barrier_post((unsigned*)(F.ws + WS_CTL) + CW_BAR, MISC + 8);
    const int lo = args.ph_lo, hi = args.ph_hi;
#define IN(k) (lo <= (k) && (k) < hi)
#if MK_PROBE_HI > 0
#define STAMP(k) do { if (F.bid == 0 && F.wave == 0 && F.lane == 0) { const unsigned long long _t = __builtin_amdgcn_s_memrealtime(); MISC[16 + 2 * (k)] = (unsigned)_t; MISC[17 + 2 * (k)] = (unsigned)(_t >> 32); } } while (0)
#else
#define STAMP(k) do { } while (0)
#endif
#define SEAM(k) do { if (IN(k) && IN((k) + 1)) xcd_barrier(bar); } while (0)
    const float* mod = (const float*)(F.ws + WS_MOD);
    STAMP(0);
    if (IN(0)) { p0a(F); SEAM(0); }
    STAMP(1);
    if (IN(1)) { norm_rows<2>(F, F.x, F.norm1_g, mod + 0, mod + 1024, nullptr, F.dout + DO_H); SEAM(1); }
    STAMP(2);
    if (IN(2)) {
        pg8::Gemm g{(const bf16*)(F.dout + DO_H), (const bf16*)(F.ws + WS_WIN), MT, NIN, 512}; pg8::StaticOrder S; S.init(MT, NIN, F.G, F.bid);
        pg8::EpiProj E{(bf16*)(F.dout + DO_Q), (bf16*)(F.dout + DO_K), (bf16*)(F.ws + WS_V), (bf16*)(F.ws + WS_G), (bf16*)(F.ws + WS_U), (bf16*)(F.ws + WS_SV), (bf16*)(F.ws + WS_GA), (bf16*)(F.ws + WS_GB),
                       (const float*)(F.ws + WS_COS), (const float*)(F.ws + WS_SIN), 1.0f / 4096.0f, (float*)(F.ws + WS_SVSTAT)};
        pg8::gemm_phase<pg8::EpiProj, pg8::StaticOrder, true, true, true>(F.lds, g, S, E);
        SEAM(2);
    }
    STAMP(3);
    if (IN(3)) { p2a(F); SEAM(3); }
    STAMP(4);
    if (IN(4)) { p2b(F); SEAM(4); }
    STAMP(5);
    if (IN(5)) { p2c(F); SEAM(5); }
    STAMP(6);
    if (IN(6)) {
        pg8::StaticOrder S; S.init(MT, DM, F.G, F.bid);
        pg8::Gemm g{(const bf16*)(F.ws + WS_YG8), (const bf16*)(F.ws + WS_WRET), MT, DM, 1024, 512, (const bf16*)(F.ws + WS_YS8), (const bf16*)(F.ws + WS_WSGU), 8};
        pg8::EpiMerged E{F.ws + WS_GA, F.ws + WS_GB, F.ws + WS_MRG8, 1.0f / 4096.0f};
        pg8::gemm_phase<pg8::EpiMerged, pg8::StaticOrder, true, true, true>(F.lds, g, S, E);
        SEAM(6);
    }
    STAMP(7);
    if (IN(7)) {
        pg8::Gemm g{(const bf16*)(F.ws + WS_MRG8), (const bf16*)(F.ws + WS_WOUT), MT, DM, 512}; pg8::StaticOrder S; S.init(MT, DM, F.G, F.bid);
        pg8::EpiX1 E{F.x, mod + 2048, (bf16*)(F.ws + WS_X1B), 1.0f / 4096.0f};
        pg8::gemm_phase<pg8::EpiX1, pg8::StaticOrder, true, true, true>(F.lds, g, S, E);
        SEAM(7);
    }
    STAMP(8);
    if (IN(8)) { norm_rows<1>(F, (const float*)(F.ws + WS_X1B), F.norm2_g, mod + 3072, mod + 4096, (bf16*)(F.ws + WS_SV), F.ws + WS_H2F8); SEAM(8); }
    STAMP(9);
    if (IN(9)) {
        pg8::Gemm g{(const bf16*)(F.ws + WS_SV), (const bf16*)(F.ws + WS_WQ), MT, 2048, DM}; pg8::StaticOrder S; S.init(MT, 2048, F.G, F.bid);
        pg8::EpiPlain E{(bf16*)(F.ws + WS_GA), 2048};
        pg8::gemm_phase<pg8::EpiPlain, pg8::StaticOrder, true, true>(F.lds, g, S, E);
        SEAM(9);
    }
    STAMP(10);
    if (IN(10)) { p5b(F); SEAM(10); }
    STAMP(11);
    if (IN(11)) { p6a(F); SEAM(11); }
    STAMP(12);
    if (IN(12)) { p6b(F); SEAM(12); }
    STAMP(13);
    if (IN(13)) { p6b2(F); SEAM(13); }
    STAMP(14);
    if (IN(14)) { p6c(F); SEAM(14); }
    STAMP(15);
    if (IN(15)) { p6d(F); }
    STAMP(16);
#if MK_PROBE_HI > 0
    __syncthreads();
    if (F.bid == 0 && F.tid == 0) { const unsigned long long t0 = ((unsigned long long)MISC[17 + 2 * MK_PROBE_LO] << 32) | MISC[16 + 2 * MK_PROBE_LO], t1 = ((unsigned long long)MISC[17 + 2 * MK_PROBE_HI] << 32) | MISC[16 + 2 * MK_PROBE_HI];
#if MK_GPROBE == 1
        ((float*)F.dout)[0] += (float)MISC[56] * 1e-3f; }
#elif MK_GPROBE == 2
        ((float*)F.dout)[0] += (float)MISC[57] * 1e-3f; }
#else
        ((float*)F.dout)[0] += (float)(t1 - t0) * 1e-3f; }
#endif
#endif
#undef IN
#undef SEAM
}

extern "C" void kernel_launch(void* const* d_in, const int* in_sizes, int n_in, void* d_out, int out_size, void* d_ws, size_t ws_size, hipStream_t stream) {
    static int grid = 0;
    if (grid == 0) {
        if (n_in != 20 || out_size != MT * DM || ws_size < WS_END) { fprintf(stderr, "kernel_launch: unexpected shapes (n_in %d, out %d, ws %zu); nothing launched\n", n_in, out_size, ws_size); grid = -1; return; }
        int dev = 0, cus = 0, per_cu = 0;
        if (hipGetDevice(&dev) != hipSuccess || hipDeviceGetAttribute(&cus, hipDeviceAttributeMultiprocessorCount, dev) != hipSuccess) { grid = -1; return; }
        if (hipFuncSetAttribute((const void*)mk_fwd, hipFuncAttributeMaxDynamicSharedMemorySize, LDS_BYTES) != hipSuccess) { fprintf(stderr, "kernel_launch: hipFuncSetAttribute failed\n"); grid = -1; return; }
        if (hipOccupancyMaxActiveBlocksPerMultiprocessor(&per_cu, (const void*)mk_fwd, NWAVES * 64, LDS_BYTES) != hipSuccess || per_cu < 1)
            fprintf(stderr, "kernel_launch: note: occupancy query reports %d workgroups per CU\n", per_cu);
        (void)hipGetLastError();
        grid = cus;
    }
    if (grid < 0) return;
    if (hipMemsetAsync((char*)d_ws + WS_CTL, 0, CTL_ZERO_BYTES, stream) != hipSuccess) { fprintf(stderr, "kernel_launch: memset failed\n"); return; }
    Args a{};
    for (int i = 0; i < 20; ++i) a.in[i] = (const float*)d_in[i];
    a.out = (float*)d_out; a.ws = (unsigned char*)d_ws;
    static_assert(N_LAUNCHES == 1 || N_LAUNCHES == N_PHASES, "N_LAUNCHES is 1 or N_PHASES");
    for (int li = 0; li < N_LAUNCHES && li < MK_MAXPH; ++li) {
        a.ph_lo = (N_LAUNCHES == 1) ? 0 : li; a.ph_hi = (N_LAUNCHES == 1) ? N_PHASES : li + 1; a.li = li;
        hipLaunchKernelGGL(mk_fwd, dim3(grid), dim3(NWAVES * 64), LDS_BYTES, stream, a);
        const hipError_t le = hipPeekAtLastError();
        if (le != hipSuccess) { fprintf(stderr, "kernel_launch: launch %d failed: %s\n", li, hipGetErrorName(le)); break; }
    }
}
```

```cpp
#include <hip/hip_runtime.h>
#include <cstdio>
#include <cstdint>

#ifndef MK_PROBE_LO
#define MK_PROBE_LO 0
#define MK_PROBE_HI 0
#endif
#ifndef MK_GPROBE
#define MK_GPROBE 0
#endif
#define MK_MISC_OFF (147456 - 256)
#ifndef MK_U4
#define MK_U4 1
#endif
#ifndef MK_ALAY
#define MK_ALAY 2
#endif
#ifndef MK_MAXPH
#define MK_MAXPH 16
#endif
#ifndef MK_N_LAUNCHES
#define MK_N_LAUNCHES 1
#endif
namespace pg8 {
#define PG8_LAS __attribute__((address_space(3)))
typedef unsigned short bf16_t;
typedef short bf16x8 __attribute__((ext_vector_type(8)));
typedef float f32x4 __attribute__((ext_vector_type(4)));
typedef unsigned u32x4 __attribute__((ext_vector_type(4)));
constexpr int BM = 256, BK = 64, HALF = 128, HTB = HALF * BK * 2  , STAGE_BYTES = 8 * HTB, NXCD = 8, WGM = 2;

__host__ __device__ __forceinline__ int lds_byte(int r, int c) { const int st = (r >> 4) * 2 + (c >> 5), rr = r & 15, cc = c & 31, ob = rr * 64 + cc * 2; return st * 1024 + (ob ^ (((ob >> 9) & 1) << 5)); }
__host__ __device__ __forceinline__ void stage_rc(int b, int& R, int& C) { const int st = b / 1024, sb = b % 1024, swz = sb ^ (((sb >> 9) & 1) << 5); R = (st >> 1) * 16 + swz / 64; C = (st & 1) * 32 + (swz % 64) / 2; }
__host__ __device__ __forceinline__ int perm32(int rho) { const int n = rho >> 4, i = rho & 15; return 8 * (i >> 2) + 4 * n + (i & 3); }

struct Unit { int pm, pn; };
struct Gemm { const bf16_t* A; const bf16_t* Bt; int M, N, K; int ld = 0; const bf16_t* A2 = nullptr; const bf16_t* Bt2 = nullptr; int ksplit = 0; };

struct StaticOrder {
    int nM, nN, nwg, G, c;
    __host__ __device__ void init(int M, int N, int G_, int c_) { nM = M / BM; nN = N / BM; nwg = nM * nN; G = G_; c = c_; }
    __host__ __device__ bool next(int i, Unit& u) const {
        const long L = (long)i * G + c; if (L >= nwg) return false;
        int wgid = (int)L; { const int q = nwg / NXCD, r = nwg % NXCD, xcd = wgid % NXCD, off = wgid / NXCD; wgid = (xcd < r ? xcd * (q + 1) : r * (q + 1) + (xcd - r) * q) + off; }
        const int nig = WGM * nN, gid = wgid / nig, fm = gid * WGM, gsz = (nM - fm) < WGM ? (nM - fm) : WGM;
        u.pm = fm + ((wgid % nig) % gsz); u.pn = (wgid % nig) / gsz; return true;
    }
    __device__ __forceinline__ void a_ready(const Unit&) const {}
    __device__ __forceinline__ void done(const Unit&) const {}
};

__device__ __forceinline__ unsigned cvt_pk_bf16(float lo, float hi) { unsigned r; asm volatile("v_cvt_pk_bf16_f32 %0, %1, %2" : "=v"(r) : "v"(lo), "v"(hi)); return r; }
typedef float f32x2 __attribute__((ext_vector_type(2)));
__device__ __forceinline__ f32x2 gelu_pk(f32x2 v) {
    const f32x2 av = __builtin_elementwise_abs(v), d = av * 0.2316418882f + 1.0f;
    f32x2 t; t.x = __builtin_amdgcn_rcpf(d.x); t.y = __builtin_amdgcn_rcpf(d.y);
    f32x2 q = t * 0.5307027145f + (-0.7265760135f); q = q * t + 0.7107068705f; q = q * t + (-0.142248368f); q = q * t + 0.127414796f; q = q * t;
    const f32x2 s = (v * v) * (-0.72134752044f);
    f32x2 e; e.x = __builtin_amdgcn_exp2f(s.x); e.y = __builtin_amdgcn_exp2f(s.y);
    const f32x2 m = v * (q * e), r = v - m;
    f32x2 o; o.x = v.x < 0.f ? m.x : r.x; o.y = v.y < 0.f ? m.y : r.y; return o;
}


typedef unsigned u32x2 __attribute__((ext_vector_type(2)));
__device__ __forceinline__ float bflo(unsigned w) { return __uint_as_float(w << 16); }
__device__ __forceinline__ float bfhi(unsigned w) { return __uint_as_float(w & 0xffff0000u); }
typedef float f32x2q __attribute__((ext_vector_type(2)));
__device__ __forceinline__ f32x4 f8x4(unsigned w) { const f32x2q lo = __builtin_amdgcn_cvt_pk_f32_fp8((int)w, false), hi = __builtin_amdgcn_cvt_pk_f32_fp8((int)w, true); return (f32x4){lo[0], lo[1], hi[0], hi[1]}; }
__device__ __forceinline__ float gelu1(float v) {
    const float av = __builtin_fabsf(v), t = __builtin_amdgcn_rcpf(av * 0.2316418882f + 1.0f);
    float q = t * 0.5307027145f + (-0.7265760135f); q = q * t + 0.7107068705f; q = q * t + (-0.142248368f); q = q * t + 0.127414796f; q = q * t;
    const float e = __builtin_amdgcn_exp2f((v * v) * (-0.72134752044f));
    const float m = v * (q * e);
    return v < 0.f ? m : v - m;
}
__device__ __forceinline__ float sigm1(float v) { return __builtin_amdgcn_rcpf(1.0f + __builtin_amdgcn_exp2f(v * (-1.44269504089f))); }
__device__ __forceinline__ float silu1(float v) { return v * sigm1(v); }

__device__ __forceinline__ unsigned bperm(int idx, unsigned v) { return (unsigned)__builtin_amdgcn_ds_bpermute(idx, (int)v); }
__device__ __forceinline__ float bpermf(int idx, float v) { return __int_as_float(__builtin_amdgcn_ds_bpermute(idx, __float_as_int(v))); }
__device__ __forceinline__ f32x4 bperm4(int idx, const f32x4& v) { return (f32x4){bpermf(idx, v[0]), bpermf(idx, v[1]), bpermf(idx, v[2]), bpermf(idx, v[3])}; }
__device__ __forceinline__ u32x4 bperm4u(int idx, const u32x4& v) { u32x4 r; r.x = bperm(idx, v.x); r.y = bperm(idx, v.y); r.z = bperm(idx, v.z); r.w = bperm(idx, v.w); return r; }
#define PG8_REMAP() const int lane_ = 16 * fq + fr, pidx = (16 * (lane_ & 3) + (lane_ >> 2)) * 4, fr2 = lane_ >> 2, fq2 = lane_ & 3

struct EpiProj {
    static constexpr bool PERM = true, AFTER_DRAIN = false, HAS_MID = false;
    bf16_t *Q, *Kb, *V, *G, *U, *SV, *GA, *GB; const float *cosT, *sinT; float osc; float* svstat;
    __device__ __forceinline__ void operator()(const f32x4 (&acc)[2][2][4][2], const Unit& u, int wr, int wc, int fr, int fq) const {
        PG8_REMAP();
        const int colt = u.pn * BM; const int row0 = u.pm * BM + wr * 64 + fr2;
        if (colt < 1024) {
            const bool isk = colt >= 512; bf16_t* base = isk ? Kb : Q; const int lc0 = (colt & 511) + wc * 32 + 8 * fq2; const float sc = (isk ? 0.08838834764831845f * 128.0f : 16.0f) * osc;
            const int fi = wc * 16 + 4 * fq2;
#pragma unroll
            for (int ai = 0; ai < 2; ++ai) {
                f32x4 csv[4], snv[4];
#pragma unroll
                for (int m = 0; m < 4; ++m) { const int s = (row0 + ai * HALF + m * 16) & 4095; csv[m] = *(const f32x4*)(cosT + s * 64 + fi) * sc; snv[m] = *(const f32x4*)(sinT + s * 64 + fi) * sc; }
#pragma unroll
                for (int m = 0; m < 4; ++m) { const int row = row0 + ai * HALF + m * 16; const f32x4 cs = csv[m], sn = snv[m];
#pragma unroll
                    for (int bj = 0; bj < 2; ++bj) { const f32x4 v0 = bperm4(pidx, acc[ai][bj][m][0]), v1 = bperm4(pidx, acc[ai][bj][m][1]);
                        int t0 = __builtin_amdgcn_cvt_pk_fp8_f32(v0[0] * cs[0] - v0[1] * sn[0], v0[0] * sn[0] + v0[1] * cs[0], 0, false); t0 = __builtin_amdgcn_cvt_pk_fp8_f32(v0[2] * cs[1] - v0[3] * sn[1], v0[2] * sn[1] + v0[3] * cs[1], t0, true);
                        int t1 = __builtin_amdgcn_cvt_pk_fp8_f32(v1[0] * cs[2] - v1[1] * sn[2], v1[0] * sn[2] + v1[1] * cs[2], 0, false); t1 = __builtin_amdgcn_cvt_pk_fp8_f32(v1[2] * cs[3] - v1[3] * sn[3], v1[2] * sn[3] + v1[3] * cs[3], t1, true);
                        u32x2 w8; w8.x = (unsigned)t0; w8.y = (unsigned)t1;
                        *(u32x2*)((unsigned char*)base + (size_t)row * 512 + lc0 + bj * HALF) = w8; } } }
        } else {
            const int seg = (colt - 1024) >> 10;
            bf16_t* base = seg == 0 ? V : seg == 1 ? G : seg == 2 ? U : seg == 3 ? SV : seg == 4 ? GA : GB;
            const int lc0 = ((colt - 1024) & 1023) + wc * 32 + 8 * fq2;
#pragma unroll
            for (int ai = 0; ai < 2; ++ai)
#pragma unroll
                for (int m = 0; m < 4; ++m) { const int row = row0 + ai * HALF + m * 16; float s1[2] = {0.f, 0.f}, s2[2] = {0.f, 0.f};
#pragma unroll
                    for (int bj = 0; bj < 2; ++bj) { f32x4 v0 = acc[ai][bj][m][0] * osc, v1 = acc[ai][bj][m][1] * osc;
                        if (seg == 1) {
#pragma unroll
                            for (int e = 0; e < 4; ++e) { v0[e] = silu1(v0[e]); v1[e] = silu1(v1[e]); }
                        } else if (seg == 2 || seg == 3) {
                            f32x2 a = gelu_pk((f32x2){v0[0], v0[1]}), b = gelu_pk((f32x2){v0[2], v0[3]}), c = gelu_pk((f32x2){v1[0], v1[1]}), d = gelu_pk((f32x2){v1[2], v1[3]});
                            v0 = (f32x4){a.x, a.y, b.x, b.y}; v1 = (f32x4){c.x, c.y, d.x, d.y};
                        } else if (seg >= 4) {
#pragma unroll
                            for (int e = 0; e < 4; ++e) { v0[e] = sigm1(v0[e]); v1[e] = sigm1(v1[e]); }
                        }
                        if (seg == 3) { s1[bj] = ((v0[0] + v0[1]) + (v0[2] + v0[3])) + ((v1[0] + v1[1]) + (v1[2] + v1[3]));
                            s2[bj] = ((v0[0] * v0[0] + v0[1] * v0[1]) + (v0[2] * v0[2] + v0[3] * v0[3])) + ((v1[0] * v1[0] + v1[1] * v1[1]) + (v1[2] * v1[2] + v1[3] * v1[3])); }
                        { const float fs = seg >= 4 ? 256.0f : 16.0f;
                            int t0 = __builtin_amdgcn_cvt_pk_fp8_f32(v0[0] * fs, v0[1] * fs, 0, false); t0 = __builtin_amdgcn_cvt_pk_fp8_f32(v0[2] * fs, v0[3] * fs, t0, true);
                            int t1 = __builtin_amdgcn_cvt_pk_fp8_f32(v1[0] * fs, v1[1] * fs, 0, false); t1 = __builtin_amdgcn_cvt_pk_fp8_f32(v1[2] * fs, v1[3] * fs, t1, true);
                            u32x2 w8; w8.x = bperm(pidx, (unsigned)t0); w8.y = bperm(pidx, (unsigned)t1);
                            *(u32x2*)((unsigned char*)base + (size_t)row * 1024 + lc0 + bj * HALF) = w8; } }
                    if (seg == 3) {
                        float a = s1[0] + s1[1], b = s2[0] + s2[1];
                        a += __shfl_xor(a, 16); b += __shfl_xor(b, 16); a += __shfl_xor(a, 32); b += __shfl_xor(b, 32);
                        if (fq == 0) { float* sp = svstat + (size_t)(u.pm * BM + wr * 64 + fr + ai * HALF + m * 16) * 2; atomicAdd(sp, a); atomicAdd(sp + 1, b); } } }
        }
    }
};
template <bool ACCUM> struct EpiGate {
    static constexpr bool PERM = true, AFTER_DRAIN = false, HAS_MID = false;
    const bf16_t* GT; bf16_t* TMP; unsigned char* OUT8; float osc;
    __device__ __forceinline__ void operator()(const f32x4 (&acc)[2][2][4][2], const Unit& u, int wr, int wc, int fr, int fq) const {
        PG8_REMAP();
        const int row0 = u.pm * BM + wr * 64 + fr2, col0 = u.pn * BM + wc * 32 + 8 * fq2;
#pragma unroll
        for (int ai = 0; ai < 2; ++ai)
#pragma unroll
            for (int mp = 0; mp < 2; ++mp) {
                u32x4 gv[2][2], pv[2][2];
#pragma unroll
                for (int mm = 0; mm < 2; ++mm)
#pragma unroll
                    for (int bj = 0; bj < 2; ++bj) { const size_t off = (size_t)(row0 + ai * HALF + (2 * mp + mm) * 16) * 1024 + col0 + bj * HALF;
                        gv[mm][bj] = *(const u32x4*)(GT + off); if (ACCUM) pv[mm][bj] = *(const u32x4*)(TMP + off); }
#pragma unroll
                for (int mm = 0; mm < 2; ++mm)
#pragma unroll
                    for (int bj = 0; bj < 2; ++bj) { const int m = 2 * mp + mm; const size_t off = (size_t)(row0 + ai * HALF + m * 16) * 1024 + col0 + bj * HALF;
                        const f32x4 v0 = bperm4(pidx, acc[ai][bj][m][0]) * osc, v1 = bperm4(pidx, acc[ai][bj][m][1]) * osc; const u32x4 g = gv[mm][bj];
                        float o[8] = {v0[0] * bflo(g.x), v0[1] * bfhi(g.x), v0[2] * bflo(g.y), v0[3] * bfhi(g.y), v1[0] * bflo(g.z), v1[1] * bfhi(g.z), v1[2] * bflo(g.w), v1[3] * bfhi(g.w)};
                        if (ACCUM) { const u32x4 p = pv[mm][bj];
                            o[0] += bflo(p.x); o[1] += bfhi(p.x); o[2] += bflo(p.y); o[3] += bfhi(p.y); o[4] += bflo(p.z); o[5] += bfhi(p.z); o[6] += bflo(p.w); o[7] += bfhi(p.w);
                            u32x2 w8; int t0 = __builtin_amdgcn_cvt_pk_fp8_f32(o[0] * 8.f, o[1] * 8.f, 0, false); t0 = __builtin_amdgcn_cvt_pk_fp8_f32(o[2] * 8.f, o[3] * 8.f, t0, true);
                            int t1 = __builtin_amdgcn_cvt_pk_fp8_f32(o[4] * 8.f, o[5] * 8.f, 0, false); t1 = __builtin_amdgcn_cvt_pk_fp8_f32(o[6] * 8.f, o[7] * 8.f, t1, true);
                            w8.x = (unsigned)t0; w8.y = (unsigned)t1; *(u32x2*)(OUT8 + off) = w8;
                        } else {
                            u32x4 w; w.x = cvt_pk_bf16(o[0], o[1]); w.y = cvt_pk_bf16(o[2], o[3]); w.z = cvt_pk_bf16(o[4], o[5]); w.w = cvt_pk_bf16(o[6], o[7]);
                            *(u32x4*)(TMP + off) = w; } }
            }
    }
};
struct EpiMerged {
    static constexpr bool PERM = true, AFTER_DRAIN = false, HAS_MID = true;
    const unsigned char* GA; const unsigned char* GB; unsigned char* OUT8; float osc;
    __device__ __forceinline__ void mid(f32x4 (&acc)[2][2][4][2], const Unit& u, int wr, int wc, int fr, int fq) const {
        int fr_ = fr, fq_ = fq; asm volatile("" : "+v"(fr_), "+v"(fq_));
        const int row0 = u.pm * BM + wr * 64 + fr_, col0 = u.pn * BM + wc * 32 + 8 * fq_;
#pragma unroll
        for (int ai = 0; ai < 2; ++ai)
#pragma unroll
            for (int mp = 0; mp < 2; ++mp) {
                u32x2 av[2][2], bv[2][2];
#pragma unroll
                for (int mm = 0; mm < 2; ++mm)
#pragma unroll
                    for (int bj = 0; bj < 2; ++bj) { const size_t off = (size_t)(row0 + ai * HALF + (2 * mp + mm) * 16) * 1024 + col0 + bj * HALF; av[mm][bj] = *(const u32x2*)(GA + off); bv[mm][bj] = *(const u32x2*)(GB + off); }
#pragma unroll
                for (int mm = 0; mm < 2; ++mm)
#pragma unroll
                    for (int bj = 0; bj < 2; ++bj) { const int m = 2 * mp + mm; const f32x4 a0 = f8x4(av[mm][bj].x), a1 = f8x4(av[mm][bj].y), b0 = f8x4(bv[mm][bj].x), b1 = f8x4(bv[mm][bj].y);
#pragma unroll
                        for (int e = 0; e < 4; ++e) { acc[ai][bj][m][0][e] *= 2.f * a0[e] * __builtin_amdgcn_rcpf(__builtin_fmaxf(b0[e], 0.001953125f)); acc[ai][bj][m][1][e] *= 2.f * a1[e] * __builtin_amdgcn_rcpf(__builtin_fmaxf(b1[e], 0.001953125f)); } }
            }
    }
    __device__ __forceinline__ void operator()(const f32x4 (&acc)[2][2][4][2], const Unit& u, int wr, int wc, int fr, int fq) const {
        PG8_REMAP();
        const int row0 = u.pm * BM + wr * 64 + fr2, col0 = u.pn * BM + wc * 32 + 8 * fq2; const float sc = osc * 8.f * (1.0f / 256.0f);
#pragma unroll
        for (int ai = 0; ai < 2; ++ai)
#pragma unroll
            for (int mp = 0; mp < 2; ++mp) {
                u32x2 gv[2][2];
#pragma unroll
                for (int mm = 0; mm < 2; ++mm)
#pragma unroll
                    for (int bj = 0; bj < 2; ++bj) gv[mm][bj] = *(const u32x2*)(GB + (size_t)(row0 + ai * HALF + (2 * mp + mm) * 16) * 1024 + col0 + bj * HALF);
#pragma unroll
                for (int mm = 0; mm < 2; ++mm)
#pragma unroll
                    for (int bj = 0; bj < 2; ++bj) { const int m = 2 * mp + mm; const size_t off = (size_t)(row0 + ai * HALF + m * 16) * 1024 + col0 + bj * HALF;
                        const f32x4 v0 = bperm4(pidx, acc[ai][bj][m][0]) * sc * f8x4(gv[mm][bj].x), v1 = bperm4(pidx, acc[ai][bj][m][1]) * sc * f8x4(gv[mm][bj].y);
                        u32x2 w8; int t0 = __builtin_amdgcn_cvt_pk_fp8_f32(v0[0], v0[1], 0, false); t0 = __builtin_amdgcn_cvt_pk_fp8_f32(v0[2], v0[3], t0, true);
                        int t1 = __builtin_amdgcn_cvt_pk_fp8_f32(v1[0], v1[1], 0, false); t1 = __builtin_amdgcn_cvt_pk_fp8_f32(v1[2], v1[3], t1, true);
                        w8.x = (unsigned)t0; w8.y = (unsigned)t1; *(u32x2*)(OUT8 + off) = w8; }
            }
    }
};
struct EpiX1 {
    static constexpr bool PERM = false, AFTER_DRAIN = false, HAS_MID = false;
    const float* X; const float* gate1; bf16_t* X1; float osc;
    __device__ __forceinline__ void operator()(const f32x4 (&acc)[2][2][4][2], const Unit& u, int wr, int wc, int fr, int fq) const {
        PG8_REMAP();
        const int row0 = u.pm * BM + wr * 64 + fr2, col0 = u.pn * BM + wc * 32 + 4 * fq2;
        const float* gp = gate1 + (size_t)((u.pm * BM) >> 12) * 6144 + col0;
        f32x4 gv[2][2];
#pragma unroll
        for (int bj = 0; bj < 2; ++bj)
#pragma unroll
            for (int n = 0; n < 2; ++n) gv[bj][n] = *(const f32x4*)(gp + bj * HALF + n * 16) * osc;
#pragma unroll
        for (int ai = 0; ai < 2; ++ai)
#pragma unroll
            for (int mp = 0; mp < 2; ++mp) {
                f32x4 xv[2][2][2];
#pragma unroll
                for (int mm = 0; mm < 2; ++mm) { const size_t off = (size_t)(row0 + ai * HALF + (2 * mp + mm) * 16) * 1024 + col0;
#pragma unroll
                    for (int bj = 0; bj < 2; ++bj)
#pragma unroll
                        for (int n = 0; n < 2; ++n) xv[mm][bj][n] = *(const f32x4*)(X + off + bj * HALF + n * 16); }
#pragma unroll
                for (int mm = 0; mm < 2; ++mm) { const int m = 2 * mp + mm; const size_t off = (size_t)(row0 + ai * HALF + m * 16) * 1024 + col0;
#pragma unroll
                    for (int bj = 0; bj < 2; ++bj)
#pragma unroll
                        for (int n = 0; n < 2; ++n) { const f32x4 x1 = xv[mm][bj][n] + gv[bj][n] * bperm4(pidx, acc[ai][bj][m][n]); u32x2 w; w.x = cvt_pk_bf16(x1[0], x1[1]); w.y = cvt_pk_bf16(x1[2], x1[3]); *(u32x2*)(X1 + off + bj * HALF + n * 16) = w; } }
            }
    }
};
struct EpiPlain {
    static constexpr bool PERM = true, AFTER_DRAIN = false, HAS_MID = false;
    bf16_t* O; int ldc;
    __device__ __forceinline__ void operator()(const f32x4 (&acc)[2][2][4][2], const Unit& u, int wr, int wc, int fr, int fq) const {
        PG8_REMAP();
        const int row0 = u.pm * BM + wr * 64 + fr2, col0 = u.pn * BM + wc * 32 + 8 * fq2;
#pragma unroll
        for (int ai = 0; ai < 2; ++ai)
#pragma unroll
            for (int m = 0; m < 4; ++m) { bf16_t* rowp = O + (size_t)(row0 + ai * HALF + m * 16) * ldc + col0;
#pragma unroll
                for (int bj = 0; bj < 2; ++bj) { const f32x4 v0 = acc[ai][bj][m][0], v1 = acc[ai][bj][m][1];
                    u32x4 w; w.x = cvt_pk_bf16(v0[0], v0[1]); w.y = cvt_pk_bf16(v0[2], v0[3]); w.z = cvt_pk_bf16(v1[0], v1[1]); w.w = cvt_pk_bf16(v1[2], v1[3]);
                    *(u32x4*)(rowp + bj * HALF) = bperm4u(pidx, w); } }
    }
};
typedef int v8i_t __attribute__((ext_vector_type(8)));
typedef int v4i_t __attribute__((ext_vector_type(4)));
template <bool F8> __device__ __forceinline__ void mma_block(f32x4 (&acc)[4][2], const bf16x8 (&At)[4][2], const bf16x8 (&Bt)[2][2]) {
    if constexpr (F8) {
        v8i_t bb[2];
#pragma unroll
        for (int n = 0; n < 2; ++n) bb[n] = __builtin_shufflevector(__builtin_bit_cast(v4i_t, Bt[n][0]), __builtin_bit_cast(v4i_t, Bt[n][1]), 0, 1, 2, 3, 4, 5, 6, 7);
#pragma unroll
        for (int m = 0; m < 4; ++m) { const v8i_t aa = __builtin_shufflevector(__builtin_bit_cast(v4i_t, At[m][0]), __builtin_bit_cast(v4i_t, At[m][1]), 0, 1, 2, 3, 4, 5, 6, 7);
#pragma unroll
            for (int n = 0; n < 2; ++n) asm volatile("v_mfma_scale_f32_16x16x128_f8f6f4 %0, %1, %2, %0, %3, %3 op_sel_hi:[0,0,0]" : "+v"(acc[m][n]) : "v"(bb[n]), "v"(aa), "v"(0x7F7F7F7F)); }
    } else {
#pragma unroll
        for (int m = 0; m < 4; ++m)
#pragma unroll
            for (int n = 0; n < 2; ++n)
#pragma unroll
                for (int k = 0; k < 2; ++k) acc[m][n] = __builtin_amdgcn_mfma_f32_16x16x32_bf16(Bt[n][k], At[m][k], acc[m][n], 0, 0, 0);
    }
}
template <class Epi, class Sched, bool ALIGN_EPI = false, bool SP2 = false, bool F8 = false>
__device__ __forceinline__ void gemm_phase(PG8_LAS unsigned char* lds, const Gemm g, const Sched& S, const Epi& E) {
    const int tid = threadIdx.x, wid = __builtin_amdgcn_readfirstlane(tid >> 6), lane = tid & 63, wr = wid >> 2, wc = wid & 3, fr = lane & 15, fq = lane >> 4;
    const int K = g.K, nt = K / BK, LD = g.ld ? g.ld : g.K, nh = g.ksplit ? g.ksplit : nt;
    unsigned voffA[2], voffB[2];
#pragma unroll
    for (int i = 0; i < 2; ++i) { int R, C; stage_rc(tid * 16 + i * 8192, R, C); const int Rb = Epi::PERM ? ((R & ~31) + perm32(R & 31)) : R;
        voffA[i] = (unsigned)(R * LD + C) * 2u; voffB[i] = (unsigned)(Rb * LD + C) * 2u; }
    const size_t kstep = (size_t)(BK * 2);
    const size_t hstep = (size_t)HALF * LD * 2;
    const size_t tstep = 2 * hstep;
    const unsigned ldsw = (unsigned)wid * 1024u;
    const int aoff = lds_byte(wr * 64 + fr, fq * 8), boff = lds_byte(wc * 32 + fr, fq * 8);
#define PG8_SA(b, h) (((b) * 2 + (h)) * HTB)
#define PG8_SB(b, h) ((4 + (b) * 2 + (h)) * HTB)
#define PG8_STAGE(bufoff, gbase, voff) do { _Pragma("unroll") for (int _i = 0; _i < 2; ++_i) \
        __builtin_amdgcn_global_load_lds((const unsigned*)((const char*)(gbase) + (voff)[_i]), (PG8_LAS unsigned*)(lds + (bufoff) + ldsw + _i * 8192), 16, 0, 0); } while (0)
#define PG8_LDA(dst, b, h) do { _Pragma("unroll") for (int m = 0; m < 4; ++m) _Pragma("unroll") for (int k = 0; k < 2; ++k) dst[m][k] = *(const PG8_LAS bf16x8*)(lds + PG8_SA(b, h) + aoff + m * 2048 + k * 1024); } while (0)
#define PG8_LDB(dst, b, h) do { _Pragma("unroll") for (int n = 0; n < 2; ++n) _Pragma("unroll") for (int k = 0; k < 2; ++k) dst[n][k] = *(const PG8_LAS bf16x8*)(lds + PG8_SB(b, h) + boff + n * 2048 + k * 1024); } while (0)
#define PG8_MMA(ai, bj, At, Bt) do { __builtin_amdgcn_s_setprio(1); mma_block<F8>(acc[ai][bj], At, Bt); __builtin_amdgcn_s_setprio(0); } while (0)
#define PG8_WAIT_V(n) asm volatile("s_waitcnt vmcnt(" #n ")" ::: "memory")
#define PG8_WAIT_L(n) asm volatile("s_waitcnt lgkmcnt(" #n ")" ::: "memory")
#define PG8_BAR __builtin_amdgcn_s_barrier()
#define PG8_SCHED __builtin_amdgcn_sched_barrier(0)
    Unit cur, nxt; int ui = 0;
#if MK_GPROBE
    unsigned long long gp_k = 0, gp_e = 0, gp_t = __builtin_amdgcn_s_memrealtime();
#endif
    if (!S.next(0, cur)) return;
    f32x4 acc[2][2][4][2];
#pragma unroll
    for (int a = 0; a < 2; ++a)
#pragma unroll
        for (int b = 0; b < 2; ++b)
#pragma unroll
            for (int m = 0; m < 4; ++m)
#pragma unroll
                for (int n = 0; n < 2; ++n) acc[a][b][m][n] = (f32x4){0.f, 0.f, 0.f, 0.f};
    bf16x8 At[4][2], B0[2][2], B1[2][2];
    const char* cA = (const char*)g.A + (size_t)cur.pm * tstep; const char* cB = (const char*)g.Bt + (size_t)cur.pn * tstep;
    const char* cA2 = g.A2 ? (const char*)g.A2 + (size_t)cur.pm * tstep : cA; const char* cB2 = g.Bt2 ? (const char*)g.Bt2 + (size_t)cur.pn * tstep : cB;
#define PG8_TA(tt) ((tt) < nh ? cA + (size_t)(tt) * kstep : cA2 + (size_t)((tt) - nh) * kstep)
#define PG8_TB(tt) ((tt) < nh ? cB + (size_t)(tt) * kstep : cB2 + (size_t)((tt) - nh) * kstep)
    S.a_ready(cur);
    if constexpr (SP2) {
        PG8_STAGE(PG8_SB(0, 0), cB, voffB); PG8_STAGE(PG8_SB(0, 1), cB + hstep, voffB); PG8_STAGE(PG8_SA(0, 0), cA, voffA); PG8_STAGE(PG8_SA(0, 1), cA + hstep, voffA);
        if (wr == 1) PG8_BAR;
        PG8_WAIT_V(2); PG8_BAR;
        PG8_STAGE(PG8_SB(1, 0), cB + kstep, voffB); PG8_STAGE(PG8_SA(1, 0), cA + kstep, voffA); PG8_STAGE(PG8_SB(1, 1), cB + hstep + kstep, voffB);
        PG8_WAIT_V(6); PG8_BAR;
    } else {
        PG8_STAGE(PG8_SB(0, 0), cB, voffB); PG8_STAGE(PG8_SA(0, 0), cA, voffA); PG8_STAGE(PG8_SB(0, 1), cB + hstep, voffB); PG8_STAGE(PG8_SA(0, 1), cA + hstep, voffA);
        if (wr == 1) PG8_BAR;
        PG8_WAIT_V(4); PG8_BAR;
        PG8_STAGE(PG8_SB(1, 0), cB + kstep, voffB); PG8_STAGE(PG8_SA(1, 0), cA + kstep, voffA); PG8_STAGE(PG8_SB(1, 1), cB + hstep + kstep, voffB);
        PG8_WAIT_V(6); PG8_BAR;
    }
    for (;;) {
        const bool has_next = S.next(ui + 1, nxt);
        const char* nA = has_next ? (const char*)g.A + (size_t)nxt.pm * tstep : cA; const char* nB = has_next ? (const char*)g.Bt + (size_t)nxt.pn * tstep : cB;
#pragma clang loop unroll(disable)
        for (int t = 0; t < nt; t += 2) {
            const bool last = (t == nt - 2);
            const char* a1 = PG8_TA(t + 1);
            const char* a2 = last ? nA : PG8_TA(t + 2); const char* b2 = last ? nB : PG8_TB(t + 2);
            const char* a3 = last ? nA + kstep : PG8_TA(t + 3); const char* b3 = last ? nB + kstep : PG8_TB(t + 3);
            if constexpr (Epi::HAS_MID) { if (t == nh) { if constexpr (F8) asm volatile("s_nop 15\n\ts_nop 15" ::: "memory"); E.mid(acc, cur, wr, wc, fr, fq); } }
            if (last && has_next) S.a_ready(nxt);
            if constexpr (SP2) {
            PG8_LDB(B0, 0, 0); PG8_LDB(B1, 0, 1); PG8_SCHED; PG8_LDA(At, 0, 0); PG8_STAGE(PG8_SA(1, 1), a1 + hstep, voffA);
            PG8_WAIT_V(8); PG8_WAIT_L(0); PG8_BAR; PG8_MMA(0, 0, At, B0); PG8_MMA(0, 1, At, B1); PG8_BAR; PG8_SCHED;
            PG8_LDA(At, 0, 1); PG8_STAGE(PG8_SB(0, 0), b2, voffB); PG8_STAGE(PG8_SB(0, 1), b2 + hstep, voffB); PG8_STAGE(PG8_SA(0, 0), a2, voffA);
            PG8_WAIT_V(8); PG8_WAIT_L(0); PG8_BAR; PG8_MMA(1, 0, At, B0); PG8_MMA(1, 1, At, B1); PG8_BAR; PG8_SCHED;
            PG8_LDB(B0, 1, 0); PG8_LDB(B1, 1, 1); PG8_SCHED; PG8_LDA(At, 1, 0); PG8_STAGE(PG8_SA(0, 1), a2 + hstep, voffA);
            PG8_WAIT_V(8); PG8_WAIT_L(0); PG8_BAR; PG8_MMA(0, 0, At, B0); PG8_MMA(0, 1, At, B1); PG8_BAR; PG8_SCHED;
            PG8_LDA(At, 1, 1); PG8_STAGE(PG8_SB(1, 0), b3, voffB); PG8_STAGE(PG8_SB(1, 1), b3 + hstep, voffB); PG8_STAGE(PG8_SA(1, 0), a3, voffA);
            PG8_WAIT_V(8); PG8_WAIT_L(0); PG8_BAR; PG8_MMA(1, 0, At, B0); PG8_MMA(1, 1, At, B1); PG8_BAR; PG8_SCHED;
            } else {
            PG8_LDB(B0, 0, 0); PG8_SCHED; PG8_LDA(At, 0, 0); PG8_STAGE(PG8_SA(1, 1), a1 + hstep, voffA);
            PG8_WAIT_L(8); PG8_BAR; PG8_WAIT_L(0); PG8_MMA(0, 0, At, B0); PG8_BAR; PG8_SCHED;
            PG8_LDB(B1, 0, 1); PG8_STAGE(PG8_SB(0, 0), b2, voffB);
            PG8_BAR; PG8_WAIT_L(0); PG8_MMA(0, 1, At, B1); PG8_BAR;
            PG8_LDA(At, 0, 1); PG8_STAGE(PG8_SA(0, 0), a2, voffA);
            PG8_BAR; PG8_WAIT_L(0); PG8_MMA(1, 0, At, B0); PG8_BAR; PG8_SCHED;
            PG8_STAGE(PG8_SB(0, 1), b2 + hstep, voffB);
            PG8_WAIT_V(6); PG8_BAR; PG8_MMA(1, 1, At, B1); PG8_BAR;
            PG8_LDB(B0, 1, 0); PG8_SCHED; PG8_LDA(At, 1, 0); PG8_STAGE(PG8_SA(0, 1), a2 + hstep, voffA);
            PG8_WAIT_L(8); PG8_BAR; PG8_WAIT_L(0); PG8_MMA(0, 0, At, B0); PG8_BAR; PG8_SCHED;
            PG8_LDB(B1, 1, 1); PG8_STAGE(PG8_SB(1, 0), b3, voffB);
            PG8_BAR; PG8_WAIT_L(0); PG8_MMA(0, 1, At, B1); PG8_BAR;
            PG8_LDA(At, 1, 1); PG8_STAGE(PG8_SA(1, 0), a3, voffA);
            PG8_BAR; PG8_WAIT_L(0); PG8_MMA(1, 0, At, B0); PG8_BAR; PG8_SCHED;
            PG8_STAGE(PG8_SB(1, 1), b3 + hstep, voffB);
            PG8_WAIT_V(6); PG8_BAR; PG8_MMA(1, 1, At, B1); PG8_BAR;
            }
        }
#if MK_GPROBE
        { const unsigned long long t_ = __builtin_amdgcn_s_memrealtime(); gp_k += t_ - gp_t; gp_t = t_; }
#endif
        if constexpr (F8) asm volatile("s_nop 15\n\ts_nop 15" ::: "memory");
        if constexpr (ALIGN_EPI) { if (wr == 0) PG8_BAR; }
        if constexpr (!Epi::AFTER_DRAIN) { E(acc, cur, wr, wc, fr, fq); S.done(cur); }
#if MK_GPROBE
        { asm volatile("s_waitcnt vmcnt(0)" ::: "memory"); const unsigned long long t_ = __builtin_amdgcn_s_memrealtime(); gp_e += t_ - gp_t; gp_t = t_; }
#endif
        if (!has_next) break;
#pragma unroll
        for (int a = 0; a < 2; ++a)
#pragma unroll
            for (int b = 0; b < 2; ++b)
#pragma unroll
                for (int m = 0; m < 4; ++m)
#pragma unroll
                    for (int n = 0; n < 2; ++n) acc[a][b][m][n] = (f32x4){0.f, 0.f, 0.f, 0.f};
        cur = nxt; cA = nA; cB = nB; ++ui;
        cA2 = g.A2 ? (const char*)g.A2 + (size_t)cur.pm * tstep : cA; cB2 = g.Bt2 ? (const char*)g.Bt2 + (size_t)cur.pn * tstep : cB;
        if constexpr (ALIGN_EPI) { if (wr == 1) PG8_BAR; }
    }
    PG8_WAIT_V(0);
    if constexpr (!ALIGN_EPI) { if (wr == 0) PG8_BAR; }
    PG8_BAR;
    if constexpr (Epi::AFTER_DRAIN) { E.fused(acc, cur, wr, wc, fr, fq, lds, wid, lane); S.done(cur); }
#if MK_GPROBE
    if (blockIdx.x == 0 && wid == 0 && lane == 0) { PG8_LAS unsigned* mq = (PG8_LAS unsigned*)(lds + MK_MISC_OFF); mq[56] += (unsigned)gp_k; mq[57] += (unsigned)gp_e; }
#endif
#undef PG8_SA
#undef PG8_SB
#undef PG8_TA
#undef PG8_TB
#undef PG8_STAGE
#undef PG8_LDA
#undef PG8_LDB
#undef PG8_MMA
#undef PG8_WAIT_V
#undef PG8_WAIT_L
#undef PG8_BAR
#undef PG8_SCHED
}
}

constexpr int NWAVES = 8;
constexpr int N_LAUNCHES = MK_N_LAUNCHES;
constexpr int N_PHASES = 16;
constexpr int NB = 8, SEQ = 4096, DM = 1024, MT = NB * SEQ, NIN = 7168;
constexpr float EPSN = 1e-6f;

constexpr size_t MiB = 1u << 20;
constexpr size_t WS_CTL = 0, CTL_ZERO_BYTES = 1 * MiB;
constexpr size_t WS_SVSTAT = 512 * 1024;
constexpr size_t WS_MOD = 1 * MiB;
constexpr size_t WS_COS = 2 * MiB, WS_SIN = 3 * MiB;
constexpr size_t WS_SK = 4 * MiB;
constexpr size_t WS_SGUW = 4 * MiB + 512 * 1024;
constexpr size_t WS_WRET = 6 * MiB, WS_WSGU = 8 * MiB, WS_WOUT = 10 * MiB, WS_WQ = 12 * MiB, WS_WIN = 16 * MiB;
constexpr size_t WS_UE8 = 32 * MiB, WS_VE8 = 48 * MiB;
constexpr size_t WS_YG8 = 288 * MiB;
constexpr size_t WS_YS8 = 480 * MiB;
constexpr size_t WS_MRG8 = 96 * MiB;
constexpr size_t WS_ACT = 288 * MiB;
constexpr size_t WS_PEERS = 352 * MiB;
constexpr size_t WS_H2F8 = 96 * MiB;
constexpr size_t WS_EID = 128 * MiB, WS_GW = 144 * MiB;
constexpr size_t WS_PD = 160 * MiB;
constexpr size_t WS_V = 96 * MiB;
constexpr size_t WS_G = 160 * MiB;
constexpr size_t WS_X1B = 224 * MiB;
constexpr size_t WS_U = 224 * MiB;
constexpr size_t WS_SV = 288 * MiB;
constexpr size_t WS_GA = 352 * MiB, WS_GB = 416 * MiB;
constexpr size_t WS_SUB = 480 * MiB;
constexpr size_t WS_END = 512 * MiB;
constexpr size_t DO_H = 0, DO_Q = 64 * MiB, DO_K = 96 * MiB, DO_KVS = 0;

constexpr int CW_BAR = 4096;
constexpr int LDS_BYTES = 147456;
constexpr int MISC_OFF = LDS_BYTES - 256;

#define GAS __attribute__((address_space(1)))
#define LAS __attribute__((address_space(3)))
typedef unsigned short bf16;
typedef unsigned v4u __attribute__((ext_vector_type(4)));
typedef unsigned v2u __attribute__((ext_vector_type(2)));
typedef float f32x4 __attribute__((ext_vector_type(4)));
typedef float f32x2v __attribute__((ext_vector_type(2)));
typedef short bf16x8 __attribute__((ext_vector_type(8)));
typedef short s16x4 __attribute__((ext_vector_type(4)));
typedef __bf16 bf16x2_t __attribute__((ext_vector_type(2)));
typedef GAS unsigned gu32;
#define RLX_AGENT __ATOMIC_RELAXED, __HIP_MEMORY_SCOPE_AGENT
#define LDS_WAIT() asm volatile("s_waitcnt lgkmcnt(0)" ::: "memory")
using pg8::bflo; using pg8::bfhi; using pg8::gelu1;
__device__ __forceinline__ unsigned pk2(float lo, float hi) { f32x2v v = {lo, hi}; bf16x2_t b = __builtin_convertvector(v, bf16x2_t); return __builtin_bit_cast(unsigned, b); }
template <int CTRL> __device__ __forceinline__ float dpp_f(float v) { return __int_as_float(__builtin_amdgcn_update_dpp(0, __float_as_int(v), CTRL, 0xF, 0xF, false)); }
__device__ __forceinline__ float wave_sum(float v) {
    v += dpp_f<0xB1>(v); v += dpp_f<0x4E>(v); v += dpp_f<0x141>(v); v += dpp_f<0x140>(v);
    const int vi = __float_as_int(v);
    return (__int_as_float(__builtin_amdgcn_readlane(vi, 0)) + __int_as_float(__builtin_amdgcn_readlane(vi, 16))) + (__int_as_float(__builtin_amdgcn_readlane(vi, 32)) + __int_as_float(__builtin_amdgcn_readlane(vi, 48)));
}
__device__ __forceinline__ float fexp2(float x) { return __builtin_amdgcn_exp2f(x); }
__device__ __forceinline__ float clamp_f8(float x) { return __builtin_amdgcn_fmed3f(x, -448.0f, 448.0f); }
__device__ __forceinline__ unsigned pk4_fp8(float a, float b, float c, float d) { int w = __builtin_amdgcn_cvt_pk_fp8_f32(clamp_f8(a), clamp_f8(b), 0, false); w = __builtin_amdgcn_cvt_pk_fp8_f32(clamp_f8(c), clamp_f8(d), w, true); return (unsigned)w; }
__device__ __forceinline__ float rl_f(float v, int l) { return __int_as_float(__builtin_amdgcn_readlane(__float_as_int(v), l)); }
__device__ __forceinline__ unsigned rl_u(unsigned v, int l) { return (unsigned)__builtin_amdgcn_readlane((int)v, l); }

#define XB_TMO      128
#define XB_XCNT(j)  (256  + 64 * (j))
#define XB_XSUB(j)  (1280 + 64 * (j))
#define XB_XGEN(j)  (2304 + 64 * (j))
#define XB_TOP      3328
#define XB_TOPGEN   3392
#define XCD_BAR_WORDS 3456
#define XB_SPIN_CAP (1u << 22)
__device__ __forceinline__ unsigned xb_ld(unsigned* p)              { return __hip_atomic_load(p, __ATOMIC_RELAXED, __HIP_MEMORY_SCOPE_AGENT); }
__device__ __forceinline__ unsigned xb_add(unsigned* p, unsigned v) { return __hip_atomic_fetch_add(p, v, __ATOMIC_RELAXED, __HIP_MEMORY_SCOPE_AGENT); }
__device__ __forceinline__ unsigned xb_xcc_id() { return (unsigned)__builtin_amdgcn_s_getreg((3 << 11) | 20) & 0xFu; }
#define XB_SPIN(cond, bar) do { unsigned _sp = 0; while (cond) { __builtin_amdgcn_s_sleep(1); \
    if ((++_sp & 255u) == 0u) { if (xb_ld(&(bar)[XB_TMO])) break; if (_sp > XB_SPIN_CAP) { atomicAdd(&(bar)[XB_TMO], 1u); break; } } } } while (0)
struct XcdBarrier { unsigned* bar; unsigned x; volatile LAS unsigned* st; };
__device__ __forceinline__ XcdBarrier xcd_barrier_post(unsigned* bar, volatile LAS unsigned* st) {
    XcdBarrier b; b.bar = bar; b.x = xb_xcc_id(); b.st = st;
    if (threadIdx.x == 0) (void)xb_add(&bar[XB_XCNT(b.x)], 1u);
    return b;
}
__device__ __forceinline__ void xcd_barrier_complete(unsigned* bar, unsigned x, unsigned& nloc, unsigned& nx) {
    const unsigned G = gridDim.x * gridDim.y * gridDim.z;
    unsigned sum, cnt, mine, sp = 0u;
    for (;;) {
        sum = 0u; cnt = 0u; mine = 0u;
#pragma unroll
        for (unsigned j = 0; j < 16; ++j) { const unsigned c = xb_ld(&bar[XB_XCNT(j)]); sum += c; cnt += (c > 0u) ? 1u : 0u; mine = (j == x) ? c : mine; }
        if (sum == G) break;
        __builtin_amdgcn_s_sleep(1);
        if ((++sp & 255u) == 0u) { if (xb_ld(&bar[XB_TMO])) break; if (sp > XB_SPIN_CAP) { atomicAdd(&bar[XB_TMO], 1u); break; } }
    }
    nloc = mine > 0u ? mine : 1u; nx = cnt > 0u ? cnt : 1u;
}
__device__ __forceinline__ void xcd_barrier(const XcdBarrier& b) {
    asm volatile("s_waitcnt vmcnt(0)" ::: "memory");
    __syncthreads();
    if (threadIdx.x == 0) {
        unsigned* bar = b.bar;
        __builtin_amdgcn_s_waitcnt(0);
        unsigned nloc = b.st[0], nx = b.st[1];
        if (nloc == 0u) { xcd_barrier_complete(bar, b.x, nloc, nx); b.st[0] = nloc; b.st[1] = nx; }
        const unsigned old = xb_add(&bar[XB_XSUB(b.x)], 1u);
        const unsigned gen = old / nloc;
        if (old + 1u == (gen + 1u) * nloc) {
            __builtin_amdgcn_fence(__ATOMIC_RELEASE, "agent");
            asm volatile("s_waitcnt vmcnt(0)" ::: "memory");
            const unsigned og = xb_add(&bar[XB_TOP], 1u);
            const unsigned tg = og / nx;
            if (og + 1u == (tg + 1u) * nx) xb_add(&bar[XB_TOPGEN], 1u);
            else XB_SPIN(xb_ld(&bar[XB_TOPGEN]) == tg, bar);
            __builtin_amdgcn_fence(__ATOMIC_ACQUIRE, "agent");
            xb_add(&bar[XB_XGEN(b.x)], 1u);
            asm volatile("s_waitcnt vmcnt(0)" ::: "memory");
        } else {
            XB_SPIN(xb_ld(&bar[XB_XGEN(b.x)]) == gen, bar);
            __builtin_amdgcn_fence(__ATOMIC_ACQUIRE, "agent");
            asm volatile("s_waitcnt vmcnt(0)" ::: "memory");
        }
    }
    __syncthreads();
}

struct Frame {
    LAS unsigned char* lds;
    int tid, lane, wave, G, bid; volatile LAS unsigned* misc;
    __device__ __forceinline__ void fence_ids() { int t = threadIdx.x; asm volatile("" : "+v"(t)); tid = t; lane = t & 63; }
    const float *x, *c, *w_ada, *b_ada, *norm1_g, *w_in, *ret_gn_g, *sgu_ln_g, *sgu_ln_b, *sgu_w, *sgu_b, *w_ret_out, *w_sgu_out, *w_out, *norm2_g, *peer_w_q, *peer_sub_keys, *peer_u, *peer_v, *final_g;
    unsigned char* ws; unsigned char* dout;
};

__device__ __forceinline__ bf16x8 lds_row_frag(LAS const unsigned char* img, int stride, int r0, int k0, int lane) {
    return *(LAS const bf16x8*)(img + (r0 + (lane & 15)) * stride + (k0 + 8 * (lane >> 4)) * 2);
}
__device__ __forceinline__ s16x4 tr16(LAS const unsigned char* p) { return __builtin_bit_cast(s16x4, __builtin_amdgcn_ds_read_tr16_b64_v4i16((LAS s16x4*)p)); }
__device__ __forceinline__ bf16x8 lds_tr_frag(LAS const unsigned char* img, int stride, int k0, int n0, int lane) {
    const int g = lane >> 4, q = (lane >> 2) & 3, p = lane & 3;
    LAS const unsigned char* a = img + (k0 + 8 * g + q) * stride + (n0 + 4 * p) * 2;
    const s16x4 lo = tr16(a), hi = tr16(a + 4 * stride);
    return __builtin_shufflevector(lo, hi, 0, 1, 2, 3, 4, 5, 6, 7);
}
#define MFMA16(a, b, c) __builtin_amdgcn_mfma_f32_16x16x32_bf16((a), (b), (c), 0, 0, 0)
constexpr int KS = 272, VS = 528;

template <bool F8, class Map>
__device__ __forceinline__ void transpose_item(const float* W, int K, int N, bf16* WT, LAS float* scr, int item, int lane, Map srcmap) {
    const int nblk = N / 32, kb = item / nblk, nb = item % nblk, k0 = 64 * kb, n0 = 32 * nb;
    const int sc = srcmap(n0 + (lane & 31));
#pragma unroll 8
    for (int i = 0; i < 32; ++i) { const int kk = 2 * i + (lane >> 5); scr[kk * 33 + (lane & 31)] = W[(size_t)(k0 + kk) * N + sc]; }
    LDS_WAIT(); asm volatile("" ::: "memory");
    const int c = lane & 7;
#pragma unroll
    for (int j = 0; j < 4; ++j) { const int n = (lane >> 3) + 8 * j; const LAS float* s = scr + (8 * c) * 33 + n;
        if (F8) { v2u o8; o8.x = pk4_fp8(s[0 * 33] * 512.f, s[1 * 33] * 512.f, s[2 * 33] * 512.f, s[3 * 33] * 512.f); o8.y = pk4_fp8(s[4 * 33] * 512.f, s[5 * 33] * 512.f, s[6 * 33] * 512.f, s[7 * 33] * 512.f);
            *(v2u*)((unsigned char*)WT + (size_t)(n0 + n) * K + k0 + 8 * c) = o8; }
        else { v4u o; o.x = pk2(s[0 * 33], s[1 * 33]); o.y = pk2(s[2 * 33], s[3 * 33]); o.z = pk2(s[4 * 33], s[5 * 33]); o.w = pk2(s[6 * 33], s[7 * 33]);
            *(v4u*)(WT + (size_t)(n0 + n) * K + k0 + 8 * c) = o; } }
    LDS_WAIT(); asm volatile("" ::: "memory");
}
struct MapId { __device__ __forceinline__ int operator()(int n) const { return n; } };
struct MapWin { __device__ __forceinline__ int operator()(int n) const { if (n >= 1024) return n; const int ci = n & 127; return (n & ~127) + (ci >> 1) + 64 * (ci & 1); } };

__device__ __forceinline__ void cvt8(const float* src, bf16* dst, size_t chunk) {
    const f32x4 a = *(const f32x4*)(src + chunk * 8), b = *(const f32x4*)(src + chunk * 8 + 4);
    v4u o; o.x = pk2(a[0], a[1]); o.y = pk2(a[2], a[3]); o.z = pk2(b[0], b[1]); o.w = pk2(b[2], b[3]);
    *(v4u*)(dst + chunk * 8) = o;
}

__device__ __forceinline__ void p0a(Frame& F) { F.fence_ids();
    if (F.bid < 192) {
        LAS float* sc = (LAS float*)F.lds; LAS float* part = (LAS float*)(F.lds + 32768);
        for (int i = F.tid; i < 8192; i += 512) { const float cv = F.c[i]; sc[i] = pg8::silu1(cv); }
        __syncthreads();
        const int n0 = 32 * F.bid, ks = F.tid >> 3, c4 = F.tid & 7;
        f32x4 acc[8];
#pragma unroll
        for (int b = 0; b < 8; ++b) acc[b] = (f32x4){0.f, 0.f, 0.f, 0.f};
        for (int kk = ks; kk < 1024; kk += 64) { const f32x4 w = *(const f32x4*)(F.w_ada + (size_t)kk * 6144 + n0 + 4 * c4);
#pragma unroll
            for (int b = 0; b < 8; ++b) acc[b] += w * sc[b * 1024 + kk]; }
#pragma unroll
        for (int b = 0; b < 8; ++b) *(LAS f32x4*)(part + (ks * 8 + b) * 32 + 4 * c4) = acc[b];
        __syncthreads();
        if (F.tid < 256) { const int b = F.tid >> 5, col = F.tid & 31; float s = 0.f;
            for (int k2 = 0; k2 < 64; ++k2) s += part[(k2 * 8 + b) * 32 + col];
            ((float*)(F.ws + WS_MOD))[b * 6144 + n0 + col] = s + F.b_ada[n0 + col]; }
        __syncthreads();
    }
    {
        LAS float* scr = (LAS float*)(F.lds + F.wave * 16384);
        const int gw = F.bid * NWAVES + F.wave, NGW = F.G * NWAVES;
        constexpr int I_IN = 16 * (NIN / 32), I_SQ = 16 * 32, I_Q = 16 * 64, NITEMS = I_IN + 3 * I_SQ + I_Q;
        for (int it = gw; it < NITEMS; it += NGW) {
            int r = it;
            if (r < I_IN) { transpose_item<true>(F.w_in, 1024, NIN, (bf16*)(F.ws + WS_WIN), scr, r, F.lane, MapWin()); continue; } r -= I_IN;
            if (r < I_SQ) { transpose_item<true>(F.w_ret_out, 1024, 1024, (bf16*)(F.ws + WS_WRET), scr, r, F.lane, MapId()); continue; } r -= I_SQ;
            if (r < I_SQ) { transpose_item<true>(F.w_sgu_out, 1024, 1024, (bf16*)(F.ws + WS_WSGU), scr, r, F.lane, MapId()); continue; } r -= I_SQ;
            if (r < I_SQ) { transpose_item<true>(F.w_out, 1024, 1024, (bf16*)(F.ws + WS_WOUT), scr, r, F.lane, MapId()); continue; } r -= I_SQ;
            transpose_item<false>(F.peer_w_q, 1024, 2048, (bf16*)(F.ws + WS_WQ), scr, r, F.lane, MapId());
        }
    }
    const size_t gt = (size_t)F.bid * 512 + F.tid, NT = (size_t)F.G * 512;
    for (size_t ch = gt; ch < (size_t)16384 * 64; ch += NT) {
        const f32x4* up = (const f32x4*)(F.peer_u + ch * 16); const f32x4* vp = (const f32x4*)(F.peer_v + ch * 16);
        v4u ou, ov;
#pragma unroll
        for (int q = 0; q < 4; ++q) { const f32x4 a = up[q] * 512.0f, b = vp[q] * 16.0f; ou[q] = pk4_fp8(a[0], a[1], a[2], a[3]); ov[q] = pk4_fp8(b[0], b[1], b[2], b[3]); }
        const size_t e_ = ch >> 6, c16_ = ch & 63, dst_ = (c16_ >> 3) * ((size_t)16384 * 128) + e_ * 128 + (c16_ & 7) * 16;
        *(v4u*)(F.ws + WS_VE8 + dst_) = ov;
        if (MK_U4) {
            v2u o4; unsigned w0 = 0u, w1 = 0u;
            { const f32x4 a0 = up[0] * 64.0f, a1 = up[1] * 64.0f, a2 = up[2] * 64.0f, a3 = up[3] * 64.0f;
              w0 = __builtin_amdgcn_cvt_scalef32_pk_fp4_f32(w0, a0[0], a0[1], 1.0f, 0); w0 = __builtin_amdgcn_cvt_scalef32_pk_fp4_f32(w0, a0[2], a0[3], 1.0f, 1);
              w0 = __builtin_amdgcn_cvt_scalef32_pk_fp4_f32(w0, a1[0], a1[1], 1.0f, 2); w0 = __builtin_amdgcn_cvt_scalef32_pk_fp4_f32(w0, a1[2], a1[3], 1.0f, 3);
              w1 = __builtin_amdgcn_cvt_scalef32_pk_fp4_f32(w1, a2[0], a2[1], 1.0f, 0); w1 = __builtin_amdgcn_cvt_scalef32_pk_fp4_f32(w1, a2[2], a2[3], 1.0f, 1);
              w1 = __builtin_amdgcn_cvt_scalef32_pk_fp4_f32(w1, a3[0], a3[1], 1.0f, 2); w1 = __builtin_amdgcn_cvt_scalef32_pk_fp4_f32(w1, a3[2], a3[3], 1.0f, 3); }
            o4.x = w0; o4.y = w1;
            *(v2u*)(F.ws + WS_UE8 + (c16_ >> 4) * ((size_t)16384 * 128) + e_ * 128 + (c16_ & 15) * 8) = o4;
        } else *(v4u*)(F.ws + WS_UE8 + dst_) = ou; }
    for (size_t ch = gt; ch < (size_t)32768; ch += NT) cvt8(F.peer_sub_keys, (bf16*)(F.ws + WS_SK), ch);
    for (size_t ch = gt; ch < (size_t)8192; ch += NT) { const int t = (int)(ch >> 4) & 127, s0 = (int)(ch & 15) * 8;
        const f32x4 a = *(const f32x4*)(F.sgu_w + ch * 8), b = *(const f32x4*)(F.sgu_w + ch * 8 + 4);
        float v[8] = {a[0], a[1], a[2], a[3], b[0], b[1], b[2], b[3]};
#pragma unroll
        for (int e = 0; e < 8; ++e) v[e] = (s0 + e <= t) ? v[e] : 0.f;
        v4u o; o.x = pk2(v[0], v[1]); o.y = pk2(v[2], v[3]); o.z = pk2(v[4], v[5]); o.w = pk2(v[6], v[7]);
        *(v4u*)((bf16*)(F.ws + WS_SGUW) + ch * 8) = o; }
    for (size_t e = gt; e < (size_t)4096 * 64; e += NT) { const int s = (int)(e >> 6), i = (int)(e & 63);
        const float inv = fexp2(-(float)i * (13.287712379549449f / 64.0f));
        const float rev = ((float)s * inv) * 0.15915494309189535f; const float fr = rev - __builtin_floorf(rev);
        ((float*)(F.ws + WS_COS))[e] = __builtin_amdgcn_cosf(fr); ((float*)(F.ws + WS_SIN))[e] = __builtin_amdgcn_sinf(fr); }
}

template <int MODE  > __device__ __forceinline__ void norm_rows(Frame& F, const float* X, const float* gain, const float* shift, const float* scale, bf16* O, unsigned char* O8) { F.fence_ids();
    const int gw = F.bid * NWAVES + F.wave, NGW = F.G * NWAVES;
    f32x4 g[4];
#pragma unroll
    for (int j = 0; j < 4; ++j) g[j] = *(const f32x4*)(gain + 4 * F.lane + 256 * j);
    f32x4 nx[4];
#define NR_LOAD(mm_) do { _Pragma("unroll") for (int j = 0; j < 4; ++j) { if (MODE == 1) { const v2u w_ = *((const v2u*)((const bf16*)X + (size_t)(mm_) * DM) + F.lane + 64 * j); nx[j] = (f32x4){bflo(w_.x), bfhi(w_.x), bflo(w_.y), bfhi(w_.y)}; } \
        else nx[j] = *((const f32x4*)(X + (size_t)(mm_) * DM) + F.lane + 64 * j); } } while (0)
    if (gw < MT) NR_LOAD(gw);
    for (int m = gw; m < MT; m += NGW) {
        f32x4 v[4]; float s = 0.f;
#pragma unroll
        for (int j = 0; j < 4; ++j) { v[j] = nx[j]; s += (v[j][0] * v[j][0] + v[j][1] * v[j][1]) + (v[j][2] * v[j][2] + v[j][3] * v[j][3]); }
        const int b = m >> 12;
        f32x4 sh[4], sc[4];
#pragma unroll
        for (int j = 0; j < 4; ++j) { const int d = 4 * F.lane + 256 * j; sh[j] = *(const f32x4*)(shift + b * 6144 + d); sc[j] = *(const f32x4*)(scale + b * 6144 + d); }
        if (m + NGW < MT) NR_LOAD(m + NGW);
        const float rstd = __builtin_amdgcn_rsqf(wave_sum(s) * (1.f / DM) + EPSN);
        v2u* o8 = (v2u*)(O + (size_t)m * DM) + F.lane;
#pragma unroll
        for (int j = 0; j < 4; ++j) { const int d = 4 * F.lane + 256 * j;
            const f32x4 h = v[j] * rstd * g[j] * (sc[j] + 1.0f) + sh[j];
            if (MODE == 2) { const f32x4 h8 = h * 8.0f; *(unsigned*)(O8 + (size_t)m * DM + d) = pk4_fp8(h8[0], h8[1], h8[2], h8[3]); }
            else { v2u w; w.x = pk2(h[0], h[1]); w.y = pk2(h[2], h[3]); o8[64 * j] = w; }
            if (MODE == 1) { const f32x4 hs = h * 16.0f; *(unsigned*)(O8 + (size_t)(d >> 8) * ((size_t)MT * 256) + (size_t)m * 256 + (d & 255)) = pk4_fp8(hs[0], hs[1], hs[2], hs[3]); } }
    }
}

__device__ __forceinline__ float lg_gamma(int h) { return __builtin_log2f(1.0f - fexp2((float)(-5 - h))); }
__device__ __forceinline__ v4u scale8(v4u w, float s) {
    v4u o; o.x = pk2(bflo(w.x) * s, bfhi(w.x) * s); o.y = pk2(bflo(w.y) * s, bfhi(w.y) * s); o.z = pk2(bflo(w.z) * s, bfhi(w.z) * s); o.w = pk2(bflo(w.w) * s, bfhi(w.w) * s); return o;
}
__device__ __forceinline__ void f8_to_bf16x16(const v4u w, float sc, v4u& o0, v4u& o1) {
    const f32x4 a = pg8::f8x4(w.x) * sc, b = pg8::f8x4(w.y) * sc, c = pg8::f8x4(w.z) * sc, d = pg8::f8x4(w.w) * sc;
    o0.x = pk2(a[0], a[1]); o0.y = pk2(a[2], a[3]); o0.z = pk2(b[0], b[1]); o0.w = pk2(b[2], b[3]);
    o1.x = pk2(c[0], c[1]); o1.y = pk2(c[2], c[3]); o1.z = pk2(d[0], d[1]); o1.w = pk2(d[2], d[3]);
}
struct KvRegs { v4u k[2], v[4]; };
__device__ __forceinline__ void kv_load(Frame& F, int u, KvRegs& R) {
    const int b = u >> 7, h = (u >> 5) & 3, c = u & 31; const size_t tok0 = (size_t)b * SEQ + c * 128;
    const unsigned char* Kb = F.dout + DO_K; const unsigned char* Vb = F.ws + WS_V;
#pragma unroll
    for (int i = 0; i < 2; ++i) { const int ch = F.tid + 512 * i, j = ch >> 3, cc = ch & 7; R.k[i] = *(const v4u*)(Kb + (tok0 + j) * 512 + h * 128 + cc * 16); }
#pragma unroll
    for (int i = 0; i < 4; ++i) { const int ch = F.tid + 512 * i, j = ch >> 4, cc = ch & 15; R.v[i] = *(const v4u*)(Vb + (tok0 + j) * 1024 + h * 256 + cc * 16); }
}
__device__ __forceinline__ void kv_unit(Frame& F, int u, KvRegs& R, int unext) {
    const int b = u >> 7, h = (u >> 5) & 3, c = u & 31;
    LAS unsigned char* Kimg = F.lds; LAS unsigned char* Vimg = F.lds + 34816;
    const float lg = lg_gamma(h);
#pragma unroll
    for (int i = 0; i < 2; ++i) { const int ch = F.tid + 512 * i, j = ch >> 3, cc = ch & 7; v4u o0, o1;
        f8_to_bf16x16(R.k[i], fexp2((float)(127 - j) * lg) * (1.0f / 128.0f), o0, o1); *(LAS v4u*)(Kimg + j * KS + cc * 32) = o0; *(LAS v4u*)(Kimg + j * KS + cc * 32 + 16) = o1; }
#pragma unroll
    for (int i = 0; i < 4; ++i) { const int ch = F.tid + 512 * i, j = ch >> 4, cc = ch & 15; v4u o0, o1;
        f8_to_bf16x16(R.v[i], 1.0f / 16.0f, o0, o1); *(LAS v4u*)(Vimg + j * VS + cc * 32) = o0; *(LAS v4u*)(Vimg + j * VS + cc * 32 + 16) = o1; }
    __syncthreads();
    if (unext >= 0) kv_load(F, unext, R);
    f32x4 acc[8][2];
#pragma unroll
    for (int dt = 0; dt < 8; ++dt) { acc[dt][0] = (f32x4){0.f, 0.f, 0.f, 0.f}; acc[dt][1] = (f32x4){0.f, 0.f, 0.f, 0.f}; }
#pragma unroll
    for (int js = 0; js < 4; ++js) {
        bf16x8 bv[2];
#pragma unroll
        for (int vt = 0; vt < 2; ++vt) bv[vt] = lds_tr_frag(Vimg, VS, 32 * js, 32 * F.wave + 16 * vt, F.lane);
#pragma unroll
        for (int dt = 0; dt < 8; ++dt) { const bf16x8 a = lds_tr_frag(Kimg, KS, 32 * js, 16 * dt, F.lane);
            acc[dt][0] = MFMA16(a, bv[0], acc[dt][0]); acc[dt][1] = MFMA16(a, bv[1], acc[dt][1]); }
    }
    bf16* dst = (bf16*)(F.dout + DO_KVS) + (size_t)(((b * 4 + h) * 32 + c)) * 32768;
#pragma unroll
    for (int dt = 0; dt < 8; ++dt)
#pragma unroll
        for (int vt = 0; vt < 2; ++vt) { const int v = 32 * F.wave + 16 * vt + (F.lane & 15), d0 = 16 * dt + 4 * (F.lane >> 4);
            v2u o; o.x = pk2(acc[dt][vt][0], acc[dt][vt][1]); o.y = pk2(acc[dt][vt][2], acc[dt][vt][3]);
            *(v2u*)(dst + v * 128 + d0) = o; }
    __syncthreads();
}
struct SguRegs { v2u sv[8]; f32x2v st[8]; };
__device__ __forceinline__ void sgu_load(Frame& F, int su, SguRegs& R) {
    const size_t tok0 = (size_t)(su >> 2) * 128; const int g = su & 3; const unsigned char* SVb = F.ws + WS_SV; const float* stat = (const float*)(F.ws + WS_SVSTAT);
    int tq = F.tid; asm volatile("" : "+v"(tq));
#pragma unroll
    for (int i = 0; i < 8; ++i) { const int ch = tq + 512 * i, sr = ch >> 5, cc = ch & 31;
        R.sv[i] = *(const v2u*)(SVb + (tok0 + sr) * 1024 + g * 256 + cc * 8); R.st[i] = *(const f32x2v*)(stat + (tok0 + sr) * 2); }
}
__device__ __forceinline__ void sgu_unit(Frame& F, int su, SguRegs& R, int snext, int& cur_g) {
    const size_t tok0 = (size_t)(su >> 2) * 128; const int g = su & 3;
    LAS unsigned char* Vn = F.lds; LAS unsigned char* Wimg = F.lds + 67584;
    const unsigned char* Ub = F.ws + WS_U; const bf16* Wm = (const bf16*)(F.ws + WS_SGUW);
    { const int cc = F.tid & 31; const int col = g * 256 + cc * 8;
        const f32x4 g0 = *(const f32x4*)(F.sgu_ln_g + col), g1 = *(const f32x4*)(F.sgu_ln_g + col + 4), b0 = *(const f32x4*)(F.sgu_ln_b + col), b1 = *(const f32x4*)(F.sgu_ln_b + col + 4);
#pragma unroll
        for (int i = 0; i < 8; ++i) { const int ch = F.tid + 512 * i, sr = ch >> 5; const f32x4 w0 = pg8::f8x4(R.sv[i].x) * 0.0625f, w1 = pg8::f8x4(R.sv[i].y) * 0.0625f;
            const float mean = R.st[i].x * (1.f / 1024.f), var = R.st[i].y * (1.f / 1024.f) - mean * mean, rstd = __builtin_amdgcn_rsqf(var + EPSN);
            v4u o;
            o.x = pk2((w0[0] - mean) * rstd * g0[0] + b0[0], (w0[1] - mean) * rstd * g0[1] + b0[1]);
            o.y = pk2((w0[2] - mean) * rstd * g0[2] + b0[2], (w0[3] - mean) * rstd * g0[3] + b0[3]);
            o.z = pk2((w1[0] - mean) * rstd * g1[0] + b1[0], (w1[1] - mean) * rstd * g1[1] + b1[1]);
            o.w = pk2((w1[2] - mean) * rstd * g1[2] + b1[2], (w1[3] - mean) * rstd * g1[3] + b1[3]);
            *(LAS v4u*)(Vn + sr * VS + cc * 16) = o; } }
    if (g != cur_g) { cur_g = g;
#pragma unroll
        for (int i = 0; i < 4; ++i) { const int ch = F.tid + 512 * i, t = ch >> 4, cc = ch & 15;
            *(LAS v4u*)(Wimg + t * KS + cc * 16) = *(const v4u*)(Wm + (size_t)(g * 128 + t) * 128 + cc * 8); } }
    __syncthreads();
    if (snext >= 0) sgu_load(F, snext, R);
    unsigned uv[8][2];
#pragma unroll
    for (int tt = 0; tt < 8; ++tt)
#pragma unroll
        for (int ct = 0; ct < 2; ++ct) uv[tt][ct] = *(const unsigned*)(Ub + (tok0 + 16 * tt + (F.lane & 15)) * 1024 + g * 256 + 32 * F.wave + 16 * ct + 4 * (F.lane >> 4));
    f32x4 acc[2][8];
#pragma unroll
    for (int ct = 0; ct < 2; ++ct)
#pragma unroll
        for (int tt = 0; tt < 8; ++tt) acc[ct][tt] = (f32x4){0.f, 0.f, 0.f, 0.f};
#pragma unroll
    for (int ss = 0; ss < 4; ++ss) {
        bf16x8 av[2];
#pragma unroll
        for (int ct = 0; ct < 2; ++ct) av[ct] = lds_tr_frag(Vn, VS, 32 * ss, 32 * F.wave + 16 * ct, F.lane);
#pragma unroll
        for (int tt = 0; tt < 8; ++tt) if (tt >= 2 * ss) { const bf16x8 bw = lds_row_frag(Wimg, KS, 16 * tt, 32 * ss, F.lane);
            acc[0][tt] = MFMA16(av[0], bw, acc[0][tt]); acc[1][tt] = MFMA16(av[1], bw, acc[1][tt]); }
    }
#pragma unroll
    for (int tt = 0; tt < 8; ++tt) { const int t = 16 * tt + (F.lane & 15); const float bs = F.sgu_b[g * 128 + t];
#pragma unroll
        for (int ct = 0; ct < 2; ++ct) { const int cg = g * 256 + 32 * F.wave + 16 * ct + 4 * (F.lane >> 4); const f32x4 u4 = pg8::f8x4(uv[tt][ct]) * 0.5f;
            *(unsigned*)(F.ws + WS_YS8 + (tok0 + t) * 1024 + cg) = pk4_fp8(u4[0] * (acc[ct][tt][0] + bs), u4[1] * (acc[ct][tt][1] + bs), u4[2] * (acc[ct][tt][2] + bs), u4[3] * (acc[ct][tt][3] + bs)); } }
    __syncthreads();
}
__device__ __forceinline__ void p2a(Frame& F) { F.fence_ids();
    { KvRegs R; if (F.bid < 1024) kv_load(F, F.bid, R);
      for (int u = F.bid; u < 1024; u += F.G) kv_unit(F, u, R, (u + F.G < 1024) ? u + F.G : -1); }
#if MK_PROBE_HI > 0
    if (F.bid == 0 && threadIdx.x == 0) { const unsigned long long _t = __builtin_amdgcn_s_memrealtime(); F.misc[16 + 2 * 20] = (unsigned)_t; F.misc[17 + 2 * 20] = (unsigned)(_t >> 32); }
#endif
    { SguRegs R; int cur_g = -1; if (F.bid < 1024) sgu_load(F, F.bid, R);
      for (int su = F.bid; su < 1024; su += F.G) sgu_unit(F, su, R, (su + F.G < 1024) ? su + F.G : -1, cur_g); }
}
__device__ __forceinline__ void p2b(Frame& F) { F.fence_ids();
    bf16* KVS = (bf16*)(F.dout + DO_KVS);
    for (int item = F.bid * 512 + F.tid; item < 32 * 4096; item += F.G * 512) {
        const int bh = item >> 12, rem = item & 4095, h = bh & 3;
        const float dc = fexp2(128.0f * lg_gamma(h));
        float s[8];
#pragma unroll
        for (int e = 0; e < 8; ++e) s[e] = 0.f;
        bf16* p = KVS + (size_t)bh * 32 * 32768 + (size_t)rem * 8;
        for (int c0 = 0; c0 < 32; c0 += 8) {
            v4u kv[8];
#pragma unroll
            for (int i = 0; i < 8; ++i) kv[i] = *(const v4u*)(p + (size_t)(c0 + i) * 32768);
#pragma unroll
            for (int i = 0; i < 8; ++i) {
                v4u o; o.x = pk2(s[0], s[1]); o.y = pk2(s[2], s[3]); o.z = pk2(s[4], s[5]); o.w = pk2(s[6], s[7]);
                *(v4u*)(p + (size_t)(c0 + i) * 32768) = o;
                s[0] = s[0] * dc + bflo(kv[i].x); s[1] = s[1] * dc + bfhi(kv[i].x); s[2] = s[2] * dc + bflo(kv[i].y); s[3] = s[3] * dc + bfhi(kv[i].y);
                s[4] = s[4] * dc + bflo(kv[i].z); s[5] = s[5] * dc + bfhi(kv[i].z); s[6] = s[6] * dc + bflo(kv[i].w); s[7] = s[7] * dc + bfhi(kv[i].w);
            }
        }
    }
}
struct RetRegs { v4u q[2], k[2], v[4]; };
__device__ __forceinline__ void ret_load(Frame& F, int u, RetRegs& R) {
    const int b = u >> 7, h = (u >> 5) & 3, c = u & 31; const size_t tok0 = (size_t)b * SEQ + c * 128;
    const unsigned char* Qb = F.dout + DO_Q; const unsigned char* Kb = F.dout + DO_K; const unsigned char* Vb = F.ws + WS_V;
#pragma unroll
    for (int i = 0; i < 2; ++i) { const int ch = F.tid + 512 * i, j = ch >> 3, cc = ch & 7;
        R.q[i] = *(const v4u*)(Qb + (tok0 + j) * 512 + h * 128 + cc * 16); R.k[i] = *(const v4u*)(Kb + (tok0 + j) * 512 + h * 128 + cc * 16); }
#pragma unroll
    for (int i = 0; i < 4; ++i) { const int ch = F.tid + 512 * i, j = ch >> 4, cc = ch & 15; R.v[i] = *(const v4u*)(Vb + (tok0 + j) * 1024 + h * 256 + cc * 16); }
}
__device__ __forceinline__ void ret_unit(Frame& F, int u, RetRegs& R, int unext) {
    const int b = u >> 7, h = (u >> 5) & 3, c = u & 31;
    const size_t tok0 = (size_t)b * SEQ + c * 128;
    LAS unsigned char* Qimg = F.lds; LAS unsigned char* Kimg = F.lds + 34816; LAS unsigned char* Vimg = F.lds + 69632;
    LAS unsigned char* Sout = F.lds;
    const unsigned char* Gb = F.ws + WS_G;
    const bf16* ST = (const bf16*)(F.dout + DO_KVS) + (size_t)(((b * 4 + h) * 32 + c)) * 32768;
    const float lg = lg_gamma(h);
    const int lane = F.lane, w = F.wave, l15 = lane & 15, g4 = lane >> 4;
#pragma unroll
    for (int i = 0; i < 2; ++i) { const int ch = F.tid + 512 * i, j = ch >> 3, cc = ch & 7; v4u o0, o1;
        f8_to_bf16x16(R.q[i], 1.0f / 16.0f, o0, o1); *(LAS v4u*)(Qimg + j * KS + cc * 32) = o0; *(LAS v4u*)(Qimg + j * KS + cc * 32 + 16) = o1;
        f8_to_bf16x16(R.k[i], 1.0f / 128.0f, o0, o1); *(LAS v4u*)(Kimg + j * KS + cc * 32) = o0; *(LAS v4u*)(Kimg + j * KS + cc * 32 + 16) = o1; }
#pragma unroll
    for (int i = 0; i < 4; ++i) { const int ch = F.tid + 512 * i, j = ch >> 4, cc = ch & 15; v4u o0, o1;
        f8_to_bf16x16(R.v[i], 1.0f / 16.0f, o0, o1); *(LAS v4u*)(Vimg + j * VS + cc * 32) = o0; *(LAS v4u*)(Vimg + j * VS + cc * 32 + 16) = o1; }
    bf16x8 bs[4][2];
#pragma unroll
    for (int ds = 0; ds < 4; ++ds)
#pragma unroll
        for (int vt = 0; vt < 2; ++vt) bs[ds][vt] = *(const bf16x8*)(ST + (size_t)(32 * w + 16 * vt + l15) * 128 + 32 * ds + 8 * g4);
    __syncthreads();
    f32x4 st[8];
#pragma unroll
    for (int jt = 0; jt < 8; ++jt) st[jt] = (f32x4){0.f, 0.f, 0.f, 0.f};
#pragma unroll
    for (int ds = 0; ds < 4; ++ds) { const bf16x8 bq = lds_row_frag(Qimg, KS, 16 * w, 32 * ds, lane);
#pragma unroll
        for (int jt = 0; jt < 8; ++jt) if (jt <= w) { const bf16x8 ak = lds_row_frag(Kimg, KS, 16 * jt, 32 * ds, lane); st[jt] = MFMA16(ak, bq, st[jt]); } }
    __syncthreads();
    { const int i = 16 * w + l15;
#pragma unroll
        for (int jt = 0; jt < 8; ++jt) { float o[4];
#pragma unroll
            for (int ii = 0; ii < 4; ++ii) { const int j = 16 * jt + 4 * g4 + ii; o[ii] = (i >= j) ? st[jt][ii] * fexp2((float)(i - j) * lg) : 0.f; }
            v2u pk; pk.x = pk2(o[0], o[1]); pk.y = pk2(o[2], o[3]);
            *(LAS v2u*)(Kimg + i * KS + (16 * jt + 4 * g4) * 2) = pk; } }
    __syncthreads();
    f32x4 acc[8][2];
#pragma unroll
    for (int it = 0; it < 8; ++it) { acc[it][0] = (f32x4){0.f, 0.f, 0.f, 0.f}; acc[it][1] = (f32x4){0.f, 0.f, 0.f, 0.f}; }
#pragma unroll
    for (int ds = 0; ds < 4; ++ds) {
#pragma unroll
        for (int it = 0; it < 8; ++it) { const bf16x8 a = lds_row_frag(Qimg, KS, 16 * it, 32 * ds, lane);
            acc[it][0] = MFMA16(a, bs[ds][0], acc[it][0]); acc[it][1] = MFMA16(a, bs[ds][1], acc[it][1]); } }
#pragma unroll
    for (int it = 0; it < 8; ++it)
#pragma unroll
        for (int ii = 0; ii < 4; ++ii) { const float dq = fexp2((float)(16 * it + 4 * g4 + ii + 1) * lg); acc[it][0][ii] *= dq; acc[it][1][ii] *= dq; }
#pragma unroll
    for (int js = 0; js < 4; ++js) { bf16x8 bv[2];
#pragma unroll
        for (int vt = 0; vt < 2; ++vt) bv[vt] = lds_tr_frag(Vimg, VS, 32 * js, 32 * w + 16 * vt, lane);
#pragma unroll
        for (int it = 0; it < 8; ++it) if (it >= 2 * js) { const bf16x8 a = lds_row_frag(Kimg, KS, 16 * it, 32 * js, lane);
            acc[it][0] = MFMA16(a, bv[0], acc[it][0]); acc[it][1] = MFMA16(a, bv[1], acc[it][1]); } }
    int lane_h = lane; asm volatile("" : "+v"(lane_h));
    unsigned gt[16];
#pragma unroll
    for (int rr = 0; rr < 16; ++rr) gt[rr] = *(const unsigned*)(Gb + (tok0 + 16 * w + rr) * 1024 + h * 256 + 4 * lane_h);
    const f32x4 gn = *(const f32x4*)(F.ret_gn_g + h * 256 + 4 * lane_h);
    __syncthreads();
#pragma unroll
    for (int it = 0; it < 8; ++it)
#pragma unroll
        for (int vt = 0; vt < 2; ++vt)
#pragma unroll
            for (int ii = 0; ii < 4; ++ii) *(LAS float*)(Sout + (16 * it + 4 * g4 + ii) * 1040 + (32 * w + 16 * vt + l15) * 4) = acc[it][vt][ii];
    __syncthreads();
#pragma unroll
    for (int rr = 0; rr < 16; ++rr) { const int i = 16 * w + rr;
        const f32x4 y = *(LAS const f32x4*)(Sout + i * 1040 + lane_h * 16);
        const float mean = wave_sum((y[0] + y[1]) + (y[2] + y[3])) * (1.f / 256.f);
        const f32x4 d = y - mean;
        const float var = wave_sum((d[0] * d[0] + d[1] * d[1]) + (d[2] * d[2] + d[3] * d[3])) * (1.f / 256.f);
        const float r8 = __builtin_amdgcn_rsqf(var + EPSN) * (4.0f / 16.0f);
        const size_t off = (tok0 + i) * 1024 + h * 256 + 4 * lane_h; const f32x4 gq = pg8::f8x4(gt[rr]);
        *(unsigned*)(F.ws + WS_YG8 + off) = pk4_fp8(d[0] * r8 * gn[0] * gq[0], d[1] * r8 * gn[1] * gq[1], d[2] * r8 * gn[2] * gq[2], d[3] * r8 * gn[3] * gq[3]); }
    __syncthreads();
}
__device__ __forceinline__ void p2c(Frame& F) { F.fence_ids(); for (int u = F.bid; u < 1024; u += F.G) { RetRegs R; ret_load(F, u, R); ret_unit(F, u, R, -1); } }

__device__ __forceinline__ float dppx(float v, int) { return v; }
template <int CTRL> __device__ __forceinline__ void merge16(float (&L)[16]) {
    float c[16];
#pragma unroll
    for (int i = 0; i < 16; ++i) c[i] = __builtin_fmaxf(L[i], dpp_f<CTRL>(L[15 - i]));
#pragma unroll
    for (int half = 8; half >= 1; half >>= 1)
#pragma unroll
        for (int i = 0; i < 16; ++i) if ((i & half) == 0) { const float hi = __builtin_fmaxf(c[i], c[i + half]), lo = __builtin_fminf(c[i], c[i + half]); c[i] = hi; c[i + half] = lo; }
#pragma unroll
    for (int i = 0; i < 16; ++i) L[i] = c[i];
}
__device__ __forceinline__ void sort16_desc(float (&v)[16]) {
#pragma unroll
    for (int k = 2; k <= 16; k <<= 1)
#pragma unroll
        for (int j = k >> 1; j >= 1; j >>= 1)
#pragma unroll
            for (int i = 0; i < 16; ++i) { const int l = i ^ j; if (l > i) { const bool desc = ((i & k) == 0) || (k == 16);
                const float hi = __builtin_fmaxf(v[i], v[l]), lo = __builtin_fminf(v[i], v[l]); v[i] = desc ? hi : lo; v[l] = desc ? lo : hi; } }
}
__device__ __forceinline__ void merge_top16(float (&A)[16], const float (&B)[16]) {
#pragma unroll
    for (int i = 0; i < 16; ++i) A[i] = __builtin_fmaxf(A[i], B[15 - i]);
#pragma unroll
    for (int half = 8; half >= 1; half >>= 1)
#pragma unroll
        for (int i = 0; i < 16; ++i) if ((i & half) == 0) { const float hi = __builtin_fmaxf(A[i], A[i + half]), lo = __builtin_fminf(A[i], A[i + half]); A[i] = hi; A[i + half] = lo; }
}
__device__ __forceinline__ void p5b(Frame& F) {
    F.fence_ids();
    LAS unsigned char* Aimg = F.lds; LAS unsigned char* Bimg = F.lds + 34816; LAS float* Sc = (LAS float*)(F.lds + 69632);
    const bf16* QP = (const bf16*)(F.ws + WS_GA);
    const int lane = F.lane, w = F.wave;
    int cur_hp = -1;
    v4u pa[4];
    if (F.bid < 4096) { const int tt = F.bid >> 4, hp = F.bid & 15;
#pragma unroll
        for (int i = 0; i < 4; ++i) { const int ch = F.tid + 512 * i, r = ch >> 4, cc = ch & 15; pa[i] = *(const v4u*)(QP + ((size_t)tt * 128 + r) * 2048 + hp * 128 + cc * 8); } }
    for (int u = F.bid; u < 4096; u += F.G) {
        const int tt = u >> 4, hp = u & 15; const size_t tok0 = (size_t)tt * 128;
#pragma unroll
        for (int i = 0; i < 4; ++i) { const int ch = F.tid + 512 * i, r = ch >> 4, cc = ch & 15; *(LAS v4u*)(Aimg + r * KS + cc * 16) = pa[i]; }
        if (hp != cur_hp) { const bf16* SK = (const bf16*)(F.ws + WS_SK) + (size_t)hp * 16384; cur_hp = hp;
#pragma unroll
            for (int i = 0; i < 4; ++i) { const int ch = F.tid + 512 * i, r = ch >> 4, cc = ch & 15; *(LAS v4u*)(Bimg + r * KS + cc * 16) = *(const v4u*)(SK + (size_t)r * 128 + cc * 8); } }
        __syncthreads();
        { const int un = u + F.G; if (un < 4096) { const int tn = un >> 4, hn = un & 15;
#pragma unroll
            for (int i = 0; i < 4; ++i) { const int ch = F.tid + 512 * i, r = ch >> 4, cc = ch & 15; pa[i] = *(const v4u*)(QP + ((size_t)tn * 128 + r) * 2048 + hn * 128 + cc * 8); } } }
        f32x4 acc[8];
#pragma unroll
        for (int nt = 0; nt < 8; ++nt) acc[nt] = (f32x4){0.f, 0.f, 0.f, 0.f};
#pragma unroll
        for (int ks = 0; ks < 4; ++ks) { const bf16x8 a = lds_row_frag(Aimg, KS, 16 * w, 32 * ks, lane);
#pragma unroll
            for (int nt = 0; nt < 8; ++nt) { const bf16x8 bb = lds_row_frag(Bimg, KS, 16 * nt, 32 * ks, lane); acc[nt] = MFMA16(a, bb, acc[nt]); } }
#pragma unroll
        for (int nt = 0; nt < 8; ++nt)
#pragma unroll
            for (int ii = 0; ii < 4; ++ii) Sc[(16 * w + 4 * (lane >> 4) + ii) * 132 + 16 * nt + (lane & 15)] = acc[nt][ii];
        __syncthreads();
        { const int row = F.tid >> 2, q = F.tid & 3;
            float L[16], L2[16];
#pragma unroll
            for (int i = 0; i < 16; ++i) { const int n = 4 * i + q, n2 = 4 * (i + 16) + q;
                L[i] = __uint_as_float((__float_as_uint(Sc[row * 132 + n]) & 0xFFFFFF80u) | (unsigned)n);
                L2[i] = __uint_as_float((__float_as_uint(Sc[row * 132 + n2]) & 0xFFFFFF80u) | (unsigned)n2); }
            sort16_desc(L); sort16_desc(L2); merge_top16(L, L2);
            merge16<0xB1>(L); merge16<0x4E>(L);
            if (q == 0) { v4u* dst = (v4u*)((unsigned*)(F.ws + WS_SUB) + ((tok0 + row) * 16 + hp) * 16);
#pragma unroll
                for (int i = 0; i < 4; ++i) dst[i] = (v4u){__float_as_uint(L[4 * i]), __float_as_uint(L[4 * i + 1]), __float_as_uint(L[4 * i + 2]), __float_as_uint(L[4 * i + 3])}; } }
        __syncthreads();
    }
}

template <int CTRL> __device__ __forceinline__ float dpp_max(float v) { return __builtin_fmaxf(v, dpp_f<CTRL>(v)); }
template <int CTRL> __device__ __forceinline__ float dpp_add(float v) { return v + dpp_f<CTRL>(v); }
__device__ __forceinline__ float row_allmax(float v) { v = dpp_max<0x128>(v); v = dpp_max<0x124>(v); v = dpp_max<0x122>(v); v = dpp_max<0x121>(v); return v; }
__device__ __forceinline__ float row_allsum(float v) { v = dpp_add<0x128>(v); v = dpp_add<0x124>(v); v = dpp_add<0x122>(v); v = dpp_add<0x121>(v); return v; }
__device__ __forceinline__ void p6a(Frame& F) { F.fence_ids();
    const int lane = F.lane, row = lane >> 4, i = lane & 15, rowbase = lane & 48;
    LAS unsigned* Sel = (LAS unsigned*)(F.lds + F.wave * 1024);
    const unsigned* SUB = (const unsigned*)(F.ws + WS_SUB);
    unsigned short* EID = (unsigned short*)(F.ws + WS_EID); float* GWp = (float*)(F.ws + WS_GW);
    const int gw = F.bid * NWAVES + F.wave, NGW = F.G * NWAVES;
    unsigned nab[2], nbb[2];
    if (gw < MT) {
#pragma unroll
        for (int r = 0; r < 2; ++r) { const int h = 4 * r + row; nab[r] = SUB[((size_t)gw * 16 + 2 * h) * 16 + i]; nbb[r] = SUB[((size_t)gw * 16 + 2 * h + 1) * 16 + i]; } }
    for (int t = gw; t < MT; t += NGW) {
        unsigned abits[2], bbits[2], bcur[2]; float a[2], hv[2]; int ptr[2];
#pragma unroll
        for (int r = 0; r < 2; ++r) { abits[r] = nab[r]; bbits[r] = nbb[r]; a[r] = __uint_as_float(abits[r]); ptr[r] = 0; bcur[r] = (unsigned)__shfl((int)bbits[r], rowbase); hv[r] = a[r] + __uint_as_float(bcur[r]); }
        if (t + NGW < MT) {
#pragma unroll
            for (int r = 0; r < 2; ++r) { const int h = 4 * r + row; nab[r] = SUB[((size_t)(t + NGW) * 16 + 2 * h) * 16 + i]; nbb[r] = SUB[((size_t)(t + NGW) * 16 + 2 * h + 1) * 16 + i]; } }
        for (int k = 0; k < 16; ++k) {
#pragma unroll
            for (int r = 0; r < 2; ++r) {
                const float key = __uint_as_float((__float_as_uint(hv[r]) & 0xFFFFFFF0u) | (unsigned)i);
                const float m = row_allmax(key);
                const bool win = (key == m);
                if (win) { Sel[((r * 4 + row) * 16 + k) * 2] = (abits[r] & 127u) * 128u + (bcur[r] & 127u); Sel[((r * 4 + row) * 16 + k) * 2 + 1] = __float_as_uint(hv[r]); ptr[r]++; }
                const unsigned bnext = (unsigned)__shfl((int)bbits[r], rowbase + (ptr[r] < 15 ? ptr[r] : 15));
                if (win) { bcur[r] = bnext; hv[r] = (ptr[r] < 16) ? a[r] + __uint_as_float(bnext) : -3.0e38f; }
            }
        }
        LDS_WAIT(); asm volatile("" ::: "memory");
#pragma unroll
        for (int r = 0; r < 2; ++r) { const int h = 4 * r + row;
            const unsigned e = Sel[((r * 4 + row) * 16 + i) * 2]; const float sc = __uint_as_float(Sel[((r * 4 + row) * 16 + i) * 2 + 1]);
            const float mx = row_allmax(sc);
            const float ex = fexp2((sc - mx) * 1.44269504089f);
            const float sum = row_allsum(ex);
            EID[(size_t)t * 128 + h * 16 + i] = (unsigned short)e; GWp[(size_t)t * 128 + h * 16 + i] = ex / sum; }
        LDS_WAIT(); asm volatile("" ::: "memory");
    }
}
typedef float f32x2c __attribute__((ext_vector_type(2)));
__device__ __forceinline__ long mk64(unsigned lo, unsigned hi) { return (long)(((unsigned long long)hi << 32) | lo); }
#if MK_U4
typedef int v8i_q __attribute__((ext_vector_type(8)));
__device__ __forceinline__ void p6b(Frame& F) { F.fence_ids();
    const int j = F.bid & 7, s2 = j >> 1, par = j & 1, nsb = F.G >> 3; if ((F.bid >> 3) >= nsb) return;
    const int wj = (F.bid >> 3) * NWAVES + F.wave, NW = nsb * NWAVES, NI = MT / 2;
    const int lane = F.lane, g = lane >> 4;
    const int pidx = (4 * (lane & 15) + (lane >> 4)) * 4;
    const unsigned char* H8 = F.ws + WS_H2F8 + (size_t)s2 * MT * 256 + 16 * g; const unsigned char* U4 = F.ws + WS_UE8 + (size_t)s2 * 16384 * 128 + 16 * (lane & 3); const unsigned short* EID = (const unsigned short*)(F.ws + WS_EID) + (lane >> 2);
    unsigned* PDp = (unsigned*)(F.ws + WS_PD) + (size_t)s2 * MT * 64;
#define TOK(ix_) (2 * ((ix_) < NI ? (ix_) : NI - 1) + par)
#define P6B_LOAD_EID(E, ix_) do { const int tc_ = TOK(ix_); _Pragma("unroll") for (int h = 0; h < 8; ++h) E[h] = EID[(size_t)tc_ * 128 + 16 * h]; } while (0)
#define P6B_LOAD_AB(A_, B0_, B1_, E, ix_) do { const int tc_ = TOK(ix_); const unsigned char* hp_ = H8 + (size_t)tc_ * 256; A_[0] = *(const v4u*)hp_; A_[1] = *(const v4u*)(hp_ + 64); A_[2] = *(const v4u*)(hp_ + 128); A_[3] = *(const v4u*)(hp_ + 192); \
        _Pragma("unroll") for (int h = 0; h < 8; ++h) { const unsigned char* rp_ = U4 + (size_t)E[h] * 128; B0_[h] = *(const v4u*)rp_; B1_[h] = *(const v4u*)(rp_ + 64); } } while (0)
#define BPM(x_) ((int)__builtin_amdgcn_ds_bpermute(pidx, (int)(x_)))
#define P6B_COMPUTE(A_, B0_, B1_, ix_) do { if ((ix_) < NI) { const int tc_ = 2 * (ix_) + par; \
        const v8i_q a0_ = (v8i_q){(int)A_[0].x, (int)A_[0].y, (int)A_[0].z, (int)A_[0].w, (int)A_[1].x, (int)A_[1].y, (int)A_[1].z, (int)A_[1].w}, a1_ = (v8i_q){(int)A_[2].x, (int)A_[2].y, (int)A_[2].z, (int)A_[2].w, (int)A_[3].x, (int)A_[3].y, (int)A_[3].z, (int)A_[3].w}; \
        float pv_[8]; \
        _Pragma("unroll") for (int h = 0; h < 8; ++h) { const v8i_q b0_ = (v8i_q){BPM(B0_[h].x), BPM(B0_[h].y), BPM(B0_[h].z), BPM(B0_[h].w), 0, 0, 0, 0}, b1_ = (v8i_q){BPM(B1_[h].x), BPM(B1_[h].y), BPM(B1_[h].z), BPM(B1_[h].w), 0, 0, 0, 0}; \
            f32x4 acc_ = __builtin_amdgcn_mfma_scale_f32_16x16x128_f8f6f4(a0_, b0_, (f32x4){0.f, 0.f, 0.f, 0.f}, 0, 4, 0, 0x7F7F7F7F, 0, 0x7F7F7F7F); \
            acc_ = __builtin_amdgcn_mfma_scale_f32_16x16x128_f8f6f4(a1_, b1_, acc_, 0, 4, 0, 0x7F7F7F7F, 0, 0x7F7F7F7F); pv_[h] = acc_[0] * (1.0f / 1024.0f); } \
        if (lane < 16) { _Pragma("unroll") for (int hp = 0; hp < 4; ++hp) PDp[(size_t)tc_ * 64 + 16 * hp + lane] = pk2(pv_[2 * hp], pv_[2 * hp + 1]); } } } while (0)
    unsigned E0[8], E1[8]; v4u A0[4], A1[4], B00[8], B01[8], B10[8], B11[8];
    int ix = wj;
    P6B_LOAD_EID(E0, ix); P6B_LOAD_EID(E1, ix + NW);
    P6B_LOAD_AB(A0, B00, B01, E0, ix);
    for (; ix < NI; ix += 2 * NW) {
        P6B_LOAD_AB(A1, B10, B11, E1, ix + NW);
        P6B_LOAD_EID(E0, ix + 2 * NW);
        P6B_COMPUTE(A0, B00, B01, ix);
        P6B_LOAD_AB(A0, B00, B01, E0, ix + 2 * NW);
        P6B_LOAD_EID(E1, ix + 3 * NW);
        P6B_COMPUTE(A1, B10, B11, ix + NW);
    }
#undef TOK
#undef P6B_LOAD_EID
#undef P6B_LOAD_AB
#undef P6B_COMPUTE
#undef BPM
}
#else
__device__ __forceinline__ void p6b(Frame& F) { F.fence_ids();
    const int j = F.bid & 7, nsb = F.G >> 3; if ((F.bid >> 3) >= nsb) return;
    const int wj = (F.bid >> 3) * NWAVES + F.wave, NW = nsb * NWAVES;
    const int lane = F.lane, g = lane >> 4;
    const int pidx = (4 * (lane & 15) + (lane >> 4)) * 4;
    const unsigned char* H8 = F.ws + WS_H2F8 + (size_t)j * MT * 128 + 16 * g; const unsigned char* UE8 = F.ws + WS_UE8 + (size_t)j * 16384 * 128 + 16 * (lane & 3); const unsigned* EID = (const unsigned*)(F.ws + WS_EID) + (lane >> 2);
    float* PD = (float*)(F.ws + WS_PD) + (size_t)j * MT * 128;
#define P6B_LOAD_EID(E, tt) do { const int tc_ = (tt) < MT ? (tt) : MT - 1; _Pragma("unroll") for (int h = 0; h < 8; ++h) E[h] = EID[(size_t)tc_ * 128 + 16 * h]; } while (0)
#define P6B_LOAD_AB(A0_, A1_, B0_, B1_, E, tt) do { const int tc_ = (tt) < MT ? (tt) : MT - 1; const unsigned char* hp_ = H8 + (size_t)tc_ * 128; A0_ = *(const v4u*)hp_; A1_ = *(const v4u*)(hp_ + 64); \
        _Pragma("unroll") for (int h = 0; h < 8; ++h) { const unsigned char* rp_ = UE8 + (size_t)E[h] * 128; B0_[h] = *(const v4u*)rp_; B1_[h] = *(const v4u*)(rp_ + 64); } } while (0)
#define BPM(x_) ((unsigned)__builtin_amdgcn_ds_bpermute(pidx, (int)(x_)))
#define P6B_COMPUTE(A0_, A1_, B0_, B1_, tt) do { if ((tt) < MT) { _Pragma("unroll") for (int h = 0; h < 8; ++h) { f32x4 acc_ = (f32x4){0.f, 0.f, 0.f, 0.f}; \
            acc_ = __builtin_amdgcn_mfma_f32_16x16x32_fp8_fp8(mk64(A0_.x, A0_.y), mk64(BPM(B0_[h].x), BPM(B0_[h].y)), acc_, 0, 0, 0); \
            acc_ = __builtin_amdgcn_mfma_f32_16x16x32_fp8_fp8(mk64(A0_.z, A0_.w), mk64(BPM(B0_[h].z), BPM(B0_[h].w)), acc_, 0, 0, 0); \
            acc_ = __builtin_amdgcn_mfma_f32_16x16x32_fp8_fp8(mk64(A1_.x, A1_.y), mk64(BPM(B1_[h].x), BPM(B1_[h].y)), acc_, 0, 0, 0); \
            acc_ = __builtin_amdgcn_mfma_f32_16x16x32_fp8_fp8(mk64(A1_.z, A1_.w), mk64(BPM(B1_[h].z), BPM(B1_[h].w)), acc_, 0, 0, 0); \
            if (lane < 16) PD[(size_t)(tt) * 128 + 16 * h + lane] = acc_[0] * (1.0f / 8192.0f); } } } while (0)
    unsigned E0[8], E1[8]; v4u A00, A01, A10, A11, B00[8], B01[8], B10[8], B11[8];
    int t = wj;
    P6B_LOAD_EID(E0, t); P6B_LOAD_EID(E1, t + NW);
    P6B_LOAD_AB(A00, A01, B00, B01, E0, t);
    for (; t < MT; t += 2 * NW) {
        P6B_LOAD_AB(A10, A11, B10, B11, E1, t + NW);
        P6B_LOAD_EID(E0, t + 2 * NW);
        P6B_COMPUTE(A00, A01, B00, B01, t);
        P6B_LOAD_AB(A00, A01, B00, B01, E0, t + 2 * NW);
        P6B_LOAD_EID(E1, t + 3 * NW);
        P6B_COMPUTE(A10, A11, B10, B11, t + NW);
    }
#undef P6B_LOAD_EID
#undef P6B_LOAD_AB
#undef P6B_COMPUTE
#undef BPM
}
#endif
__device__ __forceinline__ void p6b2(Frame& F) { F.fence_ids();
    const unsigned* PDp = (const unsigned*)(F.ws + WS_PD); const float* GWp = (const float*)(F.ws + WS_GW); bf16* ACT = (bf16*)(F.ws + WS_ACT);
    for (size_t i4 = (size_t)F.bid * 512 + F.tid; i4 < (size_t)MT * 32; i4 += (size_t)F.G * 512) { const size_t t = i4 >> 5; const int p0 = (int)(i4 & 31) * 4, h = p0 >> 4, l0 = p0 & 15;
        f32x4 s = (f32x4){0.f, 0.f, 0.f, 0.f};
#pragma unroll
        for (int jj = 0; jj < 4; ++jj) { const v4u w = *(const v4u*)(PDp + ((size_t)jj * MT + t) * 64 + (h >> 1) * 16 + l0);
            s += (h & 1) ? (f32x4){bfhi(w.x), bfhi(w.y), bfhi(w.z), bfhi(w.w)} : (f32x4){bflo(w.x), bflo(w.y), bflo(w.z), bflo(w.w)}; }
        const f32x4 gw = *(const f32x4*)(GWp + i4 * 4);
        v2u o; o.x = pk2(gelu1(s[0]) * gw[0], gelu1(s[1]) * gw[1]); o.y = pk2(gelu1(s[2]) * gw[2], gelu1(s[3]) * gw[3]);
        *(v2u*)(ACT + i4 * 4) = o;
    }
}
__device__ __forceinline__ void p6c(Frame& F) { F.fence_ids();
    const int j = F.bid & 7, nsb = F.G >> 3; if ((F.bid >> 3) >= nsb) return;
    const int wj = (F.bid >> 3) * NWAVES + F.wave, NW = nsb * NWAVES;
    const int lane = F.lane, g8 = lane >> 3, s8 = lane & 7;
    LAS float* Act = (LAS float*)(F.lds + F.wave * 8192); LAS unsigned* Eidl = (LAS unsigned*)(F.lds + F.wave * 8192 + 4096);
    const unsigned char* VE8 = F.ws + WS_VE8 + (size_t)j * 16384 * 128 + 16 * s8; const unsigned short* EID = (const unsigned short*)(F.ws + WS_EID); const bf16* ACT = (const bf16*)(F.ws + WS_ACT);
    bf16* PEERS = (bf16*)(F.ws + WS_PEERS) + (size_t)j * MT * 128;
    for (int tg = wj; tg < MT / 8; tg += NW) {
        const size_t t0 = (size_t)tg * 8;
#pragma unroll
        for (int q = 0; q < 4; ++q) { const int idx = 4 * (lane + 64 * q);
            const v2u aw = *(const v2u*)(ACT + t0 * 128 + idx), ew = *(const v2u*)(EID + t0 * 128 + idx);
            *(LAS f32x4*)(Act + idx) = (f32x4){bflo(aw.x), bfhi(aw.x), bflo(aw.y), bfhi(aw.y)}; *(LAS v4u*)(Eidl + idx) = (v4u){ew.x & 0xFFFFu, ew.x >> 16, ew.y & 0xFFFFu, ew.y >> 16}; }
        LDS_WAIT(); asm volatile("" ::: "memory");
        f32x2c acc2[8];
#pragma unroll
        for (int e = 0; e < 8; ++e) acc2[e] = (f32x2c){0.f, 0.f};
        LAS const float* ap = Act + g8 * 128; LAS const unsigned* ep = Eidl + g8 * 128;
        v4u va[8], vb[8]; f32x4 aa[2], ab[2];
#define P6C_LOAD(V_, A_, base) do { A_[0] = *(LAS const f32x4*)(ap + (base)); A_[1] = *(LAS const f32x4*)(ap + (base) + 4); const v4u e0_ = *(LAS const v4u*)(ep + (base)), e1_ = *(LAS const v4u*)(ep + (base) + 4); \
            _Pragma("unroll") for (int k = 0; k < 4; ++k) { V_[k] = *(const v4u*)(VE8 + (size_t)e0_[k] * 128); V_[4 + k] = *(const v4u*)(VE8 + (size_t)e1_[k] * 128); } } while (0)
#define P6C_FMA(V_, A_) do { _Pragma("unroll") for (int k = 0; k < 8; ++k) { const float a_ = A_[k >> 2][k & 3]; const f32x2c a2_ = (f32x2c){a_, a_}; _Pragma("unroll") for (int w = 0; w < 4; ++w) { \
            const f32x2c lo_ = __builtin_amdgcn_cvt_pk_f32_fp8((int)V_[k][w], false), hi_ = __builtin_amdgcn_cvt_pk_f32_fp8((int)V_[k][w], true); \
            acc2[2 * w] = __builtin_elementwise_fma(a2_, lo_, acc2[2 * w]); acc2[2 * w + 1] = __builtin_elementwise_fma(a2_, hi_, acc2[2 * w + 1]); } } } while (0)
        P6C_LOAD(va, aa, 0);
        for (int it = 0; it < 128; it += 16) {
            P6C_LOAD(vb, ab, it + 8);
            P6C_FMA(va, aa);
            if (it + 16 < 128) P6C_LOAD(va, aa, it + 16);
            P6C_FMA(vb, ab);
        }
#undef P6C_LOAD
#undef P6C_FMA
        float acc[16];
#pragma unroll
        for (int e = 0; e < 8; ++e) { acc[2 * e] = acc2[e][0]; acc[2 * e + 1] = acc2[e][1]; }
        { bf16* op = PEERS + (t0 + g8) * 128 + 16 * s8;
            v4u o0, o1;
            o0.x = pk2(acc[0] * 0.0625f, acc[1] * 0.0625f); o0.y = pk2(acc[2] * 0.0625f, acc[3] * 0.0625f); o0.z = pk2(acc[4] * 0.0625f, acc[5] * 0.0625f); o0.w = pk2(acc[6] * 0.0625f, acc[7] * 0.0625f);
            o1.x = pk2(acc[8] * 0.0625f, acc[9] * 0.0625f); o1.y = pk2(acc[10] * 0.0625f, acc[11] * 0.0625f); o1.z = pk2(acc[12] * 0.0625f, acc[13] * 0.0625f); o1.w = pk2(acc[14] * 0.0625f, acc[15] * 0.0625f);
            *(v4u*)op = o0; *(v4u*)(op + 8) = o1; }
        LDS_WAIT(); asm volatile("" ::: "memory");
    }
}
__device__ __forceinline__ void p6d(Frame& F) { F.fence_ids();
    const int gw = F.bid * NWAVES + F.wave, NGW = F.G * NWAVES; const bf16* PEERS = (const bf16*)(F.ws + WS_PEERS); const float* gate2 = (const float*)(F.ws + WS_MOD) + 5120;
    f32x4 fg[4];
#pragma unroll
    for (int q = 0; q < 4; ++q) fg[q] = *((const f32x4*)F.final_g + F.lane + 64 * q);
    f32x4 nx[4]; v2u np[4];
#define P6D_LOAD(tt) do { _Pragma("unroll") for (int q = 0; q < 4; ++q) { const int d = 4 * F.lane + 256 * q; { const v2u w_ = *((const v2u*)((const bf16*)(F.ws + WS_X1B) + (size_t)(tt) * DM) + F.lane + 64 * q); nx[q] = (f32x4){bflo(w_.x), bfhi(w_.x), bflo(w_.y), bfhi(w_.y)}; } \
        np[q] = *(const v2u*)(PEERS + ((size_t)(d >> 7) * MT + (tt)) * 128 + (d & 127)); } } while (0)
    if (gw < MT) P6D_LOAD(gw);
    for (int t = gw; t < MT; t += NGW) {
        const int b = t >> 12;
        f32x4* xr = (f32x4*)((float*)F.dout + (size_t)t * DM) + F.lane; f32x4 o[4]; float ss = 0.f;
#pragma unroll
        for (int q = 0; q < 4; ++q) { const int d = 4 * F.lane + 256 * q; const f32x4 g2 = *(const f32x4*)(gate2 + (size_t)b * 6144 + d);
            o[q] = nx[q] + g2 * (f32x4){bflo(np[q].x), bfhi(np[q].x), bflo(np[q].y), bfhi(np[q].y)}; ss += (o[q][0] * o[q][0] + o[q][1] * o[q][1]) + (o[q][2] * o[q][2] + o[q][3] * o[q][3]); }
        if (t + NGW < MT) P6D_LOAD(t + NGW);
        const float rstd = __builtin_amdgcn_rsqf(wave_sum(ss) * (1.f / DM) + EPSN);
#pragma unroll
        for (int q = 0; q < 4; ++q) xr[64 * q] = o[q] * rstd * fg[q];
    }
#undef P6D_LOAD
}

struct Args { const float* in[20]; float* out; unsigned char* ws; int ph_lo, ph_hi, li, pad; };
__global__ void __launch_bounds__(NWAVES * 64, 2) mk_fwd(Args args) {
    extern __shared__ __attribute__((aligned(16))) unsigned char lds_raw[];
    Frame F;
    F.lds = (LAS unsigned char*)lds_raw;
    F.tid = threadIdx.x; F.lane = F.tid & 63; F.wave = __builtin_amdgcn_readfirstlane(F.tid >> 6); F.G = gridDim.x; F.bid = blockIdx.x;
    F.x = args.in[0]; F.c = args.in[1]; F.w_ada = args.in[2]; F.b_ada = args.in[3]; F.norm1_g = args.in[4]; F.w_in = args.in[5]; F.ret_gn_g = args.in[6]; F.sgu_ln_g = args.in[7];
    F.sgu_ln_b = args.in[8]; F.sgu_w = args.in[9]; F.sgu_b = args.in[10]; F.w_ret_out = args.in[11]; F.w_sgu_out = args.in[12]; F.w_out = args.in[13]; F.norm2_g = args.in[14];
    F.peer_w_q = args.in[15]; F.peer_sub_keys = args.in[16]; F.peer_u = args.in[17]; F.peer_v = args.in[18]; F.final_g = args.in[19];
    F.ws = args.ws; F.dout = (unsigned char*)args.out;
    volatile LAS unsigned* MISC = (volatile LAS unsigned*)(F.lds + MISC_OFF); F.misc = MISC;
    if (F.tid < 64) MISC[F.tid] = 0u;
    __syncthreads();
    XcdBarrier bar; bar.bar = (unsigned*)(F.ws + WS_CTL) + CW_BAR; bar.x = 0; bar.st = nullptr;
    if (N_LAUNCHES == 1) bar = xcd_barrier_post((unsigned*)(F.ws + WS_CTL) + CW_BAR, MISC + 8);
    const int lo = args.ph_lo, hi = args.ph_hi;
#define IN(k) (lo <= (k) && (k) < hi)
#if MK_PROBE_HI > 0
#define STAMP(k) do { if (F.bid == 0 && F.wave == 0 && F.lane == 0) { const unsigned long long _t = __builtin_amdgcn_s_memrealtime(); MISC[16 + 2 * (k)] = (unsigned)_t; MISC[17 + 2 * (k)] = (unsigned)(_t >> 32); } } while (0)
#else
#define STAMP(k) do { } while (0)
#endif
#define SEAM(k) do { if (IN(k) && IN((k) + 1)) xcd_barrier(bar); } while (0)
    const float* mod = (const float*)(F.ws + WS_MOD);
    STAMP(0);
    if (IN(0)) { p0a(F); SEAM(0); }
    STAMP(1);
    if (IN(1)) { norm_rows<2>(F, F.x, F.norm1_g, mod + 0, mod + 1024, nullptr, F.dout + DO_H); SEAM(1); }
    STAMP(2);
    if (IN(2)) {
        pg8::Gemm g{(const bf16*)(F.dout + DO_H), (const bf16*)(F.ws + WS_WIN), MT, NIN, 512}; pg8::StaticOrder S; S.init(MT, NIN, F.G, F.bid);
        pg8::EpiProj E{(bf16*)(F.dout + DO_Q), (bf16*)(F.dout + DO_K), (bf16*)(F.ws + WS_V), (bf16*)(F.ws + WS_G), (bf16*)(F.ws + WS_U), (bf16*)(F.ws + WS_SV), (bf16*)(F.ws + WS_GA), (bf16*)(F.ws + WS_GB),
                       (const float*)(F.ws + WS_COS), (const float*)(F.ws + WS_SIN), 1.0f / 4096.0f, (float*)(F.ws + WS_SVSTAT)};
        pg8::gemm_phase<pg8::EpiProj, pg8::StaticOrder, true, true, true>(F.lds, g, S, E);
        SEAM(2);
    }
    STAMP(3);
    if (IN(3)) { p2a(F); SEAM(3); }
    STAMP(4);
    if (IN(4)) { p2b(F); SEAM(4); }
    STAMP(5);
    if (IN(5)) { p2c(F); SEAM(5); }
    STAMP(6);
    if (IN(6)) {
        pg8::StaticOrder S; S.init(MT, DM, F.G, F.bid);
        pg8::Gemm g{(const bf16*)(F.ws + WS_YG8), (const bf16*)(F.ws + WS_WRET), MT, DM, 1024, 512, (const bf16*)(F.ws + WS_YS8), (const bf16*)(F.ws + WS_WSGU), 8};
        pg8::EpiMerged E{F.ws + WS_GA, F.ws + WS_GB, F.ws + WS_MRG8, 1.0f / 4096.0f};
        pg8::gemm_phase<pg8::EpiMerged, pg8::StaticOrder, true, true, true>(F.lds, g, S, E);
        SEAM(6);
    }
    STAMP(7);
    if (IN(7)) {
        pg8::Gemm g{(const bf16*)(F.ws + WS_MRG8), (const bf16*)(F.ws + WS_WOUT), MT, DM, 512}; pg8::StaticOrder S; S.init(MT, DM, F.G, F.bid);
        pg8::EpiX1 E{F.x, mod + 2048, (bf16*)(F.ws + WS_X1B), 1.0f / 4096.0f};
        pg8::gemm_phase<pg8::EpiX1, pg8::StaticOrder, true, true, true>(F.lds, g, S, E);
        SEAM(7);
    }
    STAMP(8);
    if (IN(8)) { norm_rows<1>(F, (const float*)(F.ws + WS_X1B), F.norm2_g, mod + 3072, mod + 4096, (bf16*)(F.ws + WS_SV), F.ws + WS_H2F8); SEAM(8); }
    STAMP(9);
    if (IN(9)) {
        pg8::Gemm g{(const bf16*)(F.ws + WS_SV), (const bf16*)(F.ws + WS_WQ), MT, 2048, DM}; pg8::StaticOrder S; S.init(MT, 2048, F.G, F.bid);
        pg8::EpiPlain E{(bf16*)(F.ws + WS_GA), 2048};
        pg8::gemm_phase<pg8::EpiPlain, pg8::StaticOrder, true, true>(F.lds, g, S, E);
        SEAM(9);
    }
    STAMP(10);
    if (IN(10)) { p5b(F); SEAM(10); }
    STAMP(11);
    if (IN(11)) { p6a(F); SEAM(11); }
    STAMP(12);
    if (IN(12)) { p6b(F); SEAM(12); }
    STAMP(13);
    if (IN(13)) { p6b2(F); SEAM(13); }
    STAMP(14);
    if (IN(14)) { p6c(F); SEAM(14); }
    STAMP(15);
    if (IN(15)) { p6d(F); }
    STAMP(16);
#if MK_PROBE_HI > 0
    __syncthreads();
    if (F.bid == 0 && F.tid == 0) { const unsigned long long t0 = ((unsigned long long)MISC[17 + 2 * MK_PROBE_LO] << 32) | MISC[16 + 2 * MK_PROBE_LO], t1 = ((unsigned long long)MISC[17 + 2 * MK_PROBE_HI] << 32) | MISC[16 + 2 * MK_PROBE_HI];
#if MK_GPROBE == 1
        ((float*)F.dout)[0] += (float)MISC[56] * 1e-3f; }
#elif MK_GPROBE == 2
        ((float*)F.dout)[0] += (float)MISC[57] * 1e-3f; }
#else
        ((float*)F.dout)[0] += (float)(t1 - t0) * 1e-3f; }
#endif
#endif
#undef IN
#undef SEAM
}

extern "C" void kernel_launch(void* const* d_in, const int* in_sizes, int n_in, void* d_out, int out_size, void* d_ws, size_t ws_size, hipStream_t stream) {
    static int grid = 0;
    if (grid == 0) {
        if (n_in != 20 || out_size != MT * DM || ws_size < WS_END) { fprintf(stderr, "kernel_launch: unexpected shapes (n_in %d, out %d, ws %zu); nothing launched\n", n_in, out_size, ws_size); grid = -1; return; }
        int dev = 0, cus = 0, per_cu = 0;
        if (hipGetDevice(&dev) != hipSuccess || hipDeviceGetAttribute(&cus, hipDeviceAttributeMultiprocessorCount, dev) != hipSuccess) { grid = -1; return; }
        if (hipFuncSetAttribute((const void*)mk_fwd, hipFuncAttributeMaxDynamicSharedMemorySize, LDS_BYTES) != hipSuccess) { fprintf(stderr, "kernel_launch: hipFuncSetAttribute failed\n"); grid = -1; return; }
        if (hipOccupancyMaxActiveBlocksPerMultiprocessor(&per_cu, (const void*)mk_fwd, NWAVES * 64, LDS_BYTES) != hipSuccess || per_cu < 1)
            fprintf(stderr, "kernel_launch: note: occupancy query reports %d workgroups per CU\n", per_cu);
        (void)hipGetLastError();
        grid = cus;
    }
    if (grid < 0) return;
    if (hipMemsetAsync((char*)d_ws + WS_CTL, 0, CTL_ZERO_BYTES, stream) != hipSuccess) { fprintf(stderr, "kernel_launch: memset failed\n"); return; }
    Args a{};
    for (int i = 0; i < 20; ++i) a.in[i] = (const float*)d_in[i];
    a.out = (float*)d_out; a.ws = (unsigned char*)d_ws;
    static_assert(N_LAUNCHES == 1 || N_LAUNCHES == N_PHASES, "N_LAUNCHES is 1 or N_PHASES");
    for (int li = 0; li < N_LAUNCHES && li < MK_MAXPH; ++li) {
        a.ph_lo = (N_LAUNCHES == 1) ? 0 : li; a.ph_hi = (N_LAUNCHES == 1) ? N_PHASES : li + 1; a.li = li;
        hipLaunchKernelGGL(mk_fwd, dim3(grid), dim3(NWAVES * 64), LDS_BYTES, stream, a);
        const hipError_t le = hipPeekAtLastError();
        if (le != hipSuccess) { fprintf(stderr, "kernel_launch: launch %d failed: %s\n", li, hipGetErrorName(le)); break; }
    }
}
```

```cpp
#include <hip/hip_runtime.h>
#include <cstdio>
#include <cstdint>

#ifndef MK_PROBE_LO
#define MK_PROBE_LO 0
#define MK_PROBE_HI 0
#endif
#ifndef MK_GPROBE
#define MK_GPROBE 0
#endif
#define MK_MISC_OFF (147456 - 256)
#ifndef MK_U4
#define MK_U4 1
#endif
#ifndef MK_ALAY
#define MK_ALAY 2
#endif
#ifndef MK_MAXPH
#define MK_MAXPH 16
#endif
#ifndef MK_N_LAUNCHES
#define MK_N_LAUNCHES 1
#endif
namespace pg8 {
#define PG8_LAS __attribute__((address_space(3)))
typedef unsigned short bf16_t;
typedef short bf16x8 __attribute__((ext_vector_type(8)));
typedef float f32x4 __attribute__((ext_vector_type(4)));
typedef unsigned u32x4 __attribute__((ext_vector_type(4)));
constexpr int BM = 256, BK = 64, HALF = 128, HTB = HALF * BK * 2  , STAGE_BYTES = 8 * HTB, NXCD = 8, WGM = 2;

__host__ __device__ __forceinline__ int lds_byte(int r, int c) { const int st = (r >> 4) * 2 + (c >> 5), rr = r & 15, cc = c & 31, ob = rr * 64 + cc * 2; return st * 1024 + (ob ^ (((ob >> 9) & 1) << 5)); }
__host__ __device__ __forceinline__ void stage_rc(int b, int& R, int& C) { const int st = b / 1024, sb = b % 1024, swz = sb ^ (((sb >> 9) & 1) << 5); R = (st >> 1) * 16 + swz / 64; C = (st & 1) * 32 + (swz % 64) / 2; }
__host__ __device__ __forceinline__ int perm32(int rho) { const int n = rho >> 4, i = rho & 15; return 8 * (i >> 2) + 4 * n + (i & 3); }

struct Unit { int pm, pn; };
struct Gemm { const bf16_t* A; const bf16_t* Bt; int M, N, K; int ld = 0; const bf16_t* A2 = nullptr; const bf16_t* Bt2 = nullptr; int ksplit = 0; };

struct StaticOrder {
    int nM, nN, nwg, G, c;
    __host__ __device__ void init(int M, int N, int G_, int c_) { nM = M / BM; nN = N / BM; nwg = nM * nN; G = G_; c = c_; }
    __host__ __device__ bool next(int i, Unit& u) const {
        const long L = (long)i * G + c; if (L >= nwg) return false;
        int wgid = (int)L; { const int q = nwg / NXCD, r = nwg % NXCD, xcd = wgid % NXCD, off = wgid / NXCD; wgid = (xcd < r ? xcd * (q + 1) : r * (q + 1) + (xcd - r) * q) + off; }
        const int nig = WGM * nN, gid = wgid / nig, fm = gid * WGM, gsz = (nM - fm) < WGM ? (nM - fm) : WGM;
        u.pm = fm + ((wgid % nig) % gsz); u.pn = (wgid % nig) / gsz; return true;
    }
    __device__ __forceinline__ void a_ready(const Unit&) const {}
    __device__ __forceinline__ void done(const Unit&) const {}
};

__device__ __forceinline__ unsigned cvt_pk_bf16(float lo, float hi) { unsigned r; asm volatile("v_cvt_pk_bf16_f32 %0, %1, %2" : "=v"(r) : "v"(lo), "v"(hi)); return r; }
typedef float f32x2 __attribute__((ext_vector_type(2)));
__device__ __forceinline__ f32x2 gelu_pk(f32x2 v) {
    const f32x2 av = __builtin_elementwise_abs(v), d = av * 0.2316418882f + 1.0f;
    f32x2 t; t.x = __builtin_amdgcn_rcpf(d.x); t.y = __builtin_amdgcn_rcpf(d.y);
    f32x2 q = t * 0.5307027145f + (-0.7265760135f); q = q * t + 0.7107068705f; q = q * t + (-0.142248368f); q = q * t + 0.127414796f; q = q * t;
    const f32x2 s = (v * v) * (-0.72134752044f);
    f32x2 e; e.x = __builtin_amdgcn_exp2f(s.x); e.y = __builtin_amdgcn_exp2f(s.y);
    const f32x2 m = v * (q * e), r = v - m;
    f32x2 o; o.x = v.x < 0.f ? m.x : r.x; o.y = v.y < 0.f ? m.y : r.y; return o;
}


typedef unsigned u32x2 __attribute__((ext_vector_type(2)));
__device__ __forceinline__ float bflo(unsigned w) { return __uint_as_float(w << 16); }
__device__ __forceinline__ float bfhi(unsigned w) { return __uint_as_float(w & 0xffff0000u); }
typedef float f32x2q __attribute__((ext_vector_type(2)));
__device__ __forceinline__ f32x4 f8x4(unsigned w) { const f32x2q lo = __builtin_amdgcn_cvt_pk_f32_fp8((int)w, false), hi = __builtin_amdgcn_cvt_pk_f32_fp8((int)w, true); return (f32x4){lo[0], lo[1], hi[0], hi[1]}; }
__device__ __forceinline__ float gelu1(float v) {
    const float av = __builtin_fabsf(v), t = __builtin_amdgcn_rcpf(av * 0.2316418882f + 1.0f);
    float q = t * 0.5307027145f + (-0.7265760135f); q = q * t + 0.7107068705f; q = q * t + (-0.142248368f); q = q * t + 0.127414796f; q = q * t;
    const float e = __builtin_amdgcn_exp2f((v * v) * (-0.72134752044f));
    const float m = v * (q * e);
    return v < 0.f ? m : v - m;
}
__device__ __forceinline__ float sigm1(float v) { return __builtin_amdgcn_rcpf(1.0f + __builtin_amdgcn_exp2f(v * (-1.44269504089f))); }
__device__ __forceinline__ float silu1(float v) { return v * sigm1(v); }

__device__ __forceinline__ unsigned bperm(int idx, unsigned v) { return (unsigned)__builtin_amdgcn_ds_bpermute(idx, (int)v); }
__device__ __forceinline__ float bpermf(int idx, float v) { return __int_as_float(__builtin_amdgcn_ds_bpermute(idx, __float_as_int(v))); }
__device__ __forceinline__ f32x4 bperm4(int idx, const f32x4& v) { return (f32x4){bpermf(idx, v[0]), bpermf(idx, v[1]), bpermf(idx, v[2]), bpermf(idx, v[3])}; }
__device__ __forceinline__ u32x4 bperm4u(int idx, const u32x4& v) { u32x4 r; r.x = bperm(idx, v.x); r.y = bperm(idx, v.y); r.z = bperm(idx, v.z); r.w = bperm(idx, v.w); return r; }
#define PG8_REMAP() const int lane_ = 16 * fq + fr, pidx = (16 * (lane_ & 3) + (lane_ >> 2)) * 4, fr2 = lane_ >> 2, fq2 = lane_ & 3

struct EpiProj {
    static constexpr bool PERM = true, AFTER_DRAIN = false, HAS_MID = false;
    bf16_t *Q, *Kb, *V, *G, *U, *SV, *GA, *GB; const float *cosT, *sinT; float osc; float* svstat;
    __device__ __forceinline__ void operator()(const f32x4 (&acc)[2][2][4][2], const Unit& u, int wr, int wc, int fr, int fq) const {
        PG8_REMAP();
        const int colt = u.pn * BM; const int row0 = u.pm * BM + wr * 64 + fr2;
        if (colt < 1024) {
            const bool isk = colt >= 512; bf16_t* base = isk ? Kb : Q; const int lc0 = (colt & 511) + wc * 32 + 8 * fq2; const float sc = (isk ? 0.08838834764831845f * 128.0f : 16.0f) * osc;
            const int fi = wc * 16 + 4 * fq2;
#pragma unroll
            for (int ai = 0; ai < 2; ++ai) {
                f32x4 csv[4], snv[4];
#pragma unroll
                for (int m = 0; m < 4; ++m) { const int s = (row0 + ai * HALF + m * 16) & 4095; csv[m] = *(const f32x4*)(cosT + s * 64 + fi) * sc; snv[m] = *(const f32x4*)(sinT + s * 64 + fi) * sc; }
#pragma unroll
                for (int m = 0; m < 4; ++m) { const int row = row0 + ai * HALF + m * 16; const f32x4 cs = csv[m], sn = snv[m];
#pragma unroll
                    for (int bj = 0; bj < 2; ++bj) { const f32x4 v0 = bperm4(pidx, acc[ai][bj][m][0]), v1 = bperm4(pidx, acc[ai][bj][m][1]);
                        int t0 = __builtin_amdgcn_cvt_pk_fp8_f32(v0[0] * cs[0] - v0[1] * sn[0], v0[0] * sn[0] + v0[1] * cs[0], 0, false); t0 = __builtin_amdgcn_cvt_pk_fp8_f32(v0[2] * cs[1] - v0[3] * sn[1], v0[2] * sn[1] + v0[3] * cs[1], t0, true);
                        int t1 = __builtin_amdgcn_cvt_pk_fp8_f32(v1[0] * cs[2] - v1[1] * sn[2], v1[0] * sn[2] + v1[1] * cs[2], 0, false); t1 = __builtin_amdgcn_cvt_pk_fp8_f32(v1[2] * cs[3] - v1[3] * sn[3], v1[2] * sn[3] + v1[3] * cs[3], t1, true);
                        u32x2 w8; w8.x = (unsigned)t0; w8.y = (unsigned)t1;
                        *(u32x2*)((unsigned char*)base + (size_t)row * 512 + lc0 + bj * HALF) = w8; } } }
        } else {
            const int seg = (colt - 1024) >> 10;
            bf16_t* base = seg == 0 ? V : seg == 1 ? G : seg == 2 ? U : seg == 3 ? SV : seg == 4 ? GA : GB;
            const int lc0 = ((colt - 1024) & 1023) + wc * 32 + 8 * fq2;
#pragma unroll
            for (int ai = 0; ai < 2; ++ai)
#pragma unroll
                for (int m = 0; m < 4; ++m) { const int row = row0 + ai * HALF + m * 16; float s1[2] = {0.f, 0.f}, s2[2] = {0.f, 0.f};
#pragma unroll
                    for (int bj = 0; bj < 2; ++bj) { f32x4 v0 = acc[ai][bj][m][0] * osc, v1 = acc[ai][bj][m][1] * osc;
                        if (seg == 1) {
#pragma unroll
                            for (int e = 0; e < 4; ++e) { v0[e] = silu1(v0[e]); v1[e] = silu1(v1[e]); }
                        } else if (seg == 2 || seg == 3) {
                            f32x2 a = gelu_pk((f32x2){v0[0], v0[1]}), b = gelu_pk((f32x2){v0[2], v0[3]}), c = gelu_pk((f32x2){v1[0], v1[1]}), d = gelu_pk((f32x2){v1[2], v1[3]});
                            v0 = (f32x4){a.x, a.y, b.x, b.y}; v1 = (f32x4){c.x, c.y, d.x, d.y};
                        } else if (seg >= 4) {
#pragma unroll
                            for (int e = 0; e < 4; ++e) { v0[e] = sigm1(v0[e]); v1[e] = sigm1(v1[e]); }
                        }
                        if (seg == 3) { s1[bj] = ((v0[0] + v0[1]) + (v0[2] + v0[3])) + ((v1[0] + v1[1]) + (v1[2] + v1[3]));
                            s2[bj] = ((v0[0] * v0[0] + v0[1] * v0[1]) + (v0[2] * v0[2] + v0[3] * v0[3])) + ((v1[0] * v1[0] + v1[1] * v1[1]) + (v1[2] * v1[2] + v1[3] * v1[3])); }
                        { const float fs = seg >= 4 ? 256.0f : 16.0f;
                            int t0 = __builtin_amdgcn_cvt_pk_fp8_f32(v0[0] * fs, v0[1] * fs, 0, false); t0 = __builtin_amdgcn_cvt_pk_fp8_f32(v0[2] * fs, v0[3] * fs, t0, true);
                            int t1 = __builtin_amdgcn_cvt_pk_fp8_f32(v1[0] * fs, v1[1] * fs, 0, false); t1 = __builtin_amdgcn_cvt_pk_fp8_f32(v1[2] * fs, v1[3] * fs, t1, true);
                            u32x2 w8; w8.x = bperm(pidx, (unsigned)t0); w8.y = bperm(pidx, (unsigned)t1);
                            *(u32x2*)((unsigned char*)base + (size_t)row * 1024 + lc0 + bj * HALF) = w8; } }
                    if (seg == 3) {
                        float a = s1[0] + s1[1], b = s2[0] + s2[1];
                        a += __shfl_xor(a, 16); b += __shfl_xor(b, 16); a += __shfl_xor(a, 32); b += __shfl_xor(b, 32);
                        if (fq == 0) { float* sp = svstat + (size_t)(u.pm * BM + wr * 64 + fr + ai * HALF + m * 16) * 2; atomicAdd(sp, a); atomicAdd(sp + 1, b); } } }
        }
    }
};
template <bool ACCUM> struct EpiGate {
    static constexpr bool PERM = true, AFTER_DRAIN = false, HAS_MID = false;
    const bf16_t* GT; bf16_t* TMP; unsigned char* OUT8; float osc;
    __device__ __forceinline__ void operator()(const f32x4 (&acc)[2][2][4][2], const Unit& u, int wr, int wc, int fr, int fq) const {
        PG8_REMAP();
        const int row0 = u.pm * BM + wr * 64 + fr2, col0 = u.pn * BM + wc * 32 + 8 * fq2;
#pragma unroll
        for (int ai = 0; ai < 2; ++ai)
#pragma unroll
            for (int mp = 0; mp < 2; ++mp) {
                u32x4 gv[2][2], pv[2][2];
#pragma unroll
                for (int mm = 0; mm < 2; ++mm)
#pragma unroll
                    for (int bj = 0; bj < 2; ++bj) { const size_t off = (size_t)(row0 + ai * HALF + (2 * mp + mm) * 16) * 1024 + col0 + bj * HALF;
                        gv[mm][bj] = *(const u32x4*)(GT + off); if (ACCUM) pv[mm][bj] = *(const u32x4*)(TMP + off); }
#pragma unroll
                for (int mm = 0; mm < 2; ++mm)
#pragma unroll
                    for (int bj = 0; bj < 2; ++bj) { const int m = 2 * mp + mm; const size_t off = (size_t)(row0 + ai * HALF + m * 16) * 1024 + col0 + bj * HALF;
                        const f32x4 v0 = bperm4(pidx, acc[ai][bj][m][0]) * osc, v1 = bperm4(pidx, acc[ai][bj][m][1]) * osc; const u32x4 g = gv[mm][bj];
                        float o[8] = {v0[0] * bflo(g.x), v0[1] * bfhi(g.x), v0[2] * bflo(g.y), v0[3] * bfhi(g.y), v1[0] * bflo(g.z), v1[1] * bfhi(g.z), v1[2] * bflo(g.w), v1[3] * bfhi(g.w)};
                        if (ACCUM) { const u32x4 p = pv[mm][bj];
                            o[0] += bflo(p.x); o[1] += bfhi(p.x); o[2] += bflo(p.y); o[3] += bfhi(p.y); o[4] += bflo(p.z); o[5] += bfhi(p.z); o[6] += bflo(p.w); o[7] += bfhi(p.w);
                            u32x2 w8; int t0 = __builtin_amdgcn_cvt_pk_fp8_f32(o[0] * 8.f, o[1] * 8.f, 0, false); t0 = __builtin_amdgcn_cvt_pk_fp8_f32(o[2] * 8.f, o[3] * 8.f, t0, true);
                            int t1 = __builtin_amdgcn_cvt_pk_fp8_f32(o[4] * 8.f, o[5] * 8.f, 0, false); t1 = __builtin_amdgcn_cvt_pk_fp8_f32(o[6] * 8.f, o[7] * 8.f, t1, true);
                            w8.x = (unsigned)t0; w8.y = (unsigned)t1; *(u32x2*)(OUT8 + off) = w8;
                        } else {
                            u32x4 w; w.x = cvt_pk_bf16(o[0], o[1]); w.y = cvt_pk_bf16(o[2], o[3]); w.z = cvt_pk_bf16(o[4], o[5]); w.w = cvt_pk_bf16(o[6], o[7]);
                            *(u32x4*)(TMP + off) = w; } }
            }
    }
};
struct EpiMerged {
    static constexpr bool PERM = true, AFTER_DRAIN = false, HAS_MID = true;
    const unsigned char* GA; const unsigned char* GB; unsigned char* OUT8; float osc;
    __device__ __forceinline__ void mid(f32x4 (&acc)[2][2][4][2], const Unit& u, int wr, int wc, int fr, int fq) const {
        int fr_ = fr, fq_ = fq; asm volatile("" : "+v"(fr_), "+v"(fq_));
        const int row0 = u.pm * BM + wr * 64 + fr_, col0 = u.pn * BM + wc * 32 + 8 * fq_;
#pragma unroll
        for (int ai = 0; ai < 2; ++ai)
#pragma unroll
            for (int mp = 0; mp < 2; ++mp) {
                u32x2 av[2][2], bv[2][2];
#pragma unroll
                for (int mm = 0; mm < 2; ++mm)
#pragma unroll
                    for (int bj = 0; bj < 2; ++bj) { const size_t off = (size_t)(row0 + ai * HALF + (2 * mp + mm) * 16) * 1024 + col0 + bj * HALF; av[mm][bj] = *(const u32x2*)(GA + off); bv[mm][bj] = *(const u32x2*)(GB + off); }
#pragma unroll
                for (int mm = 0; mm < 2; ++mm)
#pragma unroll
                    for (int bj = 0; bj < 2; ++bj) { const int m = 2 * mp + mm; const f32x4 a0 = f8x4(av[mm][bj].x), a1 = f8x4(av[mm][bj].y), b0 = f8x4(bv[mm][bj].x), b1 = f8x4(bv[mm][bj].y);
#pragma unroll
                        for (int e = 0; e < 4; ++e) { acc[ai][bj][m][0][e] *= 2.f * a0[e] * __builtin_amdgcn_rcpf(__builtin_fmaxf(b0[e], 0.001953125f)); acc[ai][bj][m][1][e] *= 2.f * a1[e] * __builtin_amdgcn_rcpf(__builtin_fmaxf(b1[e], 0.001953125f)); } }
            }
    }
    __device__ __forceinline__ void operator()(const f32x4 (&acc)[2][2][4][2], const Unit& u, int wr, int wc, int fr, int fq) const {
        PG8_REMAP();
        const int row0 = u.pm * BM + wr * 64 + fr2, col0 = u.pn * BM + wc * 32 + 8 * fq2; const float sc = osc * 8.f * (1.0f / 256.0f);
#pragma unroll
        for (int ai = 0; ai < 2; ++ai)
#pragma unroll
            for (int mp = 0; mp < 2; ++mp) {
                u32x2 gv[2][2];
#pragma unroll
                for (int mm = 0; mm < 2; ++mm)
#pragma unroll
                    for (int bj = 0; bj < 2; ++bj) gv[mm][bj] = *(const u32x2*)(GB + (size_t)(row0 + ai * HALF + (2 * mp + mm) * 16) * 1024 + col0 + bj * HALF);
#pragma unroll
                for (int mm = 0; mm < 2; ++mm)
#pragma unroll
                    for (int bj = 0; bj < 2; ++bj) { const int m = 2 * mp + mm; const size_t off = (size_t)(row0 + ai * HALF + m * 16) * 1024 + col0 + bj * HALF;
                        const f32x4 v0 = bperm4(pidx, acc[ai][bj][m][0]) * sc * f8x4(gv[mm][bj].x), v1 = bperm4(pidx, acc[ai][bj][m][1]) * sc * f8x4(gv[mm][bj].y);
                        u32x2 w8; int t0 = __builtin_amdgcn_cvt_pk_fp8_f32(v0[0], v0[1], 0, false); t0 = __builtin_amdgcn_cvt_pk_fp8_f32(v0[2], v0[3], t0, true);
                        int t1 = __builtin_amdgcn_cvt_pk_fp8_f32(v1[0], v1[1], 0, false); t1 = __builtin_amdgcn_cvt_pk_fp8_f32(v1[2], v1[3], t1, true);
                        w8.x = (unsigned)t0; w8.y = (unsigned)t1; *(u32x2*)(OUT8 + off) = w8; }
            }
    }
};
struct EpiX1 {
    static constexpr bool PERM = false, AFTER_DRAIN = false, HAS_MID = false;
    const float* X; const float* gate1; bf16_t* X1; float osc;
    __device__ __forceinline__ void operator()(const f32x4 (&acc)[2][2][4][2], const Unit& u, int wr, int wc, int fr, int fq) const {
        PG8_REMAP();
        const int row0 = u.pm * BM + wr * 64 + fr2, col0 = u.pn * BM + wc * 32 + 4 * fq2;
        const float* gp = gate1 + (size_t)((u.pm * BM) >> 12) * 6144 + col0;
        f32x4 gv[2][2];
#pragma unroll
        for (int bj = 0; bj < 2; ++bj)
#pragma unroll
            for (int n = 0; n < 2; ++n) gv[bj][n] = *(const f32x4*)(gp + bj * HALF + n * 16) * osc;
#pragma unroll
        for (int ai = 0; ai < 2; ++ai)
#pragma unroll
            for (int mp = 0; mp < 2; ++mp) {
                f32x4 xv[2][2][2];
#pragma unroll
                for (int mm = 0; mm < 2; ++mm) { const size_t off = (size_t)(row0 + ai * HALF + (2 * mp + mm) * 16) * 1024 + col0;
#pragma unroll
                    for (int bj = 0; bj < 2; ++bj)
#pragma unroll
                        for (int n = 0; n < 2; ++n) xv[mm][bj][n] = *(const f32x4*)(X + off + bj * HALF + n * 16); }
#pragma unroll
                for (int mm = 0; mm < 2; ++mm) { const int m = 2 * mp + mm; const size_t off = (size_t)(row0 + ai * HALF + m * 16) * 1024 + col0;
#pragma unroll
                    for (int bj = 0; bj < 2; ++bj)
#pragma unroll
                        for (int n = 0; n < 2; ++n) { const f32x4 x1 = xv[mm][bj][n] + gv[bj][n] * bperm4(pidx, acc[ai][bj][m][n]); u32x2 w; w.x = cvt_pk_bf16(x1[0], x1[1]); w.y = cvt_pk_bf16(x1[2], x1[3]); *(u32x2*)(X1 + off + bj * HALF + n * 16) = w; } }
            }
    }
};
struct EpiPlain {
    static constexpr bool PERM = true, AFTER_DRAIN = false, HAS_MID = false;
    bf16_t* O; int ldc;
    __device__ __forceinline__ void operator()(const f32x4 (&acc)[2][2][4][2], const Unit& u, int wr, int wc, int fr, int fq) const {
        PG8_REMAP();
        const int row0 = u.pm * BM + wr * 64 + fr2, col0 = u.pn * BM + wc * 32 + 8 * fq2;
#pragma unroll
        for (int ai = 0; ai < 2; ++ai)
#pragma unroll
            for (int m = 0; m < 4; ++m) { bf16_t* rowp = O + (size_t)(row0 + ai * HALF + m * 16) * ldc + col0;
#pragma unroll
                for (int bj = 0; bj < 2; ++bj) { const f32x4 v0 = acc[ai][bj][m][0], v1 = acc[ai][bj][m][1];
                    u32x4 w; w.x = cvt_pk_bf16(v0[0], v0[1]); w.y = cvt_pk_bf16(v0[2], v0[3]); w.z = cvt_pk_bf16(v1[0], v1[1]); w.w = cvt_pk_bf16(v1[2], v1[3]);
                    *(u32x4*)(rowp + bj * HALF) = bperm4u(pidx, w); } }
    }
};
typedef int v8i_t __attribute__((ext_vector_type(8)));
typedef int v4i_t __attribute__((ext_vector_type(4)));
template <bool F8> __device__ __forceinline__ void mma_block(f32x4 (&acc)[4][2], const bf16x8 (&At)[4][2], const bf16x8 (&Bt)[2][2]) {
    if constexpr (F8) {
        v8i_t bb[2];
#pragma unroll
        for (int n = 0; n < 2; ++n) bb[n] = __builtin_shufflevector(__builtin_bit_cast(v4i_t, Bt[n][0]), __builtin_bit_cast(v4i_t, Bt[n][1]), 0, 1, 2, 3, 4, 5, 6, 7);
#pragma unroll
        for (int m = 0; m < 4; ++m) { const v8i_t aa = __builtin_shufflevector(__builtin_bit_cast(v4i_t, At[m][0]), __builtin_bit_cast(v4i_t, At[m][1]), 0, 1, 2, 3, 4, 5, 6, 7);
#pragma unroll
            for (int n = 0; n < 2; ++n) asm volatile("v_mfma_scale_f32_16x16x128_f8f6f4 %0, %1, %2, %0, %3, %3 op_sel_hi:[0,0,0]" : "+v"(acc[m][n]) : "v"(bb[n]), "v"(aa), "v"(0x7F7F7F7F)); }
    } else {
#pragma unroll
        for (int m = 0; m < 4; ++m)
#pragma unroll
            for (int n = 0; n < 2; ++n)
#pragma unroll
                for (int k = 0; k < 2; ++k) acc[m][n] = __builtin_amdgcn_mfma_f32_16x16x32_bf16(Bt[n][k], At[m][k], acc[m][n], 0, 0, 0);
    }
}
template <class Epi, class Sched, bool ALIGN_EPI = false, bool SP2 = false, bool F8 = false>
__device__ __forceinline__ void gemm_phase(PG8_LAS unsigned char* lds, const Gemm g, const Sched& S, const Epi& E) {
    const int tid = threadIdx.x, wid = __builtin_amdgcn_readfirstlane(tid >> 6), lane = tid & 63, wr = wid >> 2, wc = wid & 3, fr = lane & 15, fq = lane >> 4;
    const int K = g.K, nt = K / BK, LD = g.ld ? g.ld : g.K, nh = g.ksplit ? g.ksplit : nt;
    unsigned voffA[2], voffB[2];
#pragma unroll
    for (int i = 0; i < 2; ++i) { int R, C; stage_rc(tid * 16 + i * 8192, R, C); const int Rb = Epi::PERM ? ((R & ~31) + perm32(R & 31)) : R;
        voffA[i] = (unsigned)(R * LD + C) * 2u; voffB[i] = (unsigned)(Rb * LD + C) * 2u; }
    const size_t kstep = (size_t)(BK * 2);
    const size_t hstep = (size_t)HALF * LD * 2;
    const size_t tstep = 2 * hstep;
    const unsigned ldsw = (unsigned)wid * 1024u;
    const int aoff = lds_byte(wr * 64 + fr, fq * 8), boff = lds_byte(wc * 32 + fr, fq * 8);
#define PG8_SA(b, h) (((b) * 2 + (h)) * HTB)
#define PG8_SB(b, h) ((4 + (b) * 2 + (h)) * HTB)
#define PG8_STAGE(bufoff, gbase, voff) do { _Pragma("unroll") for (int _i = 0; _i < 2; ++_i) \
        __builtin_amdgcn_global_load_lds((const unsigned*)((const char*)(gbase) + (voff)[_i]), (PG8_LAS unsigned*)(lds + (bufoff) + ldsw + _i * 8192), 16, 0, 0); } while (0)
#define PG8_LDA(dst, b, h) do { _Pragma("unroll") for (int m = 0; m < 4; ++m) _Pragma("unroll") for (int k = 0; k < 2; ++k) dst[m][k] = *(const PG8_LAS bf16x8*)(lds + PG8_SA(b, h) + aoff + m * 2048 + k * 1024); } while (0)
#define PG8_LDB(dst, b, h) do { _Pragma("unroll") for (int n = 0; n < 2; ++n) _Pragma("unroll") for (int k = 0; k < 2; ++k) dst[n][k] = *(const PG8_LAS bf16x8*)(lds + PG8_SB(b, h) + boff + n * 2048 + k * 1024); } while (0)
#define PG8_MMA(ai, bj, At, Bt) do { __builtin_amdgcn_s_setprio(1); mma_block<F8>(acc[ai][bj], At, Bt); __builtin_amdgcn_s_setprio(0); } while (0)
#define PG8_WAIT_V(n) asm volatile("s_waitcnt vmcnt(" #n ")" ::: "memory")
#define PG8_WAIT_L(n) asm volatile("s_waitcnt lgkmcnt(" #n ")" ::: "memory")
#define PG8_BAR __builtin_amdgcn_s_barrier()
#define PG8_SCHED __builtin_amdgcn_sched_barrier(0)
    Unit cur, nxt; int ui = 0;
#if MK_GPROBE
    unsigned long long gp_k = 0, gp_e = 0, gp_t = __builtin_amdgcn_s_memrealtime();
#endif
    if (!S.next(0, cur)) return;
    f32x4 acc[2][2][4][2];
#pragma unroll
    for (int a = 0; a < 2; ++a)
#pragma unroll
        for (int b = 0; b < 2; ++b)
#pragma unroll
            for (int m = 0; m < 4; ++m)
#pragma unroll
                for (int n = 0; n < 2; ++n) acc[a][b][m][n] = (f32x4){0.f, 0.f, 0.f, 0.f};
    bf16x8 At[4][2], B0[2][2], B1[2][2];
    const char* cA = (const char*)g.A + (size_t)cur.pm * tstep; const char* cB = (const char*)g.Bt + (size_t)cur.pn * tstep;
    const char* cA2 = g.A2 ? (const char*)g.A2 + (size_t)cur.pm * tstep : cA; const char* cB2 = g.Bt2 ? (const char*)g.Bt2 + (size_t)cur.pn * tstep : cB;
#define PG8_TA(tt) ((tt) < nh ? cA + (size_t)(tt) * kstep : cA2 + (size_t)((tt) - nh) * kstep)
#define PG8_TB(tt) ((tt) < nh ? cB + (size_t)(tt) * kstep : cB2 + (size_t)((tt) - nh) * kstep)
    S.a_ready(cur);
    if constexpr (SP2) {
        PG8_STAGE(PG8_SB(0, 0), cB, voffB); PG8_STAGE(PG8_SB(0, 1), cB + hstep, voffB); PG8_STAGE(PG8_SA(0, 0), cA, voffA); PG8_STAGE(PG8_SA(0, 1), cA + hstep, voffA);
        if (wr == 1) PG8_BAR;
        PG8_WAIT_V(2); PG8_BAR;
        PG8_STAGE(PG8_SB(1, 0), cB + kstep, voffB); PG8_STAGE(PG8_SA(1, 0), cA + kstep, voffA); PG8_STAGE(PG8_SB(1, 1), cB + hstep + kstep, voffB);
        PG8_WAIT_V(6); PG8_BAR;
    } else {
        PG8_STAGE(PG8_SB(0, 0), cB, voffB); PG8_STAGE(PG8_SA(0, 0), cA, voffA); PG8_STAGE(PG8_SB(0, 1), cB + hstep, voffB); PG8_STAGE(PG8_SA(0, 1), cA + hstep, voffA);
        if (wr == 1) PG8_BAR;
        PG8_WAIT_V(4); PG8_BAR;
        PG8_STAGE(PG8_SB(1, 0), cB + kstep, voffB); PG8_STAGE(PG8_SA(1, 0), cA + kstep, voffA); PG8_STAGE(PG8_SB(1, 1), cB + hstep + kstep, voffB);
        PG8_WAIT_V(6); PG8_BAR;
    }
    for (;;) {
        const bool has_next = S.next(ui + 1, nxt);
        const char* nA = has_next ? (const char*)g.A + (size_t)nxt.pm * tstep : cA; const char* nB = has_next ? (const char*)g.Bt + (size_t)nxt.pn * tstep : cB;
#pragma clang loop unroll(disable)
        for (int t = 0; t < nt; t += 2) {
            const bool last = (t == nt - 2);
            const char* a1 = PG8_TA(t + 1);
            const char* a2 = last ? nA : PG8_TA(t + 2); const char* b2 = last ? nB : PG8_TB(t + 2);
            const char* a3 = last ? nA + kstep : PG8_TA(t + 3); const char* b3 = last ? nB + kstep : PG8_TB(t + 3);
            if constexpr (Epi::HAS_MID) { if (t == nh) { if constexpr (F8) asm volatile("s_nop 15\n\ts_nop 15" ::: "memory"); E.mid(acc, cur, wr, wc, fr, fq); } }
            if (last && has_next) S.a_ready(nxt);
            if constexpr (SP2) {
            PG8_LDB(B0, 0, 0); PG8_LDB(B1, 0, 1); PG8_SCHED; PG8_LDA(At, 0, 0); PG8_STAGE(PG8_SA(1, 1), a1 + hstep, voffA);
            PG8_WAIT_V(8); PG8_WAIT_L(0); PG8_BAR; PG8_MMA(0, 0, At, B0); PG8_MMA(0, 1, At, B1); PG8_BAR; PG8_SCHED;
            PG8_LDA(At, 0, 1); PG8_STAGE(PG8_SB(0, 0), b2, voffB); PG8_STAGE(PG8_SB(0, 1), b2 + hstep, voffB); PG8_STAGE(PG8_SA(0, 0), a2, voffA);
            PG8_WAIT_V(8); PG8_WAIT_L(0); PG8_BAR; PG8_MMA(1, 0, At, B0); PG8_MMA(1, 1, At, B1); PG8_BAR; PG8_SCHED;
            PG8_LDB(B0, 1, 0); PG8_LDB(B1, 1, 1); PG8_SCHED; PG8_LDA(At, 1, 0); PG8_STAGE(PG8_SA(0, 1), a2 + hstep, voffA);
            PG8_WAIT_V(8); PG8_WAIT_L(0); PG8_BAR; PG8_MMA(0, 0, At, B0); PG8_MMA(0, 1, At, B1); PG8_BAR; PG8_SCHED;
            PG8_LDA(At, 1, 1); PG8_STAGE(PG8_SB(1, 0), b3, voffB); PG8_STAGE(PG8_SB(1, 1), b3 + hstep, voffB); PG8_STAGE(PG8_SA(1, 0), a3, voffA);
            PG8_WAIT_V(8); PG8_WAIT_L(0); PG8_BAR; PG8_MMA(1, 0, At, B0); PG8_MMA(1, 1, At, B1); PG8_BAR; PG8_SCHED;
            } else {
            PG8_LDB(B0, 0, 0); PG8_SCHED; PG8_LDA(At, 0, 0); PG8_STAGE(PG8_SA(1, 1), a1 + hstep, voffA);
            PG8_WAIT_L(8); PG8_BAR; PG8_WAIT_L(0); PG8_MMA(0, 0, At, B0); PG8_BAR; PG8_SCHED;
            PG8_LDB(B1, 0, 1); PG8_STAGE(PG8_SB(0, 0), b2, voffB);
            PG8_BAR; PG8_WAIT_L(0); PG8_MMA(0, 1, At, B1); PG8_BAR;
            PG8_LDA(At, 0, 1); PG8_STAGE(PG8_SA(0, 0), a2, voffA);
            PG8_BAR; PG8_WAIT_L(0); PG8_MMA(1, 0, At, B0); PG8_BAR; PG8_SCHED;
            PG8_STAGE(PG8_SB(0, 1), b2 + hstep, voffB);
            PG8_WAIT_V(6); PG8_BAR; PG8_MMA(1, 1, At, B1); PG8_BAR;
            PG8_LDB(B0, 1, 0); PG8_SCHED; PG8_LDA(At, 1, 0); PG8_STAGE(PG8_SA(0, 1), a2 + hstep, voffA);
            PG8_WAIT_L(8); PG8_BAR; PG8_WAIT_L(0); PG8_MMA(0, 0, At, B0); PG8_BAR; PG8_SCHED;
            PG8_LDB(B1, 1, 1); PG8_STAGE(PG8_SB(1, 0), b3, voffB);
            PG8_BAR; PG8_WAIT_L(0); PG8_MMA(0, 1, At, B1); PG8_BAR;
            PG8_LDA(At, 1, 1); PG8_STAGE(PG8_SA(1, 0), a3, voffA);
            PG8_BAR; PG8_WAIT_L(0); PG8_MMA(1, 0, At, B0); PG8_BAR; PG8_SCHED;
            PG8_STAGE(PG8_SB(1, 1), b3 + hstep, voffB);
            PG8_WAIT_V(6); PG8_BAR; PG8_MMA(1, 1, At, B1); PG8_BAR;
            }
        }
#if MK_GPROBE
        { const unsigned long long t_ = __builtin_amdgcn_s_memrealtime(); gp_k += t_ - gp_t; gp_t = t_; }
#endif
        if constexpr (F8) asm volatile("s_nop 15\n\ts_nop 15" ::: "memory");
        if constexpr (ALIGN_EPI) { if (wr == 0) PG8_BAR; }
        if constexpr (!Epi::AFTER_DRAIN) { E(acc, cur, wr, wc, fr, fq); S.done(cur); }
#if MK_GPROBE
        { asm volatile("s_waitcnt vmcnt(0)" ::: "memory"); const unsigned long long t_ = __builtin_amdgcn_s_memrealtime(); gp_e += t_ - gp_t; gp_t = t_; }
#endif
        if (!has_next) break;
#pragma unroll
        for (int a = 0; a < 2; ++a)
#pragma unroll
            for (int b = 0; b < 2; ++b)
#pragma unroll
                for (int m = 0; m < 4; ++m)
#pragma unroll
                    for (int n = 0; n < 2; ++n) acc[a][b][m][n] = (f32x4){0.f, 0.f, 0.f, 0.f};
        cur = nxt; cA = nA; cB = nB; ++ui;
        cA2 = g.A2 ? (const char*)g.A2 + (size_t)cur.pm * tstep : cA; cB2 = g.Bt2 ? (const char*)g.Bt2 + (size_t)cur.pn * tstep : cB;
        if constexpr (ALIGN_EPI) { if (wr == 1) PG8_BAR; }
    }
    PG8_WAIT_V(0);
    if constexpr (!ALIGN_EPI) { if (wr == 0) PG8_BAR; }
    PG8_BAR;
    if constexpr (Epi::AFTER_DRAIN) { E.fused(acc, cur, wr, wc, fr, fq, lds, wid, lane); S.done(cur); }
#if MK_GPROBE
    if (blockIdx.x == 0 && wid == 0 && lane == 0) { PG8_LAS unsigned* mq = (PG8_LAS unsigned*)(lds + MK_MISC_OFF); mq[56] += (unsigned)gp_k; mq[57] += (unsigned)gp_e; }
#endif
#undef PG8_SA
#undef PG8_SB
#undef PG8_TA
#undef PG8_TB
#undef PG8_STAGE
#undef PG8_LDA
#undef PG8_LDB
#undef PG8_MMA
#undef PG8_WAIT_V
#undef PG8_WAIT_L
#undef PG8_BAR
#undef PG8_SCHED
}
}

constexpr int NWAVES = 8;
constexpr int N_LAUNCHES = MK_N_LAUNCHES;
constexpr int N_PHASES = 16;
constexpr int NB = 8, SEQ = 4096, DM = 1024, MT = NB * SEQ, NIN = 7168;
constexpr float EPSN = 1e-6f;

constexpr size_t MiB = 1u << 20;
constexpr size_t WS_CTL = 0, CTL_ZERO_BYTES = 1 * MiB;
constexpr size_t WS_SVSTAT = 512 * 1024;
constexpr size_t WS_MOD = 1 * MiB;
constexpr size_t WS_COS = 2 * MiB, WS_SIN = 3 * MiB;
constexpr size_t WS_SK = 4 * MiB;
constexpr size_t WS_SGUW = 4 * MiB + 512 * 1024;
constexpr size_t WS_WRET = 6 * MiB, WS_WSGU = 8 * MiB, WS_WOUT = 10 * MiB, WS_WQ = 12 * MiB, WS_WIN = 16 * MiB;
constexpr size_t WS_UE8 = 32 * MiB, WS_VE8 = 48 * MiB;
constexpr size_t WS_YG8 = 288 * MiB;
constexpr size_t WS_YS8 = 480 * MiB;
constexpr size_t WS_MRG8 = 96 * MiB;
constexpr size_t WS_ACT = 288 * MiB;
constexpr size_t WS_PEERS = 352 * MiB;
constexpr size_t WS_H2F8 = 96 * MiB;
constexpr size_t WS_EID = 128 * MiB, WS_GW = 144 * MiB;
constexpr size_t WS_PD = 160 * MiB;
constexpr size_t WS_V = 96 * MiB;
constexpr size_t WS_G = 160 * MiB;
constexpr size_t WS_X1B = 224 * MiB;
constexpr size_t WS_U = 224 * MiB;
constexpr size_t WS_SV = 288 * MiB;
constexpr size_t WS_GA = 352 * MiB, WS_GB = 416 * MiB;
constexpr size_t WS_SUB = 480 * MiB;
constexpr size_t WS_END = 512 * MiB;
constexpr size_t DO_H = 0, DO_Q = 64 * MiB, DO_K = 96 * MiB, DO_KVS = 0;

constexpr int CW_BAR = 4096;
constexpr int LDS_BYTES = 147456;
constexpr int MISC_OFF = LDS_BYTES - 256;

#define GAS __attribute__((address_space(1)))
#define LAS __attribute__((address_space(3)))
typedef unsigned short bf16;
typedef unsigned v4u __attribute__((ext_vector_type(4)));
typedef unsigned v2u __attribute__((ext_vector_type(2)));
typedef float f32x4 __attribute__((ext_vector_type(4)));
typedef float f32x2v __attribute__((ext_vector_type(2)));
typedef short bf16x8 __attribute__((ext_vector_type(8)));
typedef short s16x4 __attribute__((ext_vector_type(4)));
typedef __bf16 bf16x2_t __attribute__((ext_vector_type(2)));
typedef GAS unsigned gu32;
#define RLX_AGENT __ATOMIC_RELAXED, __HIP_MEMORY_SCOPE_AGENT
#define LDS_WAIT() asm volatile("s_waitcnt lgkmcnt(0)" ::: "memory")
using pg8::bflo; using pg8::bfhi; using pg8::gelu1;
__device__ __forceinline__ unsigned pk2(float lo, float hi) { f32x2v v = {lo, hi}; bf16x2_t b = __builtin_convertvector(v, bf16x2_t); return __builtin_bit_cast(unsigned, b); }
template <int CTRL> __device__ __forceinline__ float dpp_f(float v) { return __int_as_float(__builtin_amdgcn_update_dpp(0, __float_as_int(v), CTRL, 0xF, 0xF, false)); }
__device__ __forceinline__ float wave_sum(float v) {
    v += dpp_f<0xB1>(v); v += dpp_f<0x4E>(v); v += dpp_f<0x141>(v); v += dpp_f<0x140>(v);
    const int vi = __float_as_int(v);
    return (__int_as_float(__builtin_amdgcn_readlane(vi, 0)) + __int_as_float(__builtin_amdgcn_readlane(vi, 16))) + (__int_as_float(__builtin_amdgcn_readlane(vi, 32)) + __int_as_float(__builtin_amdgcn_readlane(vi, 48)));
}
__device__ __forceinline__ float fexp2(float x) { return __builtin_amdgcn_exp2f(x); }
__device__ __forceinline__ float clamp_f8(float x) { return __builtin_amdgcn_fmed3f(x, -448.0f, 448.0f); }
__device__ __forceinline__ unsigned pk4_fp8(float a, float b, float c, float d) { int w = __builtin_amdgcn_cvt_pk_fp8_f32(clamp_f8(a), clamp_f8(b), 0, false); w = __builtin_amdgcn_cvt_pk_fp8_f32(clamp_f8(c), clamp_f8(d), w, true); return (unsigned)w; }
__device__ __forceinline__ float rl_f(float v, int l) { return __int_as_float(__builtin_amdgcn_readlane(__float_as_int(v), l)); }
__device__ __forceinline__ unsigned rl_u(unsigned v, int l) { return (unsigned)__builtin_amdgcn_readlane((int)v, l); }

#define XB_TMO      128
#define XB_XCNT(j)  (256  + 64 * (j))
#define XB_XSUB(j)  (1280 + 64 * (j))
#define XB_XGEN(j)  (2304 + 64 * (j))
#define XB_TOP      3328
#define XB_TOPGEN   3392
#define XCD_BAR_WORDS 3456
#define XB_SPIN_CAP (1u << 22)
__device__ __forceinline__ unsigned xb_ld(unsigned* p)              { return __hip_atomic_load(p, __ATOMIC_RELAXED, __HIP_MEMORY_SCOPE_AGENT); }
__device__ __forceinline__ unsigned xb_add(unsigned* p, unsigned v) { return __hip_atomic_fetch_add(p, v, __ATOMIC_RELAXED, __HIP_MEMORY_SCOPE_AGENT); }
__device__ __forceinline__ unsigned xb_xcc_id() { return (unsigned)__builtin_amdgcn_s_getreg((3 << 11) | 20) & 0xFu; }
#define XB_SPIN(cond, bar) do { unsigned _sp = 0; while (cond) { __builtin_amdgcn_s_sleep(1); \
    if ((++_sp & 255u) == 0u) { if (xb_ld(&(bar)[XB_TMO])) break; if (_sp > XB_SPIN_CAP) { atomicAdd(&(bar)[XB_TMO], 1u); break; } } } } while (0)
struct XcdBarrier { unsigned* bar; unsigned x; volatile LAS unsigned* st; };
__device__ __forceinline__ XcdBarrier xcd_barrier_post(unsigned* bar, volatile LAS unsigned* st) {
    XcdBarrier b; b.bar = bar; b.x = xb_xcc_id(); b.st = st;
    if (threadIdx.x == 0) (void)xb_add(&bar[XB_XCNT(b.x)], 1u);
    return b;
}
__device__ __forceinline__ void xcd_barrier_complete(unsigned* bar, unsigned x, unsigned& nloc, unsigned& nx) {
    const unsigned G = gridDim.x * gridDim.y * gridDim.z;
    unsigned sum, cnt, mine, sp = 0u;
    for (;;) {
        sum = 0u; cnt = 0u; mine = 0u;
#pragma unroll
        for (unsigned j = 0; j < 16; ++j) { const unsigned c = xb_ld(&bar[XB_XCNT(j)]); sum += c; cnt += (c > 0u) ? 1u : 0u; mine = (j == x) ? c : mine; }
        if (sum == G) break;
        __builtin_amdgcn_s_sleep(1);
        if ((++sp & 255u) == 0u) { if (xb_ld(&bar[XB_TMO])) break; if (sp > XB_SPIN_CAP) { atomicAdd(&bar[XB_TMO], 1u); break; } }
    }
    nloc = mine > 0u ? mine : 1u; nx = cnt > 0u ? cnt : 1u;
}
__device__ __forceinline__ void xcd_barrier(const XcdBarrier& b) {
    asm volatile("s_waitcnt vmcnt(0)" ::: "memory");
    __syncthreads();
    if (threadIdx.x == 0) {
        unsigned* bar = b.bar;
        __builtin_amdgcn_s_waitcnt(0);
        unsigned nloc = b.st[0], nx = b.st[1];
        if (nloc == 0u) { xcd_barrier_complete(bar, b.x, nloc, nx); b.st[0] = nloc; b.st[1] = nx; }
        const unsigned old = xb_add(&bar[XB_XSUB(b.x)], 1u);
        const unsigned gen = old / nloc;
        if (old + 1u == (gen + 1u) * nloc) {
            __builtin_amdgcn_fence(__ATOMIC_RELEASE, "agent");
            asm volatile("s_waitcnt vmcnt(0)" ::: "memory");
            const unsigned og = xb_add(&bar[XB_TOP], 1u);
            const unsigned tg = og / nx;
            if (og + 1u == (tg + 1u) * nx) xb_add(&bar[XB_TOPGEN], 1u);
            else XB_SPIN(xb_ld(&bar[XB_TOPGEN]) == tg, bar);
            __builtin_amdgcn_fence(__ATOMIC_ACQUIRE, "agent");
            xb_add(&bar[XB_XGEN(b.x)], 1u);
            asm volatile("s_waitcnt vmcnt(0)" ::: "memory");
        } else {
            XB_SPIN(xb_ld(&bar[XB_XGEN(b.x)]) == gen, bar);
            __builtin_amdgcn_fence(__ATOMIC_ACQUIRE, "agent");
            asm volatile("s_waitcnt vmcnt(0)" ::: "memory");
        }
    }
    __syncthreads();
}

struct Frame {
    LAS unsigned char* lds;
    int tid, lane, wave, G, bid; volatile LAS unsigned* misc;
    __device__ __forceinline__ void fence_ids() { int t = threadIdx.x; asm volatile("" : "+v"(t)); tid = t; lane = t & 63; }
    const float *x, *c, *w_ada, *b_ada, *norm1_g, *w_in, *ret_gn_g, *sgu_ln_g, *sgu_ln_b, *sgu_w, *sgu_b, *w_ret_out, *w_sgu_out, *w_out, *norm2_g, *peer_w_q, *peer_sub_keys, *peer_u, *peer_v, *final_g;
    unsigned char* ws; unsigned char* dout;
};

__device__ __forceinline__ bf16x8 lds_row_frag(LAS const unsigned char* img, int stride, int r0, int k0, int lane) {
    return *(LAS const bf16x8*)(img + (r0 + (lane & 15)) * stride + (k0 + 8 * (lane >> 4)) * 2);
}
__device__ __forceinline__ s16x4 tr16(LAS const unsigned char* p) { return __builtin_bit_cast(s16x4, __builtin_amdgcn_ds_read_tr16_b64_v4i16((LAS s16x4*)p)); }
__device__ __forceinline__ bf16x8 lds_tr_frag(LAS const unsigned char* img, int stride, int k0, int n0, int lane) {
    const int g = lane >> 4, q = (lane >> 2) & 3, p = lane & 3;
    LAS const unsigned char* a = img + (k0 + 8 * g + q) * stride + (n0 + 4 * p) * 2;
    const s16x4 lo = tr16(a), hi = tr16(a + 4 * stride);
    return __builtin_shufflevector(lo, hi, 0, 1, 2, 3, 4, 5, 6, 7);
}
#define MFMA16(a, b, c) __builtin_amdgcn_mfma_f32_16x16x32_bf16((a), (b), (c), 0, 0, 0)
constexpr int KS = 272, VS = 528;

template <bool F8, class Map>
__device__ __forceinline__ void transpose_item(const float* W, int K, int N, bf16* WT, LAS float* scr, int item, int lane, Map srcmap) {
    const int nblk = N / 32, kb = item / nblk, nb = item % nblk, k0 = 64 * kb, n0 = 32 * nb;
    const int sc = srcmap(n0 + (lane & 31));
#pragma unroll 8
    for (int i = 0; i < 32; ++i) { const int kk = 2 * i + (lane >> 5); scr[kk * 33 + (lane & 31)] = W[(size_t)(k0 + kk) * N + sc]; }
    LDS_WAIT(); asm volatile("" ::: "memory");
    const int c = lane & 7;
#pragma unroll
    for (int j = 0; j < 4; ++j) { const int n = (lane >> 3) + 8 * j; const LAS float* s = scr + (8 * c) * 33 + n;
        if (F8) { v2u o8; o8.x = pk4_fp8(s[0 * 33] * 512.f, s[1 * 33] * 512.f, s[2 * 33] * 512.f, s[3 * 33] * 512.f); o8.y = pk4_fp8(s[4 * 33] * 512.f, s[5 * 33] * 512.f, s[6 * 33] * 512.f, s[7 * 33] * 512.f);
            *(v2u*)((unsigned char*)WT + (size_t)(n0 + n) * K + k0 + 8 * c) = o8; }
        else { v4u o; o.x = pk2(s[0 * 33], s[1 * 33]); o.y = pk2(s[2 * 33], s[3 * 33]); o.z = pk2(s[4 * 33], s[5 * 33]); o.w = pk2(s[6 * 33], s[7 * 33]);
            *(v4u*)(WT + (size_t)(n0 + n) * K + k0 + 8 * c) = o; } }
    LDS_WAIT(); asm volatile("" ::: "memory");
}
struct MapId { __device__ __forceinline__ int operator()(int n) const { return n; } };
struct MapWin { __device__ __forceinline__ int operator()(int n) const { if (n >= 1024) return n; const int ci = n & 127; return (n & ~127) + (ci >> 1) + 64 * (ci & 1); } };

__device__ __forceinline__ void cvt8(const float* src, bf16* dst, size_t chunk) {
    const f32x4 a = *(const f32x4*)(src + chunk * 8), b = *(const f32x4*)(src + chunk * 8 + 4);
    v4u o; o.x = pk2(a[0], a[1]); o.y = pk2(a[2], a[3]); o.z = pk2(b[0], b[1]); o.w = pk2(b[2], b[3]);
    *(v4u*)(dst + chunk * 8) = o;
}

__device__ __forceinline__ void p0a(Frame& F) { F.fence_ids();
    if (F.bid < 192) {
        LAS float* sc = (LAS float*)F.lds; LAS float* part = (LAS float*)(F.lds + 32768);
        for (int i = F.tid; i < 8192; i += 512) { const float cv = F.c[i]; sc[i] = pg8::silu1(cv); }
        __syncthreads();
        const int n0 = 32 * F.bid, ks = F.tid >> 3, c4 = F.tid & 7;
        f32x4 acc[8];
#pragma unroll
        for (int b = 0; b < 8; ++b) acc[b] = (f32x4){0.f, 0.f, 0.f, 0.f};
        for (int kk = ks; kk < 1024; kk += 64) { const f32x4 w = *(const f32x4*)(F.w_ada + (size_t)kk * 6144 + n0 + 4 * c4);
#pragma unroll
            for (int b = 0; b < 8; ++b) acc[b] += w * sc[b * 1024 + kk]; }
#pragma unroll
        for (int b = 0; b < 8; ++b) *(LAS f32x4*)(part + (ks * 8 + b) * 32 + 4 * c4) = acc[b];
        __syncthreads();
        if (F.tid < 256) { const int b = F.tid >> 5, col = F.tid & 31; float s = 0.f;
            for (int k2 = 0; k2 < 64; ++k2) s += part[(k2 * 8 + b) * 32 + col];
            ((float*)(F.ws + WS_MOD))[b * 6144 + n0 + col] = s + F.b_ada[n0 + col]; }
        __syncthreads();
    }
    {
        LAS float* scr = (LAS float*)(F.lds + F.wave * 16384);
        const int gw = F.bid * NWAVES + F.wave, NGW = F.G * NWAVES;
        constexpr int I_IN = 16 * (NIN / 32), I_SQ = 16 * 32, I_Q = 16 * 64, NITEMS = I_IN + 3 * I_SQ + I_Q;
        for (int it = gw; it < NITEMS; it += NGW) {
            int r = it;
            if (r < I_IN) { transpose_item<true>(F.w_in, 1024, NIN, (bf16*)(F.ws + WS_WIN), scr, r, F.lane, MapWin()); continue; } r -= I_IN;
            if (r < I_SQ) { transpose_item<true>(F.w_ret_out, 1024, 1024, (bf16*)(F.ws + WS_WRET), scr, r, F.lane, MapId()); continue; } r -= I_SQ;
            if (r < I_SQ) { transpose_item<true>(F.w_sgu_out, 1024, 1024, (bf16*)(F.ws + WS_WSGU), scr, r, F.lane, MapId()); continue; } r -= I_SQ;
            if (r < I_SQ) { transpose_item<true>(F.w_out, 1024, 1024, (bf16*)(F.ws + WS_WOUT), scr, r, F.lane, MapId()); continue; } r -= I_SQ;
            transpose_item<false>(F.peer_w_q, 1024, 2048, (bf16*)(F.ws + WS_WQ), scr, r, F.lane, MapId());
        }
    }
    const size_t gt = (size_t)F.bid * 512 + F.tid, NT = (size_t)F.G * 512;
    for (size_t ch = gt; ch < (size_t)16384 * 64; ch += NT) {
        const f32x4* up = (const f32x4*)(F.peer_u + ch * 16); const f32x4* vp = (const f32x4*)(F.peer_v + ch * 16);
        v4u ou, ov;
#pragma unroll
        for (int q = 0; q < 4; ++q) { const f32x4 a = up[q] * 512.0f, b = vp[q] * 16.0f; ou[q] = pk4_fp8(a[0], a[1], a[2], a[3]); ov[q] = pk4_fp8(b[0], b[1], b[2], b[3]); }
        const size_t e_ = ch >> 6, c16_ = ch & 63, dst_ = (c16_ >> 3) * ((size_t)16384 * 128) + e_ * 128 + (c16_ & 7) * 16;
        *(v4u*)(F.ws + WS_VE8 + dst_) = ov;
        if (MK_U4) {
            v2u o4; unsigned w0 = 0u, w1 = 0u;
            { const f32x4 a0 = up[0] * 64.0f, a1 = up[1] * 64.0f, a2 = up[2] * 64.0f, a3 = up[3] * 64.0f;
              w0 = __builtin_amdgcn_cvt_scalef32_pk_fp4_f32(w0, a0[0], a0[1], 1.0f, 0); w0 = __builtin_amdgcn_cvt_scalef32_pk_fp4_f32(w0, a0[2], a0[3], 1.0f, 1);
              w0 = __builtin_amdgcn_cvt_scalef32_pk_fp4_f32(w0, a1[0], a1[1], 1.0f, 2); w0 = __builtin_amdgcn_cvt_scalef32_pk_fp4_f32(w0, a1[2], a1[3], 1.0f, 3);
              w1 = __builtin_amdgcn_cvt_scalef32_pk_fp4_f32(w1, a2[0], a2[1], 1.0f, 0); w1 = __builtin_amdgcn_cvt_scalef32_pk_fp4_f32(w1, a2[2], a2[3], 1.0f, 1);
              w1 = __builtin_amdgcn_cvt_scalef32_pk_fp4_f32(w1, a3[0], a3[1], 1.0f, 2); w1 = __builtin_amdgcn_cvt_scalef32_pk_fp4_f32(w1, a3[2], a3[3], 1.0f, 3); }
            o4.x = w0; o4.y = w1;
            *(v2u*)(F.ws + WS_UE8 + (c16_ >> 4) * ((size_t)16384 * 128) + e_ * 128 + (c16_ & 15) * 8) = o4;
        } else *(v4u*)(F.ws + WS_UE8 + dst_) = ou; }
    for (size_t ch = gt; ch < (size_t)32768; ch += NT) cvt8(F.peer_sub_keys, (bf16*)(F.ws + WS_SK), ch);
    for (size_t ch = gt; ch < (size_t)8192; ch += NT) { const int t = (int)(ch >> 4) & 127, s0 = (int)(ch & 15) * 8;
        const f32x4 a = *(const f32x4*)(F.sgu_w + ch * 8), b = *(const f32x4*)(F.sgu_w + ch * 8 + 4);
        float v[8] = {a[0], a[1], a[2], a[3], b[0], b[1], b[2], b[3]};
#pragma unroll
        for (int e = 0; e < 8; ++e) v[e] = (s0 + e <= t) ? v[e] : 0.f;
        v4u o; o.x = pk2(v[0], v[1]); o.y = pk2(v[2], v[3]); o.z = pk2(v[4], v[5]); o.w = pk2(v[6], v[7]);
        *(v4u*)((bf16*)(F.ws + WS_SGUW) + ch * 8) = o; }
    for (size_t e = gt; e < (size_t)4096 * 64; e += NT) { const int s = (int)(e >> 6), i = (int)(e & 63);
        const float inv = fexp2(-(float)i * (13.287712379549449f / 64.0f));
        const float rev = ((float)s * inv) * 0.15915494309189535f; const float fr = rev - __builtin_floorf(rev);
        ((float*)(F.ws + WS_COS))[e] = __builtin_amdgcn_cosf(fr); ((float*)(F.ws + WS_SIN))[e] = __builtin_amdgcn_sinf(fr); }
}

template <int MODE  > __device__ __forceinline__ void norm_rows(Frame& F, const float* X, const float* gain, const float* shift, const float* scale, bf16* O, unsigned char* O8) { F.fence_ids();
    const int gw = F.bid * NWAVES + F.wave, NGW = F.G * NWAVES;
    f32x4 g[4];
#pragma unroll
    for (int j = 0; j < 4; ++j) g[j] = *(const f32x4*)(gain + 4 * F.lane + 256 * j);
    f32x4 nx[4];
#define NR_LOAD(mm_) do { _Pragma("unroll") for (int j = 0; j < 4; ++j) { if (MODE == 1) { const v2u w_ = *((const v2u*)((const bf16*)X + (size_t)(mm_) * DM) + F.lane + 64 * j); nx[j] = (f32x4){bflo(w_.x), bfhi(w_.x), bflo(w_.y), bfhi(w_.y)}; } \
        else nx[j] = *((const f32x4*)(X + (size_t)(mm_) * DM) + F.lane + 64 * j); } } while (0)
    if (gw < MT) NR_LOAD(gw);
    for (int m = gw; m < MT; m += NGW) {
        f32x4 v[4]; float s = 0.f;
#pragma unroll
        for (int j = 0; j < 4; ++j) { v[j] = nx[j]; s += (v[j][0] * v[j][0] + v[j][1] * v[j][1]) + (v[j][2] * v[j][2] + v[j][3] * v[j][3]); }
        const int b = m >> 12;
        f32x4 sh[4], sc[4];
#pragma unroll
        for (int j = 0; j < 4; ++j) { const int d = 4 * F.lane + 256 * j; sh[j] = *(const f32x4*)(shift + b * 6144 + d); sc[j] = *(const f32x4*)(scale + b * 6144 + d); }
        if (m + NGW < MT) NR_LOAD(m + NGW);
        const float rstd = __builtin_amdgcn_rsqf(wave_sum(s) * (1.f / DM) + EPSN);
        v2u* o8 = (v2u*)(O + (size_t)m * DM) + F.lane;
#pragma unroll
        for (int j = 0; j < 4; ++j) { const int d = 4 * F.lane + 256 * j;
            const f32x4 h = v[j] * rstd * g[j] * (sc[j] + 1.0f) + sh[j];
            if (MODE == 2) { const f32x4 h8 = h * 8.0f; *(unsigned*)(O8 + (size_t)m * DM + d) = pk4_fp8(h8[0], h8[1], h8[2], h8[3]); }
            else { v2u w; w.x = pk2(h[0], h[1]); w.y = pk2(h[2], h[3]); o8[64 * j] = w; }
            if (MODE == 1) { const f32x4 hs = h * 16.0f; *(unsigned*)(O8 + (size_t)(d >> 8) * ((size_t)MT * 256) + (size_t)m * 256 + (d & 255)) = pk4_fp8(hs[0], hs[1], hs[2], hs[3]); } }
    }
}

__device__ __forceinline__ float lg_gamma(int h) { return __builtin_log2f(1.0f - fexp2((float)(-5 - h))); }
__device__ __forceinline__ v4u scale8(v4u w, float s) {
    v4u o; o.x = pk2(bflo(w.x) * s, bfhi(w.x) * s); o.y = pk2(bflo(w.y) * s, bfhi(w.y) * s); o.z = pk2(bflo(w.z) * s, bfhi(w.z) * s); o.w = pk2(bflo(w.w) * s, bfhi(w.w) * s); return o;
}
__device__ __forceinline__ void f8_to_bf16x16(const v4u w, float sc, v4u& o0, v4u& o1) {
    const f32x4 a = pg8::f8x4(w.x) * sc, b = pg8::f8x4(w.y) * sc, c = pg8::f8x4(w.z) * sc, d = pg8::f8x4(w.w) * sc;
    o0.x = pk2(a[0], a[1]); o0.y = pk2(a[2], a[3]); o0.z = pk2(b[0], b[1]); o0.w = pk2(b[2], b[3]);
    o1.x = pk2(c[0], c[1]); o1.y = pk2(c[2], c[3]); o1.z = pk2(d[0], d[1]); o1.w = pk2(d[2], d[3]);
}
struct KvRegs { v4u k[2], v[4]; };
__device__ __forceinline__ void kv_load(Frame& F, int u, KvRegs& R) {
    const int b = u >> 7, h = (u >> 5) & 3, c = u & 31; const size_t tok0 = (size_t)b * SEQ + c * 128;
    const unsigned char* Kb = F.dout + DO_K; const unsigned char* Vb = F.ws + WS_V;
#pragma unroll
    for (int i = 0; i < 2; ++i) { const int ch = F.tid + 512 * i, j = ch >> 3, cc = ch & 7; R.k[i] = *(const v4u*)(Kb + (tok0 + j) * 512 + h * 128 + cc * 16); }
#pragma unroll
    for (int i = 0; i < 4; ++i) { const int ch = F.tid + 512 * i, j = ch >> 4, cc = ch & 15; R.v[i] = *(const v4u*)(Vb + (tok0 + j) * 1024 + h * 256 + cc * 16); }
}
__device__ __forceinline__ void kv_unit(Frame& F, int u, KvRegs& R, int unext) {
    const int b = u >> 7, h = (u >> 5) & 3, c = u & 31;
    LAS unsigned char* Kimg = F.lds; LAS unsigned char* Vimg = F.lds + 34816;
    const float lg = lg_gamma(h);
#pragma unroll
    for (int i = 0; i < 2; ++i) { const int ch = F.tid + 512 * i, j = ch >> 3, cc = ch & 7; v4u o0, o1;
        f8_to_bf16x16(R.k[i], fexp2((float)(127 - j) * lg) * (1.0f / 128.0f), o0, o1); *(LAS v4u*)(Kimg + j * KS + cc * 32) = o0; *(LAS v4u*)(Kimg + j * KS + cc * 32 + 16) = o1; }
#pragma unroll
    for (int i = 0; i < 4; ++i) { const int ch = F.tid + 512 * i, j = ch >> 4, cc = ch & 15; v4u o0, o1;
        f8_to_bf16x16(R.v[i], 1.0f / 16.0f, o0, o1); *(LAS v4u*)(Vimg + j * VS + cc * 32) = o0; *(LAS v4u*)(Vimg + j * VS + cc * 32 + 16) = o1; }
    __syncthreads();
    if (unext >= 0) kv_load(F, unext, R);
    f32x4 acc[8][2];
#pragma unroll
    for (int dt = 0; dt < 8; ++dt) { acc[dt][0] = (f32x4){0.f, 0.f, 0.f, 0.f}; acc[dt][1] = (f32x4){0.f, 0.f, 0.f, 0.f}; }
#pragma unroll
    for (int js = 0; js < 4; ++js) {
        bf16x8 bv[2];
#pragma unroll
        for (int vt = 0; vt < 2; ++vt) bv[vt] = lds_tr_frag(Vimg, VS, 32 * js, 32 * F.wave + 16 * vt, F.lane);
#pragma unroll
        for (int dt = 0; dt < 8; ++dt) { const bf16x8 a = lds_tr_frag(Kimg, KS, 32 * js, 16 * dt, F.lane);
            acc[dt][0] = MFMA16(a, bv[0], acc[dt][0]); acc[dt][1] = MFMA16(a, bv[1], acc[dt][1]); }
    }
    unsigned char* dst = F.dout + DO_KVS + (size_t)(((b * 4 + h) * 32 + c)) * 32768;
#pragma unroll
    for (int dt = 0; dt < 8; ++dt)
#pragma unroll
        for (int vt = 0; vt < 2; ++vt) { const int v = 32 * F.wave + 16 * vt + (F.lane & 15), d0 = 16 * dt + 4 * (F.lane >> 4);
            *(unsigned*)(dst + v * 128 + d0) = pk4_fp8(acc[dt][vt][0] * 16.f, acc[dt][vt][1] * 16.f, acc[dt][vt][2] * 16.f, acc[dt][vt][3] * 16.f); }
    __syncthreads();
}
struct SguRegs { v2u sv[8]; f32x2v st[8]; };
__device__ __forceinline__ void sgu_load(Frame& F, int su, SguRegs& R) {
    const size_t tok0 = (size_t)(su >> 2) * 128; const int g = su & 3; const unsigned char* SVb = F.ws + WS_SV; const float* stat = (const float*)(F.ws + WS_SVSTAT);
    int tq = F.tid; asm volatile("" : "+v"(tq));
#pragma unroll
    for (int i = 0; i < 8; ++i) { const int ch = tq + 512 * i, sr = ch >> 5, cc = ch & 31;
        R.sv[i] = *(const v2u*)(SVb + (tok0 + sr) * 1024 + g * 256 + cc * 8); R.st[i] = *(const f32x2v*)(stat + (tok0 + sr) * 2); }
}
__device__ __forceinline__ void sgu_unit(Frame& F, int su, SguRegs& R, int snext, int& cur_g) {
    const size_t tok0 = (size_t)(su >> 2) * 128; const int g = su & 3;
    LAS unsigned char* Vn = F.lds; LAS unsigned char* Wimg = F.lds + 67584;
    const unsigned char* Ub = F.ws + WS_U; const bf16* Wm = (const bf16*)(F.ws + WS_SGUW);
    { const int cc = F.tid & 31; const int col = g * 256 + cc * 8;
        const f32x4 g0 = *(const f32x4*)(F.sgu_ln_g + col), g1 = *(const f32x4*)(F.sgu_ln_g + col + 4), b0 = *(const f32x4*)(F.sgu_ln_b + col), b1 = *(const f32x4*)(F.sgu_ln_b + col + 4);
#pragma unroll
        for (int i = 0; i < 8; ++i) { const int ch = F.tid + 512 * i, sr = ch >> 5; const f32x4 w0 = pg8::f8x4(R.sv[i].x) * 0.0625f, w1 = pg8::f8x4(R.sv[i].y) * 0.0625f;
            const float mean = R.st[i].x * (1.f / 1024.f), var = R.st[i].y * (1.f / 1024.f) - mean * mean, rstd = __builtin_amdgcn_rsqf(var + EPSN);
            v4u o;
            o.x = pk2((w0[0] - mean) * rstd * g0[0] + b0[0], (w0[1] - mean) * rstd * g0[1] + b0[1]);
            o.y = pk2((w0[2] - mean) * rstd * g0[2] + b0[2], (w0[3] - mean) * rstd * g0[3] + b0[3]);
            o.z = pk2((w1[0] - mean) * rstd * g1[0] + b1[0], (w1[1] - mean) * rstd * g1[1] + b1[1]);
            o.w = pk2((w1[2] - mean) * rstd * g1[2] + b1[2], (w1[3] - mean) * rstd * g1[3] + b1[3]);
            *(LAS v4u*)(Vn + sr * VS + cc * 16) = o; } }
    if (g != cur_g) { cur_g = g;
#pragma unroll
        for (int i = 0; i < 4; ++i) { const int ch = F.tid + 512 * i, t = ch >> 4, cc = ch & 15;
            *(LAS v4u*)(Wimg + t * KS + cc * 16) = *(const v4u*)(Wm + (size_t)(g * 128 + t) * 128 + cc * 8); } }
    __syncthreads();
    if (snext >= 0) sgu_load(F, snext, R);
    unsigned uv[8][2];
#pragma unroll
    for (int tt = 0; tt < 8; ++tt)
#pragma unroll
        for (int ct = 0; ct < 2; ++ct) uv[tt][ct] = *(const unsigned*)(Ub + (tok0 + 16 * tt + (F.lane & 15)) * 1024 + g * 256 + 32 * F.wave + 16 * ct + 4 * (F.lane >> 4));
    f32x4 acc[2][8];
#pragma unroll
    for (int ct = 0; ct < 2; ++ct)
#pragma unroll
        for (int tt = 0; tt < 8; ++tt) acc[ct][tt] = (f32x4){0.f, 0.f, 0.f, 0.f};
#pragma unroll
    for (int ss = 0; ss < 4; ++ss) {
        bf16x8 av[2];
#pragma unroll
        for (int ct = 0; ct < 2; ++ct) av[ct] = lds_tr_frag(Vn, VS, 32 * ss, 32 * F.wave + 16 * ct, F.lane);
#pragma unroll
        for (int tt = 0; tt < 8; ++tt) if (tt >= 2 * ss) { const bf16x8 bw = lds_row_frag(Wimg, KS, 16 * tt, 32 * ss, F.lane);
            acc[0][tt] = MFMA16(av[0], bw, acc[0][tt]); acc[1][tt] = MFMA16(av[1], bw, acc[1][tt]); }
    }
#pragma unroll
    for (int tt = 0; tt < 8; ++tt) { const int t = 16 * tt + (F.lane & 15); const float bs = F.sgu_b[g * 128 + t];
#pragma unroll
        for (int ct = 0; ct < 2; ++ct) { const int cg = g * 256 + 32 * F.wave + 16 * ct + 4 * (F.lane >> 4); const f32x4 u4 = pg8::f8x4(uv[tt][ct]) * 0.5f;
            *(unsigned*)(F.ws + WS_YS8 + (tok0 + t) * 1024 + cg) = pk4_fp8(u4[0] * (acc[ct][tt][0] + bs), u4[1] * (acc[ct][tt][1] + bs), u4[2] * (acc[ct][tt][2] + bs), u4[3] * (acc[ct][tt][3] + bs)); } }
    __syncthreads();
}
__device__ __forceinline__ void p2a(Frame& F) { F.fence_ids();
    { KvRegs R; if (F.bid < 1024) kv_load(F, F.bid, R);
      for (int u = F.bid; u < 1024; u += F.G) kv_unit(F, u, R, (u + F.G < 1024) ? u + F.G : -1); }
#if MK_PROBE_HI > 0
    if (F.bid == 0 && threadIdx.x == 0) { const unsigned long long _t = __builtin_amdgcn_s_memrealtime(); F.misc[16 + 2 * 20] = (unsigned)_t; F.misc[17 + 2 * 20] = (unsigned)(_t >> 32); }
#endif
    { SguRegs R; int cur_g = -1; if (F.bid < 1024) sgu_load(F, F.bid, R);
      for (int su = F.bid; su < 1024; su += F.G) sgu_unit(F, su, R, (su + F.G < 1024) ? su + F.G : -1, cur_g); }
}
__device__ __forceinline__ void p2b(Frame& F) { F.fence_ids();
    unsigned char* KVS = F.dout + DO_KVS;
    for (int item = F.bid * 512 + F.tid; item < 32 * 4096; item += F.G * 512) {
        const int bh = item >> 12, rem = item & 4095, h = bh & 3;
        const float dc = fexp2(128.0f * lg_gamma(h));
        f32x4 s0 = (f32x4){0.f, 0.f, 0.f, 0.f}, s1 = (f32x4){0.f, 0.f, 0.f, 0.f};
        unsigned char* p = KVS + (size_t)bh * 32 * 32768 + (size_t)rem * 8;
        for (int c0 = 0; c0 < 32; c0 += 8) {
            v2u kv[8];
#pragma unroll
            for (int i = 0; i < 8; ++i) kv[i] = *(const v2u*)(p + (size_t)(c0 + i) * 32768);
#pragma unroll
            for (int i = 0; i < 8; ++i) {
                v2u o; o.x = pk4_fp8(s0[0], s0[1], s0[2], s0[3]); o.y = pk4_fp8(s1[0], s1[1], s1[2], s1[3]);
                *(v2u*)(p + (size_t)(c0 + i) * 32768) = o;
                s0 = s0 * dc + pg8::f8x4(kv[i].x); s1 = s1 * dc + pg8::f8x4(kv[i].y);
            }
        }
    }
}
struct RetRegs { v4u q[2], k[2], v[4]; };
__device__ __forceinline__ void ret_load(Frame& F, int u, RetRegs& R) {
    const int b = u >> 7, h = (u >> 5) & 3, c = u & 31; const size_t tok0 = (size_t)b * SEQ + c * 128;
    const unsigned char* Qb = F.dout + DO_Q; const unsigned char* Kb = F.dout + DO_K; const unsigned char* Vb = F.ws + WS_V;
#pragma unroll
    for (int i = 0; i < 2; ++i) { const int ch = F.tid + 512 * i, j = ch >> 3, cc = ch & 7;
        R.q[i] = *(const v4u*)(Qb + (tok0 + j) * 512 + h * 128 + cc * 16); R.k[i] = *(const v4u*)(Kb + (tok0 + j) * 512 + h * 128 + cc * 16); }
#pragma unroll
    for (int i = 0; i < 4; ++i) { const int ch = F.tid + 512 * i, j = ch >> 4, cc = ch & 15; R.v[i] = *(const v4u*)(Vb + (tok0 + j) * 1024 + h * 256 + cc * 16); }
}
__device__ __forceinline__ void ret_unit(Frame& F, int u, RetRegs& R, int unext) {
    const int b = u >> 7, h = (u >> 5) & 3, c = u & 31;
    const size_t tok0 = (size_t)b * SEQ + c * 128;
    LAS unsigned char* Qimg = F.lds; LAS unsigned char* Kimg = F.lds + 34816; LAS unsigned char* Vimg = F.lds + 69632;
    LAS unsigned char* Sout = F.lds;
    const unsigned char* Gb = F.ws + WS_G;
    const unsigned char* ST = F.dout + DO_KVS + (size_t)(((b * 4 + h) * 32 + c)) * 32768;
    const float lg = lg_gamma(h);
    const int lane = F.lane, w = F.wave, l15 = lane & 15, g4 = lane >> 4;
#pragma unroll
    for (int i = 0; i < 2; ++i) { const int ch = F.tid + 512 * i, j = ch >> 3, cc = ch & 7; v4u o0, o1;
        f8_to_bf16x16(R.q[i], 1.0f / 16.0f, o0, o1); *(LAS v4u*)(Qimg + j * KS + cc * 32) = o0; *(LAS v4u*)(Qimg + j * KS + cc * 32 + 16) = o1;
        f8_to_bf16x16(R.k[i], 1.0f / 128.0f, o0, o1); *(LAS v4u*)(Kimg + j * KS + cc * 32) = o0; *(LAS v4u*)(Kimg + j * KS + cc * 32 + 16) = o1; }
#pragma unroll
    for (int i = 0; i < 4; ++i) { const int ch = F.tid + 512 * i, j = ch >> 4, cc = ch & 15; v4u o0, o1;
        f8_to_bf16x16(R.v[i], 1.0f / 16.0f, o0, o1); *(LAS v4u*)(Vimg + j * VS + cc * 32) = o0; *(LAS v4u*)(Vimg + j * VS + cc * 32 + 16) = o1; }
    bf16x8 bs[4][2];
#pragma unroll
    for (int ds = 0; ds < 4; ++ds)
#pragma unroll
        for (int vt = 0; vt < 2; ++vt) { const v2u sw = *(const v2u*)(ST + (size_t)(32 * w + 16 * vt + l15) * 128 + 32 * ds + 8 * g4); const f32x4 sa = pg8::f8x4(sw.x) * 0.0625f, sb = pg8::f8x4(sw.y) * 0.0625f;
            v4u pk_; pk_.x = pk2(sa[0], sa[1]); pk_.y = pk2(sa[2], sa[3]); pk_.z = pk2(sb[0], sb[1]); pk_.w = pk2(sb[2], sb[3]); bs[ds][vt] = __builtin_bit_cast(bf16x8, pk_); }
    __syncthreads();
    f32x4 st[8];
#pragma unroll
    for (int jt = 0; jt < 8; ++jt) st[jt] = (f32x4){0.f, 0.f, 0.f, 0.f};
#pragma unroll
    for (int ds = 0; ds < 4; ++ds) { const bf16x8 bq = lds_row_frag(Qimg, KS, 16 * w, 32 * ds, lane);
#pragma unroll
        for (int jt = 0; jt < 8; ++jt) if (jt <= w) { const bf16x8 ak = lds_row_frag(Kimg, KS, 16 * jt, 32 * ds, lane); st[jt] = MFMA16(ak, bq, st[jt]); } }
    __syncthreads();
    { const int i = 16 * w + l15;
#pragma unroll
        for (int jt = 0; jt < 8; ++jt) { float o[4];
#pragma unroll
            for (int ii = 0; ii < 4; ++ii) { const int j = 16 * jt + 4 * g4 + ii; o[ii] = (i >= j) ? st[jt][ii] * fexp2((float)(i - j) * lg) : 0.f; }
            v2u pk; pk.x = pk2(o[0], o[1]); pk.y = pk2(o[2], o[3]);
            *(LAS v2u*)(Kimg + i * KS + (16 * jt + 4 * g4) * 2) = pk; } }
    __syncthreads();
    f32x4 acc[8][2];
#pragma unroll
    for (int it = 0; it < 8; ++it) { acc[it][0] = (f32x4){0.f, 0.f, 0.f, 0.f}; acc[it][1] = (f32x4){0.f, 0.f, 0.f, 0.f}; }
#pragma unroll
    for (int ds = 0; ds < 4; ++ds) {
#pragma unroll
        for (int it = 0; it < 8; ++it) { const bf16x8 a = lds_row_frag(Qimg, KS, 16 * it, 32 * ds, lane);
            acc[it][0] = MFMA16(a, bs[ds][0], acc[it][0]); acc[it][1] = MFMA16(a, bs[ds][1], acc[it][1]); } }
#pragma unroll
    for (int it = 0; it < 8; ++it)
#pragma unroll
        for (int ii = 0; ii < 4; ++ii) { const float dq = fexp2((float)(16 * it + 4 * g4 + ii + 1) * lg); acc[it][0][ii] *= dq; acc[it][1][ii] *= dq; }
#pragma unroll
    for (int js = 0; js < 4; ++js) { bf16x8 bv[2];
#pragma unroll
        for (int vt = 0; vt < 2; ++vt) bv[vt] = lds_tr_frag(Vimg, VS, 32 * js, 32 * w + 16 * vt, lane);
#pragma unroll
        for (int it = 0; it < 8; ++it) if (it >= 2 * js) { const bf16x8 a = lds_row_frag(Kimg, KS, 16 * it, 32 * js, lane);
            acc[it][0] = MFMA16(a, bv[0], acc[it][0]); acc[it][1] = MFMA16(a, bv[1], acc[it][1]); } }
    int lane_h = lane; asm volatile("" : "+v"(lane_h));
    unsigned gt[16];
#pragma unroll
    for (int rr = 0; rr < 16; ++rr) gt[rr] = *(const unsigned*)(Gb + (tok0 + 16 * w + rr) * 1024 + h * 256 + 4 * lane_h);
    const f32x4 gn = *(const f32x4*)(F.ret_gn_g + h * 256 + 4 * lane_h);
    __syncthreads();
#pragma unroll
    for (int it = 0; it < 8; ++it)
#pragma unroll
        for (int vt = 0; vt < 2; ++vt)
#pragma unroll
            for (int ii = 0; ii < 4; ++ii) *(LAS float*)(Sout + (16 * it + 4 * g4 + ii) * 1040 + (32 * w + 16 * vt + l15) * 4) = acc[it][vt][ii];
    __syncthreads();
#pragma unroll
    for (int rr = 0; rr < 16; ++rr) { const int i = 16 * w + rr;
        const f32x4 y = *(LAS const f32x4*)(Sout + i * 1040 + lane_h * 16);
        const float mean = wave_sum((y[0] + y[1]) + (y[2] + y[3])) * (1.f / 256.f);
        const f32x4 d = y - mean;
        const float var = wave_sum((d[0] * d[0] + d[1] * d[1]) + (d[2] * d[2] + d[3] * d[3])) * (1.f / 256.f);
        const float r8 = __builtin_amdgcn_rsqf(var + EPSN) * (4.0f / 16.0f);
        const size_t off = (tok0 + i) * 1024 + h * 256 + 4 * lane_h; const f32x4 gq = pg8::f8x4(gt[rr]);
        *(unsigned*)(F.ws + WS_YG8 + off) = pk4_fp8(d[0] * r8 * gn[0] * gq[0], d[1] * r8 * gn[1] * gq[1], d[2] * r8 * gn[2] * gq[2], d[3] * r8 * gn[3] * gq[3]); }
    __syncthreads();
}
__device__ __forceinline__ void p2c(Frame& F) { F.fence_ids(); for (int u = F.bid; u < 1024; u += F.G) { RetRegs R; ret_load(F, u, R); ret_unit(F, u, R, -1); } }

__device__ __forceinline__ float dppx(float v, int) { return v; }
template <int CTRL> __device__ __forceinline__ void merge16(float (&L)[16]) {
    float c[16];
#pragma unroll
    for (int i = 0; i < 16; ++i) c[i] = __builtin_fmaxf(L[i], dpp_f<CTRL>(L[15 - i]));
#pragma unroll
    for (int half = 8; half >= 1; half >>= 1)
#pragma unroll
        for (int i = 0; i < 16; ++i) if ((i & half) == 0) { const float hi = __builtin_fmaxf(c[i], c[i + half]), lo = __builtin_fminf(c[i], c[i + half]); c[i] = hi; c[i + half] = lo; }
#pragma unroll
    for (int i = 0; i < 16; ++i) L[i] = c[i];
}
__device__ __forceinline__ void sort16_desc(float (&v)[16]) {
#pragma unroll
    for (int k = 2; k <= 16; k <<= 1)
#pragma unroll
        for (int j = k >> 1; j >= 1; j >>= 1)
#pragma unroll
            for (int i = 0; i < 16; ++i) { const int l = i ^ j; if (l > i) { const bool desc = ((i & k) == 0) || (k == 16);
                const float hi = __builtin_fmaxf(v[i], v[l]), lo = __builtin_fminf(v[i], v[l]); v[i] = desc ? hi : lo; v[l] = desc ? lo : hi; } }
}
__device__ __forceinline__ void merge_top16(float (&A)[16], const float (&B)[16]) {
#pragma unroll
    for (int i = 0; i < 16; ++i) A[i] = __builtin_fmaxf(A[i], B[15 - i]);
#pragma unroll
    for (int half = 8; half >= 1; half >>= 1)
#pragma unroll
        for (int i = 0; i < 16; ++i) if ((i & half) == 0) { const float hi = __builtin_fmaxf(A[i], A[i + half]), lo = __builtin_fminf(A[i], A[i + half]); A[i] = hi; A[i + half] = lo; }
}
__device__ __forceinline__ void p5b(Frame& F) {
    F.fence_ids();
    LAS unsigned char* Aimg = F.lds; LAS unsigned char* Bimg = F.lds + 34816; LAS float* Sc = (LAS float*)(F.lds + 69632);
    const bf16* QP = (const bf16*)(F.ws + WS_GA);
    const int lane = F.lane, w = F.wave;
    int cur_hp = -1;
    v4u pa[4];
    if (F.bid < 4096) { const int tt = F.bid >> 4, hp = F.bid & 15;
#pragma unroll
        for (int i = 0; i < 4; ++i) { const int ch = F.tid + 512 * i, r = ch >> 4, cc = ch & 15; pa[i] = *(const v4u*)(QP + ((size_t)tt * 128 + r) * 2048 + hp * 128 + cc * 8); } }
    for (int u = F.bid; u < 4096; u += F.G) {
        const int tt = u >> 4, hp = u & 15; const size_t tok0 = (size_t)tt * 128;
#pragma unroll
        for (int i = 0; i < 4; ++i) { const int ch = F.tid + 512 * i, r = ch >> 4, cc = ch & 15; *(LAS v4u*)(Aimg + r * KS + cc * 16) = pa[i]; }
        if (hp != cur_hp) { const bf16* SK = (const bf16*)(F.ws + WS_SK) + (size_t)hp * 16384; cur_hp = hp;
#pragma unroll
            for (int i = 0; i < 4; ++i) { const int ch = F.tid + 512 * i, r = ch >> 4, cc = ch & 15; *(LAS v4u*)(Bimg + r * KS + cc * 16) = *(const v4u*)(SK + (size_t)r * 128 + cc * 8); } }
        __syncthreads();
        { const int un = u + F.G; if (un < 4096) { const int tn = un >> 4, hn = un & 15;
#pragma unroll
            for (int i = 0; i < 4; ++i) { const int ch = F.tid + 512 * i, r = ch >> 4, cc = ch & 15; pa[i] = *(const v4u*)(QP + ((size_t)tn * 128 + r) * 2048 + hn * 128 + cc * 8); } } }
        f32x4 acc[8];
#pragma unroll
        for (int nt = 0; nt < 8; ++nt) acc[nt] = (f32x4){0.f, 0.f, 0.f, 0.f};
#pragma unroll
        for (int ks = 0; ks < 4; ++ks) { const bf16x8 a = lds_row_frag(Aimg, KS, 16 * w, 32 * ks, lane);
#pragma unroll
            for (int nt = 0; nt < 8; ++nt) { const bf16x8 bb = lds_row_frag(Bimg, KS, 16 * nt, 32 * ks, lane); acc[nt] = MFMA16(a, bb, acc[nt]); } }
#pragma unroll
        for (int nt = 0; nt < 8; ++nt)
#pragma unroll
            for (int ii = 0; ii < 4; ++ii) Sc[(16 * w + 4 * (lane >> 4) + ii) * 132 + 16 * nt + (lane & 15)] = acc[nt][ii];
        __syncthreads();
        { const int row = F.tid >> 2, q = F.tid & 3;
            float L[16], L2[16];
#pragma unroll
            for (int i = 0; i < 16; ++i) { const int n = 4 * i + q, n2 = 4 * (i + 16) + q;
                L[i] = __uint_as_float((__float_as_uint(Sc[row * 132 + n]) & 0xFFFFFF80u) | (unsigned)n);
                L2[i] = __uint_as_float((__float_as_uint(Sc[row * 132 + n2]) & 0xFFFFFF80u) | (unsigned)n2); }
            sort16_desc(L); sort16_desc(L2); merge_top16(L, L2);
            merge16<0xB1>(L); merge16<0x4E>(L);
            if (q == 0) { v4u* dst = (v4u*)((unsigned*)(F.ws + WS_SUB) + ((tok0 + row) * 16 + hp) * 16);
#pragma unroll
                for (int i = 0; i < 4; ++i) dst[i] = (v4u){__float_as_uint(L[4 * i]), __float_as_uint(L[4 * i + 1]), __float_as_uint(L[4 * i + 2]), __float_as_uint(L[4 * i + 3])}; } }
        __syncthreads();
    }
}

template <int CTRL> __device__ __forceinline__ float dpp_max(float v) { return __builtin_fmaxf(v, dpp_f<CTRL>(v)); }
template <int CTRL> __device__ __forceinline__ float dpp_add(float v) { return v + dpp_f<CTRL>(v); }
__device__ __forceinline__ float row_allmax(float v) { v = dpp_max<0x128>(v); v = dpp_max<0x124>(v); v = dpp_max<0x122>(v); v = dpp_max<0x121>(v); return v; }
__device__ __forceinline__ float row_allsum(float v) { v = dpp_add<0x128>(v); v = dpp_add<0x124>(v); v = dpp_add<0x122>(v); v = dpp_add<0x121>(v); return v; }
__device__ __forceinline__ void p6a(Frame& F) { F.fence_ids();
    const int lane = F.lane, row = lane >> 4, i = lane & 15, rowbase = lane & 48;
    LAS unsigned* Sel = (LAS unsigned*)(F.lds + F.wave * 1024);
    const unsigned* SUB = (const unsigned*)(F.ws + WS_SUB);
    unsigned short* EID = (unsigned short*)(F.ws + WS_EID); float* GWp = (float*)(F.ws + WS_GW);
    const int gw = F.bid * NWAVES + F.wave, NGW = F.G * NWAVES;
    unsigned nab[2], nbb[2];
    if (gw < MT) {
#pragma unroll
        for (int r = 0; r < 2; ++r) { const int h = 4 * r + row; nab[r] = SUB[((size_t)gw * 16 + 2 * h) * 16 + i]; nbb[r] = SUB[((size_t)gw * 16 + 2 * h + 1) * 16 + i]; } }
    for (int t = gw; t < MT; t += NGW) {
        unsigned abits[2], bbits[2], bcur[2]; float a[2], hv[2]; int ptr[2];
#pragma unroll
        for (int r = 0; r < 2; ++r) { abits[r] = nab[r]; bbits[r] = nbb[r]; a[r] = __uint_as_float(abits[r]); ptr[r] = 0; bcur[r] = (unsigned)__shfl((int)bbits[r], rowbase); hv[r] = a[r] + __uint_as_float(bcur[r]); }
        if (t + NGW < MT) {
#pragma unroll
            for (int r = 0; r < 2; ++r) { const int h = 4 * r + row; nab[r] = SUB[((size_t)(t + NGW) * 16 + 2 * h) * 16 + i]; nbb[r] = SUB[((size_t)(t + NGW) * 16 + 2 * h + 1) * 16 + i]; } }
        for (int k = 0; k < 16; ++k) {
#pragma unroll
            for (int r = 0; r < 2; ++r) {
                const float key = __uint_as_float((__float_as_uint(hv[r]) & 0xFFFFFFF0u) | (unsigned)i);
                const float m = row_allmax(key);
                const bool win = (key == m);
                if (win) { Sel[((r * 4 + row) * 16 + k) * 2] = (abits[r] & 127u) * 128u + (bcur[r] & 127u); Sel[((r * 4 + row) * 16 + k) * 2 + 1] = __float_as_uint(hv[r]); ptr[r]++; }
                const unsigned bnext = (unsigned)__shfl((int)bbits[r], rowbase + (ptr[r] < 15 ? ptr[r] : 15));
                if (win) { bcur[r] = bnext; hv[r] = (ptr[r] < 16) ? a[r] + __uint_as_float(bnext) : -3.0e38f; }
            }
        }
        LDS_WAIT(); asm volatile("" ::: "memory");
#pragma unroll
        for (int r = 0; r < 2; ++r) { const int h = 4 * r + row;
            const unsigned e = Sel[((r * 4 + row) * 16 + i) * 2]; const float sc = __uint_as_float(Sel[((r * 4 + row) * 16 + i) * 2 + 1]);
            const float mx = row_allmax(sc);
            const float ex = fexp2((sc - mx) * 1.44269504089f);
            const float sum = row_allsum(ex);
            EID[(size_t)t * 128 + h * 16 + i] = (unsigned short)e; GWp[(size_t)t * 128 + h * 16 + i] = ex / sum; }
        LDS_WAIT(); asm volatile("" ::: "memory");
    }
}
typedef float f32x2c __attribute__((ext_vector_type(2)));
__device__ __forceinline__ long mk64(unsigned lo, unsigned hi) { return (long)(((unsigned long long)hi << 32) | lo); }
#if MK_U4
typedef int v8i_q __attribute__((ext_vector_type(8)));
__device__ __forceinline__ void p6b(Frame& F) { F.fence_ids();
    const int j = F.bid & 7, s2 = j >> 1, par = j & 1, nsb = F.G >> 3; if ((F.bid >> 3) >= nsb) return;
    const int wj = (F.bid >> 3) * NWAVES + F.wave, NW = nsb * NWAVES, NI = MT / 2;
    const int lane = F.lane, g = lane >> 4;
    const int pidx = (4 * (lane & 15) + (lane >> 4)) * 4;
    const unsigned char* H8 = F.ws + WS_H2F8 + (size_t)s2 * MT * 256 + 16 * g; const unsigned char* U4 = F.ws + WS_UE8 + (size_t)s2 * 16384 * 128 + 16 * (lane & 3); const unsigned short* EID = (const unsigned short*)(F.ws + WS_EID) + (lane >> 2);
    unsigned* PDp = (unsigned*)(F.ws + WS_PD) + (size_t)s2 * MT * 64;
#define TOK(ix_) (2 * ((ix_) < NI ? (ix_) : NI - 1) + par)
#define P6B_LOAD_EID(E, ix_) do { const int tc_ = TOK(ix_); _Pragma("unroll") for (int h = 0; h < 8; ++h) E[h] = EID[(size_t)tc_ * 128 + 16 * h]; } while (0)
#define P6B_LOAD_AB(A_, B0_, B1_, E, ix_) do { const int tc_ = TOK(ix_); const unsigned char* hp_ = H8 + (size_t)tc_ * 256; A_[0] = *(const v4u*)hp_; A_[1] = *(const v4u*)(hp_ + 64); A_[2] = *(const v4u*)(hp_ + 128); A_[3] = *(const v4u*)(hp_ + 192); \
        _Pragma("unroll") for (int h = 0; h < 8; ++h) { const unsigned char* rp_ = U4 + (size_t)E[h] * 128; B0_[h] = *(const v4u*)rp_; B1_[h] = *(const v4u*)(rp_ + 64); } } while (0)
#define BPM(x_) ((int)__builtin_amdgcn_ds_bpermute(pidx, (int)(x_)))
#define P6B_COMPUTE(A_, B0_, B1_, ix_) do { if ((ix_) < NI) { const int tc_ = 2 * (ix_) + par; \
        const v8i_q a0_ = (v8i_q){(int)A_[0].x, (int)A_[0].y, (int)A_[0].z, (int)A_[0].w, (int)A_[1].x, (int)A_[1].y, (int)A_[1].z, (int)A_[1].w}, a1_ = (v8i_q){(int)A_[2].x, (int)A_[2].y, (int)A_[2].z, (int)A_[2].w, (int)A_[3].x, (int)A_[3].y, (int)A_[3].z, (int)A_[3].w}; \
        float pv_[8]; \
        _Pragma("unroll") for (int h = 0; h < 8; ++h) { const v8i_q b0_ = (v8i_q){BPM(B0_[h].x), BPM(B0_[h].y), BPM(B0_[h].z), BPM(B0_[h].w), 0, 0, 0, 0}, b1_ = (v8i_q){BPM(B1_[h].x), BPM(B1_[h].y), BPM(B1_[h].z), BPM(B1_[h].w), 0, 0, 0, 0}; \
            f32x4 acc_ = __builtin_amdgcn_mfma_scale_f32_16x16x128_f8f6f4(a0_, b0_, (f32x4){0.f, 0.f, 0.f, 0.f}, 0, 4, 0, 0x7F7F7F7F, 0, 0x7F7F7F7F); \
            acc_ = __builtin_amdgcn_mfma_scale_f32_16x16x128_f8f6f4(a1_, b1_, acc_, 0, 4, 0, 0x7F7F7F7F, 0, 0x7F7F7F7F); pv_[h] = acc_[0] * (1.0f / 1024.0f); } \
        if (lane < 16) { _Pragma("unroll") for (int hp = 0; hp < 4; ++hp) PDp[(size_t)tc_ * 64 + 16 * hp + lane] = pk2(pv_[2 * hp], pv_[2 * hp + 1]); } } } while (0)
    unsigned E0[8], E1[8]; v4u A0[4], A1[4], B00[8], B01[8], B10[8], B11[8];
    int ix = wj;
    P6B_LOAD_EID(E0, ix); P6B_LOAD_EID(E1, ix + NW);
    P6B_LOAD_AB(A0, B00, B01, E0, ix);
    for (; ix < NI; ix += 2 * NW) {
        P6B_LOAD_AB(A1, B10, B11, E1, ix + NW);
        P6B_LOAD_EID(E0, ix + 2 * NW);
        P6B_COMPUTE(A0, B00, B01, ix);
        P6B_LOAD_AB(A0, B00, B01, E0, ix + 2 * NW);
        P6B_LOAD_EID(E1, ix + 3 * NW);
        P6B_COMPUTE(A1, B10, B11, ix + NW);
    }
#undef TOK
#undef P6B_LOAD_EID
#undef P6B_LOAD_AB
#undef P6B_COMPUTE
#undef BPM
}
#else
__device__ __forceinline__ void p6b(Frame& F) { F.fence_ids();
    const int j = F.bid & 7, nsb = F.G >> 3; if ((F.bid >> 3) >= nsb) return;
    const int wj = (F.bid >> 3) * NWAVES + F.wave, NW = nsb * NWAVES;
    const int lane = F.lane, g = lane >> 4;
    const int pidx = (4 * (lane & 15) + (lane >> 4)) * 4;
    const unsigned char* H8 = F.ws + WS_H2F8 + (size_t)j * MT * 128 + 16 * g; const unsigned char* UE8 = F.ws + WS_UE8 + (size_t)j * 16384 * 128 + 16 * (lane & 3); const unsigned* EID = (const unsigned*)(F.ws + WS_EID) + (lane >> 2);
    float* PD = (float*)(F.ws + WS_PD) + (size_t)j * MT * 128;
#define P6B_LOAD_EID(E, tt) do { const int tc_ = (tt) < MT ? (tt) : MT - 1; _Pragma("unroll") for (int h = 0; h < 8; ++h) E[h] = EID[(size_t)tc_ * 128 + 16 * h]; } while (0)
#define P6B_LOAD_AB(A0_, A1_, B0_, B1_, E, tt) do { const int tc_ = (tt) < MT ? (tt) : MT - 1; const unsigned char* hp_ = H8 + (size_t)tc_ * 128; A0_ = *(const v4u*)hp_; A1_ = *(const v4u*)(hp_ + 64); \
        _Pragma("unroll") for (int h = 0; h < 8; ++h) { const unsigned char* rp_ = UE8 + (size_t)E[h] * 128; B0_[h] = *(const v4u*)rp_; B1_[h] = *(const v4u*)(rp_ + 64); } } while (0)
#define BPM(x_) ((unsigned)__builtin_amdgcn_ds_bpermute(pidx, (int)(x_)))
#define P6B_COMPUTE(A0_, A1_, B0_, B1_, tt) do { if ((tt) < MT) { _Pragma("unroll") for (int h = 0; h < 8; ++h) { f32x4 acc_ = (f32x4){0.f, 0.f, 0.f, 0.f}; \
            acc_ = __builtin_amdgcn_mfma_f32_16x16x32_fp8_fp8(mk64(A0_.x, A0_.y), mk64(BPM(B0_[h].x), BPM(B0_[h].y)), acc_, 0, 0, 0); \
            acc_ = __builtin_amdgcn_mfma_f32_16x16x32_fp8_fp8(mk64(A0_.z, A0_.w), mk64(BPM(B0_[h].z), BPM(B0_[h].w)), acc_, 0, 0, 0); \
            acc_ = __builtin_amdgcn_mfma_f32_16x16x32_fp8_fp8(mk64(A1_.x, A1_.y), mk64(BPM(B1_[h].x), BPM(B1_[h].y)), acc_, 0, 0, 0); \
            acc_ = __builtin_amdgcn_mfma_f32_16x16x32_fp8_fp8(mk64(A1_.z, A1_.w), mk64(BPM(B1_[h].z), BPM(B1_[h].w)), acc_, 0, 0, 0); \
            if (lane < 16) PD[(size_t)(tt) * 128 + 16 * h + lane] = acc_[0] * (1.0f / 8192.0f); } } } while (0)
    unsigned E0[8], E1[8]; v4u A00, A01, A10, A11, B00[8], B01[8], B10[8], B11[8];
    int t = wj;
    P6B_LOAD_EID(E0, t); P6B_LOAD_EID(E1, t + NW);
    P6B_LOAD_AB(A00, A01, B00, B01, E0, t);
    for (; t < MT; t += 2 * NW) {
        P6B_LOAD_AB(A10, A11, B10, B11, E1, t + NW);
        P6B_LOAD_EID(E0, t + 2 * NW);
        P6B_COMPUTE(A00, A01, B00, B01, t);
        P6B_LOAD_AB(A00, A01, B00, B01, E0, t + 2 * NW);
        P6B_LOAD_EID(E1, t + 3 * NW);
        P6B_COMPUTE(A10, A11, B10, B11, t + NW);
    }
#undef P6B_LOAD_EID
#undef P6B_LOAD_AB
#undef P6B_COMPUTE
#undef BPM
}
#endif
__device__ __forceinline__ void p6b2(Frame& F) { F.fence_ids();
    const unsigned* PDp = (const unsigned*)(F.ws + WS_PD); const float* GWp = (const float*)(F.ws + WS_GW); bf16* ACT = (bf16*)(F.ws + WS_ACT);
    for (size_t i4 = (size_t)F.bid * 512 + F.tid; i4 < (size_t)MT * 32; i4 += (size_t)F.G * 512) { const size_t t = i4 >> 5; const int p0 = (int)(i4 & 31) * 4, h = p0 >> 4, l0 = p0 & 15;
        f32x4 s = (f32x4){0.f, 0.f, 0.f, 0.f};
#pragma unroll
        for (int jj = 0; jj < 4; ++jj) { const v4u w = *(const v4u*)(PDp + ((size_t)jj * MT + t) * 64 + (h >> 1) * 16 + l0);
            s += (h & 1) ? (f32x4){bfhi(w.x), bfhi(w.y), bfhi(w.z), bfhi(w.w)} : (f32x4){bflo(w.x), bflo(w.y), bflo(w.z), bflo(w.w)}; }
        const f32x4 gw = *(const f32x4*)(GWp + i4 * 4);
        v2u o; o.x = pk2(gelu1(s[0]) * gw[0], gelu1(s[1]) * gw[1]); o.y = pk2(gelu1(s[2]) * gw[2], gelu1(s[3]) * gw[3]);
        *(v2u*)(ACT + i4 * 4) = o;
    }
}
__device__ __forceinline__ void p6c(Frame& F) { F.fence_ids();
    const int j = F.bid & 7, nsb = F.G >> 3; if ((F.bid >> 3) >= nsb) return;
    const int wj = (F.bid >> 3) * NWAVES + F.wave, NW = nsb * NWAVES;
    const int lane = F.lane, g8 = lane >> 3, s8 = lane & 7;
    LAS float* Act = (LAS float*)(F.lds + F.wave * 8192); LAS unsigned* Eidl = (LAS unsigned*)(F.lds + F.wave * 8192 + 4096);
    const unsigned char* VE8 = F.ws + WS_VE8 + (size_t)j * 16384 * 128 + 16 * s8; const unsigned short* EID = (const unsigned short*)(F.ws + WS_EID); const bf16* ACT = (const bf16*)(F.ws + WS_ACT);
    bf16* PEERS = (bf16*)(F.ws + WS_PEERS) + (size_t)j * MT * 128;
    for (int tg = wj; tg < MT / 8; tg += NW) {
        const size_t t0 = (size_t)tg * 8;
#pragma unroll
        for (int q = 0; q < 4; ++q) { const int idx = 4 * (lane + 64 * q);
            const v2u aw = *(const v2u*)(ACT + t0 * 128 + idx), ew = *(const v2u*)(EID + t0 * 128 + idx);
            *(LAS f32x4*)(Act + idx) = (f32x4){bflo(aw.x), bfhi(aw.x), bflo(aw.y), bfhi(aw.y)}; *(LAS v4u*)(Eidl + idx) = (v4u){ew.x & 0xFFFFu, ew.x >> 16, ew.y & 0xFFFFu, ew.y >> 16}; }
        LDS_WAIT(); asm volatile("" ::: "memory");
        f32x2c acc2[8];
#pragma unroll
        for (int e = 0; e < 8; ++e) acc2[e] = (f32x2c){0.f, 0.f};
        LAS const float* ap = Act + g8 * 128; LAS const unsigned* ep = Eidl + g8 * 128;
        v4u va[8], vb[8]; f32x4 aa[2], ab[2];
#define P6C_LOAD(V_, A_, base) do { A_[0] = *(LAS const f32x4*)(ap + (base)); A_[1] = *(LAS const f32x4*)(ap + (base) + 4); const v4u e0_ = *(LAS const v4u*)(ep + (base)), e1_ = *(LAS const v4u*)(ep + (base) + 4); \
            _Pragma("unroll") for (int k = 0; k < 4; ++k) { V_[k] = *(const v4u*)(VE8 + (size_t)e0_[k] * 128); V_[4 + k] = *(const v4u*)(VE8 + (size_t)e1_[k] * 128); } } while (0)
#define P6C_FMA(V_, A_) do { _Pragma("unroll") for (int k = 0; k < 8; ++k) { const float a_ = A_[k >> 2][k & 3]; const f32x2c a2_ = (f32x2c){a_, a_}; _Pragma("unroll") for (int w = 0; w < 4; ++w) { \
            const f32x2c lo_ = __builtin_amdgcn_cvt_pk_f32_fp8((int)V_[k][w], false), hi_ = __builtin_amdgcn_cvt_pk_f32_fp8((int)V_[k][w], true); \
            acc2[2 * w] = __builtin_elementwise_fma(a2_, lo_, acc2[2 * w]); acc2[2 * w + 1] = __builtin_elementwise_fma(a2_, hi_, acc2[2 * w + 1]); } } } while (0)
        P6C_LOAD(va, aa, 0);
        for (int it = 0; it < 128; it += 16) {
            P6C_LOAD(vb, ab, it + 8);
            P6C_FMA(va, aa);
            if (it + 16 < 128) P6C_LOAD(va, aa, it + 16);
            P6C_FMA(vb, ab);
        }
#undef P6C_LOAD
#undef P6C_FMA
        float acc[16];
#pragma unroll
        for (int e = 0; e < 8; ++e) { acc[2 * e] = acc2[e][0]; acc[2 * e + 1] = acc2[e][1]; }
        { bf16* op = PEERS + (t0 + g8) * 128 + 16 * s8;
            v4u o0, o1;
            o0.x = pk2(acc[0] * 0.0625f, acc[1] * 0.0625f); o0.y = pk2(acc[2] * 0.0625f, acc[3] * 0.0625f); o0.z = pk2(acc[4] * 0.0625f, acc[5] * 0.0625f); o0.w = pk2(acc[6] * 0.0625f, acc[7] * 0.0625f);
            o1.x = pk2(acc[8] * 0.0625f, acc[9] * 0.0625f); o1.y = pk2(acc[10] * 0.0625f, acc[11] * 0.0625f); o1.z = pk2(acc[12] * 0.0625f, acc[13] * 0.0625f); o1.w = pk2(acc[14] * 0.0625f, acc[15] * 0.0625f);
            *(v4u*)op = o0; *(v4u*)(op + 8) = o1; }
        LDS_WAIT(); asm volatile("" ::: "memory");
    }
}
__device__ __forceinline__ void p6d(Frame& F) { F.fence_ids();
    const int gw = F.bid * NWAVES + F.wave, NGW = F.G * NWAVES; const bf16* PEERS = (const bf16*)(F.ws + WS_PEERS); const float* gate2 = (const float*)(F.ws + WS_MOD) + 5120;
    f32x4 fg[4];
#pragma unroll
    for (int q = 0; q < 4; ++q) fg[q] = *((const f32x4*)F.final_g + F.lane + 64 * q);
    f32x4 nx[4]; v2u np[4];
#define P6D_LOAD(tt) do { _Pragma("unroll") for (int q = 0; q < 4; ++q) { const int d = 4 * F.lane + 256 * q; { const v2u w_ = *((const v2u*)((const bf16*)(F.ws + WS_X1B) + (size_t)(tt) * DM) + F.lane + 64 * q); nx[q] = (f32x4){bflo(w_.x), bfhi(w_.x), bflo(w_.y), bfhi(w_.y)}; } \
        np[q] = *(const v2u*)(PEERS + ((size_t)(d >> 7) * MT + (tt)) * 128 + (d & 127)); } } while (0)
    if (gw < MT) P6D_LOAD(gw);
    for (int t = gw; t < MT; t += NGW) {
        const int b = t >> 12;
        f32x4* xr = (f32x4*)((float*)F.dout + (size_t)t * DM) + F.lane; f32x4 o[4]; float ss = 0.f;
#pragma unroll
        for (int q = 0; q < 4; ++q) { const int d = 4 * F.lane + 256 * q; const f32x4 g2 = *(const f32x4*)(gate2 + (size_t)b * 6144 + d);
            o[q] = nx[q] + g2 * (f32x4){bflo(np[q].x), bfhi(np[q].x), bflo(np[q].y), bfhi(np[q].y)}; ss += (o[q][0] * o[q][0] + o[q][1] * o[q][1]) + (o[q][2] * o[q][2] + o[q][3] * o[q][3]); }
        if (t + NGW < MT) P6D_LOAD(t + NGW);
        const float rstd = __builtin_amdgcn_rsqf(wave_sum(ss) * (1.f / DM) + EPSN);
#pragma unroll
        for (int q = 0; q < 4; ++q) xr[64 * q] = o[q] * rstd * fg[q];
    }
#undef P6D_LOAD
}

struct Args { const float* in[20]; float* out; unsigned char* ws; int ph_lo, ph_hi, li, pad; };
__global__ void __launch_bounds__(NWAVES * 64, 2) mk_fwd(Args args) {
    extern __shared__ __attribute__((aligned(16))) unsigned char lds_raw[];
    Frame F;
    F.lds = (LAS unsigned char*)lds_raw;
    F.tid = threadIdx.x; F.lane = F.tid & 63; F.wave = __builtin_amdgcn_readfirstlane(F.tid >> 6); F.G = gridDim.x; F.bid = blockIdx.x;
    F.x = args.in[0]; F.c = args.in[1]; F.w_ada = args.in[2]; F.b_ada = args.in[3]; F.norm1_g = args.in[4]; F.w_in = args.in[5]; F.ret_gn_g = args.in[6]; F.sgu_ln_g = args.in[7];
    F.sgu_ln_b = args.in[8]; F.sgu_w = args.in[9]; F.sgu_b = args.in[10]; F.w_ret_out = args.in[11]; F.w_sgu_out = args.in[12]; F.w_out = args.in[13]; F.norm2_g = args.in[14];
    F.peer_w_q = args.in[15]; F.peer_sub_keys = args.in[16]; F.peer_u = args.in[17]; F.peer_v = args.in[18]; F.final_g = args.in[19];
    F.ws = args.ws; F.dout = (unsigned char*)args.out;
    volatile LAS unsigned* MISC = (volatile LAS unsigned*)(F.lds + MISC_OFF); F.misc = MISC;
    if (F.tid < 64) MISC[F.tid] = 0u;
    __syncthreads();
    XcdBarrier bar; bar.bar = (unsigned*)(F.ws + WS_CTL) + CW_BAR; bar.x = 0; bar.st = nullptr;
    if (N_LAUNCHES == 1) bar = xcd_barrier_post((unsigned*)(F.ws + WS_CTL) + CW_BAR, MISC + 8);
    const int lo = args.ph_lo, hi = args.ph_hi;
#define IN(k) (lo <= (k) && (k) < hi)
#if MK_PROBE_HI > 0
#define STAMP(k) do { if (F.bid == 0 && F.wave == 0 && F.lane == 0) { const unsigned long long _t = __builtin_amdgcn_s_memrealtime(); MISC[16 + 2 * (k)] = (unsigned)_t; MISC[17 + 2 * (k)] = (unsigned)(_t >> 32); } } while (0)
#else
#define STAMP(k) do { } while (0)
#endif
#define SEAM(k) do { if (IN(k) && IN((k) + 1)) xcd_barrier(bar); } while (0)
    const float* mod = (const float*)(F.ws + WS_MOD);
    STAMP(0);
    if (IN(0)) { p0a(F); SEAM(0); }
    STAMP(1);
    if (IN(1)) { norm_rows<2>(F, F.x, F.norm1_g, mod + 0, mod + 1024, nullptr, F.dout + DO_H); SEAM(1); }
    STAMP(2);
    if (IN(2)) {
        pg8::Gemm g{(const bf16*)(F.dout + DO_H), (const bf16*)(F.ws + WS_WIN), MT, NIN, 512}; pg8::StaticOrder S; S.init(MT, NIN, F.G, F.bid);
        pg8::EpiProj E{(bf16*)(F.dout + DO_Q), (bf16*)(F.dout + DO_K), (bf16*)(F.ws + WS_V), (bf16*)(F.ws + WS_G), (bf16*)(F.ws + WS_U), (bf16*)(F.ws + WS_SV), (bf16*)(F.ws + WS_GA), (bf16*)(F.ws + WS_GB),
                       (const float*)(F.ws + WS_COS), (const float*)(F.ws + WS_SIN), 1.0f / 4096.0f, (float*)(F.ws + WS_SVSTAT)};
        pg8::gemm_phase<pg8::EpiProj, pg8::StaticOrder, true, true, true>(F.lds, g, S, E);
        SEAM(2);
    }
    STAMP(3);
    if (IN(3)) { p2a(F); SEAM(3); }
    STAMP(4);
    if (IN(4)) { p2b(F); SEAM(4); }
    STAMP(5);
    if (IN(5)) { p2c(F); SEAM(5); }
    STAMP(6);
    if (IN(6)) {
        pg8::StaticOrder S; S.init(MT, DM, F.G, F.bid);
        pg8::Gemm g{(const bf16*)(F.ws + WS_YG8), (const bf16*)(F.ws + WS_WRET), MT, DM, 1024, 512, (const bf16*)(F.ws + WS_YS8), (const bf16*)(F.ws + WS_WSGU), 8};
        pg8::EpiMerged E{F.ws + WS_GA, F.ws + WS_GB, F.ws + WS_MRG8, 1.0f / 4096.0f};
        pg8::gemm_phase<pg8::EpiMerged, pg8::StaticOrder, true, true, true>(F.lds, g, S, E);
        SEAM(6);
    }
    STAMP(7);
    if (IN(7)) {
        pg8::Gemm g{(const bf16*)(F.ws + WS_MRG8), (const bf16*)(F.ws + WS_WOUT), MT, DM, 512}; pg8::StaticOrder S; S.init(MT, DM, F.G, F.bid);
        pg8::EpiX1 E{F.x, mod + 2048, (bf16*)(F.ws + WS_X1B), 1.0f / 4096.0f};
        pg8::gemm_phase<pg8::EpiX1, pg8::StaticOrder, true, true, true>(F.lds, g, S, E);
        SEAM(7);
    }
    STAMP(8);
    if (IN(8)) { norm_rows<1>(F, (const float*)(F.ws + WS_X1B), F.norm2_g, mod + 3072, mod + 4096, (bf16*)(F.ws + WS_SV), F.ws + WS_H2F8); SEAM(8); }
    STAMP(9);
    if (IN(9)) {
        pg8::Gemm g{(const bf16*)(F.ws + WS_SV), (const bf16*)(F.ws + WS_WQ), MT, 2048, DM}; pg8::StaticOrder S; S.init(MT, 2048, F.G, F.bid);
        pg8::EpiPlain E{(bf16*)(F.ws + WS_GA), 2048};
        pg8::gemm_phase<pg8::EpiPlain, pg8::StaticOrder, true, true>(F.lds, g, S, E);
        SEAM(9);
    }
    STAMP(10);
    if (IN(10)) { p5b(F); SEAM(10); }
    STAMP(11);
    if (IN(11)) { p6a(F); SEAM(11); }
    STAMP(12);
    if (IN(12)) { p6b(F); SEAM(12); }
    STAMP(13);
    if (IN(13)) { p6b2(F); SEAM(13); }
    STAMP(14);
    if (IN(14)) { p6c(F); SEAM(14); }
    STAMP(15);
    if (IN(15)) { p6d(F); }
    STAMP(16);
#if MK_PROBE_HI > 0
    __syncthreads();
    if (F.bid == 0 && F.tid == 0) { const unsigned long long t0 = ((unsigned long long)MISC[17 + 2 * MK_PROBE_LO] << 32) | MISC[16 + 2 * MK_PROBE_LO], t1 = ((unsigned long long)MISC[17 + 2 * MK_PROBE_HI] << 32) | MISC[16 + 2 * MK_PROBE_HI];
#if MK_GPROBE == 1
        ((float*)F.dout)[0] += (float)MISC[56] * 1e-3f; }
#elif MK_GPROBE == 2
        ((float*)F.dout)[0] += (float)MISC[57] * 1e-3f; }
#else
        ((float*)F.dout)[0] += (float)(t1 - t0) * 1e-3f; }
#endif
#endif
#undef IN
#undef SEAM
}

extern "C" void kernel_launch(void* const* d_in, const int* in_sizes, int n_in, void* d_out, int out_size, void* d_ws, size_t ws_size, hipStream_t stream) {
    static int grid = 0;
    if (grid == 0) {
        if (n_in != 20 || out_size != MT * DM || ws_size < WS_END) { fprintf(stderr, "kernel_launch: unexpected shapes (n_in %d, out %d, ws %zu); nothing launched\n", n_in, out_size, ws_size); grid = -1; return; }
        int dev = 0, cus = 0, per_cu = 0;
        if (hipGetDevice(&dev) != hipSuccess || hipDeviceGetAttribute(&cus, hipDeviceAttributeMultiprocessorCount, dev) != hipSuccess) { grid = -1; return; }
        if (hipFuncSetAttribute((const void*)mk_fwd, hipFuncAttributeMaxDynamicSharedMemorySize, LDS_BYTES) != hipSuccess) { fprintf(stderr, "kernel_launch: hipFuncSetAttribute failed\n"); grid = -1; return; }
        if (hipOccupancyMaxActiveBlocksPerMultiprocessor(&per_cu, (const void*)mk_fwd, NWAVES * 64, LDS_BYTES) != hipSuccess || per_cu < 1)
            fprintf(stderr, "kernel_launch: note: occupancy query reports %d workgroups per CU\n", per_cu);
        (void)hipGetLastError();
        grid = cus;
    }
    if (grid < 0) return;
    if (hipMemsetAsync((char*)d_ws + WS_CTL, 0, CTL_ZERO_BYTES, stream) != hipSuccess) { fprintf(stderr, "kernel_launch: memset failed\n"); return; }
    Args a{};
    for (int i = 0; i < 20; ++i) a.in[i] = (const float*)d_in[i];
    a.out = (float*)d_out; a.ws = (unsigned char*)d_ws;
    static_assert(N_LAUNCHES == 1 || N_LAUNCHES == N_PHASES, "N_LAUNCHES is 1 or N_PHASES");
    for (int li = 0; li < N_LAUNCHES && li < MK_MAXPH; ++li) {
        a.ph_lo = (N_LAUNCHES == 1) ? 0 : li; a.ph_hi = (N_LAUNCHES == 1) ? N_PHASES : li + 1; a.li = li;
        hipLaunchKernelGGL(mk_fwd, dim3(grid), dim3(NWAVES * 64), LDS_BYTES, stream, a);
        const hipError_t le = hipPeekAtLastError();
        if (le != hipSuccess) { fprintf(stderr, "kernel_launch: launch %d failed: %s\n", li, hipGetErrorName(le)); break; }
    }
}
```

```cpp
#include <hip/hip_runtime.h>
#include <cstdio>
#include <cstdint>

#ifndef MK_PROBE_LO
#define MK_PROBE_LO 0
#define MK_PROBE_HI 0
#endif
#ifndef MK_GPROBE
#define MK_GPROBE 0
#endif
#define MK_MISC_OFF (147456 - 256)
#ifndef MK_U4
#define MK_U4 1
#endif
#ifndef MK_ALAY
#define MK_ALAY 2
#endif
#ifndef MK_MAXPH
#define MK_MAXPH 16
#endif
#ifndef MK_N_LAUNCHES
#define MK_N_LAUNCHES 1
#endif
namespace pg8 {
#define PG8_LAS __attribute__((address_space(3)))
typedef unsigned short bf16_t;
typedef short bf16x8 __attribute__((ext_vector_type(8)));
typedef float f32x4 __attribute__((ext_vector_type(4)));
typedef unsigned u32x4 __attribute__((ext_vector_type(4)));
constexpr int BM = 256, BK = 64, HALF = 128, HTB = HALF * BK * 2  , STAGE_BYTES = 8 * HTB, NXCD = 8, WGM = 2;

__host__ __device__ __forceinline__ int lds_byte(int r, int c) { const int st = (r >> 4) * 2 + (c >> 5), rr = r & 15, cc = c & 31, ob = rr * 64 + cc * 2; return st * 1024 + (ob ^ (((ob >> 9) & 1) << 5)); }
__host__ __device__ __forceinline__ void stage_rc(int b, int& R, int& C) { const int st = b / 1024, sb = b % 1024, swz = sb ^ (((sb >> 9) & 1) << 5); R = (st >> 1) * 16 + swz / 64; C = (st & 1) * 32 + (swz % 64) / 2; }
__host__ __device__ __forceinline__ int perm32(int rho) { const int n = rho >> 4, i = rho & 15; return 8 * (i >> 2) + 4 * n + (i & 3); }

struct Unit { int pm, pn; };
struct Gemm { const bf16_t* A; const bf16_t* Bt; int M, N, K; int ld = 0; const bf16_t* A2 = nullptr; const bf16_t* Bt2 = nullptr; int ksplit = 0; };

struct StaticOrder {
    int nM, nN, nwg, G, c;
    __host__ __device__ void init(int M, int N, int G_, int c_) { nM = M / BM; nN = N / BM; nwg = nM * nN; G = G_; c = c_; }
    __host__ __device__ bool next(int i, Unit& u) const {
        const long L = (long)i * G + c; if (L >= nwg) return false;
        int wgid = (int)L; { const int q = nwg / NXCD, r = nwg % NXCD, xcd = wgid % NXCD, off = wgid / NXCD; wgid = (xcd < r ? xcd * (q + 1) : r * (q + 1) + (xcd - r) * q) + off; }
        const int nig = WGM * nN, gid = wgid / nig, fm = gid * WGM, gsz = (nM - fm) < WGM ? (nM - fm) : WGM;
        u.pm = fm + ((wgid % nig) % gsz); u.pn = (wgid % nig) / gsz; return true;
    }
    __device__ __forceinline__ void a_ready(const Unit&) const {}
    __device__ __forceinline__ void done(const Unit&) const {}
};

__device__ __forceinline__ unsigned cvt_pk_bf16(float lo, float hi) { unsigned r; asm volatile("v_cvt_pk_bf16_f32 %0, %1, %2" : "=v"(r) : "v"(lo), "v"(hi)); return r; }
typedef float f32x2 __attribute__((ext_vector_type(2)));
__device__ __forceinline__ f32x2 gelu_pk(f32x2 v) {
    const f32x2 av = __builtin_elementwise_abs(v), d = av * 0.2316418882f + 1.0f;
    f32x2 t; t.x = __builtin_amdgcn_rcpf(d.x); t.y = __builtin_amdgcn_rcpf(d.y);
    f32x2 q = t * 0.5307027145f + (-0.7265760135f); q = q * t + 0.7107068705f; q = q * t + (-0.142248368f); q = q * t + 0.127414796f; q = q * t;
    const f32x2 s = (v * v) * (-0.72134752044f);
    f32x2 e; e.x = __builtin_amdgcn_exp2f(s.x); e.y = __builtin_amdgcn_exp2f(s.y);
    const f32x2 m = v * (q * e), r = v - m;
    f32x2 o; o.x = v.x < 0.f ? m.x : r.x; o.y = v.y < 0.f ? m.y : r.y; return o;
}


__device__ __forceinline__ f32x2 gelu16_pk(f32x2 a) {
    f32x2 z; z.x = __builtin_fabsf(a.x) * 1.7263349e-4f; z.y = __builtin_fabsf(a.y) * 1.7263349e-4f;
    f32x2 p = z * 4.4970397e-5f + 2.8881189e-4f; p = p * z + 1.5874455e-4f; p = p * z + 9.6809685e-3f; p = p * z + 4.4153996e-2f; p = p * z + 7.3645402e-2f; p = p * z + 1.0442738f;
    f32x2 r; r.x = __builtin_amdgcn_rcpf(p.x); r.y = __builtin_amdgcn_rcpf(p.y);
    r = r * r; r = r * r; r = r * r; r = r * r;
    const f32x2 u = r * (-22.627417f) + 11.313708f, h = a * 0.001953125f;
    return z * u + h;
}
__device__ __forceinline__ f32x2 silu16_pk(f32x2 a) {
    const f32x2 zz = a * (-3.5222047e-4f);
    f32x2 e; e.x = __builtin_amdgcn_exp2f(zz.x); e.y = __builtin_amdgcn_exp2f(zz.y);
    const f32x2 d = e * 256.0f + 256.0f;
    f32x2 r; r.x = __builtin_amdgcn_rcpf(d.x); r.y = __builtin_amdgcn_rcpf(d.y);
    return a * r;
}
__device__ __forceinline__ void gates_pk(f32x2 a, f32x2 b, f32x2& ratio, f32x2& gb) {
    const f32x2 za = a * (-3.5222047e-4f), zb = b * (-3.5222047e-4f);
    f32x2 ea, eb; ea.x = __builtin_amdgcn_exp2f(za.x); ea.y = __builtin_amdgcn_exp2f(za.y); eb.x = __builtin_amdgcn_exp2f(zb.x); eb.y = __builtin_amdgcn_exp2f(zb.y);
    const f32x2 da = ea + 1.0f, db2 = eb * 2.0f + 2.0f, dbs = eb * 0.00390625f + 0.00390625f;
    f32x2 ra; ra.x = __builtin_amdgcn_rcpf(da.x); ra.y = __builtin_amdgcn_rcpf(da.y);
    gb.x = __builtin_amdgcn_rcpf(dbs.x); gb.y = __builtin_amdgcn_rcpf(dbs.y);
    const f32x2 q = db2 * ra; ratio.x = __builtin_fminf(q.x, 448.0f); ratio.y = __builtin_fminf(q.y, 448.0f);
}

typedef unsigned u32x2 __attribute__((ext_vector_type(2)));
__device__ __forceinline__ float bflo(unsigned w) { return __uint_as_float(w << 16); }
__device__ __forceinline__ float bfhi(unsigned w) { return __uint_as_float(w & 0xffff0000u); }
typedef float f32x2q __attribute__((ext_vector_type(2)));
__device__ __forceinline__ f32x4 f8x4(unsigned w) { const f32x2q lo = __builtin_amdgcn_cvt_pk_f32_fp8((int)w, false), hi = __builtin_amdgcn_cvt_pk_f32_fp8((int)w, true); return (f32x4){lo[0], lo[1], hi[0], hi[1]}; }
__device__ __forceinline__ float gelu1(float v) {
    const float av = __builtin_fabsf(v), t = __builtin_amdgcn_rcpf(av * 0.2316418882f + 1.0f);
    float q = t * 0.5307027145f + (-0.7265760135f); q = q * t + 0.7107068705f; q = q * t + (-0.142248368f); q = q * t + 0.127414796f; q = q * t;
    const float e = __builtin_amdgcn_exp2f((v * v) * (-0.72134752044f));
    const float m = v * (q * e);
    return v < 0.f ? m : v - m;
}
__device__ __forceinline__ float sigm1(float v) { return __builtin_amdgcn_rcpf(1.0f + __builtin_amdgcn_exp2f(v * (-1.44269504089f))); }
__device__ __forceinline__ float silu1(float v) { return v * sigm1(v); }

__device__ __forceinline__ unsigned bperm(int idx, unsigned v) { return (unsigned)__builtin_amdgcn_ds_bpermute(idx, (int)v); }
__device__ __forceinline__ float bpermf(int idx, float v) { return __int_as_float(__builtin_amdgcn_ds_bpermute(idx, __float_as_int(v))); }
__device__ __forceinline__ f32x4 bperm4(int idx, const f32x4& v) { return (f32x4){bpermf(idx, v[0]), bpermf(idx, v[1]), bpermf(idx, v[2]), bpermf(idx, v[3])}; }
__device__ __forceinline__ u32x4 bperm4u(int idx, const u32x4& v) { u32x4 r; r.x = bperm(idx, v.x); r.y = bperm(idx, v.y); r.z = bperm(idx, v.z); r.w = bperm(idx, v.w); return r; }
#define PG8_REMAP() const int lane_ = 16 * fq + fr, pidx = (16 * (lane_ & 3) + (lane_ >> 2)) * 4, fr2 = lane_ >> 2, fq2 = lane_ & 3

struct EpiProj {
    static constexpr bool PERM = true, AFTER_DRAIN = false, HAS_MID = false;
    bf16_t *Q, *Kb, *V, *G, *U, *SV, *GA, *GB; const float *cosT, *sinT; float osc; float* svstat;
    __device__ __forceinline__ void operator()(const f32x4 (&acc)[2][2][4][2], const Unit& u, int wr, int wc, int fr, int fq) const {
        PG8_REMAP();
        const int colt = u.pn * BM; const int row0 = u.pm * BM + wr * 64 + fr2;
        if (colt < 1024) {
            const bool isk = colt >= 512; bf16_t* base = isk ? Kb : Q; const int lc0 = (colt & 511) + wc * 32 + 8 * fq2; const float sc = (isk ? 0.08838834764831845f * 128.0f : 16.0f) * osc;
            const int fi = wc * 16 + 4 * fq2;
#pragma unroll
            for (int ai = 0; ai < 2; ++ai) {
                f32x4 csv[4], snv[4];
#pragma unroll
                for (int m = 0; m < 4; ++m) { const int s = (row0 + ai * HALF + m * 16) & 4095; csv[m] = *(const f32x4*)(cosT + s * 64 + fi) * sc; snv[m] = *(const f32x4*)(sinT + s * 64 + fi) * sc; }
#pragma unroll
                for (int m = 0; m < 4; ++m) { const int row = row0 + ai * HALF + m * 16; const f32x4 cs = csv[m], sn = snv[m];
#pragma unroll
                    for (int bj = 0; bj < 2; ++bj) { const f32x4 v0 = bperm4(pidx, acc[ai][bj][m][0]), v1 = bperm4(pidx, acc[ai][bj][m][1]);
                        int t0 = __builtin_amdgcn_cvt_pk_fp8_f32(v0[0] * cs[0] - v0[1] * sn[0], v0[0] * sn[0] + v0[1] * cs[0], 0, false); t0 = __builtin_amdgcn_cvt_pk_fp8_f32(v0[2] * cs[1] - v0[3] * sn[1], v0[2] * sn[1] + v0[3] * cs[1], t0, true);
                        int t1 = __builtin_amdgcn_cvt_pk_fp8_f32(v1[0] * cs[2] - v1[1] * sn[2], v1[0] * sn[2] + v1[1] * cs[2], 0, false); t1 = __builtin_amdgcn_cvt_pk_fp8_f32(v1[2] * cs[3] - v1[3] * sn[3], v1[2] * sn[3] + v1[3] * cs[3], t1, true);
                        u32x2 w8; w8.x = (unsigned)t0; w8.y = (unsigned)t1;
                        *(u32x2*)((unsigned char*)base + (size_t)row * 512 + lc0 + bj * HALF) = w8; } } }
        } else if (colt < 5120) {
            const int seg = (colt - 1024) >> 10;
            bf16_t* base = V; if (seg == 1) base = G; asm volatile("" : "+s"(base)); if (seg == 2) base = U; asm volatile("" : "+s"(base)); if (seg == 3) base = SV;
            const int lc0 = ((colt - 1024) & 1023) + wc * 32 + 8 * fq2;
#pragma unroll
            for (int ai = 0; ai < 2; ++ai)
#pragma unroll
                for (int m = 0; m < 4; ++m) { const int row = row0 + ai * HALF + m * 16; float s1[2] = {0.f, 0.f}, s2[2] = {0.f, 0.f};
#pragma unroll
                    for (int bj = 0; bj < 2; ++bj) { const f32x4 r0 = acc[ai][bj][m][0], r1 = acc[ai][bj][m][1]; f32x2 a = {r0[0], r0[1]}, b = {r0[2], r0[3]}, c = {r1[0], r1[1]}, d = {r1[2], r1[3]};
                        if (seg == 0) { a = a * 0.00390625f; b = b * 0.00390625f; c = c * 0.00390625f; d = d * 0.00390625f; }
                        else if (seg == 1) { a = silu16_pk(a); b = silu16_pk(b); c = silu16_pk(c); d = silu16_pk(d); }
                        else { a = gelu16_pk(a); b = gelu16_pk(b); c = gelu16_pk(c); d = gelu16_pk(d); }
                        if (seg == 3) { const f32x2 t1 = (a + b) + (c + d), t2 = (a * a + b * b) + (c * c + d * d); s1[bj] = t1.x + t1.y; s2[bj] = t2.x + t2.y; }
                        int t0 = __builtin_amdgcn_cvt_pk_fp8_f32(a.x, a.y, 0, false); t0 = __builtin_amdgcn_cvt_pk_fp8_f32(b.x, b.y, t0, true);
                        int t1 = __builtin_amdgcn_cvt_pk_fp8_f32(c.x, c.y, 0, false); t1 = __builtin_amdgcn_cvt_pk_fp8_f32(d.x, d.y, t1, true);
                        u32x2 w8; w8.x = bperm(pidx, (unsigned)t0); w8.y = bperm(pidx, (unsigned)t1);
                        *(u32x2*)((unsigned char*)base + (size_t)row * 1024 + lc0 + bj * HALF) = w8; }
                    if (seg == 3) {
                        float a = (s1[0] + s1[1]) * 0.0625f, b = (s2[0] + s2[1]) * 0.00390625f;
                        a += __shfl_xor(a, 16); b += __shfl_xor(b, 16); a += __shfl_xor(a, 32); b += __shfl_xor(b, 32);
                        if (fq == 0) { float* sp = svstat + (size_t)(u.pm * BM + wr * 64 + fr + ai * HALF + m * 16) * 2; atomicAdd(sp, a); atomicAdd(sp + 1, b); } } }
        } else {
            const int lc0 = ((colt - 5120) >> 1) + wc * 32 + 8 * fq2;
#pragma unroll
            for (int ai = 0; ai < 2; ++ai)
#pragma unroll
                for (int m = 0; m < 4; ++m) { const int row = row0 + ai * HALF + m * 16; unsigned wr8[2], wg8[2];
#pragma unroll
                    for (int n = 0; n < 2; ++n) { const f32x4 ga = acc[ai][0][m][n], gb = acc[ai][1][m][n]; f32x2 q0, q1, g0, g1;
                        gates_pk((f32x2){ga[0], ga[1]}, (f32x2){gb[0], gb[1]}, q0, g0); gates_pk((f32x2){ga[2], ga[3]}, (f32x2){gb[2], gb[3]}, q1, g1);
                        int t0 = __builtin_amdgcn_cvt_pk_fp8_f32(q0.x, q0.y, 0, false); t0 = __builtin_amdgcn_cvt_pk_fp8_f32(q1.x, q1.y, t0, true);
                        int t1 = __builtin_amdgcn_cvt_pk_fp8_f32(g0.x, g0.y, 0, false); t1 = __builtin_amdgcn_cvt_pk_fp8_f32(g1.x, g1.y, t1, true);
                        wr8[n] = bperm(pidx, (unsigned)t0); wg8[n] = bperm(pidx, (unsigned)t1); }
                    u32x2 w8; w8.x = wr8[0]; w8.y = wr8[1]; *(u32x2*)((unsigned char*)GA + (size_t)row * 1024 + lc0) = w8;
                    w8.x = wg8[0]; w8.y = wg8[1]; *(u32x2*)((unsigned char*)GB + (size_t)row * 1024 + lc0) = w8; }
        }
    }
};
template <bool ACCUM> struct EpiGate {
    static constexpr bool PERM = true, AFTER_DRAIN = false, HAS_MID = false;
    const bf16_t* GT; bf16_t* TMP; unsigned char* OUT8; float osc;
    __device__ __forceinline__ void operator()(const f32x4 (&acc)[2][2][4][2], const Unit& u, int wr, int wc, int fr, int fq) const {
        PG8_REMAP();
        const int row0 = u.pm * BM + wr * 64 + fr2, col0 = u.pn * BM + wc * 32 + 8 * fq2;
#pragma unroll
        for (int ai = 0; ai < 2; ++ai)
#pragma unroll
            for (int mp = 0; mp < 2; ++mp) {
                u32x4 gv[2][2], pv[2][2];
#pragma unroll
                for (int mm = 0; mm < 2; ++mm)
#pragma unroll
                    for (int bj = 0; bj < 2; ++bj) { const size_t off = (size_t)(row0 + ai * HALF + (2 * mp + mm) * 16) * 1024 + col0 + bj * HALF;
                        gv[mm][bj] = *(const u32x4*)(GT + off); if (ACCUM) pv[mm][bj] = *(const u32x4*)(TMP + off); }
#pragma unroll
                for (int mm = 0; mm < 2; ++mm)
#pragma unroll
                    for (int bj = 0; bj < 2; ++bj) { const int m = 2 * mp + mm; const size_t off = (size_t)(row0 + ai * HALF + m * 16) * 1024 + col0 + bj * HALF;
                        const f32x4 v0 = bperm4(pidx, acc[ai][bj][m][0]) * osc, v1 = bperm4(pidx, acc[ai][bj][m][1]) * osc; const u32x4 g = gv[mm][bj];
                        float o[8] = {v0[0] * bflo(g.x), v0[1] * bfhi(g.x), v0[2] * bflo(g.y), v0[3] * bfhi(g.y), v1[0] * bflo(g.z), v1[1] * bfhi(g.z), v1[2] * bflo(g.w), v1[3] * bfhi(g.w)};
                        if (ACCUM) { const u32x4 p = pv[mm][bj];
                            o[0] += bflo(p.x); o[1] += bfhi(p.x); o[2] += bflo(p.y); o[3] += bfhi(p.y); o[4] += bflo(p.z); o[5] += bfhi(p.z); o[6] += bflo(p.w); o[7] += bfhi(p.w);
                            u32x2 w8; int t0 = __builtin_amdgcn_cvt_pk_fp8_f32(o[0] * 8.f, o[1] * 8.f, 0, false); t0 = __builtin_amdgcn_cvt_pk_fp8_f32(o[2] * 8.f, o[3] * 8.f, t0, true);
                            int t1 = __builtin_amdgcn_cvt_pk_fp8_f32(o[4] * 8.f, o[5] * 8.f, 0, false); t1 = __builtin_amdgcn_cvt_pk_fp8_f32(o[6] * 8.f, o[7] * 8.f, t1, true);
                            w8.x = (unsigned)t0; w8.y = (unsigned)t1; *(u32x2*)(OUT8 + off) = w8;
                        } else {
                            u32x4 w; w.x = cvt_pk_bf16(o[0], o[1]); w.y = cvt_pk_bf16(o[2], o[3]); w.z = cvt_pk_bf16(o[4], o[5]); w.w = cvt_pk_bf16(o[6], o[7]);
                            *(u32x4*)(TMP + off) = w; } }
            }
    }
};
struct EpiMerged {
    static constexpr bool PERM = true, AFTER_DRAIN = false, HAS_MID = true;
    const unsigned char* GA; const unsigned char* GB; unsigned char* OUT8; float osc;
    __device__ __forceinline__ void mid(f32x4 (&acc)[2][2][4][2], const Unit& u, int wr, int wc, int fr, int fq) const {
        int fr_ = fr, fq_ = fq; asm volatile("" : "+v"(fr_), "+v"(fq_));
        const int row0 = u.pm * BM + wr * 64 + fr_, col0 = u.pn * BM + wc * 32 + 8 * fq_;
        u32x2 ava[2][2][2][2];
#pragma unroll
        for (int ai = 0; ai < 2; ++ai)
#pragma unroll
            for (int mp = 0; mp < 2; ++mp)
#pragma unroll
                for (int mm = 0; mm < 2; ++mm)
#pragma unroll
                    for (int bj = 0; bj < 2; ++bj) ava[ai][mp][mm][bj] = *(const u32x2*)(GA + (size_t)(row0 + ai * HALF + (2 * mp + mm) * 16) * 1024 + col0 + bj * HALF);
#pragma unroll
        for (int ai = 0; ai < 2; ++ai)
#pragma unroll
            for (int mp = 0; mp < 2; ++mp)
#pragma unroll
                for (int mm = 0; mm < 2; ++mm)
#pragma unroll
                    for (int bj = 0; bj < 2; ++bj) { const int m = 2 * mp + mm; acc[ai][bj][m][0] *= f8x4(ava[ai][mp][mm][bj].x); acc[ai][bj][m][1] *= f8x4(ava[ai][mp][mm][bj].y); }
    }
    __device__ __forceinline__ void operator()(const f32x4 (&acc)[2][2][4][2], const Unit& u, int wr, int wc, int fr, int fq) const {
        PG8_REMAP();
        const int row0 = u.pm * BM + wr * 64 + fr2, col0 = u.pn * BM + wc * 32 + 8 * fq2; const float sc = osc * 8.f * (1.0f / 256.0f);
        u32x2 gva[2][2][2][2];
#pragma unroll
        for (int ai = 0; ai < 2; ++ai)
#pragma unroll
            for (int mp = 0; mp < 2; ++mp)
#pragma unroll
                for (int mm = 0; mm < 2; ++mm)
#pragma unroll
                    for (int bj = 0; bj < 2; ++bj) gva[ai][mp][mm][bj] = *(const u32x2*)(GB + (size_t)(row0 + ai * HALF + (2 * mp + mm) * 16) * 1024 + col0 + bj * HALF);
#pragma unroll
        for (int ai = 0; ai < 2; ++ai)
#pragma unroll
            for (int mp = 0; mp < 2; ++mp) {
#pragma unroll
                for (int mm = 0; mm < 2; ++mm)
#pragma unroll
                    for (int bj = 0; bj < 2; ++bj) { const int m = 2 * mp + mm; const size_t off = (size_t)(row0 + ai * HALF + m * 16) * 1024 + col0 + bj * HALF; const u32x2 (&gv)[2][2] = gva[ai][mp];
                        const f32x4 v0 = bperm4(pidx, acc[ai][bj][m][0]) * sc * f8x4(gv[mm][bj].x), v1 = bperm4(pidx, acc[ai][bj][m][1]) * sc * f8x4(gv[mm][bj].y);
                        u32x2 w8; int t0 = __builtin_amdgcn_cvt_pk_fp8_f32(v0[0], v0[1], 0, false); t0 = __builtin_amdgcn_cvt_pk_fp8_f32(v0[2], v0[3], t0, true);
                        int t1 = __builtin_amdgcn_cvt_pk_fp8_f32(v1[0], v1[1], 0, false); t1 = __builtin_amdgcn_cvt_pk_fp8_f32(v1[2], v1[3], t1, true);
                        w8.x = (unsigned)t0; w8.y = (unsigned)t1; *(u32x2*)(OUT8 + off) = w8; }
            }
    }
};
struct EpiX1 {
    static constexpr bool PERM = false, AFTER_DRAIN = false, HAS_MID = false;
    const float* X; const float* gate1; bf16_t* X1; float osc;
    __device__ __forceinline__ void operator()(const f32x4 (&acc)[2][2][4][2], const Unit& u, int wr, int wc, int fr, int fq) const {
        PG8_REMAP();
        const int row0 = u.pm * BM + wr * 64 + fr2, col0 = u.pn * BM + wc * 32 + 4 * fq2;
        const float* gp = gate1 + (size_t)((u.pm * BM) >> 12) * 6144 + col0;
        f32x4 gv[2][2];
#pragma unroll
        for (int bj = 0; bj < 2; ++bj)
#pragma unroll
            for (int n = 0; n < 2; ++n) gv[bj][n] = *(const f32x4*)(gp + bj * HALF + n * 16) * osc;
#pragma unroll
        for (int ai = 0; ai < 2; ++ai)
#pragma unroll
            for (int mp = 0; mp < 2; ++mp) {
                f32x4 xv[2][2][2];
#pragma unroll
                for (int mm = 0; mm < 2; ++mm) { const size_t off = (size_t)(row0 + ai * HALF + (2 * mp + mm) * 16) * 1024 + col0;
#pragma unroll
                    for (int bj = 0; bj < 2; ++bj)
#pragma unroll
                        for (int n = 0; n < 2; ++n) xv[mm][bj][n] = *(const f32x4*)(X + off + bj * HALF + n * 16); }
#pragma unroll
                for (int mm = 0; mm < 2; ++mm) { const int m = 2 * mp + mm; const size_t off = (size_t)(row0 + ai * HALF + m * 16) * 1024 + col0;
#pragma unroll
                    for (int bj = 0; bj < 2; ++bj)
#pragma unroll
                        for (int n = 0; n < 2; ++n) { const f32x4 x1 = xv[mm][bj][n] + gv[bj][n] * bperm4(pidx, acc[ai][bj][m][n]); u32x2 w; w.x = cvt_pk_bf16(x1[0], x1[1]); w.y = cvt_pk_bf16(x1[2], x1[3]); *(u32x2*)(X1 + off + bj * HALF + n * 16) = w; } }
            }
    }
};
typedef int v8i_t __attribute__((ext_vector_type(8)));
typedef int v4i_t __attribute__((ext_vector_type(4)));
typedef _Float16 h2_t __attribute__((ext_vector_type(2)));
__device__ __forceinline__ unsigned cvt_pk_f16(float lo, float hi) { const h2_t h = {(_Float16)lo, (_Float16)hi}; return __builtin_bit_cast(unsigned, h); }
struct EpiPlain {
    static constexpr bool PERM = true, AFTER_DRAIN = false, HAS_MID = false;
    bf16_t* O; int ldc; const float* rs; float cs;
    __device__ __forceinline__ void operator()(const f32x4 (&acc)[2][2][4][2], const Unit& u, int wr, int wc, int fr, int fq) const {
        PG8_REMAP();
        const int row0 = u.pm * BM + wr * 64 + fr2, col0 = u.pn * BM + wc * 32 + 8 * fq2;
#pragma unroll
        for (int ai = 0; ai < 2; ++ai)
#pragma unroll
            for (int m = 0; m < 4; ++m) { bf16_t* rowp = O + (size_t)(row0 + ai * HALF + m * 16) * ldc + col0; const float sc = rs[u.pm * BM + wr * 64 + fr + ai * HALF + m * 16] * cs;
#pragma unroll
                for (int bj = 0; bj < 2; ++bj) { const v4i_t i0 = __builtin_bit_cast(v4i_t, acc[ai][bj][m][0]), i1 = __builtin_bit_cast(v4i_t, acc[ai][bj][m][1]);
                    const f32x4 v0 = (f32x4){(float)i0[0], (float)i0[1], (float)i0[2], (float)i0[3]} * sc, v1 = (f32x4){(float)i1[0], (float)i1[1], (float)i1[2], (float)i1[3]} * sc;
                    u32x4 w; w.x = cvt_pk_f16(v0[0], v0[1]); w.y = cvt_pk_f16(v0[2], v0[3]); w.z = cvt_pk_f16(v1[0], v1[1]); w.w = cvt_pk_f16(v1[2], v1[3]);
                    *(u32x4*)(rowp + bj * HALF) = bperm4u(pidx, w); } }
    }
};
template <bool F8, bool I8 = false> __device__ __forceinline__ void mma_block(f32x4 (&acc)[4][2], const bf16x8 (&At)[4][2], const bf16x8 (&Bt)[2][2]) {
    if constexpr (I8) {
#pragma unroll
        for (int m = 0; m < 4; ++m)
#pragma unroll
            for (int n = 0; n < 2; ++n)
#pragma unroll
                for (int k = 0; k < 2; ++k) acc[m][n] = __builtin_bit_cast(f32x4, __builtin_amdgcn_mfma_i32_16x16x64_i8(__builtin_bit_cast(v4i_t, Bt[n][k]), __builtin_bit_cast(v4i_t, At[m][k]), __builtin_bit_cast(v4i_t, acc[m][n]), 0, 0, 0));
    } else if constexpr (F8) {
        v8i_t bb[2];
#pragma unroll
        for (int n = 0; n < 2; ++n) bb[n] = __builtin_shufflevector(__builtin_bit_cast(v4i_t, Bt[n][0]), __builtin_bit_cast(v4i_t, Bt[n][1]), 0, 1, 2, 3, 4, 5, 6, 7);
#pragma unroll
        for (int m = 0; m < 4; ++m) { const v8i_t aa = __builtin_shufflevector(__builtin_bit_cast(v4i_t, At[m][0]), __builtin_bit_cast(v4i_t, At[m][1]), 0, 1, 2, 3, 4, 5, 6, 7);
#pragma unroll
            for (int n = 0; n < 2; ++n) asm volatile("v_mfma_scale_f32_16x16x128_f8f6f4 %0, %1, %2, %0, %3, %3 op_sel_hi:[0,0,0]" : "+v"(acc[m][n]) : "v"(bb[n]), "v"(aa), "v"(0x7F7F7F7F)); }
    } else {
#pragma unroll
        for (int m = 0; m < 4; ++m)
#pragma unroll
            for (int n = 0; n < 2; ++n)
#pragma unroll
                for (int k = 0; k < 2; ++k) acc[m][n] = __builtin_amdgcn_mfma_f32_16x16x32_bf16(Bt[n][k], At[m][k], acc[m][n], 0, 0, 0);
    }
}
template <class Epi, class Sched, bool ALIGN_EPI = false, bool SP2 = false, bool F8 = false, bool I8 = false>
__device__ __forceinline__ void gemm_phase(PG8_LAS unsigned char* lds, const Gemm g, const Sched& S, const Epi& E) {
    const int tid = threadIdx.x, wid = __builtin_amdgcn_readfirstlane(tid >> 6), lane = tid & 63, wr = wid >> 2, wc = wid & 3, fr = lane & 15, fq = lane >> 4;
    const int K = g.K, nt = K / BK, LD = g.ld ? g.ld : g.K, nh = g.ksplit ? g.ksplit : nt;
    unsigned voffA[2], voffB[2];
#pragma unroll
    for (int i = 0; i < 2; ++i) { int R, C; stage_rc(tid * 16 + i * 8192, R, C); const int Rb = Epi::PERM ? ((R & ~31) + perm32(R & 31)) : R;
        voffA[i] = (unsigned)(R * LD + C) * 2u; voffB[i] = (unsigned)(Rb * LD + C) * 2u; }
    const size_t kstep = (size_t)(BK * 2);
    const size_t hstep = (size_t)HALF * LD * 2;
    const size_t tstep = 2 * hstep;
    const unsigned ldsw = (unsigned)wid * 1024u;
    const int aoff = lds_byte(wr * 64 + fr, fq * 8), boff = lds_byte(wc * 32 + fr, fq * 8);
#define PG8_SA(b, h) (((b) * 2 + (h)) * HTB)
#define PG8_SB(b, h) ((4 + (b) * 2 + (h)) * HTB)
#define PG8_STAGE(bufoff, gbase, voff) do { _Pragma("unroll") for (int _i = 0; _i < 2; ++_i) \
        __builtin_amdgcn_global_load_lds((const unsigned*)((const char*)(gbase) + (voff)[_i]), (PG8_LAS unsigned*)(lds + (bufoff) + ldsw + _i * 8192), 16, 0, 0); } while (0)
#define PG8_LDA(dst, b, h) do { _Pragma("unroll") for (int m = 0; m < 4; ++m) _Pragma("unroll") for (int k = 0; k < 2; ++k) dst[m][k] = *(const PG8_LAS bf16x8*)(lds + PG8_SA(b, h) + aoff + m * 2048 + k * 1024); } while (0)
#define PG8_LDB(dst, b, h) do { _Pragma("unroll") for (int n = 0; n < 2; ++n) _Pragma("unroll") for (int k = 0; k < 2; ++k) dst[n][k] = *(const PG8_LAS bf16x8*)(lds + PG8_SB(b, h) + boff + n * 2048 + k * 1024); } while (0)
#define PG8_MMA(ai, bj, At, Bt) do { __builtin_amdgcn_s_setprio(1); mma_block<F8, I8>(acc[ai][bj], At, Bt); __builtin_amdgcn_s_setprio(0); } while (0)
#define PG8_WAIT_V(n) asm volatile("s_waitcnt vmcnt(" #n ")" ::: "memory")
#define PG8_WAIT_L(n) asm volatile("s_waitcnt lgkmcnt(" #n ")" ::: "memory")
#define PG8_BAR __builtin_amdgcn_s_barrier()
#define PG8_SCHED __builtin_amdgcn_sched_barrier(0)
    Unit cur, nxt; int ui = 0;
#if MK_GPROBE
    unsigned long long gp_k = 0, gp_e = 0, gp_t = __builtin_amdgcn_s_memrealtime();
#endif
    if (!S.next(0, cur)) return;
    f32x4 acc[2][2][4][2];
#pragma unroll
    for (int a = 0; a < 2; ++a)
#pragma unroll
        for (int b = 0; b < 2; ++b)
#pragma unroll
            for (int m = 0; m < 4; ++m)
#pragma unroll
                for (int n = 0; n < 2; ++n) acc[a][b][m][n] = (f32x4){0.f, 0.f, 0.f, 0.f};
    bf16x8 At[4][2], B0[2][2], B1[2][2];
    const char* cA = (const char*)g.A + (size_t)cur.pm * tstep; const char* cB = (const char*)g.Bt + (size_t)cur.pn * tstep;
    const char* cA2 = g.A2 ? (const char*)g.A2 + (size_t)cur.pm * tstep : cA; const char* cB2 = g.Bt2 ? (const char*)g.Bt2 + (size_t)cur.pn * tstep : cB;
#define PG8_TA(tt) ((tt) < nh ? cA + (size_t)(tt) * kstep : cA2 + (size_t)((tt) - nh) * kstep)
#define PG8_TB(tt) ((tt) < nh ? cB + (size_t)(tt) * kstep : cB2 + (size_t)((tt) - nh) * kstep)
    S.a_ready(cur);
    if constexpr (SP2) {
        PG8_STAGE(PG8_SB(0, 0), cB, voffB); PG8_STAGE(PG8_SB(0, 1), cB + hstep, voffB); PG8_STAGE(PG8_SA(0, 0), cA, voffA); PG8_STAGE(PG8_SA(0, 1), cA + hstep, voffA);
        if (wr == 1) PG8_BAR;
        PG8_WAIT_V(2); PG8_BAR;
        PG8_STAGE(PG8_SB(1, 0), cB + kstep, voffB); PG8_STAGE(PG8_SA(1, 0), cA + kstep, voffA); PG8_STAGE(PG8_SB(1, 1), cB + hstep + kstep, voffB);
        PG8_WAIT_V(6); PG8_BAR;
    } else {
        PG8_STAGE(PG8_SB(0, 0), cB, voffB); PG8_STAGE(PG8_SA(0, 0), cA, voffA); PG8_STAGE(PG8_SB(0, 1), cB + hstep, voffB); PG8_STAGE(PG8_SA(0, 1), cA + hstep, voffA);
        if (wr == 1) PG8_BAR;
        PG8_WAIT_V(4); PG8_BAR;
        PG8_STAGE(PG8_SB(1, 0), cB + kstep, voffB); PG8_STAGE(PG8_SA(1, 0), cA + kstep, voffA); PG8_STAGE(PG8_SB(1, 1), cB + hstep + kstep, voffB);
        PG8_WAIT_V(6); PG8_BAR;
    }
    for (;;) {
        const bool has_next = S.next(ui + 1, nxt);
        const char* nA = has_next ? (const char*)g.A + (size_t)nxt.pm * tstep : cA; const char* nB = has_next ? (const char*)g.Bt + (size_t)nxt.pn * tstep : cB;
#pragma clang loop unroll(disable)
        for (int t = 0; t < nt; t += 2) {
            const bool last = (t == nt - 2);
            const char* a1 = PG8_TA(t + 1);
            const char* a2 = last ? nA : PG8_TA(t + 2); const char* b2 = last ? nB : PG8_TB(t + 2);
            const char* a3 = last ? nA + kstep : PG8_TA(t + 3); const char* b3 = last ? nB + kstep : PG8_TB(t + 3);
            if constexpr (Epi::HAS_MID) { if (t == nh) { if constexpr (F8) asm volatile("s_nop 15\n\ts_nop 15" ::: "memory"); E.mid(acc, cur, wr, wc, fr, fq); } }
            if (last && has_next) S.a_ready(nxt);
            if constexpr (SP2) {
            PG8_LDB(B0, 0, 0); PG8_LDB(B1, 0, 1); PG8_SCHED; PG8_LDA(At, 0, 0); PG8_STAGE(PG8_SA(1, 1), a1 + hstep, voffA);
            PG8_WAIT_V(8); PG8_WAIT_L(0); PG8_BAR; PG8_MMA(0, 0, At, B0); PG8_MMA(0, 1, At, B1); PG8_BAR; PG8_SCHED;
            PG8_LDA(At, 0, 1); PG8_STAGE(PG8_SB(0, 0), b2, voffB); PG8_STAGE(PG8_SB(0, 1), b2 + hstep, voffB); PG8_STAGE(PG8_SA(0, 0), a2, voffA);
            PG8_WAIT_V(8); PG8_WAIT_L(0); PG8_BAR; PG8_MMA(1, 0, At, B0); PG8_MMA(1, 1, At, B1); PG8_BAR; PG8_SCHED;
            PG8_LDB(B0, 1, 0); PG8_LDB(B1, 1, 1); PG8_SCHED; PG8_LDA(At, 1, 0); PG8_STAGE(PG8_SA(0, 1), a2 + hstep, voffA);
            PG8_WAIT_V(8); PG8_WAIT_L(0); PG8_BAR; PG8_MMA(0, 0, At, B0); PG8_MMA(0, 1, At, B1); PG8_BAR; PG8_SCHED;
            PG8_LDA(At, 1, 1); PG8_STAGE(PG8_SB(1, 0), b3, voffB); PG8_STAGE(PG8_SB(1, 1), b3 + hstep, voffB); PG8_STAGE(PG8_SA(1, 0), a3, voffA);
            PG8_WAIT_V(8); PG8_WAIT_L(0); PG8_BAR; PG8_MMA(1, 0, At, B0); PG8_MMA(1, 1, At, B1); PG8_BAR; PG8_SCHED;
            } else {
            PG8_LDB(B0, 0, 0); PG8_SCHED; PG8_LDA(At, 0, 0); PG8_STAGE(PG8_SA(1, 1), a1 + hstep, voffA);
            PG8_WAIT_L(8); PG8_BAR; PG8_WAIT_L(0); PG8_MMA(0, 0, At, B0); PG8_BAR; PG8_SCHED;
            PG8_LDB(B1, 0, 1); PG8_STAGE(PG8_SB(0, 0), b2, voffB);
            PG8_BAR; PG8_WAIT_L(0); PG8_MMA(0, 1, At, B1); PG8_BAR;
            PG8_LDA(At, 0, 1); PG8_STAGE(PG8_SA(0, 0), a2, voffA);
            PG8_BAR; PG8_WAIT_L(0); PG8_MMA(1, 0, At, B0); PG8_BAR; PG8_SCHED;
            PG8_STAGE(PG8_SB(0, 1), b2 + hstep, voffB);
            PG8_WAIT_V(6); PG8_BAR; PG8_MMA(1, 1, At, B1); PG8_BAR;
            PG8_LDB(B0, 1, 0); PG8_SCHED; PG8_LDA(At, 1, 0); PG8_STAGE(PG8_SA(0, 1), a2 + hstep, voffA);
            PG8_WAIT_L(8); PG8_BAR; PG8_WAIT_L(0); PG8_MMA(0, 0, At, B0); PG8_BAR; PG8_SCHED;
            PG8_LDB(B1, 1, 1); PG8_STAGE(PG8_SB(1, 0), b3, voffB);
            PG8_BAR; PG8_WAIT_L(0); PG8_MMA(0, 1, At, B1); PG8_BAR;
            PG8_LDA(At, 1, 1); PG8_STAGE(PG8_SA(1, 0), a3, voffA);
            PG8_BAR; PG8_WAIT_L(0); PG8_MMA(1, 0, At, B0); PG8_BAR; PG8_SCHED;
            PG8_STAGE(PG8_SB(1, 1), b3 + hstep, voffB);
            PG8_WAIT_V(6); PG8_BAR; PG8_MMA(1, 1, At, B1); PG8_BAR;
            }
        }
#if MK_GPROBE
        { const unsigned long long t_ = __builtin_amdgcn_s_memrealtime(); gp_k += t_ - gp_t; gp_t = t_; }
#endif
        if constexpr (F8) asm volatile("s_nop 15\n\ts_nop 15" ::: "memory");
        if constexpr (ALIGN_EPI) { if (wr == 0) PG8_BAR; }
        if constexpr (!Epi::AFTER_DRAIN) { E(acc, cur, wr, wc, fr, fq); S.done(cur); }
#if MK_GPROBE
        { asm volatile("s_waitcnt vmcnt(0)" ::: "memory"); const unsigned long long t_ = __builtin_amdgcn_s_memrealtime(); gp_e += t_ - gp_t; gp_t = t_; }
#endif
        if (!has_next) break;
#pragma unroll
        for (int a = 0; a < 2; ++a)
#pragma unroll
            for (int b = 0; b < 2; ++b)
#pragma unroll
                for (int m = 0; m < 4; ++m)
#pragma unroll
                    for (int n = 0; n < 2; ++n) acc[a][b][m][n] = (f32x4){0.f, 0.f, 0.f, 0.f};
        cur = nxt; cA = nA; cB = nB; ++ui;
        cA2 = g.A2 ? (const char*)g.A2 + (size_t)cur.pm * tstep : cA; cB2 = g.Bt2 ? (const char*)g.Bt2 + (size_t)cur.pn * tstep : cB;
        if constexpr (ALIGN_EPI) { if (wr == 1) PG8_BAR; }
    }
    PG8_WAIT_V(0);
    if constexpr (!ALIGN_EPI) { if (wr == 0) PG8_BAR; }
    PG8_BAR;
    if constexpr (Epi::AFTER_DRAIN) { E.fused(acc, cur, wr, wc, fr, fq, lds, wid, lane); S.done(cur); }
#if MK_GPROBE
    if (blockIdx.x == 0 && wid == 0 && lane == 0) { PG8_LAS unsigned* mq = (PG8_LAS unsigned*)(lds + MK_MISC_OFF); mq[56] += (unsigned)gp_k; mq[57] += (unsigned)gp_e; }
#endif
#undef PG8_SA
#undef PG8_SB
#undef PG8_TA
#undef PG8_TB
#undef PG8_STAGE
#undef PG8_LDA
#undef PG8_LDB
#undef PG8_MMA
#undef PG8_WAIT_V
#undef PG8_WAIT_L
#undef PG8_BAR
#undef PG8_SCHED
}
}

constexpr int NWAVES = 8;
constexpr int N_LAUNCHES = MK_N_LAUNCHES;
constexpr int N_PHASES = 16;
constexpr int NB = 8, SEQ = 4096, DM = 1024, MT = NB * SEQ, NIN = 7168;
constexpr float EPSN = 1e-6f;

constexpr size_t MiB = 1u << 20;
constexpr size_t WS_CTL = 0, CTL_ZERO_BYTES = 1 * MiB;
constexpr size_t WS_SVSTAT = 512 * 1024;
constexpr size_t WS_MOD = 1 * MiB;
constexpr size_t WS_COS = 2 * MiB, WS_SIN = 3 * MiB;
constexpr size_t WS_RS = 4 * MiB;
constexpr size_t WS_SGUW = 4 * MiB + 512 * 1024;
constexpr size_t WS_WRET = 6 * MiB, WS_WSGU = 8 * MiB, WS_WOUT = 10 * MiB, WS_WQ = 12 * MiB, WS_WIN = 16 * MiB;
constexpr size_t WS_EID = 24 * MiB;
constexpr size_t WS_UE8 = 32 * MiB, WS_VE8 = 48 * MiB;
constexpr size_t WS_V = 64 * MiB, WS_MRG8 = 64 * MiB;
constexpr size_t WS_G = 96 * MiB, WS_PD = 96 * MiB;
constexpr size_t WS_U = 128 * MiB;
constexpr size_t WS_SV = 160 * MiB, WS_YG8 = 160 * MiB, WS_ACT = 160 * MiB;
constexpr size_t WS_GA = 192 * MiB, WS_GB = 224 * MiB;
constexpr size_t WS_YS8 = 256 * MiB;
constexpr size_t WS_X1B = 288 * MiB;
constexpr size_t WS_SC = 352 * MiB, WS_PEERS = 352 * MiB;
constexpr size_t WS_GW = 480 * MiB;
constexpr size_t WS_SUB = 496 * MiB;
constexpr size_t WS_END = 512 * MiB;
constexpr size_t DO_H = 0, DO_KVS = 0, DO_H2F8 = 32 * MiB, DO_Q = 64 * MiB, DO_K = 96 * MiB;

constexpr int CW_BAR = 4096;
constexpr int LDS_BYTES = 147456;
constexpr int MISC_OFF = LDS_BYTES - 256;

#define GAS __attribute__((address_space(1)))
#define LAS __attribute__((address_space(3)))
typedef unsigned short bf16;
typedef unsigned v4u __attribute__((ext_vector_type(4)));
typedef unsigned v2u __attribute__((ext_vector_type(2)));
typedef float f32x4 __attribute__((ext_vector_type(4)));
typedef float f32x2v __attribute__((ext_vector_type(2)));
typedef short bf16x8 __attribute__((ext_vector_type(8)));
typedef short s16x4 __attribute__((ext_vector_type(4)));
typedef __bf16 bf16x2_t __attribute__((ext_vector_type(2)));
typedef GAS unsigned gu32;
#define RLX_AGENT __ATOMIC_RELAXED, __HIP_MEMORY_SCOPE_AGENT
#define LDS_WAIT() asm volatile("s_waitcnt lgkmcnt(0)" ::: "memory")
using pg8::bflo; using pg8::bfhi; using pg8::gelu1;
__device__ __forceinline__ unsigned pk2(float lo, float hi) { f32x2v v = {lo, hi}; bf16x2_t b = __builtin_convertvector(v, bf16x2_t); return __builtin_bit_cast(unsigned, b); }
template <int CTRL> __device__ __forceinline__ float dpp_f(float v) { return __int_as_float(__builtin_amdgcn_update_dpp(0, __float_as_int(v), CTRL, 0xF, 0xF, false)); }
__device__ __forceinline__ float wave_sum(float v) {
    v += dpp_f<0xB1>(v); v += dpp_f<0x4E>(v); v += dpp_f<0x141>(v); v += dpp_f<0x140>(v);
    const int vi = __float_as_int(v);
    return (__int_as_float(__builtin_amdgcn_readlane(vi, 0)) + __int_as_float(__builtin_amdgcn_readlane(vi, 16))) + (__int_as_float(__builtin_amdgcn_readlane(vi, 32)) + __int_as_float(__builtin_amdgcn_readlane(vi, 48)));
}
__device__ __forceinline__ float fexp2(float x) { return __builtin_amdgcn_exp2f(x); }
__device__ __forceinline__ int xr_unit(int L) { return ((L & 7) << 7) | (L >> 3); }
__device__ __forceinline__ int xr_row(int L) { return (((L >> 3) & 7) << 12) | ((L >> 6) << 3) | (L & 7); }
__device__ __forceinline__ int xr_scan(int L) { return (((L >> 9) & 7) << 14) | ((L >> 12) << 9) | (L & 511); }
__device__ __forceinline__ float clamp_f8(float x) { return __builtin_amdgcn_fmed3f(x, -448.0f, 448.0f); }
__device__ __forceinline__ unsigned pk4_fp8(float a, float b, float c, float d) { int w = __builtin_amdgcn_cvt_pk_fp8_f32(clamp_f8(a), clamp_f8(b), 0, false); w = __builtin_amdgcn_cvt_pk_fp8_f32(clamp_f8(c), clamp_f8(d), w, true); return (unsigned)w; }
constexpr float WQ_SCALE = 1042.0f;
__device__ __forceinline__ unsigned pk4_i8(float a, float b, float c, float d) {
    const int ia = (int)__builtin_rintf(__builtin_amdgcn_fmed3f(a, -127.f, 127.f)), ib = (int)__builtin_rintf(__builtin_amdgcn_fmed3f(b, -127.f, 127.f)), ic = (int)__builtin_rintf(__builtin_amdgcn_fmed3f(c, -127.f, 127.f)), id = (int)__builtin_rintf(__builtin_amdgcn_fmed3f(d, -127.f, 127.f));
    return ((unsigned)ia & 255u) | (((unsigned)ib & 255u) << 8) | (((unsigned)ic & 255u) << 16) | ((unsigned)id << 24);
}
__device__ __forceinline__ float wave_max(float v) {
    v = __builtin_fmaxf(v, dpp_f<0xB1>(v)); v = __builtin_fmaxf(v, dpp_f<0x4E>(v)); v = __builtin_fmaxf(v, dpp_f<0x141>(v)); v = __builtin_fmaxf(v, dpp_f<0x140>(v));
    const int vi = __float_as_int(v);
    return __builtin_fmaxf(__builtin_fmaxf(__int_as_float(__builtin_amdgcn_readlane(vi, 0)), __int_as_float(__builtin_amdgcn_readlane(vi, 16))), __builtin_fmaxf(__int_as_float(__builtin_amdgcn_readlane(vi, 32)), __int_as_float(__builtin_amdgcn_readlane(vi, 48))));
}
__device__ __forceinline__ float rl_f(float v, int l) { return __int_as_float(__builtin_amdgcn_readlane(__float_as_int(v), l)); }
__device__ __forceinline__ unsigned rl_u(unsigned v, int l) { return (unsigned)__builtin_amdgcn_readlane((int)v, l); }

#define XB_TMO      128
#define XB_XCNT(j)  (256  + 64 * (j))
#define XB_XSUB(j)  (1280 + 64 * (j))
#define XB_XGEN(j)  (2304 + 64 * (j))
#define XB_TOP      3328
#define XB_TOPGEN   3392
#define XB_LSUB(j)  (3456 + 64 * (j))
#define XCD_BAR_WORDS 4480
#define XB_SPIN_CAP (1u << 22)
__device__ __forceinline__ unsigned xb_ld(unsigned* p)              { return __hip_atomic_load(p, __ATOMIC_RELAXED, __HIP_MEMORY_SCOPE_AGENT); }
__device__ __forceinline__ unsigned xb_add(unsigned* p, unsigned v) { return __hip_atomic_fetch_add(p, v, __ATOMIC_RELAXED, __HIP_MEMORY_SCOPE_AGENT); }
__device__ __forceinline__ unsigned xb_xcc_id() { return (unsigned)__builtin_amdgcn_s_getreg((3 << 11) | 20) & 0xFu; }
#define XB_SPIN(cond, bar) do { unsigned _sp = 0; while (cond) { __builtin_amdgcn_s_sleep(1); \
    if ((++_sp & 255u) == 0u) { if (xb_ld(&(bar)[XB_TMO])) break; if (_sp > XB_SPIN_CAP) { atomicAdd(&(bar)[XB_TMO], 1u); break; } } } } while (0)
struct XcdBarrier { unsigned* bar; unsigned x; volatile LAS unsigned* st; };
__device__ __forceinline__ XcdBarrier xcd_barrier_post(unsigned* bar, volatile LAS unsigned* st) {
    XcdBarrier b; b.bar = bar; b.x = xb_xcc_id(); b.st = st;
    if (threadIdx.x == 0) st[2] = xb_add(&bar[XB_XCNT(b.x)], 1u);
    return b;
}
__device__ __forceinline__ void xcd_barrier_complete(unsigned* bar, unsigned x, unsigned& nloc, unsigned& nx, unsigned& slot, unsigned& even) {
    const unsigned G = gridDim.x * gridDim.y * gridDim.z;
    unsigned sum, cnt, mine, sl, ev, sp = 0u;
    for (;;) {
        sum = 0u; cnt = 0u; mine = 0u; sl = 0u; ev = 1u;
#pragma unroll
        for (unsigned j = 0; j < 16; ++j) { const unsigned c = xb_ld(&bar[XB_XCNT(j)]); sum += c; cnt += (c > 0u) ? 1u : 0u; mine = (j == x) ? c : mine; sl += (j < x && c > 0u) ? 1u : 0u; ev &= (c == 0u || c * 8u == G) ? 1u : 0u; }
        if (sum == G) break;
        __builtin_amdgcn_s_sleep(1);
        if ((++sp & 255u) == 0u) { if (xb_ld(&bar[XB_TMO])) break; if (sp > XB_SPIN_CAP) { atomicAdd(&bar[XB_TMO], 1u); break; } }
    }
    nloc = mine > 0u ? mine : 1u; nx = cnt > 0u ? cnt : 1u; slot = sl; even = (sum == G && cnt == 8u) ? ev : 0u;
}
__device__ __forceinline__ void xcd_barrier(const XcdBarrier& b) {
    asm volatile("s_waitcnt vmcnt(0)" ::: "memory");
    __syncthreads();
    if (threadIdx.x == 0) {
        unsigned* bar = b.bar;
        __builtin_amdgcn_s_waitcnt(0);
        unsigned nloc = b.st[0], nx = b.st[1];
        if (nloc == 0u) { unsigned slot, even; xcd_barrier_complete(bar, b.x, nloc, nx, slot, even); b.st[0] = nloc; b.st[1] = nx; b.st[3] = even ? (b.st[2] * 8u + slot + 1u) : 0u; }
        const unsigned old = xb_add(&bar[XB_XSUB(b.x)], 1u);
        const unsigned gen = old / nloc;
        if (old + 1u == (gen + 1u) * nloc) {
            __builtin_amdgcn_fence(__ATOMIC_RELEASE, "agent");
            asm volatile("s_waitcnt vmcnt(0)" ::: "memory");
            (void)xb_add(&bar[XB_TOP], 1u);
        }
        __builtin_amdgcn_fence(__ATOMIC_ACQUIRE, "agent");
        XB_SPIN(xb_ld(&bar[XB_TOP]) < (gen + 1u) * nx, bar);
        asm volatile("s_waitcnt vmcnt(0)" ::: "memory");
    }
    __syncthreads();
}

__device__ __forceinline__ void xcd_local_barrier(const XcdBarrier& b, unsigned& lgen) {
    asm volatile("s_waitcnt vmcnt(0)" ::: "memory");
    __syncthreads();
    if (threadIdx.x == 0) {
        unsigned* bar = b.bar;
        __builtin_amdgcn_s_waitcnt(0);
        const unsigned nloc = b.st[0];
        (void)xb_add(&bar[XB_LSUB(b.x)], 1u);
        __builtin_amdgcn_fence(__ATOMIC_ACQUIRE, "agent");
        XB_SPIN(xb_ld(&bar[XB_LSUB(b.x)]) < (lgen + 1u) * nloc, bar);
        asm volatile("s_waitcnt vmcnt(0)" ::: "memory");
    }
    ++lgen;
    __syncthreads();
}

struct Frame {
    LAS unsigned char* lds;
    int tid, lane, wave, G, bid; volatile LAS unsigned* misc;
    __device__ __forceinline__ void fence_ids() { int t = threadIdx.x; asm volatile("" : "+v"(t)); tid = t; lane = t & 63; }
    const float *x, *c, *w_ada, *b_ada, *norm1_g, *w_in, *ret_gn_g, *sgu_ln_g, *sgu_ln_b, *sgu_w, *sgu_b, *w_ret_out, *w_sgu_out, *w_out, *norm2_g, *peer_w_q, *peer_sub_keys, *peer_u, *peer_v, *final_g;
    unsigned char* ws; unsigned char* dout;
};

__device__ __forceinline__ bf16x8 lds_row_frag(LAS const unsigned char* img, int stride, int r0, int k0, int lane) {
    return *(LAS const bf16x8*)(img + (r0 + (lane & 15)) * stride + (k0 + 8 * (lane >> 4)) * 2);
}
__device__ __forceinline__ s16x4 tr16(LAS const unsigned char* p) { return __builtin_bit_cast(s16x4, __builtin_amdgcn_ds_read_tr16_b64_v4i16((LAS s16x4*)p)); }
__device__ __forceinline__ bf16x8 lds_tr_frag(LAS const unsigned char* img, int stride, int k0, int n0, int lane) {
    const int g = lane >> 4, q = (lane >> 2) & 3, p = lane & 3;
    LAS const unsigned char* a = img + (k0 + 8 * g + q) * stride + (n0 + 4 * p) * 2;
    const s16x4 lo = tr16(a), hi = tr16(a + 4 * stride);
    return __builtin_shufflevector(lo, hi, 0, 1, 2, 3, 4, 5, 6, 7);
}
#define MFMA16(a, b, c) __builtin_amdgcn_mfma_f32_16x16x32_bf16((a), (b), (c), 0, 0, 0)
constexpr int KS = 272, VS = 528;

template <bool F8, class Map>
__device__ __forceinline__ void transpose_item(const float* W, int K, int N, bf16* WT, LAS float* scr, int item, int lane, Map srcmap) {
    const int nblk = N / 32, kb = item / nblk, nb = item % nblk, k0 = 64 * kb, n0 = 32 * nb;
    const int sc = srcmap(n0 + (lane & 31));
    float tw[32];
#pragma unroll
    for (int i = 0; i < 32; ++i) tw[i] = W[(size_t)(k0 + 2 * i + (lane >> 5)) * N + sc];
#pragma unroll
    for (int i = 0; i < 32; ++i) scr[(2 * i + (lane >> 5)) * 33 + (lane & 31)] = tw[i];
    LDS_WAIT(); asm volatile("" ::: "memory");
    const int c = lane & 7;
#pragma unroll
    for (int j = 0; j < 4; ++j) { const int n = (lane >> 3) + 8 * j; const LAS float* s = scr + (8 * c) * 33 + n;
        if (F8) { v2u o8; o8.x = pk4_fp8(s[0 * 33] * 512.f, s[1 * 33] * 512.f, s[2 * 33] * 512.f, s[3 * 33] * 512.f); o8.y = pk4_fp8(s[4 * 33] * 512.f, s[5 * 33] * 512.f, s[6 * 33] * 512.f, s[7 * 33] * 512.f);
            *(v2u*)((unsigned char*)WT + (size_t)(n0 + n) * K + k0 + 8 * c) = o8; }
        else { v4u o; o.x = pk2(s[0 * 33], s[1 * 33]); o.y = pk2(s[2 * 33], s[3 * 33]); o.z = pk2(s[4 * 33], s[5 * 33]); o.w = pk2(s[6 * 33], s[7 * 33]);
            *(v4u*)(WT + (size_t)(n0 + n) * K + k0 + 8 * c) = o; } }
    LDS_WAIT(); asm volatile("" ::: "memory");
}
struct MapId { __device__ __forceinline__ int operator()(int n) const { return n; } };
struct MapWin { __device__ __forceinline__ int operator()(int n) const { if (n >= 5120) { const int w = n - 5120; return 5120 + ((w >> 7) & 1) * 1024 + (w >> 8) * 128 + (w & 127); } if (n >= 1024) return n; const int ci = n & 127; return (n & ~127) + (ci >> 1) + 64 * (ci & 1); } };

__device__ __forceinline__ void cvt8(const float* src, bf16* dst, size_t chunk) {
    const f32x4 a = *(const f32x4*)(src + chunk * 8), b = *(const f32x4*)(src + chunk * 8 + 4);
    v4u o; o.x = pk2(a[0], a[1]); o.y = pk2(a[2], a[3]); o.z = pk2(b[0], b[1]); o.w = pk2(b[2], b[3]);
    *(v4u*)(dst + chunk * 8) = o;
}

struct TabRegs { f32x4 q[4]; };
__device__ __forceinline__ void tab_load(const float* src, size_t ch, TabRegs& R) {
#pragma unroll
    for (int i = 0; i < 4; ++i) R.q[i] = *((const f32x4*)(src + ch * 16) + i);
}
__device__ __forceinline__ void tab_store_v(Frame& F, size_t ch, const TabRegs& R) {
    v4u ov;
#pragma unroll
    for (int q = 0; q < 4; ++q) { const f32x4 b = R.q[q] * 16.0f; ov[q] = pk4_fp8(b[0], b[1], b[2], b[3]); }
    const size_t e_ = ch >> 6, c16_ = ch & 63;
    *(v4u*)(F.ws + WS_VE8 + (c16_ >> 3) * ((size_t)16384 * 128) + e_ * 128 + (c16_ & 7) * 16) = ov;
}
__device__ __forceinline__ void tab_store_u(Frame& F, size_t ch, const TabRegs& R) {
    unsigned w0 = 0u, w1 = 0u;
    const f32x4 a0 = R.q[0] * 64.0f, a1 = R.q[1] * 64.0f, a2 = R.q[2] * 64.0f, a3 = R.q[3] * 64.0f;
    w0 = __builtin_amdgcn_cvt_scalef32_pk_fp4_f32(w0, a0[0], a0[1], 1.0f, 0); w0 = __builtin_amdgcn_cvt_scalef32_pk_fp4_f32(w0, a0[2], a0[3], 1.0f, 1);
    w0 = __builtin_amdgcn_cvt_scalef32_pk_fp4_f32(w0, a1[0], a1[1], 1.0f, 2); w0 = __builtin_amdgcn_cvt_scalef32_pk_fp4_f32(w0, a1[2], a1[3], 1.0f, 3);
    w1 = __builtin_amdgcn_cvt_scalef32_pk_fp4_f32(w1, a2[0], a2[1], 1.0f, 0); w1 = __builtin_amdgcn_cvt_scalef32_pk_fp4_f32(w1, a2[2], a2[3], 1.0f, 1);
    w1 = __builtin_amdgcn_cvt_scalef32_pk_fp4_f32(w1, a3[0], a3[1], 1.0f, 2); w1 = __builtin_amdgcn_cvt_scalef32_pk_fp4_f32(w1, a3[2], a3[3], 1.0f, 3);
    v2u o4; o4.x = w0; o4.y = w1;
    const size_t e_ = ch >> 6, c16_ = ch & 63;
    *(v2u*)(F.ws + WS_UE8 + (c16_ >> 4) * ((size_t)16384 * 128) + e_ * 128 + (c16_ & 15) * 8) = o4;
}
__device__ __forceinline__ void wprime_unit(Frame& F, int u) {
    const int hp = u >> 3, k0 = (u & 7) * 128, lane = F.lane, w = F.wave;
    LAS unsigned char* Aimg = F.lds; LAS unsigned char* Bimg = F.lds + 34816;
#pragma unroll
    for (int i = 0; i < 4; ++i) { const int ch = F.tid + 512 * i, r = ch >> 4, cc = ch & 15;
        const float* ap = F.peer_w_q + (size_t)(k0 + r) * 2048 + hp * 128 + cc * 8; const float* bp = F.peer_sub_keys + (size_t)hp * 16384 + r * 128 + cc * 8;
        const f32x4 a0 = *(const f32x4*)ap, a1 = *(const f32x4*)(ap + 4), b0 = *(const f32x4*)bp, b1 = *(const f32x4*)(bp + 4);
        v4u oa, ob; oa.x = pk2(a0[0], a0[1]); oa.y = pk2(a0[2], a0[3]); oa.z = pk2(a1[0], a1[1]); oa.w = pk2(a1[2], a1[3]); ob.x = pk2(b0[0], b0[1]); ob.y = pk2(b0[2], b0[3]); ob.z = pk2(b1[0], b1[1]); ob.w = pk2(b1[2], b1[3]);
        *(LAS v4u*)(Aimg + r * KS + cc * 16) = oa; *(LAS v4u*)(Bimg + r * KS + cc * 16) = ob; }
    __syncthreads();
    f32x4 acc[8];
#pragma unroll
    for (int nt = 0; nt < 8; ++nt) acc[nt] = (f32x4){0.f, 0.f, 0.f, 0.f};
#pragma unroll
    for (int ks = 0; ks < 4; ++ks) { const bf16x8 a = lds_row_frag(Aimg, KS, 16 * w, 32 * ks, lane);
#pragma unroll
        for (int nt = 0; nt < 8; ++nt) { const bf16x8 bb = lds_row_frag(Bimg, KS, 16 * nt, 32 * ks, lane); acc[nt] = MFMA16(a, bb, acc[nt]); } }
    unsigned char* WT = F.ws + WS_WQ;
#pragma unroll
    for (int nt = 0; nt < 8; ++nt) *(unsigned*)(WT + (size_t)(hp * 128 + 16 * nt + (lane & 15)) * 1024 + k0 + 16 * w + 4 * (lane >> 4)) = pk4_i8(acc[nt][0] * WQ_SCALE, acc[nt][1] * WQ_SCALE, acc[nt][2] * WQ_SCALE, acc[nt][3] * WQ_SCALE);
    __syncthreads();
}
__device__ __forceinline__ void p0a(Frame& F) { F.fence_ids();
    for (int u = F.G - 1 - F.bid; u < 128; u += F.G) wprime_unit(F, u);
    if (F.bid < 192) {
        LAS float* sc = (LAS float*)F.lds; LAS float* part = (LAS float*)(F.lds + 32768);
        { float cv[16];
#pragma unroll
          for (int i = 0; i < 16; ++i) cv[i] = F.c[F.tid + 512 * i];
#pragma unroll
          for (int i = 0; i < 16; ++i) sc[F.tid + 512 * i] = pg8::silu1(cv[i]); }
        __syncthreads();
        const int n0 = 32 * F.bid, ks = F.tid >> 3, c4 = F.tid & 7;
        f32x4 acc[8];
#pragma unroll
        for (int b = 0; b < 8; ++b) acc[b] = (f32x4){0.f, 0.f, 0.f, 0.f};
        f32x4 wv[16];
#pragma unroll
        for (int i = 0; i < 16; ++i) wv[i] = *(const f32x4*)(F.w_ada + (size_t)(ks + 64 * i) * 6144 + n0 + 4 * c4);
#pragma unroll
        for (int i = 0; i < 16; ++i) {
#pragma unroll
            for (int b = 0; b < 8; ++b) acc[b] += wv[i] * sc[b * 1024 + ks + 64 * i]; }
#pragma unroll
        for (int b = 0; b < 8; ++b) *(LAS f32x4*)(part + (ks * 8 + b) * 32 + 4 * c4) = acc[b];
        __syncthreads();
        if (F.tid < 256) { const int b = F.tid >> 5, col = F.tid & 31; float s = 0.f;
            for (int k2 = 0; k2 < 64; ++k2) s += part[(k2 * 8 + b) * 32 + col];
            ((float*)(F.ws + WS_MOD))[b * 6144 + n0 + col] = s + F.b_ada[n0 + col]; }
        __syncthreads();
    }
    {
        LAS float* scr = (LAS float*)(F.lds + F.wave * 16384);
        const int gw = F.bid * NWAVES + F.wave, NGW = F.G * NWAVES;
        constexpr int I_IN = 16 * (NIN / 32), I_SQ = 16 * 32, NITEMS = I_IN + 3 * I_SQ;
        for (int it = gw; it < NITEMS; it += NGW) {
            int r = it;
            if (r < I_IN) { transpose_item<true>(F.w_in, 1024, NIN, (bf16*)(F.ws + WS_WIN), scr, r, F.lane, MapWin()); continue; } r -= I_IN;
            if (r < I_SQ) { transpose_item<true>(F.w_ret_out, 1024, 1024, (bf16*)(F.ws + WS_WRET), scr, r, F.lane, MapId()); continue; } r -= I_SQ;
            if (r < I_SQ) { transpose_item<true>(F.w_sgu_out, 1024, 1024, (bf16*)(F.ws + WS_WSGU), scr, r, F.lane, MapId()); continue; } r -= I_SQ;
            transpose_item<true>(F.w_out, 1024, 1024, (bf16*)(F.ws + WS_WOUT), scr, r, F.lane, MapId());
        }
    }
    const size_t gt = (size_t)F.bid * 512 + F.tid, NT = (size_t)F.G * 512;
    for (size_t ch = gt; ch < (size_t)8192; ch += NT) { const int t = (int)(ch >> 4) & 127, s0 = (int)(ch & 15) * 8;
        const f32x4 a = *(const f32x4*)(F.sgu_w + ch * 8), b = *(const f32x4*)(F.sgu_w + ch * 8 + 4);
        float v[8] = {a[0], a[1], a[2], a[3], b[0], b[1], b[2], b[3]};
#pragma unroll
        for (int e = 0; e < 8; ++e) v[e] = (s0 + e <= t) ? v[e] : 0.f;
        v4u o; o.x = pk2(v[0], v[1]); o.y = pk2(v[2], v[3]); o.z = pk2(v[4], v[5]); o.w = pk2(v[6], v[7]);
        *(v4u*)((bf16*)(F.ws + WS_SGUW) + ch * 8) = o; }
    for (size_t e = gt; e < (size_t)4096 * 64; e += NT) { const int s = (int)(e >> 6), i = (int)(e & 63);
        const float inv = fexp2(-(float)i * (13.287712379549449f / 64.0f));
        const float rev = ((float)s * inv) * 0.15915494309189535f; const float fr = rev - __builtin_floorf(rev);
        ((float*)(F.ws + WS_COS))[e] = __builtin_amdgcn_cosf(fr); ((float*)(F.ws + WS_SIN))[e] = __builtin_amdgcn_sinf(fr); }
}

template <int MODE> struct NrRaw { f32x4 q[4]; };
template <> struct NrRaw<1> { v2u q[4]; };
template <int MODE> __device__ __forceinline__ void nr_load(const Frame& F, const float* X, int m, NrRaw<MODE>& R) {
#pragma unroll
    for (int j = 0; j < 4; ++j) { if constexpr (MODE == 1) R.q[j] = *((const v2u*)((const bf16*)X + (size_t)m * DM) + F.lane + 64 * j); else R.q[j] = *((const f32x4*)(X + (size_t)m * DM) + F.lane + 64 * j); }
}
template <int MODE> __device__ __forceinline__ void nr_row(Frame& F, const NrRaw<MODE>& R, int m, const f32x4 (&g)[4], const float* shift, const float* scale, bf16* O, unsigned char* O8, f32x4 (&sh)[4], f32x4 (&sc)[4], int& bcur) {
    f32x4 v[4]; float s = 0.f;
#pragma unroll
    for (int j = 0; j < 4; ++j) { if constexpr (MODE == 1) v[j] = (f32x4){bflo(R.q[j].x), bfhi(R.q[j].x), bflo(R.q[j].y), bfhi(R.q[j].y)}; else v[j] = R.q[j];
        s += (v[j][0] * v[j][0] + v[j][1] * v[j][1]) + (v[j][2] * v[j][2] + v[j][3] * v[j][3]); }
    const int b = m >> 12;
    if (b != bcur) { bcur = b;
#pragma unroll
        for (int j = 0; j < 4; ++j) { const int d = 4 * F.lane + 256 * j; sh[j] = *(const f32x4*)(shift + b * 6144 + d); sc[j] = *(const f32x4*)(scale + b * 6144 + d); } }
    const float rstd = __builtin_amdgcn_rsqf(wave_sum(s) * (1.f / DM) + EPSN);
    f32x4 hh[4]; float am = 0.f;
#pragma unroll
    for (int j = 0; j < 4; ++j) { hh[j] = v[j] * rstd * g[j] * (sc[j] + 1.0f) + sh[j];
        if (MODE == 1) am = __builtin_fmaxf(__builtin_fmaxf(am, __builtin_fmaxf(__builtin_fabsf(hh[j][0]), __builtin_fabsf(hh[j][1]))), __builtin_fmaxf(__builtin_fabsf(hh[j][2]), __builtin_fabsf(hh[j][3]))); }
    float qs = 0.f;
    if (MODE == 1) { am = __builtin_fmaxf(wave_max(am), 1e-20f); qs = 127.0f * __builtin_amdgcn_rcpf(am); if (F.lane == 0) ((float*)(F.ws + WS_RS))[m] = am * (1.0f / 127.0f); }
#pragma unroll
    for (int j = 0; j < 4; ++j) { const int d = 4 * F.lane + 256 * j; const f32x4 h = hh[j];
        if (MODE == 2) { const f32x4 h8 = h * 8.0f; *(unsigned*)(O8 + (size_t)m * DM + d) = pk4_fp8(h8[0], h8[1], h8[2], h8[3]); }
        if (MODE == 1) { const f32x4 hq = h * qs; *(unsigned*)((unsigned char*)O + (size_t)m * DM + d) = pk4_i8(hq[0], hq[1], hq[2], hq[3]);
            const f32x4 hs = h * 16.0f; *(unsigned*)(O8 + (size_t)(d >> 8) * ((size_t)MT * 256) + (size_t)m * 256 + (d & 255)) = pk4_fp8(hs[0], hs[1], hs[2], hs[3]); } }
}
template <int MODE  > __device__ __forceinline__ void norm_rows(Frame& F, const float* X, const float* gain, const float* shift, const float* scale, bf16* O, unsigned char* O8) { F.fence_ids();
    const int gw = F.bid * NWAVES + F.wave, NGW = F.G * NWAVES;
    f32x4 g[4];
#pragma unroll
    for (int j = 0; j < 4; ++j) g[j] = *(const f32x4*)(gain + 4 * F.lane + 256 * j);
    NrRaw<MODE> ra, rb; f32x4 sh[4], sc[4]; int bcur = -1;
#pragma unroll
    for (int j = 0; j < 4; ++j) { sh[j] = (f32x4){0.f, 0.f, 0.f, 0.f}; sc[j] = sh[j]; }
    if (gw >= MT) return;
    const int mtop = gw + ((MT - 1 - gw) / NGW) * NGW;
    nr_load<MODE>(F, X, xr_row(mtop), ra);
    if (mtop - NGW >= 0) nr_load<MODE>(F, X, xr_row(mtop - NGW), rb);
    for (int ml = mtop; ml >= 0; ml -= 2 * NGW) {
        { const int m = xr_row(ml); NrRaw<MODE> cur = ra; asm volatile("" ::: "memory");
          if (ml - 2 * NGW >= 0) nr_load<MODE>(F, X, xr_row(ml - 2 * NGW), ra);
          nr_row<MODE>(F, cur, m, g, shift, scale, O, O8, sh, sc, bcur); }
        if (ml - NGW >= 0) { const int m = xr_row(ml - NGW); NrRaw<MODE> cur = rb; asm volatile("" ::: "memory");
          if (ml - 3 * NGW >= 0) nr_load<MODE>(F, X, xr_row(ml - 3 * NGW), rb);
          nr_row<MODE>(F, cur, m, g, shift, scale, O, O8, sh, sc, bcur); }
    }
}

__device__ __forceinline__ float lg_gamma(int h) { return __builtin_log2f(1.0f - fexp2((float)(-5 - h))); }
__device__ __forceinline__ v4u scale8(v4u w, float s) {
    v4u o; o.x = pk2(bflo(w.x) * s, bfhi(w.x) * s); o.y = pk2(bflo(w.y) * s, bfhi(w.y) * s); o.z = pk2(bflo(w.z) * s, bfhi(w.z) * s); o.w = pk2(bflo(w.w) * s, bfhi(w.w) * s); return o;
}
__device__ __forceinline__ void f8_to_bf16x16(const v4u w, float sc, v4u& o0, v4u& o1) {
    const f32x4 a = pg8::f8x4(w.x) * sc, b = pg8::f8x4(w.y) * sc, c = pg8::f8x4(w.z) * sc, d = pg8::f8x4(w.w) * sc;
    o0.x = pk2(a[0], a[1]); o0.y = pk2(a[2], a[3]); o0.z = pk2(b[0], b[1]); o0.w = pk2(b[2], b[3]);
    o1.x = pk2(c[0], c[1]); o1.y = pk2(c[2], c[3]); o1.z = pk2(d[0], d[1]); o1.w = pk2(d[2], d[3]);
}
struct KvRegs { v4u k[2], v[4]; };
__device__ __forceinline__ void kv_load(Frame& F, int u, KvRegs& R) {
    const int b = u >> 7, h = (u >> 5) & 3, c = u & 31; const size_t tok0 = (size_t)b * SEQ + c * 128;
    const unsigned char* Kb = F.dout + DO_K; const unsigned char* Vb = F.ws + WS_V;
#pragma unroll
    for (int i = 0; i < 2; ++i) { const int ch = F.tid + 512 * i, j = ch >> 3, cc = ch & 7; R.k[i] = *(const v4u*)(Kb + (tok0 + j) * 512 + h * 128 + cc * 16); }
#pragma unroll
    for (int i = 0; i < 4; ++i) { const int ch = F.tid + 512 * i, j = ch >> 4, cc = ch & 15; R.v[i] = *(const v4u*)(Vb + (tok0 + j) * 1024 + h * 256 + cc * 16); }
}
__device__ __forceinline__ void kv_unit(Frame& F, int u, KvRegs& R, int unext) {
    const int b = u >> 7, h = (u >> 5) & 3, c = u & 31;
    LAS unsigned char* Kimg = F.lds; LAS unsigned char* Vimg = F.lds + 34816;
    const float lg = lg_gamma(h);
#pragma unroll
    for (int i = 0; i < 2; ++i) { const int ch = F.tid + 512 * i, j = ch >> 3, cc = ch & 7; v4u o0, o1;
        f8_to_bf16x16(R.k[i], fexp2((float)(127 - j) * lg) * (1.0f / 128.0f), o0, o1); *(LAS v4u*)(Kimg + j * KS + cc * 32) = o0; *(LAS v4u*)(Kimg + j * KS + cc * 32 + 16) = o1; }
#pragma unroll
    for (int i = 0; i < 4; ++i) { const int ch = F.tid + 512 * i, j = ch >> 4, cc = ch & 15; v4u o0, o1;
        f8_to_bf16x16(R.v[i], 1.0f / 16.0f, o0, o1); *(LAS v4u*)(Vimg + j * VS + cc * 32) = o0; *(LAS v4u*)(Vimg + j * VS + cc * 32 + 16) = o1; }
    __syncthreads();
    if (unext >= 0) kv_load(F, unext, R);
    f32x4 acc[8][2];
#pragma unroll
    for (int dt = 0; dt < 8; ++dt) { acc[dt][0] = (f32x4){0.f, 0.f, 0.f, 0.f}; acc[dt][1] = (f32x4){0.f, 0.f, 0.f, 0.f}; }
#pragma unroll
    for (int js = 0; js < 4; ++js) {
        bf16x8 bv[2];
#pragma unroll
        for (int vt = 0; vt < 2; ++vt) bv[vt] = lds_tr_frag(Vimg, VS, 32 * js, 32 * F.wave + 16 * vt, F.lane);
#pragma unroll
        for (int dt = 0; dt < 8; ++dt) { const bf16x8 a = lds_tr_frag(Kimg, KS, 32 * js, 16 * dt, F.lane);
            acc[dt][0] = MFMA16(a, bv[0], acc[dt][0]); acc[dt][1] = MFMA16(a, bv[1], acc[dt][1]); }
    }
    unsigned char* dst = F.dout + DO_KVS + (size_t)(((b * 4 + h) * 32 + c)) * 32768;
    int lq = F.lane; asm volatile("" : "+v"(lq)); const int pidx = (16 * (lq & 3) + (lq >> 2)) * 4, r2 = lq >> 2, q2 = lq & 3;
#pragma unroll
    for (int dt = 0; dt < 8; ++dt)
#pragma unroll
        for (int vt = 0; vt < 2; ++vt) { const int v = 32 * F.wave + 16 * vt + r2, d0 = 16 * dt + 4 * q2;
            const unsigned w = pk4_fp8(acc[dt][vt][0] * 16.f, acc[dt][vt][1] * 16.f, acc[dt][vt][2] * 16.f, acc[dt][vt][3] * 16.f);
            *(unsigned*)(dst + v * 128 + d0) = (unsigned)__builtin_amdgcn_ds_bpermute(pidx, (int)w); }
    __syncthreads();
}
struct SguRegs { v2u sv[8]; f32x2v st[8]; };
__device__ __forceinline__ void sgu_load(Frame& F, int su, SguRegs& R) {
    const size_t tok0 = (size_t)(su >> 2) * 128; const int g = su & 3; const unsigned char* SVb = F.ws + WS_SV; const float* stat = (const float*)(F.ws + WS_SVSTAT);
    int tq = F.tid; asm volatile("" : "+v"(tq));
#pragma unroll
    for (int i = 0; i < 8; ++i) { const int ch = tq + 512 * i, sr = ch >> 5, cc = ch & 31;
        R.sv[i] = *(const v2u*)(SVb + (tok0 + sr) * 1024 + g * 256 + cc * 8); R.st[i] = *(const f32x2v*)(stat + (tok0 + sr) * 2); }
}
__device__ __forceinline__ void sgu_unit(Frame& F, int su, SguRegs& R, int snext, int& cur_g) {
    const size_t tok0 = (size_t)(su >> 2) * 128; const int g = su & 3;
    LAS unsigned char* Vn = F.lds; LAS unsigned char* Wimg = F.lds + 67584;
    const unsigned char* Ub = F.ws + WS_U; const bf16* Wm = (const bf16*)(F.ws + WS_SGUW);
    { const int cc = F.tid & 31; const int col = g * 256 + cc * 8;
        const f32x4 g0 = *(const f32x4*)(F.sgu_ln_g + col), g1 = *(const f32x4*)(F.sgu_ln_g + col + 4), b0 = *(const f32x4*)(F.sgu_ln_b + col), b1 = *(const f32x4*)(F.sgu_ln_b + col + 4);
#pragma unroll
        for (int i = 0; i < 8; ++i) { const int ch = F.tid + 512 * i, sr = ch >> 5; const f32x4 w0 = pg8::f8x4(R.sv[i].x) * 0.0625f, w1 = pg8::f8x4(R.sv[i].y) * 0.0625f;
            const float mean = R.st[i].x * (1.f / 1024.f), var = R.st[i].y * (1.f / 1024.f) - mean * mean, rstd = __builtin_amdgcn_rsqf(var + EPSN);
            v4u o;
            o.x = pk2((w0[0] - mean) * rstd * g0[0] + b0[0], (w0[1] - mean) * rstd * g0[1] + b0[1]);
            o.y = pk2((w0[2] - mean) * rstd * g0[2] + b0[2], (w0[3] - mean) * rstd * g0[3] + b0[3]);
            o.z = pk2((w1[0] - mean) * rstd * g1[0] + b1[0], (w1[1] - mean) * rstd * g1[1] + b1[1]);
            o.w = pk2((w1[2] - mean) * rstd * g1[2] + b1[2], (w1[3] - mean) * rstd * g1[3] + b1[3]);
            *(LAS v4u*)(Vn + sr * VS + cc * 16) = o; } }
    if (g != cur_g) { cur_g = g;
#pragma unroll
        for (int i = 0; i < 4; ++i) { const int ch = F.tid + 512 * i, t = ch >> 4, cc = ch & 15;
            *(LAS v4u*)(Wimg + t * KS + cc * 16) = *(const v4u*)(Wm + (size_t)(g * 128 + t) * 128 + cc * 8); } }
    __syncthreads();
    if (snext >= 0) sgu_load(F, snext, R);
    int lq = F.lane; asm volatile("" : "+v"(lq)); const int r2 = lq >> 2, q2 = lq & 3, pfwd = (16 * q2 + r2) * 4, pinv = (4 * (lq & 15) + (lq >> 4)) * 4;
    unsigned uv[8][2];
#pragma unroll
    for (int tt = 0; tt < 8; ++tt)
#pragma unroll
        for (int ct = 0; ct < 2; ++ct) uv[tt][ct] = *(const unsigned*)(Ub + (tok0 + 16 * tt + r2) * 1024 + g * 256 + 32 * F.wave + 16 * ct + 4 * q2);
    f32x4 acc[2][8];
#pragma unroll
    for (int ct = 0; ct < 2; ++ct)
#pragma unroll
        for (int tt = 0; tt < 8; ++tt) acc[ct][tt] = (f32x4){0.f, 0.f, 0.f, 0.f};
#pragma unroll
    for (int ss = 0; ss < 4; ++ss) {
        bf16x8 av[2];
#pragma unroll
        for (int ct = 0; ct < 2; ++ct) av[ct] = lds_tr_frag(Vn, VS, 32 * ss, 32 * F.wave + 16 * ct, F.lane);
#pragma unroll
        for (int tt = 0; tt < 8; ++tt) if (tt >= 2 * ss) { const bf16x8 bw = lds_row_frag(Wimg, KS, 16 * tt, 32 * ss, F.lane);
            acc[0][tt] = MFMA16(av[0], bw, acc[0][tt]); acc[1][tt] = MFMA16(av[1], bw, acc[1][tt]); }
    }
#pragma unroll
    for (int tt = 0; tt < 8; ++tt) { const int t = 16 * tt + (F.lane & 15); const float bs = F.sgu_b[g * 128 + t];
#pragma unroll
        for (int ct = 0; ct < 2; ++ct) { const int cg = g * 256 + 32 * F.wave + 16 * ct + 4 * q2; const f32x4 u4 = pg8::f8x4((unsigned)__builtin_amdgcn_ds_bpermute(pinv, (int)uv[tt][ct])) * 0.5f;
            const unsigned w = pk4_fp8(u4[0] * (acc[ct][tt][0] + bs), u4[1] * (acc[ct][tt][1] + bs), u4[2] * (acc[ct][tt][2] + bs), u4[3] * (acc[ct][tt][3] + bs));
            *(unsigned*)(F.ws + WS_YS8 + (tok0 + 16 * tt + r2) * 1024 + cg) = (unsigned)__builtin_amdgcn_ds_bpermute(pfwd, (int)w); } }
    __syncthreads();
}
__device__ __forceinline__ void p2a(Frame& F) { F.fence_ids();
    { KvRegs R; if (F.bid < 1024) kv_load(F, xr_unit(F.bid), R);
      for (int u = F.bid; u < 1024; u += F.G) kv_unit(F, xr_unit(u), R, (u + F.G < 1024) ? xr_unit(u + F.G) : -1); }
#if MK_PROBE_HI > 0
    if (F.bid == 0 && threadIdx.x == 0) { const unsigned long long _t = __builtin_amdgcn_s_memrealtime(); F.misc[16 + 2 * 20] = (unsigned)_t; F.misc[17 + 2 * 20] = (unsigned)(_t >> 32); }
#endif
    { SguRegs R; int cur_g = -1; if (F.bid < 1024) sgu_load(F, xr_unit(F.bid), R);
      for (int su = F.bid; su < 1024; su += F.G) sgu_unit(F, xr_unit(su), R, (su + F.G < 1024) ? xr_unit(su + F.G) : -1, cur_g); }
}
__device__ __forceinline__ void p2b(Frame& F) { F.fence_ids();
    unsigned char* KVS = F.dout + DO_KVS;
    for (int il = F.bid * 512 + F.tid; il < 32 * 4096; il += F.G * 512) { const int item = xr_scan(il);
        const int bh = item >> 12, rem = item & 4095, h = bh & 3;
        const float dc = fexp2(128.0f * lg_gamma(h));
        f32x4 s0 = (f32x4){0.f, 0.f, 0.f, 0.f}, s1 = (f32x4){0.f, 0.f, 0.f, 0.f};
        unsigned char* p = KVS + (size_t)bh * 32 * 32768 + (size_t)rem * 8;
        v2u kn[8];
#pragma unroll
        for (int i = 0; i < 8; ++i) kn[i] = *(const v2u*)(p + (size_t)i * 32768);
        for (int c0 = 0; c0 < 32; c0 += 8) {
            v2u kv[8];
#pragma unroll
            for (int i = 0; i < 8; ++i) kv[i] = kn[i];
            asm volatile("" ::: "memory");
            if (c0 + 8 < 32) {
#pragma unroll
                for (int i = 0; i < 8; ++i) kn[i] = *(const v2u*)(p + (size_t)(c0 + 8 + i) * 32768); }
#pragma unroll
            for (int i = 0; i < 8; ++i) {
                v2u o; o.x = pk4_fp8(s0[0], s0[1], s0[2], s0[3]); o.y = pk4_fp8(s1[0], s1[1], s1[2], s1[3]);
                *(v2u*)(p + (size_t)(c0 + i) * 32768) = o;
                s0 = s0 * dc + pg8::f8x4(kv[i].x); s1 = s1 * dc + pg8::f8x4(kv[i].y);
            }
        }
    }
}
struct RetRegs { v4u q[2], k[2], v[4]; };
template <int WHAT  > __device__ __forceinline__ void ret_load(Frame& F, int u, RetRegs& R) {
    const int b = u >> 7, h = (u >> 5) & 3, c = u & 31; const size_t tok0 = (size_t)b * SEQ + c * 128;
    const unsigned char* Qb = F.dout + DO_Q; const unsigned char* Kb = F.dout + DO_K; const unsigned char* Vb = F.ws + WS_V;
    int tq = F.tid; asm volatile("" : "+v"(tq));
    if (WHAT & 1) {
#pragma unroll
    for (int i = 0; i < 2; ++i) { const int ch = tq + 512 * i, j = ch >> 3, cc = ch & 7;
        R.q[i] = *(const v4u*)(Qb + (tok0 + j) * 512 + h * 128 + cc * 16); R.k[i] = *(const v4u*)(Kb + (tok0 + j) * 512 + h * 128 + cc * 16); } }
    if (WHAT & 2) {
#pragma unroll
    for (int i = 0; i < 4; ++i) { const int ch = tq + 512 * i, j = ch >> 4, cc = ch & 15; R.v[i] = *(const v4u*)(Vb + (tok0 + j) * 1024 + h * 256 + cc * 16); } }
}
__device__ __forceinline__ void ret_unit(Frame& F, int u, RetRegs& R, int unext) {
    const int b = u >> 7, h = (u >> 5) & 3, c = u & 31;
    const size_t tok0 = (size_t)b * SEQ + c * 128;
    LAS unsigned char* Qimg = F.lds; LAS unsigned char* Kimg = F.lds + 34816; LAS unsigned char* Vimg = F.lds + 69632;
    LAS unsigned char* Sout = F.lds;
    const unsigned char* Gb = F.ws + WS_G;
    const unsigned char* ST = F.dout + DO_KVS + (size_t)(((b * 4 + h) * 32 + c)) * 32768;
    const float lg = lg_gamma(h);
    const int lane = F.lane, w = F.wave, l15 = lane & 15, g4 = lane >> 4;
#pragma unroll
    for (int i = 0; i < 2; ++i) { const int ch = F.tid + 512 * i, j = ch >> 3, cc = ch & 7; v4u o0, o1;
        f8_to_bf16x16(R.q[i], 1.0f / 16.0f, o0, o1); *(LAS v4u*)(Qimg + j * KS + cc * 32) = o0; *(LAS v4u*)(Qimg + j * KS + cc * 32 + 16) = o1;
        f8_to_bf16x16(R.k[i], 1.0f / 128.0f, o0, o1); *(LAS v4u*)(Kimg + j * KS + cc * 32) = o0; *(LAS v4u*)(Kimg + j * KS + cc * 32 + 16) = o1; }
    bf16x8 bs[4][2];
#pragma unroll
    for (int ds = 0; ds < 4; ++ds)
#pragma unroll
        for (int vt = 0; vt < 2; ++vt) { const v2u sw = *(const v2u*)(ST + (size_t)(32 * w + 16 * vt + l15) * 128 + 32 * ds + 8 * g4); const f32x4 sa = pg8::f8x4(sw.x) * 0.0625f, sb = pg8::f8x4(sw.y) * 0.0625f;
            v4u pk_; pk_.x = pk2(sa[0], sa[1]); pk_.y = pk2(sa[2], sa[3]); pk_.z = pk2(sb[0], sb[1]); pk_.w = pk2(sb[2], sb[3]); bs[ds][vt] = __builtin_bit_cast(bf16x8, pk_); }
    __syncthreads();
    f32x4 st[8];
#pragma unroll
    for (int jt = 0; jt < 8; ++jt) st[jt] = (f32x4){0.f, 0.f, 0.f, 0.f};
#pragma unroll
    for (int ds = 0; ds < 4; ++ds) { const bf16x8 bq = lds_row_frag(Qimg, KS, 16 * w, 32 * ds, lane);
#pragma unroll
        for (int jt = 0; jt < 8; ++jt) if (jt <= w) { const bf16x8 ak = lds_row_frag(Kimg, KS, 16 * jt, 32 * ds, lane); st[jt] = MFMA16(ak, bq, st[jt]); } }
    __syncthreads();
    { const int i = 16 * w + l15;
#pragma unroll
        for (int jt = 0; jt < 8; ++jt) { float o[4];
#pragma unroll
            for (int ii = 0; ii < 4; ++ii) { const int j = 16 * jt + 4 * g4 + ii; o[ii] = (i >= j) ? st[jt][ii] * fexp2((float)(i - j) * lg) : 0.f; }
            v2u pk; pk.x = pk2(o[0], o[1]); pk.y = pk2(o[2], o[3]);
            *(LAS v2u*)(Kimg + i * KS + (16 * jt + 4 * g4) * 2) = pk; } }
    { int tv = F.tid; asm volatile("" : "+v"(tv));
#pragma unroll
    for (int i = 0; i < 4; ++i) { const int ch = tv + 512 * i, j = ch >> 4, cc = ch & 15; v4u o0, o1;
        f8_to_bf16x16(R.v[i], 1.0f / 16.0f, o0, o1); *(LAS v4u*)(Vimg + j * VS + cc * 32) = o0; *(LAS v4u*)(Vimg + j * VS + cc * 32 + 16) = o1; }
    }
    __syncthreads();
    f32x4 acc[8][2];
#pragma unroll
    for (int it = 0; it < 8; ++it) { acc[it][0] = (f32x4){0.f, 0.f, 0.f, 0.f}; acc[it][1] = (f32x4){0.f, 0.f, 0.f, 0.f}; }
#pragma unroll
    for (int ds = 0; ds < 4; ++ds) {
#pragma unroll
        for (int it = 0; it < 8; ++it) { const bf16x8 a = lds_row_frag(Qimg, KS, 16 * it, 32 * ds, lane);
            acc[it][0] = MFMA16(a, bs[ds][0], acc[it][0]); acc[it][1] = MFMA16(a, bs[ds][1], acc[it][1]); } }
#pragma unroll
    for (int it = 0; it < 8; ++it)
#pragma unroll
        for (int ii = 0; ii < 4; ++ii) { const float dq = fexp2((float)(16 * it + 4 * g4 + ii + 1) * lg); acc[it][0][ii] *= dq; acc[it][1][ii] *= dq; }
#pragma unroll
    for (int js = 0; js < 4; ++js) { bf16x8 bv[2];
#pragma unroll
        for (int vt = 0; vt < 2; ++vt) bv[vt] = lds_tr_frag(Vimg, VS, 32 * js, 32 * w + 16 * vt, lane);
#pragma unroll
        for (int it = 0; it < 8; ++it) if (it >= 2 * js) { const bf16x8 a = lds_row_frag(Kimg, KS, 16 * it, 32 * js, lane);
            acc[it][0] = MFMA16(a, bv[0], acc[it][0]); acc[it][1] = MFMA16(a, bv[1], acc[it][1]); } }
    int lane_h = lane; asm volatile("" : "+v"(lane_h));
    unsigned gt[16];
#pragma unroll
    for (int rr = 0; rr < 16; ++rr) gt[rr] = *(const unsigned*)(Gb + (tok0 + 16 * w + rr) * 1024 + h * 256 + 4 * lane_h);
    const f32x4 gn = *(const f32x4*)(F.ret_gn_g + h * 256 + 4 * lane_h);
    __syncthreads();
#pragma unroll
    for (int it = 0; it < 8; ++it)
#pragma unroll
        for (int vt = 0; vt < 2; ++vt)
#pragma unroll
            for (int ii = 0; ii < 4; ++ii) *(LAS float*)(Sout + (16 * it + 4 * g4 + ii) * 1040 + (32 * w + 16 * vt + l15) * 4) = acc[it][vt][ii];
    __syncthreads();
    if (unext >= 0) ret_load<1>(F, unext, R);
#pragma unroll
    for (int rr = 0; rr < 16; ++rr) { const int i = 16 * w + rr;
        const f32x4 y = *(LAS const f32x4*)(Sout + i * 1040 + lane_h * 16);
        const float mean = wave_sum((y[0] + y[1]) + (y[2] + y[3])) * (1.f / 256.f);
        const f32x4 d = y - mean;
        const float var = wave_sum((d[0] * d[0] + d[1] * d[1]) + (d[2] * d[2] + d[3] * d[3])) * (1.f / 256.f);
        const float r8 = __builtin_amdgcn_rsqf(var + EPSN) * (4.0f / 16.0f);
        const size_t off = (tok0 + i) * 1024 + h * 256 + 4 * lane_h; const f32x4 gq = pg8::f8x4(gt[rr]);
        *(unsigned*)(F.ws + WS_YG8 + off) = pk4_fp8(d[0] * r8 * gn[0] * gq[0], d[1] * r8 * gn[1] * gq[1], d[2] * r8 * gn[2] * gq[2], d[3] * r8 * gn[3] * gq[3]); }
    __syncthreads();
}
__device__ __forceinline__ void p2c(Frame& F) { F.fence_ids(); RetRegs R; if (F.bid < 1024) ret_load<1>(F, xr_unit(F.bid), R); for (int u = F.bid; u < 1024; u += F.G) { ret_load<2>(F, xr_unit(u), R); ret_unit(F, xr_unit(u), R, (u + F.G < 1024) ? xr_unit(u + F.G) : -1); } }

__device__ __forceinline__ float dppx(float v, int) { return v; }
template <int CTRL> __device__ __forceinline__ void merge16(float (&L)[16]) {
    float c[16];
#pragma unroll
    for (int i = 0; i < 16; ++i) c[i] = __builtin_fmaxf(L[i], dpp_f<CTRL>(L[15 - i]));
#pragma unroll
    for (int half = 8; half >= 1; half >>= 1)
#pragma unroll
        for (int i = 0; i < 16; ++i) if ((i & half) == 0) { const float hi = __builtin_fmaxf(c[i], c[i + half]), lo = __builtin_fminf(c[i], c[i + half]); c[i] = hi; c[i + half] = lo; }
#pragma unroll
    for (int i = 0; i < 16; ++i) L[i] = c[i];
}
__device__ __forceinline__ void sort16_desc(float (&v)[16]) {
#pragma unroll
    for (int k = 2; k <= 16; k <<= 1)
#pragma unroll
        for (int j = k >> 1; j >= 1; j >>= 1)
#pragma unroll
            for (int i = 0; i < 16; ++i) { const int l = i ^ j; if (l > i) { const bool desc = ((i & k) == 0) || (k == 16);
                const float hi = __builtin_fmaxf(v[i], v[l]), lo = __builtin_fminf(v[i], v[l]); v[i] = desc ? hi : lo; v[l] = desc ? lo : hi; } }
}
__device__ __forceinline__ void merge_top16(float (&A)[16], const float (&B)[16]) {
#pragma unroll
    for (int i = 0; i < 16; ++i) A[i] = __builtin_fmaxf(A[i], B[15 - i]);
#pragma unroll
    for (int half = 8; half >= 1; half >>= 1)
#pragma unroll
        for (int i = 0; i < 16; ++i) if ((i & half) == 0) { const float hi = __builtin_fmaxf(A[i], A[i + half]), lo = __builtin_fminf(A[i], A[i + half]); A[i] = hi; A[i + half] = lo; }
}
__device__ __forceinline__ void p5b(Frame& F) {
    F.fence_ids();
    const v4u* SC = (const v4u*)(F.ws + WS_SC);
    const int lane = F.lane, q = lane & 3;
    const int gw = F.bid * NWAVES + F.wave, NGW = F.G * NWAVES;
    v4u nx[4];
    if (gw < MT) {
#pragma unroll
        for (int j = 0; j < 4; ++j) nx[j] = SC[(size_t)gw * 256 + lane * 4 + j]; }
    for (int t = gw; t < MT; t += NGW) {
        v4u cu[4];
#pragma unroll
        for (int j = 0; j < 4; ++j) cu[j] = nx[j];
        if (t + NGW < MT) {
#pragma unroll
            for (int j = 0; j < 4; ++j) nx[j] = SC[(size_t)(t + NGW) * 256 + lane * 4 + j]; }
        float L[16], L2[16];
#pragma unroll
        for (int j = 0; j < 2; ++j)
#pragma unroll
            for (int e = 0; e < 4; ++e) { const unsigned wa = cu[j][e], wb = cu[2 + j][e]; const pg8::h2_t ha = __builtin_bit_cast(pg8::h2_t, wa), hb = __builtin_bit_cast(pg8::h2_t, wb); const unsigned n = 32u * q + 8 * j + 2 * e;
                L[8 * j + 2 * e] = __uint_as_float((__float_as_uint((float)ha.x) & 0xFFFFFF80u) | n); L[8 * j + 2 * e + 1] = __uint_as_float((__float_as_uint((float)ha.y) & 0xFFFFFF80u) | (n + 1u));
                L2[8 * j + 2 * e] = __uint_as_float((__float_as_uint((float)hb.x) & 0xFFFFFF80u) | (n + 16u)); L2[8 * j + 2 * e + 1] = __uint_as_float((__float_as_uint((float)hb.y) & 0xFFFFFF80u) | (n + 17u)); }
        sort16_desc(L); sort16_desc(L2); merge_top16(L, L2);
        merge16<0xB1>(L); merge16<0x4E>(L);
        if (q == 0) { v4u* dst = (v4u*)((unsigned*)(F.ws + WS_SUB) + ((size_t)t * 16 + (lane >> 2)) * 16);
#pragma unroll
            for (int i = 0; i < 4; ++i) dst[i] = (v4u){__float_as_uint(L[4 * i]), __float_as_uint(L[4 * i + 1]), __float_as_uint(L[4 * i + 2]), __float_as_uint(L[4 * i + 3])}; }
    }
}

template <int CTRL> __device__ __forceinline__ float dpp_max(float v) { return __builtin_fmaxf(v, dpp_f<CTRL>(v)); }
template <int CTRL> __device__ __forceinline__ float dpp_add(float v) { return v + dpp_f<CTRL>(v); }
__device__ __forceinline__ float row_allmax(float v) { v = dpp_max<0x128>(v); v = dpp_max<0x124>(v); v = dpp_max<0x122>(v); v = dpp_max<0x121>(v); return v; }
__device__ __forceinline__ float row_allsum(float v) { v = dpp_add<0x128>(v); v = dpp_add<0x124>(v); v = dpp_add<0x122>(v); v = dpp_add<0x121>(v); return v; }
__device__ __forceinline__ void p6a(Frame& F) { F.fence_ids();
    const int lane = F.lane, row = lane >> 4, i = lane & 15, rowbase = lane & 48;
    LAS unsigned* Sel = (LAS unsigned*)(F.lds + F.wave * 1024);
    const unsigned* SUB = (const unsigned*)(F.ws + WS_SUB);
    unsigned short* EID = (unsigned short*)(F.ws + WS_EID); float* GWp = (float*)(F.ws + WS_GW);
    const int gw = F.bid * NWAVES + F.wave, NGW = F.G * NWAVES;
    unsigned nab[2], nbb[2];
    if (gw < MT) {
#pragma unroll
        for (int r = 0; r < 2; ++r) { const int h = 4 * r + row; nab[r] = SUB[((size_t)gw * 16 + 2 * h) * 16 + i]; nbb[r] = SUB[((size_t)gw * 16 + 2 * h + 1) * 16 + i]; } }
    for (int t = gw; t < MT; t += NGW) {
        unsigned abits[2], bbits[2], bcur[2]; float a[2], hv[2]; int ptr[2];
#pragma unroll
        for (int r = 0; r < 2; ++r) { abits[r] = nab[r]; bbits[r] = nbb[r]; a[r] = __uint_as_float(abits[r]); ptr[r] = 0; bcur[r] = (unsigned)__shfl((int)bbits[r], rowbase); hv[r] = a[r] + __uint_as_float(bcur[r]); }
        if (t + NGW < MT) {
#pragma unroll
            for (int r = 0; r < 2; ++r) { const int h = 4 * r + row; nab[r] = SUB[((size_t)(t + NGW) * 16 + 2 * h) * 16 + i]; nbb[r] = SUB[((size_t)(t + NGW) * 16 + 2 * h + 1) * 16 + i]; } }
        for (int k = 0; k < 16; ++k) {
#pragma unroll
            for (int r = 0; r < 2; ++r) {
                const float key = __uint_as_float((__float_as_uint(hv[r]) & 0xFFFFFFF0u) | (unsigned)i);
                const float m = row_allmax(key);
                const bool win = (key == m);
                if (win) { Sel[((r * 4 + row) * 16 + k) * 2] = (abits[r] & 127u) * 128u + (bcur[r] & 127u); Sel[((r * 4 + row) * 16 + k) * 2 + 1] = __float_as_uint(hv[r]); ptr[r]++; }
                const unsigned bnext = (unsigned)__shfl((int)bbits[r], rowbase + (ptr[r] < 15 ? ptr[r] : 15));
                if (win) { bcur[r] = bnext; hv[r] = (ptr[r] < 16) ? a[r] + __uint_as_float(bnext) : -3.0e38f; }
            }
        }
        LDS_WAIT(); asm volatile("" ::: "memory");
#pragma unroll
        for (int r = 0; r < 2; ++r) { const int h = 4 * r + row;
            const unsigned e = Sel[((r * 4 + row) * 16 + i) * 2]; const float sc = __uint_as_float(Sel[((r * 4 + row) * 16 + i) * 2 + 1]);
            const float mx = row_allmax(sc);
            const float ex = fexp2((sc - mx) * 1.44269504089f);
            const float sum = row_allsum(ex);
            EID[(size_t)t * 128 + h * 16 + i] = (unsigned short)e; GWp[(size_t)t * 128 + h * 16 + i] = ex / sum; }
        LDS_WAIT(); asm volatile("" ::: "memory");
    }
}
template <int CTRL> __device__ __forceinline__ void merge8to16(const float (&A)[8], float (&c)[16]) {
#pragma unroll
    for (int i = 0; i < 8; ++i) { c[i] = A[i]; c[8 + i] = dpp_f<CTRL>(A[7 - i]); }
#pragma unroll
    for (int half = 8; half >= 1; half >>= 1)
#pragma unroll
        for (int i = 0; i < 16; ++i) if ((i & half) == 0) { const float hi = __builtin_fmaxf(c[i], c[i + half]), lo = __builtin_fminf(c[i], c[i + half]); c[i] = hi; c[i + half] = lo; }
}
__device__ __forceinline__ void sort8_desc(float (&v)[8]) {
#pragma unroll
    for (int k = 2; k <= 8; k <<= 1)
#pragma unroll
        for (int j = k >> 1; j >= 1; j >>= 1)
#pragma unroll
            for (int i = 0; i < 8; ++i) { const int l = i ^ j; if (l > i) { const bool desc = ((i & k) == 0) || (k == 8);
                const float hi = __builtin_fmaxf(v[i], v[l]), lo = __builtin_fminf(v[i], v[l]); v[i] = desc ? hi : lo; v[l] = desc ? lo : hi; } }
}
__device__ __forceinline__ unsigned tbl8(unsigned long long t, int k) { return (unsigned)(t >> (8 * k)) & 0xFFu; }
__device__ __forceinline__ void p5b6a(Frame& F) {
    F.fence_ids();
    const v4u* SC = (const v4u*)(F.ws + WS_SC);
    const int lane = F.lane, q = lane & 3, k8 = lane & 7, hd = lane >> 3;
    LAS unsigned* Sub = (LAS unsigned*)(F.lds + F.wave * 1024);
    unsigned* EID32 = (unsigned*)(F.ws + WS_EID); f32x2v* GW2 = (f32x2v*)(F.ws + WS_GW);
    const int gw = F.bid * NWAVES + F.wave, NGW = F.G * NWAVES;
    const unsigned xo0 = tbl8(0x040C041010101810ull, k8), xo1 = tbl8(0x0404081414141C14ull, k8), yo0 = tbl8(0x1210100302010000ull, k8), yo1 = tbl8(0x1311100302010000ull, k8);
    const unsigned tb0 = tbl8(0x42C0403020100800ull, k8), tb1 = tbl8(0x4341803424140C04ull, k8), tst = k8 >= 5 ? 16u : 1u;
    unsigned tag[8];
#pragma unroll
    for (int e = 0; e < 4; ++e) { tag[e] = tb0 + e * tst; tag[4 + e] = tb1 + e * tst; }
    LAS const unsigned* hb = Sub + hd * 32;
    const bool kb0 = (k8 & 1) != 0, kb1 = (k8 & 2) != 0, kb2 = (k8 & 4) != 0;
    v4u nx[4];
    const int ttop = gw < MT ? gw + ((MT - 1 - gw) / NGW) * NGW : -1;
    if (ttop >= 0) {
#pragma unroll
        for (int j = 0; j < 4; ++j) nx[j] = SC[(size_t)xr_row(ttop) * 256 + (lane & ~3) * 4 + 4 * j + q]; }
    const size_t tgt = (size_t)F.bid * 512 + F.tid, TNT = (size_t)F.G * 512, TSTEPS = (size_t)16384 * 64; int tk = 0;
    for (int tl = ttop; tl >= 0; tl -= NGW) { const int t = xr_row(tl);
        TabRegs TR; const size_t tch = tgt + (size_t)(tk >> 1) * TNT; const bool tdo = tch < TSTEPS;
        if (tdo) tab_load((tk & 1) ? F.peer_v : F.peer_u, tch, TR);
        {
            v4u cu[4];
#pragma unroll
            for (int j = 0; j < 4; ++j) cu[j] = nx[j];
            if (tl - NGW >= 0) {
#pragma unroll
                for (int j = 0; j < 4; ++j) nx[j] = SC[(size_t)xr_row(tl - NGW) * 256 + (lane & ~3) * 4 + 4 * j + q]; }
            float L[16], L2[16];
#pragma unroll
            for (int j = 0; j < 2; ++j)
#pragma unroll
                for (int e = 0; e < 4; ++e) { const unsigned wa = cu[j][e], wb = cu[2 + j][e]; const pg8::h2_t ha = __builtin_bit_cast(pg8::h2_t, wa), hb2 = __builtin_bit_cast(pg8::h2_t, wb); const unsigned n = 32u * j + 8 * q + 2 * e;
                    L[8 * j + 2 * e] = __uint_as_float((__float_as_uint((float)ha.x) & 0xFFFFFF80u) | n); L[8 * j + 2 * e + 1] = __uint_as_float((__float_as_uint((float)ha.y) & 0xFFFFFF80u) | (n + 1u));
                    L2[8 * j + 2 * e] = __uint_as_float((__float_as_uint((float)hb2.x) & 0xFFFFFF80u) | (n + 64u)); L2[8 * j + 2 * e + 1] = __uint_as_float((__float_as_uint((float)hb2.y) & 0xFFFFFF80u) | (n + 65u)); }
            sort16_desc(L); sort16_desc(L2); merge_top16(L, L2);
            merge16<0xB1>(L); merge16<0x4E>(L);
            if (q == 0) { LAS v4u* dst = (LAS v4u*)(Sub + (lane >> 2) * 16);
#pragma unroll
                for (int i4 = 0; i4 < 4; ++i4) dst[i4] = (v4u){__float_as_uint(L[4 * i4]), __float_as_uint(L[4 * i4 + 1]), __float_as_uint(L[4 * i4 + 2]), __float_as_uint(L[4 * i4 + 3])}; }
        }
        LDS_WAIT(); asm volatile("" ::: "memory");
        float c[16];
        {
            const v4u x0 = *(LAS const v4u*)(hb + xo0), x1 = *(LAS const v4u*)(hb + xo1); const float y0 = __uint_as_float(hb[yo0]), y1 = __uint_as_float(hb[yo1]);
            float A[8];
#pragma unroll
            for (int e = 0; e < 4; ++e) { A[e] = __uint_as_float((__float_as_uint(__uint_as_float(x0[e]) + y0) & 0xFFFFFF00u) | tag[e]); A[4 + e] = __uint_as_float((__float_as_uint(__uint_as_float(x1[e]) + y1) & 0xFFFFFF00u) | tag[4 + e]); }
            sort8_desc(A);
            merge8to16<0xB1>(A, c);
        }
        merge16<0x4E>(c); merge16<0x141>(c);
        float s0, s1;
        { const float a0 = kb0 ? c[2] : c[0], a1 = kb0 ? c[6] : c[4], a2 = kb0 ? c[10] : c[8], a3 = kb0 ? c[14] : c[12]; const float b0 = kb1 ? a1 : a0, b1 = kb1 ? a3 : a2; s0 = kb2 ? b1 : b0; }
        { const float a0 = kb0 ? c[3] : c[1], a1 = kb0 ? c[7] : c[5], a2 = kb0 ? c[11] : c[9], a3 = kb0 ? c[15] : c[13]; const float b0 = kb1 ? a1 : a0, b1 = kb1 ? a3 : a2; s1 = kb2 ? b1 : b0; }
        const unsigned t0 = __float_as_uint(s0) & 0xFFu, t1 = __float_as_uint(s1) & 0xFFu;
        const unsigned ab0 = hb[t0 >> 4], bb0 = hb[16 + (t0 & 15u)], ab1 = hb[t1 >> 4], bb1 = hb[16 + (t1 & 15u)];
        const float h0 = __uint_as_float(ab0) + __uint_as_float(bb0), h1 = __uint_as_float(ab1) + __uint_as_float(bb1);
        const unsigned e0 = (ab0 & 127u) * 128u + (bb0 & 127u), e1 = (ab1 & 127u) * 128u + (bb1 & 127u);
        float mx = __builtin_fmaxf(h0, h1); mx = dpp_max<0xB1>(mx); mx = dpp_max<0x4E>(mx); mx = dpp_max<0x141>(mx);
        const float x0e = fexp2((h0 - mx) * 1.44269504089f), x1e = fexp2((h1 - mx) * 1.44269504089f);
        float sm = x0e + x1e; sm = dpp_add<0xB1>(sm); sm = dpp_add<0x4E>(sm); sm = dpp_add<0x141>(sm);
        const float inv = __builtin_amdgcn_rcpf(sm);
        EID32[(size_t)t * 64 + lane] = e0 | (e1 << 16);
        GW2[(size_t)t * 64 + lane] = (f32x2v){x0e * inv, x1e * inv};
        if (tdo) { if (tk & 1) tab_store_v(F, tch, TR); else tab_store_u(F, tch, TR); }
        ++tk;
        LDS_WAIT(); asm volatile("" ::: "memory");
    }
    for (;; ++tk) {
        const size_t tch = tgt + (size_t)(tk >> 1) * TNT; if (tch >= TSTEPS) break;
        TabRegs TR; tab_load((tk & 1) ? F.peer_v : F.peer_u, tch, TR);
        if (tk & 1) tab_store_v(F, tch, TR); else tab_store_u(F, tch, TR); }
}
typedef float f32x2c __attribute__((ext_vector_type(2)));
__device__ __forceinline__ long mk64(unsigned lo, unsigned hi) { return (long)(((unsigned long long)hi << 32) | lo); }
#if MK_U4
typedef int v8i_q __attribute__((ext_vector_type(8)));
__device__ __forceinline__ void p6b(Frame& F) { F.fence_ids();
    const int j = F.bid & 7, s2 = j >> 1, par = j & 1, nsb = F.G >> 3; if ((F.bid >> 3) >= nsb) return;
    const int wj = (F.bid >> 3) * NWAVES + F.wave, NW = nsb * NWAVES, NI = MT / 2;
    const int lane = F.lane, g = lane >> 4;
    const int pidx = (4 * (lane & 15) + (lane >> 4)) * 4;
    const unsigned char* H8 = F.dout + DO_H2F8 + (size_t)s2 * MT * 256 + 16 * g; const unsigned char* U4 = F.ws + WS_UE8 + (size_t)s2 * 16384 * 128 + 16 * (lane & 3); const unsigned short* EID = (const unsigned short*)(F.ws + WS_EID) + (lane >> 2);
    unsigned* PDp = (unsigned*)(F.ws + WS_PD) + (size_t)s2 * MT * 64;
#define TOK(ix_) (2 * ((ix_) < NI ? (ix_) : NI - 1) + par)
#define P6B_LOAD_EID(E, ix_) do { const int tc_ = TOK(ix_); _Pragma("unroll") for (int h = 0; h < 8; ++h) E[h] = EID[(size_t)tc_ * 128 + 16 * h]; } while (0)
#define P6B_LOAD_AB(A_, B0_, B1_, E, ix_) do { const int tc_ = TOK(ix_); const unsigned char* hp_ = H8 + (size_t)tc_ * 256; A_[0] = *(const v4u*)hp_; A_[1] = *(const v4u*)(hp_ + 64); A_[2] = *(const v4u*)(hp_ + 128); A_[3] = *(const v4u*)(hp_ + 192); \
        _Pragma("unroll") for (int h = 0; h < 8; ++h) { const unsigned char* rp_ = U4 + (size_t)E[h] * 128; B0_[h] = *(const v4u*)rp_; B1_[h] = *(const v4u*)(rp_ + 64); } } while (0)
#define BPM(x_) ((int)__builtin_amdgcn_ds_bpermute(pidx, (int)(x_)))
#define P6B_COMPUTE(A_, B0_, B1_, ix_) do { if ((ix_) < NI) { const int tc_ = 2 * (ix_) + par; \
        const v8i_q a0_ = (v8i_q){(int)A_[0].x, (int)A_[0].y, (int)A_[0].z, (int)A_[0].w, (int)A_[1].x, (int)A_[1].y, (int)A_[1].z, (int)A_[1].w}, a1_ = (v8i_q){(int)A_[2].x, (int)A_[2].y, (int)A_[2].z, (int)A_[2].w, (int)A_[3].x, (int)A_[3].y, (int)A_[3].z, (int)A_[3].w}; \
        float pv_[8]; \
        _Pragma("unroll") for (int h = 0; h < 8; ++h) { const v8i_q b0_ = (v8i_q){BPM(B0_[h].x), BPM(B0_[h].y), BPM(B0_[h].z), BPM(B0_[h].w), 0, 0, 0, 0}, b1_ = (v8i_q){BPM(B1_[h].x), BPM(B1_[h].y), BPM(B1_[h].z), BPM(B1_[h].w), 0, 0, 0, 0}; \
            f32x4 acc_ = __builtin_amdgcn_mfma_scale_f32_16x16x128_f8f6f4(a0_, b0_, (f32x4){0.f, 0.f, 0.f, 0.f}, 0, 4, 0, 0x7F7F7F7F, 0, 0x7F7F7F7F); \
            acc_ = __builtin_amdgcn_mfma_scale_f32_16x16x128_f8f6f4(a1_, b1_, acc_, 0, 4, 0, 0x7F7F7F7F, 0, 0x7F7F7F7F); pv_[h] = acc_[0] * (1.0f / 1024.0f); } \
        if (lane < 16) { _Pragma("unroll") for (int hp = 0; hp < 4; ++hp) PDp[(size_t)tc_ * 64 + 16 * hp + lane] = pk2(pv_[2 * hp], pv_[2 * hp + 1]); } } } while (0)
    unsigned E0[8], E1[8]; v4u A0[4], A1[4], B00[8], B01[8], B10[8], B11[8];
    int ix = wj;
    P6B_LOAD_EID(E0, ix); P6B_LOAD_EID(E1, ix + NW);
    P6B_LOAD_AB(A0, B00, B01, E0, ix);
    for (; ix < NI; ix += 2 * NW) {
        P6B_LOAD_AB(A1, B10, B11, E1, ix + NW);
        P6B_LOAD_EID(E0, ix + 2 * NW);
        P6B_COMPUTE(A0, B00, B01, ix);
        P6B_LOAD_AB(A0, B00, B01, E0, ix + 2 * NW);
        P6B_LOAD_EID(E1, ix + 3 * NW);
        P6B_COMPUTE(A1, B10, B11, ix + NW);
    }
#undef TOK
#undef P6B_LOAD_EID
#undef P6B_LOAD_AB
#undef P6B_COMPUTE
#undef BPM
}
#else
__device__ __forceinline__ void p6b(Frame& F) { F.fence_ids();
    const int j = F.bid & 7, nsb = F.G >> 3; if ((F.bid >> 3) >= nsb) return;
    const int wj = (F.bid >> 3) * NWAVES + F.wave, NW = nsb * NWAVES;
    const int lane = F.lane, g = lane >> 4;
    const int pidx = (4 * (lane & 15) + (lane >> 4)) * 4;
    const unsigned char* H8 = F.dout + DO_H2F8 + (size_t)j * MT * 128 + 16 * g; const unsigned char* UE8 = F.ws + WS_UE8 + (size_t)j * 16384 * 128 + 16 * (lane & 3); const unsigned* EID = (const unsigned*)(F.ws + WS_EID) + (lane >> 2);
    float* PD = (float*)(F.ws + WS_PD) + (size_t)j * MT * 128;
#define P6B_LOAD_EID(E, tt) do { const int tc_ = (tt) < MT ? (tt) : MT - 1; _Pragma("unroll") for (int h = 0; h < 8; ++h) E[h] = EID[(size_t)tc_ * 128 + 16 * h]; } while (0)
#define P6B_LOAD_AB(A0_, A1_, B0_, B1_, E, tt) do { const int tc_ = (tt) < MT ? (tt) : MT - 1; const unsigned char* hp_ = H8 + (size_t)tc_ * 128; A0_ = *(const v4u*)hp_; A1_ = *(const v4u*)(hp_ + 64); \
        _Pragma("unroll") for (int h = 0; h < 8; ++h) { const unsigned char* rp_ = UE8 + (size_t)E[h] * 128; B0_[h] = *(const v4u*)rp_; B1_[h] = *(const v4u*)(rp_ + 64); } } while (0)
#define BPM(x_) ((unsigned)__builtin_amdgcn_ds_bpermute(pidx, (int)(x_)))
#define P6B_COMPUTE(A0_, A1_, B0_, B1_, tt) do { if ((tt) < MT) { _Pragma("unroll") for (int h = 0; h < 8; ++h) { f32x4 acc_ = (f32x4){0.f, 0.f, 0.f, 0.f}; \
            acc_ = __builtin_amdgcn_mfma_f32_16x16x32_fp8_fp8(mk64(A0_.x, A0_.y), mk64(BPM(B0_[h].x), BPM(B0_[h].y)), acc_, 0, 0, 0); \
            acc_ = __builtin_amdgcn_mfma_f32_16x16x32_fp8_fp8(mk64(A0_.z, A0_.w), mk64(BPM(B0_[h].z), BPM(B0_[h].w)), acc_, 0, 0, 0); \
            acc_ = __builtin_amdgcn_mfma_f32_16x16x32_fp8_fp8(mk64(A1_.x, A1_.y), mk64(BPM(B1_[h].x), BPM(B1_[h].y)), acc_, 0, 0, 0); \
            acc_ = __builtin_amdgcn_mfma_f32_16x16x32_fp8_fp8(mk64(A1_.z, A1_.w), mk64(BPM(B1_[h].z), BPM(B1_[h].w)), acc_, 0, 0, 0); \
            if (lane < 16) PD[(size_t)(tt) * 128 + 16 * h + lane] = acc_[0] * (1.0f / 8192.0f); } } } while (0)
    unsigned E0[8], E1[8]; v4u A00, A01, A10, A11, B00[8], B01[8], B10[8], B11[8];
    int t = wj;
    P6B_LOAD_EID(E0, t); P6B_LOAD_EID(E1, t + NW);
    P6B_LOAD_AB(A00, A01, B00, B01, E0, t);
    for (; t < MT; t += 2 * NW) {
        P6B_LOAD_AB(A10, A11, B10, B11, E1, t + NW);
        P6B_LOAD_EID(E0, t + 2 * NW);
        P6B_COMPUTE(A00, A01, B00, B01, t);
        P6B_LOAD_AB(A00, A01, B00, B01, E0, t + 2 * NW);
        P6B_LOAD_EID(E1, t + 3 * NW);
        P6B_COMPUTE(A10, A11, B10, B11, t + NW);
    }
#undef P6B_LOAD_EID
#undef P6B_LOAD_AB
#undef P6B_COMPUTE
#undef BPM
}
#endif
struct P6b2Regs { v4u w[4]; f32x4 ga, gb; };
__device__ __forceinline__ void p6b2_load(const Frame& F, size_t i, P6b2Regs& R) {
    const unsigned* PDp = (const unsigned*)(F.ws + WS_PD); const float* GWp = (const float*)(F.ws + WS_GW);
    const size_t t = i >> 4; const int hp = (int)(i >> 2) & 3, l0 = (int)(i & 3) * 4;
#pragma unroll
    for (int jj = 0; jj < 4; ++jj) R.w[jj] = *(const v4u*)(PDp + ((size_t)jj * MT + t) * 64 + hp * 16 + l0);
    R.ga = *(const f32x4*)(GWp + t * 128 + (2 * hp) * 16 + l0); R.gb = *(const f32x4*)(GWp + t * 128 + (2 * hp + 1) * 16 + l0);
}
__device__ __forceinline__ void p6b2(Frame& F) { F.fence_ids();
    bf16* ACT = (bf16*)(F.ws + WS_ACT);
    const size_t gt = (size_t)F.bid * 512 + F.tid, NT = (size_t)F.G * 512, NI = (size_t)MT * 16;
    P6b2Regs N; if (gt < NI) p6b2_load(F, gt, N);
    for (size_t i = gt; i < NI; i += NT) {
        const P6b2Regs C = N; asm volatile("" ::: "memory");
        if (i + NT < NI) p6b2_load(F, i + NT, N);
        const size_t t = i >> 4; const int hp = (int)(i >> 2) & 3, l0 = (int)(i & 3) * 4;
        f32x4 sl = (f32x4){0.f, 0.f, 0.f, 0.f}, sh = sl;
#pragma unroll
        for (int jj = 0; jj < 4; ++jj) { const v4u w = C.w[jj]; sl += (f32x4){bflo(w.x), bflo(w.y), bflo(w.z), bflo(w.w)}; sh += (f32x4){bfhi(w.x), bfhi(w.y), bfhi(w.z), bfhi(w.w)}; }
        v2u o; o.x = pk2(gelu1(sl[0]) * C.ga[0], gelu1(sl[1]) * C.ga[1]); o.y = pk2(gelu1(sl[2]) * C.ga[2], gelu1(sl[3]) * C.ga[3]);
        *(v2u*)(ACT + t * 128 + (2 * hp) * 16 + l0) = o;
        o.x = pk2(gelu1(sh[0]) * C.gb[0], gelu1(sh[1]) * C.gb[1]); o.y = pk2(gelu1(sh[2]) * C.gb[2], gelu1(sh[3]) * C.gb[3]);
        *(v2u*)(ACT + t * 128 + (2 * hp + 1) * 16 + l0) = o;
    }
}
__device__ __forceinline__ void p6c(Frame& F) { F.fence_ids();
    const int j = F.bid & 7, nsb = F.G >> 3; if ((F.bid >> 3) >= nsb) return;
    const int wj = (F.bid >> 3) * NWAVES + F.wave, NW = nsb * NWAVES;
    const int lane = F.lane, g8 = lane >> 3, s8 = lane & 7;
    LAS float* Act = (LAS float*)(F.lds + F.wave * 8192); LAS unsigned* Eidl = (LAS unsigned*)(F.lds + F.wave * 8192 + 4096);
    const unsigned char* VE8 = F.ws + WS_VE8 + (size_t)j * 16384 * 128 + 16 * s8; const unsigned short* EID = (const unsigned short*)(F.ws + WS_EID); const bf16* ACT = (const bf16*)(F.ws + WS_ACT);
    bf16* PEERS = (bf16*)(F.ws + WS_PEERS) + (size_t)j * MT * 128;
    for (int tg = wj; tg < MT / 8; tg += NW) {
        const size_t t0 = (size_t)tg * 8;
#pragma unroll
        for (int q = 0; q < 4; ++q) { const int idx = 4 * (lane + 64 * q);
            const v2u aw = *(const v2u*)(ACT + t0 * 128 + idx), ew = *(const v2u*)(EID + t0 * 128 + idx);
            *(LAS f32x4*)(Act + idx) = (f32x4){bflo(aw.x), bfhi(aw.x), bflo(aw.y), bfhi(aw.y)}; *(LAS v4u*)(Eidl + idx) = (v4u){ew.x & 0xFFFFu, ew.x >> 16, ew.y & 0xFFFFu, ew.y >> 16}; }
        LDS_WAIT(); asm volatile("" ::: "memory");
        f32x2c acc2[8];
#pragma unroll
        for (int e = 0; e < 8; ++e) acc2[e] = (f32x2c){0.f, 0.f};
        LAS const float* ap = Act + g8 * 128; LAS const unsigned* ep = Eidl + g8 * 128;
        v4u va[8], vb[8]; f32x4 aa[2], ab[2];
#define P6C_LOAD(V_, A_, base) do { A_[0] = *(LAS const f32x4*)(ap + (base)); A_[1] = *(LAS const f32x4*)(ap + (base) + 4); const v4u e0_ = *(LAS const v4u*)(ep + (base)), e1_ = *(LAS const v4u*)(ep + (base) + 4); \
            _Pragma("unroll") for (int k = 0; k < 4; ++k) { V_[k] = *(const v4u*)(VE8 + (size_t)e0_[k] * 128); V_[4 + k] = *(const v4u*)(VE8 + (size_t)e1_[k] * 128); } } while (0)
#define P6C_FMA(V_, A_) do { _Pragma("unroll") for (int k = 0; k < 8; ++k) { const float a_ = A_[k >> 2][k & 3]; const f32x2c a2_ = (f32x2c){a_, a_}; _Pragma("unroll") for (int w = 0; w < 4; ++w) { \
            const f32x2c lo_ = __builtin_amdgcn_cvt_pk_f32_fp8((int)V_[k][w], false), hi_ = __builtin_amdgcn_cvt_pk_f32_fp8((int)V_[k][w], true); \
            acc2[2 * w] = __builtin_elementwise_fma(a2_, lo_, acc2[2 * w]); acc2[2 * w + 1] = __builtin_elementwise_fma(a2_, hi_, acc2[2 * w + 1]); } } } while (0)
        P6C_LOAD(va, aa, 0);
        for (int it = 0; it < 128; it += 16) {
            P6C_LOAD(vb, ab, it + 8);
            P6C_FMA(va, aa);
            if (it + 16 < 128) P6C_LOAD(va, aa, it + 16);
            P6C_FMA(vb, ab);
        }
#undef P6C_LOAD
#undef P6C_FMA
        float acc[16];
#pragma unroll
        for (int e = 0; e < 8; ++e) { acc[2 * e] = acc2[e][0]; acc[2 * e + 1] = acc2[e][1]; }
        { bf16* op = PEERS + (t0 + g8) * 128 + 16 * s8;
            v4u o0, o1;
            o0.x = pk2(acc[0] * 0.0625f, acc[1] * 0.0625f); o0.y = pk2(acc[2] * 0.0625f, acc[3] * 0.0625f); o0.z = pk2(acc[4] * 0.0625f, acc[5] * 0.0625f); o0.w = pk2(acc[6] * 0.0625f, acc[7] * 0.0625f);
            o1.x = pk2(acc[8] * 0.0625f, acc[9] * 0.0625f); o1.y = pk2(acc[10] * 0.0625f, acc[11] * 0.0625f); o1.z = pk2(acc[12] * 0.0625f, acc[13] * 0.0625f); o1.w = pk2(acc[14] * 0.0625f, acc[15] * 0.0625f);
            *(v4u*)op = o0; *(v4u*)(op + 8) = o1; }
        LDS_WAIT(); asm volatile("" ::: "memory");
    }
}
__device__ __forceinline__ void p6d(Frame& F) { F.fence_ids();
    const int gw = F.bid * NWAVES + F.wave, NGW = F.G * NWAVES; const bf16* PEERS = (const bf16*)(F.ws + WS_PEERS); const float* gate2 = (const float*)(F.ws + WS_MOD) + 5120;
    f32x4 fg[4];
#pragma unroll
    for (int q = 0; q < 4; ++q) fg[q] = *((const f32x4*)F.final_g + F.lane + 64 * q);
    f32x4 nx[4]; v2u np[4];
#define P6D_LOAD(tt) do { _Pragma("unroll") for (int q = 0; q < 4; ++q) { const int d = 4 * F.lane + 256 * q; { const v2u w_ = *((const v2u*)((const bf16*)(F.ws + WS_X1B) + (size_t)(tt) * DM) + F.lane + 64 * q); nx[q] = (f32x4){bflo(w_.x), bfhi(w_.x), bflo(w_.y), bfhi(w_.y)}; } \
        np[q] = *(const v2u*)(PEERS + ((size_t)(d >> 7) * MT + (tt)) * 128 + (d & 127)); } } while (0)
    if (gw < MT) P6D_LOAD(xr_row(gw));
    f32x4 g2[4]; int bcur = -1;
#pragma unroll
    for (int q = 0; q < 4; ++q) g2[q] = (f32x4){0.f, 0.f, 0.f, 0.f};
    for (int tl = gw; tl < MT; tl += NGW) { const int t = xr_row(tl);
        const int b = t >> 12;
        if (b != bcur) { bcur = b;
#pragma unroll
            for (int q = 0; q < 4; ++q) g2[q] = *(const f32x4*)(gate2 + (size_t)b * 6144 + 4 * F.lane + 256 * q); }
        f32x4* xr = (f32x4*)((float*)F.dout + (size_t)t * DM) + F.lane; f32x4 o[4]; float ss = 0.f;
#pragma unroll
        for (int q = 0; q < 4; ++q) {
            o[q] = nx[q] + g2[q] * (f32x4){bflo(np[q].x), bfhi(np[q].x), bflo(np[q].y), bfhi(np[q].y)}; ss += (o[q][0] * o[q][0] + o[q][1] * o[q][1]) + (o[q][2] * o[q][2] + o[q][3] * o[q][3]); }
        if (tl + NGW < MT) P6D_LOAD(xr_row(tl + NGW));
        const float rstd = __builtin_amdgcn_rsqf(wave_sum(ss) * (1.f / DM) + EPSN);
#pragma unroll
        for (int q = 0; q < 4; ++q) xr[64 * q] = o[q] * rstd * fg[q];
    }
#undef P6D_LOAD
}

struct Args { const float* in[20]; float* out; unsigned char* ws; int ph_lo, ph_hi, li, pad; };
__global__ void __launch_bounds__(NWAVES * 64, 2) mk_fwd(Args args) {
    extern __shared__ __attribute__((aligned(16))) unsigned char lds_raw[];
    Frame F;
    F.lds = (LAS unsigned char*)lds_raw;
    F.tid = threadIdx.x; F.lane = F.tid & 63; F.wave = __builtin_amdgcn_readfirstlane(F.tid >> 6); F.G = gridDim.x; F.bid = blockIdx.x;
    F.x = args.in[0]; F.c = args.in[1]; F.w_ada = args.in[2]; F.b_ada = args.in[3]; F.norm1_g = args.in[4]; F.w_in = args.in[5]; F.ret_gn_g = args.in[6]; F.sgu_ln_g = args.in[7];
    F.sgu_ln_b = args.in[8]; F.sgu_w = args.in[9]; F.sgu_b = args.in[10]; F.w_ret_out = args.in[11]; F.w_sgu_out = args.in[12]; F.w_out = args.in[13]; F.norm2_g = args.in[14];
    F.peer_w_q = args.in[15]; F.peer_sub_keys = args.in[16]; F.peer_u = args.in[17]; F.peer_v = args.in[18]; F.final_g = args.in[19];
    F.ws = args.ws; F.dout = (unsigned char*)args.out;
    volatile LAS unsigned* MISC = (volatile LAS unsigned*)(F.lds + MISC_OFF); F.misc = MISC;
    if (F.tid < 64) MISC[F.tid] = 0u;
    __syncthreads();
    XcdBarrier bar; bar.bar = (unsigned*)(F.ws + WS_CTL) + CW_BAR; bar.x = 0; bar.st = nullptr;
    if (N_LAUNCHES == 1) bar = xcd_barrier_post((unsigned*)(F.ws + WS_CTL) + CW_BAR, MISC + 8);
    const int lo = args.ph_lo, hi = args.ph_hi;
#define IN(k) (lo <= (k) && (k) < hi)
#if MK_PROBE_HI > 0
#define STAMP(k) do { if (F.bid == 0 && F.wave == 0 && F.lane == 0) { const unsigned long long _t = __builtin_amdgcn_s_memrealtime(); MISC[16 + 2 * (k)] = (unsigned)_t; MISC[17 + 2 * (k)] = (unsigned)(_t >> 32); } } while (0)
#else
#define STAMP(k) do { } while (0)
#endif
    unsigned lgen = 0u; bool xlocal = false;
#define SEAM(k) do { if (IN(k) && IN((k) + 1)) { if (xlocal && (k) >= 1 && (k) <= 9) xcd_local_barrier(bar, lgen); else xcd_barrier(bar); } } while (0)
    const float* mod = (const float*)(F.ws + WS_MOD);
    STAMP(0);
    if (IN(0)) { p0a(F); SEAM(0); }
    if (N_LAUNCHES == 1 && lo == 0 && hi == N_PHASES) { const unsigned vb = (unsigned)__builtin_amdgcn_readfirstlane((int)MISC[8 + 3]); if (vb != 0u) { F.bid = (int)(vb - 1u); xlocal = true; } }
    STAMP(1);
    if (IN(1)) { norm_rows<2>(F, F.x, F.norm1_g, mod + 0, mod + 1024, nullptr, F.dout + DO_H); SEAM(1); }
    STAMP(2);
    if (IN(2)) {
        pg8::Gemm g{(const bf16*)(F.dout + DO_H), (const bf16*)(F.ws + WS_WIN), MT, NIN, 512}; pg8::StaticOrder S; S.init(MT, NIN, F.G, F.bid);
        pg8::EpiProj E{(bf16*)(F.dout + DO_Q), (bf16*)(F.dout + DO_K), (bf16*)(F.ws + WS_V), (bf16*)(F.ws + WS_G), (bf16*)(F.ws + WS_U), (bf16*)(F.ws + WS_SV), (bf16*)(F.ws + WS_GA), (bf16*)(F.ws + WS_GB),
                       (const float*)(F.ws + WS_COS), (const float*)(F.ws + WS_SIN), 1.0f / 4096.0f, (float*)(F.ws + WS_SVSTAT)};
        pg8::gemm_phase<pg8::EpiProj, pg8::StaticOrder, true, true, true>(F.lds, g, S, E);
        SEAM(2);
    }
    STAMP(3);
    if (IN(3)) { p2a(F); SEAM(3); }
    STAMP(4);
    if (IN(4)) { p2b(F); SEAM(4); }
    STAMP(5);
    if (IN(5)) { p2c(F); SEAM(5); }
    STAMP(6);
    if (IN(6)) {
        pg8::StaticOrder S; S.init(MT, DM, F.G, F.bid);
        pg8::Gemm g{(const bf16*)(F.ws + WS_YG8), (const bf16*)(F.ws + WS_WRET), MT, DM, 1024, 512, (const bf16*)(F.ws + WS_YS8), (const bf16*)(F.ws + WS_WSGU), 8};
        pg8::EpiMerged E{F.ws + WS_GA, F.ws + WS_GB, F.ws + WS_MRG8, 1.0f / 4096.0f};
        pg8::gemm_phase<pg8::EpiMerged, pg8::StaticOrder, true, true, true>(F.lds, g, S, E);
        SEAM(6);
    }
    STAMP(7);
    if (IN(7)) {
        pg8::Gemm g{(const bf16*)(F.ws + WS_MRG8), (const bf16*)(F.ws + WS_WOUT), MT, DM, 512}; pg8::StaticOrder S; S.init(MT, DM, F.G, F.bid);
        pg8::EpiX1 E{F.x, mod + 2048, (bf16*)(F.ws + WS_X1B), 1.0f / 4096.0f};
        pg8::gemm_phase<pg8::EpiX1, pg8::StaticOrder, true, true, true>(F.lds, g, S, E);
        SEAM(7);
    }
    STAMP(8);
    if (IN(8)) { norm_rows<1>(F, (const float*)(F.ws + WS_X1B), F.norm2_g, mod + 3072, mod + 4096, (bf16*)(F.ws + WS_SV), F.dout + DO_H2F8); SEAM(8); }
    STAMP(9);
    if (IN(9)) {
        pg8::Gemm g{(const bf16*)(F.ws + WS_SV), (const bf16*)(F.ws + WS_WQ), MT, 2048, 512}; pg8::StaticOrder S; S.init(MT, 2048, F.G, F.bid);
        pg8::EpiPlain E{(bf16*)(F.ws + WS_SC), 2048, (const float*)(F.ws + WS_RS), 1.0f / WQ_SCALE};
        pg8::gemm_phase<pg8::EpiPlain, pg8::StaticOrder, true, true, false, true>(F.lds, g, S, E);
        SEAM(9);
    }
    STAMP(10);
    if (IN(10)) { p5b6a(F); SEAM(10); }
    STAMP(11);
    STAMP(12);
    if (IN(12)) { p6b(F); SEAM(12); }
    STAMP(13);
    if (IN(13)) { p6b2(F); SEAM(13); }
    STAMP(14);
    if (IN(14)) { p6c(F); SEAM(14); }
    STAMP(15);
    if (IN(15)) { p6d(F); }
    STAMP(16);
#if MK_PROBE_HI > 0
    __syncthreads();
    if (F.bid == 0 && F.tid == 0) { const unsigned long long t0 = ((unsigned long long)MISC[17 + 2 * MK_PROBE_LO] << 32) | MISC[16 + 2 * MK_PROBE_LO], t1 = ((unsigned long long)MISC[17 + 2 * MK_PROBE_HI] << 32) | MISC[16 + 2 * MK_PROBE_HI];
#if MK_GPROBE == 1
        ((float*)F.dout)[0] += (float)MISC[56] * 1e-3f; }
#elif MK_GPROBE == 2
        ((float*)F.dout)[0] += (float)MISC[57] * 1e-3f; }
#else
        ((float*)F.dout)[0] += (float)(t1 - t0) * 1e-3f; }
#endif
#endif
#undef IN
#undef SEAM
}

extern "C" void kernel_launch(void* const* d_in, const int* in_sizes, int n_in, void* d_out, int out_size, void* d_ws, size_t ws_size, hipStream_t stream) {
    static int grid = 0;
    if (grid == 0) {
        if (n_in != 20 || out_size != MT * DM || ws_size < WS_END) { fprintf(stderr, "kernel_launch: unexpected shapes (n_in %d, out %d, ws %zu); nothing launched\n", n_in, out_size, ws_size); grid = -1; return; }
        int dev = 0, cus = 0, per_cu = 0;
        if (hipGetDevice(&dev) != hipSuccess || hipDeviceGetAttribute(&cus, hipDeviceAttributeMultiprocessorCount, dev) != hipSuccess) { grid = -1; return; }
        if (hipFuncSetAttribute((const void*)mk_fwd, hipFuncAttributeMaxDynamicSharedMemorySize, LDS_BYTES) != hipSuccess) { fprintf(stderr, "kernel_launch: hipFuncSetAttribute failed\n"); grid = -1; return; }
        if (hipOccupancyMaxActiveBlocksPerMultiprocessor(&per_cu, (const void*)mk_fwd, NWAVES * 64, LDS_BYTES) != hipSuccess || per_cu < 1)
            fprintf(stderr, "kernel_launch: note: occupancy query reports %d workgroups per CU\n", per_cu);
        (void)hipGetLastError();
        grid = cus;
    }
    if (grid < 0) return;
    if (hipMemsetAsync((char*)d_ws + WS_CTL, 0, CTL_ZERO_BYTES, stream) != hipSuccess) { fprintf(stderr, "kernel_launch: memset failed\n"); return; }
    Args a{};
    for (int i = 0; i < 20; ++i) a.in[i] = (const float*)d_in[i];
    a.out = (float*)d_out; a.ws = (unsigned char*)d_ws;
    static_assert(N_LAUNCHES == 1 || N_LAUNCHES == N_PHASES, "N_LAUNCHES is 1 or N_PHASES");
    for (int li = 0; li < N_LAUNCHES && li < MK_MAXPH; ++li) {
        a.ph_lo = (N_LAUNCHES == 1) ? 0 : li; a.ph_hi = (N_LAUNCHES == 1) ? N_PHASES : li + 1; a.li = li;
        hipLaunchKernelGGL(mk_fwd, dim3(grid), dim3(NWAVES * 64), LDS_BYTES, stream, a);
        const hipError_t le = hipPeekAtLastError();
        if (le != hipSuccess) { fprintf(stderr, "kernel_launch: launch %d failed: %s\n", li, hipGetErrorName(le)); break; }
    }
}
```
